# Optimizing an MI355X kernel written in HIP

```python
import jax
import jax.numpy as jnp
from jax import lax
import numpy as np

D_MODEL = 1024
BATCH = 8
SEQ = 4096
DEPTH = 2

CTX_LEN = 256
GRID_W = 64
HEAD_DIM = 64
NORM_EPS = 1e-6
ROPE_BASE = 10000.0
NEG_INF = -1e30
Q_BLOCK = 128

MLA_HEADS = 4
MLA_Q_RANK = 192
MLA_KV_RANK = 128
MLA_NOPE = 64
MLA_ROPE = 32
MLA_V = 64

SWA_Q_HEADS = 8
SWA_KV_HEADS = 2
SWA_WINDOW = 128
SWA_BLOCK = 128

RET_HEADS = 4
RET_DK = 64
RET_DV = 64
RET_CHUNK = 128

D_FF = 2816
N_EXPERTS = 8
TOP_K = 2
D_FF_EXPERT = 3584

IN_SIZES = (MLA_Q_RANK, MLA_KV_RANK, MLA_ROPE,
            SWA_Q_HEADS * HEAD_DIM, SWA_KV_HEADS * HEAD_DIM, SWA_KV_HEADS * HEAD_DIM,
            RET_HEADS * RET_DK, RET_HEADS * RET_DK, RET_HEADS * RET_DV, RET_HEADS * RET_DV)
IN_DIM = sum(IN_SIZES)
MIX_DIM = MLA_HEADS * MLA_V + SWA_Q_HEADS * HEAD_DIM + RET_HEADS * RET_DV
N_DENSE = (DEPTH + 1) // 2
N_MOE = DEPTH // 2

kernel_name = 'hybrid_mla_swa_retention_moe_dit'


def _rms(x):
    xf = x.astype(jnp.float32)
    return xf * lax.rsqrt(jnp.mean(xf * xf, axis=-1, keepdims=True) + NORM_EPS)


def rms_norm(x, g):
    return (_rms(x) * g.astype(jnp.float32)).astype(x.dtype)


def modulate(h, shift, scale):
    return h * (1.0 + scale) + shift


def rope_angles(pos, dim):
    inv = ROPE_BASE ** (-jnp.arange(0, dim, 2, dtype=jnp.float32) / dim)
    ang = pos.astype(jnp.float32)[:, None] * inv[None, :]
    ang = jnp.concatenate([ang, ang], axis=-1)
    return jnp.cos(ang), jnp.sin(ang)


def apply_rope(x, cos, sin):
    x1, x2 = jnp.split(x, 2, axis=-1)
    rot = jnp.concatenate([-x2, x1], axis=-1)
    return (x * cos[:, None, :] + rot * sin[:, None, :]).astype(x.dtype)


def axial_rope(x, rows, cols):
    half = x.shape[-1] // 2
    cr, sr = rope_angles(rows, half)
    cc, sc = rope_angles(cols, half)
    return jnp.concatenate([apply_rope(x[..., :half], cr, sr),
                            apply_rope(x[..., half:], cc, sc)], axis=-1)


def split_proj(p):
    cuts = [int(v) for v in np.cumsum(IN_SIZES)[:-1]]
    return jnp.split(p, cuts, axis=-1)


def flip_seq(t):
    return t[:, ::-1]


def mla_queries(cq, q_norm, w_uq, rows, cols):
    B, L, _ = cq.shape
    q = (rms_norm(cq, q_norm) @ w_uq).reshape(B, L, MLA_HEADS, MLA_NOPE + MLA_ROPE)
    q_pe = q[..., MLA_NOPE:]
    if rows is not None:
        q_pe = axial_rope(q_pe, rows, cols)
    return jnp.concatenate([q[..., :MLA_NOPE], q_pe], axis=-1)


def mla_keys_values(ckv, k_pe, kv_norm, w_ukv, rows, cols):
    B, L, _ = ckv.shape
    kv = (rms_norm(ckv, kv_norm) @ w_ukv).reshape(B, L, MLA_HEADS, MLA_NOPE + MLA_V)
    k_pe = k_pe[:, :, None, :]
    if rows is not None:
        k_pe = axial_rope(k_pe, rows, cols)
    k = jnp.concatenate([kv[..., :MLA_NOPE],
                         jnp.broadcast_to(k_pe, (B, L, MLA_HEADS, MLA_ROPE))], axis=-1)
    return k, kv[..., MLA_NOPE:]


def block_attention(q, k, v, scale):
    B, L, H, d = q.shape
    nb = L // Q_BLOCK
    q_blocks = q.reshape(B, nb, Q_BLOCK, H, d).transpose(1, 0, 2, 3, 4)

    def one_block(q_blk):
        s = jnp.einsum('bqhd,bkhd->bhqk', q_blk, k, preferred_element_type=jnp.float32) * scale
        p = jax.nn.softmax(s, axis=-1).astype(v.dtype)
        return jnp.einsum('bhqk,bkhd->bqhd', p, v)

    o = lax.map(one_block, q_blocks)
    return o.transpose(1, 0, 2, 3, 4).reshape(B, L, -1)


def sink_softmax(s, sink_g):
    sk = jnp.broadcast_to(sink_g.astype(jnp.float32)[None, :, :, None, None], s.shape[:-1] + (1,))
    return jax.nn.softmax(jnp.concatenate([s, sk], axis=-1), axis=-1)[..., :-1]


def banded_sink_attention(q, k, v, k_ctx, v_ctx, sink):
    B, L, Hq, d = q.shape
    Hkv = k.shape[2]
    G = Hq // Hkv
    W = SWA_BLOCK
    nb = L // W
    scale = d ** -0.5
    pad = ((0, 0), (W, W), (0, 0), (0, 0))
    k_pad = jnp.pad(k, pad)
    v_pad = jnp.pad(v, pad)
    q_blocks = q.reshape(B, nb, W, Hkv, G, d).transpose(1, 0, 2, 3, 4, 5)
    offs = jnp.arange(3 * W) - W
    rel = offs[None, :] - jnp.arange(W)[:, None]
    in_band = jnp.abs(rel) <= SWA_WINDOW
    sink_g = sink.reshape(Hkv, G)

    def one_block(args):
        i, q_blk = args
        start = i * W
        k_blk = lax.dynamic_slice_in_dim(k_pad, start, 3 * W, axis=1)
        v_blk = lax.dynamic_slice_in_dim(v_pad, start, 3 * W, axis=1)
        key_t = start + offs
        valid = in_band & ((key_t >= 0) & (key_t < L))[None, :]
        s_band = jnp.einsum('bqhgd,bkhd->bhgqk', q_blk, k_blk,
                            preferred_element_type=jnp.float32) * scale
        s_band = jnp.where(valid, s_band, NEG_INF)
        s_ctx = jnp.einsum('bqhgd,bkhd->bhgqk', q_blk, k_ctx,
                           preferred_element_type=jnp.float32) * scale
        p = sink_softmax(jnp.concatenate([s_band, s_ctx], axis=-1), sink_g)
        p_band = p[..., :3 * W].astype(v.dtype)
        p_ctx = p[..., 3 * W:].astype(v.dtype)
        return (jnp.einsum('bhgqk,bkhd->bqhgd', p_band, v_blk)
                + jnp.einsum('bhgqk,bkhd->bqhgd', p_ctx, v_ctx))

    o = lax.map(one_block, (jnp.arange(nb), q_blocks))
    return o.transpose(1, 0, 2, 3, 4, 5).reshape(B, L, Hq * d)


def full_sink_attention(q, k, v, sink):
    B, L, Hq, d = q.shape
    Hkv = k.shape[2]
    G = Hq // Hkv
    qg = q.reshape(B, L, Hkv, G, d)
    s = jnp.einsum('bqhgd,bkhd->bhgqk', qg, k, preferred_element_type=jnp.float32) * d ** -0.5
    p = sink_softmax(s, sink.reshape(Hkv, G)).astype(v.dtype)
    return jnp.einsum('bhgqk,bkhd->bqhgd', p, v).reshape(B, L, Hq * d)


def retention_scan(q, k, v, gamma, state0):
    B, L, H, _ = q.shape
    dv = v.shape[-1]
    C = RET_CHUNK
    n = L // C
    log_g = jnp.log(gamma)[:, None]
    idx = jnp.arange(C, dtype=jnp.float32)
    diff = idx[:, None] - idx[None, :]
    intra = jnp.where(diff >= 0, jnp.exp(log_g[:, :, None] * jnp.maximum(diff, 0.0)), 0.0)
    q_dec = jnp.exp(log_g * (idx + 1.0))[:, :, None]
    k_dec = jnp.exp(log_g * (C - 1.0 - idx))[:, :, None]
    chunk_dec = jnp.exp(log_g * C)[:, :, None]

    def to_chunks(t):
        return t.astype(jnp.float32).reshape(B, n, C, H, -1).transpose(1, 0, 3, 2, 4)

    def step(state, inp):
        qi, ki, vi = inp
        att = jnp.einsum('bhqd,bhkd->bhqk', qi, ki) * intra
        out = (jnp.einsum('bhqk,bhkv->bhqv', att, vi)
               + jnp.einsum('bhqd,bhdv->bhqv', qi * q_dec, state))
        state = chunk_dec * state + jnp.einsum('bhkd,bhkv->bhdv', ki * k_dec, vi)
        return state, out

    state, out = lax.scan(step, state0, (to_chunks(q), to_chunks(k), to_chunks(v)))
    return out.transpose(1, 0, 3, 2, 4).reshape(B, L, H, dv), state


def retention_output(o, g):
    B, L = g.shape[:2]
    y = _rms(o).reshape(B, L, -1)
    return (y * jax.nn.silu(g.astype(jnp.float32))).astype(g.dtype)


def hybrid_mixer(h, hc, w_in, q_norm, w_uq, kv_norm, w_ukv, sink, decay_f, decay_b, w_out,
                 need_ctx_out):
    B, L, _ = h.shape
    Lc = hc.shape[1]
    n_rows = L // GRID_W
    t = jnp.arange(n_rows * GRID_W)
    rows, cols = t // GRID_W, t % GRID_W
    cq, ckv, kpe, sq, sk, sv, rq, rk, rv, rg = split_proj(h @ w_in)
    cq_x, ckv_x, kpe_x, sq_x, sk_x, sv_x, rq_x, rk_x, rv_x, rg_x = split_proj(hc @ w_in)

    mla_scale = (MLA_NOPE + MLA_ROPE) ** -0.5
    k_a, v_a = mla_keys_values(ckv, kpe, kv_norm, w_ukv, rows, cols)
    k_a_x, v_a_x = mla_keys_values(ckv_x, kpe_x, kv_norm, w_ukv, None, None)
    q_a = mla_queries(cq, q_norm, w_uq, rows, cols)
    o_a = block_attention(q_a, jnp.concatenate([k_a, k_a_x], axis=1),
                          jnp.concatenate([v_a, v_a_x], axis=1), mla_scale)

    q_b = axial_rope(sq.reshape(B, L, SWA_Q_HEADS, HEAD_DIM), rows, cols)
    k_b = axial_rope(sk.reshape(B, L, SWA_KV_HEADS, HEAD_DIM), rows, cols)
    v_b = sv.reshape(B, L, SWA_KV_HEADS, HEAD_DIM)
    k_b_x = sk_x.reshape(B, Lc, SWA_KV_HEADS, HEAD_DIM)
    v_b_x = sv_x.reshape(B, Lc, SWA_KV_HEADS, HEAD_DIM)
    o_b = banded_sink_attention(q_b, k_b, v_b, k_b_x, v_b_x, sink)

    gamma_f = jax.nn.sigmoid(decay_f.astype(jnp.float32))
    gamma_b = jax.nn.sigmoid(decay_b.astype(jnp.float32))
    cos, sin = rope_angles(t, RET_DK)
    k_scale = RET_DK ** -0.5
    q_c = apply_rope(rq.reshape(B, L, RET_HEADS, RET_DK), cos, sin)
    k_c = apply_rope(rk.reshape(B, L, RET_HEADS, RET_DK), cos, sin) * k_scale
    v_c = rv.reshape(B, L, RET_HEADS, RET_DV)
    q_c_x = rq_x.reshape(B, Lc, RET_HEADS, RET_DK)
    k_c_x = rk_x.reshape(B, Lc, RET_HEADS, RET_DK) * k_scale
    v_c_x = rv_x.reshape(B, Lc, RET_HEADS, RET_DV)
    zero_state = jnp.zeros((B, RET_HEADS, RET_DK, RET_DV), jnp.float32)
    oc_f, s_f = retention_scan(q_c_x, k_c_x, v_c_x, gamma_f, zero_state)
    oc_b, s_b = retention_scan(flip_seq(q_c_x), flip_seq(k_c_x), flip_seq(v_c_x), gamma_b, zero_state)
    o_f, _ = retention_scan(q_c, k_c, v_c, gamma_f, s_f)
    o_bk, _ = retention_scan(flip_seq(q_c), flip_seq(k_c), flip_seq(v_c), gamma_b, s_b)
    o_c = retention_output(o_f + flip_seq(o_bk), rg)

    y = jnp.concatenate([o_a, o_b, o_c], axis=-1) @ w_out
    if not need_ctx_out:
        return y, None

    q_a_x = mla_queries(cq_x, q_norm, w_uq, None, None)
    oc_a = block_attention(q_a_x, k_a_x, v_a_x, mla_scale)
    oc_bw = full_sink_attention(sq_x.reshape(B, Lc, SWA_Q_HEADS, HEAD_DIM), k_b_x, v_b_x, sink)
    oc_c = retention_output(oc_f + flip_seq(oc_b), rg_x)
    yc = jnp.concatenate([oc_a, oc_bw, oc_c], axis=-1) @ w_out
    return y, yc


def swiglu(h, w_gate, w_up, w_down):
    return (jax.nn.silu(h @ w_gate) * (h @ w_up)) @ w_down


def moe_swiglu(h, router, w_gate, w_up, w_down):
    logits = (h @ router).astype(jnp.float32)
    top_v, top_i = lax.top_k(logits, TOP_K)
    top_w = jax.nn.softmax(top_v, axis=-1)
    gates = jnp.sum(jax.nn.one_hot(top_i, N_EXPERTS, dtype=jnp.float32) * top_w[..., None], axis=-2)
    out = jnp.zeros_like(h)
    for e in range(N_EXPERTS):
        out = out + gates[..., e:e + 1].astype(h.dtype) * swiglu(h, w_gate[e], w_up[e], w_down[e])
    return out


def channel_mixer(h, layer, ffn_w_gate, ffn_w_up, ffn_w_down, moe_router, moe_w_gate, moe_w_up,
                  moe_w_down):
    i = layer // 2
    if layer % 2 == 0:
        return swiglu(h, ffn_w_gate[i], ffn_w_up[i], ffn_w_down[i])
    return moe_swiglu(h, moe_router[i], moe_w_gate[i], moe_w_up[i], moe_w_down[i])


def setup_inputs(seed: int = 0) -> dict:
    key = jax.random.key(seed)
    keys = iter(jax.random.split(key, 32))
    f32 = jnp.float32

    def normal(shape, scale):
        return jax.random.normal(next(keys), shape, f32) * scale

    def gain(shape):
        return 1.0 + normal(shape, 0.02)

    gamma0 = 1.0 - 2.0 ** (-5.0 - jnp.arange(RET_HEADS, dtype=f32))
    decay_logit0 = jnp.log(gamma0) - jnp.log1p(-gamma0)
    return {
        'x': normal((BATCH, SEQ, D_MODEL), 1.0),
        'c': normal((BATCH, D_MODEL), 1.0),
        'ctx': normal((BATCH, CTX_LEN, D_MODEL), 1.0),
        'c_ctx': normal((D_MODEL,), 1.0),
        'w_mod': normal((DEPTH, D_MODEL, 6 * D_MODEL), 0.5 * D_MODEL ** -0.5),
        'b_mod': normal((DEPTH, 6 * D_MODEL), 0.01),
        'norm1_g': gain((DEPTH, D_MODEL)),
        'norm2_g': gain((DEPTH, D_MODEL)),
        'w_in': normal((DEPTH, D_MODEL, IN_DIM), D_MODEL ** -0.5),
        'mla_q_norm': gain((DEPTH, MLA_Q_RANK)),
        'mla_w_uq': normal((DEPTH, MLA_Q_RANK, MLA_HEADS * (MLA_NOPE + MLA_ROPE)), MLA_Q_RANK ** -0.5),
        'mla_kv_norm': gain((DEPTH, MLA_KV_RANK)),
        'mla_w_ukv': normal((DEPTH, MLA_KV_RANK, MLA_HEADS * (MLA_NOPE + MLA_V)), MLA_KV_RANK ** -0.5),
        'swa_sink': normal((DEPTH, SWA_Q_HEADS), 0.5),
        'ret_decay_fwd': decay_logit0 + normal((DEPTH, RET_HEADS), 0.05),
        'ret_decay_bwd': decay_logit0 + normal((DEPTH, RET_HEADS), 0.05),
        'w_out': normal((DEPTH, MIX_DIM, D_MODEL), MIX_DIM ** -0.5),
        'ffn_w_gate': normal((N_DENSE, D_MODEL, D_FF), D_MODEL ** -0.5),
        'ffn_w_up': normal((N_DENSE, D_MODEL, D_FF), D_MODEL ** -0.5),
        'ffn_w_down': normal((N_DENSE, D_FF, D_MODEL), D_FF ** -0.5),
        'moe_router': normal((N_MOE, D_MODEL, N_EXPERTS), D_MODEL ** -0.5),
        'moe_w_gate': normal((N_MOE, N_EXPERTS, D_MODEL, D_FF_EXPERT), D_MODEL ** -0.5),
        'moe_w_up': normal((N_MOE, N_EXPERTS, D_MODEL, D_FF_EXPERT), D_MODEL ** -0.5),
        'moe_w_down': normal((N_MOE, N_EXPERTS, D_FF_EXPERT, D_MODEL), D_FF_EXPERT ** -0.5),
        'final_norm_g': gain((D_MODEL,)),
    }


def reference(x, c, ctx, c_ctx, w_mod, b_mod, norm1_g, norm2_g, w_in, mla_q_norm, mla_w_uq,
              mla_kv_norm, mla_w_ukv, swa_sink, ret_decay_fwd, ret_decay_bwd, w_out,
              ffn_w_gate, ffn_w_up, ffn_w_down, moe_router, moe_w_gate, moe_w_up, moe_w_down,
              final_norm_g):
    xc = ctx
    cond_lat = jax.nn.silu(c)
    cond_ctx = jax.nn.silu(c_ctx)[None]
    for layer in range(DEPTH):
        last = layer == DEPTH - 1
        mod = (cond_lat @ w_mod[layer] + b_mod[layer])[:, None, :]
        mod_x = (cond_ctx @ w_mod[layer] + b_mod[layer])[:, None, :]
        sh1, sc1, g1, sh2, sc2, g2 = jnp.split(mod, 6, axis=-1)
        sh1x, sc1x, g1x, sh2x, sc2x, g2x = jnp.split(mod_x, 6, axis=-1)

        h = modulate(rms_norm(x, norm1_g[layer]), sh1, sc1)
        hc = modulate(rms_norm(xc, norm1_g[layer]), sh1x, sc1x)
        y, yc = hybrid_mixer(h, hc, w_in[layer], mla_q_norm[layer], mla_w_uq[layer],
                             mla_kv_norm[layer], mla_w_ukv[layer], swa_sink[layer],
                             ret_decay_fwd[layer], ret_decay_bwd[layer], w_out[layer],
                             not last)
        x = x + g1 * y
        h = modulate(rms_norm(x, norm2_g[layer]), sh2, sc2)
        x = x + g2 * channel_mixer(h, layer, ffn_w_gate, ffn_w_up, ffn_w_down, moe_router,
                                   moe_w_gate, moe_w_up, moe_w_down)
        if not last:
            xc = xc + g1x * yc
            hcf = modulate(rms_norm(xc, norm2_g[layer]), sh2x, sc2x)
            xc = xc + g2x * channel_mixer(hcf, layer, ffn_w_gate, ffn_w_up, ffn_w_down, moe_router,
                                          moe_w_gate, moe_w_up, moe_w_down)
    return rms_norm(x, final_norm_g)
```

```cpp
#include <hip/hip_runtime.h>
#include <stdint.h>
#include <stdio.h>

#define D_MODEL 1024
#define BATCH 8
#define SEQ 4096
#define CTXL 256
#define T_LAT (BATCH * SEQ)
#define T_CTX (BATCH * CTXL)
#define T_ALL (T_LAT + T_CTX)
#define IN_DIM 2144
#define PROJ_LD 2304
#define POST_LD 2816
#define D_FF 2816
#define D_FFE 3584
#define NEXP 8
#define NT 512
#define NORM_EPS 1e-6f

typedef unsigned short bf16_t;
__device__ __forceinline__ float bf2f(bf16_t v) { return __uint_as_float(((unsigned)v) << 16); }
__device__ __forceinline__ bf16_t f2bf(float f) { unsigned u = __float_as_uint(f); u += 0x7FFFu + ((u >> 16) & 1u); return (bf16_t)(u >> 16); }
__device__ __forceinline__ float silu_f(float v) { return v / (1.f + expf(-v)); }

#define PJ_RQ 1280
#define PJ_RK 1536
#define PJ_RV 1792
#define PJ_RG 2048
#define PJ_F8 1280
#define PC_QA 0
#define PC_KA 384
#define PC_VA 768
#define PC_QB 1024
#define PC_KB 1536
#define PC_VB 1664
#define PC_RQ 1792
#define PC_RK 2048
#define PC_RV 2304
#define PC_RG 2560

constexpr size_t AL256(size_t x) { return (x + 255) & ~(size_t)255; }
constexpr size_t OFF_CTL  = 0;
constexpr size_t CTL_BYTES = 262144;
constexpr size_t OFF_PCNT = 32768;
constexpr size_t OFF_CLAIM = 20480;
constexpr size_t OFF_CNT  = 16384;
constexpr size_t OFF_MOD  = 1u << 20;
constexpr size_t OFF_TAB  = 3u << 19;
constexpr size_t OFF_WIN  = 3u << 20;
constexpr size_t OFF_WOUT = OFF_WIN + (size_t)2 * PROJ_LD * 1024 * 2;
constexpr size_t OFF_FGU  = OFF_WOUT + (size_t)2 * 1024 * 1024 * 2;
constexpr size_t OFF_FD   = OFF_FGU + (size_t)2 * D_FF * 1024 * 2;
constexpr size_t OFF_WUQ  = OFF_FD + (size_t)1024 * D_FF * 2;
constexpr size_t OFF_WUKV = OFF_WUQ + (size_t)2 * 384 * 192 * 2;
constexpr size_t OFF_H    = OFF_WUKV + (size_t)2 * 512 * 128 * 2;
constexpr size_t OFF_XC   = OFF_H + (size_t)T_ALL * 1024 * 2;
constexpr size_t OFF_LIST = OFF_XC + (size_t)T_CTX * 1024 * 4;
constexpr size_t OFF_WL   = OFF_LIST + (size_t)2 * 8 * 32768 * 4;
constexpr size_t OFF_R    = OFF_WL + (size_t)2 * 8 * 32768 * 4;
constexpr size_t OFF_PROJ = OFF_R;
constexpr size_t OFF_POST = OFF_PROJ + (size_t)T_ALL * PROJ_LD * 2;
constexpr size_t OFF_TT   = OFF_POST + (size_t)T_ALL * POST_LD * 2;
constexpr size_t R1_END   = OFF_TT + (size_t)BATCH * 4 * 34 * 2 * 4096 * 4;
constexpr size_t OFF_ACT  = OFF_R;
constexpr size_t OFF_Y    = OFF_PROJ;
constexpr size_t OFF_H8D  = OFF_ACT + (size_t)T_ALL * D_FF;
constexpr size_t OFF_Y2   = OFF_ACT + (size_t)T_ALL * D_FF * 2;
constexpr size_t ACT_ROWS = T_LAT + NEXP * 256;
constexpr size_t OFF_MGU  = OFF_ACT + ACT_ROWS * D_FFE;
constexpr size_t OFF_MD   = OFF_MGU + (size_t)NEXP * 2 * D_FFE * 1024;
constexpr size_t OFF_PART = OFF_MD + (size_t)NEXP * 1024 * D_FFE;
constexpr size_t PART_END = OFF_PART + (size_t)256 * 65536 * 4;
constexpr size_t OFF_YM   = PART_END;
constexpr size_t OFF_INV  = OFF_YM + (size_t)2 * ACT_ROWS * 1024 * 2;
constexpr size_t YM_END   = OFF_INV + (size_t)T_LAT * 32;
constexpr size_t OFF_QK8  = YM_END;
constexpr size_t OFF_V8T  = OFF_QK8 + (size_t)T_ALL * 1024;
constexpr size_t F8_END   = OFF_V8T + (size_t)BATCH * 4 * 64 * 4352;
constexpr size_t WS_END   = F8_END > R1_END ? F8_END : R1_END;
static_assert(R1_END <= WS_END, "phase-1 buffers fit");
static_assert(WS_END <= 607070848, "workspace budget");
static_assert(OFF_Y2 + (size_t)T_ALL * 1024 * 2 <= WS_END, "Y2 fits");
static_assert(OFF_MGU >= OFF_Y + (size_t)T_ALL * 1024 * 2, "expert weights are converted while norm2(L1) still reads Y");

struct P { const float* in[25]; float* out; unsigned char* ws; };

#define XB_TMO      128
#define XB_XCNT(j)  (256  + 64 * (j))
#define XB_XSUB(j)  (1280 + 64 * (j))
#define XB_XGEN(j)  (2304 + 64 * (j))
#define XB_TOP      3328
#define XB_TOPGEN   3392
#define XCD_BAR_WORDS 3456
#define XB_SPIN_CAP (1u << 22)
#define LAS __attribute__((address_space(3)))

__device__ __forceinline__ unsigned xb_ld(unsigned* p)              { return __hip_atomic_load(p, __ATOMIC_RELAXED, __HIP_MEMORY_SCOPE_AGENT); }
__device__ __forceinline__ unsigned xb_add(unsigned* p, unsigned v) { return __hip_atomic_fetch_add(p, v, __ATOMIC_RELAXED, __HIP_MEMORY_SCOPE_AGENT); }
__device__ __forceinline__ unsigned xb_xcc_id() { return (unsigned)__builtin_amdgcn_s_getreg((3 << 11) | 20) & 0xFu; }
#define XB_SPIN(cond, bar) do { unsigned _sp = 0; while (cond) { __builtin_amdgcn_s_sleep(1); \
    if ((++_sp & 255u) == 0u) { if (xb_ld(&(bar)[XB_TMO])) break; if (_sp > XB_SPIN_CAP) { atomicAdd(&(bar)[XB_TMO], 1u); break; } } } } while (0)

struct XcdBarrier { unsigned* bar; unsigned x; volatile LAS unsigned* st; };

__device__ __forceinline__ XcdBarrier xcd_barrier_post(unsigned* bar, volatile LAS unsigned* st) {
    XcdBarrier b; b.bar = bar; b.x = xb_xcc_id(); b.st = st;
    if (threadIdx.x == 0) (void)xb_add(&bar[XB_XCNT(b.x)], 1u);
    return b;
}
__device__ __forceinline__ void xcd_barrier_complete(unsigned* bar, unsigned x, unsigned& nloc, unsigned& nx) {
    const unsigned G = gridDim.x * gridDim.y * gridDim.z;
    unsigned sum, cnt, mine, sp = 0u;
    for (;;) {
        sum = 0u; cnt = 0u; mine = 0u;
#pragma unroll
        for (unsigned j = 0; j < 16; ++j) { const unsigned c = xb_ld(&bar[XB_XCNT(j)]); sum += c; cnt += (c > 0u) ? 1u : 0u; mine = (j == x) ? c : mine; }
        if (sum == G) break;
        __builtin_amdgcn_s_sleep(1);
        if ((++sp & 255u) == 0u) { if (xb_ld(&bar[XB_TMO])) break; if (sp > XB_SPIN_CAP) { atomicAdd(&bar[XB_TMO], 1u); break; } }
    }
    nloc = mine > 0u ? mine : 1u; nx = cnt > 0u ? cnt : 1u;
}
__device__ __forceinline__ void xcd_barrier(const XcdBarrier& b) {
    asm volatile("s_waitcnt vmcnt(0)" ::: "memory");
    __syncthreads();
    if (threadIdx.x == 0) {
        unsigned* bar = b.bar;
        __builtin_amdgcn_s_waitcnt(0);
        unsigned nloc = b.st[0], nx = b.st[1];
        if (nloc == 0u) { xcd_barrier_complete(bar, b.x, nloc, nx); b.st[0] = nloc; b.st[1] = nx; }
        const unsigned old = xb_add(&bar[XB_XSUB(b.x)], 1u);
        const unsigned gen = old / nloc;
        if (old + 1u == (gen + 1u) * nloc) {
            __builtin_amdgcn_fence(__ATOMIC_RELEASE, "agent");
            asm volatile("s_waitcnt vmcnt(0)" ::: "memory");
            const unsigned og = xb_add(&bar[XB_TOP], 1u);
            const unsigned tg = og / nx;
            if (og + 1u == (tg + 1u) * nx) xb_add(&bar[XB_TOPGEN], 1u);
            else XB_SPIN(xb_ld(&bar[XB_TOPGEN]) == tg, bar);
            __builtin_amdgcn_fence(__ATOMIC_ACQUIRE, "agent");
            xb_add(&bar[XB_XGEN(b.x)], 1u);
            asm volatile("s_waitcnt vmcnt(0)" ::: "memory");
        } else {
            XB_SPIN(xb_ld(&bar[XB_XGEN(b.x)]) == gen, bar);
            __builtin_amdgcn_fence(__ATOMIC_ACQUIRE, "agent");
            asm volatile("s_waitcnt vmcnt(0)" ::: "memory");
        }
    }
    __syncthreads();
}

__device__ __forceinline__ float wave_sum(float v) {
#pragma unroll
    for (int o = 32; o > 0; o >>= 1) v += __shfl_xor(v, o);
    return v;
}
__device__ __forceinline__ void unpack8(const uint4 r, float* f) {
    f[0] = __uint_as_float(r.x << 16); f[1] = __uint_as_float(r.x & 0xFFFF0000u);
    f[2] = __uint_as_float(r.y << 16); f[3] = __uint_as_float(r.y & 0xFFFF0000u);
    f[4] = __uint_as_float(r.z << 16); f[5] = __uint_as_float(r.z & 0xFFFF0000u);
    f[6] = __uint_as_float(r.w << 16); f[7] = __uint_as_float(r.w & 0xFFFF0000u);
}
__device__ __forceinline__ int tok_row(int b, int i) { return i < SEQ ? b * SEQ + i : T_LAT + b * CTXL + (i - SEQ); }

__device__ __forceinline__ void ph_mod(const P& p, float* lds) {
    float* MOD = (float*)(p.ws + OFF_MOD);
    float* sl = lds; float* part = lds + 9 * 1024;
    int tid_ = threadIdx.x; asm volatile("" : "+v"(tid_));
    const int t = tid_, col = t & 63, ks = t >> 6;
    __syncthreads();
    for (int i = t; i < 9 * 1024; i += NT) { const int r = i >> 10, k = i & 1023; sl[i] = silu_f(r < 8 ? p.in[1][r * 1024 + k] : p.in[3][k]); }
    __syncthreads();
    for (int u = blockIdx.x; u < 2 * 96; u += gridDim.x) {
        const int l = u / 96, n = (u % 96) * 64 + col;
        const float* w = p.in[4] + (size_t)l * 1024 * 6144 + (size_t)(ks * 128) * 6144 + n;
        float acc[9];
#pragma unroll
        for (int r = 0; r < 9; ++r) acc[r] = 0.f;
#pragma unroll 8
        for (int k = 0; k < 128; ++k) { const float wv = w[(size_t)k * 6144];
#pragma unroll
            for (int r = 0; r < 9; ++r) acc[r] += sl[r * 1024 + ks * 128 + k] * wv; }
        __syncthreads();
#pragma unroll
        for (int r = 0; r < 9; ++r) part[(ks * 9 + r) * 64 + col] = acc[r];
        __syncthreads();
        for (int i = t; i < 9 * 64; i += NT) { const int r = i >> 6, c2 = i & 63; float s = 0.f;
#pragma unroll
            for (int q = 0; q < 8; ++q) s += part[(q * 9 + r) * 64 + c2];
            const int nn = (u % 96) * 64 + c2; MOD[(l * 9 + r) * 6144 + nn] = s + p.in[5][l * 6144 + nn]; }
    }
}

#define F8_SH 8.f
#define F8_SW 64.f
#define F8_SA 4.f
#define MOE_WAYS 7
__device__ __forceinline__ float f8clamp(float x) { return fminf(fmaxf(x, -448.f), 448.f); }
struct NormArgs { int layer, which; bool router, from_input; const bf16_t* resY; int res_layer, res_goff, ctx_ways; unsigned char* h8; bool both; };
__device__ __forceinline__ void norm_row(const P& p, const NormArgs& a, int row, int lane) {
    const int layer = a.layer, which = a.which, res_layer = a.res_layer, res_goff = a.res_goff, ctx_ways = a.ctx_ways; const bool router = a.router, from_input = a.from_input; const bf16_t* resY = a.resY;
    const float* MOD = (const float*)(p.ws + OFF_MOD);
    const float* gain = (which == 1 ? p.in[6] : p.in[7]) + layer * 1024;
    bf16_t* H = (bf16_t*)(p.ws + OFF_H);
    float* XC = (float*)(p.ws + OFF_XC);
    int* CNT = (int*)(p.ws + OFF_CNT);
    int* LIST = (int*)(p.ws + OFF_LIST);
    float* WL = (float*)(p.ws + OFF_WL);
    {
        const float* src; float* dstx; int r;
        if (row < T_LAT) { r = row >> 12; src = (from_input ? p.in[0] : p.out) + (size_t)row * 1024; dstx = p.out + (size_t)row * 1024; }
        else { r = 8; src = (from_input ? p.in[2] : XC) + (size_t)(row - T_LAT) * 1024; dstx = XC + (size_t)(row - T_LAT) * 1024; }
        const float* md = MOD + (layer * 9 + r) * 6144 + (which == 1 ? 0 : 3072);
        float4 v[4]; float ss = 0.f;
#pragma unroll
        for (int i = 0; i < 4; ++i) v[i] = *(const float4*)(src + i * 256 + lane * 4);
        if (resY) {
            const float* gt = MOD + (res_layer * 9 + r) * 6144 + res_goff;
#pragma unroll
            for (int i = 0; i < 4; ++i) { const int col = i * 256 + lane * 4;
                const float4 g = *(const float4*)(gt + col); float4 y;
                if (row >= T_LAT && ctx_ways > 0) {
                    const int cr = row - T_LAT; const float* pp = (const float*)(p.ws + OFF_PART) + (size_t)(((cr >> 8) * 4 + i) * ctx_ways) * 65536 + (cr & 255) * 256 + lane * 4;
                    y = *(const float4*)pp;
                    for (int q = 1; q < ctx_ways; ++q) { const float4 z = *(const float4*)(pp + (size_t)q * 65536); y.x += z.x; y.y += z.y; y.z += z.z; y.w += z.w; }
                } else { const uint2 yr = *(const uint2*)(resY + (size_t)row * 1024 + col);
                    y = make_float4(__uint_as_float(yr.x << 16), __uint_as_float(yr.x & 0xFFFF0000u), __uint_as_float(yr.y << 16), __uint_as_float(yr.y & 0xFFFF0000u)); }
                v[i].x += g.x * y.x; v[i].y += g.y * y.y; v[i].z += g.z * y.z; v[i].w += g.w * y.w;
                *(float4*)(dstx + col) = v[i]; }
        }
#pragma unroll
        for (int i = 0; i < 4; ++i) ss += v[i].x * v[i].x + v[i].y * v[i].y + v[i].z * v[i].z + v[i].w * v[i].w;
        ss = wave_sum(ss);
        const float rs = rsqrtf(ss * (1.f / 1024.f) + NORM_EPS);
        float lg[8] = {0.f, 0.f, 0.f, 0.f, 0.f, 0.f, 0.f, 0.f};
#pragma unroll
        for (int i = 0; i < 4; ++i) {
            const int col = i * 256 + lane * 4;
            const float4 g = *(const float4*)(gain + col), sh = *(const float4*)(md + col), sc = *(const float4*)(md + 1024 + col);
            float o[4];
            o[0] = (v[i].x * rs * g.x) * (1.f + sc.x) + sh.x; o[1] = (v[i].y * rs * g.y) * (1.f + sc.y) + sh.y;
            o[2] = (v[i].z * rs * g.z) * (1.f + sc.z) + sh.z; o[3] = (v[i].w * rs * g.w) * (1.f + sc.w) + sh.w;
            if (a.h8) {
                int w8 = 0; w8 = __builtin_amdgcn_cvt_pk_fp8_f32(f8clamp(o[0] * F8_SH), f8clamp(o[1] * F8_SH), w8, false); w8 = __builtin_amdgcn_cvt_pk_fp8_f32(f8clamp(o[2] * F8_SH), f8clamp(o[3] * F8_SH), w8, true);
                *(int*)(a.h8 + (size_t)row * 1024 + col) = w8;
            }
            if (!a.h8 || a.both) {
            uint2 pk; pk.x = (unsigned)f2bf(o[0]) | ((unsigned)f2bf(o[1]) << 16); pk.y = (unsigned)f2bf(o[2]) | ((unsigned)f2bf(o[3]) << 16);
            *(uint2*)(H + (size_t)row * 1024 + col) = pk; }
            if (router) {
                const float* rw = p.in[20] + (size_t)col * 8;
#pragma unroll
                for (int j = 0; j < 4; ++j) {
                    const float4 w0 = *(const float4*)(rw + j * 8), w1 = *(const float4*)(rw + j * 8 + 4);
                    lg[0] += o[j] * w0.x; lg[1] += o[j] * w0.y; lg[2] += o[j] * w0.z; lg[3] += o[j] * w0.w;
                    lg[4] += o[j] * w1.x; lg[5] += o[j] * w1.y; lg[6] += o[j] * w1.z; lg[7] += o[j] * w1.w;
                }
            }
        }
        if (router) {
#pragma unroll
            for (int e = 0; e < 8; ++e) lg[e] = wave_sum(lg[e]);
            if (lane == 0) {
                int e0 = 0; float v0 = lg[0];
#pragma unroll
                for (int e = 1; e < 8; ++e) if (lg[e] > v0) { v0 = lg[e]; e0 = e; }
                int e1 = -1; float v1 = -3.0e38f;
#pragma unroll
                for (int e = 0; e < 8; ++e) if (e != e0 && lg[e] > v1) { v1 = lg[e]; e1 = e; }
                const float x1 = expf(v1 - v0), inv = 1.f / (1.f + x1);
                const float w0 = inv, w1 = x1 * inv;
                const int p0 = atomicAdd(&CNT[e0], 1), p1 = atomicAdd(&CNT[8 + e1], 1);
                LIST[(size_t)e0 * 32768 + p0] = row; WL[(size_t)e0 * 32768 + p0] = w0;
                LIST[(size_t)(8 + e1) * 32768 + p1] = row; WL[(size_t)(8 + e1) * 32768 + p1] = w1;
                { int* iv = (int*)(p.ws + OFF_INV) + (size_t)row * 8; *(int4*)iv = make_int4(e0, p0, e1, p1); *(float2*)(iv + 4) = make_float2(w0, w1); }
            }
        }
    }
}
__device__ __forceinline__ void norm_rows4(const P& p, const NormArgs& a, int row0, int lane) {
    const float* MOD = (const float*)(p.ws + OFF_MOD);
    bf16_t* H = (bf16_t*)(p.ws + OFF_H); float* XC = (float*)(p.ws + OFF_XC);
    const bool lat = row0 < T_LAT; const int r = lat ? (row0 >> 12) : 8;
    const float* srcb = lat ? (a.from_input ? p.in[0] : p.out) + (size_t)row0 * 1024 : (a.from_input ? p.in[2] : XC) + (size_t)(row0 - T_LAT) * 1024;
    float* dstb = lat ? p.out + (size_t)row0 * 1024 : XC + (size_t)(row0 - T_LAT) * 1024;
    float4 v[4][4]; uint2 y[4][4];
#pragma unroll
    for (int q = 0; q < 4; ++q)
#pragma unroll
        for (int i = 0; i < 4; ++i) { v[q][i] = *(const float4*)(srcb + q * 1024 + i * 256 + lane * 4); y[q][i] = *(const uint2*)(a.resY + (size_t)(row0 + q) * 1024 + i * 256 + lane * 4); }
    const float* gt = MOD + (a.res_layer * 9 + r) * 6144 + a.res_goff;
    const float* md = MOD + (a.layer * 9 + r) * 6144 + (a.which == 1 ? 0 : 3072);
    const float* gain = (a.which == 1 ? p.in[6] : p.in[7]) + a.layer * 1024;
    float4 gg[4], gn[4], sh[4], sc[4];
#pragma unroll
    for (int i = 0; i < 4; ++i) { const int col = i * 256 + lane * 4; gg[i] = *(const float4*)(gt + col); gn[i] = *(const float4*)(gain + col); sh[i] = *(const float4*)(md + col); sc[i] = *(const float4*)(md + 1024 + col); }
#pragma unroll
    for (int q = 0; q < 4; ++q) {
        float ss = 0.f;
#pragma unroll
        for (int i = 0; i < 4; ++i) { const uint2 yr = y[q][i];
            v[q][i].x += gg[i].x * __uint_as_float(yr.x << 16); v[q][i].y += gg[i].y * __uint_as_float(yr.x & 0xFFFF0000u);
            v[q][i].z += gg[i].z * __uint_as_float(yr.y << 16); v[q][i].w += gg[i].w * __uint_as_float(yr.y & 0xFFFF0000u);
            *(float4*)(dstb + q * 1024 + i * 256 + lane * 4) = v[q][i];
            ss += v[q][i].x * v[q][i].x + v[q][i].y * v[q][i].y + v[q][i].z * v[q][i].z + v[q][i].w * v[q][i].w; }
        ss = wave_sum(ss);
        const float rs = rsqrtf(ss * (1.f / 1024.f) + NORM_EPS);
#pragma unroll
        for (int i = 0; i < 4; ++i) { float o[4];
            o[0] = (v[q][i].x * rs * gn[i].x) * (1.f + sc[i].x) + sh[i].x; o[1] = (v[q][i].y * rs * gn[i].y) * (1.f + sc[i].y) + sh[i].y;
            o[2] = (v[q][i].z * rs * gn[i].z) * (1.f + sc[i].z) + sh[i].z; o[3] = (v[q][i].w * rs * gn[i].w) * (1.f + sc[i].w) + sh[i].w;
            if (a.h8) { int w8 = 0; w8 = __builtin_amdgcn_cvt_pk_fp8_f32(f8clamp(o[0] * F8_SH), f8clamp(o[1] * F8_SH), w8, false); w8 = __builtin_amdgcn_cvt_pk_fp8_f32(f8clamp(o[2] * F8_SH), f8clamp(o[3] * F8_SH), w8, true);
                *(int*)(a.h8 + (size_t)(row0 + q) * 1024 + i * 256 + lane * 4) = w8; }
            if (!a.h8 || a.both) { uint2 pk; pk.x = (unsigned)f2bf(o[0]) | ((unsigned)f2bf(o[1]) << 16); pk.y = (unsigned)f2bf(o[2]) | ((unsigned)f2bf(o[3]) << 16);
            *(uint2*)(H + (size_t)(row0 + q) * 1024 + i * 256 + lane * 4) = pk; } }
    }
}
__device__ __forceinline__ void norm_help(const P& p, const NormArgs& a, unsigned* cnt, unsigned need, unsigned* claim, int npanels, LAS unsigned* lw) {
    int tid_ = threadIdx.x; asm volatile("" : "+v"(tid_));
    const int wave = __builtin_amdgcn_readfirstlane(tid_ >> 6), lane = tid_ & 63;
    for (;;) {
        __syncthreads();
        if (threadIdx.x == 0) {
            const unsigned part = __hip_atomic_fetch_add(claim, 1u, __ATOMIC_RELAXED, __HIP_MEMORY_SCOPE_AGENT);
            if (part < (unsigned)npanels * 4u) {
                unsigned sp = 0;
                while (__hip_atomic_load(cnt + 64 * (part >> 2), __ATOMIC_RELAXED, __HIP_MEMORY_SCOPE_AGENT) < need) { __builtin_amdgcn_s_sleep(8); if (++sp > (1u << 22)) break; }
                __builtin_amdgcn_fence(__ATOMIC_ACQUIRE, "agent");
                asm volatile("s_waitcnt vmcnt(0)" ::: "memory");
            }
            lw[0] = part;
        }
        __syncthreads();
        const unsigned part = lw[0];
        if (part >= (unsigned)npanels * 4u) break;
        const int base = (int)(part >> 2) * 256 + (int)(part & 3u) * 64 + wave * 8;
        norm_rows4(p, a, base, lane); norm_rows4(p, a, base + 4, lane);
    }
}
__device__ __forceinline__ void ph_norm(const P& p, int layer, int which, int nrows, bool router, bool from_input, const bf16_t* resY, int res_layer, int res_goff, int ctx_ways, unsigned char* h8, bool both) {
    int tid_ = threadIdx.x; asm volatile("" : "+v"(tid_));
    const int wave = tid_ >> 6, lane = tid_ & 63;
    const NormArgs a{layer, which, router, from_input, resY, res_layer, res_goff, ctx_ways, h8, both};
    for (int row = blockIdx.x * 8 + wave; row < nrows; row += gridDim.x * 8) norm_row(p, a, row, lane);
}

struct ConvJob { const float* src; bf16_t* dst; int K, N, map, f8; };
__device__ __forceinline__ void conv_tiles4(const ConvJob& j, int tile, int step, int ntl, float* T  ) {
    int tid_ = threadIdx.x; asm volatile("" : "+v"(tid_));
    const int ntn = (j.N + 63) >> 6, t = tid_;
    float4 v[4][2];
#pragma unroll
    for (int q = 0; q < 4; ++q) { const int tl = tile + q * step, tk = tl / ntn, tn = tl % ntn;
#pragma unroll
        for (int i = 0; i < 2; ++i) { const int kr = (t >> 4) + 32 * i, c4 = (t & 15) * 4, n = tn * 64 + c4;
            v[q][i] = make_float4(0.f, 0.f, 0.f, 0.f);
            if (tl < ntl && n < j.N) v[q][i] = *(const float4*)(j.src + (size_t)(tk * 64 + kr) * j.N + n); } }
    __syncthreads();
#pragma unroll
    for (int q = 0; q < 4; ++q)
#pragma unroll
        for (int i = 0; i < 2; ++i) { const int kr = (t >> 4) + 32 * i, c4 = (t & 15) * 4; float* Tq = T + q * (64 * 65);
            Tq[kr * 65 + c4 + 0] = v[q][i].x; Tq[kr * 65 + c4 + 1] = v[q][i].y; Tq[kr * 65 + c4 + 2] = v[q][i].z; Tq[kr * 65 + c4 + 3] = v[q][i].w; }
    __syncthreads();
#pragma unroll
    for (int q = 0; q < 4; ++q) { const int tl = tile + q * step, tk = tl / ntn, tn = tl % ntn; const float* Tq = T + q * (64 * 65);
        const int nl = t >> 3, ks = (t & 7) * 8, n = tn * 64 + nl;
        if (tl < ntl && n < j.N) {
            int nd = j.map == 0 ? n : ((n >> 7) * 256 + (n & 127) + (j.map == 2 ? 128 : 0)); bool f8 = j.f8 != 0;
            if (j.map == 3) {
                nd = n < 1120 ? n : PJ_RQ + (n - 1120);
                f8 = nd < PJ_F8; }
            if (f8) {
                int w0 = 0, w1 = 0;
                w0 = __builtin_amdgcn_cvt_pk_fp8_f32(f8clamp(Tq[(ks + 0) * 65 + nl] * F8_SW), f8clamp(Tq[(ks + 1) * 65 + nl] * F8_SW), w0, false);
                w0 = __builtin_amdgcn_cvt_pk_fp8_f32(f8clamp(Tq[(ks + 2) * 65 + nl] * F8_SW), f8clamp(Tq[(ks + 3) * 65 + nl] * F8_SW), w0, true);
                w1 = __builtin_amdgcn_cvt_pk_fp8_f32(f8clamp(Tq[(ks + 4) * 65 + nl] * F8_SW), f8clamp(Tq[(ks + 5) * 65 + nl] * F8_SW), w1, false);
                w1 = __builtin_amdgcn_cvt_pk_fp8_f32(f8clamp(Tq[(ks + 6) * 65 + nl] * F8_SW), f8clamp(Tq[(ks + 7) * 65 + nl] * F8_SW), w1, true);
                *(uint2*)((unsigned char*)j.dst + (size_t)nd * j.K + tk * 64 + ks) = make_uint2((unsigned)w0, (unsigned)w1);
            } else {
            unsigned w[4];
#pragma unroll
            for (int i = 0; i < 4; ++i) w[i] = (unsigned)f2bf(Tq[(ks + 2 * i) * 65 + nl]) | ((unsigned)f2bf(Tq[(ks + 2 * i + 1) * 65 + nl]) << 16);
            *(uint4*)(j.dst + (size_t)nd * j.K + tk * 64 + ks) = make_uint4(w[0], w[1], w[2], w[3]);
            }
        } }
}
__device__ __forceinline__ int conv_ntiles(int K, int N) { return (K >> 6) * ((N + 63) >> 6); }

#define CONV_F8 0
__device__ __forceinline__ void ph_conv_early(const P& p, float* lds) {
    const int G = gridDim.x, bid = blockIdx.x;
    int base = 0;
#define CONV_RUN(SRC, DST, K_, N_, MAP_) do { ConvJob j{SRC, DST, K_, N_, MAP_, CONV_F8}; const int nt_ = conv_ntiles(K_, N_), ns_ = (nt_ + 3) >> 2; \
          \
        for (int u = (((bid - base % G) + G) % G); u < ns_; u += G) conv_tiles4(j, 4 * u, 1, nt_, lds); base += ns_; } while (0)
    for (int l = 0; l < 2; ++l) {
        CONV_RUN(p.in[8] + (size_t)l * 1024 * IN_DIM, (bf16_t*)(p.ws + OFF_WIN) + (size_t)l * PROJ_LD * 1024, 1024, IN_DIM, 3);
        CONV_RUN(p.in[16] + (size_t)l * 1024 * 1024, (bf16_t*)(p.ws + OFF_WOUT) + (size_t)l * 1024 * 1024, 1024, 1024, 0);
        CONV_RUN(p.in[10] + (size_t)l * 192 * 384, (bf16_t*)(p.ws + OFF_WUQ) + (size_t)l * 384 * 192, 192, 384, 0);
        CONV_RUN(p.in[12] + (size_t)l * 128 * 512, (bf16_t*)(p.ws + OFF_WUKV) + (size_t)l * 512 * 128, 128, 512, 0);
    }
    CONV_RUN(p.in[17], (bf16_t*)(p.ws + OFF_FGU), 1024, D_FF, 1);
    CONV_RUN(p.in[18], (bf16_t*)(p.ws + OFF_FGU), 1024, D_FF, 2);
#undef CONV_F8
#define CONV_F8 1
    CONV_RUN(p.in[19], (bf16_t*)(p.ws + OFF_FD), D_FF, 1024, 0);
    for (int l = 0; l < 2; ++l) {
        uint4* z = (uint4*)((unsigned char*)((bf16_t*)(p.ws + OFF_WIN) + (size_t)l * PROJ_LD * 1024) + (size_t)1120 * 1024);
        const int n16 = (PJ_F8 - 1120) * 1024 / 16;
        for (int i = bid * NT + threadIdx.x; i < n16; i += G * NT) z[i] = make_uint4(0u, 0u, 0u, 0u);
    }
}
#undef CONV_F8
#define CONV_F8 1
__device__ __forceinline__ void ph_conv_late(const P& p, float* lds) {
    const int G = gridDim.x, bid = blockIdx.x;
    int base = 0;
    for (int e = 0; e < NEXP; ++e) {
        CONV_RUN(p.in[21] + (size_t)e * 1024 * D_FFE, (bf16_t*)(p.ws + OFF_MGU + (size_t)e * 2 * D_FFE * 1024), 1024, D_FFE, 1);
        CONV_RUN(p.in[22] + (size_t)e * 1024 * D_FFE, (bf16_t*)(p.ws + OFF_MGU + (size_t)e * 2 * D_FFE * 1024), 1024, D_FFE, 2);
        CONV_RUN(p.in[23] + (size_t)e * D_FFE * 1024, (bf16_t*)(p.ws + OFF_MD + (size_t)e * 1024 * D_FFE), D_FFE, 1024, 0);
    }
}

namespace pg8 {
#define PG8_LAS __attribute__((address_space(3)))
typedef short bf16x8 __attribute__((ext_vector_type(8)));
typedef float f32x4 __attribute__((ext_vector_type(4)));
typedef unsigned u32x4 __attribute__((ext_vector_type(4)));
typedef int i32x4v __attribute__((ext_vector_type(4)));
constexpr int BM = 256, BK = 64, HALF = 128, HTB = HALF * BK * 2, STAGE_BYTES = 8 * HTB, NXCD = 8, WGM = 8;

__host__ __device__ __forceinline__ int lds_byte(int r, int c) { const int st = (r >> 4) * 2 + (c >> 5), rr = r & 15, cc = c & 31, ob = rr * 64 + cc * 2; return st * 1024 + (ob ^ (((ob >> 9) & 1) << 5)); }
__host__ __device__ __forceinline__ void stage_rc(int b, int& R, int& C) { const int st = b / 1024, sb = b % 1024, swz = sb ^ (((sb >> 9) & 1) << 5); R = (st >> 1) * 16 + swz / 64; C = (st & 1) * 32 + (swz % 64) / 2; }
__host__ __device__ __forceinline__ int perm32(int rho) { const int n = rho >> 4, i = rho & 15; return 8 * (i >> 2) + 4 * n + (i & 3); }

struct Unit { int pm, pn, e, rl, kp, ri; };

__device__ __forceinline__ void static_order_L(int L, int nM, int nN, int& pm, int& pn) {
    const int nwg = nM * nN;
    int wgid = L; { const int q = nwg / NXCD, r = nwg % NXCD, xcd = wgid % NXCD, off = wgid / NXCD; wgid = (xcd < r ? xcd * (q + 1) : r * (q + 1) + (xcd - r) * q) + off; }
    const int nig = WGM * nN, gid = wgid / nig, fm = gid * WGM, gsz = (nM - fm) < WGM ? (nM - fm) : WGM;
    pm = fm + ((wgid % nig) % gsz); pn = (wgid % nig) / gsz;
}
__device__ __forceinline__ bool static_order(int i, int G, int c, int nM, int nN, int& pm, int& pn) {
    const int nwg = nM * nN; const long L = (long)i * G + c; if (L >= nwg) return false;
    static_order_L((int)L, nM, nN, pm, pn); return true;
}

template <bool FP8_> struct DenseSchedT {
    static constexpr bool GATHER = false, FP8 = FP8_;
    const bf16_t* A; const bf16_t* Bt; int lda, K, nM, nN, G, c; int L0 = 0, Lend = 1 << 30;
    __device__ __forceinline__ int nt() const { return K / BK; }
    __device__ __forceinline__ bool next(int i, Unit& u) const { u.e = 0; u.kp = 0; u.ri = 0; const long L = L0 + (long)i * G + c; const int nwg = nM * nN;
        if (L >= nwg || L >= Lend) return false; static_order_L((int)L, nM, nN, u.pm, u.pn); u.rl = u.pm; return true; }
    __device__ __forceinline__ const char* a_base(const Unit& u) const { return (const char*)A + (size_t)u.pm * BM * lda * 2; }
    __device__ __forceinline__ const char* b_base(const Unit& u) const { return (const char*)Bt + (size_t)u.pn * BM * K * 2; }
    __device__ __forceinline__ unsigned a_off(const Unit&, int r, int C) const { return (unsigned)(r * lda + C) * 2u; }
};
typedef DenseSchedT<false> DenseSched;
struct DenseSplitSched {
    static constexpr bool GATHER = false;
    const bf16_t* A; const bf16_t* Bt; int lda, K, pm0, nMs, nN, ways, ntp, G, c;
    __device__ __forceinline__ int nt() const { return ntp; }
    __device__ __forceinline__ bool next(int i, Unit& u) const {
        const long j = (long)i * G + c; if (j >= (long)nMs * nN * ways) return false;
        const int ui = (int)(j / ways); u.kp = (int)(j % ways) * ntp; u.ri = (int)j; u.pm = pm0 + ui / nN; u.pn = ui % nN; u.e = 0; u.rl = u.pm; return true;
    }
    __device__ __forceinline__ const char* a_base(const Unit& u) const { return (const char*)A + (size_t)u.pm * BM * lda * 2 + (size_t)u.kp * (BK * 2); }
    __device__ __forceinline__ const char* b_base(const Unit& u) const { return (const char*)Bt + (size_t)u.pn * BM * K * 2 + (size_t)u.kp * (BK * 2); }
    __device__ __forceinline__ unsigned a_off(const Unit&, int r, int C) const { return (unsigned)(r * lda + C) * 2u; }
};
template <bool GATHER_, bool FP8_ = false> struct MoeSched {
    static constexpr bool GATHER = GATHER_, FP8 = FP8_;
    const bf16_t* A; const bf16_t* Bt; int lda, K, nN, G, c; size_t bstride;
    const int* list;
    const PG8_LAS int* tab;
    int ulo, uhi, ways, ntp;
    __device__ __forceinline__ int nt() const { return ntp; }
    __device__ __forceinline__ bool next(int i, Unit& u) const {
        const int nM = __builtin_amdgcn_readfirstlane(tab[16]);
        const long j = (long)i * G + c; const int L = ulo + (int)(j / ways);
        if (L >= uhi) return false;
        u.kp = (int)(j % ways) * ntp; u.ri = (int)j;
        static_order_L(L, nM, nN, u.pm, u.pn);
        int e = 0, t0 = 0;
#pragma unroll
        for (int k = 1; k < 8; ++k) { const int tk = tab[8 + k]; if (u.pm >= tk) { e = k; t0 = tk; } }
        u.e = __builtin_amdgcn_readfirstlane(e); u.rl = u.pm - __builtin_amdgcn_readfirstlane(t0); return true;
    }
    __device__ __forceinline__ const char* a_base(const Unit& u) const { return (GATHER ? (const char*)A : (const char*)A + (size_t)u.pm * BM * lda * 2) + (size_t)u.kp * (BK * 2); }
    __device__ __forceinline__ const char* b_base(const Unit& u) const { return (const char*)(Bt + (size_t)u.e * bstride) + (size_t)u.pn * BM * K * 2 + (size_t)u.kp * (BK * 2); }
    __device__ __forceinline__ unsigned a_off(const Unit& u, int r, int C) const {
        if (!GATHER) return (unsigned)(r * lda + C) * 2u;
        const int lr = u.rl * BM + r, c1 = tab[u.e] - 1;
        const int tok = list[(size_t)u.e * 32768 + (lr < c1 ? lr : c1)];
        return (unsigned)(tok * lda + C) * 2u;
    }
};

__device__ __forceinline__ unsigned pk2(float lo, float hi) { typedef float f32x2_t __attribute__((ext_vector_type(2))); typedef __bf16 bf16x2_t __attribute__((ext_vector_type(2)));
    f32x2_t v = {lo, hi}; bf16x2_t b = __builtin_convertvector(v, bf16x2_t); return __builtin_bit_cast(unsigned, b); }

struct EpiBf16 {
    static constexpr bool PERM = true;
    bf16_t* O; int ldc;
    __device__ __forceinline__ void operator()(const f32x4 (&acc)[2][2][4][2], const Unit& u, int wr, int wc, int fr, int fq) const {
        const int row0 = u.pm * BM + wr * 64 + fr, col0 = u.pn * BM + wc * 32 + 8 * fq;
#pragma unroll
        for (int ai = 0; ai < 2; ++ai)
#pragma unroll
            for (int m = 0; m < 4; ++m) { bf16_t* rowp = O + (size_t)(row0 + ai * HALF + m * 16) * ldc + col0;
#pragma unroll
                for (int bj = 0; bj < 2; ++bj) { const f32x4 v0 = acc[ai][bj][m][0], v1 = acc[ai][bj][m][1];
                    u32x4 w; w[0] = pk2(v0[0], v0[1]); w[1] = pk2(v0[2], v0[3]); w[2] = pk2(v1[0], v1[1]); w[3] = pk2(v1[2], v1[3]);
                    *(u32x4*)(rowp + bj * HALF) = w; } }
    }
};
struct EpiBf16Norm {
    static constexpr bool PERM = true, HAS_POST = true;
    bf16_t* O; int ldc; unsigned obytes; unsigned* cnt; float sc;
    __device__ __forceinline__ void operator()(const f32x4 (&acc)[2][2][4][2], const Unit& u, int wr, int wc, int fr, int fq) const {
        const auto rsrc = __builtin_amdgcn_make_buffer_rsrc((void*)O, 0, (int)obytes, 0x00020000);
        const int row0 = u.pm * BM + wr * 64 + fr, col0 = u.pn * BM + wc * 32 + 8 * fq;
#pragma unroll
        for (int ai = 0; ai < 2; ++ai)
#pragma unroll
            for (int m = 0; m < 4; ++m) { const unsigned ro = (unsigned)((row0 + ai * HALF + m * 16) * ldc + col0) * 2u;
#pragma unroll
                for (int bj = 0; bj < 2; ++bj) { const f32x4 v0 = acc[ai][bj][m][0] * sc, v1 = acc[ai][bj][m][1] * sc;
                    u32x4 w; w[0] = pk2(v0[0], v0[1]); w[1] = pk2(v0[2], v0[3]); w[2] = pk2(v1[0], v1[1]); w[3] = pk2(v1[2], v1[3]);
                    __builtin_amdgcn_raw_buffer_store_b128(w, rsrc, ro + bj * HALF * 2, 0, 16); } }
    }
    __device__ __forceinline__ void post(const Unit& u) const {
        asm volatile("s_waitcnt vmcnt(0)" ::: "memory");
        if ((threadIdx.x & 63) == 0) __hip_atomic_fetch_add(cnt + 64 * u.pm, 1u, __ATOMIC_RELAXED, __HIP_MEMORY_SCOPE_AGENT);
    }
};
template <bool F8IN, bool F8> struct EpiSwigluT {
    static constexpr bool PERM = true;
    bf16_t* O; int ldc;
    __device__ __forceinline__ void operator()(const f32x4 (&acc)[2][2][4][2], const Unit& u, int wr, int wc, int fr, int fq) const {
        const int row0 = u.pm * BM + wr * 64 + fr, col0 = u.pn * HALF + wc * 32 + 8 * fq;
#pragma unroll
        for (int ai = 0; ai < 2; ++ai)
#pragma unroll
            for (int m = 0; m < 4; ++m) { bf16_t* rowp = O + (size_t)(row0 + ai * HALF + m * 16) * ldc + col0;
                float o[8];
                typedef float f32x2_t __attribute__((ext_vector_type(2)));
#pragma unroll
                for (int n = 0; n < 2; ++n)
#pragma unroll
                    for (int j = 0; j < 4; j += 2) {
                        f32x2_t gg = {acc[ai][0][m][n][j], acc[ai][0][m][n][j + 1]}, uu = {acc[ai][1][m][n][j], acc[ai][1][m][n][j + 1]};
                        if constexpr (F8IN) { gg = gg * (1.f / (F8_SH * F8_SW)); uu = uu * ((F8 ? F8_SA : 1.f) / (F8_SH * F8_SW)); } else if constexpr (F8) uu = uu * F8_SA;
                        const f32x2_t t = gg * (-1.4426950408889634f); f32x2_t e;
                        e[0] = __builtin_amdgcn_exp2f(t[0]); e[1] = __builtin_amdgcn_exp2f(t[1]);
                        e = e + 1.0f; f32x2_t r; r[0] = __builtin_amdgcn_rcpf(e[0]); r[1] = __builtin_amdgcn_rcpf(e[1]);
                        const f32x2_t v = (gg * uu) * r; o[n * 4 + j] = v[0]; o[n * 4 + j + 1] = v[1]; }
                if constexpr (F8) { int w0 = 0, w1 = 0;
                    w0 = __builtin_amdgcn_cvt_pk_fp8_f32(f8clamp(o[0]), f8clamp(o[1]), w0, false); w0 = __builtin_amdgcn_cvt_pk_fp8_f32(f8clamp(o[2]), f8clamp(o[3]), w0, true);
                    w1 = __builtin_amdgcn_cvt_pk_fp8_f32(f8clamp(o[4]), f8clamp(o[5]), w1, false); w1 = __builtin_amdgcn_cvt_pk_fp8_f32(f8clamp(o[6]), f8clamp(o[7]), w1, true);
                    typedef unsigned u32x2v __attribute__((ext_vector_type(2))); u32x2v w = {(unsigned)w0, (unsigned)w1};
                    *(u32x2v*)((unsigned char*)O + (size_t)(row0 + ai * HALF + m * 16) * ldc + col0) = w; }
                else { u32x4 w; w[0] = pk2(o[0], o[1]); w[1] = pk2(o[2], o[3]); w[2] = pk2(o[4], o[5]); w[3] = pk2(o[6], o[7]);
                *(u32x4*)rowp = w; } }
    }
};
typedef EpiSwigluT<false, false> EpiSwiglu;
struct EpiRes {
    static constexpr bool PERM = false;
    const float* in_lat; const float* in_ctx; float* out_lat; float* out_ctx; const float* modl; int goff;
    __device__ __forceinline__ void operator()(const f32x4 (&acc)[2][2][4][2], const Unit& u, int wr, int wc, int fr, int fq) const {
        const bool lat = u.pm < T_LAT / BM; const int r = lat ? (u.pm >> 4) : 8;
        const size_t rbase = (size_t)(lat ? u.pm : u.pm - T_LAT / BM) * BM + wr * 64 + fr;
        const float* src = (lat ? in_lat : in_ctx); float* dst = (lat ? out_lat : out_ctx);
        const int col0 = u.pn * BM + wc * 32 + 4 * fq;
        f32x4 gv[2][2];
#pragma unroll
        for (int bj = 0; bj < 2; ++bj)
#pragma unroll
            for (int n = 0; n < 2; ++n) gv[bj][n] = *(const f32x4*)(modl + r * 6144 + goff + col0 + bj * HALF + n * 16);
#pragma unroll
        for (int ai = 0; ai < 2; ++ai)
#pragma unroll
            for (int m = 0; m < 4; ++m) { const size_t ro = (rbase + ai * HALF + m * 16) * 1024 + col0;
#pragma unroll
                for (int bj = 0; bj < 2; ++bj)
#pragma unroll
                    for (int n = 0; n < 2; ++n) { const f32x4 x = *(const f32x4*)(src + ro + bj * HALF + n * 16);
                        *(f32x4*)(dst + ro + bj * HALF + n * 16) = x + gv[bj][n] * acc[ai][bj][m][n]; } }
    }
};
struct EpiBf16S {
    static constexpr bool PERM = true;
    bf16_t* O; int ldc; float sc;
    __device__ __forceinline__ void operator()(const f32x4 (&acc)[2][2][4][2], const Unit& u, int wr, int wc, int fr, int fq) const {
        const int row0 = u.pm * BM + wr * 64 + fr, col0 = u.pn * BM + wc * 32 + 8 * fq;
#pragma unroll
        for (int ai = 0; ai < 2; ++ai)
#pragma unroll
            for (int m = 0; m < 4; ++m) { bf16_t* rowp = O + (size_t)(row0 + ai * HALF + m * 16) * ldc + col0;
#pragma unroll
                for (int bj = 0; bj < 2; ++bj) { const f32x4 v0 = acc[ai][bj][m][0] * sc, v1 = acc[ai][bj][m][1] * sc;
                    u32x4 w; w[0] = pk2(v0[0], v0[1]); w[1] = pk2(v0[2], v0[3]); w[2] = pk2(v1[0], v1[1]); w[3] = pk2(v1[2], v1[3]);
                    *(u32x4*)(rowp + bj * HALF) = w; } }
    }
};
struct EpiPart {
    static constexpr bool PERM = false;
    float* PART;
    __device__ __forceinline__ void operator()(const f32x4 (&acc)[2][2][4][2], const Unit& u, int wr, int wc, int fr, int fq) const {
        float* tp = PART + (size_t)u.ri * 65536 + (wr * 64 + fr) * 256 + wc * 32 + 4 * fq;
#pragma unroll
        for (int ai = 0; ai < 2; ++ai)
#pragma unroll
            for (int m = 0; m < 4; ++m)
#pragma unroll
                for (int bj = 0; bj < 2; ++bj)
#pragma unroll
                    for (int n = 0; n < 2; ++n) *(f32x4*)(tp + (ai * HALF + m * 16) * 256 + bj * HALF + n * 16) = acc[ai][bj][m][n];
    }
};
__device__ __forceinline__ void moe_combine(bf16_t* YM, const float* PART, const PG8_LAS int* tab, int nN, float sc) {
    const int nTm = __builtin_amdgcn_readfirstlane(tab[16]), G = gridDim.x, U = nTm * nN, rem = U % G;
    if (!(rem > 0 && rem * MOE_WAYS <= G)) return;
    int tid_ = threadIdx.x; asm volatile("" : "+v"(tid_));
    const int umain = U - rem, wave = tid_ >> 6, lane = tid_ & 63;
    for (int task = blockIdx.x * 8 + wave; task < rem * 256; task += G * 8) {
        const int r = task >> 8, i = task & 255; int pm, pn; static_order_L(umain + r, nTm, nN, pm, pn);
        const float* pp = PART + (size_t)(r * MOE_WAYS) * 65536 + i * 256 + lane * 4;
        f32x4 s = *(const f32x4*)pp;
#pragma unroll
        for (int q = 1; q < MOE_WAYS; ++q) s = s + *(const f32x4*)(pp + q * 65536);
        s = s * sc;
        typedef unsigned u32x2v __attribute__((ext_vector_type(2))); u32x2v w = {pk2(s[0], s[1]), pk2(s[2], s[3])};
        *(u32x2v*)(YM + (size_t)(pm * BM + i) * 1024 + pn * BM + lane * 4) = w;
    }
}

template <class T, class = void> struct sched_fp8 { static constexpr bool value = false; };
template <class T> struct sched_fp8<T, decltype((void)T::FP8)> { static constexpr bool value = T::FP8; };
template <class T, class = void> struct epi_has_post { static constexpr bool value = false; };
template <class T> struct epi_has_post<T, decltype((void)T::HAS_POST)> { static constexpr bool value = T::HAS_POST; };
template <class Epi, class Sched>
__device__ __forceinline__ void gemm_phase(PG8_LAS unsigned char* lds, const Sched& S, const Epi& E) {
    int tid_ = threadIdx.x; asm volatile("" : "+v"(tid_));
    const int tid = tid_, wid = __builtin_amdgcn_readfirstlane(tid >> 6), lane = tid & 63, wr = wid >> 2, wc = wid & 3, fr = lane & 15, fq = lane >> 4;
    const int K = S.K, nt = S.nt();
    int RA[2], CA[2]; unsigned voffB;
    { int R, C; stage_rc(tid * 16, R, C); const int Rb = Epi::PERM ? ((R & ~31) + perm32(R & 31)) : R;
      RA[0] = R; CA[0] = C; RA[1] = R + 64; CA[1] = C; voffB = (unsigned)(Rb * K + C) * 2u; }
    const unsigned incB = (unsigned)(64 * K * 2), incA = (unsigned)(64 * S.lda * 2);
    const unsigned kstep = (unsigned)(BK * 2);
    const unsigned hstepB = (unsigned)(HALF * K * 2);
    const auto rsA = __builtin_amdgcn_make_buffer_rsrc((void*)S.A, 0, 0x7fffffff, 0x00020000), rsB = __builtin_amdgcn_make_buffer_rsrc((void*)S.Bt, 0, 0x7fffffff, 0x00020000);
    const unsigned ldsw = (unsigned)wid * 1024u;
    const int aoff = lds_byte(wr * 64 + fr, fq * 8), boff = lds_byte(wc * 32 + fr, fq * 8);
#define PG8_SA(b, h) (((b) * 2 + (h)) * HTB)
#define PG8_SB(b, h) ((4 + (b) * 2 + (h)) * HTB)
  \

#define PG8_STAGE_B(bufoff, soff) do { _Pragma("unroll") for (int _i = 0; _i < 2; ++_i) \
        __builtin_amdgcn_raw_ptr_buffer_load_lds(rsB, (PG8_LAS void*)(lds + (bufoff) + ldsw + _i * 8192), 16, voffB, (soff) + _i * incB, 0, 0); } while (0)
#define PG8_STAGE_A(bufoff, soff, h) do { _Pragma("unroll") for (int _i = 0; _i < 2; ++_i) { \
        if constexpr (Sched::GATHER) __builtin_amdgcn_raw_ptr_buffer_load_lds(rsA, (PG8_LAS void*)(lds + (bufoff) + ldsw + _i * 8192), 16, vA[h][_i], (soff), 0, 0); \
        else __builtin_amdgcn_raw_ptr_buffer_load_lds(rsA, (PG8_LAS void*)(lds + (bufoff) + ldsw + _i * 8192), 16, vA[0][0], (soff) + ((h) * 2 + _i) * incA, 0, 0); } } while (0)
#define PG8_LDA(dst, b, h) do { _Pragma("unroll") for (int m = 0; m < 4; ++m) _Pragma("unroll") for (int k = 0; k < 2; ++k) dst[m][k] = *(const PG8_LAS bf16x8*)(lds + PG8_SA(b, h) + aoff + m * 2048 + k * 1024); } while (0)
#define PG8_LDB(dst, b, h) do { _Pragma("unroll") for (int n = 0; n < 2; ++n) _Pragma("unroll") for (int k = 0; k < 2; ++k) dst[n][k] = *(const PG8_LAS bf16x8*)(lds + PG8_SB(b, h) + boff + n * 2048 + k * 1024); } while (0)
#define PG8_CAT8(x, y) __builtin_shufflevector(__builtin_bit_cast(i32x4v, x), __builtin_bit_cast(i32x4v, y), 0, 1, 2, 3, 4, 5, 6, 7)
#define PG8_MMA(ai, bj, At, Bt) do { __builtin_amdgcn_s_setprio(1); _Pragma("unroll") for (int m = 0; m < 4; ++m) _Pragma("unroll") for (int n = 0; n < 2; ++n) { \
        if constexpr (sched_fp8<Sched>::value)   \
              \
              \
            asm volatile("v_mfma_f32_16x16x128_f8f6f4 %0, %1, %2, %0" : "+v"(acc[ai][bj][m][n]) : "v"(PG8_CAT8(Bt[n][0], Bt[n][1])), "v"(PG8_CAT8(At[m][0], At[m][1]))); \
        else { _Pragma("unroll") for (int k = 0; k < 2; ++k) acc[ai][bj][m][n] = __builtin_amdgcn_mfma_f32_16x16x32_bf16(Bt[n][k], At[m][k], acc[ai][bj][m][n], 0, 0, 0); } } __builtin_amdgcn_s_setprio(0); } while (0)
#define PG8_WAIT_V(n) asm volatile("s_waitcnt vmcnt(" #n ")" ::: "memory")
#define PG8_WAIT_L(n) asm volatile("s_waitcnt lgkmcnt(" #n ")" ::: "memory")
#define PG8_BAR __builtin_amdgcn_s_barrier()
#define PG8_SCHED __builtin_amdgcn_sched_barrier(0)
#define PG8_AOFFS(dst, U) do { _Pragma("unroll") for (int _h = 0; _h < 2; ++_h) _Pragma("unroll") for (int _i = 0; _i < 2; ++_i) dst[_h][_i] = S.a_off(U, _h * HALF + RA[_i], CA[_i]); } while (0)
    Unit cur, nxt; int ui = 0;
    if (!S.next(0, cur)) return;
    f32x4 acc[2][2][4][2];
#pragma unroll
    for (int a = 0; a < 2; ++a)
#pragma unroll
        for (int b = 0; b < 2; ++b)
#pragma unroll
            for (int m = 0; m < 4; ++m)
#pragma unroll
                for (int n = 0; n < 2; ++n) acc[a][b][m][n] = (f32x4){0.f, 0.f, 0.f, 0.f};
    bf16x8 At[4][2], B0[2][2], B1[2][2];
    unsigned vA[2][2], vN[2][2];
    PG8_AOFFS(vA, cur);
    unsigned cA = (unsigned)(S.a_base(cur) - (const char*)S.A), cB = (unsigned)(S.b_base(cur) - (const char*)S.Bt);
    PG8_STAGE_B(PG8_SB(0, 0), cB); PG8_STAGE_B(PG8_SB(0, 1), cB + hstepB); PG8_STAGE_A(PG8_SA(0, 0), cA, 0); PG8_STAGE_A(PG8_SA(0, 1), cA, 1);
    if (wr == 1) PG8_BAR;
    PG8_WAIT_V(2); PG8_BAR;
    PG8_STAGE_B(PG8_SB(1, 0), cB + kstep); PG8_STAGE_A(PG8_SA(1, 0), cA + kstep, 0); PG8_STAGE_B(PG8_SB(1, 1), cB + hstepB + kstep);
    PG8_WAIT_V(6); PG8_BAR;
    for (;;) {
        const bool has_next = S.next(ui + 1, nxt);
        const unsigned nA = has_next ? (unsigned)(S.a_base(nxt) - (const char*)S.A) : cA, nB = has_next ? (unsigned)(S.b_base(nxt) - (const char*)S.Bt) : cB;
        for (int t = 0; t < nt; t += 2) {
            const bool last = (t == nt - 2);
            const bool sw = Sched::GATHER && last && has_next;
            if constexpr (Sched::GATHER) { if (sw) { PG8_AOFFS(vN, nxt); } }
            const unsigned a1 = cA + (unsigned)(t + 1) * kstep;
            const unsigned a2 = last ? nA : cA + (unsigned)(t + 2) * kstep, b2 = last ? nB : cB + (unsigned)(t + 2) * kstep;
            const unsigned a3 = a2 + kstep, b3 = b2 + kstep;
            PG8_LDB(B0, 0, 0); PG8_LDB(B1, 0, 1); PG8_SCHED; PG8_LDA(At, 0, 0); PG8_STAGE_A(PG8_SA(1, 1), a1, 1);
            if constexpr (Sched::GATHER) { if (sw) {
#pragma unroll
                for (int _h = 0; _h < 2; ++_h)
#pragma unroll
                    for (int _i = 0; _i < 2; ++_i) vA[_h][_i] = vN[_h][_i]; } }
            PG8_WAIT_V(8); PG8_WAIT_L(0); PG8_BAR; PG8_MMA(0, 0, At, B0); PG8_MMA(0, 1, At, B1); PG8_BAR; PG8_SCHED;
            PG8_LDA(At, 0, 1); PG8_STAGE_B(PG8_SB(0, 0), b2); PG8_STAGE_B(PG8_SB(0, 1), b2 + hstepB); PG8_STAGE_A(PG8_SA(0, 0), a2, 0);
            PG8_WAIT_V(8); PG8_WAIT_L(0); PG8_BAR; PG8_MMA(1, 0, At, B0); PG8_MMA(1, 1, At, B1); PG8_BAR; PG8_SCHED;
            PG8_LDB(B0, 1, 0); PG8_LDB(B1, 1, 1); PG8_SCHED; PG8_LDA(At, 1, 0); PG8_STAGE_A(PG8_SA(0, 1), a2, 1);
            PG8_WAIT_V(8); PG8_WAIT_L(0); PG8_BAR; PG8_MMA(0, 0, At, B0); PG8_MMA(0, 1, At, B1); PG8_BAR; PG8_SCHED;
            PG8_LDA(At, 1, 1); PG8_STAGE_B(PG8_SB(1, 0), b3); PG8_STAGE_B(PG8_SB(1, 1), b3 + hstepB); PG8_STAGE_A(PG8_SA(1, 0), a3, 0);
            PG8_WAIT_V(8); PG8_WAIT_L(0); PG8_BAR; PG8_MMA(1, 0, At, B0); PG8_MMA(1, 1, At, B1); PG8_BAR; PG8_SCHED;
        }
        if constexpr (sched_fp8<Sched>::value) asm volatile("s_nop 15\n\ts_nop 7" ::: "memory");
        if (wr == 0) PG8_BAR;
        { int te_ = threadIdx.x; asm volatile("" : "+v"(te_));
          E(acc, cur, wr, wc, te_ & 15, (te_ & 63) >> 4); }
        if constexpr (epi_has_post<Epi>::value) E.post(cur);
        if (!has_next) break;
#pragma unroll
        for (int a = 0; a < 2; ++a)
#pragma unroll
            for (int b = 0; b < 2; ++b)
#pragma unroll
                for (int m = 0; m < 4; ++m)
#pragma unroll
                    for (int n = 0; n < 2; ++n) acc[a][b][m][n] = (f32x4){0.f, 0.f, 0.f, 0.f};
        cur = nxt; cA = nA; cB = nB; ++ui;
        if (wr == 1) PG8_BAR;
    }
    PG8_WAIT_V(0);
    PG8_BAR;
#undef PG8_SA
#undef PG8_SB
#undef PG8_STAGE_A
#undef PG8_STAGE_B
#undef PG8_LDA
#undef PG8_LDB
#undef PG8_MMA
#undef PG8_CAT8
#undef PG8_WAIT_V
#undef PG8_WAIT_L
#undef PG8_BAR
#undef PG8_SCHED
#undef PG8_AOFFS
}
}

__device__ __forceinline__ float rope_inv(int i2, int dim) { return powf(10000.0f, -(float)i2 / (float)dim); }

__device__ __forceinline__ void ph_final(const P& p) {
    int tid_ = threadIdx.x; asm volatile("" : "+v"(tid_));
    const int wave = tid_ >> 6, lane = tid_ & 63;
    const float* gain = p.in[24];
    for (int row = blockIdx.x * 8 + wave; row < T_LAT; row += gridDim.x * 8) {
        float* src = p.out + (size_t)row * 1024;
        float4 v[4]; float ss = 0.f;
#pragma unroll
        for (int i = 0; i < 4; ++i) { v[i] = *(const float4*)(src + i * 256 + lane * 4); ss += v[i].x * v[i].x + v[i].y * v[i].y + v[i].z * v[i].z + v[i].w * v[i].w; }
        ss = wave_sum(ss);
        const float rs = rsqrtf(ss * (1.f / 1024.f) + NORM_EPS);
#pragma unroll
        for (int i = 0; i < 4; ++i) { const int col = i * 256 + lane * 4; const float4 g = *(const float4*)(gain + col);
            *(float4*)(src + col) = make_float4(v[i].x * rs * g.x, v[i].y * rs * g.y, v[i].z * rs * g.z, v[i].w * rs * g.w); }
    }
}


__device__ __forceinline__ void ph_final_moe(const P& p, const LAS int* tab0, const LAS int* tab1) {
    int tid_ = threadIdx.x; asm volatile("" : "+v"(tid_));
    const int wave = tid_ >> 6, lane = tid_ & 63;
    const float* gain = p.in[24];
    const bf16_t* YM0 = (const bf16_t*)(p.ws + OFF_YM); const bf16_t* YM1 = YM0 + (size_t)ACT_ROWS * 1024;
    const float* MODL = (const float*)(p.ws + OFF_MOD) + 9 * 6144 + 5120;
    int row = blockIdx.x * 8 + wave; const int stride = gridDim.x * 8;
    int4 ep = make_int4(0, 0, 0, 0), nep = ep; float2 ww = make_float2(0.f, 0.f), nww = ww;
    if (row < T_LAT) { const int* iv = (const int*)(p.ws + OFF_INV) + (size_t)row * 8; ep = *(const int4*)iv; ww = *(const float2*)(iv + 4); }
    for (; row < T_LAT; row += stride) {
        if (row + stride < T_LAT) { const int* iv = (const int*)(p.ws + OFF_INV) + (size_t)(row + stride) * 8; nep = *(const int4*)iv; nww = *(const float2*)(iv + 4); }
        const size_t r0 = (size_t)(tab0[8 + ep.x] * 256 + ep.y) * 1024, r1 = (size_t)(tab1[8 + ep.z] * 256 + ep.w) * 1024;
        float* src = p.out + (size_t)row * 1024;
        const float* gt = MODL + (row >> 12) * 6144;
        float4 v[4]; uint2 y0[4], y1[4]; float4 gg[4]; float ss = 0.f;
#pragma unroll
        for (int i = 0; i < 4; ++i) { const int col = i * 256 + lane * 4; v[i] = *(const float4*)(src + col); y0[i] = *(const uint2*)(YM0 + r0 + col); y1[i] = *(const uint2*)(YM1 + r1 + col); gg[i] = *(const float4*)(gt + col); }
#pragma unroll
        for (int i = 0; i < 4; ++i) {
            v[i].x += gg[i].x * (ww.x * __uint_as_float(y0[i].x << 16) + ww.y * __uint_as_float(y1[i].x << 16));
            v[i].y += gg[i].y * (ww.x * __uint_as_float(y0[i].x & 0xFFFF0000u) + ww.y * __uint_as_float(y1[i].x & 0xFFFF0000u));
            v[i].z += gg[i].z * (ww.x * __uint_as_float(y0[i].y << 16) + ww.y * __uint_as_float(y1[i].y << 16));
            v[i].w += gg[i].w * (ww.x * __uint_as_float(y0[i].y & 0xFFFF0000u) + ww.y * __uint_as_float(y1[i].y & 0xFFFF0000u));
            ss += v[i].x * v[i].x + v[i].y * v[i].y + v[i].z * v[i].z + v[i].w * v[i].w; }
        ss = wave_sum(ss);
        const float rs = rsqrtf(ss * (1.f / 1024.f) + NORM_EPS);
#pragma unroll
        for (int i = 0; i < 4; ++i) { const int col = i * 256 + lane * 4; const float4 g = *(const float4*)(gain + col);
            *(float4*)(src + col) = make_float4(v[i].x * rs * g.x, v[i].y * rs * g.y, v[i].z * rs * g.z, v[i].w * rs * g.w); }
        ep = nep; ww = nww;
    }
}
typedef short bf16x8_t __attribute__((ext_vector_type(8)));
typedef short s16x4_t __attribute__((ext_vector_type(4)));
typedef float f32x16_t __attribute__((ext_vector_type(16)));
typedef unsigned u32x4_t __attribute__((ext_vector_type(4)));
typedef float f32x4_t __attribute__((ext_vector_type(4)));
__device__ __forceinline__ s16x4_t lds_tr16(LAS const unsigned char* p) { typedef short v4i16_t __attribute__((ext_vector_type(4))); return __builtin_bit_cast(s16x4_t, __builtin_amdgcn_ds_read_tr16_b64_v4i16((LAS v4i16_t*)p)); }
__device__ __forceinline__ unsigned pkbf(float lo, float hi) { typedef float f32x2_t __attribute__((ext_vector_type(2))); typedef __bf16 bf16x2_t __attribute__((ext_vector_type(2)));
    f32x2_t v = {lo, hi}; bf16x2_t b = __builtin_convertvector(v, bf16x2_t); return __builtin_bit_cast(unsigned, b); }
__device__ __forceinline__ float max3f(float a, float b, float c) { return fmaxf(fmaxf(a, b), c); }

#define ATT_VP 192
#define ATT_THR 6.0f
template <int DQK, bool SWA, bool GQA = false>
__device__ __forceinline__ void attn_unit(LAS unsigned char* lds, const bf16_t* POST, const bf16_t* VBUF, int vld, bf16_t* MIX, int b, int q0, int qcol, int kcol, int vcol, int ocol,
                                          int band_lo, int band_hi, float sinkl2, float qscale, const float* sinkp, float sinkmul) {
    constexpr int KP = DQK * 2 + 16, NPK = DQK / 8, NKL = NPK / 4, STAGE = 128 * KP + 128 * ATT_VP, NS = DQK / 16;
    int tid_ = threadIdx.x; asm volatile("" : "+v"(tid_));
    const int tid = tid_, wid = __builtin_amdgcn_readfirstlane(tid >> 6), lane = tid & 63, r = lane & 31, h = lane >> 5;
    const int nb = (band_hi - band_lo) >> 7, ntiles = nb + 2;
    const int qw0 = GQA ? q0 + 32 * (wid & 1) : q0 + 32 * wid;
    const int qi = qw0 + r;
    const int qrow = tok_row(b, qi);
    if (GQA) { qcol += (wid >> 1) * 64; ocol += (wid >> 1) * 64; sinkl2 = sinkp[wid >> 1] * sinkmul; }
    bf16x8_t qf[NS];
    { const bf16_t* qp = POST + (size_t)qrow * POST_LD + qcol + 8 * h;
#pragma unroll
      for (int s = 0; s < NS; ++s) { float f[8]; unpack8(*(const uint4*)(qp + 16 * s), f);
          const unsigned w0 = pkbf(f[0] * qscale, f[1] * qscale), w1 = pkbf(f[2] * qscale, f[3] * qscale), w2 = pkbf(f[4] * qscale, f[5] * qscale), w3 = pkbf(f[6] * qscale, f[7] * qscale);
          qf[s] = __builtin_bit_cast(bf16x8_t, make_uint4(w0, w1, w2, w3)); } }
    f32x16_t O0, O1;
#pragma unroll
    for (int i = 0; i < 16; ++i) { O0[i] = 0.f; O1[i] = 0.f; }
    float m = SWA ? sinkl2 : -1e30f, l = 0.f;
    u32x4_t kreg[NKL], vreg[2];
    const int vrow = tid >> 3, vpc = tid & 7;
#define ATT_KS(t) ((t) < nb ? band_lo + 128 * (t) : SEQ + 128 * ((t) - nb))
#define ATT_LOAD(t) do { const int ks_ = ATT_KS(t); const bf16_t* base_ = POST + (size_t)tok_row(b, ks_) * POST_LD; \
        _Pragma("unroll") for (int i_ = 0; i_ < NKL; ++i_) { const int idx_ = tid + 512 * i_, row_ = idx_ / NPK, pc_ = idx_ % NPK; kreg[i_] = *(const u32x4_t*)(base_ + (size_t)row_ * POST_LD + kcol + pc_ * 8); } \
        const bf16_t* vbase_ = VBUF + (size_t)tok_row(b, ks_) * vld; \
        _Pragma("unroll") for (int i_ = 0; i_ < 2; ++i_) vreg[i_] = *(const u32x4_t*)(vbase_ + (size_t)(vrow + 64 * i_) * vld + vcol + vpc * 8); } while (0)
#define ATT_WRITE(buf) do { LAS unsigned char* kb_ = lds + (buf) * STAGE; LAS unsigned char* vb_ = kb_ + 128 * KP; \
        _Pragma("unroll") for (int i_ = 0; i_ < NKL; ++i_) { const int idx_ = tid + 512 * i_, row_ = idx_ / NPK, pc_ = idx_ % NPK; *(LAS u32x4_t*)(kb_ + row_ * KP + pc_ * 16) = kreg[i_]; } \
        _Pragma("unroll") for (int i_ = 0; i_ < 2; ++i_) *(LAS u32x4_t*)(vb_ + (vrow + 64 * i_) * ATT_VP + vpc * 16) = vreg[i_]; } while (0)
    const int koff = r * KP + 16 * h;
    const int voff = (4 * h + ((lane & 15) >> 2)) * ATT_VP + (16 * ((lane >> 4) & 1) + 4 * (lane & 3)) * 2;
    __syncthreads();
    ATT_LOAD(0); ATT_WRITE(0);
    __syncthreads();
    for (int t = 0; t < ntiles; ++t) {
        if (t + 1 < ntiles) ATT_LOAD(t + 1);
        LAS const unsigned char* kb = lds + (t & 1) * STAGE; LAS const unsigned char* vb = kb + 128 * KP;
        const int ks = ATT_KS(t);
        bool skip[2] = {false, false}, need_mask[2] = {false, false};
        if (SWA && t < nb) {
#pragma unroll
            for (int sub = 0; sub < 2; ++sub) { const int kb0 = ks + sub * 64, qlo = qw0, qhi = qlo + 31;
                skip[sub] = (kb0 > qhi + 128) || (kb0 + 63 < qlo - 128);
                need_mask[sub] = !((kb0 >= qhi - 128) && (kb0 + 63 <= qlo + 128)); }
        }
        f32x16_t S[4];
#pragma unroll
        for (int blk = 0; blk < 4; ++blk)
#pragma unroll
            for (int i = 0; i < 16; ++i) S[blk][i] = 0.f;
#pragma unroll
        for (int sub = 0; sub < 2; ++sub) {
            if (!skip[sub]) {
#pragma unroll
                for (int s = 0; s < NS; ++s) {
                    const bf16x8_t k0 = *(LAS const bf16x8_t*)(kb + (sub * 64) * KP + koff + 32 * s), k1 = *(LAS const bf16x8_t*)(kb + (sub * 64 + 32) * KP + koff + 32 * s);
                    S[2 * sub] = __builtin_amdgcn_mfma_f32_32x32x16_bf16(k0, qf[s], S[2 * sub], 0, 0, 0);
                    S[2 * sub + 1] = __builtin_amdgcn_mfma_f32_32x32x16_bf16(k1, qf[s], S[2 * sub + 1], 0, 0, 0);
                }
            }
        }
#pragma unroll
        for (int sub = 0; sub < 2; ++sub) {
            if (!skip[sub]) {
                const int kb0 = ks + sub * 64;
                f32x16_t& S0 = S[2 * sub]; f32x16_t& S1 = S[2 * sub + 1];
                bf16x8_t va[8];
#pragma unroll
                for (int g = 0; g < 4; ++g) { LAS const unsigned char* vp = vb + (sub * 64 + 16 * g) * ATT_VP + voff;
                    const s16x4_t l0 = lds_tr16(vp), h0 = lds_tr16(vp + 8 * ATT_VP), l1 = lds_tr16(vp + 64), h1 = lds_tr16(vp + 8 * ATT_VP + 64);
                    va[2 * g] = __builtin_shufflevector(l0, h0, 0, 1, 2, 3, 4, 5, 6, 7); va[2 * g + 1] = __builtin_shufflevector(l1, h1, 0, 1, 2, 3, 4, 5, 6, 7); }
                if (SWA && need_mask[sub]) {
#pragma unroll
                    for (int i = 0; i < 16; ++i) { const int d0 = kb0 + (i & 3) + 8 * (i >> 2) + 4 * h - qi, d1 = d0 + 32;
                        if (d0 > 128 || d0 < -128) S0[i] = -1e30f;
                        if (d1 > 128 || d1 < -128) S1[i] = -1e30f; }
                }
                float mx = max3f(S0[0], S0[1], S1[0]), mx2 = max3f(S0[2], S0[3], S1[1]);
                mx = max3f(mx, S1[2], S1[3]);
#pragma unroll
                for (int i = 4; i < 16; i += 4) { mx = max3f(mx, S0[i], S0[i + 1]); mx2 = max3f(mx2, S0[i + 2], S0[i + 3]); mx = max3f(mx, S1[i], S1[i + 1]); mx2 = max3f(mx2, S1[i + 2], S1[i + 3]); }
                mx = fmaxf(mx, mx2);
                { const auto rr_ = __builtin_amdgcn_permlane32_swap(__float_as_uint(mx), __float_as_uint(mx), false, false); mx = fmaxf(__uint_as_float(rr_[0]), __uint_as_float(rr_[1])); }
                if (__any(mx > m + ATT_THR)) {
                    const float mn = fmaxf(m, mx), al = __builtin_amdgcn_exp2f(m - mn);
                    m = mn; l *= al;
#pragma unroll
                    for (int i = 0; i < 16; ++i) { O0[i] *= al; O1[i] *= al; }
                }
                typedef float f32x2_t __attribute__((ext_vector_type(2)));
                const f32x2_t m2 = {m, m}; f32x2_t ps2 = {0.f, 0.f};
#pragma unroll
                for (int i = 0; i < 16; i += 2) {
                    f32x2_t a = (f32x2_t){S0[i], S0[i + 1]} - m2, c = (f32x2_t){S1[i], S1[i + 1]} - m2;
                    a[0] = __builtin_amdgcn_exp2f(a[0]); a[1] = __builtin_amdgcn_exp2f(a[1]); c[0] = __builtin_amdgcn_exp2f(c[0]); c[1] = __builtin_amdgcn_exp2f(c[1]);
                    S0[i] = a[0]; S0[i + 1] = a[1]; S1[i] = c[0]; S1[i + 1] = c[1];
                    ps2 += a; ps2 += c;
                }
                l += ps2[0] + ps2[1];
#pragma unroll
                for (int g = 0; g < 4; ++g) { const f32x16_t& Sx = (g >> 1) ? S1 : S0; const int o8 = 8 * (g & 1);
                    const bf16x8_t pf = __builtin_bit_cast(bf16x8_t, make_uint4(pkbf(Sx[o8 + 0], Sx[o8 + 1]), pkbf(Sx[o8 + 2], Sx[o8 + 3]), pkbf(Sx[o8 + 4], Sx[o8 + 5]), pkbf(Sx[o8 + 6], Sx[o8 + 7])));
                    O0 = __builtin_amdgcn_mfma_f32_32x32x16_bf16(va[2 * g], pf, O0, 0, 0, 0);
                    O1 = __builtin_amdgcn_mfma_f32_32x32x16_bf16(va[2 * g + 1], pf, O1, 0, 0, 0);
                }
            }
        }
        if (t + 1 < ntiles) ATT_WRITE((t + 1) & 1);
        __syncthreads();
    }
#undef ATT_LOAD
#undef ATT_KS
#undef ATT_WRITE
    float lt = l + __shfl_xor(l, 32);
    if (SWA) lt += __builtin_amdgcn_exp2f(sinkl2 - m);
    const float inv = 1.f / lt;
    bf16_t* op = MIX + (size_t)qrow * 1024 + ocol + 4 * h;
#pragma unroll
    for (int g = 0; g < 4; ++g) {
        *(uint2*)(op + 8 * g) = make_uint2(pkbf(O0[4 * g] * inv, O0[4 * g + 1] * inv), pkbf(O0[4 * g + 2] * inv, O0[4 * g + 3] * inv));
        *(uint2*)(op + 32 + 8 * g) = make_uint2(pkbf(O1[4 * g] * inv, O1[4 * g + 1] * inv), pkbf(O1[4 * g + 2] * inv, O1[4 * g + 3] * inv));
    }
}


typedef int i32x8_t __attribute__((ext_vector_type(8)));
typedef int i32x4_t __attribute__((ext_vector_type(4)));
#define A8_KP 144
__device__ __forceinline__ i32x8_t lds_frag32(LAS const unsigned char* p) { const i32x4_t lo = *(LAS const i32x4_t*)p, hi = *(LAS const i32x4_t*)(p + 16); return __builtin_shufflevector(lo, hi, 0, 1, 2, 3, 4, 5, 6, 7); }
__device__ __forceinline__ int cvt4_f8(float a, float b, float c, float d) { return __builtin_amdgcn_cvt_pk_fp8_f32(c, d, __builtin_amdgcn_cvt_pk_fp8_f32(a, b, 0, false), true); }
__device__ __forceinline__ void attn_unit_f8(LAS unsigned char* lds, const unsigned char* QK8, const unsigned char* V8T, bf16_t* MIX, int b, int q0, int head, int band_lo, int band_hi, float qscale) {
    constexpr int STAGE = 128 * A8_KP + 64 * A8_KP;
    int tid_ = threadIdx.x; asm volatile("" : "+v"(tid_));
    const int tid = tid_, wid = __builtin_amdgcn_readfirstlane(tid >> 6), lane = tid & 63, r = lane & 31, h = lane >> 5;
    const int nb = (band_hi - band_lo) >> 7, ntiles = nb + 2;
    const int qi = q0 + 32 * wid + r, qrow = tok_row(b, qi);
    i32x8_t qf[2];
    { const unsigned char* qp = QK8 + (size_t)qrow * 1024 + head * 128 + 32 * h;
#pragma unroll
      for (int s = 0; s < 2; ++s) { const i32x4_t lo = *(const i32x4_t*)(qp + 64 * s), hi = *(const i32x4_t*)(qp + 64 * s + 16); qf[s] = __builtin_shufflevector(lo, hi, 0, 1, 2, 3, 4, 5, 6, 7); } }
    f32x16_t O0, O1;
#pragma unroll
    for (int i = 0; i < 16; ++i) { O0[i] = 0.f; O1[i] = 0.f; }
    float m = -1e30f;
    f32x16_t Ls;
#pragma unroll
    for (int i = 0; i < 16; ++i) Ls[i] = 0.f;
    const i32x8_t ones8 = {0x38383838, 0x38383838, 0x38383838, 0x38383838, 0x38383838, 0x38383838, 0x38383838, 0x38383838};
    u32x4_t kreg[2], vreg;
    const unsigned char* vbase = V8T + (size_t)((b * 4 + head) * 64 + (tid >> 3)) * 4352 + (tid & 7) * 16;
#define A8_KS(t) ((t) < nb ? band_lo + 128 * (t) : SEQ + 128 * ((t) - nb))
#define A8_LOAD(t) do { const int ks_ = A8_KS(t); const unsigned char* base_ = QK8 + (size_t)tok_row(b, ks_) * 1024 + 512 + head * 128; \
        _Pragma("unroll") for (int i_ = 0; i_ < 2; ++i_) { const int idx_ = tid + 512 * i_; kreg[i_] = *(const u32x4_t*)(base_ + (size_t)(idx_ >> 3) * 1024 + (idx_ & 7) * 16); } \
        vreg = *(const u32x4_t*)(vbase + ks_); } while (0)
#define A8_WRITE(buf) do { LAS unsigned char* kb_ = lds + (buf) * STAGE; \
        _Pragma("unroll") for (int i_ = 0; i_ < 2; ++i_) { const int idx_ = tid + 512 * i_; *(LAS u32x4_t*)(kb_ + (idx_ >> 3) * A8_KP + (idx_ & 7) * 16) = kreg[i_]; } \
        *(LAS u32x4_t*)(kb_ + 128 * A8_KP + (tid >> 3) * A8_KP + (tid & 7) * 16) = vreg; } while (0)
    const int foff = r * A8_KP + 32 * h;
    __syncthreads();
    A8_LOAD(0); A8_WRITE(0);
    __syncthreads();
    typedef float f32x2_t __attribute__((ext_vector_type(2)));
    const f32x2_t qs2 = {qscale, qscale};
    for (int t = 0; t < ntiles; ++t) {
        if (t + 1 < ntiles) A8_LOAD(t + 1);
        LAS const unsigned char* kb = lds + (t & 1) * STAGE; LAS const unsigned char* vb = kb + 128 * A8_KP;
        f32x16_t S[4];
#pragma unroll
        for (int blk = 0; blk < 4; ++blk)
#pragma unroll
            for (int i = 0; i < 16; ++i) S[blk][i] = 0.f;
#pragma unroll
        for (int blk = 0; blk < 4; ++blk)
#pragma unroll
            for (int s = 0; s < 2; ++s) S[blk] = __builtin_amdgcn_mfma_scale_f32_32x32x64_f8f6f4(lds_frag32(kb + (blk * 32) * A8_KP + foff + 64 * s), qf[s], S[blk], 0, 0, 0, 0, 0, 0);
#pragma unroll
        for (int sub = 0; sub < 2; ++sub) {
            f32x16_t& S0 = S[2 * sub]; f32x16_t& S1 = S[2 * sub + 1];
            const i32x8_t va0 = lds_frag32(vb + foff + 64 * sub), va1 = lds_frag32(vb + 32 * A8_KP + foff + 64 * sub);
            float mx = max3f(S0[0], S0[1], S1[0]), mx2 = max3f(S0[2], S0[3], S1[1]);
            mx = max3f(mx, S1[2], S1[3]);
#pragma unroll
            for (int i = 4; i < 16; i += 4) { mx = max3f(mx, S0[i], S0[i + 1]); mx2 = max3f(mx2, S0[i + 2], S0[i + 3]); mx = max3f(mx, S1[i], S1[i + 1]); mx2 = max3f(mx2, S1[i + 2], S1[i + 3]); }
            mx = fmaxf(mx, mx2);
            { const auto rr_ = __builtin_amdgcn_permlane32_swap(__float_as_uint(mx), __float_as_uint(mx), false, false); mx = fmaxf(__uint_as_float(rr_[0]), __uint_as_float(rr_[1])); }
            mx *= qscale;
            if (__any(mx > m + ATT_THR)) {
                const float mn = fmaxf(m, mx), al = __builtin_amdgcn_exp2f(m - mn);
                m = mn; Ls[0] *= al;
#pragma unroll
                for (int i = 0; i < 16; ++i) { O0[i] *= al; O1[i] *= al; }
            }
            const f32x2_t m2 = {-m, -m};
#pragma unroll
            for (int i = 0; i < 16; i += 2) {
                f32x2_t a = (f32x2_t){S0[i], S0[i + 1]} * qs2 + m2, c = (f32x2_t){S1[i], S1[i + 1]} * qs2 + m2;
                a[0] = __builtin_amdgcn_exp2f(a[0]); a[1] = __builtin_amdgcn_exp2f(a[1]); c[0] = __builtin_amdgcn_exp2f(c[0]); c[1] = __builtin_amdgcn_exp2f(c[1]);
                S0[i] = a[0]; S0[i + 1] = a[1]; S1[i] = c[0]; S1[i + 1] = c[1];
            }
            i32x8_t pf;
#pragma unroll
            for (int w = 0; w < 4; ++w) { pf[w] = cvt4_f8(S0[4 * w], S0[4 * w + 1], S0[4 * w + 2], S0[4 * w + 3]); pf[4 + w] = cvt4_f8(S1[4 * w], S1[4 * w + 1], S1[4 * w + 2], S1[4 * w + 3]); }
            O0 = __builtin_amdgcn_mfma_scale_f32_32x32x64_f8f6f4(va0, pf, O0, 0, 0, 0, 0, 0, 0);
            O1 = __builtin_amdgcn_mfma_scale_f32_32x32x64_f8f6f4(va1, pf, O1, 0, 0, 0, 0, 0, 0);
            Ls = __builtin_amdgcn_mfma_scale_f32_32x32x64_f8f6f4(ones8, pf, Ls, 0, 0, 0, 0, 0, 0);
        }
        if (t + 1 < ntiles) A8_WRITE((t + 1) & 1);
        __syncthreads();
    }
#undef A8_LOAD
#undef A8_KS
#undef A8_WRITE
    const float inv = 1.f / Ls[0];
    bf16_t* op = MIX + (size_t)qrow * 1024 + head * 64 + 4 * h;
#pragma unroll
    for (int g = 0; g < 4; ++g) {
        *(uint2*)(op + 8 * g) = make_uint2(pkbf(O0[4 * g] * inv, O0[4 * g + 1] * inv), pkbf(O0[4 * g + 2] * inv, O0[4 * g + 3] * inv));
        *(uint2*)(op + 32 + 8 * g) = make_uint2(pkbf(O1[4 * g] * inv, O1[4 * g + 1] * inv), pkbf(O1[4 * g + 2] * inv, O1[4 * g + 3] * inv));
    }
}
__device__ __forceinline__ float log2_sigmoid(float x) { return log2f(1.f / (1.f + expf(-x))); }

__device__ __forceinline__ void ph_ret_T(const P& p, int layer, LAS unsigned char* lds) {
    const bf16_t* POST = (const bf16_t*)(p.ws + OFF_POST); const bf16_t* PROJB = (const bf16_t*)(p.ws + OFF_PROJ);
    bf16_t* TT = (bf16_t*)(p.ws + OFF_TT);
    int tid_ = threadIdx.x; asm volatile("" : "+v"(tid_));
    const int tid = tid_, wid = __builtin_amdgcn_readfirstlane(tid >> 6), lane = tid & 63, h2 = lane >> 5;
    const int G = gridDim.x, bid = blockIdx.x;
    const int trq = (lane & 15) >> 2, trc = (16 * ((lane >> 4) & 1) + 4 * (lane & 3)) * 2;
    for (int u = bid; u < BATCH * 34 * 2; u += G) {
        const int hp = u & 1, c = (u >> 1) % 34, b = u / 68;
        const int row0 = c < 32 ? b * SEQ + c * 128 : T_LAT + b * CTXL + (c - 32) * 128;
        __syncthreads();
#pragma unroll
        for (int i = 0; i < 8; ++i) {
            const int idx = tid + 512 * i, arr = idx >> 10, rem = idx & 1023, row = rem >> 3, pc = rem & 7;
            const u32x4_t v = arr < 2 ? *(const u32x4_t*)(POST + (size_t)(row0 + row) * POST_LD + PC_RK + (2 * hp + (arr & 1)) * 64 + pc * 8)
                                      : *(const u32x4_t*)(PROJB + (size_t)(row0 + row) * PROJ_LD + PJ_RV + (2 * hp + (arr & 1)) * 64 + pc * 8);
            *(LAS u32x4_t*)(lds + arr * 24576 + row * 192 + pc * 16) = v;
        }
        __syncthreads();
        const int hh = wid >> 2, head = 2 * hp + hh, dir = (wid >> 1) & 1, dvb = wid & 1;
        const float lg = log2_sigmoid(dir ? p.in[15][layer * 4 + head] : p.in[14][layer * 4 + head]);
        f32x16_t acc0, acc1;
#pragma unroll
        for (int i = 0; i < 16; ++i) { acc0[i] = 0.f; acc1[i] = 0.f; }
        LAS const unsigned char* kt = lds + hh * 24576; LAS const unsigned char* vt = lds + (2 + hh) * 24576;
#pragma unroll
        for (int s = 0; s < 8; ++s) {
            const int kr = 16 * s + 8 * h2;
            LAS const unsigned char* vp = vt + (kr + trq) * 192 + dvb * 64 + trc;
            const s16x4_t vlo = lds_tr16(vp), vhi = lds_tr16(vp + 4 * 192);
            const bf16x8_t a = {vlo[0], vlo[1], vlo[2], vlo[3], vhi[0], vhi[1], vhi[2], vhi[3]};
            float w[8];
#pragma unroll
            for (int j = 0; j < 8; ++j) w[j] = __builtin_amdgcn_exp2f(lg * (float)(dir ? (kr + j) : (127 - kr - j)));
#pragma unroll
            for (int dkb = 0; dkb < 2; ++dkb) {
                LAS const unsigned char* kp = kt + (kr + trq) * 192 + dkb * 64 + trc;
                const s16x4_t klo = lds_tr16(kp), khi = lds_tr16(kp + 4 * 192);
                float f[8];
#pragma unroll
                for (int j = 0; j < 4; ++j) { f[j] = bf2f((bf16_t)klo[j]) * w[j]; f[4 + j] = bf2f((bf16_t)khi[j]) * w[4 + j]; }
                const bf16x8_t bb = __builtin_bit_cast(bf16x8_t, make_uint4(pkbf(f[0], f[1]), pkbf(f[2], f[3]), pkbf(f[4], f[5]), pkbf(f[6], f[7])));
                if (dkb == 0) acc0 = __builtin_amdgcn_mfma_f32_32x32x16_bf16(a, bb, acc0, 0, 0, 0);
                else acc1 = __builtin_amdgcn_mfma_f32_32x32x16_bf16(a, bb, acc1, 0, 0, 0);
            }
        }
        bf16_t* tp = TT + ((((size_t)(b * 4 + head) * 34 + c) * 2 + dir) * 4096) + (lane & 31);
#pragma unroll
        for (int i = 0; i < 16; ++i) { const int dv = 32 * dvb + (i & 3) + 8 * (i >> 2) + 4 * h2; tp[dv * 64] = f2bf(acc0[i]); tp[dv * 64 + 32] = f2bf(acc1[i]); }
    }
}

__device__ __forceinline__ void ret_unit(LAS unsigned char* lds, const P& p, int layer, int b, int c, int hp) {
    const bf16_t* POST = (const bf16_t*)(p.ws + OFF_POST); const bf16_t* PROJB = (const bf16_t*)(p.ws + OFF_PROJ);
    bf16_t* MIX = (bf16_t*)(p.ws + OFF_H);
    const bf16_t* TT = (const bf16_t*)(p.ws + OFF_TT);
    int tid_ = threadIdx.x; asm volatile("" : "+v"(tid_));
    const int tid = tid_, wid = __builtin_amdgcn_readfirstlane(tid >> 6), lane = tid & 63, r = lane & 31, h2 = lane >> 5;
    const bool isctx = c >= 32;
    const int row0 = !isctx ? b * SEQ + c * 128 : T_LAT + b * CTXL + (c - 32) * 128;
    constexpr int L_ST = 0, L_K = 36864, L_V = 73728;
    __syncthreads();
#pragma unroll
    for (int i = 0; i < 8; ++i) {
        const int idx = tid + 512 * i, arr = idx >> 10, rem = idx & 1023, row = rem >> 3, pc = rem & 7;
        const u32x4_t v = arr < 2 ? *(const u32x4_t*)(POST + (size_t)(row0 + row) * POST_LD + PC_RK + (2 * hp + (arr & 1)) * 64 + pc * 8)
                                      : *(const u32x4_t*)(PROJB + (size_t)(row0 + row) * PROJ_LD + PJ_RV + (2 * hp + (arr & 1)) * 64 + pc * 8);
        if (arr < 2) *(LAS u32x4_t*)(lds + L_K + (arr & 1) * 18432 + row * 144 + pc * 16) = v;
        else *(LAS u32x4_t*)(lds + L_V + (arr & 1) * 24576 + row * 192 + pc * 16) = v;
    }
    {
        const int hd = tid >> 7, hh = hd >> 1, dir = hd & 1, head = 2 * hp + hh;
        const float g128 = 128.f * log2_sigmoid(dir ? p.in[15][layer * 4 + head] : p.in[14][layer * 4 + head]);
        const bf16_t* tb = TT + (size_t)(b * 4 + head) * 34 * 2 * 4096 + dir * 4096 + (tid & 127) * 4;
        f32x4_t acc[8];
#pragma unroll
        for (int i = 0; i < 8; ++i) acc[i] = (f32x4_t){0.f, 0.f, 0.f, 0.f};
        int v0, v1;
        if (!isctx) { if (dir == 0) { v0 = -2; v1 = c - 1; } else { v0 = c + 1; v1 = 33; } }
        else { const int cc = c - 32; if (dir == 0) { v0 = -2; v1 = cc - 3; } else { v0 = 33 + cc; v1 = 33; } }
        for (int v = v0; v <= v1; ++v) {
            const int idxT = v < 0 ? 34 + v : v;
            const float coef = __builtin_amdgcn_exp2f(g128 * (float)(dir == 0 ? (v1 - v) : (v - v0)));
            const bf16_t* tp = tb + (size_t)idxT * 2 * 4096;
#pragma unroll
            for (int i = 0; i < 8; ++i) { const uint2 r_ = *(const uint2*)(tp + 512 * i);
                const f32x4_t x = {__uint_as_float(r_.x << 16), __uint_as_float(r_.x & 0xFFFF0000u), __uint_as_float(r_.y << 16), __uint_as_float(r_.y & 0xFFFF0000u)}; acc[i] += x * coef; }
        }
#pragma unroll
        for (int i = 0; i < 8; ++i) { const int e = (tid & 127) * 4 + 512 * i, dv = e >> 6, dk = e & 63;
            typedef unsigned u32x2_t __attribute__((ext_vector_type(2))); *(LAS u32x2_t*)(lds + L_ST + hd * 9216 + dv * 144 + dk * 2) = (u32x2_t){pkbf(acc[i][0], acc[i][1]), pkbf(acc[i][2], acc[i][3])}; }
    }
    __syncthreads();
    const int hh = wid >> 2, head = 2 * hp + hh, qb = wid & 3, qi = 32 * qb + r;
    const int qrow = row0 + qi;
    const float lgf = log2_sigmoid(p.in[14][layer * 4 + head]), lgb = log2_sigmoid(p.in[15][layer * 4 + head]);
    bf16x8_t qf[4];
    { const bf16_t* qp = POST + (size_t)qrow * POST_LD + PC_RQ + head * 64 + 8 * h2;
#pragma unroll
      for (int s = 0; s < 4; ++s) qf[s] = *(const bf16x8_t*)(qp + 16 * s); }
    f32x16_t O0, O1;
#pragma unroll
    for (int i = 0; i < 16; ++i) { O0[i] = 0.f; O1[i] = 0.f; }
    LAS const unsigned char* kt = lds + L_K + hh * 18432; LAS const unsigned char* vt = lds + L_V + hh * 24576;
    const int voff = (4 * h2 + ((lane & 15) >> 2)) * 192 + (16 * ((lane >> 4) & 1) + 4 * (lane & 3)) * 2;
#pragma unroll
    for (int blk = 0; blk < 4; ++blk) {
        f32x16_t S;
#pragma unroll
        for (int i = 0; i < 16; ++i) S[i] = 0.f;
#pragma unroll
        for (int s = 0; s < 4; ++s) { const bf16x8_t a = *(LAS const bf16x8_t*)(kt + (32 * blk + r) * 144 + 32 * s + 16 * h2); S = __builtin_amdgcn_mfma_f32_32x32x16_bf16(a, qf[s], S, 0, 0, 0); }
#pragma unroll
        for (int i = 0; i < 16; ++i) { const int d = qi - (32 * blk + (i & 3) + 8 * (i >> 2) + 4 * h2);
            const float w = d > 0 ? __builtin_amdgcn_exp2f(lgf * (float)d) : (d == 0 ? 2.f : __builtin_amdgcn_exp2f(lgb * (float)(-d)));
            S[i] *= w; }
#pragma unroll
        for (int s2 = 0; s2 < 2; ++s2) {
            const bf16x8_t pf = __builtin_bit_cast(bf16x8_t, make_uint4(pkbf(S[8 * s2 + 0], S[8 * s2 + 1]), pkbf(S[8 * s2 + 2], S[8 * s2 + 3]), pkbf(S[8 * s2 + 4], S[8 * s2 + 5]), pkbf(S[8 * s2 + 6], S[8 * s2 + 7])));
            LAS const unsigned char* vp = vt + (32 * blk + 16 * s2) * 192 + voff;
            const s16x4_t lo0 = lds_tr16(vp), hi0 = lds_tr16(vp + 8 * 192), lo1 = lds_tr16(vp + 64), hi1 = lds_tr16(vp + 8 * 192 + 64);
            const bf16x8_t a0 = {lo0[0], lo0[1], lo0[2], lo0[3], hi0[0], hi0[1], hi0[2], hi0[3]};
            const bf16x8_t a1 = {lo1[0], lo1[1], lo1[2], lo1[3], hi1[0], hi1[1], hi1[2], hi1[3]};
            O0 = __builtin_amdgcn_mfma_f32_32x32x16_bf16(a0, pf, O0, 0, 0, 0);
            O1 = __builtin_amdgcn_mfma_f32_32x32x16_bf16(a1, pf, O1, 0, 0, 0);
        }
    }
#pragma unroll
    for (int dir = 0; dir < 2; ++dir) {
        f32x16_t T0, T1;
#pragma unroll
        for (int i = 0; i < 16; ++i) { T0[i] = 0.f; T1[i] = 0.f; }
        LAS const unsigned char* st = lds + L_ST + (hh * 2 + dir) * 9216;
#pragma unroll
        for (int s = 0; s < 4; ++s) {
            const bf16x8_t a0 = *(LAS const bf16x8_t*)(st + r * 144 + 32 * s + 16 * h2), a1 = *(LAS const bf16x8_t*)(st + (32 + r) * 144 + 32 * s + 16 * h2);
            T0 = __builtin_amdgcn_mfma_f32_32x32x16_bf16(a0, qf[s], T0, 0, 0, 0);
            T1 = __builtin_amdgcn_mfma_f32_32x32x16_bf16(a1, qf[s], T1, 0, 0, 0);
        }
        const float coef = dir == 0 ? __builtin_amdgcn_exp2f(lgf * (float)(qi + 1)) : __builtin_amdgcn_exp2f(lgb * (float)(128 - qi));
#pragma unroll
        for (int i = 0; i < 16; ++i) { O0[i] += coef * T0[i]; O1[i] += coef * T1[i]; }
    }
    float ss = 0.f;
#pragma unroll
    for (int i = 0; i < 16; ++i) ss += O0[i] * O0[i] + O1[i] * O1[i];
    ss += __shfl_xor(ss, 32);
    const float rs = rsqrtf(ss * (1.f / 64.f) + NORM_EPS);
    const bf16_t* gp = PROJB + (size_t)qrow * PROJ_LD + PJ_RG + head * 64 + 4 * h2;
    bf16_t* op = MIX + (size_t)qrow * 1024 + 768 + head * 64 + 4 * h2;
#pragma unroll
    for (int g = 0; g < 4; ++g) {
        const uint2 g0 = *(const uint2*)(gp + 8 * g), g1 = *(const uint2*)(gp + 32 + 8 * g);
        float gv[8] = {__uint_as_float(g0.x << 16), __uint_as_float(g0.x & 0xFFFF0000u), __uint_as_float(g0.y << 16), __uint_as_float(g0.y & 0xFFFF0000u),
                       __uint_as_float(g1.x << 16), __uint_as_float(g1.x & 0xFFFF0000u), __uint_as_float(g1.y << 16), __uint_as_float(g1.y & 0xFFFF0000u)};
        float o[8];
#pragma unroll
        for (int j = 0; j < 4; ++j) { o[j] = O0[4 * g + j] * rs * silu_f(gv[j]); o[4 + j] = O1[4 * g + j] * rs * silu_f(gv[4 + j]); }
        *(uint2*)(op + 8 * g) = make_uint2(pkbf(o[0], o[1]), pkbf(o[2], o[3]));
        *(uint2*)(op + 32 + 8 * g) = make_uint2(pkbf(o[4], o[5]), pkbf(o[6], o[7]));
    }
}

__device__ __forceinline__ void ph_mixer_mfma(const P& p, int layer, bool ctxq, LAS unsigned char* lds) {
    const bf16_t* POST = (const bf16_t*)(p.ws + OFF_POST); const bf16_t* PROJB = (const bf16_t*)(p.ws + OFF_PROJ);
    bf16_t* MIX = (bf16_t*)(p.ws + OFF_H);
    const int G = gridDim.x, bid = blockIdx.x;
    const float L2E = 1.4426950408889634f;
    const int n_mla = BATCH * 4 * 16, n_swa = BATCH * 8 * 16, n_mlac = ctxq ? BATCH * 4 : 0, n_swac = ctxq ? BATCH * 8 : 0;
    const int n_ret = BATCH * 32 * 2, n_retc = ctxq ? BATCH * 2 * 2 : 0;
    const int total = n_mla + n_swa + n_mlac + n_swac + n_ret + n_retc;
    const int nmine = (total - bid + G - 1) / G;
    const int cls = bid % 3;
    for (int k = 0; k < nmine; ++k) { const int kk = cls == 0 ? k : (cls == 1 ? nmine - 1 - k : (k + nmine / 2) % nmine); const int u = bid + kk * G;
        if (u < n_mla) {
            const int qb = u & 15, h = (u >> 4) & 3, b = u >> 6;
            attn_unit_f8(lds, p.ws + OFF_QK8, p.ws + OFF_V8T, MIX, b, qb * 256, h, 0, SEQ, 0.10206207261596575f * L2E);
        } else if (u < n_mla + n_swa) {
            const int v = u - n_mla, qb = v & 63, kvh = (v >> 6) & 1, b = v >> 7;
            const int q0 = qb * 64; int lo = (q0 - 128) & ~127; lo = lo < 0 ? 0 : lo; int hi = (q0 + 192 + 127) & ~127; hi = hi > SEQ ? SEQ : hi;
            attn_unit<64, true, true>(lds, POST, PROJB, PROJ_LD, MIX, b, q0, PC_QB + kvh * 256, PC_KB + kvh * 64, 992 + kvh * 64, 256 + kvh * 256, lo, hi, 0.f, 0.125f * L2E, p.in[13] + layer * 8 + kvh * 4, L2E);
        } else if (u < n_mla + n_swa + n_mlac) {
            const int v = u - n_mla - n_swa, h = v & 3, b = v >> 2;
            attn_unit_f8(lds, p.ws + OFF_QK8, p.ws + OFF_V8T, MIX, b, SEQ, h, 0, 0, 0.10206207261596575f * L2E);
        } else if (u < n_mla + n_swa + n_mlac + n_swac) {
            const int v = u - n_mla - n_swa - n_mlac, qb = v & 3, kvh = (v >> 2) & 1, b = v >> 3;
            attn_unit<64, true, true>(lds, POST, PROJB, PROJ_LD, MIX, b, SEQ + qb * 64, PC_QB + kvh * 256, PC_KB + kvh * 64, 992 + kvh * 64, 256 + kvh * 256, 0, 0, 0.f, 0.125f * L2E, p.in[13] + layer * 8 + kvh * 4, L2E);
        } else if (u < n_mla + n_swa + n_mlac + n_swac + n_ret) {
            const int v = u - n_mla - n_swa - n_mlac - n_swac;
            ret_unit(lds, p, layer, v >> 6, (v >> 1) & 31, v & 1);
        } else {
            const int v = u - n_mla - n_swa - n_mlac - n_swac - n_ret;
            ret_unit(lds, p, layer, v >> 2, 32 + ((v >> 1) & 1), v & 1);
        }
    }
}

__device__ __forceinline__ void ph_tables(const P& p) {
    float2* tr = (float2*)(p.ws + OFF_TAB); float2* t32 = tr + 4096 * 32; float2* t16 = t32 + 64 * 16;
    const int n = 4096 * 32 + 64 * 16 + 64 * 8;
    for (int i = blockIdx.x * NT + threadIdx.x; i < n; i += gridDim.x * NT) {
        float ang;
        if (i < 4096 * 32) ang = (float)(i >> 5) * rope_inv(2 * (i & 31), 64);
        else if (i < 4096 * 32 + 64 * 16) { const int j = i - 4096 * 32; ang = (float)(j >> 4) * rope_inv(2 * (j & 15), 32); }
        else { const int j = i - 4096 * 32 - 64 * 16; ang = (float)(j >> 3) * rope_inv(2 * (j & 7), 16); }
        tr[i] = make_float2(cosf(ang), sinf(ang));
    }
}

__device__ __forceinline__ void ph_prep2(const P& p, int layer, LAS unsigned char* lds) {
    const bf16_t* PROJ = (const bf16_t*)(p.ws + OFF_PROJ);
    bf16_t* POST = (bf16_t*)(p.ws + OFF_POST);
    unsigned char* QK8 = p.ws + OFF_QK8; unsigned char* V8T = p.ws + OFF_V8T;
#define CVT4_F8(a_, b_, c_, d_) __builtin_amdgcn_cvt_pk_fp8_f32(f8clamp(c_), f8clamp(d_), __builtin_amdgcn_cvt_pk_fp8_f32(f8clamp(a_), f8clamp(b_), 0, false), true)
    const bf16_t* WUQ = (const bf16_t*)(p.ws + OFF_WUQ) + (size_t)layer * 384 * 192;
    const bf16_t* WUKV = (const bf16_t*)(p.ws + OFF_WUKV) + (size_t)layer * 512 * 128;
    const float* qn = p.in[9] + layer * 192; const float* kvn = p.in[11] + layer * 128;
    const float2* tab_ret = (const float2*)(p.ws + OFF_TAB); const float2* tab32 = tab_ret + 4096 * 32; const float2* tab16 = tab32 + 64 * 16;
    int tid_ = threadIdx.x; asm volatile("" : "+v"(tid_));
    const int tid = tid_, wid = __builtin_amdgcn_readfirstlane(tid >> 6), lane = tid & 63, fr = lane & 15, fq = lane >> 4;
    constexpr int QP = 400, KVP = 272, L_CQ = 0, L_CKV = 32 * QP;
    constexpr int SQP = 1040, L_SQ = L_CKV + 32 * KVP, L_SV = L_SQ + 32 * SQP;
#define PREP_LOADS(RA, RB, RC, RK, P1, P2, UNIT) do { const int R0_ = (UNIT) * 32; int tidA = tid; asm volatile("" : "+v"(tidA)); const int tk_ = tidA >> 4, sub_ = tidA & 15; \
        { const bf16_t* pr_ = PROJ + (size_t)(R0_ + tk_) * PROJ_LD; RA = *(const uint2*)(pr_ + sub_ * 12); RB = *(const uint2*)(pr_ + sub_ * 12 + 4); RC = *(const uint2*)(pr_ + sub_ * 12 + 8); RK = *(const u32x4_t*)(pr_ + 192 + sub_ * 8); } \
        _Pragma("unroll") for (int it_ = 0; it_ < 5; ++it_) { const int w_ = it_ * NT + tidA; \
            if (w_ < 32 * 74) { const int tok_ = w_ / 74, task_ = w_ % 74; int src_, dist_; \
                if (task_ < 40) { const int hd_ = task_ >> 2, half_ = (task_ >> 1) & 1, cp_ = task_ & 1; src_ = (task_ < 32 ? 352 : 864 - 8 * 64) + hd_ * 64 + half_ * 32 + cp_ * 8; dist_ = 16; } \
                else if (task_ < 72) { const int q_ = task_ - 40, hd_ = q_ >> 2, cp_ = q_ & 3; src_ = (hd_ < 4 ? PJ_RQ + hd_ * 64 : PJ_RK + (hd_ - 4) * 64) + cp_ * 8; dist_ = 32; } \
                else { src_ = 320 + (task_ - 72) * 16; dist_ = 8; } \
                const bf16_t* pr_ = PROJ + (size_t)(R0_ + tok_) * PROJ_LD + src_; P1[it_] = *(const u32x4_t*)pr_; P2[it_] = *(const u32x4_t*)(pr_ + dist_); } \
            else { P1[it_] = (u32x4_t){0u, 0u, 0u, 0u}; P2[it_] = P1[it_]; } } } while (0)
    uint2 ra, rb, rc, na_, nb_, nc_; u32x4_t rk, nk_; u32x4_t p1[5], p2[5], n1[5], n2[5];
    if ((int)blockIdx.x < T_ALL / 32) PREP_LOADS(ra, rb, rc, rk, p1, p2, (int)blockIdx.x);
    for (int u = blockIdx.x; u < T_ALL / 32; u += gridDim.x) {
        const int R0 = u * 32; const bool isctx = R0 >= T_LAT;
        const int t0 = isctx ? (R0 - T_LAT) % CTXL : R0 % SEQ;
        const int tk = tid >> 4, sub = tid & 15;
        const bool has_next = u + (int)gridDim.x < T_ALL / 32;
        if (has_next) PREP_LOADS(na_, nb_, nc_, nk_, n1, n2, u + (int)gridDim.x);
        __syncthreads();
        *(LAS u32x4_t*)(lds + L_SQ + tk * SQP + (sub >> 3) * 512 + ((sub >> 1) & 3) * 128 + 96 + (sub & 1) * 16) = (u32x4_t){0u, 0u, 0u, 0u};
        {
            float c[12], k[8];
            c[0] = __uint_as_float(ra.x << 16); c[1] = __uint_as_float(ra.x & 0xFFFF0000u); c[2] = __uint_as_float(ra.y << 16); c[3] = __uint_as_float(ra.y & 0xFFFF0000u);
            c[4] = __uint_as_float(rb.x << 16); c[5] = __uint_as_float(rb.x & 0xFFFF0000u); c[6] = __uint_as_float(rb.y << 16); c[7] = __uint_as_float(rb.y & 0xFFFF0000u);
            c[8] = __uint_as_float(rc.x << 16); c[9] = __uint_as_float(rc.x & 0xFFFF0000u); c[10] = __uint_as_float(rc.y << 16); c[11] = __uint_as_float(rc.y & 0xFFFF0000u);
            unpack8(make_uint4(rk[0], rk[1], rk[2], rk[3]), k);
            float s1 = 0.f, s2 = 0.f;
#pragma unroll
            for (int i = 0; i < 12; ++i) s1 += c[i] * c[i];
#pragma unroll
            for (int i = 0; i < 8; ++i) s2 += k[i] * k[i];
#pragma unroll
            for (int o = 1; o < 16; o <<= 1) { s1 += __shfl_xor(s1, o); s2 += __shfl_xor(s2, o); }
            const float r1 = rsqrtf(s1 * (1.f / 192.f) + NORM_EPS), r2 = rsqrtf(s2 * (1.f / 128.f) + NORM_EPS);
            typedef unsigned u32x2_t __attribute__((ext_vector_type(2)));
#pragma unroll
            for (int i = 0; i < 3; ++i) { const int e = sub * 12 + 4 * i;
                *(LAS u32x2_t*)(lds + L_CQ + tk * QP + e * 2) = (u32x2_t){pkbf(c[4 * i] * r1 * qn[e], c[4 * i + 1] * r1 * qn[e + 1]), pkbf(c[4 * i + 2] * r1 * qn[e + 2], c[4 * i + 3] * r1 * qn[e + 3])}; }
            { const int e = sub * 8;
              *(LAS u32x4_t*)(lds + L_CKV + tk * KVP + e * 2) = (u32x4_t){pkbf(k[0] * r2 * kvn[e], k[1] * r2 * kvn[e + 1]), pkbf(k[2] * r2 * kvn[e + 2], k[3] * r2 * kvn[e + 3]),
                                                                        pkbf(k[4] * r2 * kvn[e + 4], k[5] * r2 * kvn[e + 5]), pkbf(k[6] * r2 * kvn[e + 6], k[7] * r2 * kvn[e + 7])}; }
        }
        __syncthreads();
        {
            pg8::f32x4 acc[3][2];
#pragma unroll
            for (int a = 0; a < 3; ++a)
#pragma unroll
                for (int m = 0; m < 2; ++m) acc[a][m] = (pg8::f32x4){0.f, 0.f, 0.f, 0.f};
#pragma unroll
            for (int ks = 0; ks < 6; ++ks) {
                bf16x8_t af[2];
#pragma unroll
                for (int m = 0; m < 2; ++m) af[m] = *(LAS const bf16x8_t*)(lds + L_CQ + (m * 16 + fr) * QP + (32 * ks + 8 * fq) * 2);
#pragma unroll
                for (int a = 0; a < 3; ++a) {
                    const bf16x8_t bfrag = *(const bf16x8_t*)(WUQ + (size_t)((3 * wid + a) * 16 + fr) * 192 + 32 * ks + 8 * fq);
#pragma unroll
                    for (int m = 0; m < 2; ++m) acc[a][m] = __builtin_amdgcn_mfma_f32_16x16x32_bf16(bfrag, af[m], acc[a][m], 0, 0, 0);
                }
            }
#pragma unroll
            for (int a = 0; a < 3; ++a) {
                const int nt = 3 * wid + a, t6 = nt % 6, col = nt * 16 + 4 * fq;
#pragma unroll
                for (int m = 0; m < 2; ++m) {
                    const int tok = m * 16 + fr, t = t0 + tok;
                    pg8::f32x4 v = acc[a][m];
                    if (t6 >= 4) {
                        pg8::f32x4 pv; pv[0] = __shfl_xor(v[0], 32); pv[1] = __shfl_xor(v[1], 32); pv[2] = __shfl_xor(v[2], 32); pv[3] = __shfl_xor(v[3], 32);
                        if (!isctx) { const int pos = t6 == 4 ? (t >> 6) : (t & 63);
#pragma unroll
                            for (int j = 0; j < 4; ++j) { const float2 cs = tab16[pos * 8 + 4 * (fq & 1) + j]; v[j] = v[j] * cs.x + (fq < 2 ? -pv[j] : pv[j]) * cs.y; } }
                    }
                    *(LAS int*)(lds + L_SQ + tok * SQP + (nt / 6) * 128 + t6 * 16 + 4 * fq) = CVT4_F8(v[0], v[1], v[2], v[3]);
                }
            }
        }
        {
            pg8::f32x4 acc[4][2];
#pragma unroll
            for (int a = 0; a < 4; ++a)
#pragma unroll
                for (int m = 0; m < 2; ++m) acc[a][m] = (pg8::f32x4){0.f, 0.f, 0.f, 0.f};
#pragma unroll
            for (int ks = 0; ks < 4; ++ks) {
                bf16x8_t af[2];
#pragma unroll
                for (int m = 0; m < 2; ++m) af[m] = *(LAS const bf16x8_t*)(lds + L_CKV + (m * 16 + fr) * KVP + (32 * ks + 8 * fq) * 2);
#pragma unroll
                for (int a = 0; a < 4; ++a) {
                    const bf16x8_t bfrag = *(const bf16x8_t*)(WUKV + (size_t)((4 * wid + a) * 16 + fr) * 128 + 32 * ks + 8 * fq);
#pragma unroll
                    for (int m = 0; m < 2; ++m) acc[a][m] = __builtin_amdgcn_mfma_f32_16x16x32_bf16(bfrag, af[m], acc[a][m], 0, 0, 0);
                }
            }
#pragma unroll
            for (int a = 0; a < 4; ++a) {
                const int n = (4 * wid + a) * 16 + 4 * fq, hh = n >> 7, d = n & 127;
                const int dst = d < 64 ? PC_KA + hh * 96 + d : PC_VA + hh * 64 + (d - 64);
#pragma unroll
                for (int m = 0; m < 2; ++m) { const pg8::f32x4 v = acc[a][m]; const int row = R0 + m * 16 + fr;
                    const int w8 = CVT4_F8(v[0], v[1], v[2], v[3]);
                    const int tl = m * 16 + fr; (void)row;
                    if (d < 64) *(LAS int*)(lds + L_SQ + tl * SQP + 512 + hh * 128 + d) = w8;
                    else { LAS unsigned char* vp = lds + L_SV + (hh * 64 + (d - 64)) * 32 + 16 * ((tl >> 2) & 1) + 4 * (tl >> 3) + (tl & 3);
                        vp[0] = (unsigned char)w8; vp[32] = (unsigned char)(w8 >> 8); vp[64] = (unsigned char)(w8 >> 16); vp[96] = (unsigned char)((unsigned)w8 >> 24); } }
                (void)dst;
            }
        }
        int tidB = tid; asm volatile("" : "+v"(tidB));
#pragma unroll
        for (int it = 0; it < 5; ++it) {
            const int w = it * NT + tidB;
            if (w < 32 * 74) {
                const int tok = w / 74, task = w % 74, t = t0 + tok;
                bf16_t* po = POST + (size_t)(R0 + tok) * POST_LD;
                int dst, dist; const float2* tb; float scl = 1.f; bool bc = false;
                if (task < 40) { const int hd = task >> 2, half = (task >> 1) & 1, cp = task & 1;
                    dst = (task < 32 ? PC_QB : PC_KB - 8 * 64) + hd * 64 + half * 32 + cp * 8; dist = 16; tb = tab32 + (half ? (t & 63) : (t >> 6)) * 16 + cp * 8; }
                else if (task < 72) { const int q = task - 40, hd = q >> 2, cp = q & 3;
                    dst = PC_RQ + hd * 64 + cp * 8; dist = 32; tb = tab_ret + t * 32 + cp * 8; if (hd >= 4) scl = 0.125f; }
                else { const int half = task - 72; dst = PC_KA + 64 + half * 16; dist = 8; bc = true; tb = tab16 + (half ? (t & 63) : (t >> 6)) * 8; }
                float x1[8], x2[8]; unpack8(make_uint4(p1[it][0], p1[it][1], p1[it][2], p1[it][3]), x1); unpack8(make_uint4(p2[it][0], p2[it][1], p2[it][2], p2[it][3]), x2);
                if (!isctx) {
                    const float4 c0 = *(const float4*)(tb), c1 = *(const float4*)(tb + 2), c2 = *(const float4*)(tb + 4), c3 = *(const float4*)(tb + 6);
                    const float cs[8] = {c0.x, c0.z, c1.x, c1.z, c2.x, c2.z, c3.x, c3.z}, sn[8] = {c0.y, c0.w, c1.y, c1.w, c2.y, c2.w, c3.y, c3.w};
#pragma unroll
                    for (int j = 0; j < 8; ++j) { const float a = x1[j], b2 = x2[j]; x1[j] = a * cs[j] - b2 * sn[j]; x2[j] = b2 * cs[j] + a * sn[j]; }
                }
#pragma unroll
                for (int j = 0; j < 8; ++j) { x1[j] *= scl; x2[j] *= scl; }
                const uint4 o1 = make_uint4(pkbf(x1[0], x1[1]), pkbf(x1[2], x1[3]), pkbf(x1[4], x1[5]), pkbf(x1[6], x1[7]));
                const uint4 o2 = make_uint4(pkbf(x2[0], x2[1]), pkbf(x2[2], x2[3]), pkbf(x2[4], x2[5]), pkbf(x2[6], x2[7]));
                if (bc) {
                    LAS unsigned char* k8 = lds + L_SQ + tok * SQP + 512 + 64 + (task - 72) * 16;
                    typedef unsigned u32x2_t __attribute__((ext_vector_type(2)));
                    const uint2 f1 = make_uint2((unsigned)CVT4_F8(x1[0], x1[1], x1[2], x1[3]), (unsigned)CVT4_F8(x1[4], x1[5], x1[6], x1[7]));
                    const uint2 f2 = make_uint2((unsigned)CVT4_F8(x2[0], x2[1], x2[2], x2[3]), (unsigned)CVT4_F8(x2[4], x2[5], x2[6], x2[7]));
#pragma unroll
                    for (int hh = 0; hh < 4; ++hh) { *(LAS u32x2_t*)(k8 + hh * 128) = (u32x2_t){f1.x, f1.y}; *(LAS u32x2_t*)(k8 + hh * 128 + 8) = (u32x2_t){f2.x, f2.y}; }
                } else { *(uint4*)(po + dst) = o1; *(uint4*)(po + dst + dist) = o2; }
            }
        }
        __syncthreads();
        {
            const int rr = tid >> 4, pc = tid & 15;
            uint4* qd = (uint4*)(QK8 + (size_t)(R0 + rr) * 1024 + pc * 64);
#pragma unroll
            for (int j = 0; j < 4; ++j) { const u32x4_t t4 = *(LAS const u32x4_t*)(lds + L_SQ + rr * SQP + pc * 64 + j * 16); qd[j] = make_uint4(t4[0], t4[1], t4[2], t4[3]); }
            int bb, key0; if (R0 < T_LAT) { bb = R0 >> 12; key0 = R0 & (SEQ - 1); } else { bb = (R0 - T_LAT) >> 8; key0 = SEQ + ((R0 - T_LAT) & (CTXL - 1)); }
            const int vr = tid >> 1, hf = tid & 1;
            const u32x4_t t4 = *(LAS const u32x4_t*)(lds + L_SV + vr * 32 + hf * 16);
            *(uint4*)(V8T + (size_t)((bb * 4 + (vr >> 6)) * 64 + (vr & 63)) * 4352 + (key0 & ~63) + 32 * hf + 16 * ((key0 >> 5) & 1)) = make_uint4(t4[0], t4[1], t4[2], t4[3]);
        }
        if (has_next) { ra = na_; rb = nb_; rc = nc_; rk = nk_;
#pragma unroll
            for (int it = 0; it < 5; ++it) { p1[it] = n1[it]; p2[it] = n2[it]; } }
    }
#undef PREP_LOADS
#undef CVT4_F8
}
#define N_PHASES 23
#define LDS_BYTES 147456
#define LDS_MISC 131072
__device__ __forceinline__ P load_p() {
#if defined(__HIP_DEVICE_COMPILE__)
    const __attribute__((address_space(4))) P* kq = (const __attribute__((address_space(4))) P*)__builtin_amdgcn_kernarg_segment_ptr();
    asm volatile("" : "+s"(kq));
    return *kq;
#else
    return P{};
#endif
}
__global__ void __launch_bounds__(NT, 2) fwd_kernel(P p0, int lo, int hi) {
    extern __shared__ __attribute__((aligned(16))) unsigned char lds_raw[];
    float* lds = (float*)lds_raw;
    LAS unsigned char* ldsl = (LAS unsigned char*)lds_raw;
    volatile LAS unsigned* st = (volatile LAS unsigned*)(ldsl + LDS_MISC);
    if (threadIdx.x < 4) st[threadIdx.x] = 0u;
    __syncthreads();
    XcdBarrier bar; bar.bar = (unsigned*)(p0.ws + OFF_CTL); bar.x = 0; bar.st = st;
    if (hi - lo > 1) bar = xcd_barrier_post((unsigned*)(p0.ws + OFF_CTL), st);
#define IN(k) (lo <= (k) && (k) < hi)
#define PH(k) if (IN(k)) if (const P p = load_p(); true)
#define SEAM(k) do { if (IN(k) && IN((k) + 1)) xcd_barrier(bar); } while (0)
#define MOD ((const float*)(p.ws + OFF_MOD))
#define H ((bf16_t*)(p.ws + OFF_H))
#define XC ((float*)(p.ws + OFF_XC))
#define PROJ ((bf16_t*)(p.ws + OFF_PROJ))
#define ACT ((bf16_t*)(p.ws + OFF_ACT))
#define CNT ((int*)(p.ws + OFF_CNT))
#define LIST ((const int*)(p.ws + OFF_LIST))
#define WL ((const float*)(p.ws + OFF_WL))
#define WIN ((const bf16_t*)(p.ws + OFF_WIN))
#define WOUT ((const bf16_t*)(p.ws + OFF_WOUT))
#define FGU ((const bf16_t*)(p.ws + OFF_FGU))
#define FD ((const bf16_t*)(p.ws + OFF_FD))
#define MGU ((const bf16_t*)(p.ws + OFF_MGU))
#define MDW ((const bf16_t*)(p.ws + OFF_MD))
#define YB ((bf16_t*)(p.ws + OFF_Y))
#define YB2 ((bf16_t*)(p.ws + OFF_Y2))
#define PARTB ((float*)(p.ws + OFF_PART))
    const int G = gridDim.x, bid = blockIdx.x;

    PH(0) { ph_mod(p, lds); ph_tables(p); ph_conv_early(p, lds); }
    SEAM(0);
    PH(1) ph_norm(p, 0, 1, T_ALL, false, true, nullptr, 0, 0, 0, p.ws + OFF_QK8, true);
    SEAM(1);
#define WINL WIN
    PH(2) {
        { pg8::DenseSched S{H, WINL + (size_t)PJ_F8 * 1024, 1024, 1024, T_ALL / 256, (PROJ_LD - PJ_F8) / 256, G, bid}; pg8::EpiBf16 E{PROJ + PJ_F8, PROJ_LD}; pg8::gemm_phase(ldsl, S, E); }
        const int U2 = (T_ALL / 256) * ((PROJ_LD - PJ_F8) / 256), U8 = (T_ALL / 256) * (PJ_F8 / 256), x3 = U2 - 2 * G;
        const pg8::EpiBf16S E8{PROJ, PROJ_LD, 1.f / (F8_SH * F8_SW)};
        if (x3 > 0 && x3 < G && 3 * (G - x3) <= U8 && U8 - 3 * (G - x3) <= x3) {
            if (bid >= x3) { pg8::DenseSchedT<true> S{(const bf16_t*)(p.ws + OFF_QK8), WINL, 512, 512, T_ALL / 256, PJ_F8 / 256, G - x3, bid - x3, 0, 3 * (G - x3)}; pg8::gemm_phase(ldsl, S, E8); }
            else { pg8::DenseSchedT<true> S{(const bf16_t*)(p.ws + OFF_QK8), WINL, 512, 512, T_ALL / 256, PJ_F8 / 256, x3, bid, 3 * (G - x3), U8}; pg8::gemm_phase(ldsl, S, E8); }
        } else { pg8::DenseSchedT<true> S{(const bf16_t*)(p.ws + OFF_QK8), WINL, 512, 512, T_ALL / 256, PJ_F8 / 256, G, bid}; pg8::gemm_phase(ldsl, S, E8); } }
#undef WINL
    SEAM(2);
    PH(3) ph_prep2(p, 0, ldsl);
    SEAM(3);
    PH(4) ph_ret_T(p, 0, ldsl);
    SEAM(4);
    PH(5) ph_mixer_mfma(p, 0, true, ldsl);
    SEAM(5);
    PH(6) {
        { pg8::DenseSched S{H, WOUT, 1024, 1024, T_ALL / 256, 4, G, bid};
          pg8::EpiBf16Norm E{YB, 1024, (unsigned)((size_t)T_ALL * 1024 * 2), (unsigned*)(p.ws + OFF_PCNT), 1.f};
          pg8::gemm_phase(ldsl, S, E); }
        norm_help(p, NormArgs{0, 2, false, true, YB, 0, 2048, 0, nullptr, false}, (unsigned*)(p.ws + OFF_PCNT), 32u, (unsigned*)(p.ws + OFF_CLAIM), T_ALL / 256, (LAS unsigned*)(ldsl + LDS_MISC + 32));
    }
    SEAM(6);
    PH(8) { pg8::DenseSched S{H, FGU, 1024, 1024, T_ALL / 256, 2 * D_FF / 256, G, bid}; pg8::EpiSwigluT<false, true> E{ACT, D_FF}; pg8::gemm_phase(ldsl, S, E); }
    SEAM(8);
    PH(9) {
        { pg8::DenseSchedT<true> S{ACT, FD, D_FF / 2, D_FF / 2, T_ALL / 256, 4, G, bid};
          pg8::EpiBf16Norm E{YB2, 1024, (unsigned)((size_t)T_ALL * 1024 * 2), (unsigned*)(p.ws + OFF_PCNT) + 136 * 64, 1.f / (F8_SA * F8_SW)};
          pg8::gemm_phase(ldsl, S, E); }
        norm_help(p, NormArgs{1, 1, false, false, YB2, 0, 5120, 0, p.ws + OFF_QK8, true}, (unsigned*)(p.ws + OFF_PCNT) + 136 * 64, 32u, (unsigned*)(p.ws + OFF_CLAIM) + 64, T_ALL / 256, (LAS unsigned*)(ldsl + LDS_MISC + 32));
    }
    SEAM(9);
#define WINL (WIN + (size_t)PROJ_LD * 1024)
    PH(11) {
        { pg8::DenseSched S{H, WINL + (size_t)PJ_F8 * 1024, 1024, 1024, T_ALL / 256, (PROJ_LD - PJ_F8) / 256, G, bid}; pg8::EpiBf16 E{PROJ + PJ_F8, PROJ_LD}; pg8::gemm_phase(ldsl, S, E); }
        const int U2 = (T_ALL / 256) * ((PROJ_LD - PJ_F8) / 256), U8 = (T_ALL / 256) * (PJ_F8 / 256), x3 = U2 - 2 * G;
        const pg8::EpiBf16S E8{PROJ, PROJ_LD, 1.f / (F8_SH * F8_SW)};
        if (x3 > 0 && x3 < G && 3 * (G - x3) <= U8 && U8 - 3 * (G - x3) <= x3) {
            if (bid >= x3) { pg8::DenseSchedT<true> S{(const bf16_t*)(p.ws + OFF_QK8), WINL, 512, 512, T_ALL / 256, PJ_F8 / 256, G - x3, bid - x3, 0, 3 * (G - x3)}; pg8::gemm_phase(ldsl, S, E8); }
            else { pg8::DenseSchedT<true> S{(const bf16_t*)(p.ws + OFF_QK8), WINL, 512, 512, T_ALL / 256, PJ_F8 / 256, x3, bid, 3 * (G - x3), U8}; pg8::gemm_phase(ldsl, S, E8); }
        } else { pg8::DenseSchedT<true> S{(const bf16_t*)(p.ws + OFF_QK8), WINL, 512, 512, T_ALL / 256, PJ_F8 / 256, G, bid}; pg8::gemm_phase(ldsl, S, E8); } }
#undef WINL
    SEAM(11);
    PH(12) ph_prep2(p, 1, ldsl);
    SEAM(12);
    PH(13) ph_ret_T(p, 1, ldsl);
    SEAM(13);
    PH(14) ph_mixer_mfma(p, 1, false, ldsl);
    SEAM(14);
    PH(15) { pg8::DenseSched S{H, WOUT + (size_t)1024 * 1024, 1024, 1024, T_LAT / 256, 4, G, bid}; pg8::EpiBf16 E{YB, 1024}; pg8::gemm_phase(ldsl, S, E); }
    SEAM(15);
    PH(16) { ph_norm(p, 1, 2, T_LAT, true, false, YB, 1, 2048, 0, p.ws + OFF_H, false); ph_conv_late(p, lds); }
    SEAM(16);
#pragma unroll
    for (int s = 0; s < 2; ++s) {
        if (IN(17 + 2 * s) || IN(18 + 2 * s)) {
            LAS int* tab = (LAS int*)(ldsl + LDS_MISC + 64 + 128 * s);
            { const P p = load_p();
            __syncthreads();
            if (threadIdx.x == 0) { int tbv = 0; tab[8] = 0;
                for (int e = 0; e < 8; ++e) { const int ce = __hip_atomic_load(CNT + s * 8 + e, __ATOMIC_RELAXED, __HIP_MEMORY_SCOPE_AGENT); tab[e] = ce; tbv += (ce + 255) >> 8; tab[9 + e] = tbv; } }
            __syncthreads(); }
            const int nTm = tab[16];
            PH(17 + 2 * s) {
                if (s == 1) pg8::moe_combine((bf16_t*)(p.ws + OFF_YM), PARTB, (const LAS int*)(ldsl + LDS_MISC + 64), 4, 1.f / (F8_SA * F8_SW));
                pg8::MoeSched<true, true> S{H, MGU, 512, 512, 2 * D_FFE / 256, G, bid, (size_t)D_FFE * 1024, LIST + (size_t)s * 8 * 32768, tab, 0, nTm * (2 * D_FFE / 256), 1, 512 / 64};
                pg8::EpiSwigluT<true, true> E{ACT, D_FFE}; pg8::gemm_phase(ldsl, S, E);
            }
            SEAM(17 + 2 * s);
            PH(18 + 2 * s) {
                const int U = nTm * 4, rem = U % G, split = (rem > 0 && rem * MOE_WAYS <= G) ? 1 : 0, umain = split ? U - rem : U;
                { pg8::MoeSched<false, true> S{ACT, MDW, D_FFE / 2, D_FFE / 2, 4, G, bid, (size_t)512 * D_FFE, nullptr, tab, 0, umain, 1, D_FFE / 128};
                  pg8::EpiBf16S E{(bf16_t*)(p.ws + OFF_YM) + (size_t)s * ACT_ROWS * 1024, 1024, 1.f / (F8_SA * F8_SW)};
                  pg8::gemm_phase(ldsl, S, E); }
                if (split) { pg8::MoeSched<false, true> S{ACT, MDW, D_FFE / 2, D_FFE / 2, 4, G, bid, (size_t)512 * D_FFE, nullptr, tab, umain, U, MOE_WAYS, D_FFE / 128 / MOE_WAYS};
                  pg8::EpiPart E{PARTB}; pg8::gemm_phase(ldsl, S, E); }
            }
        }
        SEAM(18 + 2 * s);
    }
    PH(21) { const LAS int* tab1 = (const LAS int*)(ldsl + LDS_MISC + 64 + 128);
        pg8::moe_combine((bf16_t*)(p.ws + OFF_YM) + (size_t)ACT_ROWS * 1024, PARTB, tab1, 4, 1.f / (F8_SA * F8_SW)); }
    SEAM(21);
    PH(22) ph_final_moe(p, (const LAS int*)(ldsl + LDS_MISC + 64), (const LAS int*)(ldsl + LDS_MISC + 64 + 128));
}

extern "C" void kernel_launch(void* const* d_in, const int* in_sizes, int n_in, void* d_out, int out_size, void* d_ws, size_t ws_size, hipStream_t stream) {
    static int grid = 0;
    if (!grid) {
        if (n_in != 25 || out_size != T_LAT * 1024 || ws_size < WS_END) { fprintf(stderr, "kernel_launch: unexpected shapes (n_in %d out %d ws %zu need %zu)\n", n_in, out_size, ws_size, (size_t)WS_END); grid = -1; return; }
        int dev = 0, cus = 0, per_cu = 0;
        (void)hipGetDevice(&dev); (void)hipDeviceGetAttribute(&cus, hipDeviceAttributeMultiprocessorCount, dev);
        (void)hipFuncSetAttribute((const void*)fwd_kernel, hipFuncAttributeMaxDynamicSharedMemorySize, LDS_BYTES);
        (void)hipOccupancyMaxActiveBlocksPerMultiprocessor(&per_cu, (const void*)fwd_kernel, NT, LDS_BYTES);
        if (per_cu < 1) { fprintf(stderr, "kernel_launch: occupancy query says %d\n", per_cu); }
        grid = cus > 0 ? cus : 256;
    }
    if (grid < 0) return;
    (void)hipMemsetAsync((char*)d_ws + OFF_CTL, 0, CTL_BYTES, stream);
    P p{};
    for (int i = 0; i < 25; ++i) p.in[i] = (const float*)d_in[i];
    p.out = (float*)d_out; p.ws = (unsigned char*)d_ws;
    hipLaunchKernelGGL(fwd_kernel, dim3(grid), dim3(NT), LDS_BYTES, stream, p, 0, N_PHASES);
}
```

```cpp
#include <hip/hip_runtime.h>
#include <stdint.h>
#include <stdio.h>

#define D_MODEL 1024
#define BATCH 8
#define SEQ 4096
#define CTXL 256
#define T_LAT (BATCH * SEQ)
#define T_CTX (BATCH * CTXL)
#define T_ALL (T_LAT + T_CTX)
#define IN_DIM 2144
#define PROJ_LD 2304
#define POST_LD 2816
#define D_FF 2816
#define D_FFE 3584
#define NEXP 8
#define NT 512
#define NORM_EPS 1e-6f

typedef unsigned short bf16_t;
__device__ __forceinline__ float bf2f(bf16_t v) { return __uint_as_float(((unsigned)v) << 16); }
__device__ __forceinline__ bf16_t f2bf(float f) { unsigned u = __float_as_uint(f); u += 0x7FFFu + ((u >> 16) & 1u); return (bf16_t)(u >> 16); }
__device__ __forceinline__ float silu_f(float v) { return v / (1.f + expf(-v)); }

#define PJ_RQ 1280
#define PJ_RK 1536
#define PJ_RV 1792
#define PJ_RG 2048
#define PJ_F8 1280
#define PC_QA 0
#define PC_KA 384
#define PC_VA 768
#define PC_QB 1024
#define PC_KB 1536
#define PC_VB 1664
#define PC_RQ 1792
#define PC_RK 2048
#define PC_RV 2304
#define PC_RG 2560

constexpr size_t AL256(size_t x) { return (x + 255) & ~(size_t)255; }
constexpr size_t OFF_CTL  = 0;
constexpr size_t CTL_BYTES = 262144;
constexpr size_t OFF_PCNT = 32768;
constexpr size_t OFF_CLAIM = 20480;
constexpr size_t OFF_CNT  = 16384;
constexpr size_t OFF_MOD  = 1u << 20;
constexpr size_t OFF_TAB  = 3u << 19;
constexpr size_t OFF_WIN  = 3u << 20;
constexpr size_t OFF_WOUT = OFF_WIN + (size_t)2 * PROJ_LD * 1024 * 2;
constexpr size_t OFF_FGU  = OFF_WOUT + (size_t)2 * 1024 * 1024 * 2;
constexpr size_t OFF_FD   = OFF_FGU + (size_t)2 * D_FF * 1024 * 2;
constexpr size_t OFF_WUQ  = OFF_FD + (size_t)1024 * D_FF * 2;
constexpr size_t OFF_WUKV = OFF_WUQ + (size_t)2 * 384 * 192 * 2;
constexpr size_t OFF_H    = OFF_WUKV + (size_t)2 * 512 * 128 * 2;
constexpr size_t OFF_XC   = OFF_H + (size_t)T_ALL * 1024 * 2;
constexpr size_t OFF_LIST = OFF_XC + (size_t)T_CTX * 1024 * 4;
constexpr size_t OFF_WL   = OFF_LIST + (size_t)2 * 8 * 32768 * 4;
constexpr size_t OFF_R    = OFF_WL + (size_t)2 * 8 * 32768 * 4;
constexpr size_t OFF_PROJ = OFF_R;
constexpr size_t OFF_POST = OFF_PROJ + (size_t)T_ALL * PROJ_LD * 2;
constexpr size_t OFF_TT   = OFF_POST + (size_t)T_ALL * POST_LD * 2;
constexpr size_t R1_END   = OFF_TT + (size_t)BATCH * 4 * 34 * 2 * 4096 * 4;
constexpr size_t OFF_ACT  = OFF_R;
constexpr size_t OFF_Y    = OFF_PROJ;
constexpr size_t OFF_H8D  = OFF_ACT + (size_t)T_ALL * D_FF;
constexpr size_t OFF_Y2   = OFF_ACT + (size_t)T_ALL * D_FF * 2;
constexpr size_t ACT_ROWS = T_LAT + NEXP * 256;
constexpr size_t OFF_MGU  = OFF_ACT + ACT_ROWS * D_FFE;
constexpr size_t OFF_MD   = OFF_MGU + (size_t)NEXP * 2 * D_FFE * 1024;
constexpr size_t OFF_PART = OFF_MD + (size_t)NEXP * 1024 * D_FFE;
constexpr size_t PART_END = OFF_PART + (size_t)256 * 65536 * 4;
constexpr size_t OFF_YM   = PART_END;
constexpr size_t OFF_INV  = OFF_YM + (size_t)2 * ACT_ROWS * 1024 * 2;
constexpr size_t YM_END   = OFF_INV + (size_t)T_LAT * 32;
constexpr size_t OFF_QK8  = YM_END;
constexpr size_t OFF_V8T  = OFF_QK8 + (size_t)T_ALL * 1024;
constexpr size_t F8_END   = OFF_V8T + (size_t)BATCH * 4 * 64 * 4352;
constexpr size_t WS_END   = F8_END > R1_END ? F8_END : R1_END;
static_assert(R1_END <= WS_END, "phase-1 buffers fit");
static_assert(WS_END <= 607070848, "workspace budget");
static_assert(OFF_Y2 + (size_t)T_ALL * 1024 * 2 <= WS_END, "Y2 fits");
static_assert(OFF_MGU >= OFF_Y + (size_t)T_ALL * 1024 * 2, "expert weights are converted while norm2(L1) still reads Y");

struct P { const float* in[25]; float* out; unsigned char* ws; };

#define XB_TMO      128
#define XB_XCNT(j)  (256  + 64 * (j))
#define XB_XSUB(j)  (1280 + 64 * (j))
#define XB_XGEN(j)  (2304 + 64 * (j))
#define XB_TOP      3328
#define XB_TOPGEN   3392
#define XCD_BAR_WORDS 3456
#define XB_SPIN_CAP (1u << 22)
#define LAS __attribute__((address_space(3)))

__device__ __forceinline__ unsigned xb_ld(unsigned* p)              { return __hip_atomic_load(p, __ATOMIC_RELAXED, __HIP_MEMORY_SCOPE_AGENT); }
__device__ __forceinline__ unsigned xb_add(unsigned* p, unsigned v) { return __hip_atomic_fetch_add(p, v, __ATOMIC_RELAXED, __HIP_MEMORY_SCOPE_AGENT); }
__device__ __forceinline__ unsigned xb_xcc_id() { return (unsigned)__builtin_amdgcn_s_getreg((3 << 11) | 20) & 0xFu; }
#define XB_SPIN(cond, bar) do { unsigned _sp = 0; while (cond) { __builtin_amdgcn_s_sleep(1); \
    if ((++_sp & 255u) == 0u) { if (xb_ld(&(bar)[XB_TMO])) break; if (_sp > XB_SPIN_CAP) { atomicAdd(&(bar)[XB_TMO], 1u); break; } } } } while (0)

struct XcdBarrier { unsigned* bar; unsigned x; volatile LAS unsigned* st; };

__device__ __forceinline__ XcdBarrier xcd_barrier_post(unsigned* bar, volatile LAS unsigned* st) {
    XcdBarrier b; b.bar = bar; b.x = xb_xcc_id(); b.st = st;
    if (threadIdx.x == 0) (void)xb_add(&bar[XB_XCNT(b.x)], 1u);
    return b;
}
__device__ __forceinline__ void xcd_barrier_complete(unsigned* bar, unsigned x, unsigned& nloc, unsigned& nx) {
    const unsigned G = gridDim.x * gridDim.y * gridDim.z;
    unsigned sum, cnt, mine, sp = 0u;
    for (;;) {
        sum = 0u; cnt = 0u; mine = 0u;
#pragma unroll
        for (unsigned j = 0; j < 16; ++j) { const unsigned c = xb_ld(&bar[XB_XCNT(j)]); sum += c; cnt += (c > 0u) ? 1u : 0u; mine = (j == x) ? c : mine; }
        if (sum == G) break;
        __builtin_amdgcn_s_sleep(1);
        if ((++sp & 255u) == 0u) { if (xb_ld(&bar[XB_TMO])) break; if (sp > XB_SPIN_CAP) { atomicAdd(&bar[XB_TMO], 1u); break; } }
    }
    nloc = mine > 0u ? mine : 1u; nx = cnt > 0u ? cnt : 1u;
}
__device__ __forceinline__ void xcd_barrier(const XcdBarrier& b) {
    asm volatile("s_waitcnt vmcnt(0)" ::: "memory");
    __syncthreads();
    if (threadIdx.x == 0) {
        unsigned* bar = b.bar;
        __builtin_amdgcn_s_waitcnt(0);
        unsigned nloc = b.st[0], nx = b.st[1];
        if (nloc == 0u) { xcd_barrier_complete(bar, b.x, nloc, nx); b.st[0] = nloc; b.st[1] = nx; }
        const unsigned old = xb_add(&bar[XB_XSUB(b.x)], 1u);
        const unsigned gen = old / nloc;
        if (old + 1u == (gen + 1u) * nloc) {
            __builtin_amdgcn_fence(__ATOMIC_RELEASE, "agent");
            asm volatile("s_waitcnt vmcnt(0)" ::: "memory");
            const unsigned og = xb_add(&bar[XB_TOP], 1u);
            const unsigned tg = og / nx;
            if (og + 1u == (tg + 1u) * nx) xb_add(&bar[XB_TOPGEN], 1u);
            else XB_SPIN(xb_ld(&bar[XB_TOPGEN]) == tg, bar);
            __builtin_amdgcn_fence(__ATOMIC_ACQUIRE, "agent");
            xb_add(&bar[XB_XGEN(b.x)], 1u);
            asm volatile("s_waitcnt vmcnt(0)" ::: "memory");
        } else {
            XB_SPIN(xb_ld(&bar[XB_XGEN(b.x)]) == gen, bar);
            __builtin_amdgcn_fence(__ATOMIC_ACQUIRE, "agent");
            asm volatile("s_waitcnt vmcnt(0)" ::: "memory");
        }
    }
    __syncthreads();
}

__device__ __forceinline__ float wave_sum(float v) {
#pragma unroll
    for (int o = 32; o > 0; o >>= 1) v += __shfl_xor(v, o);
    return v;
}
__device__ __forceinline__ void unpack8(const uint4 r, float* f) {
    f[0] = __uint_as_float(r.x << 16); f[1] = __uint_as_float(r.x & 0xFFFF0000u);
    f[2] = __uint_as_float(r.y << 16); f[3] = __uint_as_float(r.y & 0xFFFF0000u);
    f[4] = __uint_as_float(r.z << 16); f[5] = __uint_as_float(r.z & 0xFFFF0000u);
    f[6] = __uint_as_float(r.w << 16); f[7] = __uint_as_float(r.w & 0xFFFF0000u);
}
__device__ __forceinline__ int tok_row(int b, int i) { return i < SEQ ? b * SEQ + i : T_LAT + b * CTXL + (i - SEQ); }

__device__ __forceinline__ void ph_mod(const P& p, float* lds) {
    float* MOD = (float*)(p.ws + OFF_MOD);
    float* sl = lds; float* part = lds + 9 * 1024;
    int tid_ = threadIdx.x; asm volatile("" : "+v"(tid_));
    const int t = tid_, col = t & 63, ks = t >> 6;
    __syncthreads();
    for (int i = t; i < 9 * 1024; i += NT) { const int r = i >> 10, k = i & 1023; sl[i] = silu_f(r < 8 ? p.in[1][r * 1024 + k] : p.in[3][k]); }
    __syncthreads();
    for (int u = blockIdx.x; u < 2 * 96; u += gridDim.x) {
        const int l = u / 96, n = (u % 96) * 64 + col;
        const float* w = p.in[4] + (size_t)l * 1024 * 6144 + (size_t)(ks * 128) * 6144 + n;
        float acc[9];
#pragma unroll
        for (int r = 0; r < 9; ++r) acc[r] = 0.f;
#pragma unroll 8
        for (int k = 0; k < 128; ++k) { const float wv = w[(size_t)k * 6144];
#pragma unroll
            for (int r = 0; r < 9; ++r) acc[r] += sl[r * 1024 + ks * 128 + k] * wv; }
        __syncthreads();
#pragma unroll
        for (int r = 0; r < 9; ++r) part[(ks * 9 + r) * 64 + col] = acc[r];
        __syncthreads();
        for (int i = t; i < 9 * 64; i += NT) { const int r = i >> 6, c2 = i & 63; float s = 0.f;
#pragma unroll
            for (int q = 0; q < 8; ++q) s += part[(q * 9 + r) * 64 + c2];
            const int nn = (u % 96) * 64 + c2; MOD[(l * 9 + r) * 6144 + nn] = s + p.in[5][l * 6144 + nn]; }
    }
}

#define F8_SH 8.f
#define F8_SW 64.f
#define F8_SA 4.f
#define MOE_WAYS 7
__device__ __forceinline__ float f8clamp(float x) { return fminf(fmaxf(x, -448.f), 448.f); }
struct NormArgs { int layer, which; bool router, from_input; const bf16_t* resY; int res_layer, res_goff, ctx_ways; unsigned char* h8; bool both; };
__device__ __forceinline__ void norm_row(const P& p, const NormArgs& a, int row, int lane) {
    const int layer = a.layer, which = a.which, res_layer = a.res_layer, res_goff = a.res_goff, ctx_ways = a.ctx_ways; const bool router = a.router, from_input = a.from_input; const bf16_t* resY = a.resY;
    const float* MOD = (const float*)(p.ws + OFF_MOD);
    const float* gain = (which == 1 ? p.in[6] : p.in[7]) + layer * 1024;
    bf16_t* H = (bf16_t*)(p.ws + OFF_H);
    float* XC = (float*)(p.ws + OFF_XC);
    int* CNT = (int*)(p.ws + OFF_CNT);
    int* LIST = (int*)(p.ws + OFF_LIST);
    float* WL = (float*)(p.ws + OFF_WL);
    {
        const float* src; float* dstx; int r;
        if (row < T_LAT) { r = row >> 12; src = (from_input ? p.in[0] : p.out) + (size_t)row * 1024; dstx = p.out + (size_t)row * 1024; }
        else { r = 8; src = (from_input ? p.in[2] : XC) + (size_t)(row - T_LAT) * 1024; dstx = XC + (size_t)(row - T_LAT) * 1024; }
        const float* md = MOD + (layer * 9 + r) * 6144 + (which == 1 ? 0 : 3072);
        float4 v[4]; float ss = 0.f;
#pragma unroll
        for (int i = 0; i < 4; ++i) v[i] = *(const float4*)(src + i * 256 + lane * 4);
        if (resY) {
            const float* gt = MOD + (res_layer * 9 + r) * 6144 + res_goff;
#pragma unroll
            for (int i = 0; i < 4; ++i) { const int col = i * 256 + lane * 4;
                const float4 g = *(const float4*)(gt + col); float4 y;
                if (row >= T_LAT && ctx_ways > 0) {
                    const int cr = row - T_LAT; const float* pp = (const float*)(p.ws + OFF_PART) + (size_t)(((cr >> 8) * 4 + i) * ctx_ways) * 65536 + (cr & 255) * 256 + lane * 4;
                    y = *(const float4*)pp;
                    for (int q = 1; q < ctx_ways; ++q) { const float4 z = *(const float4*)(pp + (size_t)q * 65536); y.x += z.x; y.y += z.y; y.z += z.z; y.w += z.w; }
                } else { const uint2 yr = *(const uint2*)(resY + (size_t)row * 1024 + col);
                    y = make_float4(__uint_as_float(yr.x << 16), __uint_as_float(yr.x & 0xFFFF0000u), __uint_as_float(yr.y << 16), __uint_as_float(yr.y & 0xFFFF0000u)); }
                v[i].x += g.x * y.x; v[i].y += g.y * y.y; v[i].z += g.z * y.z; v[i].w += g.w * y.w;
                *(float4*)(dstx + col) = v[i]; }
        }
#pragma unroll
        for (int i = 0; i < 4; ++i) ss += v[i].x * v[i].x + v[i].y * v[i].y + v[i].z * v[i].z + v[i].w * v[i].w;
        ss = wave_sum(ss);
        const float rs = rsqrtf(ss * (1.f / 1024.f) + NORM_EPS);
        float lg[8] = {0.f, 0.f, 0.f, 0.f, 0.f, 0.f, 0.f, 0.f};
#pragma unroll
        for (int i = 0; i < 4; ++i) {
            const int col = i * 256 + lane * 4;
            const float4 g = *(const float4*)(gain + col), sh = *(const float4*)(md + col), sc = *(const float4*)(md + 1024 + col);
            float o[4];
            o[0] = (v[i].x * rs * g.x) * (1.f + sc.x) + sh.x; o[1] = (v[i].y * rs * g.y) * (1.f + sc.y) + sh.y;
            o[2] = (v[i].z * rs * g.z) * (1.f + sc.z) + sh.z; o[3] = (v[i].w * rs * g.w) * (1.f + sc.w) + sh.w;
            if (a.h8) {
                int w8 = 0; w8 = __builtin_amdgcn_cvt_pk_fp8_f32(f8clamp(o[0] * F8_SH), f8clamp(o[1] * F8_SH), w8, false); w8 = __builtin_amdgcn_cvt_pk_fp8_f32(f8clamp(o[2] * F8_SH), f8clamp(o[3] * F8_SH), w8, true);
                *(int*)(a.h8 + (size_t)row * 1024 + col) = w8;
            }
            if (!a.h8 || a.both) {
            uint2 pk; pk.x = (unsigned)f2bf(o[0]) | ((unsigned)f2bf(o[1]) << 16); pk.y = (unsigned)f2bf(o[2]) | ((unsigned)f2bf(o[3]) << 16);
            *(uint2*)(H + (size_t)row * 1024 + col) = pk; }
            if (router) {
                const float* rw = p.in[20] + (size_t)col * 8;
#pragma unroll
                for (int j = 0; j < 4; ++j) {
                    const float4 w0 = *(const float4*)(rw + j * 8), w1 = *(const float4*)(rw + j * 8 + 4);
                    lg[0] += o[j] * w0.x; lg[1] += o[j] * w0.y; lg[2] += o[j] * w0.z; lg[3] += o[j] * w0.w;
                    lg[4] += o[j] * w1.x; lg[5] += o[j] * w1.y; lg[6] += o[j] * w1.z; lg[7] += o[j] * w1.w;
                }
            }
        }
        if (router) {
#pragma unroll
            for (int e = 0; e < 8; ++e) lg[e] = wave_sum(lg[e]);
            if (lane == 0) {
                int e0 = 0; float v0 = lg[0];
#pragma unroll
                for (int e = 1; e < 8; ++e) if (lg[e] > v0) { v0 = lg[e]; e0 = e; }
                int e1 = -1; float v1 = -3.0e38f;
#pragma unroll
                for (int e = 0; e < 8; ++e) if (e != e0 && lg[e] > v1) { v1 = lg[e]; e1 = e; }
                const float x1 = expf(v1 - v0), inv = 1.f / (1.f + x1);
                const float w0 = inv, w1 = x1 * inv;
                const int p0 = atomicAdd(&CNT[e0], 1), p1 = atomicAdd(&CNT[8 + e1], 1);
                LIST[(size_t)e0 * 32768 + p0] = row; WL[(size_t)e0 * 32768 + p0] = w0;
                LIST[(size_t)(8 + e1) * 32768 + p1] = row; WL[(size_t)(8 + e1) * 32768 + p1] = w1;
                { int* iv = (int*)(p.ws + OFF_INV) + (size_t)row * 8; *(int4*)iv = make_int4(e0, p0, e1, p1); *(float2*)(iv + 4) = make_float2(w0, w1); }
            }
        }
    }
}
__device__ __forceinline__ void norm_rows4(const P& p, const NormArgs& a, int row0, int lane) {
    const float* MOD = (const float*)(p.ws + OFF_MOD);
    bf16_t* H = (bf16_t*)(p.ws + OFF_H); float* XC = (float*)(p.ws + OFF_XC);
    const bool lat = row0 < T_LAT; const int r = lat ? (row0 >> 12) : 8;
    const float* srcb = lat ? (a.from_input ? p.in[0] : p.out) + (size_t)row0 * 1024 : (a.from_input ? p.in[2] : XC) + (size_t)(row0 - T_LAT) * 1024;
    float* dstb = lat ? p.out + (size_t)row0 * 1024 : XC + (size_t)(row0 - T_LAT) * 1024;
    float4 v[4][4]; uint2 y[4][4];
#pragma unroll
    for (int q = 0; q < 4; ++q)
#pragma unroll
        for (int i = 0; i < 4; ++i) { v[q][i] = *(const float4*)(srcb + q * 1024 + i * 256 + lane * 4); y[q][i] = *(const uint2*)(a.resY + (size_t)(row0 + q) * 1024 + i * 256 + lane * 4); }
    const float* gt = MOD + (a.res_layer * 9 + r) * 6144 + a.res_goff;
    const float* md = MOD + (a.layer * 9 + r) * 6144 + (a.which == 1 ? 0 : 3072);
    const float* gain = (a.which == 1 ? p.in[6] : p.in[7]) + a.layer * 1024;
    float4 gg[4], gn[4], sh[4], sc[4];
#pragma unroll
    for (int i = 0; i < 4; ++i) { const int col = i * 256 + lane * 4; gg[i] = *(const float4*)(gt + col); gn[i] = *(const float4*)(gain + col); sh[i] = *(const float4*)(md + col); sc[i] = *(const float4*)(md + 1024 + col); }
#pragma unroll
    for (int q = 0; q < 4; ++q) {
        float ss = 0.f;
#pragma unroll
        for (int i = 0; i < 4; ++i) { const uint2 yr = y[q][i];
            v[q][i].x += gg[i].x * __uint_as_float(yr.x << 16); v[q][i].y += gg[i].y * __uint_as_float(yr.x & 0xFFFF0000u);
            v[q][i].z += gg[i].z * __uint_as_float(yr.y << 16); v[q][i].w += gg[i].w * __uint_as_float(yr.y & 0xFFFF0000u);
            *(float4*)(dstb + q * 1024 + i * 256 + lane * 4) = v[q][i];
            ss += v[q][i].x * v[q][i].x + v[q][i].y * v[q][i].y + v[q][i].z * v[q][i].z + v[q][i].w * v[q][i].w; }
        ss = wave_sum(ss);
        const float rs = rsqrtf(ss * (1.f / 1024.f) + NORM_EPS);
#pragma unroll
        for (int i = 0; i < 4; ++i) { float o[4];
            o[0] = (v[q][i].x * rs * gn[i].x) * (1.f + sc[i].x) + sh[i].x; o[1] = (v[q][i].y * rs * gn[i].y) * (1.f + sc[i].y) + sh[i].y;
            o[2] = (v[q][i].z * rs * gn[i].z) * (1.f + sc[i].z) + sh[i].z; o[3] = (v[q][i].w * rs * gn[i].w) * (1.f + sc[i].w) + sh[i].w;
            if (a.h8) { int w8 = 0; w8 = __builtin_amdgcn_cvt_pk_fp8_f32(f8clamp(o[0] * F8_SH), f8clamp(o[1] * F8_SH), w8, false); w8 = __builtin_amdgcn_cvt_pk_fp8_f32(f8clamp(o[2] * F8_SH), f8clamp(o[3] * F8_SH), w8, true);
                *(int*)(a.h8 + (size_t)(row0 + q) * 1024 + i * 256 + lane * 4) = w8; }
            if (!a.h8 || a.both) { uint2 pk; pk.x = (unsigned)f2bf(o[0]) | ((unsigned)f2bf(o[1]) << 16); pk.y = (unsigned)f2bf(o[2]) | ((unsigned)f2bf(o[3]) << 16);
            *(uint2*)(H + (size_t)(row0 + q) * 1024 + i * 256 + lane * 4) = pk; } }
    }
}
__device__ __forceinline__ void norm_help(const P& p, const NormArgs& a, unsigned* cnt, unsigned need, unsigned* claim, int npanels, LAS unsigned* lw) {
    int tid_ = threadIdx.x; asm volatile("" : "+v"(tid_));
    const int wave = __builtin_amdgcn_readfirstlane(tid_ >> 6), lane = tid_ & 63;
    for (;;) {
        __syncthreads();
        if (threadIdx.x == 0) {
            const unsigned part = __hip_atomic_fetch_add(claim, 1u, __ATOMIC_RELAXED, __HIP_MEMORY_SCOPE_AGENT);
            if (part < (unsigned)npanels * 4u) {
                unsigned sp = 0;
                while (__hip_atomic_load(cnt + 64 * (part >> 2), __ATOMIC_RELAXED, __HIP_MEMORY_SCOPE_AGENT) < need) { __builtin_amdgcn_s_sleep(8); if (++sp > (1u << 22)) break; }
                __builtin_amdgcn_fence(__ATOMIC_ACQUIRE, "agent");
                asm volatile("s_waitcnt vmcnt(0)" ::: "memory");
            }
            lw[0] = part;
        }
        __syncthreads();
        const unsigned part = lw[0];
        if (part >= (unsigned)npanels * 4u) break;
        const int base = (int)(part >> 2) * 256 + (int)(part & 3u) * 64 + wave * 8;
        norm_rows4(p, a, base, lane); norm_rows4(p, a, base + 4, lane);
    }
}
__device__ __forceinline__ void ph_norm(const P& p, int layer, int which, int nrows, bool router, bool from_input, const bf16_t* resY, int res_layer, int res_goff, int ctx_ways, unsigned char* h8, bool both) {
    int tid_ = threadIdx.x; asm volatile("" : "+v"(tid_));
    const int wave = tid_ >> 6, lane = tid_ & 63;
    const NormArgs a{layer, which, router, from_input, resY, res_layer, res_goff, ctx_ways, h8, both};
    for (int row = blockIdx.x * 8 + wave; row < nrows; row += gridDim.x * 8) norm_row(p, a, row, lane);
}

struct ConvJob { const float* src; bf16_t* dst; int K, N, map, f8; };
__device__ __forceinline__ void conv_tiles4(const ConvJob& j, int tile, int step, int ntl, float* T  ) {
    int tid_ = threadIdx.x; asm volatile("" : "+v"(tid_));
    const int ntn = (j.N + 63) >> 6, t = tid_;
    float4 v[4][2];
#pragma unroll
    for (int q = 0; q < 4; ++q) { const int tl = tile + q * step, tk = tl / ntn, tn = tl % ntn;
#pragma unroll
        for (int i = 0; i < 2; ++i) { const int kr = (t >> 4) + 32 * i, c4 = (t & 15) * 4, n = tn * 64 + c4;
            v[q][i] = make_float4(0.f, 0.f, 0.f, 0.f);
            if (tl < ntl && n < j.N) v[q][i] = *(const float4*)(j.src + (size_t)(tk * 64 + kr) * j.N + n); } }
    __syncthreads();
#pragma unroll
    for (int q = 0; q < 4; ++q)
#pragma unroll
        for (int i = 0; i < 2; ++i) { const int kr = (t >> 4) + 32 * i, c4 = (t & 15) * 4; float* Tq = T + q * (64 * 65);
            Tq[kr * 65 + c4 + 0] = v[q][i].x; Tq[kr * 65 + c4 + 1] = v[q][i].y; Tq[kr * 65 + c4 + 2] = v[q][i].z; Tq[kr * 65 + c4 + 3] = v[q][i].w; }
    __syncthreads();
#pragma unroll
    for (int q = 0; q < 4; ++q) { const int tl = tile + q * step, tk = tl / ntn, tn = tl % ntn; const float* Tq = T + q * (64 * 65);
        const int nl = t >> 3, ks = (t & 7) * 8, n = tn * 64 + nl;
        if (tl < ntl && n < j.N) {
            int nd = j.map == 0 ? n : ((n >> 7) * 256 + (n & 127) + (j.map == 2 ? 128 : 0)); bool f8 = j.f8 != 0;
            if (j.map == 3) {
                nd = n < 1120 ? n : PJ_RQ + (n - 1120);
                f8 = nd < PJ_F8; }
            if (f8) {
                int w0 = 0, w1 = 0;
                w0 = __builtin_amdgcn_cvt_pk_fp8_f32(f8clamp(Tq[(ks + 0) * 65 + nl] * F8_SW), f8clamp(Tq[(ks + 1) * 65 + nl] * F8_SW), w0, false);
                w0 = __builtin_amdgcn_cvt_pk_fp8_f32(f8clamp(Tq[(ks + 2) * 65 + nl] * F8_SW), f8clamp(Tq[(ks + 3) * 65 + nl] * F8_SW), w0, true);
                w1 = __builtin_amdgcn_cvt_pk_fp8_f32(f8clamp(Tq[(ks + 4) * 65 + nl] * F8_SW), f8clamp(Tq[(ks + 5) * 65 + nl] * F8_SW), w1, false);
                w1 = __builtin_amdgcn_cvt_pk_fp8_f32(f8clamp(Tq[(ks + 6) * 65 + nl] * F8_SW), f8clamp(Tq[(ks + 7) * 65 + nl] * F8_SW), w1, true);
                *(uint2*)((unsigned char*)j.dst + (size_t)nd * j.K + tk * 64 + ks) = make_uint2((unsigned)w0, (unsigned)w1);
            } else {
            unsigned w[4];
#pragma unroll
            for (int i = 0; i < 4; ++i) w[i] = (unsigned)f2bf(Tq[(ks + 2 * i) * 65 + nl]) | ((unsigned)f2bf(Tq[(ks + 2 * i + 1) * 65 + nl]) << 16);
            *(uint4*)(j.dst + (size_t)nd * j.K + tk * 64 + ks) = make_uint4(w[0], w[1], w[2], w[3]);
            }
        } }
}
__device__ __forceinline__ int conv_ntiles(int K, int N) { return (K >> 6) * ((N + 63) >> 6); }

#define CONV_F8 0
__device__ __forceinline__ void ph_conv_early(const P& p, float* lds) {
    const int G = gridDim.x, bid = blockIdx.x;
    int base = 0;
#define CONV_RUN(SRC, DST, K_, N_, MAP_) do { ConvJob j{SRC, DST, K_, N_, MAP_, CONV_F8}; const int nt_ = conv_ntiles(K_, N_), ns_ = (nt_ + 3) >> 2; \
          \
        for (int u = (((bid - base % G) + G) % G); u < ns_; u += G) conv_tiles4(j, 4 * u, 1, nt_, lds); base += ns_; } while (0)
    for (int l = 0; l < 2; ++l) {
        CONV_RUN(p.in[8] + (size_t)l * 1024 * IN_DIM, (bf16_t*)(p.ws + OFF_WIN) + (size_t)l * PROJ_LD * 1024, 1024, IN_DIM, 3);
        CONV_RUN(p.in[16] + (size_t)l * 1024 * 1024, (bf16_t*)(p.ws + OFF_WOUT) + (size_t)l * 1024 * 1024, 1024, 1024, 0);
        CONV_RUN(p.in[10] + (size_t)l * 192 * 384, (bf16_t*)(p.ws + OFF_WUQ) + (size_t)l * 384 * 192, 192, 384, 0);
        CONV_RUN(p.in[12] + (size_t)l * 128 * 512, (bf16_t*)(p.ws + OFF_WUKV) + (size_t)l * 512 * 128, 128, 512, 0);
    }
    CONV_RUN(p.in[17], (bf16_t*)(p.ws + OFF_FGU), 1024, D_FF, 1);
    CONV_RUN(p.in[18], (bf16_t*)(p.ws + OFF_FGU), 1024, D_FF, 2);
#undef CONV_F8
#define CONV_F8 1
    CONV_RUN(p.in[19], (bf16_t*)(p.ws + OFF_FD), D_FF, 1024, 0);
    for (int l = 0; l < 2; ++l) {
        uint4* z = (uint4*)((unsigned char*)((bf16_t*)(p.ws + OFF_WIN) + (size_t)l * PROJ_LD * 1024) + (size_t)1120 * 1024);
        const int n16 = (PJ_F8 - 1120) * 1024 / 16;
        for (int i = bid * NT + threadIdx.x; i < n16; i += G * NT) z[i] = make_uint4(0u, 0u, 0u, 0u);
    }
}
#undef CONV_F8
#define CONV_F8 1
__device__ __forceinline__ void ph_conv_late(const P& p, float* lds) {
    const int G = gridDim.x, bid = blockIdx.x;
    int base = 0;
    for (int e = 0; e < NEXP; ++e) {
        CONV_RUN(p.in[21] + (size_t)e * 1024 * D_FFE, (bf16_t*)(p.ws + OFF_MGU + (size_t)e * 2 * D_FFE * 1024), 1024, D_FFE, 1);
        CONV_RUN(p.in[22] + (size_t)e * 1024 * D_FFE, (bf16_t*)(p.ws + OFF_MGU + (size_t)e * 2 * D_FFE * 1024), 1024, D_FFE, 2);
        CONV_RUN(p.in[23] + (size_t)e * D_FFE * 1024, (bf16_t*)(p.ws + OFF_MD + (size_t)e * 1024 * D_FFE), D_FFE, 1024, 0);
    }
}

namespace pg8 {
#define PG8_LAS __attribute__((address_space(3)))
typedef short bf16x8 __attribute__((ext_vector_type(8)));
typedef float f32x4 __attribute__((ext_vector_type(4)));
typedef unsigned u32x4 __attribute__((ext_vector_type(4)));
typedef int i32x4v __attribute__((ext_vector_type(4)));
constexpr int BM = 256, BK = 64, HALF = 128, HTB = HALF * BK * 2, STAGE_BYTES = 8 * HTB, NXCD = 8, WGM = 8;

__host__ __device__ __forceinline__ int lds_byte(int r, int c) { const int st = (r >> 4) * 2 + (c >> 5), rr = r & 15, cc = c & 31, ob = rr * 64 + cc * 2; return st * 1024 + (ob ^ (((ob >> 9) & 1) << 5)); }
__host__ __device__ __forceinline__ void stage_rc(int b, int& R, int& C) { const int st = b / 1024, sb = b % 1024, swz = sb ^ (((sb >> 9) & 1) << 5); R = (st >> 1) * 16 + swz / 64; C = (st & 1) * 32 + (swz % 64) / 2; }
__host__ __device__ __forceinline__ int perm32(int rho) { const int n = rho >> 4, i = rho & 15; return 8 * (i >> 2) + 4 * n + (i & 3); }

struct Unit { int pm, pn, e, rl, kp, ri; };

__device__ __forceinline__ void static_order_L(int L, int nM, int nN, int& pm, int& pn) {
    const int nwg = nM * nN;
    int wgid = L; { const int q = nwg / NXCD, r = nwg % NXCD, xcd = wgid % NXCD, off = wgid / NXCD; wgid = (xcd < r ? xcd * (q + 1) : r * (q + 1) + (xcd - r) * q) + off; }
    const int nig = WGM * nN, gid = wgid / nig, fm = gid * WGM, gsz = (nM - fm) < WGM ? (nM - fm) : WGM;
    pm = fm + ((wgid % nig) % gsz); pn = (wgid % nig) / gsz;
}
__device__ __forceinline__ bool static_order(int i, int G, int c, int nM, int nN, int& pm, int& pn) {
    const int nwg = nM * nN; const long L = (long)i * G + c; if (L >= nwg) return false;
    static_order_L((int)L, nM, nN, pm, pn); return true;
}

template <bool FP8_> struct DenseSchedT {
    static constexpr bool GATHER = false, FP8 = FP8_;
    const bf16_t* A; const bf16_t* Bt; int lda, K, nM, nN, G, c; int L0 = 0, Lend = 1 << 30;
    __device__ __forceinline__ int nt() const { return K / BK; }
    __device__ __forceinline__ bool next(int i, Unit& u) const { u.e = 0; u.kp = 0; u.ri = 0; const long L = L0 + (long)i * G + c; const int nwg = nM * nN;
        if (L >= nwg || L >= Lend) return false; static_order_L((int)L, nM, nN, u.pm, u.pn); u.rl = u.pm; return true; }
    __device__ __forceinline__ const char* a_base(const Unit& u) const { return (const char*)A + (size_t)u.pm * BM * lda * 2; }
    __device__ __forceinline__ const char* b_base(const Unit& u) const { return (const char*)Bt + (size_t)u.pn * BM * K * 2; }
    __device__ __forceinline__ unsigned a_off(const Unit&, int r, int C) const { return (unsigned)(r * lda + C) * 2u; }
};
typedef DenseSchedT<false> DenseSched;
struct DenseSplitSched {
    static constexpr bool GATHER = false;
    const bf16_t* A; const bf16_t* Bt; int lda, K, pm0, nMs, nN, ways, ntp, G, c;
    __device__ __forceinline__ int nt() const { return ntp; }
    __device__ __forceinline__ bool next(int i, Unit& u) const {
        const long j = (long)i * G + c; if (j >= (long)nMs * nN * ways) return false;
        const int ui = (int)(j / ways); u.kp = (int)(j % ways) * ntp; u.ri = (int)j; u.pm = pm0 + ui / nN; u.pn = ui % nN; u.e = 0; u.rl = u.pm; return true;
    }
    __device__ __forceinline__ const char* a_base(const Unit& u) const { return (const char*)A + (size_t)u.pm * BM * lda * 2 + (size_t)u.kp * (BK * 2); }
    __device__ __forceinline__ const char* b_base(const Unit& u) const { return (const char*)Bt + (size_t)u.pn * BM * K * 2 + (size_t)u.kp * (BK * 2); }
    __device__ __forceinline__ unsigned a_off(const Unit&, int r, int C) const { return (unsigned)(r * lda + C) * 2u; }
};
template <bool GATHER_, bool FP8_ = false> struct MoeSched {
    static constexpr bool GATHER = GATHER_, FP8 = FP8_;
    const bf16_t* A; const bf16_t* Bt; int lda, K, nN, G, c; size_t bstride;
    const int* list;
    const PG8_LAS int* tab;
    int ulo, uhi, ways, ntp;
    __device__ __forceinline__ int nt() const { return ntp; }
    __device__ __forceinline__ bool next(int i, Unit& u) const {
        const int nM = __builtin_amdgcn_readfirstlane(tab[16]);
        const long j = (long)i * G + c; const int L = ulo + (int)(j / ways);
        if (L >= uhi) return false;
        u.kp = (int)(j % ways) * ntp; u.ri = (int)j;
        static_order_L(L, nM, nN, u.pm, u.pn);
        int e = 0, t0 = 0;
#pragma unroll
        for (int k = 1; k < 8; ++k) { const int tk = tab[8 + k]; if (u.pm >= tk) { e = k; t0 = tk; } }
        u.e = __builtin_amdgcn_readfirstlane(e); u.rl = u.pm - __builtin_amdgcn_readfirstlane(t0); return true;
    }
    __device__ __forceinline__ const char* a_base(const Unit& u) const { return (GATHER ? (const char*)A : (const char*)A + (size_t)u.pm * BM * lda * 2) + (size_t)u.kp * (BK * 2); }
    __device__ __forceinline__ const char* b_base(const Unit& u) const { return (const char*)(Bt + (size_t)u.e * bstride) + (size_t)u.pn * BM * K * 2 + (size_t)u.kp * (BK * 2); }
    __device__ __forceinline__ unsigned a_off(const Unit& u, int r, int C) const {
        if (!GATHER) return (unsigned)(r * lda + C) * 2u;
        const int lr = u.rl * BM + r, c1 = tab[u.e] - 1;
        const int tok = list[(size_t)u.e * 32768 + (lr < c1 ? lr : c1)];
        return (unsigned)(tok * lda + C) * 2u;
    }
};

__device__ __forceinline__ unsigned pk2(float lo, float hi) { typedef float f32x2_t __attribute__((ext_vector_type(2))); typedef __bf16 bf16x2_t __attribute__((ext_vector_type(2)));
    f32x2_t v = {lo, hi}; bf16x2_t b = __builtin_convertvector(v, bf16x2_t); return __builtin_bit_cast(unsigned, b); }

struct EpiBf16 {
    static constexpr bool PERM = true;
    bf16_t* O; int ldc;
    __device__ __forceinline__ void operator()(const f32x4 (&acc)[2][2][4][2], const Unit& u, int wr, int wc, int fr, int fq) const {
        const int row0 = u.pm * BM + wr * 64 + fr, col0 = u.pn * BM + wc * 32 + 8 * fq;
#pragma unroll
        for (int ai = 0; ai < 2; ++ai)
#pragma unroll
            for (int m = 0; m < 4; ++m) { bf16_t* rowp = O + (size_t)(row0 + ai * HALF + m * 16) * ldc + col0;
#pragma unroll
                for (int bj = 0; bj < 2; ++bj) { const f32x4 v0 = acc[ai][bj][m][0], v1 = acc[ai][bj][m][1];
                    u32x4 w; w[0] = pk2(v0[0], v0[1]); w[1] = pk2(v0[2], v0[3]); w[2] = pk2(v1[0], v1[1]); w[3] = pk2(v1[2], v1[3]);
                    *(u32x4*)(rowp + bj * HALF) = w; } }
    }
};
struct EpiBf16Norm {
    static constexpr bool PERM = true, HAS_POST = true;
    bf16_t* O; int ldc; unsigned obytes; unsigned* cnt; float sc;
    __device__ __forceinline__ void operator()(const f32x4 (&acc)[2][2][4][2], const Unit& u, int wr, int wc, int fr, int fq) const {
        const auto rsrc = __builtin_amdgcn_make_buffer_rsrc((void*)O, 0, (int)obytes, 0x00020000);
        const int row0 = u.pm * BM + wr * 64 + fr, col0 = u.pn * BM + wc * 32 + 8 * fq;
#pragma unroll
        for (int ai = 0; ai < 2; ++ai)
#pragma unroll
            for (int m = 0; m < 4; ++m) { const unsigned ro = (unsigned)((row0 + ai * HALF + m * 16) * ldc + col0) * 2u;
#pragma unroll
                for (int bj = 0; bj < 2; ++bj) { const f32x4 v0 = acc[ai][bj][m][0] * sc, v1 = acc[ai][bj][m][1] * sc;
                    u32x4 w; w[0] = pk2(v0[0], v0[1]); w[1] = pk2(v0[2], v0[3]); w[2] = pk2(v1[0], v1[1]); w[3] = pk2(v1[2], v1[3]);
                    __builtin_amdgcn_raw_buffer_store_b128(w, rsrc, ro + bj * HALF * 2, 0, 16); } }
    }
    __device__ __forceinline__ void post(const Unit& u) const {
        asm volatile("s_waitcnt vmcnt(0)" ::: "memory");
        if ((threadIdx.x & 63) == 0) __hip_atomic_fetch_add(cnt + 64 * u.pm, 1u, __ATOMIC_RELAXED, __HIP_MEMORY_SCOPE_AGENT);
    }
};
template <bool F8IN, bool F8> struct EpiSwigluT {
    static constexpr bool PERM = true;
    bf16_t* O; int ldc;
    __device__ __forceinline__ void operator()(const f32x4 (&acc)[2][2][4][2], const Unit& u, int wr, int wc, int fr, int fq) const {
        const int row0 = u.pm * BM + wr * 64 + fr, col0 = u.pn * HALF + wc * 32 + 8 * fq;
#pragma unroll
        for (int ai = 0; ai < 2; ++ai)
#pragma unroll
            for (int m = 0; m < 4; ++m) { bf16_t* rowp = O + (size_t)(row0 + ai * HALF + m * 16) * ldc + col0;
                float o[8];
                typedef float f32x2_t __attribute__((ext_vector_type(2)));
#pragma unroll
                for (int n = 0; n < 2; ++n)
#pragma unroll
                    for (int j = 0; j < 4; j += 2) {
                        f32x2_t gg = {acc[ai][0][m][n][j], acc[ai][0][m][n][j + 1]}, uu = {acc[ai][1][m][n][j], acc[ai][1][m][n][j + 1]};
                        if constexpr (F8IN) { gg = gg * (1.f / (F8_SH * F8_SW)); uu = uu * ((F8 ? F8_SA : 1.f) / (F8_SH * F8_SW)); } else if constexpr (F8) uu = uu * F8_SA;
                        const f32x2_t t = gg * (-1.4426950408889634f); f32x2_t e;
                        e[0] = __builtin_amdgcn_exp2f(t[0]); e[1] = __builtin_amdgcn_exp2f(t[1]);
                        e = e + 1.0f; f32x2_t r; r[0] = __builtin_amdgcn_rcpf(e[0]); r[1] = __builtin_amdgcn_rcpf(e[1]);
                        const f32x2_t v = (gg * uu) * r; o[n * 4 + j] = v[0]; o[n * 4 + j + 1] = v[1]; }
                if constexpr (F8) { int w0 = 0, w1 = 0;
                    w0 = __builtin_amdgcn_cvt_pk_fp8_f32(f8clamp(o[0]), f8clamp(o[1]), w0, false); w0 = __builtin_amdgcn_cvt_pk_fp8_f32(f8clamp(o[2]), f8clamp(o[3]), w0, true);
                    w1 = __builtin_amdgcn_cvt_pk_fp8_f32(f8clamp(o[4]), f8clamp(o[5]), w1, false); w1 = __builtin_amdgcn_cvt_pk_fp8_f32(f8clamp(o[6]), f8clamp(o[7]), w1, true);
                    typedef unsigned u32x2v __attribute__((ext_vector_type(2))); u32x2v w = {(unsigned)w0, (unsigned)w1};
                    *(u32x2v*)((unsigned char*)O + (size_t)(row0 + ai * HALF + m * 16) * ldc + col0) = w; }
                else { u32x4 w; w[0] = pk2(o[0], o[1]); w[1] = pk2(o[2], o[3]); w[2] = pk2(o[4], o[5]); w[3] = pk2(o[6], o[7]);
                *(u32x4*)rowp = w; } }
    }
};
typedef EpiSwigluT<false, false> EpiSwiglu;
struct EpiRes {
    static constexpr bool PERM = false;
    const float* in_lat; const float* in_ctx; float* out_lat; float* out_ctx; const float* modl; int goff;
    __device__ __forceinline__ void operator()(const f32x4 (&acc)[2][2][4][2], const Unit& u, int wr, int wc, int fr, int fq) const {
        const bool lat = u.pm < T_LAT / BM; const int r = lat ? (u.pm >> 4) : 8;
        const size_t rbase = (size_t)(lat ? u.pm : u.pm - T_LAT / BM) * BM + wr * 64 + fr;
        const float* src = (lat ? in_lat : in_ctx); float* dst = (lat ? out_lat : out_ctx);
        const int col0 = u.pn * BM + wc * 32 + 4 * fq;
        f32x4 gv[2][2];
#pragma unroll
        for (int bj = 0; bj < 2; ++bj)
#pragma unroll
            for (int n = 0; n < 2; ++n) gv[bj][n] = *(const f32x4*)(modl + r * 6144 + goff + col0 + bj * HALF + n * 16);
#pragma unroll
        for (int ai = 0; ai < 2; ++ai)
#pragma unroll
            for (int m = 0; m < 4; ++m) { const size_t ro = (rbase + ai * HALF + m * 16) * 1024 + col0;
#pragma unroll
                for (int bj = 0; bj < 2; ++bj)
#pragma unroll
                    for (int n = 0; n < 2; ++n) { const f32x4 x = *(const f32x4*)(src + ro + bj * HALF + n * 16);
                        *(f32x4*)(dst + ro + bj * HALF + n * 16) = x + gv[bj][n] * acc[ai][bj][m][n]; } }
    }
};
struct EpiBf16S {
    static constexpr bool PERM = true;
    bf16_t* O; int ldc; float sc;
    __device__ __forceinline__ void operator()(const f32x4 (&acc)[2][2][4][2], const Unit& u, int wr, int wc, int fr, int fq) const {
        const int row0 = u.pm * BM + wr * 64 + fr, col0 = u.pn * BM + wc * 32 + 8 * fq;
#pragma unroll
        for (int ai = 0; ai < 2; ++ai)
#pragma unroll
            for (int m = 0; m < 4; ++m) { bf16_t* rowp = O + (size_t)(row0 + ai * HALF + m * 16) * ldc + col0;
#pragma unroll
                for (int bj = 0; bj < 2; ++bj) { const f32x4 v0 = acc[ai][bj][m][0] * sc, v1 = acc[ai][bj][m][1] * sc;
                    u32x4 w; w[0] = pk2(v0[0], v0[1]); w[1] = pk2(v0[2], v0[3]); w[2] = pk2(v1[0], v1[1]); w[3] = pk2(v1[2], v1[3]);
                    *(u32x4*)(rowp + bj * HALF) = w; } }
    }
};
struct EpiPart {
    static constexpr bool PERM = false;
    float* PART;
    __device__ __forceinline__ void operator()(const f32x4 (&acc)[2][2][4][2], const Unit& u, int wr, int wc, int fr, int fq) const {
        float* tp = PART + (size_t)u.ri * 65536 + (wr * 64 + fr) * 256 + wc * 32 + 4 * fq;
#pragma unroll
        for (int ai = 0; ai < 2; ++ai)
#pragma unroll
            for (int m = 0; m < 4; ++m)
#pragma unroll
                for (int bj = 0; bj < 2; ++bj)
#pragma unroll
                    for (int n = 0; n < 2; ++n) *(f32x4*)(tp + (ai * HALF + m * 16) * 256 + bj * HALF + n * 16) = acc[ai][bj][m][n];
    }
};
__device__ __forceinline__ void moe_combine(bf16_t* YM, const float* PART, const PG8_LAS int* tab, int nN, float sc) {
    const int nTm = __builtin_amdgcn_readfirstlane(tab[16]), G = gridDim.x, U = nTm * nN, rem = U % G;
    if (!(rem > 0 && rem * MOE_WAYS <= G)) return;
    int tid_ = threadIdx.x; asm volatile("" : "+v"(tid_));
    const int umain = U - rem, wave = tid_ >> 6, lane = tid_ & 63;
    for (int task = blockIdx.x * 8 + wave; task < rem * 256; task += G * 8) {
        const int r = task >> 8, i = task & 255; int pm, pn; static_order_L(umain + r, nTm, nN, pm, pn);
        const float* pp = PART + (size_t)(r * MOE_WAYS) * 65536 + i * 256 + lane * 4;
        f32x4 s = *(const f32x4*)pp;
#pragma unroll
        for (int q = 1; q < MOE_WAYS; ++q) s = s + *(const f32x4*)(pp + q * 65536);
        s = s * sc;
        typedef unsigned u32x2v __attribute__((ext_vector_type(2))); u32x2v w = {pk2(s[0], s[1]), pk2(s[2], s[3])};
        *(u32x2v*)(YM + (size_t)(pm * BM + i) * 1024 + pn * BM + lane * 4) = w;
    }
}

template <class T, class = void> struct sched_fp8 { static constexpr bool value = false; };
template <class T> struct sched_fp8<T, decltype((void)T::FP8)> { static constexpr bool value = T::FP8; };
template <class T, class = void> struct epi_has_post { static constexpr bool value = false; };
template <class T> struct epi_has_post<T, decltype((void)T::HAS_POST)> { static constexpr bool value = T::HAS_POST; };
template <class Epi, class Sched>
__device__ __forceinline__ void gemm_phase(PG8_LAS unsigned char* lds, const Sched& S, const Epi& E) {
    int tid_ = threadIdx.x; asm volatile("" : "+v"(tid_));
    const int tid = tid_, wid = __builtin_amdgcn_readfirstlane(tid >> 6), lane = tid & 63, wr = wid >> 2, wc = wid & 3, fr = lane & 15, fq = lane >> 4;
    const int K = S.K, nt = S.nt();
    int RA[2], CA[2]; unsigned voffB;
    { int R, C; stage_rc(tid * 16, R, C); const int Rb = Epi::PERM ? ((R & ~31) + perm32(R & 31)) : R;
      RA[0] = R; CA[0] = C; RA[1] = R + 64; CA[1] = C; voffB = (unsigned)(Rb * K + C) * 2u; }
    const unsigned incB = (unsigned)(64 * K * 2), incA = (unsigned)(64 * S.lda * 2);
    const unsigned kstep = (unsigned)(BK * 2);
    const unsigned hstepB = (unsigned)(HALF * K * 2);
    const auto rsA = __builtin_amdgcn_make_buffer_rsrc((void*)S.A, 0, 0x7fffffff, 0x00020000), rsB = __builtin_amdgcn_make_buffer_rsrc((void*)S.Bt, 0, 0x7fffffff, 0x00020000);
    const unsigned ldsw = (unsigned)wid * 1024u;
    const int aoff = lds_byte(wr * 64 + fr, fq * 8), boff = lds_byte(wc * 32 + fr, fq * 8);
#define PG8_SA(b, h) (((b) * 2 + (h)) * HTB)
#define PG8_SB(b, h) ((4 + (b) * 2 + (h)) * HTB)
  \

#define PG8_STAGE_B(bufoff, soff) do { _Pragma("unroll") for (int _i = 0; _i < 2; ++_i) \
        __builtin_amdgcn_raw_ptr_buffer_load_lds(rsB, (PG8_LAS void*)(lds + (bufoff) + ldsw + _i * 8192), 16, voffB, (soff) + _i * incB, 0, 0); } while (0)
#define PG8_STAGE_A(bufoff, soff, h) do { _Pragma("unroll") for (int _i = 0; _i < 2; ++_i) { \
        if constexpr (Sched::GATHER) __builtin_amdgcn_raw_ptr_buffer_load_lds(rsA, (PG8_LAS void*)(lds + (bufoff) + ldsw + _i * 8192), 16, vA[h][_i], (soff), 0, 0); \
        else __builtin_amdgcn_raw_ptr_buffer_load_lds(rsA, (PG8_LAS void*)(lds + (bufoff) + ldsw + _i * 8192), 16, vA[0][0], (soff) + ((h) * 2 + _i) * incA, 0, 0); } } while (0)
#define PG8_LDA(dst, b, h) do { _Pragma("unroll") for (int m = 0; m < 4; ++m) _Pragma("unroll") for (int k = 0; k < 2; ++k) dst[m][k] = *(const PG8_LAS bf16x8*)(lds + PG8_SA(b, h) + aoff + m * 2048 + k * 1024); } while (0)
#define PG8_LDB(dst, b, h) do { _Pragma("unroll") for (int n = 0; n < 2; ++n) _Pragma("unroll") for (int k = 0; k < 2; ++k) dst[n][k] = *(const PG8_LAS bf16x8*)(lds + PG8_SB(b, h) + boff + n * 2048 + k * 1024); } while (0)
#define PG8_CAT8(x, y) __builtin_shufflevector(__builtin_bit_cast(i32x4v, x), __builtin_bit_cast(i32x4v, y), 0, 1, 2, 3, 4, 5, 6, 7)
#define PG8_MMA(ai, bj, At, Bt) do { __builtin_amdgcn_s_setprio(1); _Pragma("unroll") for (int m = 0; m < 4; ++m) _Pragma("unroll") for (int n = 0; n < 2; ++n) { \
        if constexpr (sched_fp8<Sched>::value)   \
              \
              \
            asm volatile("v_mfma_f32_16x16x128_f8f6f4 %0, %1, %2, %0" : "+v"(acc[ai][bj][m][n]) : "v"(PG8_CAT8(Bt[n][0], Bt[n][1])), "v"(PG8_CAT8(At[m][0], At[m][1]))); \
        else { _Pragma("unroll") for (int k = 0; k < 2; ++k) acc[ai][bj][m][n] = __builtin_amdgcn_mfma_f32_16x16x32_bf16(Bt[n][k], At[m][k], acc[ai][bj][m][n], 0, 0, 0); } } __builtin_amdgcn_s_setprio(0); } while (0)
#define PG8_WAIT_V(n) asm volatile("s_waitcnt vmcnt(" #n ")" ::: "memory")
#define PG8_WAIT_L(n) asm volatile("s_waitcnt lgkmcnt(" #n ")" ::: "memory")
#define PG8_BAR __builtin_amdgcn_s_barrier()
#define PG8_SCHED __builtin_amdgcn_sched_barrier(0)
#define PG8_AOFFS(dst, U) do { _Pragma("unroll") for (int _h = 0; _h < 2; ++_h) _Pragma("unroll") for (int _i = 0; _i < 2; ++_i) dst[_h][_i] = S.a_off(U, _h * HALF + RA[_i], CA[_i]); } while (0)
    Unit cur, nxt; int ui = 0;
    if (!S.next(0, cur)) return;
    f32x4 acc[2][2][4][2];
#pragma unroll
    for (int a = 0; a < 2; ++a)
#pragma unroll
        for (int b = 0; b < 2; ++b)
#pragma unroll
            for (int m = 0; m < 4; ++m)
#pragma unroll
                for (int n = 0; n < 2; ++n) acc[a][b][m][n] = (f32x4){0.f, 0.f, 0.f, 0.f};
    bf16x8 At[4][2], B0[2][2], B1[2][2];
    unsigned vA[2][2], vN[2][2];
    PG8_AOFFS(vA, cur);
    unsigned cA = (unsigned)(S.a_base(cur) - (const char*)S.A), cB = (unsigned)(S.b_base(cur) - (const char*)S.Bt);
    PG8_STAGE_B(PG8_SB(0, 0), cB); PG8_STAGE_B(PG8_SB(0, 1), cB + hstepB); PG8_STAGE_A(PG8_SA(0, 0), cA, 0); PG8_STAGE_A(PG8_SA(0, 1), cA, 1);
    if (wr == 1) PG8_BAR;
    PG8_WAIT_V(2); PG8_BAR;
    PG8_STAGE_B(PG8_SB(1, 0), cB + kstep); PG8_STAGE_A(PG8_SA(1, 0), cA + kstep, 0); PG8_STAGE_B(PG8_SB(1, 1), cB + hstepB + kstep);
    PG8_WAIT_V(6); PG8_BAR;
    for (;;) {
        const bool has_next = S.next(ui + 1, nxt);
        const unsigned nA = has_next ? (unsigned)(S.a_base(nxt) - (const char*)S.A) : cA, nB = has_next ? (unsigned)(S.b_base(nxt) - (const char*)S.Bt) : cB;
        for (int t = 0; t < nt; t += 2) {
            const bool last = (t == nt - 2);
            const bool sw = Sched::GATHER && last && has_next;
            if constexpr (Sched::GATHER) { if (sw) { PG8_AOFFS(vN, nxt); } }
            const unsigned a1 = cA + (unsigned)(t + 1) * kstep;
            const unsigned a2 = last ? nA : cA + (unsigned)(t + 2) * kstep, b2 = last ? nB : cB + (unsigned)(t + 2) * kstep;
            const unsigned a3 = a2 + kstep, b3 = b2 + kstep;
            PG8_LDB(B0, 0, 0); PG8_LDB(B1, 0, 1); PG8_SCHED; PG8_LDA(At, 0, 0); PG8_STAGE_A(PG8_SA(1, 1), a1, 1);
            if constexpr (Sched::GATHER) { if (sw) {
#pragma unroll
                for (int _h = 0; _h < 2; ++_h)
#pragma unroll
                    for (int _i = 0; _i < 2; ++_i) vA[_h][_i] = vN[_h][_i]; } }
            PG8_WAIT_V(8); PG8_WAIT_L(0); PG8_BAR; PG8_MMA(0, 0, At, B0); PG8_MMA(0, 1, At, B1); PG8_BAR; PG8_SCHED;
            PG8_LDA(At, 0, 1); PG8_STAGE_B(PG8_SB(0, 0), b2); PG8_STAGE_B(PG8_SB(0, 1), b2 + hstepB); PG8_STAGE_A(PG8_SA(0, 0), a2, 0);
            PG8_WAIT_V(8); PG8_WAIT_L(0); PG8_BAR; PG8_MMA(1, 0, At, B0); PG8_MMA(1, 1, At, B1); PG8_BAR; PG8_SCHED;
            PG8_LDB(B0, 1, 0); PG8_LDB(B1, 1, 1); PG8_SCHED; PG8_LDA(At, 1, 0); PG8_STAGE_A(PG8_SA(0, 1), a2, 1);
            PG8_WAIT_V(8); PG8_WAIT_L(0); PG8_BAR; PG8_MMA(0, 0, At, B0); PG8_MMA(0, 1, At, B1); PG8_BAR; PG8_SCHED;
            PG8_LDA(At, 1, 1); PG8_STAGE_B(PG8_SB(1, 0), b3); PG8_STAGE_B(PG8_SB(1, 1), b3 + hstepB); PG8_STAGE_A(PG8_SA(1, 0), a3, 0);
            PG8_WAIT_V(8); PG8_WAIT_L(0); PG8_BAR; PG8_MMA(1, 0, At, B0); PG8_MMA(1, 1, At, B1); PG8_BAR; PG8_SCHED;
        }
        if constexpr (sched_fp8<Sched>::value) asm volatile("s_nop 15\n\ts_nop 7" ::: "memory");
        if (wr == 0) PG8_BAR;
        { int te_ = threadIdx.x; asm volatile("" : "+v"(te_));
          E(acc, cur, wr, wc, te_ & 15, (te_ & 63) >> 4); }
        if constexpr (epi_has_post<Epi>::value) E.post(cur);
        if (!has_next) break;
#pragma unroll
        for (int a = 0; a < 2; ++a)
#pragma unroll
            for (int b = 0; b < 2; ++b)
#pragma unroll
                for (int m = 0; m < 4; ++m)
#pragma unroll
                    for (int n = 0; n < 2; ++n) acc[a][b][m][n] = (f32x4){0.f, 0.f, 0.f, 0.f};
        cur = nxt; cA = nA; cB = nB; ++ui;
        if (wr == 1) PG8_BAR;
    }
    PG8_WAIT_V(0);
    PG8_BAR;
#undef PG8_SA
#undef PG8_SB
#undef PG8_STAGE_A
#undef PG8_STAGE_B
#undef PG8_LDA
#undef PG8_LDB
#undef PG8_MMA
#undef PG8_CAT8
#undef PG8_WAIT_V
#undef PG8_WAIT_L
#undef PG8_BAR
#undef PG8_SCHED
#undef PG8_AOFFS
}
}

__device__ __forceinline__ float rope_inv(int i2, int dim) { return powf(10000.0f, -(float)i2 / (float)dim); }

__device__ __forceinline__ void ph_final(const P& p) {
    int tid_ = threadIdx.x; asm volatile("" : "+v"(tid_));
    const int wave = tid_ >> 6, lane = tid_ & 63;
    const float* gain = p.in[24];
    for (int row = blockIdx.x * 8 + wave; row < T_LAT; row += gridDim.x * 8) {
        float* src = p.out + (size_t)row * 1024;
        float4 v[4]; float ss = 0.f;
#pragma unroll
        for (int i = 0; i < 4; ++i) { v[i] = *(const float4*)(src + i * 256 + lane * 4); ss += v[i].x * v[i].x + v[i].y * v[i].y + v[i].z * v[i].z + v[i].w * v[i].w; }
        ss = wave_sum(ss);
        const float rs = rsqrtf(ss * (1.f / 1024.f) + NORM_EPS);
#pragma unroll
        for (int i = 0; i < 4; ++i) { const int col = i * 256 + lane * 4; const float4 g = *(const float4*)(gain + col);
            *(float4*)(src + col) = make_float4(v[i].x * rs * g.x, v[i].y * rs * g.y, v[i].z * rs * g.z, v[i].w * rs * g.w); }
    }
}


__device__ __forceinline__ void ph_final_moe(const P& p, const LAS int* tab0, const LAS int* tab1) {
    int tid_ = threadIdx.x; asm volatile("" : "+v"(tid_));
    const int wave = tid_ >> 6, lane = tid_ & 63;
    const float* gain = p.in[24];
    const bf16_t* YM0 = (const bf16_t*)(p.ws + OFF_YM); const bf16_t* YM1 = YM0 + (size_t)ACT_ROWS * 1024;
    const float* MODL = (const float*)(p.ws + OFF_MOD) + 9 * 6144 + 5120;
    int row = blockIdx.x * 8 + wave; const int stride = gridDim.x * 8;
    int4 ep = make_int4(0, 0, 0, 0), nep = ep; float2 ww = make_float2(0.f, 0.f), nww = ww;
    if (row < T_LAT) { const int* iv = (const int*)(p.ws + OFF_INV) + (size_t)row * 8; ep = *(const int4*)iv; ww = *(const float2*)(iv + 4); }
    for (; row < T_LAT; row += stride) {
        if (row + stride < T_LAT) { const int* iv = (const int*)(p.ws + OFF_INV) + (size_t)(row + stride) * 8; nep = *(const int4*)iv; nww = *(const float2*)(iv + 4); }
        const size_t r0 = (size_t)(tab0[8 + ep.x] * 256 + ep.y) * 1024, r1 = (size_t)(tab1[8 + ep.z] * 256 + ep.w) * 1024;
        float* src = p.out + (size_t)row * 1024;
        const float* gt = MODL + (row >> 12) * 6144;
        float4 v[4]; uint2 y0[4], y1[4]; float4 gg[4]; float ss = 0.f;
#pragma unroll
        for (int i = 0; i < 4; ++i) { const int col = i * 256 + lane * 4; v[i] = *(const float4*)(src + col); y0[i] = *(const uint2*)(YM0 + r0 + col); y1[i] = *(const uint2*)(YM1 + r1 + col); gg[i] = *(const float4*)(gt + col); }
#pragma unroll
        for (int i = 0; i < 4; ++i) {
            v[i].x += gg[i].x * (ww.x * __uint_as_float(y0[i].x << 16) + ww.y * __uint_as_float(y1[i].x << 16));
            v[i].y += gg[i].y * (ww.x * __uint_as_float(y0[i].x & 0xFFFF0000u) + ww.y * __uint_as_float(y1[i].x & 0xFFFF0000u));
            v[i].z += gg[i].z * (ww.x * __uint_as_float(y0[i].y << 16) + ww.y * __uint_as_float(y1[i].y << 16));
            v[i].w += gg[i].w * (ww.x * __uint_as_float(y0[i].y & 0xFFFF0000u) + ww.y * __uint_as_float(y1[i].y & 0xFFFF0000u));
            ss += v[i].x * v[i].x + v[i].y * v[i].y + v[i].z * v[i].z + v[i].w * v[i].w; }
        ss = wave_sum(ss);
        const float rs = rsqrtf(ss * (1.f / 1024.f) + NORM_EPS);
#pragma unroll
        for (int i = 0; i < 4; ++i) { const int col = i * 256 + lane * 4; const float4 g = *(const float4*)(gain + col);
            *(float4*)(src + col) = make_float4(v[i].x * rs * g.x, v[i].y * rs * g.y, v[i].z * rs * g.z, v[i].w * rs * g.w); }
        ep = nep; ww = nww;
    }
}
typedef short bf16x8_t __attribute__((ext_vector_type(8)));
typedef short s16x4_t __attribute__((ext_vector_type(4)));
typedef float f32x16_t __attribute__((ext_vector_type(16)));
typedef unsigned u32x4_t __attribute__((ext_vector_type(4)));
typedef float f32x4_t __attribute__((ext_vector_type(4)));
__device__ __forceinline__ s16x4_t lds_tr16(LAS const unsigned char* p) { typedef short v4i16_t __attribute__((ext_vector_type(4))); return __builtin_bit_cast(s16x4_t, __builtin_amdgcn_ds_read_tr16_b64_v4i16((LAS v4i16_t*)p)); }
__device__ __forceinline__ unsigned pkbf(float lo, float hi) { typedef float f32x2_t __attribute__((ext_vector_type(2))); typedef __bf16 bf16x2_t __attribute__((ext_vector_type(2)));
    f32x2_t v = {lo, hi}; bf16x2_t b = __builtin_convertvector(v, bf16x2_t); return __builtin_bit_cast(unsigned, b); }
__device__ __forceinline__ float max3f(float a, float b, float c) { return fmaxf(fmaxf(a, b), c); }

#define ATT_VP 192
#define ATT_THR 6.0f
template <int DQK, bool SWA, bool GQA = false>
__device__ __forceinline__ void attn_unit(LAS unsigned char* lds, const bf16_t* POST, const bf16_t* VBUF, int vld, bf16_t* MIX, int b, int q0, int qcol, int kcol, int vcol, int ocol,
                                          int band_lo, int band_hi, float sinkl2, float qscale, const float* sinkp, float sinkmul) {
    constexpr int KP = DQK * 2 + 16, NPK = DQK / 8, NKL = NPK / 4, STAGE = 128 * KP + 128 * ATT_VP, NS = DQK / 16;
    int tid_ = threadIdx.x; asm volatile("" : "+v"(tid_));
    const int tid = tid_, wid = __builtin_amdgcn_readfirstlane(tid >> 6), lane = tid & 63, r = lane & 31, h = lane >> 5;
    const int nb = (band_hi - band_lo) >> 7, ntiles = nb + 2;
    const int qw0 = GQA ? q0 + 32 * (wid & 1) : q0 + 32 * wid;
    const int qi = qw0 + r;
    const int qrow = tok_row(b, qi);
    if (GQA) { qcol += (wid >> 1) * 64; ocol += (wid >> 1) * 64; sinkl2 = sinkp[wid >> 1] * sinkmul; }
    bf16x8_t qf[NS];
    { const bf16_t* qp = POST + (size_t)qrow * POST_LD + qcol + 8 * h;
#pragma unroll
      for (int s = 0; s < NS; ++s) { float f[8]; unpack8(*(const uint4*)(qp + 16 * s), f);
          const unsigned w0 = pkbf(f[0] * qscale, f[1] * qscale), w1 = pkbf(f[2] * qscale, f[3] * qscale), w2 = pkbf(f[4] * qscale, f[5] * qscale), w3 = pkbf(f[6] * qscale, f[7] * qscale);
          qf[s] = __builtin_bit_cast(bf16x8_t, make_uint4(w0, w1, w2, w3)); } }
    f32x16_t O0, O1;
#pragma unroll
    for (int i = 0; i < 16; ++i) { O0[i] = 0.f; O1[i] = 0.f; }
    float m = SWA ? sinkl2 : -1e30f, l = 0.f;
    u32x4_t kreg[NKL], vreg[2];
    const int vrow = tid >> 3, vpc = tid & 7;
#define ATT_KS(t) ((t) < nb ? band_lo + 128 * (t) : SEQ + 128 * ((t) - nb))
#define ATT_LOAD(t) do { const int ks_ = ATT_KS(t); const bf16_t* base_ = POST + (size_t)tok_row(b, ks_) * POST_LD; \
        _Pragma("unroll") for (int i_ = 0; i_ < NKL; ++i_) { const int idx_ = tid + 512 * i_, row_ = idx_ / NPK, pc_ = idx_ % NPK; kreg[i_] = *(const u32x4_t*)(base_ + (size_t)row_ * POST_LD + kcol + pc_ * 8); } \
        const bf16_t* vbase_ = VBUF + (size_t)tok_row(b, ks_) * vld; \
        _Pragma("unroll") for (int i_ = 0; i_ < 2; ++i_) vreg[i_] = *(const u32x4_t*)(vbase_ + (size_t)(vrow + 64 * i_) * vld + vcol + vpc * 8); } while (0)
#define ATT_WRITE(buf) do { LAS unsigned char* kb_ = lds + (buf) * STAGE; LAS unsigned char* vb_ = kb_ + 128 * KP; \
        _Pragma("unroll") for (int i_ = 0; i_ < NKL; ++i_) { const int idx_ = tid + 512 * i_, row_ = idx_ / NPK, pc_ = idx_ % NPK; *(LAS u32x4_t*)(kb_ + row_ * KP + pc_ * 16) = kreg[i_]; } \
        _Pragma("unroll") for (int i_ = 0; i_ < 2; ++i_) *(LAS u32x4_t*)(vb_ + (vrow + 64 * i_) * ATT_VP + vpc * 16) = vreg[i_]; } while (0)
    const int koff = r * KP + 16 * h;
    const int voff = (4 * h + ((lane & 15) >> 2)) * ATT_VP + (16 * ((lane >> 4) & 1) + 4 * (lane & 3)) * 2;
    __syncthreads();
    ATT_LOAD(0); ATT_WRITE(0);
    __syncthreads();
    for (int t = 0; t < ntiles; ++t) {
        if (t + 1 < ntiles) ATT_LOAD(t + 1);
        LAS const unsigned char* kb = lds + (t & 1) * STAGE; LAS const unsigned char* vb = kb + 128 * KP;
        const int ks = ATT_KS(t);
        bool skip[2] = {false, false}, need_mask[2] = {false, false};
        if (SWA && t < nb) {
#pragma unroll
            for (int sub = 0; sub < 2; ++sub) { const int kb0 = ks + sub * 64, qlo = qw0, qhi = qlo + 31;
                skip[sub] = (kb0 > qhi + 128) || (kb0 + 63 < qlo - 128);
                need_mask[sub] = !((kb0 >= qhi - 128) && (kb0 + 63 <= qlo + 128)); }
        }
        f32x16_t S[4];
#pragma unroll
        for (int blk = 0; blk < 4; ++blk)
#pragma unroll
            for (int i = 0; i < 16; ++i) S[blk][i] = 0.f;
#pragma unroll
        for (int sub = 0; sub < 2; ++sub) {
            if (!skip[sub]) {
#pragma unroll
                for (int s = 0; s < NS; ++s) {
                    const bf16x8_t k0 = *(LAS const bf16x8_t*)(kb + (sub * 64) * KP + koff + 32 * s), k1 = *(LAS const bf16x8_t*)(kb + (sub * 64 + 32) * KP + koff + 32 * s);
                    S[2 * sub] = __builtin_amdgcn_mfma_f32_32x32x16_bf16(k0, qf[s], S[2 * sub], 0, 0, 0);
                    S[2 * sub + 1] = __builtin_amdgcn_mfma_f32_32x32x16_bf16(k1, qf[s], S[2 * sub + 1], 0, 0, 0);
                }
            }
        }
#pragma unroll
        for (int sub = 0; sub < 2; ++sub) {
            if (!skip[sub]) {
                const int kb0 = ks + sub * 64;
                f32x16_t& S0 = S[2 * sub]; f32x16_t& S1 = S[2 * sub + 1];
                bf16x8_t va[8];
#pragma unroll
                for (int g = 0; g < 4; ++g) { LAS const unsigned char* vp = vb + (sub * 64 + 16 * g) * ATT_VP + voff;
                    const s16x4_t l0 = lds_tr16(vp), h0 = lds_tr16(vp + 8 * ATT_VP), l1 = lds_tr16(vp + 64), h1 = lds_tr16(vp + 8 * ATT_VP + 64);
                    va[2 * g] = __builtin_shufflevector(l0, h0, 0, 1, 2, 3, 4, 5, 6, 7); va[2 * g + 1] = __builtin_shufflevector(l1, h1, 0, 1, 2, 3, 4, 5, 6, 7); }
                if (SWA && need_mask[sub]) {
#pragma unroll
                    for (int i = 0; i < 16; ++i) { const int d0 = kb0 + (i & 3) + 8 * (i >> 2) + 4 * h - qi, d1 = d0 + 32;
                        if (d0 > 128 || d0 < -128) S0[i] = -1e30f;
                        if (d1 > 128 || d1 < -128) S1[i] = -1e30f; }
                }
                float mx = max3f(S0[0], S0[1], S1[0]), mx2 = max3f(S0[2], S0[3], S1[1]);
                mx = max3f(mx, S1[2], S1[3]);
#pragma unroll
                for (int i = 4; i < 16; i += 4) { mx = max3f(mx, S0[i], S0[i + 1]); mx2 = max3f(mx2, S0[i + 2], S0[i + 3]); mx = max3f(mx, S1[i], S1[i + 1]); mx2 = max3f(mx2, S1[i + 2], S1[i + 3]); }
                mx = fmaxf(mx, mx2);
                { const auto rr_ = __builtin_amdgcn_permlane32_swap(__float_as_uint(mx), __float_as_uint(mx), false, false); mx = fmaxf(__uint_as_float(rr_[0]), __uint_as_float(rr_[1])); }
                if (__any(mx > m + ATT_THR)) {
                    const float mn = fmaxf(m, mx), al = __builtin_amdgcn_exp2f(m - mn);
                    m = mn; l *= al;
#pragma unroll
                    for (int i = 0; i < 16; ++i) { O0[i] *= al; O1[i] *= al; }
                }
                typedef float f32x2_t __attribute__((ext_vector_type(2)));
                const f32x2_t m2 = {m, m}; f32x2_t ps2 = {0.f, 0.f};
#pragma unroll
                for (int i = 0; i < 16; i += 2) {
                    f32x2_t a = (f32x2_t){S0[i], S0[i + 1]} - m2, c = (f32x2_t){S1[i], S1[i + 1]} - m2;
                    a[0] = __builtin_amdgcn_exp2f(a[0]); a[1] = __builtin_amdgcn_exp2f(a[1]); c[0] = __builtin_amdgcn_exp2f(c[0]); c[1] = __builtin_amdgcn_exp2f(c[1]);
                    S0[i] = a[0]; S0[i + 1] = a[1]; S1[i] = c[0]; S1[i + 1] = c[1];
                    ps2 += a; ps2 += c;
                }
                l += ps2[0] + ps2[1];
#pragma unroll
                for (int g = 0; g < 4; ++g) { const f32x16_t& Sx = (g >> 1) ? S1 : S0; const int o8 = 8 * (g & 1);
                    const bf16x8_t pf = __builtin_bit_cast(bf16x8_t, make_uint4(pkbf(Sx[o8 + 0], Sx[o8 + 1]), pkbf(Sx[o8 + 2], Sx[o8 + 3]), pkbf(Sx[o8 + 4], Sx[o8 + 5]), pkbf(Sx[o8 + 6], Sx[o8 + 7])));
                    O0 = __builtin_amdgcn_mfma_f32_32x32x16_bf16(va[2 * g], pf, O0, 0, 0, 0);
                    O1 = __builtin_amdgcn_mfma_f32_32x32x16_bf16(va[2 * g + 1], pf, O1, 0, 0, 0);
                }
            }
        }
        if (t + 1 < ntiles) ATT_WRITE((t + 1) & 1);
        __syncthreads();
    }
#undef ATT_LOAD
#undef ATT_KS
#undef ATT_WRITE
    float lt = l + __shfl_xor(l, 32);
    if (SWA) lt += __builtin_amdgcn_exp2f(sinkl2 - m);
    const float inv = 1.f / lt;
    bf16_t* op = MIX + (size_t)qrow * 1024 + ocol + 4 * h;
#pragma unroll
    for (int g = 0; g < 4; ++g) {
        *(uint2*)(op + 8 * g) = make_uint2(pkbf(O0[4 * g] * inv, O0[4 * g + 1] * inv), pkbf(O0[4 * g + 2] * inv, O0[4 * g + 3] * inv));
        *(uint2*)(op + 32 + 8 * g) = make_uint2(pkbf(O1[4 * g] * inv, O1[4 * g + 1] * inv), pkbf(O1[4 * g + 2] * inv, O1[4 * g + 3] * inv));
    }
}


typedef int i32x8_t __attribute__((ext_vector_type(8)));
typedef int i32x4_t __attribute__((ext_vector_type(4)));
#define A8_KP 144
__device__ __forceinline__ i32x8_t lds_frag32(LAS const unsigned char* p) { const i32x4_t lo = *(LAS const i32x4_t*)p, hi = *(LAS const i32x4_t*)(p + 16); return __builtin_shufflevector(lo, hi, 0, 1, 2, 3, 4, 5, 6, 7); }
__device__ __forceinline__ int cvt4_f8(float a, float b, float c, float d) { return __builtin_amdgcn_cvt_pk_fp8_f32(c, d, __builtin_amdgcn_cvt_pk_fp8_f32(a, b, 0, false), true); }
__device__ __forceinline__ void attn_unit_f8(LAS unsigned char* lds, const unsigned char* QK8, const unsigned char* V8T, bf16_t* MIX, int b, int q0, int head, int band_lo, int band_hi, float qscale) {
    constexpr int STAGE = 128 * A8_KP + 64 * A8_KP;
    int tid_ = threadIdx.x; asm volatile("" : "+v"(tid_));
    const int tid = tid_, wid = __builtin_amdgcn_readfirstlane(tid >> 6), lane = tid & 63, r = lane & 31, h = lane >> 5;
    const int nb = (band_hi - band_lo) >> 7, ntiles = nb + 2;
    const int qi = q0 + 32 * wid + r, qrow = tok_row(b, qi);
    i32x8_t qf[2];
    { const unsigned char* qp = QK8 + (size_t)qrow * 1024 + head * 128 + 32 * h;
#pragma unroll
      for (int s = 0; s < 2; ++s) { const i32x4_t lo = *(const i32x4_t*)(qp + 64 * s), hi = *(const i32x4_t*)(qp + 64 * s + 16); qf[s] = __builtin_shufflevector(lo, hi, 0, 1, 2, 3, 4, 5, 6, 7); } }
    f32x16_t O0, O1;
#pragma unroll
    for (int i = 0; i < 16; ++i) { O0[i] = 0.f; O1[i] = 0.f; }
    float m = -1e30f;
    f32x16_t Ls;
#pragma unroll
    for (int i = 0; i < 16; ++i) Ls[i] = 0.f;
    const i32x8_t ones8 = {0x38383838, 0x38383838, 0x38383838, 0x38383838, 0x38383838, 0x38383838, 0x38383838, 0x38383838};
    u32x4_t kreg[2], vreg;
    const unsigned char* vbase = V8T + (size_t)((b * 4 + head) * 64 + (tid >> 3)) * 4352 + (tid & 7) * 16;
#define A8_KS(t) ((t) < nb ? band_lo + 128 * (t) : SEQ + 128 * ((t) - nb))
#define A8_LOAD(t) do { const int ks_ = A8_KS(t); const unsigned char* base_ = QK8 + (size_t)tok_row(b, ks_) * 1024 + 512 + head * 128; \
        _Pragma("unroll") for (int i_ = 0; i_ < 2; ++i_) { const int idx_ = tid + 512 * i_; kreg[i_] = *(const u32x4_t*)(base_ + (size_t)(idx_ >> 3) * 1024 + (idx_ & 7) * 16); } \
        vreg = *(const u32x4_t*)(vbase + ks_); } while (0)
#define A8_WRITE(buf) do { LAS unsigned char* kb_ = lds + (buf) * STAGE; \
        _Pragma("unroll") for (int i_ = 0; i_ < 2; ++i_) { const int idx_ = tid + 512 * i_; *(LAS u32x4_t*)(kb_ + (idx_ >> 3) * A8_KP + (idx_ & 7) * 16) = kreg[i_]; } \
        *(LAS u32x4_t*)(kb_ + 128 * A8_KP + (tid >> 3) * A8_KP + (tid & 7) * 16) = vreg; } while (0)
    const int foff = r * A8_KP + 32 * h;
    __syncthreads();
    A8_LOAD(0); A8_WRITE(0);
    __syncthreads();
    typedef float f32x2_t __attribute__((ext_vector_type(2)));
    const f32x2_t qs2 = {qscale, qscale};
    for (int t = 0; t < ntiles; ++t) {
        if (t + 1 < ntiles) A8_LOAD(t + 1);
        LAS const unsigned char* kb = lds + (t & 1) * STAGE; LAS const unsigned char* vb = kb + 128 * A8_KP;
        f32x16_t S[4];
#pragma unroll
        for (int blk = 0; blk < 4; ++blk)
#pragma unroll
            for (int i = 0; i < 16; ++i) S[blk][i] = 0.f;
#pragma unroll
        for (int blk = 0; blk < 4; ++blk)
#pragma unroll
            for (int s = 0; s < 2; ++s) S[blk] = __builtin_amdgcn_mfma_scale_f32_32x32x64_f8f6f4(lds_frag32(kb + (blk * 32) * A8_KP + foff + 64 * s), qf[s], S[blk], 0, 0, 0, 0, 0, 0);
#pragma unroll
        for (int sub = 0; sub < 2; ++sub) {
            f32x16_t& S0 = S[2 * sub]; f32x16_t& S1 = S[2 * sub + 1];
            const i32x8_t va0 = lds_frag32(vb + foff + 64 * sub), va1 = lds_frag32(vb + 32 * A8_KP + foff + 64 * sub);
            float mx = max3f(S0[0], S0[1], S1[0]), mx2 = max3f(S0[2], S0[3], S1[1]);
            mx = max3f(mx, S1[2], S1[3]);
#pragma unroll
            for (int i = 4; i < 16; i += 4) { mx = max3f(mx, S0[i], S0[i + 1]); mx2 = max3f(mx2, S0[i + 2], S0[i + 3]); mx = max3f(mx, S1[i], S1[i + 1]); mx2 = max3f(mx2, S1[i + 2], S1[i + 3]); }
            mx = fmaxf(mx, mx2);
            { const auto rr_ = __builtin_amdgcn_permlane32_swap(__float_as_uint(mx), __float_as_uint(mx), false, false); mx = fmaxf(__uint_as_float(rr_[0]), __uint_as_float(rr_[1])); }
            mx *= qscale;
            if (__any(mx > m + ATT_THR)) {
                const float mn = fmaxf(m, mx), al = __builtin_amdgcn_exp2f(m - mn);
                m = mn; Ls[0] *= al;
#pragma unroll
                for (int i = 0; i < 16; ++i) { O0[i] *= al; O1[i] *= al; }
            }
            const f32x2_t m2 = {-m, -m};
#pragma unroll
            for (int i = 0; i < 16; i += 2) {
                f32x2_t a = (f32x2_t){S0[i], S0[i + 1]} * qs2 + m2, c = (f32x2_t){S1[i], S1[i + 1]} * qs2 + m2;
                a[0] = __builtin_amdgcn_exp2f(a[0]); a[1] = __builtin_amdgcn_exp2f(a[1]); c[0] = __builtin_amdgcn_exp2f(c[0]); c[1] = __builtin_amdgcn_exp2f(c[1]);
                S0[i] = a[0]; S0[i + 1] = a[1]; S1[i] = c[0]; S1[i + 1] = c[1];
            }
            i32x8_t pf;
#pragma unroll
            for (int w = 0; w < 4; ++w) { pf[w] = cvt4_f8(S0[4 * w], S0[4 * w + 1], S0[4 * w + 2], S0[4 * w + 3]); pf[4 + w] = cvt4_f8(S1[4 * w], S1[4 * w + 1], S1[4 * w + 2], S1[4 * w + 3]); }
            O0 = __builtin_amdgcn_mfma_scale_f32_32x32x64_f8f6f4(va0, pf, O0, 0, 0, 0, 0, 0, 0);
            O1 = __builtin_amdgcn_mfma_scale_f32_32x32x64_f8f6f4(va1, pf, O1, 0, 0, 0, 0, 0, 0);
            Ls = __builtin_amdgcn_mfma_scale_f32_32x32x64_f8f6f4(ones8, pf, Ls, 0, 0, 0, 0, 0, 0);
        }
        if (t + 1 < ntiles) A8_WRITE((t + 1) & 1);
        __syncthreads();
    }
#undef A8_LOAD
#undef A8_KS
#undef A8_WRITE
    const float inv = 1.f / Ls[0];
    bf16_t* op = MIX + (size_t)qrow * 1024 + head * 64 + 4 * h;
#pragma unroll
    for (int g = 0; g < 4; ++g) {
        *(uint2*)(op + 8 * g) = make_uint2(pkbf(O0[4 * g] * inv, O0[4 * g + 1] * inv), pkbf(O0[4 * g + 2] * inv, O0[4 * g + 3] * inv));
        *(uint2*)(op + 32 + 8 * g) = make_uint2(pkbf(O1[4 * g] * inv, O1[4 * g + 1] * inv), pkbf(O1[4 * g + 2] * inv, O1[4 * g + 3] * inv));
    }
}
__device__ __forceinline__ float log2_sigmoid(float x) { return log2f(1.f / (1.f + expf(-x))); }

__device__ __forceinline__ void ph_ret_T(const P& p, int layer, LAS unsigned char* lds) {
    const bf16_t* POST = (const bf16_t*)(p.ws + OFF_POST); const bf16_t* PROJB = (const bf16_t*)(p.ws + OFF_PROJ);
    bf16_t* TT = (bf16_t*)(p.ws + OFF_TT);
    int tid_ = threadIdx.x; asm volatile("" : "+v"(tid_));
    const int tid = tid_, wid = __builtin_amdgcn_readfirstlane(tid >> 6), lane = tid & 63, h2 = lane >> 5;
    const int G = gridDim.x, bid = blockIdx.x;
    const int trq = (lane & 15) >> 2, trc = (16 * ((lane >> 4) & 1) + 4 * (lane & 3)) * 2;
    for (int u = bid; u < BATCH * 34 * 2; u += G) {
        const int hp = u & 1, c = (u >> 1) % 34, b = u / 68;
        const int row0 = c < 32 ? b * SEQ + c * 128 : T_LAT + b * CTXL + (c - 32) * 128;
        __syncthreads();
#pragma unroll
        for (int i = 0; i < 8; ++i) {
            const int idx = tid + 512 * i, arr = idx >> 10, rem = idx & 1023, row = rem >> 3, pc = rem & 7;
            const u32x4_t v = arr < 2 ? *(const u32x4_t*)(POST + (size_t)(row0 + row) * POST_LD + PC_RK + (2 * hp + (arr & 1)) * 64 + pc * 8)
                                      : *(const u32x4_t*)(PROJB + (size_t)(row0 + row) * PROJ_LD + PJ_RV + (2 * hp + (arr & 1)) * 64 + pc * 8);
            *(LAS u32x4_t*)(lds + arr * 24576 + row * 192 + pc * 16) = v;
        }
        __syncthreads();
        const int hh = wid >> 2, head = 2 * hp + hh, dir = (wid >> 1) & 1, dvb = wid & 1;
        const float lg = log2_sigmoid(dir ? p.in[15][layer * 4 + head] : p.in[14][layer * 4 + head]);
        f32x16_t acc0, acc1;
#pragma unroll
        for (int i = 0; i < 16; ++i) { acc0[i] = 0.f; acc1[i] = 0.f; }
        LAS const unsigned char* kt = lds + hh * 24576; LAS const unsigned char* vt = lds + (2 + hh) * 24576;
#pragma unroll
        for (int s = 0; s < 8; ++s) {
            const int kr = 16 * s + 8 * h2;
            LAS const unsigned char* vp = vt + (kr + trq) * 192 + dvb * 64 + trc;
            const s16x4_t vlo = lds_tr16(vp), vhi = lds_tr16(vp + 4 * 192);
            const bf16x8_t a = {vlo[0], vlo[1], vlo[2], vlo[3], vhi[0], vhi[1], vhi[2], vhi[3]};
            float w[8];
#pragma unroll
            for (int j = 0; j < 8; ++j) w[j] = __builtin_amdgcn_exp2f(lg * (float)(dir ? (kr + j) : (127 - kr - j)));
#pragma unroll
            for (int dkb = 0; dkb < 2; ++dkb) {
                LAS const unsigned char* kp = kt + (kr + trq) * 192 + dkb * 64 + trc;
                const s16x4_t klo = lds_tr16(kp), khi = lds_tr16(kp + 4 * 192);
                float f[8];
#pragma unroll
                for (int j = 0; j < 4; ++j) { f[j] = bf2f((bf16_t)klo[j]) * w[j]; f[4 + j] = bf2f((bf16_t)khi[j]) * w[4 + j]; }
                const bf16x8_t bb = __builtin_bit_cast(bf16x8_t, make_uint4(pkbf(f[0], f[1]), pkbf(f[2], f[3]), pkbf(f[4], f[5]), pkbf(f[6], f[7])));
                if (dkb == 0) acc0 = __builtin_amdgcn_mfma_f32_32x32x16_bf16(a, bb, acc0, 0, 0, 0);
                else acc1 = __builtin_amdgcn_mfma_f32_32x32x16_bf16(a, bb, acc1, 0, 0, 0);
            }
        }
        bf16_t* tp = TT + ((((size_t)(b * 4 + head) * 34 + c) * 2 + dir) * 4096) + (lane & 31);
#pragma unroll
        for (int i = 0; i < 16; ++i) { const int dv = 32 * dvb + (i & 3) + 8 * (i >> 2) + 4 * h2; tp[dv * 64] = f2bf(acc0[i]); tp[dv * 64 + 32] = f2bf(acc1[i]); }
    }
}

__device__ __forceinline__ void ret_unit(LAS unsigned char* lds, const P& p, int layer, int b, int c, int hp) {
    const bf16_t* POST = (const bf16_t*)(p.ws + OFF_POST); const bf16_t* PROJB = (const bf16_t*)(p.ws + OFF_PROJ);
    bf16_t* MIX = (bf16_t*)(p.ws + OFF_H);
    const bf16_t* TT = (const bf16_t*)(p.ws + OFF_TT);
    int tid_ = threadIdx.x; asm volatile("" : "+v"(tid_));
    const int tid = tid_, wid = __builtin_amdgcn_readfirstlane(tid >> 6), lane = tid & 63, r = lane & 31, h2 = lane >> 5;
    const bool isctx = c >= 32;
    const int row0 = !isctx ? b * SEQ + c * 128 : T_LAT + b * CTXL + (c - 32) * 128;
    constexpr int L_ST = 0, L_K = 36864, L_V = 73728;
    __syncthreads();
#pragma unroll
    for (int i = 0; i < 8; ++i) {
        const int idx = tid + 512 * i, arr = idx >> 10, rem = idx & 1023, row = rem >> 3, pc = rem & 7;
        const u32x4_t v = arr < 2 ? *(const u32x4_t*)(POST + (size_t)(row0 + row) * POST_LD + PC_RK + (2 * hp + (arr & 1)) * 64 + pc * 8)
                                      : *(const u32x4_t*)(PROJB + (size_t)(row0 + row) * PROJ_LD + PJ_RV + (2 * hp + (arr & 1)) * 64 + pc * 8);
        if (arr < 2) *(LAS u32x4_t*)(lds + L_K + (arr & 1) * 18432 + row * 144 + pc * 16) = v;
        else *(LAS u32x4_t*)(lds + L_V + (arr & 1) * 24576 + row * 192 + pc * 16) = v;
    }
    {
        const int hd = tid >> 7, hh = hd >> 1, dir = hd & 1, head = 2 * hp + hh;
        const float g128 = 128.f * log2_sigmoid(dir ? p.in[15][layer * 4 + head] : p.in[14][layer * 4 + head]);
        const bf16_t* tb = TT + (size_t)(b * 4 + head) * 34 * 2 * 4096 + dir * 4096 + (tid & 127) * 4;
        f32x4_t acc[8];
#pragma unroll
        for (int i = 0; i < 8; ++i) acc[i] = (f32x4_t){0.f, 0.f, 0.f, 0.f};
        int v0, v1;
        if (!isctx) { if (dir == 0) { v0 = -2; v1 = c - 1; } else { v0 = c + 1; v1 = 33; } }
        else { const int cc = c - 32; if (dir == 0) { v0 = -2; v1 = cc - 3; } else { v0 = 33 + cc; v1 = 33; } }
        for (int v = v0; v <= v1; ++v) {
            const int idxT = v < 0 ? 34 + v : v;
            const float coef = __builtin_amdgcn_exp2f(g128 * (float)(dir == 0 ? (v1 - v) : (v - v0)));
            const bf16_t* tp = tb + (size_t)idxT * 2 * 4096;
#pragma unroll
            for (int i = 0; i < 8; ++i) { const uint2 r_ = *(const uint2*)(tp + 512 * i);
                const f32x4_t x = {__uint_as_float(r_.x << 16), __uint_as_float(r_.x & 0xFFFF0000u), __uint_as_float(r_.y << 16), __uint_as_float(r_.y & 0xFFFF0000u)}; acc[i] += x * coef; }
        }
#pragma unroll
        for (int i = 0; i < 8; ++i) { const int e = (tid & 127) * 4 + 512 * i, dv = e >> 6, dk = e & 63;
            typedef unsigned u32x2_t __attribute__((ext_vector_type(2))); *(LAS u32x2_t*)(lds + L_ST + hd * 9216 + dv * 144 + dk * 2) = (u32x2_t){pkbf(acc[i][0], acc[i][1]), pkbf(acc[i][2], acc[i][3])}; }
    }
    __syncthreads();
    const int hh = wid >> 2, head = 2 * hp + hh, qb = wid & 3, qi = 32 * qb + r;
    const int qrow = row0 + qi;
    const float lgf = log2_sigmoid(p.in[14][layer * 4 + head]), lgb = log2_sigmoid(p.in[15][layer * 4 + head]);
    bf16x8_t qf[4];
    { const bf16_t* qp = POST + (size_t)qrow * POST_LD + PC_RQ + head * 64 + 8 * h2;
#pragma unroll
      for (int s = 0; s < 4; ++s) qf[s] = *(const bf16x8_t*)(qp + 16 * s); }
    f32x16_t O0, O1;
#pragma unroll
    for (int i = 0; i < 16; ++i) { O0[i] = 0.f; O1[i] = 0.f; }
    LAS const unsigned char* kt = lds + L_K + hh * 18432; LAS const unsigned char* vt = lds + L_V + hh * 24576;
    const int voff = (4 * h2 + ((lane & 15) >> 2)) * 192 + (16 * ((lane >> 4) & 1) + 4 * (lane & 3)) * 2;
#pragma unroll
    for (int blk = 0; blk < 4; ++blk) {
        f32x16_t S;
#pragma unroll
        for (int i = 0; i < 16; ++i) S[i] = 0.f;
#pragma unroll
        for (int s = 0; s < 4; ++s) { const bf16x8_t a = *(LAS const bf16x8_t*)(kt + (32 * blk + r) * 144 + 32 * s + 16 * h2); S = __builtin_amdgcn_mfma_f32_32x32x16_bf16(a, qf[s], S, 0, 0, 0); }
#pragma unroll
        for (int i = 0; i < 16; ++i) { const int d = qi - (32 * blk + (i & 3) + 8 * (i >> 2) + 4 * h2);
            const float w = d > 0 ? __builtin_amdgcn_exp2f(lgf * (float)d) : (d == 0 ? 2.f : __builtin_amdgcn_exp2f(lgb * (float)(-d)));
            S[i] *= w; }
#pragma unroll
        for (int s2 = 0; s2 < 2; ++s2) {
            const bf16x8_t pf = __builtin_bit_cast(bf16x8_t, make_uint4(pkbf(S[8 * s2 + 0], S[8 * s2 + 1]), pkbf(S[8 * s2 + 2], S[8 * s2 + 3]), pkbf(S[8 * s2 + 4], S[8 * s2 + 5]), pkbf(S[8 * s2 + 6], S[8 * s2 + 7])));
            LAS const unsigned char* vp = vt + (32 * blk + 16 * s2) * 192 + voff;
            const s16x4_t lo0 = lds_tr16(vp), hi0 = lds_tr16(vp + 8 * 192), lo1 = lds_tr16(vp + 64), hi1 = lds_tr16(vp + 8 * 192 + 64);
            const bf16x8_t a0 = {lo0[0], lo0[1], lo0[2], lo0[3], hi0[0], hi0[1], hi0[2], hi0[3]};
            const bf16x8_t a1 = {lo1[0], lo1[1], lo1[2], lo1[3], hi1[0], hi1[1], hi1[2], hi1[3]};
            O0 = __builtin_amdgcn_mfma_f32_32x32x16_bf16(a0, pf, O0, 0, 0, 0);
            O1 = __builtin_amdgcn_mfma_f32_32x32x16_bf16(a1, pf, O1, 0, 0, 0);
        }
    }
#pragma unroll
    for (int dir = 0; dir < 2; ++dir) {
        f32x16_t T0, T1;
#pragma unroll
        for (int i = 0; i < 16; ++i) { T0[i] = 0.f; T1[i] = 0.f; }
        LAS const unsigned char* st = lds + L_ST + (hh * 2 + dir) * 9216;
#pragma unroll
        for (int s = 0; s < 4; ++s) {
            const bf16x8_t a0 = *(LAS const bf16x8_t*)(st + r * 144 + 32 * s + 16 * h2), a1 = *(LAS const bf16x8_t*)(st + (32 + r) * 144 + 32 * s + 16 * h2);
            T0 = __builtin_amdgcn_mfma_f32_32x32x16_bf16(a0, qf[s], T0, 0, 0, 0);
            T1 = __builtin_amdgcn_mfma_f32_32x32x16_bf16(a1, qf[s], T1, 0, 0, 0);
        }
        const float coef = dir == 0 ? __builtin_amdgcn_exp2f(lgf * (float)(qi + 1)) : __builtin_amdgcn_exp2f(lgb * (float)(128 - qi));
#pragma unroll
        for (int i = 0; i < 16; ++i) { O0[i] += coef * T0[i]; O1[i] += coef * T1[i]; }
    }
    float ss = 0.f;
#pragma unroll
    for (int i = 0; i < 16; ++i) ss += O0[i] * O0[i] + O1[i] * O1[i];
    ss += __shfl_xor(ss, 32);
    const float rs = rsqrtf(ss * (1.f / 64.f) + NORM_EPS);
    const bf16_t* gp = PROJB + (size_t)qrow * PROJ_LD + PJ_RG + head * 64 + 4 * h2;
    bf16_t* op = MIX + (size_t)qrow * 1024 + 768 + head * 64 + 4 * h2;
#pragma unroll
    for (int g = 0; g < 4; ++g) {
        const uint2 g0 = *(const uint2*)(gp + 8 * g), g1 = *(const uint2*)(gp + 32 + 8 * g);
        float gv[8] = {__uint_as_float(g0.x << 16), __uint_as_float(g0.x & 0xFFFF0000u), __uint_as_float(g0.y << 16), __uint_as_float(g0.y & 0xFFFF0000u),
                       __uint_as_float(g1.x << 16), __uint_as_float(g1.x & 0xFFFF0000u), __uint_as_float(g1.y << 16), __uint_as_float(g1.y & 0xFFFF0000u)};
        float o[8];
#pragma unroll
        for (int j = 0; j < 4; ++j) { o[j] = O0[4 * g + j] * rs * silu_f(gv[j]); o[4 + j] = O1[4 * g + j] * rs * silu_f(gv[4 + j]); }
        *(uint2*)(op + 8 * g) = make_uint2(pkbf(o[0], o[1]), pkbf(o[2], o[3]));
        *(uint2*)(op + 32 + 8 * g) = make_uint2(pkbf(o[4], o[5]), pkbf(o[6], o[7]));
    }
}

__device__ __forceinline__ void ph_mixer_mfma(const P& p, int layer, bool ctxq, LAS unsigned char* lds) {
    const bf16_t* POST = (const bf16_t*)(p.ws + OFF_POST); const bf16_t* PROJB = (const bf16_t*)(p.ws + OFF_PROJ);
    bf16_t* MIX = (bf16_t*)(p.ws + OFF_H);
    const int G = gridDim.x, bid = blockIdx.x;
    const float L2E = 1.4426950408889634f;
    const int n_mla = BATCH * 4 * 16, n_swa = BATCH * 8 * 16, n_mlac = ctxq ? BATCH * 4 : 0, n_swac = ctxq ? BATCH * 8 : 0;
    const int n_ret = BATCH * 32 * 2, n_retc = ctxq ? BATCH * 2 * 2 : 0;
    const int total = n_mla + n_swa + n_mlac + n_swac + n_ret + n_retc;
    const int nmine = (total - bid + G - 1) / G;
    for (int k = 0; k < nmine; ++k) { const int u = bid + (((bid >> 3) & 1) ? (nmine - 1 - k) : k) * G;
        if (u < n_mla) {
            const int qb = u & 15, h = (u >> 4) & 3, b = u >> 6;
            attn_unit_f8(lds, p.ws + OFF_QK8, p.ws + OFF_V8T, MIX, b, qb * 256, h, 0, SEQ, 0.10206207261596575f * L2E);
        } else if (u < n_mla + n_swa) {
            const int v = u - n_mla, qb = v & 63, kvh = (v >> 6) & 1, b = v >> 7;
            const int q0 = qb * 64; int lo = (q0 - 128) & ~127; lo = lo < 0 ? 0 : lo; int hi = (q0 + 192 + 127) & ~127; hi = hi > SEQ ? SEQ : hi;
            attn_unit<64, true, true>(lds, POST, PROJB, PROJ_LD, MIX, b, q0, PC_QB + kvh * 256, PC_KB + kvh * 64, 992 + kvh * 64, 256 + kvh * 256, lo, hi, 0.f, 0.125f * L2E, p.in[13] + layer * 8 + kvh * 4, L2E);
        } else if (u < n_mla + n_swa + n_mlac) {
            const int v = u - n_mla - n_swa, h = v & 3, b = v >> 2;
            attn_unit_f8(lds, p.ws + OFF_QK8, p.ws + OFF_V8T, MIX, b, SEQ, h, 0, 0, 0.10206207261596575f * L2E);
        } else if (u < n_mla + n_swa + n_mlac + n_swac) {
            const int v = u - n_mla - n_swa - n_mlac, qb = v & 3, kvh = (v >> 2) & 1, b = v >> 3;
            attn_unit<64, true, true>(lds, POST, PROJB, PROJ_LD, MIX, b, SEQ + qb * 64, PC_QB + kvh * 256, PC_KB + kvh * 64, 992 + kvh * 64, 256 + kvh * 256, 0, 0, 0.f, 0.125f * L2E, p.in[13] + layer * 8 + kvh * 4, L2E);
        } else if (u < n_mla + n_swa + n_mlac + n_swac + n_ret) {
            const int v = u - n_mla - n_swa - n_mlac - n_swac;
            ret_unit(lds, p, layer, v >> 6, (v >> 1) & 31, v & 1);
        } else {
            const int v = u - n_mla - n_swa - n_mlac - n_swac - n_ret;
            ret_unit(lds, p, layer, v >> 2, 32 + ((v >> 1) & 1), v & 1);
        }
    }
}

__device__ __forceinline__ void ph_tables(const P& p) {
    float2* tr = (float2*)(p.ws + OFF_TAB); float2* t32 = tr + 4096 * 32; float2* t16 = t32 + 64 * 16;
    const int n = 4096 * 32 + 64 * 16 + 64 * 8;
    for (int i = blockIdx.x * NT + threadIdx.x; i < n; i += gridDim.x * NT) {
        float ang;
        if (i < 4096 * 32) ang = (float)(i >> 5) * rope_inv(2 * (i & 31), 64);
        else if (i < 4096 * 32 + 64 * 16) { const int j = i - 4096 * 32; ang = (float)(j >> 4) * rope_inv(2 * (j & 15), 32); }
        else { const int j = i - 4096 * 32 - 64 * 16; ang = (float)(j >> 3) * rope_inv(2 * (j & 7), 16); }
        tr[i] = make_float2(cosf(ang), sinf(ang));
    }
}

__device__ __forceinline__ void ph_prep2(const P& p, int layer, LAS unsigned char* lds) {
    const bf16_t* PROJ = (const bf16_t*)(p.ws + OFF_PROJ);
    bf16_t* POST = (bf16_t*)(p.ws + OFF_POST);
    unsigned char* QK8 = p.ws + OFF_QK8; unsigned char* V8T = p.ws + OFF_V8T;
#define CVT4_F8(a_, b_, c_, d_) __builtin_amdgcn_cvt_pk_fp8_f32(f8clamp(c_), f8clamp(d_), __builtin_amdgcn_cvt_pk_fp8_f32(f8clamp(a_), f8clamp(b_), 0, false), true)
    const bf16_t* WUQ = (const bf16_t*)(p.ws + OFF_WUQ) + (size_t)layer * 384 * 192;
    const bf16_t* WUKV = (const bf16_t*)(p.ws + OFF_WUKV) + (size_t)layer * 512 * 128;
    const float* qn = p.in[9] + layer * 192; const float* kvn = p.in[11] + layer * 128;
    const float2* tab_ret = (const float2*)(p.ws + OFF_TAB); const float2* tab32 = tab_ret + 4096 * 32; const float2* tab16 = tab32 + 64 * 16;
    int tid_ = threadIdx.x; asm volatile("" : "+v"(tid_));
    const int tid = tid_, wid = __builtin_amdgcn_readfirstlane(tid >> 6), lane = tid & 63, fr = lane & 15, fq = lane >> 4;
    constexpr int QP = 400, KVP = 272, L_CQ = 0, L_CKV = 32 * QP;
    constexpr int SQP = 1040, L_SQ = L_CKV + 32 * KVP, L_SV = L_SQ + 32 * SQP;
#define PREP_LOADS(RA, RB, RC, RK, P1, P2, UNIT) do { const int R0_ = (UNIT) * 32; int tidA = tid; asm volatile("" : "+v"(tidA)); const int tk_ = tidA >> 4, sub_ = tidA & 15; \
        { const bf16_t* pr_ = PROJ + (size_t)(R0_ + tk_) * PROJ_LD; RA = *(const uint2*)(pr_ + sub_ * 12); RB = *(const uint2*)(pr_ + sub_ * 12 + 4); RC = *(const uint2*)(pr_ + sub_ * 12 + 8); RK = *(const u32x4_t*)(pr_ + 192 + sub_ * 8); } \
        _Pragma("unroll") for (int it_ = 0; it_ < 5; ++it_) { const int w_ = it_ * NT + tidA; \
            if (w_ < 32 * 74) { const int tok_ = w_ / 74, task_ = w_ % 74; int src_, dist_; \
                if (task_ < 40) { const int hd_ = task_ >> 2, half_ = (task_ >> 1) & 1, cp_ = task_ & 1; src_ = (task_ < 32 ? 352 : 864 - 8 * 64) + hd_ * 64 + half_ * 32 + cp_ * 8; dist_ = 16; } \
                else if (task_ < 72) { const int q_ = task_ - 40, hd_ = q_ >> 2, cp_ = q_ & 3; src_ = (hd_ < 4 ? PJ_RQ + hd_ * 64 : PJ_RK + (hd_ - 4) * 64) + cp_ * 8; dist_ = 32; } \
                else { src_ = 320 + (task_ - 72) * 16; dist_ = 8; } \
                const bf16_t* pr_ = PROJ + (size_t)(R0_ + tok_) * PROJ_LD + src_; P1[it_] = *(const u32x4_t*)pr_; P2[it_] = *(const u32x4_t*)(pr_ + dist_); } \
            else { P1[it_] = (u32x4_t){0u, 0u, 0u, 0u}; P2[it_] = P1[it_]; } } } while (0)
    uint2 ra, rb, rc, na_, nb_, nc_; u32x4_t rk, nk_; u32x4_t p1[5], p2[5], n1[5], n2[5];
    if ((int)blockIdx.x < T_ALL / 32) PREP_LOADS(ra, rb, rc, rk, p1, p2, (int)blockIdx.x);
    for (int u = blockIdx.x; u < T_ALL / 32; u += gridDim.x) {
        const int R0 = u * 32; const bool isctx = R0 >= T_LAT;
        const int t0 = isctx ? (R0 - T_LAT) % CTXL : R0 % SEQ;
        const int tk = tid >> 4, sub = tid & 15;
        const bool has_next = u + (int)gridDim.x < T_ALL / 32;
        if (has_next) PREP_LOADS(na_, nb_, nc_, nk_, n1, n2, u + (int)gridDim.x);
        __syncthreads();
        *(LAS u32x4_t*)(lds + L_SQ + tk * SQP + (sub >> 3) * 512 + ((sub >> 1) & 3) * 128 + 96 + (sub & 1) * 16) = (u32x4_t){0u, 0u, 0u, 0u};
        {
            float c[12], k[8];
            c[0] = __uint_as_float(ra.x << 16); c[1] = __uint_as_float(ra.x & 0xFFFF0000u); c[2] = __uint_as_float(ra.y << 16); c[3] = __uint_as_float(ra.y & 0xFFFF0000u);
            c[4] = __uint_as_float(rb.x << 16); c[5] = __uint_as_float(rb.x & 0xFFFF0000u); c[6] = __uint_as_float(rb.y << 16); c[7] = __uint_as_float(rb.y & 0xFFFF0000u);
            c[8] = __uint_as_float(rc.x << 16); c[9] = __uint_as_float(rc.x & 0xFFFF0000u); c[10] = __uint_as_float(rc.y << 16); c[11] = __uint_as_float(rc.y & 0xFFFF0000u);
            unpack8(make_uint4(rk[0], rk[1], rk[2], rk[3]), k);
            float s1 = 0.f, s2 = 0.f;
#pragma unroll
            for (int i = 0; i < 12; ++i) s1 += c[i] * c[i];
#pragma unroll
            for (int i = 0; i < 8; ++i) s2 += k[i] * k[i];
#pragma unroll
            for (int o = 1; o < 16; o <<= 1) { s1 += __shfl_xor(s1, o); s2 += __shfl_xor(s2, o); }
            const float r1 = rsqrtf(s1 * (1.f / 192.f) + NORM_EPS), r2 = rsqrtf(s2 * (1.f / 128.f) + NORM_EPS);
            typedef unsigned u32x2_t __attribute__((ext_vector_type(2)));
#pragma unroll
            for (int i = 0; i < 3; ++i) { const int e = sub * 12 + 4 * i;
                *(LAS u32x2_t*)(lds + L_CQ + tk * QP + e * 2) = (u32x2_t){pkbf(c[4 * i] * r1 * qn[e], c[4 * i + 1] * r1 * qn[e + 1]), pkbf(c[4 * i + 2] * r1 * qn[e + 2], c[4 * i + 3] * r1 * qn[e + 3])}; }
            { const int e = sub * 8;
              *(LAS u32x4_t*)(lds + L_CKV + tk * KVP + e * 2) = (u32x4_t){pkbf(k[0] * r2 * kvn[e], k[1] * r2 * kvn[e + 1]), pkbf(k[2] * r2 * kvn[e + 2], k[3] * r2 * kvn[e + 3]),
                                                                        pkbf(k[4] * r2 * kvn[e + 4], k[5] * r2 * kvn[e + 5]), pkbf(k[6] * r2 * kvn[e + 6], k[7] * r2 * kvn[e + 7])}; }
        }
        __syncthreads();
        {
            pg8::f32x4 acc[3][2];
#pragma unroll
            for (int a = 0; a < 3; ++a)
#pragma unroll
                for (int m = 0; m < 2; ++m) acc[a][m] = (pg8::f32x4){0.f, 0.f, 0.f, 0.f};
#pragma unroll
            for (int ks = 0; ks < 6; ++ks) {
                bf16x8_t af[2];
#pragma unroll
                for (int m = 0; m < 2; ++m) af[m] = *(LAS const bf16x8_t*)(lds + L_CQ + (m * 16 + fr) * QP + (32 * ks + 8 * fq) * 2);
#pragma unroll
                for (int a = 0; a < 3; ++a) {
                    const bf16x8_t bfrag = *(const bf16x8_t*)(WUQ + (size_t)((3 * wid + a) * 16 + fr) * 192 + 32 * ks + 8 * fq);
#pragma unroll
                    for (int m = 0; m < 2; ++m) acc[a][m] = __builtin_amdgcn_mfma_f32_16x16x32_bf16(bfrag, af[m], acc[a][m], 0, 0, 0);
                }
            }
#pragma unroll
            for (int a = 0; a < 3; ++a) {
                const int nt = 3 * wid + a, t6 = nt % 6, col = nt * 16 + 4 * fq;
#pragma unroll
                for (int m = 0; m < 2; ++m) {
                    const int tok = m * 16 + fr, t = t0 + tok;
                    pg8::f32x4 v = acc[a][m];
                    if (t6 >= 4) {
                        pg8::f32x4 pv; pv[0] = __shfl_xor(v[0], 32); pv[1] = __shfl_xor(v[1], 32); pv[2] = __shfl_xor(v[2], 32); pv[3] = __shfl_xor(v[3], 32);
                        if (!isctx) { const int pos = t6 == 4 ? (t >> 6) : (t & 63);
#pragma unroll
                            for (int j = 0; j < 4; ++j) { const float2 cs = tab16[pos * 8 + 4 * (fq & 1) + j]; v[j] = v[j] * cs.x + (fq < 2 ? -pv[j] : pv[j]) * cs.y; } }
                    }
                    *(LAS int*)(lds + L_SQ + tok * SQP + (nt / 6) * 128 + t6 * 16 + 4 * fq) = CVT4_F8(v[0], v[1], v[2], v[3]);
                }
            }
        }
        {
            pg8::f32x4 acc[4][2];
#pragma unroll
            for (int a = 0; a < 4; ++a)
#pragma unroll
                for (int m = 0; m < 2; ++m) acc[a][m] = (pg8::f32x4){0.f, 0.f, 0.f, 0.f};
#pragma unroll
            for (int ks = 0; ks < 4; ++ks) {
                bf16x8_t af[2];
#pragma unroll
                for (int m = 0; m < 2; ++m) af[m] = *(LAS const bf16x8_t*)(lds + L_CKV + (m * 16 + fr) * KVP + (32 * ks + 8 * fq) * 2);
#pragma unroll
                for (int a = 0; a < 4; ++a) {
                    const bf16x8_t bfrag = *(const bf16x8_t*)(WUKV + (size_t)((4 * wid + a) * 16 + fr) * 128 + 32 * ks + 8 * fq);
#pragma unroll
                    for (int m = 0; m < 2; ++m) acc[a][m] = __builtin_amdgcn_mfma_f32_16x16x32_bf16(bfrag, af[m], acc[a][m], 0, 0, 0);
                }
            }
#pragma unroll
            for (int a = 0; a < 4; ++a) {
                const int n = (4 * wid + a) * 16 + 4 * fq, hh = n >> 7, d = n & 127;
                const int dst = d < 64 ? PC_KA + hh * 96 + d : PC_VA + hh * 64 + (d - 64);
#pragma unroll
                for (int m = 0; m < 2; ++m) { const pg8::f32x4 v = acc[a][m]; const int row = R0 + m * 16 + fr;
                    const int w8 = CVT4_F8(v[0], v[1], v[2], v[3]);
                    const int tl = m * 16 + fr; (void)row;
                    if (d < 64) *(LAS int*)(lds + L_SQ + tl * SQP + 512 + hh * 128 + d) = w8;
                    else { LAS unsigned char* vp = lds + L_SV + (hh * 64 + (d - 64)) * 32 + 16 * ((tl >> 2) & 1) + 4 * (tl >> 3) + (tl & 3);
                        vp[0] = (unsigned char)w8; vp[32] = (unsigned char)(w8 >> 8); vp[64] = (unsigned char)(w8 >> 16); vp[96] = (unsigned char)((unsigned)w8 >> 24); } }
                (void)dst;
            }
        }
        int tidB = tid; asm volatile("" : "+v"(tidB));
#pragma unroll
        for (int it = 0; it < 5; ++it) {
            const int w = it * NT + tidB;
            if (w < 32 * 74) {
                const int tok = w / 74, task = w % 74, t = t0 + tok;
                bf16_t* po = POST + (size_t)(R0 + tok) * POST_LD;
                int dst, dist; const float2* tb; float scl = 1.f; bool bc = false;
                if (task < 40) { const int hd = task >> 2, half = (task >> 1) & 1, cp = task & 1;
                    dst = (task < 32 ? PC_QB : PC_KB - 8 * 64) + hd * 64 + half * 32 + cp * 8; dist = 16; tb = tab32 + (half ? (t & 63) : (t >> 6)) * 16 + cp * 8; }
                else if (task < 72) { const int q = task - 40, hd = q >> 2, cp = q & 3;
                    dst = PC_RQ + hd * 64 + cp * 8; dist = 32; tb = tab_ret + t * 32 + cp * 8; if (hd >= 4) scl = 0.125f; }
                else { const int half = task - 72; dst = PC_KA + 64 + half * 16; dist = 8; bc = true; tb = tab16 + (half ? (t & 63) : (t >> 6)) * 8; }
                float x1[8], x2[8]; unpack8(make_uint4(p1[it][0], p1[it][1], p1[it][2], p1[it][3]), x1); unpack8(make_uint4(p2[it][0], p2[it][1], p2[it][2], p2[it][3]), x2);
                if (!isctx) {
                    const float4 c0 = *(const float4*)(tb), c1 = *(const float4*)(tb + 2), c2 = *(const float4*)(tb + 4), c3 = *(const float4*)(tb + 6);
                    const float cs[8] = {c0.x, c0.z, c1.x, c1.z, c2.x, c2.z, c3.x, c3.z}, sn[8] = {c0.y, c0.w, c1.y, c1.w, c2.y, c2.w, c3.y, c3.w};
#pragma unroll
                    for (int j = 0; j < 8; ++j) { const float a = x1[j], b2 = x2[j]; x1[j] = a * cs[j] - b2 * sn[j]; x2[j] = b2 * cs[j] + a * sn[j]; }
                }
#pragma unroll
                for (int j = 0; j < 8; ++j) { x1[j] *= scl; x2[j] *= scl; }
                const uint4 o1 = make_uint4(pkbf(x1[0], x1[1]), pkbf(x1[2], x1[3]), pkbf(x1[4], x1[5]), pkbf(x1[6], x1[7]));
                const uint4 o2 = make_uint4(pkbf(x2[0], x2[1]), pkbf(x2[2], x2[3]), pkbf(x2[4], x2[5]), pkbf(x2[6], x2[7]));
                if (bc) {
                    LAS unsigned char* k8 = lds + L_SQ + tok * SQP + 512 + 64 + (task - 72) * 16;
                    typedef unsigned u32x2_t __attribute__((ext_vector_type(2)));
                    const uint2 f1 = make_uint2((unsigned)CVT4_F8(x1[0], x1[1], x1[2], x1[3]), (unsigned)CVT4_F8(x1[4], x1[5], x1[6], x1[7]));
                    const uint2 f2 = make_uint2((unsigned)CVT4_F8(x2[0], x2[1], x2[2], x2[3]), (unsigned)CVT4_F8(x2[4], x2[5], x2[6], x2[7]));
#pragma unroll
                    for (int hh = 0; hh < 4; ++hh) { *(LAS u32x2_t*)(k8 + hh * 128) = (u32x2_t){f1.x, f1.y}; *(LAS u32x2_t*)(k8 + hh * 128 + 8) = (u32x2_t){f2.x, f2.y}; }
                } else { *(uint4*)(po + dst) = o1; *(uint4*)(po + dst + dist) = o2; }
            }
        }
        __syncthreads();
        {
            const int rr = tid >> 4, pc = tid & 15;
            uint4* qd = (uint4*)(QK8 + (size_t)(R0 + rr) * 1024 + pc * 64);
#pragma unroll
            for (int j = 0; j < 4; ++j) { const u32x4_t t4 = *(LAS const u32x4_t*)(lds + L_SQ + rr * SQP + pc * 64 + j * 16); qd[j] = make_uint4(t4[0], t4[1], t4[2], t4[3]); }
            int bb, key0; if (R0 < T_LAT) { bb = R0 >> 12; key0 = R0 & (SEQ - 1); } else { bb = (R0 - T_LAT) >> 8; key0 = SEQ + ((R0 - T_LAT) & (CTXL - 1)); }
            const int vr = tid >> 1, hf = tid & 1;
            const u32x4_t t4 = *(LAS const u32x4_t*)(lds + L_SV + vr * 32 + hf * 16);
            *(uint4*)(V8T + (size_t)((bb * 4 + (vr >> 6)) * 64 + (vr & 63)) * 4352 + (key0 & ~63) + 32 * hf + 16 * ((key0 >> 5) & 1)) = make_uint4(t4[0], t4[1], t4[2], t4[3]);
        }
        if (has_next) { ra = na_; rb = nb_; rc = nc_; rk = nk_;
#pragma unroll
            for (int it = 0; it < 5; ++it) { p1[it] = n1[it]; p2[it] = n2[it]; } }
    }
#undef PREP_LOADS
#undef CVT4_F8
}
#define N_PHASES 23
#define LDS_BYTES 147456
#define LDS_MISC 131072
__device__ __forceinline__ P load_p() {
#if defined(__HIP_DEVICE_COMPILE__)
    const __attribute__((address_space(4))) P* kq = (const __attribute__((address_space(4))) P*)__builtin_amdgcn_kernarg_segment_ptr();
    asm volatile("" : "+s"(kq));
    return *kq;
#else
    return P{};
#endif
}
__global__ void __launch_bounds__(NT, 2) fwd_kernel(P p0, int lo, int hi) {
    extern __shared__ __attribute__((aligned(16))) unsigned char lds_raw[];
    float* lds = (float*)lds_raw;
    LAS unsigned char* ldsl = (LAS unsigned char*)lds_raw;
    volatile LAS unsigned* st = (volatile LAS unsigned*)(ldsl + LDS_MISC);
    if (threadIdx.x < 4) st[threadIdx.x] = 0u;
    __syncthreads();
    XcdBarrier bar; bar.bar = (unsigned*)(p0.ws + OFF_CTL); bar.x = 0; bar.st = st;
    if (hi - lo > 1) bar = xcd_barrier_post((unsigned*)(p0.ws + OFF_CTL), st);
#define IN(k) (lo <= (k) && (k) < hi)
#define PH(k) if (IN(k)) if (const P p = load_p(); true)
#define SEAM(k) do { if (IN(k) && IN((k) + 1)) xcd_barrier(bar); } while (0)
#define MOD ((const float*)(p.ws + OFF_MOD))
#define H ((bf16_t*)(p.ws + OFF_H))
#define XC ((float*)(p.ws + OFF_XC))
#define PROJ ((bf16_t*)(p.ws + OFF_PROJ))
#define ACT ((bf16_t*)(p.ws + OFF_ACT))
#define CNT ((int*)(p.ws + OFF_CNT))
#define LIST ((const int*)(p.ws + OFF_LIST))
#define WL ((const float*)(p.ws + OFF_WL))
#define WIN ((const bf16_t*)(p.ws + OFF_WIN))
#define WOUT ((const bf16_t*)(p.ws + OFF_WOUT))
#define FGU ((const bf16_t*)(p.ws + OFF_FGU))
#define FD ((const bf16_t*)(p.ws + OFF_FD))
#define MGU ((const bf16_t*)(p.ws + OFF_MGU))
#define MDW ((const bf16_t*)(p.ws + OFF_MD))
#define YB ((bf16_t*)(p.ws + OFF_Y))
#define YB2 ((bf16_t*)(p.ws + OFF_Y2))
#define PARTB ((float*)(p.ws + OFF_PART))
    const int G = gridDim.x, bid = blockIdx.x;

    PH(0) { ph_mod(p, lds); ph_tables(p); ph_conv_early(p, lds); }
    SEAM(0);
    PH(1) ph_norm(p, 0, 1, T_ALL, false, true, nullptr, 0, 0, 0, p.ws + OFF_QK8, true);
    SEAM(1);
#define WINL WIN
    PH(2) {
        { pg8::DenseSched S{H, WINL + (size_t)PJ_F8 * 1024, 1024, 1024, T_ALL / 256, (PROJ_LD - PJ_F8) / 256, G, bid}; pg8::EpiBf16 E{PROJ + PJ_F8, PROJ_LD}; pg8::gemm_phase(ldsl, S, E); }
        const int U2 = (T_ALL / 256) * ((PROJ_LD - PJ_F8) / 256), U8 = (T_ALL / 256) * (PJ_F8 / 256), x3 = U2 - 2 * G;
        const pg8::EpiBf16S E8{PROJ, PROJ_LD, 1.f / (F8_SH * F8_SW)};
        if (x3 > 0 && x3 < G && 3 * (G - x3) <= U8 && U8 - 3 * (G - x3) <= x3) {
            if (bid >= x3) { pg8::DenseSchedT<true> S{(const bf16_t*)(p.ws + OFF_QK8), WINL, 512, 512, T_ALL / 256, PJ_F8 / 256, G - x3, bid - x3, 0, 3 * (G - x3)}; pg8::gemm_phase(ldsl, S, E8); }
            else { pg8::DenseSchedT<true> S{(const bf16_t*)(p.ws + OFF_QK8), WINL, 512, 512, T_ALL / 256, PJ_F8 / 256, x3, bid, 3 * (G - x3), U8}; pg8::gemm_phase(ldsl, S, E8); }
        } else { pg8::DenseSchedT<true> S{(const bf16_t*)(p.ws + OFF_QK8), WINL, 512, 512, T_ALL / 256, PJ_F8 / 256, G, bid}; pg8::gemm_phase(ldsl, S, E8); } }
#undef WINL
    SEAM(2);
    PH(3) ph_prep2(p, 0, ldsl);
    SEAM(3);
    PH(4) ph_ret_T(p, 0, ldsl);
    SEAM(4);
    PH(5) ph_mixer_mfma(p, 0, true, ldsl);
    SEAM(5);
    PH(6) {
        { pg8::DenseSched S{H, WOUT, 1024, 1024, T_ALL / 256, 4, G, bid};
          pg8::EpiBf16Norm E{YB, 1024, (unsigned)((size_t)T_ALL * 1024 * 2), (unsigned*)(p.ws + OFF_PCNT), 1.f};
          pg8::gemm_phase(ldsl, S, E); }
        norm_help(p, NormArgs{0, 2, false, true, YB, 0, 2048, 0, nullptr, false}, (unsigned*)(p.ws + OFF_PCNT), 32u, (unsigned*)(p.ws + OFF_CLAIM), T_ALL / 256, (LAS unsigned*)(ldsl + LDS_MISC + 32));
    }
    SEAM(6);
    PH(8) { pg8::DenseSched S{H, FGU, 1024, 1024, T_ALL / 256, 2 * D_FF / 256, G, bid}; pg8::EpiSwigluT<false, true> E{ACT, D_FF}; pg8::gemm_phase(ldsl, S, E); }
    SEAM(8);
    PH(9) {
        { pg8::DenseSchedT<true> S{ACT, FD, D_FF / 2, D_FF / 2, T_ALL / 256, 4, G, bid};
          pg8::EpiBf16Norm E{YB2, 1024, (unsigned)((size_t)T_ALL * 1024 * 2), (unsigned*)(p.ws + OFF_PCNT) + 136 * 64, 1.f / (F8_SA * F8_SW)};
          pg8::gemm_phase(ldsl, S, E); }
        norm_help(p, NormArgs{1, 1, false, false, YB2, 0, 5120, 0, p.ws + OFF_QK8, true}, (unsigned*)(p.ws + OFF_PCNT) + 136 * 64, 32u, (unsigned*)(p.ws + OFF_CLAIM) + 64, T_ALL / 256, (LAS unsigned*)(ldsl + LDS_MISC + 32));
    }
    SEAM(9);
#define WINL (WIN + (size_t)PROJ_LD * 1024)
    PH(11) {
        { pg8::DenseSched S{H, WINL + (size_t)PJ_F8 * 1024, 1024, 1024, T_ALL / 256, (PROJ_LD - PJ_F8) / 256, G, bid}; pg8::EpiBf16 E{PROJ + PJ_F8, PROJ_LD}; pg8::gemm_phase(ldsl, S, E); }
        const int U2 = (T_ALL / 256) * ((PROJ_LD - PJ_F8) / 256), U8 = (T_ALL / 256) * (PJ_F8 / 256), x3 = U2 - 2 * G;
        const pg8::EpiBf16S E8{PROJ, PROJ_LD, 1.f / (F8_SH * F8_SW)};
        if (x3 > 0 && x3 < G && 3 * (G - x3) <= U8 && U8 - 3 * (G - x3) <= x3) {
            if (bid >= x3) { pg8::DenseSchedT<true> S{(const bf16_t*)(p.ws + OFF_QK8), WINL, 512, 512, T_ALL / 256, PJ_F8 / 256, G - x3, bid - x3, 0, 3 * (G - x3)}; pg8::gemm_phase(ldsl, S, E8); }
            else { pg8::DenseSchedT<true> S{(const bf16_t*)(p.ws + OFF_QK8), WINL, 512, 512, T_ALL / 256, PJ_F8 / 256, x3, bid, 3 * (G - x3), U8}; pg8::gemm_phase(ldsl, S, E8); }
        } else { pg8::DenseSchedT<true> S{(const bf16_t*)(p.ws + OFF_QK8), WINL, 512, 512, T_ALL / 256, PJ_F8 / 256, G, bid}; pg8::gemm_phase(ldsl, S, E8); } }
#undef WINL
    SEAM(11);
    PH(12) ph_prep2(p, 1, ldsl);
    SEAM(12);
    PH(13) ph_ret_T(p, 1, ldsl);
    SEAM(13);
    PH(14) ph_mixer_mfma(p, 1, false, ldsl);
    SEAM(14);
    PH(15) { pg8::DenseSched S{H, WOUT + (size_t)1024 * 1024, 1024, 1024, T_LAT / 256, 4, G, bid}; pg8::EpiBf16 E{YB, 1024}; pg8::gemm_phase(ldsl, S, E); }
    SEAM(15);
    PH(16) { ph_norm(p, 1, 2, T_LAT, true, false, YB, 1, 2048, 0, p.ws + OFF_H, false); ph_conv_late(p, lds); }
    SEAM(16);
#pragma unroll
    for (int s = 0; s < 2; ++s) {
        if (IN(17 + 2 * s) || IN(18 + 2 * s)) {
            LAS int* tab = (LAS int*)(ldsl + LDS_MISC + 64 + 128 * s);
            { const P p = load_p();
            __syncthreads();
            if (threadIdx.x == 0) { int tbv = 0; tab[8] = 0;
                for (int e = 0; e < 8; ++e) { const int ce = __hip_atomic_load(CNT + s * 8 + e, __ATOMIC_RELAXED, __HIP_MEMORY_SCOPE_AGENT); tab[e] = ce; tbv += (ce + 255) >> 8; tab[9 + e] = tbv; } }
            __syncthreads(); }
            const int nTm = tab[16];
            PH(17 + 2 * s) {
                if (s == 1) pg8::moe_combine((bf16_t*)(p.ws + OFF_YM), PARTB, (const LAS int*)(ldsl + LDS_MISC + 64), 4, 1.f / (F8_SA * F8_SW));
                pg8::MoeSched<true, true> S{H, MGU, 512, 512, 2 * D_FFE / 256, G, bid, (size_t)D_FFE * 1024, LIST + (size_t)s * 8 * 32768, tab, 0, nTm * (2 * D_FFE / 256), 1, 512 / 64};
                pg8::EpiSwigluT<true, true> E{ACT, D_FFE}; pg8::gemm_phase(ldsl, S, E);
            }
            SEAM(17 + 2 * s);
            PH(18 + 2 * s) {
                const int U = nTm * 4, rem = U % G, split = (rem > 0 && rem * MOE_WAYS <= G) ? 1 : 0, umain = split ? U - rem : U;
                { pg8::MoeSched<false, true> S{ACT, MDW, D_FFE / 2, D_FFE / 2, 4, G, bid, (size_t)512 * D_FFE, nullptr, tab, 0, umain, 1, D_FFE / 128};
                  pg8::EpiBf16S E{(bf16_t*)(p.ws + OFF_YM) + (size_t)s * ACT_ROWS * 1024, 1024, 1.f / (F8_SA * F8_SW)};
                  pg8::gemm_phase(ldsl, S, E); }
                if (split) { pg8::MoeSched<false, true> S{ACT, MDW, D_FFE / 2, D_FFE / 2, 4, G, bid, (size_t)512 * D_FFE, nullptr, tab, umain, U, MOE_WAYS, D_FFE / 128 / MOE_WAYS};
                  pg8::EpiPart E{PARTB}; pg8::gemm_phase(ldsl, S, E); }
            }
        }
        SEAM(18 + 2 * s);
    }
    PH(21) { const LAS int* tab1 = (const LAS int*)(ldsl + LDS_MISC + 64 + 128);
        pg8::moe_combine((bf16_t*)(p.ws + OFF_YM) + (size_t)ACT_ROWS * 1024, PARTB, tab1, 4, 1.f / (F8_SA * F8_SW)); }
    SEAM(21);
    PH(22) ph_final_moe(p, (const LAS int*)(ldsl + LDS_MISC + 64), (const LAS int*)(ldsl + LDS_MISC + 64 + 128));
}

extern "C" void kernel_launch(void* const* d_in, const int* in_sizes, int n_in, void* d_out, int out_size, void* d_ws, size_t ws_size, hipStream_t stream) {
    static int grid = 0;
    if (!grid) {
        if (n_in != 25 || out_size != T_LAT * 1024 || ws_size < WS_END) { fprintf(stderr, "kernel_launch: unexpected shapes (n_in %d out %d ws %zu need %zu)\n", n_in, out_size, ws_size, (size_t)WS_END); grid = -1; return; }
        int dev = 0, cus = 0, per_cu = 0;
        (void)hipGetDevice(&dev); (void)hipDeviceGetAttribute(&cus, hipDeviceAttributeMultiprocessorCount, dev);
        (void)hipFuncSetAttribute((const void*)fwd_kernel, hipFuncAttributeMaxDynamicSharedMemorySize, LDS_BYTES);
        (void)hipOccupancyMaxActiveBlocksPerMultiprocessor(&per_cu, (const void*)fwd_kernel, NT, LDS_BYTES);
        if (per_cu < 1) { fprintf(stderr, "kernel_launch: occupancy query says %d\n", per_cu); }
        grid = cus > 0 ? cus : 256;
    }
    if (grid < 0) return;
    (void)hipMemsetAsync((char*)d_ws + OFF_CTL, 0, CTL_BYTES, stream);
    P p{};
    for (int i = 0; i < 25; ++i) p.in[i] = (const float*)d_in[i];
    p.out = (float*)d_out; p.ws = (unsigned char*)d_ws;
    hipLaunchKernelGGL(fwd_kernel, dim3(grid), dim3(NT), LDS_BYTES, stream, p, 0, N_PHASES);
}
```

```cpp
#include <hip/hip_runtime.h>
#include <stdint.h>
#include <stdio.h>

#define D_MODEL 1024
#define BATCH 8
#define SEQ 4096
#define CTXL 256
#define T_LAT (BATCH * SEQ)
#define T_CTX (BATCH * CTXL)
#define T_ALL (T_LAT + T_CTX)
#define IN_DIM 2144
#define PROJ_LD 2304
#define POST_LD 2816
#define D_FF 2816
#define D_FFE 3584
#define NEXP 8
#define NT 512
#define NORM_EPS 1e-6f

typedef unsigned short bf16_t;
__device__ __forceinline__ float bf2f(bf16_t v) { return __uint_as_float(((unsigned)v) << 16); }
__device__ __forceinline__ bf16_t f2bf(float f) { unsigned u = __float_as_uint(f); u += 0x7FFFu + ((u >> 16) & 1u); return (bf16_t)(u >> 16); }
__device__ __forceinline__ float silu_f(float v) { return v / (1.f + expf(-v)); }

#define PJ_RQ 1280
#define PJ_RK 1536
#define PJ_RV 1792
#define PJ_RG 2048
#define PJ_F8 1280
#define PC_QA 0
#define PC_KA 384
#define PC_VA 768
#define PC_QB 1024
#define PC_KB 1536
#define PC_VB 1664
#define PC_RQ 1792
#define PC_RK 2048
#define PC_RV 2304
#define PC_RG 2560

constexpr size_t AL256(size_t x) { return (x + 255) & ~(size_t)255; }
constexpr size_t OFF_CTL  = 0;
constexpr size_t CTL_BYTES = 262144;
constexpr size_t OFF_PCNT = 32768;
constexpr size_t OFF_CLAIM = 20480;
constexpr size_t OFF_CMAX = 196608;
constexpr size_t OFF_CS8  = OFF_CMAX + 5632 * 4;
constexpr size_t OFF_CNT  = 16384;
constexpr size_t OFF_MOD  = 1u << 20;
constexpr size_t OFF_TAB  = 3u << 19;
constexpr size_t OFF_WIN  = 3u << 20;
constexpr size_t OFF_WOUT = OFF_WIN + (size_t)2 * PROJ_LD * 1024 * 2;
constexpr size_t OFF_FGU  = OFF_WOUT + (size_t)2 * 1024 * 1024 * 2;
constexpr size_t OFF_FD   = OFF_FGU + (size_t)2 * D_FF * 1024 * 2;
constexpr size_t OFF_WUQ  = OFF_FD + (size_t)1024 * D_FF * 2;
constexpr size_t OFF_WUKV = OFF_WUQ + (size_t)2 * 384 * 192 * 2;
constexpr size_t OFF_H    = OFF_WUKV + (size_t)2 * 512 * 128 * 2;
constexpr size_t OFF_XC   = OFF_H + (size_t)T_ALL * 1024 * 2;
constexpr size_t OFF_LIST = OFF_XC + (size_t)T_CTX * 1024 * 4;
constexpr size_t OFF_WL   = OFF_LIST + (size_t)2 * 8 * 32768 * 4;
constexpr size_t OFF_R    = OFF_WL + (size_t)2 * 8 * 32768 * 4;
constexpr size_t OFF_PROJ = OFF_R;
constexpr size_t OFF_POST = OFF_PROJ + (size_t)T_ALL * PROJ_LD * 2;
constexpr size_t OFF_TT   = OFF_POST + (size_t)T_ALL * POST_LD * 2;
constexpr size_t R1_END   = OFF_TT + (size_t)BATCH * 4 * 34 * 2 * 4096 * 4;
constexpr size_t OFF_ACT  = OFF_R;
constexpr size_t OFF_Y    = OFF_PROJ;
constexpr size_t OFF_H8D  = OFF_ACT + (size_t)T_ALL * D_FF;
constexpr size_t OFF_RS8   = OFF_H8D + (size_t)T_ALL * 1024;
constexpr size_t OFF_Y2   = OFF_ACT + (size_t)T_ALL * D_FF * 2;
constexpr size_t ACT_ROWS = T_LAT + NEXP * 256;
constexpr size_t OFF_MGU  = OFF_ACT + ACT_ROWS * D_FFE;
constexpr size_t OFF_MD   = OFF_MGU + (size_t)NEXP * 2 * D_FFE * 1024;
constexpr size_t OFF_PART = OFF_MD + (size_t)NEXP * 1024 * D_FFE;
constexpr size_t PART_END = OFF_PART + (size_t)256 * 65536 * 4;
constexpr size_t OFF_YM   = PART_END;
constexpr size_t OFF_INV  = OFF_YM + (size_t)2 * ACT_ROWS * 1024 * 2;
constexpr size_t YM_END   = OFF_INV + (size_t)T_LAT * 32;
constexpr size_t OFF_QK8  = YM_END;
constexpr size_t OFF_V8T  = OFF_QK8 + (size_t)T_ALL * 1024;
constexpr size_t F8_END   = OFF_V8T + (size_t)BATCH * 4 * 64 * 4352;
constexpr size_t WS_END   = F8_END > R1_END ? F8_END : R1_END;
static_assert(R1_END <= WS_END, "phase-1 buffers fit");
static_assert(WS_END <= 607070848, "workspace budget");
static_assert(OFF_Y2 + (size_t)T_ALL * 1024 * 2 <= WS_END, "Y2 fits");
static_assert(OFF_MGU >= OFF_Y + (size_t)T_ALL * 1024 * 2, "expert weights are converted while norm2(L1) still reads Y");

struct P { const float* in[25]; float* out; unsigned char* ws; };

#define XB_TMO      128
#define XB_XCNT(j)  (256  + 64 * (j))
#define XB_XSUB(j)  (1280 + 64 * (j))
#define XB_XGEN(j)  (2304 + 64 * (j))
#define XB_TOP      3328
#define XB_TOPGEN   3392
#define XCD_BAR_WORDS 3456
#define XB_SPIN_CAP (1u << 22)
#define LAS __attribute__((address_space(3)))

__device__ __forceinline__ unsigned xb_ld(unsigned* p)              { return __hip_atomic_load(p, __ATOMIC_RELAXED, __HIP_MEMORY_SCOPE_AGENT); }
__device__ __forceinline__ unsigned xb_add(unsigned* p, unsigned v) { return __hip_atomic_fetch_add(p, v, __ATOMIC_RELAXED, __HIP_MEMORY_SCOPE_AGENT); }
__device__ __forceinline__ unsigned xb_xcc_id() { return (unsigned)__builtin_amdgcn_s_getreg((3 << 11) | 20) & 0xFu; }
#define XB_SPIN(cond, bar) do { unsigned _sp = 0; while (cond) { __builtin_amdgcn_s_sleep(1); \
    if ((++_sp & 255u) == 0u) { if (xb_ld(&(bar)[XB_TMO])) break; if (_sp > XB_SPIN_CAP) { atomicAdd(&(bar)[XB_TMO], 1u); break; } } } } while (0)

struct XcdBarrier { unsigned* bar; unsigned x; volatile LAS unsigned* st; };

__device__ __forceinline__ XcdBarrier xcd_barrier_post(unsigned* bar, volatile LAS unsigned* st) {
    XcdBarrier b; b.bar = bar; b.x = xb_xcc_id(); b.st = st;
    if (threadIdx.x == 0) (void)xb_add(&bar[XB_XCNT(b.x)], 1u);
    return b;
}
__device__ __forceinline__ void xcd_barrier_complete(unsigned* bar, unsigned x, unsigned& nloc, unsigned& nx) {
    const unsigned G = gridDim.x * gridDim.y * gridDim.z;
    unsigned sum, cnt, mine, sp = 0u;
    for (;;) {
        sum = 0u; cnt = 0u; mine = 0u;
#pragma unroll
        for (unsigned j = 0; j < 16; ++j) { const unsigned c = xb_ld(&bar[XB_XCNT(j)]); sum += c; cnt += (c > 0u) ? 1u : 0u; mine = (j == x) ? c : mine; }
        if (sum == G) break;
        __builtin_amdgcn_s_sleep(1);
        if ((++sp & 255u) == 0u) { if (xb_ld(&bar[XB_TMO])) break; if (sp > XB_SPIN_CAP) { atomicAdd(&bar[XB_TMO], 1u); break; } }
    }
    nloc = mine > 0u ? mine : 1u; nx = cnt > 0u ? cnt : 1u;
}
__device__ __forceinline__ void xcd_barrier(const XcdBarrier& b) {
    asm volatile("s_waitcnt vmcnt(0)" ::: "memory");
    __syncthreads();
    if (threadIdx.x == 0) {
        unsigned* bar = b.bar;
        __builtin_amdgcn_s_waitcnt(0);
        unsigned nloc = b.st[0], nx = b.st[1];
        if (nloc == 0u) { xcd_barrier_complete(bar, b.x, nloc, nx); b.st[0] = nloc; b.st[1] = nx; }
        const unsigned old = xb_add(&bar[XB_XSUB(b.x)], 1u);
        const unsigned gen = old / nloc;
        if (old + 1u == (gen + 1u) * nloc) {
            __builtin_amdgcn_fence(__ATOMIC_RELEASE, "agent");
            asm volatile("s_waitcnt vmcnt(0)" ::: "memory");
            const unsigned og = xb_add(&bar[XB_TOP], 1u);
            const unsigned tg = og / nx;
            if (og + 1u == (tg + 1u) * nx) xb_add(&bar[XB_TOPGEN], 1u);
            else XB_SPIN(xb_ld(&bar[XB_TOPGEN]) == tg, bar);
            __builtin_amdgcn_fence(__ATOMIC_ACQUIRE, "agent");
            xb_add(&bar[XB_XGEN(b.x)], 1u);
            asm volatile("s_waitcnt vmcnt(0)" ::: "memory");
        } else {
            XB_SPIN(xb_ld(&bar[XB_XGEN(b.x)]) == gen, bar);
            __builtin_amdgcn_fence(__ATOMIC_ACQUIRE, "agent");
            asm volatile("s_waitcnt vmcnt(0)" ::: "memory");
        }
    }
    __syncthreads();
}

__device__ __forceinline__ float wave_sum(float v) {
#pragma unroll
    for (int o = 32; o > 0; o >>= 1) v += __shfl_xor(v, o);
    return v;
}
__device__ __forceinline__ void unpack8(const uint4 r, float* f) {
    f[0] = __uint_as_float(r.x << 16); f[1] = __uint_as_float(r.x & 0xFFFF0000u);
    f[2] = __uint_as_float(r.y << 16); f[3] = __uint_as_float(r.y & 0xFFFF0000u);
    f[4] = __uint_as_float(r.z << 16); f[5] = __uint_as_float(r.z & 0xFFFF0000u);
    f[6] = __uint_as_float(r.w << 16); f[7] = __uint_as_float(r.w & 0xFFFF0000u);
}
__device__ __forceinline__ int tok_row(int b, int i) { return i < SEQ ? b * SEQ + i : T_LAT + b * CTXL + (i - SEQ); }

__device__ __forceinline__ void ph_mod(const P& p, float* lds) {
    float* MOD = (float*)(p.ws + OFF_MOD);
    float* sl = lds; float* part = lds + 9 * 1024;
    int tid_ = threadIdx.x; asm volatile("" : "+v"(tid_));
    const int t = tid_, col = t & 63, ks = t >> 6;
    __syncthreads();
    for (int i = t; i < 9 * 1024; i += NT) { const int r = i >> 10, k = i & 1023; sl[i] = silu_f(r < 8 ? p.in[1][r * 1024 + k] : p.in[3][k]); }
    __syncthreads();
    for (int u = blockIdx.x; u < 2 * 96; u += gridDim.x) {
        const int l = u / 96, n = (u % 96) * 64 + col;
        const float* w = p.in[4] + (size_t)l * 1024 * 6144 + (size_t)(ks * 128) * 6144 + n;
        float acc[9];
#pragma unroll
        for (int r = 0; r < 9; ++r) acc[r] = 0.f;
#pragma unroll 8
        for (int k = 0; k < 128; ++k) { const float wv = w[(size_t)k * 6144];
#pragma unroll
            for (int r = 0; r < 9; ++r) acc[r] += sl[r * 1024 + ks * 128 + k] * wv; }
        __syncthreads();
#pragma unroll
        for (int r = 0; r < 9; ++r) part[(ks * 9 + r) * 64 + col] = acc[r];
        __syncthreads();
        for (int i = t; i < 9 * 64; i += NT) { const int r = i >> 6, c2 = i & 63; float s = 0.f;
#pragma unroll
            for (int q = 0; q < 8; ++q) s += part[(q * 9 + r) * 64 + c2];
            const int nn = (u % 96) * 64 + c2; MOD[(l * 9 + r) * 6144 + nn] = s + p.in[5][l * 6144 + nn]; }
    }
}

#define F8_SH 8.f
#define F8_SW 64.f
#define F8_SA 4.f
#define MOE_WAYS 7
__device__ __forceinline__ float f8clamp(float x) { return fminf(fmaxf(x, -448.f), 448.f); }
struct NormArgs { int layer, which; bool router, from_input; const bf16_t* resY; int res_layer, res_goff, ctx_ways; unsigned char* h8; bool both; float* i8s = nullptr; };
__device__ __forceinline__ void norm_row(const P& p, const NormArgs& a, int row, int lane) {
    const int layer = a.layer, which = a.which, res_layer = a.res_layer, res_goff = a.res_goff, ctx_ways = a.ctx_ways; const bool router = a.router, from_input = a.from_input; const bf16_t* resY = a.resY;
    const float* MOD = (const float*)(p.ws + OFF_MOD);
    const float* gain = (which == 1 ? p.in[6] : p.in[7]) + layer * 1024;
    bf16_t* H = (bf16_t*)(p.ws + OFF_H);
    float* XC = (float*)(p.ws + OFF_XC);
    int* CNT = (int*)(p.ws + OFF_CNT);
    int* LIST = (int*)(p.ws + OFF_LIST);
    float* WL = (float*)(p.ws + OFF_WL);
    {
        const float* src; float* dstx; int r;
        if (row < T_LAT) { r = row >> 12; src = (from_input ? p.in[0] : p.out) + (size_t)row * 1024; dstx = p.out + (size_t)row * 1024; }
        else { r = 8; src = (from_input ? p.in[2] : XC) + (size_t)(row - T_LAT) * 1024; dstx = XC + (size_t)(row - T_LAT) * 1024; }
        const float* md = MOD + (layer * 9 + r) * 6144 + (which == 1 ? 0 : 3072);
        float4 v[4]; float ss = 0.f;
#pragma unroll
        for (int i = 0; i < 4; ++i) v[i] = *(const float4*)(src + i * 256 + lane * 4);
        if (resY) {
            const float* gt = MOD + (res_layer * 9 + r) * 6144 + res_goff;
#pragma unroll
            for (int i = 0; i < 4; ++i) { const int col = i * 256 + lane * 4;
                const float4 g = *(const float4*)(gt + col); float4 y;
                if (row >= T_LAT && ctx_ways > 0) {
                    const int cr = row - T_LAT; const float* pp = (const float*)(p.ws + OFF_PART) + (size_t)(((cr >> 8) * 4 + i) * ctx_ways) * 65536 + (cr & 255) * 256 + lane * 4;
                    y = *(const float4*)pp;
                    for (int q = 1; q < ctx_ways; ++q) { const float4 z = *(const float4*)(pp + (size_t)q * 65536); y.x += z.x; y.y += z.y; y.z += z.z; y.w += z.w; }
                } else { const uint2 yr = *(const uint2*)(resY + (size_t)row * 1024 + col);
                    y = make_float4(__uint_as_float(yr.x << 16), __uint_as_float(yr.x & 0xFFFF0000u), __uint_as_float(yr.y << 16), __uint_as_float(yr.y & 0xFFFF0000u)); }
                v[i].x += g.x * y.x; v[i].y += g.y * y.y; v[i].z += g.z * y.z; v[i].w += g.w * y.w;
                *(float4*)(dstx + col) = v[i]; }
        }
#pragma unroll
        for (int i = 0; i < 4; ++i) ss += v[i].x * v[i].x + v[i].y * v[i].y + v[i].z * v[i].z + v[i].w * v[i].w;
        ss = wave_sum(ss);
        const float rs = rsqrtf(ss * (1.f / 1024.f) + NORM_EPS);
        float lg[8] = {0.f, 0.f, 0.f, 0.f, 0.f, 0.f, 0.f, 0.f};
#pragma unroll
        for (int i = 0; i < 4; ++i) {
            const int col = i * 256 + lane * 4;
            const float4 g = *(const float4*)(gain + col), sh = *(const float4*)(md + col), sc = *(const float4*)(md + 1024 + col);
            float o[4];
            o[0] = (v[i].x * rs * g.x) * (1.f + sc.x) + sh.x; o[1] = (v[i].y * rs * g.y) * (1.f + sc.y) + sh.y;
            o[2] = (v[i].z * rs * g.z) * (1.f + sc.z) + sh.z; o[3] = (v[i].w * rs * g.w) * (1.f + sc.w) + sh.w;
            if (a.h8) {
                int w8 = 0; w8 = __builtin_amdgcn_cvt_pk_fp8_f32(f8clamp(o[0] * F8_SH), f8clamp(o[1] * F8_SH), w8, false); w8 = __builtin_amdgcn_cvt_pk_fp8_f32(f8clamp(o[2] * F8_SH), f8clamp(o[3] * F8_SH), w8, true);
                *(int*)(a.h8 + (size_t)row * 1024 + col) = w8;
            }
            if (!a.h8 || a.both) {
            uint2 pk; pk.x = (unsigned)f2bf(o[0]) | ((unsigned)f2bf(o[1]) << 16); pk.y = (unsigned)f2bf(o[2]) | ((unsigned)f2bf(o[3]) << 16);
            *(uint2*)(H + (size_t)row * 1024 + col) = pk; }
            if (router) {
                const float* rw = p.in[20] + (size_t)col * 8;
#pragma unroll
                for (int j = 0; j < 4; ++j) {
                    const float4 w0 = *(const float4*)(rw + j * 8), w1 = *(const float4*)(rw + j * 8 + 4);
                    lg[0] += o[j] * w0.x; lg[1] += o[j] * w0.y; lg[2] += o[j] * w0.z; lg[3] += o[j] * w0.w;
                    lg[4] += o[j] * w1.x; lg[5] += o[j] * w1.y; lg[6] += o[j] * w1.z; lg[7] += o[j] * w1.w;
                }
            }
        }
        if (router) {
#pragma unroll
            for (int e = 0; e < 8; ++e) lg[e] = wave_sum(lg[e]);
            if (lane == 0) {
                int e0 = 0; float v0 = lg[0];
#pragma unroll
                for (int e = 1; e < 8; ++e) if (lg[e] > v0) { v0 = lg[e]; e0 = e; }
                int e1 = -1; float v1 = -3.0e38f;
#pragma unroll
                for (int e = 0; e < 8; ++e) if (e != e0 && lg[e] > v1) { v1 = lg[e]; e1 = e; }
                const float x1 = expf(v1 - v0), inv = 1.f / (1.f + x1);
                const float w0 = inv, w1 = x1 * inv;
                const int p0 = atomicAdd(&CNT[e0], 1), p1 = atomicAdd(&CNT[8 + e1], 1);
                LIST[(size_t)e0 * 32768 + p0] = row; WL[(size_t)e0 * 32768 + p0] = w0;
                LIST[(size_t)(8 + e1) * 32768 + p1] = row; WL[(size_t)(8 + e1) * 32768 + p1] = w1;
                { int* iv = (int*)(p.ws + OFF_INV) + (size_t)row * 8; *(int4*)iv = make_int4(e0, p0, e1, p1); *(float2*)(iv + 4) = make_float2(w0, w1); }
            }
        }
    }
}
__device__ __forceinline__ void norm_rows4(const P& p, const NormArgs& a, int row0, int lane) {
    const float* MOD = (const float*)(p.ws + OFF_MOD);
    bf16_t* H = (bf16_t*)(p.ws + OFF_H); float* XC = (float*)(p.ws + OFF_XC);
    const bool lat = row0 < T_LAT; const int r = lat ? (row0 >> 12) : 8;
    const float* srcb = lat ? (a.from_input ? p.in[0] : p.out) + (size_t)row0 * 1024 : (a.from_input ? p.in[2] : XC) + (size_t)(row0 - T_LAT) * 1024;
    float* dstb = lat ? p.out + (size_t)row0 * 1024 : XC + (size_t)(row0 - T_LAT) * 1024;
    float4 v[4][4]; uint2 y[4][4];
#pragma unroll
    for (int q = 0; q < 4; ++q)
#pragma unroll
        for (int i = 0; i < 4; ++i) { v[q][i] = *(const float4*)(srcb + q * 1024 + i * 256 + lane * 4); y[q][i] = *(const uint2*)(a.resY + (size_t)(row0 + q) * 1024 + i * 256 + lane * 4); }
    const float* gt = MOD + (a.res_layer * 9 + r) * 6144 + a.res_goff;
    const float* md = MOD + (a.layer * 9 + r) * 6144 + (a.which == 1 ? 0 : 3072);
    const float* gain = (a.which == 1 ? p.in[6] : p.in[7]) + a.layer * 1024;
    float4 gg[4], gn[4], sh[4], sc[4];
#pragma unroll
    for (int i = 0; i < 4; ++i) { const int col = i * 256 + lane * 4; gg[i] = *(const float4*)(gt + col); gn[i] = *(const float4*)(gain + col); sh[i] = *(const float4*)(md + col); sc[i] = *(const float4*)(md + 1024 + col); }
#pragma unroll
    for (int q = 0; q < 4; ++q) {
        float ss = 0.f;
#pragma unroll
        for (int i = 0; i < 4; ++i) { const uint2 yr = y[q][i];
            v[q][i].x += gg[i].x * __uint_as_float(yr.x << 16); v[q][i].y += gg[i].y * __uint_as_float(yr.x & 0xFFFF0000u);
            v[q][i].z += gg[i].z * __uint_as_float(yr.y << 16); v[q][i].w += gg[i].w * __uint_as_float(yr.y & 0xFFFF0000u);
            *(float4*)(dstb + q * 1024 + i * 256 + lane * 4) = v[q][i];
            ss += v[q][i].x * v[q][i].x + v[q][i].y * v[q][i].y + v[q][i].z * v[q][i].z + v[q][i].w * v[q][i].w; }
        ss = wave_sum(ss);
        const float rs = rsqrtf(ss * (1.f / 1024.f) + NORM_EPS);
        if (a.i8s) {
            float oo[4][4]; float amax = 0.f;
#pragma unroll
            for (int i = 0; i < 4; ++i) {
                oo[i][0] = (v[q][i].x * rs * gn[i].x) * (1.f + sc[i].x) + sh[i].x; oo[i][1] = (v[q][i].y * rs * gn[i].y) * (1.f + sc[i].y) + sh[i].y;
                oo[i][2] = (v[q][i].z * rs * gn[i].z) * (1.f + sc[i].z) + sh[i].z; oo[i][3] = (v[q][i].w * rs * gn[i].w) * (1.f + sc[i].w) + sh[i].w;
                amax = fmaxf(fmaxf(amax, fmaxf(fabsf(oo[i][0]), fabsf(oo[i][1]))), fmaxf(fabsf(oo[i][2]), fabsf(oo[i][3]))); }
#pragma unroll
            for (int o_ = 1; o_ < 64; o_ <<= 1) amax = fmaxf(amax, __shfl_xor(amax, o_));
            amax = fmaxf(amax, 1e-20f);
            const float qs = 127.f / amax;
#pragma unroll
            for (int i = 0; i < 4; ++i) { const int q0 = (int)rintf(oo[i][0] * qs), q1 = (int)rintf(oo[i][1] * qs), q2 = (int)rintf(oo[i][2] * qs), q3 = (int)rintf(oo[i][3] * qs);
                *(int*)(a.h8 + (size_t)(row0 + q) * 1024 + i * 256 + lane * 4) = (int)((unsigned)(q0 & 255) | ((unsigned)(q1 & 255) << 8) | ((unsigned)(q2 & 255) << 16) | ((unsigned)q3 << 24)); }
            if (lane == 0) a.i8s[row0 + q] = amax * (1.f / 127.f);
        } else
#pragma unroll
        for (int i = 0; i < 4; ++i) { float o[4];
            o[0] = (v[q][i].x * rs * gn[i].x) * (1.f + sc[i].x) + sh[i].x; o[1] = (v[q][i].y * rs * gn[i].y) * (1.f + sc[i].y) + sh[i].y;
            o[2] = (v[q][i].z * rs * gn[i].z) * (1.f + sc[i].z) + sh[i].z; o[3] = (v[q][i].w * rs * gn[i].w) * (1.f + sc[i].w) + sh[i].w;
            if (a.h8) { int w8 = 0; w8 = __builtin_amdgcn_cvt_pk_fp8_f32(f8clamp(o[0] * F8_SH), f8clamp(o[1] * F8_SH), w8, false); w8 = __builtin_amdgcn_cvt_pk_fp8_f32(f8clamp(o[2] * F8_SH), f8clamp(o[3] * F8_SH), w8, true);
                *(int*)(a.h8 + (size_t)(row0 + q) * 1024 + i * 256 + lane * 4) = w8; }
            if (!a.h8 || a.both) { uint2 pk; pk.x = (unsigned)f2bf(o[0]) | ((unsigned)f2bf(o[1]) << 16); pk.y = (unsigned)f2bf(o[2]) | ((unsigned)f2bf(o[3]) << 16);
            *(uint2*)(H + (size_t)(row0 + q) * 1024 + i * 256 + lane * 4) = pk; } }
    }
}
__device__ __forceinline__ void norm_help(const P& p, const NormArgs& a, unsigned* cnt, unsigned need, unsigned* claim, int npanels, LAS unsigned* lw) {
    int tid_ = threadIdx.x; asm volatile("" : "+v"(tid_));
    const int wave = __builtin_amdgcn_readfirstlane(tid_ >> 6), lane = tid_ & 63;
    for (;;) {
        __syncthreads();
        if (threadIdx.x == 0) {
            const unsigned part = __hip_atomic_fetch_add(claim, 1u, __ATOMIC_RELAXED, __HIP_MEMORY_SCOPE_AGENT);
            if (part < (unsigned)npanels * 4u) {
                unsigned sp = 0;
                while (__hip_atomic_load(cnt + 64 * (part >> 2), __ATOMIC_RELAXED, __HIP_MEMORY_SCOPE_AGENT) < need) { __builtin_amdgcn_s_sleep(8); if (++sp > (1u << 22)) break; }
                __builtin_amdgcn_fence(__ATOMIC_ACQUIRE, "agent");
                asm volatile("s_waitcnt vmcnt(0)" ::: "memory");
            }
            lw[0] = part;
        }
        __syncthreads();
        const unsigned part = lw[0];
        if (part >= (unsigned)npanels * 4u) break;
        const int base = (int)(part >> 2) * 256 + (int)(part & 3u) * 64 + wave * 8;
        norm_rows4(p, a, base, lane); norm_rows4(p, a, base + 4, lane);
    }
}
__device__ __forceinline__ void ph_norm(const P& p, int layer, int which, int nrows, bool router, bool from_input, const bf16_t* resY, int res_layer, int res_goff, int ctx_ways, unsigned char* h8, bool both) {
    int tid_ = threadIdx.x; asm volatile("" : "+v"(tid_));
    const int wave = tid_ >> 6, lane = tid_ & 63;
    const NormArgs a{layer, which, router, from_input, resY, res_layer, res_goff, ctx_ways, h8, both};
    for (int row = blockIdx.x * 8 + wave; row < nrows; row += gridDim.x * 8) norm_row(p, a, row, lane);
}

struct ConvJob { const float* src; bf16_t* dst; int K, N, map, f8; const unsigned* cmax = nullptr; float* cs = nullptr; };
__device__ __forceinline__ void conv_tiles4(const ConvJob& j, int tile, int step, int ntl, float* T  ) {
    int tid_ = threadIdx.x; asm volatile("" : "+v"(tid_));
    const int ntn = (j.N + 63) >> 6, t = tid_;
    float4 v[4][2];
#pragma unroll
    for (int q = 0; q < 4; ++q) { const int tl = tile + q * step, tk = tl / ntn, tn = tl % ntn;
#pragma unroll
        for (int i = 0; i < 2; ++i) { const int kr = (t >> 4) + 32 * i, c4 = (t & 15) * 4, n = tn * 64 + c4;
            v[q][i] = make_float4(0.f, 0.f, 0.f, 0.f);
            if (tl < ntl && n < j.N) v[q][i] = *(const float4*)(j.src + (size_t)(tk * 64 + kr) * j.N + n); } }
    __syncthreads();
#pragma unroll
    for (int q = 0; q < 4; ++q)
#pragma unroll
        for (int i = 0; i < 2; ++i) { const int kr = (t >> 4) + 32 * i, c4 = (t & 15) * 4; float* Tq = T + q * (64 * 65);
            Tq[kr * 65 + c4 + 0] = v[q][i].x; Tq[kr * 65 + c4 + 1] = v[q][i].y; Tq[kr * 65 + c4 + 2] = v[q][i].z; Tq[kr * 65 + c4 + 3] = v[q][i].w; }
    __syncthreads();
#pragma unroll
    for (int q = 0; q < 4; ++q) { const int tl = tile + q * step, tk = tl / ntn, tn = tl % ntn; const float* Tq = T + q * (64 * 65);
        const int nl = t >> 3, ks = (t & 7) * 8, n = tn * 64 + nl;
        if (tl < ntl && n < j.N) {
            int nd = j.map == 0 ? n : ((n >> 7) * 256 + (n & 127) + (j.map == 2 ? 128 : 0)); bool f8 = j.f8 != 0;
            if (j.map == 3) {
                nd = n < 1120 ? n : PJ_RQ + (n - 1120);
                f8 = nd < PJ_F8; }
            if (j.cmax) {
                const float am = fmaxf(__uint_as_float(j.cmax[nd]), 1e-30f), qs = 127.f / am;
                int q[8];
#pragma unroll
                for (int i = 0; i < 8; ++i) q[i] = (int)rintf(Tq[(ks + i) * 65 + nl] * qs) & 255;
                *(uint2*)((unsigned char*)j.dst + (size_t)nd * j.K + tk * 64 + ks) = make_uint2((unsigned)(q[0] | (q[1] << 8) | (q[2] << 16) | (q[3] << 24)), (unsigned)(q[4] | (q[5] << 8) | (q[6] << 16) | (q[7] << 24)));
                if (tk == 0 && ks == 0) j.cs[nd] = am * (1.f / 127.f);
            } else if (f8) {
                int w0 = 0, w1 = 0;
                w0 = __builtin_amdgcn_cvt_pk_fp8_f32(f8clamp(Tq[(ks + 0) * 65 + nl] * F8_SW), f8clamp(Tq[(ks + 1) * 65 + nl] * F8_SW), w0, false);
                w0 = __builtin_amdgcn_cvt_pk_fp8_f32(f8clamp(Tq[(ks + 2) * 65 + nl] * F8_SW), f8clamp(Tq[(ks + 3) * 65 + nl] * F8_SW), w0, true);
                w1 = __builtin_amdgcn_cvt_pk_fp8_f32(f8clamp(Tq[(ks + 4) * 65 + nl] * F8_SW), f8clamp(Tq[(ks + 5) * 65 + nl] * F8_SW), w1, false);
                w1 = __builtin_amdgcn_cvt_pk_fp8_f32(f8clamp(Tq[(ks + 6) * 65 + nl] * F8_SW), f8clamp(Tq[(ks + 7) * 65 + nl] * F8_SW), w1, true);
                *(uint2*)((unsigned char*)j.dst + (size_t)nd * j.K + tk * 64 + ks) = make_uint2((unsigned)w0, (unsigned)w1);
            } else {
            unsigned w[4];
#pragma unroll
            for (int i = 0; i < 4; ++i) w[i] = (unsigned)f2bf(Tq[(ks + 2 * i) * 65 + nl]) | ((unsigned)f2bf(Tq[(ks + 2 * i + 1) * 65 + nl]) << 16);
            *(uint4*)(j.dst + (size_t)nd * j.K + tk * 64 + ks) = make_uint4(w[0], w[1], w[2], w[3]);
            }
        } }
}
__device__ __forceinline__ int conv_ntiles(int K, int N) { return (K >> 6) * ((N + 63) >> 6); }

#define CONV_F8 0
__device__ __forceinline__ void ph_conv_early(const P& p, float* lds) {
    const int G = gridDim.x, bid = blockIdx.x;
    int base = 0;
#define CONV_RUN(SRC, DST, K_, N_, MAP_) do { ConvJob j{SRC, DST, K_, N_, MAP_, CONV_F8}; const int nt_ = conv_ntiles(K_, N_), ns_ = (nt_ + 3) >> 2; \
          \
        for (int u = (((bid - base % G) + G) % G); u < ns_; u += G) conv_tiles4(j, 4 * u, 1, nt_, lds); base += ns_; } while (0)
    for (int l = 0; l < 2; ++l) {
        CONV_RUN(p.in[8] + (size_t)l * 1024 * IN_DIM, (bf16_t*)(p.ws + OFF_WIN) + (size_t)l * PROJ_LD * 1024, 1024, IN_DIM, 3);
        CONV_RUN(p.in[16] + (size_t)l * 1024 * 1024, (bf16_t*)(p.ws + OFF_WOUT) + (size_t)l * 1024 * 1024, 1024, 1024, 0);
        CONV_RUN(p.in[10] + (size_t)l * 192 * 384, (bf16_t*)(p.ws + OFF_WUQ) + (size_t)l * 384 * 192, 192, 384, 0);
        CONV_RUN(p.in[12] + (size_t)l * 128 * 512, (bf16_t*)(p.ws + OFF_WUKV) + (size_t)l * 512 * 128, 128, 512, 0);
    }
#undef CONV_F8
#define CONV_F8 1
    CONV_RUN(p.in[19], (bf16_t*)(p.ws + OFF_FD), D_FF, 1024, 0);
    for (int l = 0; l < 2; ++l) {
        uint4* z = (uint4*)((unsigned char*)((bf16_t*)(p.ws + OFF_WIN) + (size_t)l * PROJ_LD * 1024) + (size_t)1120 * 1024);
        const int n16 = (PJ_F8 - 1120) * 1024 / 16;
        for (int i = bid * NT + threadIdx.x; i < n16; i += G * NT) z[i] = make_uint4(0u, 0u, 0u, 0u);
    }
}
#undef CONV_F8
#define CONV_F8 1
__device__ __forceinline__ void ph_fgu_colmax(const P& p) {
    const int G = gridDim.x, bid = blockIdx.x;
    unsigned* cmax = (unsigned*)(p.ws + OFF_CMAX);
    for (int u = bid; u < 2 * 8 * 6; u += G) {
        const int mat = u / 48, kc = (u % 48) / 6, nc = u % 6, n = nc * 512 + (int)threadIdx.x;
        if (n < D_FF) { const float* s = (mat ? p.in[18] : p.in[17]) + (size_t)(kc * 128) * D_FF + n; float am = 0.f;
#pragma unroll 8
            for (int k = 0; k < 128; ++k) am = fmaxf(am, fabsf(s[(size_t)k * D_FF]));
            atomicMax(cmax + ((n >> 7) * 256 + (n & 127) + (mat ? 128 : 0)), __float_as_uint(am)); }
    }
}
__device__ __forceinline__ void ph_conv_fgu_i8(const P& p, float* lds) {
    const int G = gridDim.x, bid = blockIdx.x;
    int base = 0;
#define CONV_RUN_I8(SRC, MAP_) do { ConvJob j{SRC, (bf16_t*)(p.ws + OFF_FGU), 1024, D_FF, MAP_, 0, (const unsigned*)(p.ws + OFF_CMAX), (float*)(p.ws + OFF_CS8)}; const int nt_ = conv_ntiles(1024, D_FF), ns_ = (nt_ + 3) >> 2; \
        for (int u = (((bid - base % G) + G) % G); u < ns_; u += G) conv_tiles4(j, 4 * u, 1, nt_, lds); base += ns_; } while (0)
    CONV_RUN_I8(p.in[17], 1);
    CONV_RUN_I8(p.in[18], 2);
#undef CONV_RUN_I8
}
__device__ __forceinline__ void ph_conv_late(const P& p, float* lds) {
    const int G = gridDim.x, bid = blockIdx.x;
    int base = 0;
    for (int e = 0; e < NEXP; ++e) {
        CONV_RUN(p.in[21] + (size_t)e * 1024 * D_FFE, (bf16_t*)(p.ws + OFF_MGU + (size_t)e * 2 * D_FFE * 1024), 1024, D_FFE, 1);
        CONV_RUN(p.in[22] + (size_t)e * 1024 * D_FFE, (bf16_t*)(p.ws + OFF_MGU + (size_t)e * 2 * D_FFE * 1024), 1024, D_FFE, 2);
        CONV_RUN(p.in[23] + (size_t)e * D_FFE * 1024, (bf16_t*)(p.ws + OFF_MD + (size_t)e * 1024 * D_FFE), D_FFE, 1024, 0);
    }
}

namespace pg8 {
#define PG8_LAS __attribute__((address_space(3)))
typedef short bf16x8 __attribute__((ext_vector_type(8)));
typedef float f32x4 __attribute__((ext_vector_type(4)));
typedef unsigned u32x4 __attribute__((ext_vector_type(4)));
typedef int i32x4v __attribute__((ext_vector_type(4)));
constexpr int BM = 256, BK = 64, HALF = 128, HTB = HALF * BK * 2, STAGE_BYTES = 8 * HTB, NXCD = 8, WGM = 8;

__host__ __device__ __forceinline__ int lds_byte(int r, int c) { const int st = (r >> 4) * 2 + (c >> 5), rr = r & 15, cc = c & 31, ob = rr * 64 + cc * 2; return st * 1024 + (ob ^ (((ob >> 9) & 1) << 5)); }
__host__ __device__ __forceinline__ void stage_rc(int b, int& R, int& C) { const int st = b / 1024, sb = b % 1024, swz = sb ^ (((sb >> 9) & 1) << 5); R = (st >> 1) * 16 + swz / 64; C = (st & 1) * 32 + (swz % 64) / 2; }
__host__ __device__ __forceinline__ int perm32(int rho) { const int n = rho >> 4, i = rho & 15; return 8 * (i >> 2) + 4 * n + (i & 3); }

struct Unit { int pm, pn, e, rl, kp, ri; };

__device__ __forceinline__ void static_order_L(int L, int nM, int nN, int& pm, int& pn) {
    const int nwg = nM * nN;
    int wgid = L; { const int q = nwg / NXCD, r = nwg % NXCD, xcd = wgid % NXCD, off = wgid / NXCD; wgid = (xcd < r ? xcd * (q + 1) : r * (q + 1) + (xcd - r) * q) + off; }
    const int nig = WGM * nN, gid = wgid / nig, fm = gid * WGM, gsz = (nM - fm) < WGM ? (nM - fm) : WGM;
    pm = fm + ((wgid % nig) % gsz); pn = (wgid % nig) / gsz;
}
__device__ __forceinline__ bool static_order(int i, int G, int c, int nM, int nN, int& pm, int& pn) {
    const int nwg = nM * nN; const long L = (long)i * G + c; if (L >= nwg) return false;
    static_order_L((int)L, nM, nN, pm, pn); return true;
}

template <bool FP8_, bool I8_ = false> struct DenseSchedT {
    static constexpr bool GATHER = false, FP8 = FP8_, I8 = I8_;
    const bf16_t* A; const bf16_t* Bt; int lda, K, nM, nN, G, c; int L0 = 0, Lend = 1 << 30;
    __device__ __forceinline__ int nt() const { return K / BK; }
    __device__ __forceinline__ bool next(int i, Unit& u) const { u.e = 0; u.kp = 0; u.ri = 0; const long L = L0 + (long)i * G + c; const int nwg = nM * nN;
        if (L >= nwg || L >= Lend) return false; static_order_L((int)L, nM, nN, u.pm, u.pn); u.rl = u.pm; return true; }
    __device__ __forceinline__ const char* a_base(const Unit& u) const { return (const char*)A + (size_t)u.pm * BM * lda * 2; }
    __device__ __forceinline__ const char* b_base(const Unit& u) const { return (const char*)Bt + (size_t)u.pn * BM * K * 2; }
    __device__ __forceinline__ unsigned a_off(const Unit&, int r, int C) const { return (unsigned)(r * lda + C) * 2u; }
};
typedef DenseSchedT<false> DenseSched;
struct DenseSplitSched {
    static constexpr bool GATHER = false;
    const bf16_t* A; const bf16_t* Bt; int lda, K, pm0, nMs, nN, ways, ntp, G, c;
    __device__ __forceinline__ int nt() const { return ntp; }
    __device__ __forceinline__ bool next(int i, Unit& u) const {
        const long j = (long)i * G + c; if (j >= (long)nMs * nN * ways) return false;
        const int ui = (int)(j / ways); u.kp = (int)(j % ways) * ntp; u.ri = (int)j; u.pm = pm0 + ui / nN; u.pn = ui % nN; u.e = 0; u.rl = u.pm; return true;
    }
    __device__ __forceinline__ const char* a_base(const Unit& u) const { return (const char*)A + (size_t)u.pm * BM * lda * 2 + (size_t)u.kp * (BK * 2); }
    __device__ __forceinline__ const char* b_base(const Unit& u) const { return (const char*)Bt + (size_t)u.pn * BM * K * 2 + (size_t)u.kp * (BK * 2); }
    __device__ __forceinline__ unsigned a_off(const Unit&, int r, int C) const { return (unsigned)(r * lda + C) * 2u; }
};
template <bool GATHER_, bool FP8_ = false> struct MoeSched {
    static constexpr bool GATHER = GATHER_, FP8 = FP8_;
    const bf16_t* A; const bf16_t* Bt; int lda, K, nN, G, c; size_t bstride;
    const int* list;
    const PG8_LAS int* tab;
    int ulo, uhi, ways, ntp;
    __device__ __forceinline__ int nt() const { return ntp; }
    __device__ __forceinline__ bool next(int i, Unit& u) const {
        const int nM = __builtin_amdgcn_readfirstlane(tab[16]);
        const long j = (long)i * G + c; const int L = ulo + (int)(j / ways);
        if (L >= uhi) return false;
        u.kp = (int)(j % ways) * ntp; u.ri = (int)j;
        static_order_L(L, nM, nN, u.pm, u.pn);
        int e = 0, t0 = 0;
#pragma unroll
        for (int k = 1; k < 8; ++k) { const int tk = tab[8 + k]; if (u.pm >= tk) { e = k; t0 = tk; } }
        u.e = __builtin_amdgcn_readfirstlane(e); u.rl = u.pm - __builtin_amdgcn_readfirstlane(t0); return true;
    }
    __device__ __forceinline__ const char* a_base(const Unit& u) const { return (GATHER ? (const char*)A : (const char*)A + (size_t)u.pm * BM * lda * 2) + (size_t)u.kp * (BK * 2); }
    __device__ __forceinline__ const char* b_base(const Unit& u) const { return (const char*)(Bt + (size_t)u.e * bstride) + (size_t)u.pn * BM * K * 2 + (size_t)u.kp * (BK * 2); }
    __device__ __forceinline__ unsigned a_off(const Unit& u, int r, int C) const {
        if (!GATHER) return (unsigned)(r * lda + C) * 2u;
        const int lr = u.rl * BM + r, c1 = tab[u.e] - 1;
        const int tok = list[(size_t)u.e * 32768 + (lr < c1 ? lr : c1)];
        return (unsigned)(tok * lda + C) * 2u;
    }
};

__device__ __forceinline__ unsigned pk2(float lo, float hi) { typedef float f32x2_t __attribute__((ext_vector_type(2))); typedef __bf16 bf16x2_t __attribute__((ext_vector_type(2)));
    f32x2_t v = {lo, hi}; bf16x2_t b = __builtin_convertvector(v, bf16x2_t); return __builtin_bit_cast(unsigned, b); }

struct EpiBf16 {
    static constexpr bool PERM = true;
    bf16_t* O; int ldc;
    __device__ __forceinline__ void operator()(const f32x4 (&acc)[2][2][4][2], const Unit& u, int wr, int wc, int fr, int fq) const {
        const int row0 = u.pm * BM + wr * 64 + fr, col0 = u.pn * BM + wc * 32 + 8 * fq;
#pragma unroll
        for (int ai = 0; ai < 2; ++ai)
#pragma unroll
            for (int m = 0; m < 4; ++m) { bf16_t* rowp = O + (size_t)(row0 + ai * HALF + m * 16) * ldc + col0;
#pragma unroll
                for (int bj = 0; bj < 2; ++bj) { const f32x4 v0 = acc[ai][bj][m][0], v1 = acc[ai][bj][m][1];
                    u32x4 w; w[0] = pk2(v0[0], v0[1]); w[1] = pk2(v0[2], v0[3]); w[2] = pk2(v1[0], v1[1]); w[3] = pk2(v1[2], v1[3]);
                    *(u32x4*)(rowp + bj * HALF) = w; } }
    }
};
struct EpiBf16Norm {
    static constexpr bool PERM = true, HAS_POST = true;
    bf16_t* O; int ldc; unsigned obytes; unsigned* cnt; float sc;
    __device__ __forceinline__ void operator()(const f32x4 (&acc)[2][2][4][2], const Unit& u, int wr, int wc, int fr, int fq) const {
        const auto rsrc = __builtin_amdgcn_make_buffer_rsrc((void*)O, 0, (int)obytes, 0x00020000);
        const int row0 = u.pm * BM + wr * 64 + fr, col0 = u.pn * BM + wc * 32 + 8 * fq;
#pragma unroll
        for (int ai = 0; ai < 2; ++ai)
#pragma unroll
            for (int m = 0; m < 4; ++m) { const unsigned ro = (unsigned)((row0 + ai * HALF + m * 16) * ldc + col0) * 2u;
#pragma unroll
                for (int bj = 0; bj < 2; ++bj) { const f32x4 v0 = acc[ai][bj][m][0] * sc, v1 = acc[ai][bj][m][1] * sc;
                    u32x4 w; w[0] = pk2(v0[0], v0[1]); w[1] = pk2(v0[2], v0[3]); w[2] = pk2(v1[0], v1[1]); w[3] = pk2(v1[2], v1[3]);
                    __builtin_amdgcn_raw_buffer_store_b128(w, rsrc, ro + bj * HALF * 2, 0, 16); } }
    }
    __device__ __forceinline__ void post(const Unit& u) const {
        asm volatile("s_waitcnt vmcnt(0)" ::: "memory");
        if ((threadIdx.x & 63) == 0) __hip_atomic_fetch_add(cnt + 64 * u.pm, 1u, __ATOMIC_RELAXED, __HIP_MEMORY_SCOPE_AGENT);
    }
};
template <bool F8IN, bool F8> struct EpiSwigluT {
    static constexpr bool PERM = true;
    bf16_t* O; int ldc;
    __device__ __forceinline__ void operator()(const f32x4 (&acc)[2][2][4][2], const Unit& u, int wr, int wc, int fr, int fq) const {
        const int row0 = u.pm * BM + wr * 64 + fr, col0 = u.pn * HALF + wc * 32 + 8 * fq;
#pragma unroll
        for (int ai = 0; ai < 2; ++ai)
#pragma unroll
            for (int m = 0; m < 4; ++m) { bf16_t* rowp = O + (size_t)(row0 + ai * HALF + m * 16) * ldc + col0;
                float o[8];
                typedef float f32x2_t __attribute__((ext_vector_type(2)));
#pragma unroll
                for (int n = 0; n < 2; ++n)
#pragma unroll
                    for (int j = 0; j < 4; j += 2) {
                        f32x2_t gg = {acc[ai][0][m][n][j], acc[ai][0][m][n][j + 1]}, uu = {acc[ai][1][m][n][j], acc[ai][1][m][n][j + 1]};
                        if constexpr (F8IN) { gg = gg * (1.f / (F8_SH * F8_SW)); uu = uu * ((F8 ? F8_SA : 1.f) / (F8_SH * F8_SW)); } else if constexpr (F8) uu = uu * F8_SA;
                        const f32x2_t t = gg * (-1.4426950408889634f); f32x2_t e;
                        e[0] = __builtin_amdgcn_exp2f(t[0]); e[1] = __builtin_amdgcn_exp2f(t[1]);
                        e = e + 1.0f; f32x2_t r; r[0] = __builtin_amdgcn_rcpf(e[0]); r[1] = __builtin_amdgcn_rcpf(e[1]);
                        const f32x2_t v = (gg * uu) * r; o[n * 4 + j] = v[0]; o[n * 4 + j + 1] = v[1]; }
                if constexpr (F8) { int w0 = 0, w1 = 0;
                    w0 = __builtin_amdgcn_cvt_pk_fp8_f32(f8clamp(o[0]), f8clamp(o[1]), w0, false); w0 = __builtin_amdgcn_cvt_pk_fp8_f32(f8clamp(o[2]), f8clamp(o[3]), w0, true);
                    w1 = __builtin_amdgcn_cvt_pk_fp8_f32(f8clamp(o[4]), f8clamp(o[5]), w1, false); w1 = __builtin_amdgcn_cvt_pk_fp8_f32(f8clamp(o[6]), f8clamp(o[7]), w1, true);
                    typedef unsigned u32x2v __attribute__((ext_vector_type(2))); u32x2v w = {(unsigned)w0, (unsigned)w1};
                    *(u32x2v*)((unsigned char*)O + (size_t)(row0 + ai * HALF + m * 16) * ldc + col0) = w; }
                else { u32x4 w; w[0] = pk2(o[0], o[1]); w[1] = pk2(o[2], o[3]); w[2] = pk2(o[4], o[5]); w[3] = pk2(o[6], o[7]);
                *(u32x4*)rowp = w; } }
    }
};
typedef EpiSwigluT<false, false> EpiSwiglu;
struct EpiSwigluI8 {
    static constexpr bool PERM = true;
    bf16_t* O; int ldc; const float* rsc; const float* csc;
    __device__ __forceinline__ void operator()(const f32x4 (&acc)[2][2][4][2], const Unit& u, int wr, int wc, int fr, int fq) const {
        const int row0 = u.pm * BM + wr * 64 + fr, col0 = u.pn * HALF + wc * 32 + 8 * fq;
        const float* cg = csc + u.pn * BM + wc * 32 + 8 * fq;
        const f32x4 cg0 = *(const f32x4*)cg, cg1 = *(const f32x4*)(cg + 4), cu0 = *(const f32x4*)(cg + HALF), cu1 = *(const f32x4*)(cg + HALF + 4);
#pragma unroll
        for (int ai = 0; ai < 2; ++ai)
#pragma unroll
            for (int m = 0; m < 4; ++m) { const int row = row0 + ai * HALF + m * 16; const float rsv = rsc[row];
                float o[8];
#pragma unroll
                for (int n = 0; n < 2; ++n)
#pragma unroll
                    for (int j = 0; j < 4; ++j) {
                        const float gg = (float)__float_as_int(acc[ai][0][m][n][j]) * (rsv * (n ? cg1[j] : cg0[j])), uu = (float)__float_as_int(acc[ai][1][m][n][j]) * (rsv * F8_SA * (n ? cu1[j] : cu0[j]));
                        const float e = __builtin_amdgcn_exp2f(gg * (-1.4426950408889634f)) + 1.0f;
                        o[n * 4 + j] = (gg * uu) * __builtin_amdgcn_rcpf(e); }
                int w0 = 0, w1 = 0;
                w0 = __builtin_amdgcn_cvt_pk_fp8_f32(f8clamp(o[0]), f8clamp(o[1]), w0, false); w0 = __builtin_amdgcn_cvt_pk_fp8_f32(f8clamp(o[2]), f8clamp(o[3]), w0, true);
                w1 = __builtin_amdgcn_cvt_pk_fp8_f32(f8clamp(o[4]), f8clamp(o[5]), w1, false); w1 = __builtin_amdgcn_cvt_pk_fp8_f32(f8clamp(o[6]), f8clamp(o[7]), w1, true);
                typedef unsigned u32x2v __attribute__((ext_vector_type(2))); u32x2v w = {(unsigned)w0, (unsigned)w1};
                *(u32x2v*)((unsigned char*)O + (size_t)row * ldc + col0) = w; }
    }
};
struct EpiRes {
    static constexpr bool PERM = false;
    const float* in_lat; const float* in_ctx; float* out_lat; float* out_ctx; const float* modl; int goff;
    __device__ __forceinline__ void operator()(const f32x4 (&acc)[2][2][4][2], const Unit& u, int wr, int wc, int fr, int fq) const {
        const bool lat = u.pm < T_LAT / BM; const int r = lat ? (u.pm >> 4) : 8;
        const size_t rbase = (size_t)(lat ? u.pm : u.pm - T_LAT / BM) * BM + wr * 64 + fr;
        const float* src = (lat ? in_lat : in_ctx); float* dst = (lat ? out_lat : out_ctx);
        const int col0 = u.pn * BM + wc * 32 + 4 * fq;
        f32x4 gv[2][2];
#pragma unroll
        for (int bj = 0; bj < 2; ++bj)
#pragma unroll
            for (int n = 0; n < 2; ++n) gv[bj][n] = *(const f32x4*)(modl + r * 6144 + goff + col0 + bj * HALF + n * 16);
#pragma unroll
        for (int ai = 0; ai < 2; ++ai)
#pragma unroll
            for (int m = 0; m < 4; ++m) { const size_t ro = (rbase + ai * HALF + m * 16) * 1024 + col0;
#pragma unroll
                for (int bj = 0; bj < 2; ++bj)
#pragma unroll
                    for (int n = 0; n < 2; ++n) { const f32x4 x = *(const f32x4*)(src + ro + bj * HALF + n * 16);
                        *(f32x4*)(dst + ro + bj * HALF + n * 16) = x + gv[bj][n] * acc[ai][bj][m][n]; } }
    }
};
struct EpiBf16S {
    static constexpr bool PERM = true;
    bf16_t* O; int ldc; float sc;
    __device__ __forceinline__ void operator()(const f32x4 (&acc)[2][2][4][2], const Unit& u, int wr, int wc, int fr, int fq) const {
        const int row0 = u.pm * BM + wr * 64 + fr, col0 = u.pn * BM + wc * 32 + 8 * fq;
#pragma unroll
        for (int ai = 0; ai < 2; ++ai)
#pragma unroll
            for (int m = 0; m < 4; ++m) { bf16_t* rowp = O + (size_t)(row0 + ai * HALF + m * 16) * ldc + col0;
#pragma unroll
                for (int bj = 0; bj < 2; ++bj) { const f32x4 v0 = acc[ai][bj][m][0] * sc, v1 = acc[ai][bj][m][1] * sc;
                    u32x4 w; w[0] = pk2(v0[0], v0[1]); w[1] = pk2(v0[2], v0[3]); w[2] = pk2(v1[0], v1[1]); w[3] = pk2(v1[2], v1[3]);
                    *(u32x4*)(rowp + bj * HALF) = w; } }
    }
};
struct EpiPart {
    static constexpr bool PERM = false;
    float* PART;
    __device__ __forceinline__ void operator()(const f32x4 (&acc)[2][2][4][2], const Unit& u, int wr, int wc, int fr, int fq) const {
        float* tp = PART + (size_t)u.ri * 65536 + (wr * 64 + fr) * 256 + wc * 32 + 4 * fq;
#pragma unroll
        for (int ai = 0; ai < 2; ++ai)
#pragma unroll
            for (int m = 0; m < 4; ++m)
#pragma unroll
                for (int bj = 0; bj < 2; ++bj)
#pragma unroll
                    for (int n = 0; n < 2; ++n) *(f32x4*)(tp + (ai * HALF + m * 16) * 256 + bj * HALF + n * 16) = acc[ai][bj][m][n];
    }
};
__device__ __forceinline__ void moe_combine(bf16_t* YM, const float* PART, const PG8_LAS int* tab, int nN, float sc) {
    const int nTm = __builtin_amdgcn_readfirstlane(tab[16]), G = gridDim.x, U = nTm * nN, rem = U % G;
    if (!(rem > 0 && rem * MOE_WAYS <= G)) return;
    int tid_ = threadIdx.x; asm volatile("" : "+v"(tid_));
    const int umain = U - rem, wave = tid_ >> 6, lane = tid_ & 63;
    for (int task = blockIdx.x * 8 + wave; task < rem * 256; task += G * 8) {
        const int r = task >> 8, i = task & 255; int pm, pn; static_order_L(umain + r, nTm, nN, pm, pn);
        const float* pp = PART + (size_t)(r * MOE_WAYS) * 65536 + i * 256 + lane * 4;
        f32x4 s = *(const f32x4*)pp;
#pragma unroll
        for (int q = 1; q < MOE_WAYS; ++q) s = s + *(const f32x4*)(pp + q * 65536);
        s = s * sc;
        typedef unsigned u32x2v __attribute__((ext_vector_type(2))); u32x2v w = {pk2(s[0], s[1]), pk2(s[2], s[3])};
        *(u32x2v*)(YM + (size_t)(pm * BM + i) * 1024 + pn * BM + lane * 4) = w;
    }
}

template <class T, class = void> struct sched_i8 { static constexpr bool value = false; };
template <class T> struct sched_i8<T, decltype((void)T::I8)> { static constexpr bool value = T::I8; };
template <class T, class = void> struct sched_fp8 { static constexpr bool value = false; };
template <class T> struct sched_fp8<T, decltype((void)T::FP8)> { static constexpr bool value = T::FP8; };
template <class T, class = void> struct epi_has_post { static constexpr bool value = false; };
template <class T> struct epi_has_post<T, decltype((void)T::HAS_POST)> { static constexpr bool value = T::HAS_POST; };
template <class Epi, class Sched>
__device__ __forceinline__ void gemm_phase(PG8_LAS unsigned char* lds, const Sched& S, const Epi& E) {
    int tid_ = threadIdx.x; asm volatile("" : "+v"(tid_));
    const int tid = tid_, wid = __builtin_amdgcn_readfirstlane(tid >> 6), lane = tid & 63, wr = wid >> 2, wc = wid & 3, fr = lane & 15, fq = lane >> 4;
    const int K = S.K, nt = S.nt();
    int RA[2], CA[2]; unsigned voffB;
    { int R, C; stage_rc(tid * 16, R, C); const int Rb = Epi::PERM ? ((R & ~31) + perm32(R & 31)) : R;
      RA[0] = R; CA[0] = C; RA[1] = R + 64; CA[1] = C; voffB = (unsigned)(Rb * K + C) * 2u; }
    const unsigned incB = (unsigned)(64 * K * 2), incA = (unsigned)(64 * S.lda * 2);
    const unsigned kstep = (unsigned)(BK * 2);
    const unsigned hstepB = (unsigned)(HALF * K * 2);
    const auto rsA = __builtin_amdgcn_make_buffer_rsrc((void*)S.A, 0, 0x7fffffff, 0x00020000), rsB = __builtin_amdgcn_make_buffer_rsrc((void*)S.Bt, 0, 0x7fffffff, 0x00020000);
    const unsigned ldsw = (unsigned)wid * 1024u;
    const int aoff = lds_byte(wr * 64 + fr, fq * 8), boff = lds_byte(wc * 32 + fr, fq * 8);
#define PG8_SA(b, h) (((b) * 2 + (h)) * HTB)
#define PG8_SB(b, h) ((4 + (b) * 2 + (h)) * HTB)
  \

#define PG8_STAGE_B(bufoff, soff) do { _Pragma("unroll") for (int _i = 0; _i < 2; ++_i) \
        __builtin_amdgcn_raw_ptr_buffer_load_lds(rsB, (PG8_LAS void*)(lds + (bufoff) + ldsw + _i * 8192), 16, voffB, (soff) + _i * incB, 0, 0); } while (0)
#define PG8_STAGE_A(bufoff, soff, h) do { _Pragma("unroll") for (int _i = 0; _i < 2; ++_i) { \
        if constexpr (Sched::GATHER) __builtin_amdgcn_raw_ptr_buffer_load_lds(rsA, (PG8_LAS void*)(lds + (bufoff) + ldsw + _i * 8192), 16, vA[h][_i], (soff), 0, 0); \
        else __builtin_amdgcn_raw_ptr_buffer_load_lds(rsA, (PG8_LAS void*)(lds + (bufoff) + ldsw + _i * 8192), 16, vA[0][0], (soff) + ((h) * 2 + _i) * incA, 0, 0); } } while (0)
#define PG8_LDA(dst, b, h) do { _Pragma("unroll") for (int m = 0; m < 4; ++m) _Pragma("unroll") for (int k = 0; k < 2; ++k) dst[m][k] = *(const PG8_LAS bf16x8*)(lds + PG8_SA(b, h) + aoff + m * 2048 + k * 1024); } while (0)
#define PG8_LDB(dst, b, h) do { _Pragma("unroll") for (int n = 0; n < 2; ++n) _Pragma("unroll") for (int k = 0; k < 2; ++k) dst[n][k] = *(const PG8_LAS bf16x8*)(lds + PG8_SB(b, h) + boff + n * 2048 + k * 1024); } while (0)
#define PG8_CAT8(x, y) __builtin_shufflevector(__builtin_bit_cast(i32x4v, x), __builtin_bit_cast(i32x4v, y), 0, 1, 2, 3, 4, 5, 6, 7)
#define PG8_MMA(ai, bj, At, Bt) do { __builtin_amdgcn_s_setprio(1); _Pragma("unroll") for (int m = 0; m < 4; ++m) _Pragma("unroll") for (int n = 0; n < 2; ++n) { \
        if constexpr (sched_fp8<Sched>::value)   \
              \
              \
            asm volatile("v_mfma_f32_16x16x128_f8f6f4 %0, %1, %2, %0" : "+v"(acc[ai][bj][m][n]) : "v"(PG8_CAT8(Bt[n][0], Bt[n][1])), "v"(PG8_CAT8(At[m][0], At[m][1]))); \
        else if constexpr (sched_i8<Sched>::value) { _Pragma("unroll") for (int k = 0; k < 2; ++k)   \
            acc[ai][bj][m][n] = __builtin_bit_cast(f32x4, __builtin_amdgcn_mfma_i32_16x16x64_i8(__builtin_bit_cast(i32x4v, Bt[n][k]), __builtin_bit_cast(i32x4v, At[m][k]), __builtin_bit_cast(i32x4v, acc[ai][bj][m][n]), 0, 0, 0)); } \
        else { _Pragma("unroll") for (int k = 0; k < 2; ++k) acc[ai][bj][m][n] = __builtin_amdgcn_mfma_f32_16x16x32_bf16(Bt[n][k], At[m][k], acc[ai][bj][m][n], 0, 0, 0); } } __builtin_amdgcn_s_setprio(0); } while (0)
#define PG8_WAIT_V(n) asm volatile("s_waitcnt vmcnt(" #n ")" ::: "memory")
#define PG8_WAIT_L(n) asm volatile("s_waitcnt lgkmcnt(" #n ")" ::: "memory")
#define PG8_BAR __builtin_amdgcn_s_barrier()
#define PG8_SCHED __builtin_amdgcn_sched_barrier(0)
#define PG8_AOFFS(dst, U) do { _Pragma("unroll") for (int _h = 0; _h < 2; ++_h) _Pragma("unroll") for (int _i = 0; _i < 2; ++_i) dst[_h][_i] = S.a_off(U, _h * HALF + RA[_i], CA[_i]); } while (0)
    Unit cur, nxt; int ui = 0;
    if (!S.next(0, cur)) return;
    f32x4 acc[2][2][4][2];
#pragma unroll
    for (int a = 0; a < 2; ++a)
#pragma unroll
        for (int b = 0; b < 2; ++b)
#pragma unroll
            for (int m = 0; m < 4; ++m)
#pragma unroll
                for (int n = 0; n < 2; ++n) acc[a][b][m][n] = (f32x4){0.f, 0.f, 0.f, 0.f};
    bf16x8 At[4][2], B0[2][2], B1[2][2];
    unsigned vA[2][2], vN[2][2];
    PG8_AOFFS(vA, cur);
    unsigned cA = (unsigned)(S.a_base(cur) - (const char*)S.A), cB = (unsigned)(S.b_base(cur) - (const char*)S.Bt);
    PG8_STAGE_B(PG8_SB(0, 0), cB); PG8_STAGE_B(PG8_SB(0, 1), cB + hstepB); PG8_STAGE_A(PG8_SA(0, 0), cA, 0); PG8_STAGE_A(PG8_SA(0, 1), cA, 1);
    if (wr == 1) PG8_BAR;
    PG8_WAIT_V(2); PG8_BAR;
    PG8_STAGE_B(PG8_SB(1, 0), cB + kstep); PG8_STAGE_A(PG8_SA(1, 0), cA + kstep, 0); PG8_STAGE_B(PG8_SB(1, 1), cB + hstepB + kstep);
    PG8_WAIT_V(6); PG8_BAR;
    for (;;) {
        const bool has_next = S.next(ui + 1, nxt);
        const unsigned nA = has_next ? (unsigned)(S.a_base(nxt) - (const char*)S.A) : cA, nB = has_next ? (unsigned)(S.b_base(nxt) - (const char*)S.Bt) : cB;
        for (int t = 0; t < nt; t += 2) {
            const bool last = (t == nt - 2);
            const bool sw = Sched::GATHER && last && has_next;
            if constexpr (Sched::GATHER) { if (sw) { PG8_AOFFS(vN, nxt); } }
            const unsigned a1 = cA + (unsigned)(t + 1) * kstep;
            const unsigned a2 = last ? nA : cA + (unsigned)(t + 2) * kstep, b2 = last ? nB : cB + (unsigned)(t + 2) * kstep;
            const unsigned a3 = a2 + kstep, b3 = b2 + kstep;
            PG8_LDB(B0, 0, 0); PG8_LDB(B1, 0, 1); PG8_SCHED; PG8_LDA(At, 0, 0); PG8_STAGE_A(PG8_SA(1, 1), a1, 1);
            if constexpr (Sched::GATHER) { if (sw) {
#pragma unroll
                for (int _h = 0; _h < 2; ++_h)
#pragma unroll
                    for (int _i = 0; _i < 2; ++_i) vA[_h][_i] = vN[_h][_i]; } }
            PG8_WAIT_V(8); PG8_WAIT_L(0); PG8_BAR; PG8_MMA(0, 0, At, B0); PG8_MMA(0, 1, At, B1); PG8_BAR; PG8_SCHED;
            PG8_LDA(At, 0, 1); PG8_STAGE_B(PG8_SB(0, 0), b2); PG8_STAGE_B(PG8_SB(0, 1), b2 + hstepB); PG8_STAGE_A(PG8_SA(0, 0), a2, 0);
            PG8_WAIT_V(8); PG8_WAIT_L(0); PG8_BAR; PG8_MMA(1, 0, At, B0); PG8_MMA(1, 1, At, B1); PG8_BAR; PG8_SCHED;
            PG8_LDB(B0, 1, 0); PG8_LDB(B1, 1, 1); PG8_SCHED; PG8_LDA(At, 1, 0); PG8_STAGE_A(PG8_SA(0, 1), a2, 1);
            PG8_WAIT_V(8); PG8_WAIT_L(0); PG8_BAR; PG8_MMA(0, 0, At, B0); PG8_MMA(0, 1, At, B1); PG8_BAR; PG8_SCHED;
            PG8_LDA(At, 1, 1); PG8_STAGE_B(PG8_SB(1, 0), b3); PG8_STAGE_B(PG8_SB(1, 1), b3 + hstepB); PG8_STAGE_A(PG8_SA(1, 0), a3, 0);
            PG8_WAIT_V(8); PG8_WAIT_L(0); PG8_BAR; PG8_MMA(1, 0, At, B0); PG8_MMA(1, 1, At, B1); PG8_BAR; PG8_SCHED;
        }
        if constexpr (sched_fp8<Sched>::value) asm volatile("s_nop 15\n\ts_nop 7" ::: "memory");
        if (wr == 0) PG8_BAR;
        { int te_ = threadIdx.x; asm volatile("" : "+v"(te_));
          E(acc, cur, wr, wc, te_ & 15, (te_ & 63) >> 4); }
        if constexpr (epi_has_post<Epi>::value) E.post(cur);
        if (!has_next) break;
#pragma unroll
        for (int a = 0; a < 2; ++a)
#pragma unroll
            for (int b = 0; b < 2; ++b)
#pragma unroll
                for (int m = 0; m < 4; ++m)
#pragma unroll
                    for (int n = 0; n < 2; ++n) acc[a][b][m][n] = (f32x4){0.f, 0.f, 0.f, 0.f};
        cur = nxt; cA = nA; cB = nB; ++ui;
        if (wr == 1) PG8_BAR;
    }
    PG8_WAIT_V(0);
    PG8_BAR;
#undef PG8_SA
#undef PG8_SB
#undef PG8_STAGE_A
#undef PG8_STAGE_B
#undef PG8_LDA
#undef PG8_LDB
#undef PG8_MMA
#undef PG8_CAT8
#undef PG8_WAIT_V
#undef PG8_WAIT_L
#undef PG8_BAR
#undef PG8_SCHED
#undef PG8_AOFFS
}
}

__device__ __forceinline__ float rope_inv(int i2, int dim) { return powf(10000.0f, -(float)i2 / (float)dim); }

__device__ __forceinline__ void ph_final(const P& p) {
    int tid_ = threadIdx.x; asm volatile("" : "+v"(tid_));
    const int wave = tid_ >> 6, lane = tid_ & 63;
    const float* gain = p.in[24];
    for (int row = blockIdx.x * 8 + wave; row < T_LAT; row += gridDim.x * 8) {
        float* src = p.out + (size_t)row * 1024;
        float4 v[4]; float ss = 0.f;
#pragma unroll
        for (int i = 0; i < 4; ++i) { v[i] = *(const float4*)(src + i * 256 + lane * 4); ss += v[i].x * v[i].x + v[i].y * v[i].y + v[i].z * v[i].z + v[i].w * v[i].w; }
        ss = wave_sum(ss);
        const float rs = rsqrtf(ss * (1.f / 1024.f) + NORM_EPS);
#pragma unroll
        for (int i = 0; i < 4; ++i) { const int col = i * 256 + lane * 4; const float4 g = *(const float4*)(gain + col);
            *(float4*)(src + col) = make_float4(v[i].x * rs * g.x, v[i].y * rs * g.y, v[i].z * rs * g.z, v[i].w * rs * g.w); }
    }
}


__device__ __forceinline__ void ph_final_moe(const P& p, const LAS int* tab0, const LAS int* tab1) {
    int tid_ = threadIdx.x; asm volatile("" : "+v"(tid_));
    const int wave = tid_ >> 6, lane = tid_ & 63;
    const float* gain = p.in[24];
    const bf16_t* YM0 = (const bf16_t*)(p.ws + OFF_YM); const bf16_t* YM1 = YM0 + (size_t)ACT_ROWS * 1024;
    const float* MODL = (const float*)(p.ws + OFF_MOD) + 9 * 6144 + 5120;
    int row = blockIdx.x * 8 + wave; const int stride = gridDim.x * 8;
    int4 ep = make_int4(0, 0, 0, 0), nep = ep; float2 ww = make_float2(0.f, 0.f), nww = ww;
    if (row < T_LAT) { const int* iv = (const int*)(p.ws + OFF_INV) + (size_t)row * 8; ep = *(const int4*)iv; ww = *(const float2*)(iv + 4); }
    for (; row < T_LAT; row += stride) {
        if (row + stride < T_LAT) { const int* iv = (const int*)(p.ws + OFF_INV) + (size_t)(row + stride) * 8; nep = *(const int4*)iv; nww = *(const float2*)(iv + 4); }
        const size_t r0 = (size_t)(tab0[8 + ep.x] * 256 + ep.y) * 1024, r1 = (size_t)(tab1[8 + ep.z] * 256 + ep.w) * 1024;
        float* src = p.out + (size_t)row * 1024;
        const float* gt = MODL + (row >> 12) * 6144;
        float4 v[4]; uint2 y0[4], y1[4]; float4 gg[4]; float ss = 0.f;
#pragma unroll
        for (int i = 0; i < 4; ++i) { const int col = i * 256 + lane * 4; v[i] = *(const float4*)(src + col); y0[i] = *(const uint2*)(YM0 + r0 + col); y1[i] = *(const uint2*)(YM1 + r1 + col); gg[i] = *(const float4*)(gt + col); }
#pragma unroll
        for (int i = 0; i < 4; ++i) {
            v[i].x += gg[i].x * (ww.x * __uint_as_float(y0[i].x << 16) + ww.y * __uint_as_float(y1[i].x << 16));
            v[i].y += gg[i].y * (ww.x * __uint_as_float(y0[i].x & 0xFFFF0000u) + ww.y * __uint_as_float(y1[i].x & 0xFFFF0000u));
            v[i].z += gg[i].z * (ww.x * __uint_as_float(y0[i].y << 16) + ww.y * __uint_as_float(y1[i].y << 16));
            v[i].w += gg[i].w * (ww.x * __uint_as_float(y0[i].y & 0xFFFF0000u) + ww.y * __uint_as_float(y1[i].y & 0xFFFF0000u));
            ss += v[i].x * v[i].x + v[i].y * v[i].y + v[i].z * v[i].z + v[i].w * v[i].w; }
        ss = wave_sum(ss);
        const float rs = rsqrtf(ss * (1.f / 1024.f) + NORM_EPS);
#pragma unroll
        for (int i = 0; i < 4; ++i) { const int col = i * 256 + lane * 4; const float4 g = *(const float4*)(gain + col);
            *(float4*)(src + col) = make_float4(v[i].x * rs * g.x, v[i].y * rs * g.y, v[i].z * rs * g.z, v[i].w * rs * g.w); }
        ep = nep; ww = nww;
    }
}
typedef short bf16x8_t __attribute__((ext_vector_type(8)));
typedef short s16x4_t __attribute__((ext_vector_type(4)));
typedef float f32x16_t __attribute__((ext_vector_type(16)));
typedef unsigned u32x4_t __attribute__((ext_vector_type(4)));
typedef float f32x4_t __attribute__((ext_vector_type(4)));
__device__ __forceinline__ s16x4_t lds_tr16(LAS const unsigned char* p) { typedef short v4i16_t __attribute__((ext_vector_type(4))); return __builtin_bit_cast(s16x4_t, __builtin_amdgcn_ds_read_tr16_b64_v4i16((LAS v4i16_t*)p)); }
__device__ __forceinline__ unsigned pkbf(float lo, float hi) { typedef float f32x2_t __attribute__((ext_vector_type(2))); typedef __bf16 bf16x2_t __attribute__((ext_vector_type(2)));
    f32x2_t v = {lo, hi}; bf16x2_t b = __builtin_convertvector(v, bf16x2_t); return __builtin_bit_cast(unsigned, b); }
__device__ __forceinline__ float max3f(float a, float b, float c) { return fmaxf(fmaxf(a, b), c); }

#define ATT_VP 192
#define ATT_THR 6.0f
template <int DQK, bool SWA, bool GQA = false>
__device__ __forceinline__ void attn_unit(LAS unsigned char* lds, const bf16_t* POST, const bf16_t* VBUF, int vld, bf16_t* MIX, int b, int q0, int qcol, int kcol, int vcol, int ocol,
                                          int band_lo, int band_hi, float sinkl2, float qscale, const float* sinkp, float sinkmul) {
    constexpr int KP = DQK * 2 + 16, NPK = DQK / 8, NKL = NPK / 4, STAGE = 128 * KP + 128 * ATT_VP, NS = DQK / 16;
    int tid_ = threadIdx.x; asm volatile("" : "+v"(tid_));
    const int tid = tid_, wid = __builtin_amdgcn_readfirstlane(tid >> 6), lane = tid & 63, r = lane & 31, h = lane >> 5;
    const int nb = (band_hi - band_lo) >> 7, ntiles = nb + 2;
    const int qw0 = GQA ? q0 + 32 * (wid & 1) : q0 + 32 * wid;
    const int qi = qw0 + r;
    const int qrow = tok_row(b, qi);
    if (GQA) { qcol += (wid >> 1) * 64; ocol += (wid >> 1) * 64; sinkl2 = sinkp[wid >> 1] * sinkmul; }
    bf16x8_t qf[NS];
    { const bf16_t* qp = POST + (size_t)qrow * POST_LD + qcol + 8 * h;
#pragma unroll
      for (int s = 0; s < NS; ++s) { float f[8]; unpack8(*(const uint4*)(qp + 16 * s), f);
          const unsigned w0 = pkbf(f[0] * qscale, f[1] * qscale), w1 = pkbf(f[2] * qscale, f[3] * qscale), w2 = pkbf(f[4] * qscale, f[5] * qscale), w3 = pkbf(f[6] * qscale, f[7] * qscale);
          qf[s] = __builtin_bit_cast(bf16x8_t, make_uint4(w0, w1, w2, w3)); } }
    f32x16_t O0, O1;
#pragma unroll
    for (int i = 0; i < 16; ++i) { O0[i] = 0.f; O1[i] = 0.f; }
    float m = SWA ? sinkl2 : -1e30f, l = 0.f;
    u32x4_t kreg[NKL], vreg[2];
    const int vrow = tid >> 3, vpc = tid & 7;
#define ATT_KS(t) ((t) < nb ? band_lo + 128 * (t) : SEQ + 128 * ((t) - nb))
#define ATT_LOAD(t) do { const int ks_ = ATT_KS(t); const bf16_t* base_ = POST + (size_t)tok_row(b, ks_) * POST_LD; \
        _Pragma("unroll") for (int i_ = 0; i_ < NKL; ++i_) { const int idx_ = tid + 512 * i_, row_ = idx_ / NPK, pc_ = idx_ % NPK; kreg[i_] = *(const u32x4_t*)(base_ + (size_t)row_ * POST_LD + kcol + pc_ * 8); } \
        const bf16_t* vbase_ = VBUF + (size_t)tok_row(b, ks_) * vld; \
        _Pragma("unroll") for (int i_ = 0; i_ < 2; ++i_) vreg[i_] = *(const u32x4_t*)(vbase_ + (size_t)(vrow + 64 * i_) * vld + vcol + vpc * 8); } while (0)
#define ATT_WRITE(buf) do { LAS unsigned char* kb_ = lds + (buf) * STAGE; LAS unsigned char* vb_ = kb_ + 128 * KP; \
        _Pragma("unroll") for (int i_ = 0; i_ < NKL; ++i_) { const int idx_ = tid + 512 * i_, row_ = idx_ / NPK, pc_ = idx_ % NPK; *(LAS u32x4_t*)(kb_ + row_ * KP + pc_ * 16) = kreg[i_]; } \
        _Pragma("unroll") for (int i_ = 0; i_ < 2; ++i_) *(LAS u32x4_t*)(vb_ + (vrow + 64 * i_) * ATT_VP + vpc * 16) = vreg[i_]; } while (0)
    const int koff = r * KP + 16 * h;
    const int voff = (4 * h + ((lane & 15) >> 2)) * ATT_VP + (16 * ((lane >> 4) & 1) + 4 * (lane & 3)) * 2;
    __syncthreads();
    ATT_LOAD(0); ATT_WRITE(0);
    __syncthreads();
    for (int t = 0; t < ntiles; ++t) {
        if (t + 1 < ntiles) ATT_LOAD(t + 1);
        LAS const unsigned char* kb = lds + (t & 1) * STAGE; LAS const unsigned char* vb = kb + 128 * KP;
        const int ks = ATT_KS(t);
        bool skip[2] = {false, false}, need_mask[2] = {false, false};
        if (SWA && t < nb) {
#pragma unroll
            for (int sub = 0; sub < 2; ++sub) { const int kb0 = ks + sub * 64, qlo = qw0, qhi = qlo + 31;
                skip[sub] = (kb0 > qhi + 128) || (kb0 + 63 < qlo - 128);
                need_mask[sub] = !((kb0 >= qhi - 128) && (kb0 + 63 <= qlo + 128)); }
        }
        f32x16_t S[4];
#pragma unroll
        for (int blk = 0; blk < 4; ++blk)
#pragma unroll
            for (int i = 0; i < 16; ++i) S[blk][i] = 0.f;
#pragma unroll
        for (int sub = 0; sub < 2; ++sub) {
            if (!skip[sub]) {
#pragma unroll
                for (int s = 0; s < NS; ++s) {
                    const bf16x8_t k0 = *(LAS const bf16x8_t*)(kb + (sub * 64) * KP + koff + 32 * s), k1 = *(LAS const bf16x8_t*)(kb + (sub * 64 + 32) * KP + koff + 32 * s);
                    S[2 * sub] = __builtin_amdgcn_mfma_f32_32x32x16_bf16(k0, qf[s], S[2 * sub], 0, 0, 0);
                    S[2 * sub + 1] = __builtin_amdgcn_mfma_f32_32x32x16_bf16(k1, qf[s], S[2 * sub + 1], 0, 0, 0);
                }
            }
        }
#pragma unroll
        for (int sub = 0; sub < 2; ++sub) {
            if (!skip[sub]) {
                const int kb0 = ks + sub * 64;
                f32x16_t& S0 = S[2 * sub]; f32x16_t& S1 = S[2 * sub + 1];
                bf16x8_t va[8];
#pragma unroll
                for (int g = 0; g < 4; ++g) { LAS const unsigned char* vp = vb + (sub * 64 + 16 * g) * ATT_VP + voff;
                    const s16x4_t l0 = lds_tr16(vp), h0 = lds_tr16(vp + 8 * ATT_VP), l1 = lds_tr16(vp + 64), h1 = lds_tr16(vp + 8 * ATT_VP + 64);
                    va[2 * g] = __builtin_shufflevector(l0, h0, 0, 1, 2, 3, 4, 5, 6, 7); va[2 * g + 1] = __builtin_shufflevector(l1, h1, 0, 1, 2, 3, 4, 5, 6, 7); }
                if (SWA && need_mask[sub]) {
#pragma unroll
                    for (int i = 0; i < 16; ++i) { const int d0 = kb0 + (i & 3) + 8 * (i >> 2) + 4 * h - qi, d1 = d0 + 32;
                        if (d0 > 128 || d0 < -128) S0[i] = -1e30f;
                        if (d1 > 128 || d1 < -128) S1[i] = -1e30f; }
                }
                float mx = max3f(S0[0], S0[1], S1[0]), mx2 = max3f(S0[2], S0[3], S1[1]);
                mx = max3f(mx, S1[2], S1[3]);
#pragma unroll
                for (int i = 4; i < 16; i += 4) { mx = max3f(mx, S0[i], S0[i + 1]); mx2 = max3f(mx2, S0[i + 2], S0[i + 3]); mx = max3f(mx, S1[i], S1[i + 1]); mx2 = max3f(mx2, S1[i + 2], S1[i + 3]); }
                mx = fmaxf(mx, mx2);
                { const auto rr_ = __builtin_amdgcn_permlane32_swap(__float_as_uint(mx), __float_as_uint(mx), false, false); mx = fmaxf(__uint_as_float(rr_[0]), __uint_as_float(rr_[1])); }
                if (__any(mx > m + ATT_THR)) {
                    const float mn = fmaxf(m, mx), al = __builtin_amdgcn_exp2f(m - mn);
                    m = mn; l *= al;
#pragma unroll
                    for (int i = 0; i < 16; ++i) { O0[i] *= al; O1[i] *= al; }
                }
                typedef float f32x2_t __attribute__((ext_vector_type(2)));
                const f32x2_t m2 = {m, m}; f32x2_t ps2 = {0.f, 0.f};
#pragma unroll
                for (int i = 0; i < 16; i += 2) {
                    f32x2_t a = (f32x2_t){S0[i], S0[i + 1]} - m2, c = (f32x2_t){S1[i], S1[i + 1]} - m2;
                    a[0] = __builtin_amdgcn_exp2f(a[0]); a[1] = __builtin_amdgcn_exp2f(a[1]); c[0] = __builtin_amdgcn_exp2f(c[0]); c[1] = __builtin_amdgcn_exp2f(c[1]);
                    S0[i] = a[0]; S0[i + 1] = a[1]; S1[i] = c[0]; S1[i + 1] = c[1];
                    ps2 += a; ps2 += c;
                }
                l += ps2[0] + ps2[1];
#pragma unroll
                for (int g = 0; g < 4; ++g) { const f32x16_t& Sx = (g >> 1) ? S1 : S0; const int o8 = 8 * (g & 1);
                    const bf16x8_t pf = __builtin_bit_cast(bf16x8_t, make_uint4(pkbf(Sx[o8 + 0], Sx[o8 + 1]), pkbf(Sx[o8 + 2], Sx[o8 + 3]), pkbf(Sx[o8 + 4], Sx[o8 + 5]), pkbf(Sx[o8 + 6], Sx[o8 + 7])));
                    O0 = __builtin_amdgcn_mfma_f32_32x32x16_bf16(va[2 * g], pf, O0, 0, 0, 0);
                    O1 = __builtin_amdgcn_mfma_f32_32x32x16_bf16(va[2 * g + 1], pf, O1, 0, 0, 0);
                }
            }
        }
        if (t + 1 < ntiles) ATT_WRITE((t + 1) & 1);
        __syncthreads();
    }
#undef ATT_LOAD
#undef ATT_KS
#undef ATT_WRITE
    float lt = l + __shfl_xor(l, 32);
    if (SWA) lt += __builtin_amdgcn_exp2f(sinkl2 - m);
    const float inv = 1.f / lt;
    bf16_t* op = MIX + (size_t)qrow * 1024 + ocol + 4 * h;
#pragma unroll
    for (int g = 0; g < 4; ++g) {
        *(uint2*)(op + 8 * g) = make_uint2(pkbf(O0[4 * g] * inv, O0[4 * g + 1] * inv), pkbf(O0[4 * g + 2] * inv, O0[4 * g + 3] * inv));
        *(uint2*)(op + 32 + 8 * g) = make_uint2(pkbf(O1[4 * g] * inv, O1[4 * g + 1] * inv), pkbf(O1[4 * g + 2] * inv, O1[4 * g + 3] * inv));
    }
}


typedef int i32x8_t __attribute__((ext_vector_type(8)));
typedef int i32x4_t __attribute__((ext_vector_type(4)));
#define A8_KP 144
__device__ __forceinline__ i32x8_t lds_frag32(LAS const unsigned char* p) { const i32x4_t lo = *(LAS const i32x4_t*)p, hi = *(LAS const i32x4_t*)(p + 16); return __builtin_shufflevector(lo, hi, 0, 1, 2, 3, 4, 5, 6, 7); }
__device__ __forceinline__ int cvt4_f8(float a, float b, float c, float d) { return __builtin_amdgcn_cvt_pk_fp8_f32(c, d, __builtin_amdgcn_cvt_pk_fp8_f32(a, b, 0, false), true); }
__device__ __forceinline__ void attn_unit_f8(LAS unsigned char* lds, const unsigned char* QK8, const unsigned char* V8T, bf16_t* MIX, int b, int q0, int head, int band_lo, int band_hi, float qscale) {
    constexpr int STAGE = 128 * A8_KP + 64 * A8_KP;
    int tid_ = threadIdx.x; asm volatile("" : "+v"(tid_));
    const int tid = tid_, wid = __builtin_amdgcn_readfirstlane(tid >> 6), lane = tid & 63, r = lane & 31, h = lane >> 5;
    const int nb = (band_hi - band_lo) >> 7, ntiles = nb + 2;
    const int qi = q0 + 32 * wid + r, qrow = tok_row(b, qi);
    i32x8_t qf[2];
    { const unsigned char* qp = QK8 + (size_t)qrow * 1024 + head * 128 + 32 * h;
#pragma unroll
      for (int s = 0; s < 2; ++s) { const i32x4_t lo = *(const i32x4_t*)(qp + 64 * s), hi = *(const i32x4_t*)(qp + 64 * s + 16); qf[s] = __builtin_shufflevector(lo, hi, 0, 1, 2, 3, 4, 5, 6, 7); } }
    f32x16_t O0, O1;
#pragma unroll
    for (int i = 0; i < 16; ++i) { O0[i] = 0.f; O1[i] = 0.f; }
    float m = -1e30f;
    f32x16_t Ls;
#pragma unroll
    for (int i = 0; i < 16; ++i) Ls[i] = 0.f;
    const i32x8_t ones8 = {0x38383838, 0x38383838, 0x38383838, 0x38383838, 0x38383838, 0x38383838, 0x38383838, 0x38383838};
    u32x4_t kreg[2], vreg;
    const unsigned char* vbase = V8T + (size_t)((b * 4 + head) * 64 + (tid >> 3)) * 4352 + (tid & 7) * 16;
#define A8_KS(t) ((t) < nb ? band_lo + 128 * (t) : SEQ + 128 * ((t) - nb))
#define A8_LOAD(t) do { const int ks_ = A8_KS(t); const unsigned char* base_ = QK8 + (size_t)tok_row(b, ks_) * 1024 + 512 + head * 128; \
        _Pragma("unroll") for (int i_ = 0; i_ < 2; ++i_) { const int idx_ = tid + 512 * i_; kreg[i_] = *(const u32x4_t*)(base_ + (size_t)(idx_ >> 3) * 1024 + (idx_ & 7) * 16); } \
        vreg = *(const u32x4_t*)(vbase + ks_); } while (0)
#define A8_WRITE(buf) do { LAS unsigned char* kb_ = lds + (buf) * STAGE; \
        _Pragma("unroll") for (int i_ = 0; i_ < 2; ++i_) { const int idx_ = tid + 512 * i_; *(LAS u32x4_t*)(kb_ + (idx_ >> 3) * A8_KP + (idx_ & 7) * 16) = kreg[i_]; } \
        *(LAS u32x4_t*)(kb_ + 128 * A8_KP + (tid >> 3) * A8_KP + (tid & 7) * 16) = vreg; } while (0)
    const int foff = r * A8_KP + 32 * h;
    __syncthreads();
    A8_LOAD(0); A8_WRITE(0);
    __syncthreads();
    typedef float f32x2_t __attribute__((ext_vector_type(2)));
    const f32x2_t qs2 = {qscale, qscale};
    for (int t = 0; t < ntiles; ++t) {
        if (t + 1 < ntiles) A8_LOAD(t + 1);
        LAS const unsigned char* kb = lds + (t & 1) * STAGE; LAS const unsigned char* vb = kb + 128 * A8_KP;
        f32x16_t S[4];
#pragma unroll
        for (int blk = 0; blk < 4; ++blk)
#pragma unroll
            for (int i = 0; i < 16; ++i) S[blk][i] = 0.f;
#pragma unroll
        for (int blk = 0; blk < 4; ++blk)
#pragma unroll
            for (int s = 0; s < 2; ++s) S[blk] = __builtin_amdgcn_mfma_scale_f32_32x32x64_f8f6f4(lds_frag32(kb + (blk * 32) * A8_KP + foff + 64 * s), qf[s], S[blk], 0, 0, 0, 0, 0, 0);
#pragma unroll
        for (int sub = 0; sub < 2; ++sub) {
            f32x16_t& S0 = S[2 * sub]; f32x16_t& S1 = S[2 * sub + 1];
            const i32x8_t va0 = lds_frag32(vb + foff + 64 * sub), va1 = lds_frag32(vb + 32 * A8_KP + foff + 64 * sub);
            float mx = max3f(S0[0], S0[1], S1[0]), mx2 = max3f(S0[2], S0[3], S1[1]);
            mx = max3f(mx, S1[2], S1[3]);
#pragma unroll
            for (int i = 4; i < 16; i += 4) { mx = max3f(mx, S0[i], S0[i + 1]); mx2 = max3f(mx2, S0[i + 2], S0[i + 3]); mx = max3f(mx, S1[i], S1[i + 1]); mx2 = max3f(mx2, S1[i + 2], S1[i + 3]); }
            mx = fmaxf(mx, mx2);
            { const auto rr_ = __builtin_amdgcn_permlane32_swap(__float_as_uint(mx), __float_as_uint(mx), false, false); mx = fmaxf(__uint_as_float(rr_[0]), __uint_as_float(rr_[1])); }
            mx *= qscale;
            if (__any(mx > m + ATT_THR)) {
                const float mn = fmaxf(m, mx), al = __builtin_amdgcn_exp2f(m - mn);
                m = mn; Ls[0] *= al;
#pragma unroll
                for (int i = 0; i < 16; ++i) { O0[i] *= al; O1[i] *= al; }
            }
            const f32x2_t m2 = {-m, -m};
#pragma unroll
            for (int i = 0; i < 16; i += 2) {
                f32x2_t a = (f32x2_t){S0[i], S0[i + 1]} * qs2 + m2, c = (f32x2_t){S1[i], S1[i + 1]} * qs2 + m2;
                a[0] = __builtin_amdgcn_exp2f(a[0]); a[1] = __builtin_amdgcn_exp2f(a[1]); c[0] = __builtin_amdgcn_exp2f(c[0]); c[1] = __builtin_amdgcn_exp2f(c[1]);
                S0[i] = a[0]; S0[i + 1] = a[1]; S1[i] = c[0]; S1[i + 1] = c[1];
            }
            i32x8_t pf;
#pragma unroll
            for (int w = 0; w < 4; ++w) { pf[w] = cvt4_f8(S0[4 * w], S0[4 * w + 1], S0[4 * w + 2], S0[4 * w + 3]); pf[4 + w] = cvt4_f8(S1[4 * w], S1[4 * w + 1], S1[4 * w + 2], S1[4 * w + 3]); }
            O0 = __builtin_amdgcn_mfma_scale_f32_32x32x64_f8f6f4(va0, pf, O0, 0, 0, 0, 0, 0, 0);
            O1 = __builtin_amdgcn_mfma_scale_f32_32x32x64_f8f6f4(va1, pf, O1, 0, 0, 0, 0, 0, 0);
            Ls = __builtin_amdgcn_mfma_scale_f32_32x32x64_f8f6f4(ones8, pf, Ls, 0, 0, 0, 0, 0, 0);
        }
        if (t + 1 < ntiles) A8_WRITE((t + 1) & 1);
        __syncthreads();
    }
#undef A8_LOAD
#undef A8_KS
#undef A8_WRITE
    const float inv = 1.f / Ls[0];
    bf16_t* op = MIX + (size_t)qrow * 1024 + head * 64 + 4 * h;
#pragma unroll
    for (int g = 0; g < 4; ++g) {
        *(uint2*)(op + 8 * g) = make_uint2(pkbf(O0[4 * g] * inv, O0[4 * g + 1] * inv), pkbf(O0[4 * g + 2] * inv, O0[4 * g + 3] * inv));
        *(uint2*)(op + 32 + 8 * g) = make_uint2(pkbf(O1[4 * g] * inv, O1[4 * g + 1] * inv), pkbf(O1[4 * g + 2] * inv, O1[4 * g + 3] * inv));
    }
}
__device__ __forceinline__ float log2_sigmoid(float x) { return log2f(1.f / (1.f + expf(-x))); }

__device__ __forceinline__ void ph_ret_T(const P& p, int layer, LAS unsigned char* lds) {
    const bf16_t* POST = (const bf16_t*)(p.ws + OFF_POST); const bf16_t* PROJB = (const bf16_t*)(p.ws + OFF_PROJ);
    bf16_t* TT = (bf16_t*)(p.ws + OFF_TT);
    int tid_ = threadIdx.x; asm volatile("" : "+v"(tid_));
    const int tid = tid_, wid = __builtin_amdgcn_readfirstlane(tid >> 6), lane = tid & 63, h2 = lane >> 5;
    const int G = gridDim.x, bid = blockIdx.x;
    const int trq = (lane & 15) >> 2, trc = (16 * ((lane >> 4) & 1) + 4 * (lane & 3)) * 2;
    for (int u = bid; u < BATCH * 34 * 2; u += G) {
        const int hp = u & 1, c = (u >> 1) % 34, b = u / 68;
        const int row0 = c < 32 ? b * SEQ + c * 128 : T_LAT + b * CTXL + (c - 32) * 128;
        __syncthreads();
#pragma unroll
        for (int i = 0; i < 8; ++i) {
            const int idx = tid + 512 * i, arr = idx >> 10, rem = idx & 1023, row = rem >> 3, pc = rem & 7;
            const u32x4_t v = arr < 2 ? *(const u32x4_t*)(POST + (size_t)(row0 + row) * POST_LD + PC_RK + (2 * hp + (arr & 1)) * 64 + pc * 8)
                                      : *(const u32x4_t*)(PROJB + (size_t)(row0 + row) * PROJ_LD + PJ_RV + (2 * hp + (arr & 1)) * 64 + pc * 8);
            *(LAS u32x4_t*)(lds + arr * 24576 + row * 192 + pc * 16) = v;
        }
        __syncthreads();
        const int hh = wid >> 2, head = 2 * hp + hh, dir = (wid >> 1) & 1, dvb = wid & 1;
        const float lg = log2_sigmoid(dir ? p.in[15][layer * 4 + head] : p.in[14][layer * 4 + head]);
        f32x16_t acc0, acc1;
#pragma unroll
        for (int i = 0; i < 16; ++i) { acc0[i] = 0.f; acc1[i] = 0.f; }
        LAS const unsigned char* kt = lds + hh * 24576; LAS const unsigned char* vt = lds + (2 + hh) * 24576;
#pragma unroll
        for (int s = 0; s < 8; ++s) {
            const int kr = 16 * s + 8 * h2;
            LAS const unsigned char* vp = vt + (kr + trq) * 192 + dvb * 64 + trc;
            const s16x4_t vlo = lds_tr16(vp), vhi = lds_tr16(vp + 4 * 192);
            const bf16x8_t a = {vlo[0], vlo[1], vlo[2], vlo[3], vhi[0], vhi[1], vhi[2], vhi[3]};
            float w[8];
#pragma unroll
            for (int j = 0; j < 8; ++j) w[j] = __builtin_amdgcn_exp2f(lg * (float)(dir ? (kr + j) : (127 - kr - j)));
#pragma unroll
            for (int dkb = 0; dkb < 2; ++dkb) {
                LAS const unsigned char* kp = kt + (kr + trq) * 192 + dkb * 64 + trc;
                const s16x4_t klo = lds_tr16(kp), khi = lds_tr16(kp + 4 * 192);
                float f[8];
#pragma unroll
                for (int j = 0; j < 4; ++j) { f[j] = bf2f((bf16_t)klo[j]) * w[j]; f[4 + j] = bf2f((bf16_t)khi[j]) * w[4 + j]; }
                const bf16x8_t bb = __builtin_bit_cast(bf16x8_t, make_uint4(pkbf(f[0], f[1]), pkbf(f[2], f[3]), pkbf(f[4], f[5]), pkbf(f[6], f[7])));
                if (dkb == 0) acc0 = __builtin_amdgcn_mfma_f32_32x32x16_bf16(a, bb, acc0, 0, 0, 0);
                else acc1 = __builtin_amdgcn_mfma_f32_32x32x16_bf16(a, bb, acc1, 0, 0, 0);
            }
        }
        bf16_t* tp = TT + ((((size_t)(b * 4 + head) * 34 + c) * 2 + dir) * 4096) + (lane & 31);
#pragma unroll
        for (int i = 0; i < 16; ++i) { const int dv = 32 * dvb + (i & 3) + 8 * (i >> 2) + 4 * h2; tp[dv * 64] = f2bf(acc0[i]); tp[dv * 64 + 32] = f2bf(acc1[i]); }
    }
}

__device__ __forceinline__ void ret_unit(LAS unsigned char* lds, const P& p, int layer, int b, int c, int hp) {
    const bf16_t* POST = (const bf16_t*)(p.ws + OFF_POST); const bf16_t* PROJB = (const bf16_t*)(p.ws + OFF_PROJ);
    bf16_t* MIX = (bf16_t*)(p.ws + OFF_H);
    const bf16_t* TT = (const bf16_t*)(p.ws + OFF_TT);
    int tid_ = threadIdx.x; asm volatile("" : "+v"(tid_));
    const int tid = tid_, wid = __builtin_amdgcn_readfirstlane(tid >> 6), lane = tid & 63, r = lane & 31, h2 = lane >> 5;
    const bool isctx = c >= 32;
    const int row0 = !isctx ? b * SEQ + c * 128 : T_LAT + b * CTXL + (c - 32) * 128;
    constexpr int L_ST = 0, L_K = 36864, L_V = 73728;
    __syncthreads();
#pragma unroll
    for (int i = 0; i < 8; ++i) {
        const int idx = tid + 512 * i, arr = idx >> 10, rem = idx & 1023, row = rem >> 3, pc = rem & 7;
        const u32x4_t v = arr < 2 ? *(const u32x4_t*)(POST + (size_t)(row0 + row) * POST_LD + PC_RK + (2 * hp + (arr & 1)) * 64 + pc * 8)
                                      : *(const u32x4_t*)(PROJB + (size_t)(row0 + row) * PROJ_LD + PJ_RV + (2 * hp + (arr & 1)) * 64 + pc * 8);
        if (arr < 2) *(LAS u32x4_t*)(lds + L_K + (arr & 1) * 18432 + row * 144 + pc * 16) = v;
        else *(LAS u32x4_t*)(lds + L_V + (arr & 1) * 24576 + row * 192 + pc * 16) = v;
    }
    {
        const int hd = tid >> 7, hh = hd >> 1, dir = hd & 1, head = 2 * hp + hh;
        const float g128 = 128.f * log2_sigmoid(dir ? p.in[15][layer * 4 + head] : p.in[14][layer * 4 + head]);
        const bf16_t* tb = TT + (size_t)(b * 4 + head) * 34 * 2 * 4096 + dir * 4096 + (tid & 127) * 4;
        f32x4_t acc[8];
#pragma unroll
        for (int i = 0; i < 8; ++i) acc[i] = (f32x4_t){0.f, 0.f, 0.f, 0.f};
        int v0, v1;
        if (!isctx) { if (dir == 0) { v0 = -2; v1 = c - 1; } else { v0 = c + 1; v1 = 33; } }
        else { const int cc = c - 32; if (dir == 0) { v0 = -2; v1 = cc - 3; } else { v0 = 33 + cc; v1 = 33; } }
        for (int v = v0; v <= v1; ++v) {
            const int idxT = v < 0 ? 34 + v : v;
            const float coef = __builtin_amdgcn_exp2f(g128 * (float)(dir == 0 ? (v1 - v) : (v - v0)));
            const bf16_t* tp = tb + (size_t)idxT * 2 * 4096;
#pragma unroll
            for (int i = 0; i < 8; ++i) { const uint2 r_ = *(const uint2*)(tp + 512 * i);
                const f32x4_t x = {__uint_as_float(r_.x << 16), __uint_as_float(r_.x & 0xFFFF0000u), __uint_as_float(r_.y << 16), __uint_as_float(r_.y & 0xFFFF0000u)}; acc[i] += x * coef; }
        }
#pragma unroll
        for (int i = 0; i < 8; ++i) { const int e = (tid & 127) * 4 + 512 * i, dv = e >> 6, dk = e & 63;
            typedef unsigned u32x2_t __attribute__((ext_vector_type(2))); *(LAS u32x2_t*)(lds + L_ST + hd * 9216 + dv * 144 + dk * 2) = (u32x2_t){pkbf(acc[i][0], acc[i][1]), pkbf(acc[i][2], acc[i][3])}; }
    }
    __syncthreads();
    const int hh = wid >> 2, head = 2 * hp + hh, qb = wid & 3, qi = 32 * qb + r;
    const int qrow = row0 + qi;
    const float lgf = log2_sigmoid(p.in[14][layer * 4 + head]), lgb = log2_sigmoid(p.in[15][layer * 4 + head]);
    bf16x8_t qf[4];
    { const bf16_t* qp = POST + (size_t)qrow * POST_LD + PC_RQ + head * 64 + 8 * h2;
#pragma unroll
      for (int s = 0; s < 4; ++s) qf[s] = *(const bf16x8_t*)(qp + 16 * s); }
    f32x16_t O0, O1;
#pragma unroll
    for (int i = 0; i < 16; ++i) { O0[i] = 0.f; O1[i] = 0.f; }
    LAS const unsigned char* kt = lds + L_K + hh * 18432; LAS const unsigned char* vt = lds + L_V + hh * 24576;
    const int voff = (4 * h2 + ((lane & 15) >> 2)) * 192 + (16 * ((lane >> 4) & 1) + 4 * (lane & 3)) * 2;
#pragma unroll
    for (int blk = 0; blk < 4; ++blk) {
        f32x16_t S;
#pragma unroll
        for (int i = 0; i < 16; ++i) S[i] = 0.f;
#pragma unroll
        for (int s = 0; s < 4; ++s) { const bf16x8_t a = *(LAS const bf16x8_t*)(kt + (32 * blk + r) * 144 + 32 * s + 16 * h2); S = __builtin_amdgcn_mfma_f32_32x32x16_bf16(a, qf[s], S, 0, 0, 0); }
#pragma unroll
        for (int i = 0; i < 16; ++i) { const int d = qi - (32 * blk + (i & 3) + 8 * (i >> 2) + 4 * h2);
            const float w = d > 0 ? __builtin_amdgcn_exp2f(lgf * (float)d) : (d == 0 ? 2.f : __builtin_amdgcn_exp2f(lgb * (float)(-d)));
            S[i] *= w; }
#pragma unroll
        for (int s2 = 0; s2 < 2; ++s2) {
            const bf16x8_t pf = __builtin_bit_cast(bf16x8_t, make_uint4(pkbf(S[8 * s2 + 0], S[8 * s2 + 1]), pkbf(S[8 * s2 + 2], S[8 * s2 + 3]), pkbf(S[8 * s2 + 4], S[8 * s2 + 5]), pkbf(S[8 * s2 + 6], S[8 * s2 + 7])));
            LAS const unsigned char* vp = vt + (32 * blk + 16 * s2) * 192 + voff;
            const s16x4_t lo0 = lds_tr16(vp), hi0 = lds_tr16(vp + 8 * 192), lo1 = lds_tr16(vp + 64), hi1 = lds_tr16(vp + 8 * 192 + 64);
            const bf16x8_t a0 = {lo0[0], lo0[1], lo0[2], lo0[3], hi0[0], hi0[1], hi0[2], hi0[3]};
            const bf16x8_t a1 = {lo1[0], lo1[1], lo1[2], lo1[3], hi1[0], hi1[1], hi1[2], hi1[3]};
            O0 = __builtin_amdgcn_mfma_f32_32x32x16_bf16(a0, pf, O0, 0, 0, 0);
            O1 = __builtin_amdgcn_mfma_f32_32x32x16_bf16(a1, pf, O1, 0, 0, 0);
        }
    }
#pragma unroll
    for (int dir = 0; dir < 2; ++dir) {
        f32x16_t T0, T1;
#pragma unroll
        for (int i = 0; i < 16; ++i) { T0[i] = 0.f; T1[i] = 0.f; }
        LAS const unsigned char* st = lds + L_ST + (hh * 2 + dir) * 9216;
#pragma unroll
        for (int s = 0; s < 4; ++s) {
            const bf16x8_t a0 = *(LAS const bf16x8_t*)(st + r * 144 + 32 * s + 16 * h2), a1 = *(LAS const bf16x8_t*)(st + (32 + r) * 144 + 32 * s + 16 * h2);
            T0 = __builtin_amdgcn_mfma_f32_32x32x16_bf16(a0, qf[s], T0, 0, 0, 0);
            T1 = __builtin_amdgcn_mfma_f32_32x32x16_bf16(a1, qf[s], T1, 0, 0, 0);
        }
        const float coef = dir == 0 ? __builtin_amdgcn_exp2f(lgf * (float)(qi + 1)) : __builtin_amdgcn_exp2f(lgb * (float)(128 - qi));
#pragma unroll
        for (int i = 0; i < 16; ++i) { O0[i] += coef * T0[i]; O1[i] += coef * T1[i]; }
    }
    float ss = 0.f;
#pragma unroll
    for (int i = 0; i < 16; ++i) ss += O0[i] * O0[i] + O1[i] * O1[i];
    ss += __shfl_xor(ss, 32);
    const float rs = rsqrtf(ss * (1.f / 64.f) + NORM_EPS);
    const bf16_t* gp = PROJB + (size_t)qrow * PROJ_LD + PJ_RG + head * 64 + 4 * h2;
    bf16_t* op = MIX + (size_t)qrow * 1024 + 768 + head * 64 + 4 * h2;
#pragma unroll
    for (int g = 0; g < 4; ++g) {
        const uint2 g0 = *(const uint2*)(gp + 8 * g), g1 = *(const uint2*)(gp + 32 + 8 * g);
        float gv[8] = {__uint_as_float(g0.x << 16), __uint_as_float(g0.x & 0xFFFF0000u), __uint_as_float(g0.y << 16), __uint_as_float(g0.y & 0xFFFF0000u),
                       __uint_as_float(g1.x << 16), __uint_as_float(g1.x & 0xFFFF0000u), __uint_as_float(g1.y << 16), __uint_as_float(g1.y & 0xFFFF0000u)};
        float o[8];
#pragma unroll
        for (int j = 0; j < 4; ++j) { o[j] = O0[4 * g + j] * rs * silu_f(gv[j]); o[4 + j] = O1[4 * g + j] * rs * silu_f(gv[4 + j]); }
        *(uint2*)(op + 8 * g) = make_uint2(pkbf(o[0], o[1]), pkbf(o[2], o[3]));
        *(uint2*)(op + 32 + 8 * g) = make_uint2(pkbf(o[4], o[5]), pkbf(o[6], o[7]));
    }
}

__device__ __forceinline__ void ph_mixer_mfma(const P& p, int layer, bool ctxq, LAS unsigned char* lds) {
    const bf16_t* POST = (const bf16_t*)(p.ws + OFF_POST); const bf16_t* PROJB = (const bf16_t*)(p.ws + OFF_PROJ);
    bf16_t* MIX = (bf16_t*)(p.ws + OFF_H);
    const int G = gridDim.x, bid = blockIdx.x;
    const float L2E = 1.4426950408889634f;
    const int n_mla = BATCH * 4 * 16, n_swa = BATCH * 8 * 16, n_mlac = ctxq ? BATCH * 4 : 0, n_swac = ctxq ? BATCH * 8 : 0;
    const int n_ret = BATCH * 32 * 2, n_retc = ctxq ? BATCH * 2 * 2 : 0;
    const int total = n_mla + n_swa + n_mlac + n_swac + n_ret + n_retc;
    const int nmine = (total - bid + G - 1) / G;
    for (int k = 0; k < nmine; ++k) { const int u = bid + ((bid & 1) ? (nmine - 1 - k) : k) * G;
        if (u < n_mla) {
            const int qb = u & 15, h = (u >> 4) & 3, b = u >> 6;
            attn_unit_f8(lds, p.ws + OFF_QK8, p.ws + OFF_V8T, MIX, b, qb * 256, h, 0, SEQ, 0.10206207261596575f * L2E);
        } else if (u < n_mla + n_swa) {
            const int v = u - n_mla, qb = v & 63, kvh = (v >> 6) & 1, b = v >> 7;
            const int q0 = qb * 64; int lo = (q0 - 128) & ~127; lo = lo < 0 ? 0 : lo; int hi = (q0 + 192 + 127) & ~127; hi = hi > SEQ ? SEQ : hi;
            attn_unit<64, true, true>(lds, POST, PROJB, PROJ_LD, MIX, b, q0, PC_QB + kvh * 256, PC_KB + kvh * 64, 992 + kvh * 64, 256 + kvh * 256, lo, hi, 0.f, 0.125f * L2E, p.in[13] + layer * 8 + kvh * 4, L2E);
        } else if (u < n_mla + n_swa + n_mlac) {
            const int v = u - n_mla - n_swa, h = v & 3, b = v >> 2;
            attn_unit_f8(lds, p.ws + OFF_QK8, p.ws + OFF_V8T, MIX, b, SEQ, h, 0, 0, 0.10206207261596575f * L2E);
        } else if (u < n_mla + n_swa + n_mlac + n_swac) {
            const int v = u - n_mla - n_swa - n_mlac, qb = v & 3, kvh = (v >> 2) & 1, b = v >> 3;
            attn_unit<64, true, true>(lds, POST, PROJB, PROJ_LD, MIX, b, SEQ + qb * 64, PC_QB + kvh * 256, PC_KB + kvh * 64, 992 + kvh * 64, 256 + kvh * 256, 0, 0, 0.f, 0.125f * L2E, p.in[13] + layer * 8 + kvh * 4, L2E);
        } else if (u < n_mla + n_swa + n_mlac + n_swac + n_ret) {
            const int v = u - n_mla - n_swa - n_mlac - n_swac;
            ret_unit(lds, p, layer, v >> 6, (v >> 1) & 31, v & 1);
        } else {
            const int v = u - n_mla - n_swa - n_mlac - n_swac - n_ret;
            ret_unit(lds, p, layer, v >> 2, 32 + ((v >> 1) & 1), v & 1);
        }
    }
}

__device__ __forceinline__ void ph_tables(const P& p) {
    float2* tr = (float2*)(p.ws + OFF_TAB); float2* t32 = tr + 4096 * 32; float2* t16 = t32 + 64 * 16;
    const int n = 4096 * 32 + 64 * 16 + 64 * 8;
    for (int i = blockIdx.x * NT + threadIdx.x; i < n; i += gridDim.x * NT) {
        float ang;
        if (i < 4096 * 32) ang = (float)(i >> 5) * rope_inv(2 * (i & 31), 64);
        else if (i < 4096 * 32 + 64 * 16) { const int j = i - 4096 * 32; ang = (float)(j >> 4) * rope_inv(2 * (j & 15), 32); }
        else { const int j = i - 4096 * 32 - 64 * 16; ang = (float)(j >> 3) * rope_inv(2 * (j & 7), 16); }
        tr[i] = make_float2(cosf(ang), sinf(ang));
    }
}

__device__ __forceinline__ void ph_prep2(const P& p, int layer, LAS unsigned char* lds) {
    const bf16_t* PROJ = (const bf16_t*)(p.ws + OFF_PROJ);
    bf16_t* POST = (bf16_t*)(p.ws + OFF_POST);
    unsigned char* QK8 = p.ws + OFF_QK8; unsigned char* V8T = p.ws + OFF_V8T;
#define CVT4_F8(a_, b_, c_, d_) __builtin_amdgcn_cvt_pk_fp8_f32(f8clamp(c_), f8clamp(d_), __builtin_amdgcn_cvt_pk_fp8_f32(f8clamp(a_), f8clamp(b_), 0, false), true)
    const bf16_t* WUQ = (const bf16_t*)(p.ws + OFF_WUQ) + (size_t)layer * 384 * 192;
    const bf16_t* WUKV = (const bf16_t*)(p.ws + OFF_WUKV) + (size_t)layer * 512 * 128;
    const float* qn = p.in[9] + layer * 192; const float* kvn = p.in[11] + layer * 128;
    const float2* tab_ret = (const float2*)(p.ws + OFF_TAB); const float2* tab32 = tab_ret + 4096 * 32; const float2* tab16 = tab32 + 64 * 16;
    int tid_ = threadIdx.x; asm volatile("" : "+v"(tid_));
    const int tid = tid_, wid = __builtin_amdgcn_readfirstlane(tid >> 6), lane = tid & 63, fr = lane & 15, fq = lane >> 4;
    constexpr int QP = 400, KVP = 272, L_CQ = 0, L_CKV = 32 * QP;
    constexpr int SQP = 1040, L_SQ = L_CKV + 32 * KVP, L_SV = L_SQ + 32 * SQP;
#define PREP_LOADS(RA, RB, RC, RK, P1, P2, UNIT) do { const int R0_ = (UNIT) * 32; int tidA = tid; asm volatile("" : "+v"(tidA)); const int tk_ = tidA >> 4, sub_ = tidA & 15; \
        { const bf16_t* pr_ = PROJ + (size_t)(R0_ + tk_) * PROJ_LD; RA = *(const uint2*)(pr_ + sub_ * 12); RB = *(const uint2*)(pr_ + sub_ * 12 + 4); RC = *(const uint2*)(pr_ + sub_ * 12 + 8); RK = *(const u32x4_t*)(pr_ + 192 + sub_ * 8); } \
        _Pragma("unroll") for (int it_ = 0; it_ < 5; ++it_) { const int w_ = it_ * NT + tidA; \
            if (w_ < 32 * 74) { const int tok_ = w_ / 74, task_ = w_ % 74; int src_, dist_; \
                if (task_ < 40) { const int hd_ = task_ >> 2, half_ = (task_ >> 1) & 1, cp_ = task_ & 1; src_ = (task_ < 32 ? 352 : 864 - 8 * 64) + hd_ * 64 + half_ * 32 + cp_ * 8; dist_ = 16; } \
                else if (task_ < 72) { const int q_ = task_ - 40, hd_ = q_ >> 2, cp_ = q_ & 3; src_ = (hd_ < 4 ? PJ_RQ + hd_ * 64 : PJ_RK + (hd_ - 4) * 64) + cp_ * 8; dist_ = 32; } \
                else { src_ = 320 + (task_ - 72) * 16; dist_ = 8; } \
                const bf16_t* pr_ = PROJ + (size_t)(R0_ + tok_) * PROJ_LD + src_; P1[it_] = *(const u32x4_t*)pr_; P2[it_] = *(const u32x4_t*)(pr_ + dist_); } \
            else { P1[it_] = (u32x4_t){0u, 0u, 0u, 0u}; P2[it_] = P1[it_]; } } } while (0)
    uint2 ra, rb, rc, na_, nb_, nc_; u32x4_t rk, nk_; u32x4_t p1[5], p2[5], n1[5], n2[5];
    if ((int)blockIdx.x < T_ALL / 32) PREP_LOADS(ra, rb, rc, rk, p1, p2, (int)blockIdx.x);
    for (int u = blockIdx.x; u < T_ALL / 32; u += gridDim.x) {
        const int R0 = u * 32; const bool isctx = R0 >= T_LAT;
        const int t0 = isctx ? (R0 - T_LAT) % CTXL : R0 % SEQ;
        const int tk = tid >> 4, sub = tid & 15;
        const bool has_next = u + (int)gridDim.x < T_ALL / 32;
        if (has_next) PREP_LOADS(na_, nb_, nc_, nk_, n1, n2, u + (int)gridDim.x);
        __syncthreads();
        *(LAS u32x4_t*)(lds + L_SQ + tk * SQP + (sub >> 3) * 512 + ((sub >> 1) & 3) * 128 + 96 + (sub & 1) * 16) = (u32x4_t){0u, 0u, 0u, 0u};
        {
            float c[12], k[8];
            c[0] = __uint_as_float(ra.x << 16); c[1] = __uint_as_float(ra.x & 0xFFFF0000u); c[2] = __uint_as_float(ra.y << 16); c[3] = __uint_as_float(ra.y & 0xFFFF0000u);
            c[4] = __uint_as_float(rb.x << 16); c[5] = __uint_as_float(rb.x & 0xFFFF0000u); c[6] = __uint_as_float(rb.y << 16); c[7] = __uint_as_float(rb.y & 0xFFFF0000u);
            c[8] = __uint_as_float(rc.x << 16); c[9] = __uint_as_float(rc.x & 0xFFFF0000u); c[10] = __uint_as_float(rc.y << 16); c[11] = __uint_as_float(rc.y & 0xFFFF0000u);
            unpack8(make_uint4(rk[0], rk[1], rk[2], rk[3]), k);
            float s1 = 0.f, s2 = 0.f;
#pragma unroll
            for (int i = 0; i < 12; ++i) s1 += c[i] * c[i];
#pragma unroll
            for (int i = 0; i < 8; ++i) s2 += k[i] * k[i];
#pragma unroll
            for (int o = 1; o < 16; o <<= 1) { s1 += __shfl_xor(s1, o); s2 += __shfl_xor(s2, o); }
            const float r1 = rsqrtf(s1 * (1.f / 192.f) + NORM_EPS), r2 = rsqrtf(s2 * (1.f / 128.f) + NORM_EPS);
            typedef unsigned u32x2_t __attribute__((ext_vector_type(2)));
#pragma unroll
            for (int i = 0; i < 3; ++i) { const int e = sub * 12 + 4 * i;
                *(LAS u32x2_t*)(lds + L_CQ + tk * QP + e * 2) = (u32x2_t){pkbf(c[4 * i] * r1 * qn[e], c[4 * i + 1] * r1 * qn[e + 1]), pkbf(c[4 * i + 2] * r1 * qn[e + 2], c[4 * i + 3] * r1 * qn[e + 3])}; }
            { const int e = sub * 8;
              *(LAS u32x4_t*)(lds + L_CKV + tk * KVP + e * 2) = (u32x4_t){pkbf(k[0] * r2 * kvn[e], k[1] * r2 * kvn[e + 1]), pkbf(k[2] * r2 * kvn[e + 2], k[3] * r2 * kvn[e + 3]),
                                                                        pkbf(k[4] * r2 * kvn[e + 4], k[5] * r2 * kvn[e + 5]), pkbf(k[6] * r2 * kvn[e + 6], k[7] * r2 * kvn[e + 7])}; }
        }
        __syncthreads();
        {
            pg8::f32x4 acc[3][2];
#pragma unroll
            for (int a = 0; a < 3; ++a)
#pragma unroll
                for (int m = 0; m < 2; ++m) acc[a][m] = (pg8::f32x4){0.f, 0.f, 0.f, 0.f};
#pragma unroll
            for (int ks = 0; ks < 6; ++ks) {
                bf16x8_t af[2];
#pragma unroll
                for (int m = 0; m < 2; ++m) af[m] = *(LAS const bf16x8_t*)(lds + L_CQ + (m * 16 + fr) * QP + (32 * ks + 8 * fq) * 2);
#pragma unroll
                for (int a = 0; a < 3; ++a) {
                    const bf16x8_t bfrag = *(const bf16x8_t*)(WUQ + (size_t)((3 * wid + a) * 16 + fr) * 192 + 32 * ks + 8 * fq);
#pragma unroll
                    for (int m = 0; m < 2; ++m) acc[a][m] = __builtin_amdgcn_mfma_f32_16x16x32_bf16(bfrag, af[m], acc[a][m], 0, 0, 0);
                }
            }
#pragma unroll
            for (int a = 0; a < 3; ++a) {
                const int nt = 3 * wid + a, t6 = nt % 6, col = nt * 16 + 4 * fq;
#pragma unroll
                for (int m = 0; m < 2; ++m) {
                    const int tok = m * 16 + fr, t = t0 + tok;
                    pg8::f32x4 v = acc[a][m];
                    if (t6 >= 4) {
                        pg8::f32x4 pv; pv[0] = __shfl_xor(v[0], 32); pv[1] = __shfl_xor(v[1], 32); pv[2] = __shfl_xor(v[2], 32); pv[3] = __shfl_xor(v[3], 32);
                        if (!isctx) { const int pos = t6 == 4 ? (t >> 6) : (t & 63);
#pragma unroll
                            for (int j = 0; j < 4; ++j) { const float2 cs = tab16[pos * 8 + 4 * (fq & 1) + j]; v[j] = v[j] * cs.x + (fq < 2 ? -pv[j] : pv[j]) * cs.y; } }
                    }
                    *(LAS int*)(lds + L_SQ + tok * SQP + (nt / 6) * 128 + t6 * 16 + 4 * fq) = CVT4_F8(v[0], v[1], v[2], v[3]);
                }
            }
        }
        {
            pg8::f32x4 acc[4][2];
#pragma unroll
            for (int a = 0; a < 4; ++a)
#pragma unroll
                for (int m = 0; m < 2; ++m) acc[a][m] = (pg8::f32x4){0.f, 0.f, 0.f, 0.f};
#pragma unroll
            for (int ks = 0; ks < 4; ++ks) {
                bf16x8_t af[2];
#pragma unroll
                for (int m = 0; m < 2; ++m) af[m] = *(LAS const bf16x8_t*)(lds + L_CKV + (m * 16 + fr) * KVP + (32 * ks + 8 * fq) * 2);
#pragma unroll
                for (int a = 0; a < 4; ++a) {
                    const bf16x8_t bfrag = *(const bf16x8_t*)(WUKV + (size_t)((4 * wid + a) * 16 + fr) * 128 + 32 * ks + 8 * fq);
#pragma unroll
                    for (int m = 0; m < 2; ++m) acc[a][m] = __builtin_amdgcn_mfma_f32_16x16x32_bf16(bfrag, af[m], acc[a][m], 0, 0, 0);
                }
            }
#pragma unroll
            for (int a = 0; a < 4; ++a) {
                const int n = (4 * wid + a) * 16 + 4 * fq, hh = n >> 7, d = n & 127;
                const int dst = d < 64 ? PC_KA + hh * 96 + d : PC_VA + hh * 64 + (d - 64);
#pragma unroll
                for (int m = 0; m < 2; ++m) { const pg8::f32x4 v = acc[a][m]; const int row = R0 + m * 16 + fr;
                    const int w8 = CVT4_F8(v[0], v[1], v[2], v[3]);
                    const int tl = m * 16 + fr; (void)row;
                    if (d < 64) *(LAS int*)(lds + L_SQ + tl * SQP + 512 + hh * 128 + d) = w8;
                    else { LAS unsigned char* vp = lds + L_SV + (hh * 64 + (d - 64)) * 32 + 16 * ((tl >> 2) & 1) + 4 * (tl >> 3) + (tl & 3);
                        vp[0] = (unsigned char)w8; vp[32] = (unsigned char)(w8 >> 8); vp[64] = (unsigned char)(w8 >> 16); vp[96] = (unsigned char)((unsigned)w8 >> 24); } }
                (void)dst;
            }
        }
        int tidB = tid; asm volatile("" : "+v"(tidB));
#pragma unroll
        for (int it = 0; it < 5; ++it) {
            const int w = it * NT + tidB;
            if (w < 32 * 74) {
                const int tok = w / 74, task = w % 74, t = t0 + tok;
                bf16_t* po = POST + (size_t)(R0 + tok) * POST_LD;
                int dst, dist; const float2* tb; float scl = 1.f; bool bc = false;
                if (task < 40) { const int hd = task >> 2, half = (task >> 1) & 1, cp = task & 1;
                    dst = (task < 32 ? PC_QB : PC_KB - 8 * 64) + hd * 64 + half * 32 + cp * 8; dist = 16; tb = tab32 + (half ? (t & 63) : (t >> 6)) * 16 + cp * 8; }
                else if (task < 72) { const int q = task - 40, hd = q >> 2, cp = q & 3;
                    dst = PC_RQ + hd * 64 + cp * 8; dist = 32; tb = tab_ret + t * 32 + cp * 8; if (hd >= 4) scl = 0.125f; }
                else { const int half = task - 72; dst = PC_KA + 64 + half * 16; dist = 8; bc = true; tb = tab16 + (half ? (t & 63) : (t >> 6)) * 8; }
                float x1[8], x2[8]; unpack8(make_uint4(p1[it][0], p1[it][1], p1[it][2], p1[it][3]), x1); unpack8(make_uint4(p2[it][0], p2[it][1], p2[it][2], p2[it][3]), x2);
                if (!isctx) {
                    const float4 c0 = *(const float4*)(tb), c1 = *(const float4*)(tb + 2), c2 = *(const float4*)(tb + 4), c3 = *(const float4*)(tb + 6);
                    const float cs[8] = {c0.x, c0.z, c1.x, c1.z, c2.x, c2.z, c3.x, c3.z}, sn[8] = {c0.y, c0.w, c1.y, c1.w, c2.y, c2.w, c3.y, c3.w};
#pragma unroll
                    for (int j = 0; j < 8; ++j) { const float a = x1[j], b2 = x2[j]; x1[j] = a * cs[j] - b2 * sn[j]; x2[j] = b2 * cs[j] + a * sn[j]; }
                }
#pragma unroll
                for (int j = 0; j < 8; ++j) { x1[j] *= scl; x2[j] *= scl; }
                const uint4 o1 = make_uint4(pkbf(x1[0], x1[1]), pkbf(x1[2], x1[3]), pkbf(x1[4], x1[5]), pkbf(x1[6], x1[7]));
                const uint4 o2 = make_uint4(pkbf(x2[0], x2[1]), pkbf(x2[2], x2[3]), pkbf(x2[4], x2[5]), pkbf(x2[6], x2[7]));
                if (bc) {
                    LAS unsigned char* k8 = lds + L_SQ + tok * SQP + 512 + 64 + (task - 72) * 16;
                    typedef unsigned u32x2_t __attribute__((ext_vector_type(2)));
                    const uint2 f1 = make_uint2((unsigned)CVT4_F8(x1[0], x1[1], x1[2], x1[3]), (unsigned)CVT4_F8(x1[4], x1[5], x1[6], x1[7]));
                    const uint2 f2 = make_uint2((unsigned)CVT4_F8(x2[0], x2[1], x2[2], x2[3]), (unsigned)CVT4_F8(x2[4], x2[5], x2[6], x2[7]));
#pragma unroll
                    for (int hh = 0; hh < 4; ++hh) { *(LAS u32x2_t*)(k8 + hh * 128) = (u32x2_t){f1.x, f1.y}; *(LAS u32x2_t*)(k8 + hh * 128 + 8) = (u32x2_t){f2.x, f2.y}; }
                } else { *(uint4*)(po + dst) = o1; *(uint4*)(po + dst + dist) = o2; }
            }
        }
        __syncthreads();
        {
            const int rr = tid >> 4, pc = tid & 15;
            uint4* qd = (uint4*)(QK8 + (size_t)(R0 + rr) * 1024 + pc * 64);
#pragma unroll
            for (int j = 0; j < 4; ++j) { const u32x4_t t4 = *(LAS const u32x4_t*)(lds + L_SQ + rr * SQP + pc * 64 + j * 16); qd[j] = make_uint4(t4[0], t4[1], t4[2], t4[3]); }
            int bb, key0; if (R0 < T_LAT) { bb = R0 >> 12; key0 = R0 & (SEQ - 1); } else { bb = (R0 - T_LAT) >> 8; key0 = SEQ + ((R0 - T_LAT) & (CTXL - 1)); }
            const int vr = tid >> 1, hf = tid & 1;
            const u32x4_t t4 = *(LAS const u32x4_t*)(lds + L_SV + vr * 32 + hf * 16);
            *(uint4*)(V8T + (size_t)((bb * 4 + (vr >> 6)) * 64 + (vr & 63)) * 4352 + (key0 & ~63) + 32 * hf + 16 * ((key0 >> 5) & 1)) = make_uint4(t4[0], t4[1], t4[2], t4[3]);
        }
        if (has_next) { ra = na_; rb = nb_; rc = nc_; rk = nk_;
#pragma unroll
            for (int it = 0; it < 5; ++it) { p1[it] = n1[it]; p2[it] = n2[it]; } }
    }
#undef PREP_LOADS
#undef CVT4_F8
}
#define N_PHASES 23
#define LDS_BYTES 147456
#define LDS_MISC 131072
__device__ __forceinline__ P load_p() {
#if defined(__HIP_DEVICE_COMPILE__)
    const __attribute__((address_space(4))) P* kq = (const __attribute__((address_space(4))) P*)__builtin_amdgcn_kernarg_segment_ptr();
    asm volatile("" : "+s"(kq));
    return *kq;
#else
    return P{};
#endif
}
__global__ void __launch_bounds__(NT, 2) fwd_kernel(P p0, int lo, int hi) {
    extern __shared__ __attribute__((aligned(16))) unsigned char lds_raw[];
    float* lds = (float*)lds_raw;
    LAS unsigned char* ldsl = (LAS unsigned char*)lds_raw;
    volatile LAS unsigned* st = (volatile LAS unsigned*)(ldsl + LDS_MISC);
    if (threadIdx.x < 4) st[threadIdx.x] = 0u;
    __syncthreads();
    XcdBarrier bar; bar.bar = (unsigned*)(p0.ws + OFF_CTL); bar.x = 0; bar.st = st;
    if (hi - lo > 1) bar = xcd_barrier_post((unsigned*)(p0.ws + OFF_CTL), st);
#define IN(k) (lo <= (k) && (k) < hi)
#define PH(k) if (IN(k)) if (const P p = load_p(); true)
#define SEAM(k) do { if (IN(k) && IN((k) + 1)) xcd_barrier(bar); } while (0)
#define MOD ((const float*)(p.ws + OFF_MOD))
#define H ((bf16_t*)(p.ws + OFF_H))
#define XC ((float*)(p.ws + OFF_XC))
#define PROJ ((bf16_t*)(p.ws + OFF_PROJ))
#define ACT ((bf16_t*)(p.ws + OFF_ACT))
#define CNT ((int*)(p.ws + OFF_CNT))
#define LIST ((const int*)(p.ws + OFF_LIST))
#define WL ((const float*)(p.ws + OFF_WL))
#define WIN ((const bf16_t*)(p.ws + OFF_WIN))
#define WOUT ((const bf16_t*)(p.ws + OFF_WOUT))
#define FGU ((const bf16_t*)(p.ws + OFF_FGU))
#define FD ((const bf16_t*)(p.ws + OFF_FD))
#define MGU ((const bf16_t*)(p.ws + OFF_MGU))
#define MDW ((const bf16_t*)(p.ws + OFF_MD))
#define YB ((bf16_t*)(p.ws + OFF_Y))
#define YB2 ((bf16_t*)(p.ws + OFF_Y2))
#define PARTB ((float*)(p.ws + OFF_PART))
    const int G = gridDim.x, bid = blockIdx.x;

    PH(0) { ph_mod(p, lds); ph_tables(p); ph_conv_early(p, lds); ph_fgu_colmax(p); }
    SEAM(0);
    PH(1) { ph_norm(p, 0, 1, T_ALL, false, true, nullptr, 0, 0, 0, p.ws + OFF_QK8, true); __syncthreads(); ph_conv_fgu_i8(p, lds); }
    SEAM(1);
#define WINL WIN
    PH(2) {
        { pg8::DenseSched S{H, WINL + (size_t)PJ_F8 * 1024, 1024, 1024, T_ALL / 256, (PROJ_LD - PJ_F8) / 256, G, bid}; pg8::EpiBf16 E{PROJ + PJ_F8, PROJ_LD}; pg8::gemm_phase(ldsl, S, E); }
        const int U2 = (T_ALL / 256) * ((PROJ_LD - PJ_F8) / 256), U8 = (T_ALL / 256) * (PJ_F8 / 256), x3 = U2 - 2 * G;
        const pg8::EpiBf16S E8{PROJ, PROJ_LD, 1.f / (F8_SH * F8_SW)};
        if (x3 > 0 && x3 < G && 3 * (G - x3) <= U8 && U8 - 3 * (G - x3) <= x3) {
            if (bid >= x3) { pg8::DenseSchedT<true> S{(const bf16_t*)(p.ws + OFF_QK8), WINL, 512, 512, T_ALL / 256, PJ_F8 / 256, G - x3, bid - x3, 0, 3 * (G - x3)}; pg8::gemm_phase(ldsl, S, E8); }
            else { pg8::DenseSchedT<true> S{(const bf16_t*)(p.ws + OFF_QK8), WINL, 512, 512, T_ALL / 256, PJ_F8 / 256, x3, bid, 3 * (G - x3), U8}; pg8::gemm_phase(ldsl, S, E8); }
        } else { pg8::DenseSchedT<true> S{(const bf16_t*)(p.ws + OFF_QK8), WINL, 512, 512, T_ALL / 256, PJ_F8 / 256, G, bid}; pg8::gemm_phase(ldsl, S, E8); } }
#undef WINL
    SEAM(2);
    PH(3) ph_prep2(p, 0, ldsl);
    SEAM(3);
    PH(4) ph_ret_T(p, 0, ldsl);
    SEAM(4);
    PH(5) ph_mixer_mfma(p, 0, true, ldsl);
    SEAM(5);
    PH(6) {
        { pg8::DenseSched S{H, WOUT, 1024, 1024, T_ALL / 256, 4, G, bid};
          pg8::EpiBf16Norm E{YB, 1024, (unsigned)((size_t)T_ALL * 1024 * 2), (unsigned*)(p.ws + OFF_PCNT), 1.f};
          pg8::gemm_phase(ldsl, S, E); }
        norm_help(p, NormArgs{0, 2, false, true, YB, 0, 2048, 0, p.ws + OFF_H8D, false, (float*)(p.ws + OFF_RS8)}, (unsigned*)(p.ws + OFF_PCNT), 32u, (unsigned*)(p.ws + OFF_CLAIM), T_ALL / 256, (LAS unsigned*)(ldsl + LDS_MISC + 32));
    }
    SEAM(6);
    PH(8) { pg8::DenseSchedT<false, true> S{(const bf16_t*)(p.ws + OFF_H8D), FGU, 512, 512, T_ALL / 256, 2 * D_FF / 256, G, bid};
            pg8::EpiSwigluI8 E{ACT, D_FF, (const float*)(p.ws + OFF_RS8), (const float*)(p.ws + OFF_CS8)}; pg8::gemm_phase(ldsl, S, E); }
    SEAM(8);
    PH(9) {
        { pg8::DenseSchedT<true> S{ACT, FD, D_FF / 2, D_FF / 2, T_ALL / 256, 4, G, bid};
          pg8::EpiBf16Norm E{YB2, 1024, (unsigned)((size_t)T_ALL * 1024 * 2), (unsigned*)(p.ws + OFF_PCNT) + 136 * 64, 1.f / (F8_SA * F8_SW)};
          pg8::gemm_phase(ldsl, S, E); }
        norm_help(p, NormArgs{1, 1, false, false, YB2, 0, 5120, 0, p.ws + OFF_QK8, true}, (unsigned*)(p.ws + OFF_PCNT) + 136 * 64, 32u, (unsigned*)(p.ws + OFF_CLAIM) + 64, T_ALL / 256, (LAS unsigned*)(ldsl + LDS_MISC + 32));
    }
    SEAM(9);
#define WINL (WIN + (size_t)PROJ_LD * 1024)
    PH(11) {
        { pg8::DenseSched S{H, WINL + (size_t)PJ_F8 * 1024, 1024, 1024, T_ALL / 256, (PROJ_LD - PJ_F8) / 256, G, bid}; pg8::EpiBf16 E{PROJ + PJ_F8, PROJ_LD}; pg8::gemm_phase(ldsl, S, E); }
        const int U2 = (T_ALL / 256) * ((PROJ_LD - PJ_F8) / 256), U8 = (T_ALL / 256) * (PJ_F8 / 256), x3 = U2 - 2 * G;
        const pg8::EpiBf16S E8{PROJ, PROJ_LD, 1.f / (F8_SH * F8_SW)};
        if (x3 > 0 && x3 < G && 3 * (G - x3) <= U8 && U8 - 3 * (G - x3) <= x3) {
            if (bid >= x3) { pg8::DenseSchedT<true> S{(const bf16_t*)(p.ws + OFF_QK8), WINL, 512, 512, T_ALL / 256, PJ_F8 / 256, G - x3, bid - x3, 0, 3 * (G - x3)}; pg8::gemm_phase(ldsl, S, E8); }
            else { pg8::DenseSchedT<true> S{(const bf16_t*)(p.ws + OFF_QK8), WINL, 512, 512, T_ALL / 256, PJ_F8 / 256, x3, bid, 3 * (G - x3), U8}; pg8::gemm_phase(ldsl, S, E8); }
        } else { pg8::DenseSchedT<true> S{(const bf16_t*)(p.ws + OFF_QK8), WINL, 512, 512, T_ALL / 256, PJ_F8 / 256, G, bid}; pg8::gemm_phase(ldsl, S, E8); } }
#undef WINL
    SEAM(11);
    PH(12) ph_prep2(p, 1, ldsl);
    SEAM(12);
    PH(13) ph_ret_T(p, 1, ldsl);
    SEAM(13);
    PH(14) ph_mixer_mfma(p, 1, false, ldsl);
    SEAM(14);
    PH(15) { pg8::DenseSched S{H, WOUT + (size_t)1024 * 1024, 1024, 1024, T_LAT / 256, 4, G, bid}; pg8::EpiBf16 E{YB, 1024}; pg8::gemm_phase(ldsl, S, E); }
    SEAM(15);
    PH(16) { ph_norm(p, 1, 2, T_LAT, true, false, YB, 1, 2048, 0, p.ws + OFF_H, false); ph_conv_late(p, lds); }
    SEAM(16);
#pragma unroll
    for (int s = 0; s < 2; ++s) {
        if (IN(17 + 2 * s) || IN(18 + 2 * s)) {
            LAS int* tab = (LAS int*)(ldsl + LDS_MISC + 64 + 128 * s);
            { const P p = load_p();
            __syncthreads();
            if (threadIdx.x == 0) { int tbv = 0; tab[8] = 0;
                for (int e = 0; e < 8; ++e) { const int ce = __hip_atomic_load(CNT + s * 8 + e, __ATOMIC_RELAXED, __HIP_MEMORY_SCOPE_AGENT); tab[e] = ce; tbv += (ce + 255) >> 8; tab[9 + e] = tbv; } }
            __syncthreads(); }
            const int nTm = tab[16];
            PH(17 + 2 * s) {
                if (s == 1) pg8::moe_combine((bf16_t*)(p.ws + OFF_YM), PARTB, (const LAS int*)(ldsl + LDS_MISC + 64), 4, 1.f / (F8_SA * F8_SW));
                pg8::MoeSched<true, true> S{H, MGU, 512, 512, 2 * D_FFE / 256, G, bid, (size_t)D_FFE * 1024, LIST + (size_t)s * 8 * 32768, tab, 0, nTm * (2 * D_FFE / 256), 1, 512 / 64};
                pg8::EpiSwigluT<true, true> E{ACT, D_FFE}; pg8::gemm_phase(ldsl, S, E);
            }
            SEAM(17 + 2 * s);
            PH(18 + 2 * s) {
                const int U = nTm * 4, rem = U % G, split = (rem > 0 && rem * MOE_WAYS <= G) ? 1 : 0, umain = split ? U - rem : U;
                { pg8::MoeSched<false, true> S{ACT, MDW, D_FFE / 2, D_FFE / 2, 4, G, bid, (size_t)512 * D_FFE, nullptr, tab, 0, umain, 1, D_FFE / 128};
                  pg8::EpiBf16S E{(bf16_t*)(p.ws + OFF_YM) + (size_t)s * ACT_ROWS * 1024, 1024, 1.f / (F8_SA * F8_SW)};
                  pg8::gemm_phase(ldsl, S, E); }
                if (split) { pg8::MoeSched<false, true> S{ACT, MDW, D_FFE / 2, D_FFE / 2, 4, G, bid, (size_t)512 * D_FFE, nullptr, tab, umain, U, MOE_WAYS, D_FFE / 128 / MOE_WAYS};
                  pg8::EpiPart E{PARTB}; pg8::gemm_phase(ldsl, S, E); }
            }
        }
        SEAM(18 + 2 * s);
    }
    PH(21) { const LAS int* tab1 = (const LAS int*)(ldsl + LDS_MISC + 64 + 128);
        pg8::moe_combine((bf16_t*)(p.ws + OFF_YM) + (size_t)ACT_ROWS * 1024, PARTB, tab1, 4, 1.f / (F8_SA * F8_SW)); }
    SEAM(21);
    PH(22) ph_final_moe(p, (const LAS int*)(ldsl + LDS_MISC + 64), (const LAS int*)(ldsl + LDS_MISC + 64 + 128));
}

extern "C" void kernel_launch(void* const* d_in, const int* in_sizes, int n_in, void* d_out, int out_size, void* d_ws, size_t ws_size, hipStream_t stream) {
    static int grid = 0;
    if (!grid) {
        if (n_in != 25 || out_size != T_LAT * 1024 || ws_size < WS_END) { fprintf(stderr, "kernel_launch: unexpected shapes (n_in %d out %d ws %zu need %zu)\n", n_in, out_size, ws_size, (size_t)WS_END); grid = -1; return; }
        int dev = 0, cus = 0, per_cu = 0;
        (void)hipGetDevice(&dev); (void)hipDeviceGetAttribute(&cus, hipDeviceAttributeMultiprocessorCount, dev);
        (void)hipFuncSetAttribute((const void*)fwd_kernel, hipFuncAttributeMaxDynamicSharedMemorySize, LDS_BYTES);
        (void)hipOccupancyMaxActiveBlocksPerMultiprocessor(&per_cu, (const void*)fwd_kernel, NT, LDS_BYTES);
        if (per_cu < 1) { fprintf(stderr, "kernel_launch: occupancy query says %d\n", per_cu); }
        grid = cus > 0 ? cus : 256;
    }
    if (grid < 0) return;
    (void)hipMemsetAsync((char*)d_ws + OFF_CTL, 0, CTL_BYTES, stream);
    P p{};
    for (int i = 0; i < 25; ++i) p.in[i] = (const float*)d_in[i];
    p.out = (float*)d_out; p.ws = (unsigned char*)d_ws;
    hipLaunchKernelGGL(fwd_kernel, dim3(grid), dim3(NT), LDS_BYTES, stream, p, 0, N_PHASES);
}
```

```cpp
#include <hip/hip_runtime.h>
#include <stdint.h>
#include <stdio.h>

#define D_MODEL 1024
#define BATCH 8
#define SEQ 4096
#define CTXL 256
#define T_LAT (BATCH * SEQ)
#define T_CTX (BATCH * CTXL)
#define T_ALL (T_LAT + T_CTX)
#define IN_DIM 2144
#define PROJ_LD 2304
#define POST_LD 2816
#define D_FF 2816
#define D_FFE 3584
#define NEXP 8
#define NT 512
#define NORM_EPS 1e-6f

typedef unsigned short bf16_t;
__device__ __forceinline__ float bf2f(bf16_t v) { return __uint_as_float(((unsigned)v) << 16); }
__device__ __forceinline__ bf16_t f2bf(float f) { unsigned u = __float_as_uint(f); u += 0x7FFFu + ((u >> 16) & 1u); return (bf16_t)(u >> 16); }
__device__ __forceinline__ float silu_f(float v) { return v / (1.f + expf(-v)); }

#define PJ_RQ 1280
#define PJ_RK 1536
#define PJ_RV 1792
#define PJ_RG 2048
#define PJ_F8 1280
#define PC_QA 0
#define PC_KA 384
#define PC_VA 768
#define PC_QB 1024
#define PC_KB 1536
#define PC_VB 1664
#define PC_RQ 1792
#define PC_RK 2048
#define PC_RV 2304
#define PC_RG 2560

constexpr size_t AL256(size_t x) { return (x + 255) & ~(size_t)255; }
constexpr size_t OFF_CTL  = 0;
constexpr size_t CTL_BYTES = 262144;
constexpr size_t OFF_PCNT = 32768;
constexpr size_t OFF_CLAIM = 20480;
constexpr size_t OFF_CMAX = 196608;
constexpr size_t OFF_CS8  = OFF_CMAX + 5632 * 4;
constexpr size_t OFF_CNT  = 16384;
constexpr size_t OFF_MOD  = 1u << 20;
constexpr size_t OFF_TAB  = 3u << 19;
constexpr size_t OFF_WIN  = 3u << 20;
constexpr size_t OFF_WOUT = OFF_WIN + (size_t)2 * PROJ_LD * 1024 * 2;
constexpr size_t OFF_FGU  = OFF_WOUT + (size_t)2 * 1024 * 1024 * 2;
constexpr size_t OFF_FD   = OFF_FGU + (size_t)2 * D_FF * 1024 * 2;
constexpr size_t OFF_WUQ  = OFF_FD + (size_t)1024 * D_FF * 2;
constexpr size_t OFF_WUKV = OFF_WUQ + (size_t)2 * 384 * 192 * 2;
constexpr size_t OFF_H    = OFF_WUKV + (size_t)2 * 512 * 128 * 2;
constexpr size_t OFF_XC   = OFF_H + (size_t)T_ALL * 1024 * 2;
constexpr size_t OFF_LIST = OFF_XC + (size_t)T_CTX * 1024 * 4;
constexpr size_t OFF_WL   = OFF_LIST + (size_t)2 * 8 * 32768 * 4;
constexpr size_t OFF_R    = OFF_WL + (size_t)2 * 8 * 32768 * 4;
constexpr size_t OFF_PROJ = OFF_R;
constexpr size_t OFF_POST = OFF_PROJ + (size_t)T_ALL * PROJ_LD * 2;
constexpr size_t OFF_TT   = OFF_POST + (size_t)T_ALL * POST_LD * 2;
constexpr size_t R1_END   = OFF_TT + (size_t)BATCH * 4 * 34 * 2 * 4096 * 4;
constexpr size_t OFF_ACT  = OFF_R;
constexpr size_t OFF_Y    = OFF_PROJ;
constexpr size_t OFF_H8D  = OFF_ACT + (size_t)T_ALL * D_FF;
constexpr size_t OFF_RS8   = OFF_H8D + (size_t)T_ALL * 1024;
constexpr size_t OFF_Y2   = OFF_ACT + (size_t)T_ALL * D_FF * 2;
constexpr size_t ACT_ROWS = T_LAT + NEXP * 256;
constexpr size_t OFF_MGU  = OFF_ACT + ACT_ROWS * D_FFE;
constexpr size_t OFF_MD   = OFF_MGU + (size_t)NEXP * 2 * D_FFE * 1024;
constexpr size_t OFF_PART = OFF_MD + (size_t)NEXP * 1024 * D_FFE;
constexpr size_t PART_END = OFF_PART + (size_t)256 * 65536 * 4;
constexpr size_t OFF_YM   = PART_END;
constexpr size_t OFF_INV  = OFF_YM + (size_t)2 * ACT_ROWS * 1024 * 2;
constexpr size_t YM_END   = OFF_INV + (size_t)T_LAT * 32;
constexpr size_t OFF_QK8  = YM_END;
constexpr size_t OFF_V8T  = OFF_QK8 + (size_t)T_ALL * 1024;
constexpr size_t F8_END   = OFF_V8T + (size_t)BATCH * 4 * 64 * 4352;
constexpr size_t WS_END   = F8_END > R1_END ? F8_END : R1_END;
static_assert(R1_END <= WS_END, "phase-1 buffers fit");
static_assert(WS_END <= 607070848, "workspace budget");
static_assert(OFF_Y2 + (size_t)T_ALL * 1024 * 2 <= WS_END, "Y2 fits");
static_assert(OFF_MGU >= OFF_Y + (size_t)T_ALL * 1024 * 2, "expert weights are converted while norm2(L1) still reads Y");

struct P { const float* in[25]; float* out; unsigned char* ws; };

#define XB_TMO      128
#define XB_XCNT(j)  (256  + 64 * (j))
#define XB_XSUB(j)  (1280 + 64 * (j))
#define XB_XGEN(j)  (2304 + 64 * (j))
#define XB_TOP      3328
#define XB_TOPGEN   3392
#define XCD_BAR_WORDS 3456
#define XB_SPIN_CAP (1u << 22)
#define LAS __attribute__((address_space(3)))

__device__ __forceinline__ unsigned xb_ld(unsigned* p)              { return __hip_atomic_load(p, __ATOMIC_RELAXED, __HIP_MEMORY_SCOPE_AGENT); }
__device__ __forceinline__ unsigned xb_add(unsigned* p, unsigned v) { return __hip_atomic_fetch_add(p, v, __ATOMIC_RELAXED, __HIP_MEMORY_SCOPE_AGENT); }
__device__ __forceinline__ unsigned xb_xcc_id() { return (unsigned)__builtin_amdgcn_s_getreg((3 << 11) | 20) & 0xFu; }
#define XB_SPIN(cond, bar) do { unsigned _sp = 0; while (cond) { __builtin_amdgcn_s_sleep(1); \
    if ((++_sp & 255u) == 0u) { if (xb_ld(&(bar)[XB_TMO])) break; if (_sp > XB_SPIN_CAP) { atomicAdd(&(bar)[XB_TMO], 1u); break; } } } } while (0)

struct XcdBarrier { unsigned* bar; unsigned x; volatile LAS unsigned* st; };

__device__ __forceinline__ XcdBarrier xcd_barrier_post(unsigned* bar, volatile LAS unsigned* st) {
    XcdBarrier b; b.bar = bar; b.x = xb_xcc_id(); b.st = st;
    if (threadIdx.x == 0) (void)xb_add(&bar[XB_XCNT(b.x)], 1u);
    return b;
}
__device__ __forceinline__ void xcd_barrier_complete(unsigned* bar, unsigned x, unsigned& nloc, unsigned& nx) {
    const unsigned G = gridDim.x * gridDim.y * gridDim.z;
    unsigned sum, cnt, mine, sp = 0u;
    for (;;) {
        sum = 0u; cnt = 0u; mine = 0u;
#pragma unroll
        for (unsigned j = 0; j < 16; ++j) { const unsigned c = xb_ld(&bar[XB_XCNT(j)]); sum += c; cnt += (c > 0u) ? 1u : 0u; mine = (j == x) ? c : mine; }
        if (sum == G) break;
        __builtin_amdgcn_s_sleep(1);
        if ((++sp & 255u) == 0u) { if (xb_ld(&bar[XB_TMO])) break; if (sp > XB_SPIN_CAP) { atomicAdd(&bar[XB_TMO], 1u); break; } }
    }
    nloc = mine > 0u ? mine : 1u; nx = cnt > 0u ? cnt : 1u;
}
__device__ __forceinline__ void xcd_barrier(const XcdBarrier& b) {
    asm volatile("s_waitcnt vmcnt(0)" ::: "memory");
    __syncthreads();
    if (threadIdx.x == 0) {
        unsigned* bar = b.bar;
        __builtin_amdgcn_s_waitcnt(0);
        unsigned nloc = b.st[0], nx = b.st[1];
        if (nloc == 0u) { xcd_barrier_complete(bar, b.x, nloc, nx); b.st[0] = nloc; b.st[1] = nx; }
        const unsigned old = xb_add(&bar[XB_XSUB(b.x)], 1u);
        const unsigned gen = old / nloc;
        if (old + 1u == (gen + 1u) * nloc) {
            __builtin_amdgcn_fence(__ATOMIC_RELEASE, "agent");
            asm volatile("s_waitcnt vmcnt(0)" ::: "memory");
            const unsigned og = xb_add(&bar[XB_TOP], 1u);
            const unsigned tg = og / nx;
            if (og + 1u == (tg + 1u) * nx) xb_add(&bar[XB_TOPGEN], 1u);
            else XB_SPIN(xb_ld(&bar[XB_TOPGEN]) == tg, bar);
            __builtin_amdgcn_fence(__ATOMIC_ACQUIRE, "agent");
            xb_add(&bar[XB_XGEN(b.x)], 1u);
            asm volatile("s_waitcnt vmcnt(0)" ::: "memory");
        } else {
            XB_SPIN(xb_ld(&bar[XB_XGEN(b.x)]) == gen, bar);
            __builtin_amdgcn_fence(__ATOMIC_ACQUIRE, "agent");
            asm volatile("s_waitcnt vmcnt(0)" ::: "memory");
        }
    }
    __syncthreads();
}

__device__ __forceinline__ float wave_sum(float v) {
#pragma unroll
    for (int o = 32; o > 0; o >>= 1) v += __shfl_xor(v, o);
    return v;
}
__device__ __forceinline__ void unpack8(const uint4 r, float* f) {
    f[0] = __uint_as_float(r.x << 16); f[1] = __uint_as_float(r.x & 0xFFFF0000u);
    f[2] = __uint_as_float(r.y << 16); f[3] = __uint_as_float(r.y & 0xFFFF0000u);
    f[4] = __uint_as_float(r.z << 16); f[5] = __uint_as_float(r.z & 0xFFFF0000u);
    f[6] = __uint_as_float(r.w << 16); f[7] = __uint_as_float(r.w & 0xFFFF0000u);
}
__device__ __forceinline__ int tok_row(int b, int i) { return i < SEQ ? b * SEQ + i : T_LAT + b * CTXL + (i - SEQ); }

__device__ __forceinline__ void ph_mod(const P& p, float* lds) {
    float* MOD = (float*)(p.ws + OFF_MOD);
    float* sl = lds; float* part = lds + 9 * 1024;
    int tid_ = threadIdx.x; asm volatile("" : "+v"(tid_));
    const int t = tid_, col = t & 63, ks = t >> 6;
    __syncthreads();
    for (int i = t; i < 9 * 1024; i += NT) { const int r = i >> 10, k = i & 1023; sl[i] = silu_f(r < 8 ? p.in[1][r * 1024 + k] : p.in[3][k]); }
    __syncthreads();
    for (int u = blockIdx.x; u < 2 * 96; u += gridDim.x) {
        const int l = u / 96, n = (u % 96) * 64 + col;
        const float* w = p.in[4] + (size_t)l * 1024 * 6144 + (size_t)(ks * 128) * 6144 + n;
        float acc[9];
#pragma unroll
        for (int r = 0; r < 9; ++r) acc[r] = 0.f;
#pragma unroll 8
        for (int k = 0; k < 128; ++k) { const float wv = w[(size_t)k * 6144];
#pragma unroll
            for (int r = 0; r < 9; ++r) acc[r] += sl[r * 1024 + ks * 128 + k] * wv; }
        __syncthreads();
#pragma unroll
        for (int r = 0; r < 9; ++r) part[(ks * 9 + r) * 64 + col] = acc[r];
        __syncthreads();
        for (int i = t; i < 9 * 64; i += NT) { const int r = i >> 6, c2 = i & 63; float s = 0.f;
#pragma unroll
            for (int q = 0; q < 8; ++q) s += part[(q * 9 + r) * 64 + c2];
            const int nn = (u % 96) * 64 + c2; MOD[(l * 9 + r) * 6144 + nn] = s + p.in[5][l * 6144 + nn]; }
    }
}

#define F8_SH 8.f
#define F8_SW 64.f
#define F8_SA 4.f
#define MOE_WAYS 7
__device__ __forceinline__ float f8clamp(float x) { return fminf(fmaxf(x, -448.f), 448.f); }
struct NormArgs { int layer, which; bool router, from_input; const bf16_t* resY; int res_layer, res_goff, ctx_ways; unsigned char* h8; bool both; float* i8s = nullptr; };
__device__ __forceinline__ void norm_row(const P& p, const NormArgs& a, int row, int lane) {
    const int layer = a.layer, which = a.which, res_layer = a.res_layer, res_goff = a.res_goff, ctx_ways = a.ctx_ways; const bool router = a.router, from_input = a.from_input; const bf16_t* resY = a.resY;
    const float* MOD = (const float*)(p.ws + OFF_MOD);
    const float* gain = (which == 1 ? p.in[6] : p.in[7]) + layer * 1024;
    bf16_t* H = (bf16_t*)(p.ws + OFF_H);
    float* XC = (float*)(p.ws + OFF_XC);
    int* CNT = (int*)(p.ws + OFF_CNT);
    int* LIST = (int*)(p.ws + OFF_LIST);
    float* WL = (float*)(p.ws + OFF_WL);
    {
        const float* src; float* dstx; int r;
        if (row < T_LAT) { r = row >> 12; src = (from_input ? p.in[0] : p.out) + (size_t)row * 1024; dstx = p.out + (size_t)row * 1024; }
        else { r = 8; src = (from_input ? p.in[2] : XC) + (size_t)(row - T_LAT) * 1024; dstx = XC + (size_t)(row - T_LAT) * 1024; }
        const float* md = MOD + (layer * 9 + r) * 6144 + (which == 1 ? 0 : 3072);
        float4 v[4]; float ss = 0.f;
#pragma unroll
        for (int i = 0; i < 4; ++i) v[i] = *(const float4*)(src + i * 256 + lane * 4);
        if (resY) {
            const float* gt = MOD + (res_layer * 9 + r) * 6144 + res_goff;
#pragma unroll
            for (int i = 0; i < 4; ++i) { const int col = i * 256 + lane * 4;
                const float4 g = *(const float4*)(gt + col); float4 y;
                if (row >= T_LAT && ctx_ways > 0) {
                    const int cr = row - T_LAT; const float* pp = (const float*)(p.ws + OFF_PART) + (size_t)(((cr >> 8) * 4 + i) * ctx_ways) * 65536 + (cr & 255) * 256 + lane * 4;
                    y = *(const float4*)pp;
                    for (int q = 1; q < ctx_ways; ++q) { const float4 z = *(const float4*)(pp + (size_t)q * 65536); y.x += z.x; y.y += z.y; y.z += z.z; y.w += z.w; }
                } else { const uint2 yr = *(const uint2*)(resY + (size_t)row * 1024 + col);
                    y = make_float4(__uint_as_float(yr.x << 16), __uint_as_float(yr.x & 0xFFFF0000u), __uint_as_float(yr.y << 16), __uint_as_float(yr.y & 0xFFFF0000u)); }
                v[i].x += g.x * y.x; v[i].y += g.y * y.y; v[i].z += g.z * y.z; v[i].w += g.w * y.w;
                *(float4*)(dstx + col) = v[i]; }
        }
#pragma unroll
        for (int i = 0; i < 4; ++i) ss += v[i].x * v[i].x + v[i].y * v[i].y + v[i].z * v[i].z + v[i].w * v[i].w;
        ss = wave_sum(ss);
        const float rs = rsqrtf(ss * (1.f / 1024.f) + NORM_EPS);
        float lg[8] = {0.f, 0.f, 0.f, 0.f, 0.f, 0.f, 0.f, 0.f};
#pragma unroll
        for (int i = 0; i < 4; ++i) {
            const int col = i * 256 + lane * 4;
            const float4 g = *(const float4*)(gain + col), sh = *(const float4*)(md + col), sc = *(const float4*)(md + 1024 + col);
            float o[4];
            o[0] = (v[i].x * rs * g.x) * (1.f + sc.x) + sh.x; o[1] = (v[i].y * rs * g.y) * (1.f + sc.y) + sh.y;
            o[2] = (v[i].z * rs * g.z) * (1.f + sc.z) + sh.z; o[3] = (v[i].w * rs * g.w) * (1.f + sc.w) + sh.w;
            if (a.h8) {
                int w8 = 0; w8 = __builtin_amdgcn_cvt_pk_fp8_f32(f8clamp(o[0] * F8_SH), f8clamp(o[1] * F8_SH), w8, false); w8 = __builtin_amdgcn_cvt_pk_fp8_f32(f8clamp(o[2] * F8_SH), f8clamp(o[3] * F8_SH), w8, true);
                *(int*)(a.h8 + (size_t)row * 1024 + col) = w8;
            }
            if (!a.h8 || a.both) {
            uint2 pk; pk.x = (unsigned)f2bf(o[0]) | ((unsigned)f2bf(o[1]) << 16); pk.y = (unsigned)f2bf(o[2]) | ((unsigned)f2bf(o[3]) << 16);
            *(uint2*)(H + (size_t)row * 1024 + col) = pk; }
            if (router) {
                const float* rw = p.in[20] + (size_t)col * 8;
#pragma unroll
                for (int j = 0; j < 4; ++j) {
                    const float4 w0 = *(const float4*)(rw + j * 8), w1 = *(const float4*)(rw + j * 8 + 4);
                    lg[0] += o[j] * w0.x; lg[1] += o[j] * w0.y; lg[2] += o[j] * w0.z; lg[3] += o[j] * w0.w;
                    lg[4] += o[j] * w1.x; lg[5] += o[j] * w1.y; lg[6] += o[j] * w1.z; lg[7] += o[j] * w1.w;
                }
            }
        }
        if (router) {
#pragma unroll
            for (int e = 0; e < 8; ++e) lg[e] = wave_sum(lg[e]);
            if (lane == 0) {
                int e0 = 0; float v0 = lg[0];
#pragma unroll
                for (int e = 1; e < 8; ++e) if (lg[e] > v0) { v0 = lg[e]; e0 = e; }
                int e1 = -1; float v1 = -3.0e38f;
#pragma unroll
                for (int e = 0; e < 8; ++e) if (e != e0 && lg[e] > v1) { v1 = lg[e]; e1 = e; }
                const float x1 = expf(v1 - v0), inv = 1.f / (1.f + x1);
                const float w0 = inv, w1 = x1 * inv;
                const int p0 = atomicAdd(&CNT[e0], 1), p1 = atomicAdd(&CNT[8 + e1], 1);
                LIST[(size_t)e0 * 32768 + p0] = row; WL[(size_t)e0 * 32768 + p0] = w0;
                LIST[(size_t)(8 + e1) * 32768 + p1] = row; WL[(size_t)(8 + e1) * 32768 + p1] = w1;
                { int* iv = (int*)(p.ws + OFF_INV) + (size_t)row * 8; *(int4*)iv = make_int4(e0, p0, e1, p1); *(float2*)(iv + 4) = make_float2(w0, w1); }
            }
        }
    }
}
__device__ __forceinline__ void norm_rows4(const P& p, const NormArgs& a, int row0, int lane) {
    const float* MOD = (const float*)(p.ws + OFF_MOD);
    bf16_t* H = (bf16_t*)(p.ws + OFF_H); float* XC = (float*)(p.ws + OFF_XC);
    const bool lat = row0 < T_LAT; const int r = lat ? (row0 >> 12) : 8;
    const float* srcb = lat ? (a.from_input ? p.in[0] : p.out) + (size_t)row0 * 1024 : (a.from_input ? p.in[2] : XC) + (size_t)(row0 - T_LAT) * 1024;
    float* dstb = lat ? p.out + (size_t)row0 * 1024 : XC + (size_t)(row0 - T_LAT) * 1024;
    float4 v[4][4]; uint2 y[4][4];
#pragma unroll
    for (int q = 0; q < 4; ++q)
#pragma unroll
        for (int i = 0; i < 4; ++i) { v[q][i] = *(const float4*)(srcb + q * 1024 + i * 256 + lane * 4); y[q][i] = *(const uint2*)(a.resY + (size_t)(row0 + q) * 1024 + i * 256 + lane * 4); }
    const float* gt = MOD + (a.res_layer * 9 + r) * 6144 + a.res_goff;
    const float* md = MOD + (a.layer * 9 + r) * 6144 + (a.which == 1 ? 0 : 3072);
    const float* gain = (a.which == 1 ? p.in[6] : p.in[7]) + a.layer * 1024;
    float4 gg[4], gn[4], sh[4], sc[4];
#pragma unroll
    for (int i = 0; i < 4; ++i) { const int col = i * 256 + lane * 4; gg[i] = *(const float4*)(gt + col); gn[i] = *(const float4*)(gain + col); sh[i] = *(const float4*)(md + col); sc[i] = *(const float4*)(md + 1024 + col); }
#pragma unroll
    for (int q = 0; q < 4; ++q) {
        float ss = 0.f;
#pragma unroll
        for (int i = 0; i < 4; ++i) { const uint2 yr = y[q][i];
            v[q][i].x += gg[i].x * __uint_as_float(yr.x << 16); v[q][i].y += gg[i].y * __uint_as_float(yr.x & 0xFFFF0000u);
            v[q][i].z += gg[i].z * __uint_as_float(yr.y << 16); v[q][i].w += gg[i].w * __uint_as_float(yr.y & 0xFFFF0000u);
            *(float4*)(dstb + q * 1024 + i * 256 + lane * 4) = v[q][i];
            ss += v[q][i].x * v[q][i].x + v[q][i].y * v[q][i].y + v[q][i].z * v[q][i].z + v[q][i].w * v[q][i].w; }
        ss = wave_sum(ss);
        const float rs = rsqrtf(ss * (1.f / 1024.f) + NORM_EPS);
        if (a.i8s) {
            float oo[4][4]; float amax = 0.f;
#pragma unroll
            for (int i = 0; i < 4; ++i) {
                oo[i][0] = (v[q][i].x * rs * gn[i].x) * (1.f + sc[i].x) + sh[i].x; oo[i][1] = (v[q][i].y * rs * gn[i].y) * (1.f + sc[i].y) + sh[i].y;
                oo[i][2] = (v[q][i].z * rs * gn[i].z) * (1.f + sc[i].z) + sh[i].z; oo[i][3] = (v[q][i].w * rs * gn[i].w) * (1.f + sc[i].w) + sh[i].w;
                amax = fmaxf(fmaxf(amax, fmaxf(fabsf(oo[i][0]), fabsf(oo[i][1]))), fmaxf(fabsf(oo[i][2]), fabsf(oo[i][3]))); }
#pragma unroll
            for (int o_ = 1; o_ < 64; o_ <<= 1) amax = fmaxf(amax, __shfl_xor(amax, o_));
            amax = fmaxf(amax, 1e-20f);
            const float qs = 127.f / amax;
#pragma unroll
            for (int i = 0; i < 4; ++i) { const int q0 = (int)rintf(oo[i][0] * qs), q1 = (int)rintf(oo[i][1] * qs), q2 = (int)rintf(oo[i][2] * qs), q3 = (int)rintf(oo[i][3] * qs);
                *(int*)(a.h8 + (size_t)(row0 + q) * 1024 + i * 256 + lane * 4) = (int)((unsigned)(q0 & 255) | ((unsigned)(q1 & 255) << 8) | ((unsigned)(q2 & 255) << 16) | ((unsigned)q3 << 24)); }
            if (lane == 0) a.i8s[row0 + q] = amax * (1.f / 127.f);
        } else
#pragma unroll
        for (int i = 0; i < 4; ++i) { float o[4];
            o[0] = (v[q][i].x * rs * gn[i].x) * (1.f + sc[i].x) + sh[i].x; o[1] = (v[q][i].y * rs * gn[i].y) * (1.f + sc[i].y) + sh[i].y;
            o[2] = (v[q][i].z * rs * gn[i].z) * (1.f + sc[i].z) + sh[i].z; o[3] = (v[q][i].w * rs * gn[i].w) * (1.f + sc[i].w) + sh[i].w;
            if (a.h8) { int w8 = 0; w8 = __builtin_amdgcn_cvt_pk_fp8_f32(f8clamp(o[0] * F8_SH), f8clamp(o[1] * F8_SH), w8, false); w8 = __builtin_amdgcn_cvt_pk_fp8_f32(f8clamp(o[2] * F8_SH), f8clamp(o[3] * F8_SH), w8, true);
                *(int*)(a.h8 + (size_t)(row0 + q) * 1024 + i * 256 + lane * 4) = w8; }
            if (!a.h8 || a.both) { uint2 pk; pk.x = (unsigned)f2bf(o[0]) | ((unsigned)f2bf(o[1]) << 16); pk.y = (unsigned)f2bf(o[2]) | ((unsigned)f2bf(o[3]) << 16);
            *(uint2*)(H + (size_t)(row0 + q) * 1024 + i * 256 + lane * 4) = pk; } }
    }
}
__device__ __forceinline__ void norm_help(const P& p, const NormArgs& a, unsigned* cnt, unsigned need, unsigned* claim, int npanels, LAS unsigned* lw) {
    int tid_ = threadIdx.x; asm volatile("" : "+v"(tid_));
    const int wave = __builtin_amdgcn_readfirstlane(tid_ >> 6), lane = tid_ & 63;
    for (;;) {
        __syncthreads();
        if (threadIdx.x == 0) {
            const unsigned part = __hip_atomic_fetch_add(claim, 1u, __ATOMIC_RELAXED, __HIP_MEMORY_SCOPE_AGENT);
            if (part < (unsigned)npanels * 4u) {
                unsigned sp = 0;
                while (__hip_atomic_load(cnt + 64 * (part >> 2), __ATOMIC_RELAXED, __HIP_MEMORY_SCOPE_AGENT) < need) { __builtin_amdgcn_s_sleep(8); if (++sp > (1u << 22)) break; }
                __builtin_amdgcn_fence(__ATOMIC_ACQUIRE, "agent");
                asm volatile("s_waitcnt vmcnt(0)" ::: "memory");
            }
            lw[0] = part;
        }
        __syncthreads();
        const unsigned part = lw[0];
        if (part >= (unsigned)npanels * 4u) break;
        const int base = (int)(part >> 2) * 256 + (int)(part & 3u) * 64 + wave * 8;
        norm_rows4(p, a, base, lane); norm_rows4(p, a, base + 4, lane);
    }
}
__device__ __forceinline__ void ph_norm(const P& p, int layer, int which, int nrows, bool router, bool from_input, const bf16_t* resY, int res_layer, int res_goff, int ctx_ways, unsigned char* h8, bool both) {
    int tid_ = threadIdx.x; asm volatile("" : "+v"(tid_));
    const int wave = tid_ >> 6, lane = tid_ & 63;
    const NormArgs a{layer, which, router, from_input, resY, res_layer, res_goff, ctx_ways, h8, both};
    for (int row = blockIdx.x * 8 + wave; row < nrows; row += gridDim.x * 8) norm_row(p, a, row, lane);
}

struct ConvJob { const float* src; bf16_t* dst; int K, N, map, f8; const unsigned* cmax = nullptr; float* cs = nullptr; };
__device__ __forceinline__ void conv_tiles4(const ConvJob& j, int tile, int step, int ntl, float* T  ) {
    int tid_ = threadIdx.x; asm volatile("" : "+v"(tid_));
    const int ntn = (j.N + 63) >> 6, t = tid_;
    float4 v[4][2];
#pragma unroll
    for (int q = 0; q < 4; ++q) { const int tl = tile + q * step, tk = tl / ntn, tn = tl % ntn;
#pragma unroll
        for (int i = 0; i < 2; ++i) { const int kr = (t >> 4) + 32 * i, c4 = (t & 15) * 4, n = tn * 64 + c4;
            v[q][i] = make_float4(0.f, 0.f, 0.f, 0.f);
            if (tl < ntl && n < j.N) v[q][i] = *(const float4*)(j.src + (size_t)(tk * 64 + kr) * j.N + n); } }
    __syncthreads();
#pragma unroll
    for (int q = 0; q < 4; ++q)
#pragma unroll
        for (int i = 0; i < 2; ++i) { const int kr = (t >> 4) + 32 * i, c4 = (t & 15) * 4; float* Tq = T + q * (64 * 65);
            Tq[kr * 65 + c4 + 0] = v[q][i].x; Tq[kr * 65 + c4 + 1] = v[q][i].y; Tq[kr * 65 + c4 + 2] = v[q][i].z; Tq[kr * 65 + c4 + 3] = v[q][i].w; }
    __syncthreads();
#pragma unroll
    for (int q = 0; q < 4; ++q) { const int tl = tile + q * step, tk = tl / ntn, tn = tl % ntn; const float* Tq = T + q * (64 * 65);
        const int nl = t >> 3, ks = (t & 7) * 8, n = tn * 64 + nl;
        if (tl < ntl && n < j.N) {
            int nd = j.map == 0 ? n : ((n >> 7) * 256 + (n & 127) + (j.map == 2 ? 128 : 0)); bool f8 = j.f8 != 0;
            if (j.map == 3) {
                nd = n < 1120 ? n : PJ_RQ + (n - 1120);
                f8 = nd < PJ_F8; }
            if (j.cmax) {
                const float am = fmaxf(__uint_as_float(j.cmax[nd]), 1e-30f), qs = 127.f / am;
                int q[8];
#pragma unroll
                for (int i = 0; i < 8; ++i) q[i] = (int)rintf(Tq[(ks + i) * 65 + nl] * qs) & 255;
                *(uint2*)((unsigned char*)j.dst + (size_t)nd * j.K + tk * 64 + ks) = make_uint2((unsigned)(q[0] | (q[1] << 8) | (q[2] << 16) | (q[3] << 24)), (unsigned)(q[4] | (q[5] << 8) | (q[6] << 16) | (q[7] << 24)));
                if (tk == 0 && ks == 0) j.cs[nd] = am * (1.f / 127.f);
            } else if (f8) {
                int w0 = 0, w1 = 0;
                w0 = __builtin_amdgcn_cvt_pk_fp8_f32(f8clamp(Tq[(ks + 0) * 65 + nl] * F8_SW), f8clamp(Tq[(ks + 1) * 65 + nl] * F8_SW), w0, false);
                w0 = __builtin_amdgcn_cvt_pk_fp8_f32(f8clamp(Tq[(ks + 2) * 65 + nl] * F8_SW), f8clamp(Tq[(ks + 3) * 65 + nl] * F8_SW), w0, true);
                w1 = __builtin_amdgcn_cvt_pk_fp8_f32(f8clamp(Tq[(ks + 4) * 65 + nl] * F8_SW), f8clamp(Tq[(ks + 5) * 65 + nl] * F8_SW), w1, false);
                w1 = __builtin_amdgcn_cvt_pk_fp8_f32(f8clamp(Tq[(ks + 6) * 65 + nl] * F8_SW), f8clamp(Tq[(ks + 7) * 65 + nl] * F8_SW), w1, true);
                *(uint2*)((unsigned char*)j.dst + (size_t)nd * j.K + tk * 64 + ks) = make_uint2((unsigned)w0, (unsigned)w1);
            } else {
            unsigned w[4];
#pragma unroll
            for (int i = 0; i < 4; ++i) w[i] = (unsigned)f2bf(Tq[(ks + 2 * i) * 65 + nl]) | ((unsigned)f2bf(Tq[(ks + 2 * i + 1) * 65 + nl]) << 16);
            *(uint4*)(j.dst + (size_t)nd * j.K + tk * 64 + ks) = make_uint4(w[0], w[1], w[2], w[3]);
            }
        } }
}
__device__ __forceinline__ int conv_ntiles(int K, int N) { return (K >> 6) * ((N + 63) >> 6); }

#define CONV_F8 0
__device__ __forceinline__ void ph_conv_early(const P& p, float* lds) {
    const int G = gridDim.x, bid = blockIdx.x;
    int base = 0;
#define CONV_RUN(SRC, DST, K_, N_, MAP_) do { ConvJob j{SRC, DST, K_, N_, MAP_, CONV_F8}; const int nt_ = conv_ntiles(K_, N_), ns_ = (nt_ + 3) >> 2; \
          \
        for (int u = (((bid - base % G) + G) % G); u < ns_; u += G) conv_tiles4(j, 4 * u, 1, nt_, lds); base += ns_; } while (0)
    for (int l = 0; l < 2; ++l) {
        CONV_RUN(p.in[8] + (size_t)l * 1024 * IN_DIM, (bf16_t*)(p.ws + OFF_WIN) + (size_t)l * PROJ_LD * 1024, 1024, IN_DIM, 3);
        CONV_RUN(p.in[16] + (size_t)l * 1024 * 1024, (bf16_t*)(p.ws + OFF_WOUT) + (size_t)l * 1024 * 1024, 1024, 1024, 0);
        CONV_RUN(p.in[10] + (size_t)l * 192 * 384, (bf16_t*)(p.ws + OFF_WUQ) + (size_t)l * 384 * 192, 192, 384, 0);
        CONV_RUN(p.in[12] + (size_t)l * 128 * 512, (bf16_t*)(p.ws + OFF_WUKV) + (size_t)l * 512 * 128, 128, 512, 0);
    }
#undef CONV_F8
#define CONV_F8 1
    CONV_RUN(p.in[19], (bf16_t*)(p.ws + OFF_FD), D_FF, 1024, 0);
    for (int l = 0; l < 2; ++l) {
        uint4* z = (uint4*)((unsigned char*)((bf16_t*)(p.ws + OFF_WIN) + (size_t)l * PROJ_LD * 1024) + (size_t)1120 * 1024);
        const int n16 = (PJ_F8 - 1120) * 1024 / 16;
        for (int i = bid * NT + threadIdx.x; i < n16; i += G * NT) z[i] = make_uint4(0u, 0u, 0u, 0u);
    }
}
#undef CONV_F8
#define CONV_F8 1
__device__ __forceinline__ void ph_fgu_colmax(const P& p) {
    const int G = gridDim.x, bid = blockIdx.x;
    unsigned* cmax = (unsigned*)(p.ws + OFF_CMAX);
    for (int u = bid; u < 2 * 8 * 6; u += G) {
        const int mat = u / 48, kc = (u % 48) / 6, nc = u % 6, n = nc * 512 + (int)threadIdx.x;
        if (n < D_FF) { const float* s = (mat ? p.in[18] : p.in[17]) + (size_t)(kc * 128) * D_FF + n; float am = 0.f;
#pragma unroll 8
            for (int k = 0; k < 128; ++k) am = fmaxf(am, fabsf(s[(size_t)k * D_FF]));
            atomicMax(cmax + ((n >> 7) * 256 + (n & 127) + (mat ? 128 : 0)), __float_as_uint(am)); }
    }
}
__device__ __forceinline__ void ph_conv_fgu_i8(const P& p, float* lds) {
    const int G = gridDim.x, bid = blockIdx.x;
    int base = 0;
#define CONV_RUN_I8(SRC, MAP_) do { ConvJob j{SRC, (bf16_t*)(p.ws + OFF_FGU), 1024, D_FF, MAP_, 0, (const unsigned*)(p.ws + OFF_CMAX), (float*)(p.ws + OFF_CS8)}; const int nt_ = conv_ntiles(1024, D_FF), ns_ = (nt_ + 3) >> 2; \
        for (int u = (((bid - base % G) + G) % G); u < ns_; u += G) conv_tiles4(j, 4 * u, 1, nt_, lds); base += ns_; } while (0)
    CONV_RUN_I8(p.in[17], 1);
    CONV_RUN_I8(p.in[18], 2);
#undef CONV_RUN_I8
}
__device__ __forceinline__ void ph_conv_late(const P& p, float* lds) {
    const int G = gridDim.x, bid = blockIdx.x;
    int base = 0;
    for (int e = 0; e < NEXP; ++e) {
        CONV_RUN(p.in[21] + (size_t)e * 1024 * D_FFE, (bf16_t*)(p.ws + OFF_MGU + (size_t)e * 2 * D_FFE * 1024), 1024, D_FFE, 1);
        CONV_RUN(p.in[22] + (size_t)e * 1024 * D_FFE, (bf16_t*)(p.ws + OFF_MGU + (size_t)e * 2 * D_FFE * 1024), 1024, D_FFE, 2);
        CONV_RUN(p.in[23] + (size_t)e * D_FFE * 1024, (bf16_t*)(p.ws + OFF_MD + (size_t)e * 1024 * D_FFE), D_FFE, 1024, 0);
    }
}

namespace pg8 {
#define PG8_LAS __attribute__((address_space(3)))
typedef short bf16x8 __attribute__((ext_vector_type(8)));
typedef float f32x4 __attribute__((ext_vector_type(4)));
typedef unsigned u32x4 __attribute__((ext_vector_type(4)));
typedef int i32x4v __attribute__((ext_vector_type(4)));
constexpr int BM = 256, BK = 64, HALF = 128, HTB = HALF * BK * 2, STAGE_BYTES = 8 * HTB, NXCD = 8, WGM = 8;

__host__ __device__ __forceinline__ int lds_byte(int r, int c) { const int st = (r >> 4) * 2 + (c >> 5), rr = r & 15, cc = c & 31, ob = rr * 64 + cc * 2; return st * 1024 + (ob ^ (((ob >> 9) & 1) << 5)); }
__host__ __device__ __forceinline__ void stage_rc(int b, int& R, int& C) { const int st = b / 1024, sb = b % 1024, swz = sb ^ (((sb >> 9) & 1) << 5); R = (st >> 1) * 16 + swz / 64; C = (st & 1) * 32 + (swz % 64) / 2; }
__host__ __device__ __forceinline__ int perm32(int rho) { const int n = rho >> 4, i = rho & 15; return 8 * (i >> 2) + 4 * n + (i & 3); }

struct Unit { int pm, pn, e, rl, kp, ri; };

__device__ __forceinline__ void static_order_L(int L, int nM, int nN, int& pm, int& pn) {
    const int nwg = nM * nN;
    int wgid = L; { const int q = nwg / NXCD, r = nwg % NXCD, xcd = wgid % NXCD, off = wgid / NXCD; wgid = (xcd < r ? xcd * (q + 1) : r * (q + 1) + (xcd - r) * q) + off; }
    const int nig = WGM * nN, gid = wgid / nig, fm = gid * WGM, gsz = (nM - fm) < WGM ? (nM - fm) : WGM;
    pm = fm + ((wgid % nig) % gsz); pn = (wgid % nig) / gsz;
}
__device__ __forceinline__ bool static_order(int i, int G, int c, int nM, int nN, int& pm, int& pn) {
    const int nwg = nM * nN; const long L = (long)i * G + c; if (L >= nwg) return false;
    static_order_L((int)L, nM, nN, pm, pn); return true;
}

template <bool FP8_, bool I8_ = false> struct DenseSchedT {
    static constexpr bool GATHER = false, FP8 = FP8_, I8 = I8_;
    const bf16_t* A; const bf16_t* Bt; int lda, K, nM, nN, G, c; int L0 = 0, Lend = 1 << 30;
    __device__ __forceinline__ int nt() const { return K / BK; }
    __device__ __forceinline__ bool next(int i, Unit& u) const { u.e = 0; u.kp = 0; u.ri = 0; const long L = L0 + (long)i * G + c; const int nwg = nM * nN;
        if (L >= nwg || L >= Lend) return false; static_order_L((int)L, nM, nN, u.pm, u.pn); u.rl = u.pm; return true; }
    __device__ __forceinline__ const char* a_base(const Unit& u) const { return (const char*)A + (size_t)u.pm * BM * lda * 2; }
    __device__ __forceinline__ const char* b_base(const Unit& u) const { return (const char*)Bt + (size_t)u.pn * BM * K * 2; }
    __device__ __forceinline__ unsigned a_off(const Unit&, int r, int C) const { return (unsigned)(r * lda + C) * 2u; }
};
typedef DenseSchedT<false> DenseSched;
struct DenseSplitSched {
    static constexpr bool GATHER = false;
    const bf16_t* A; const bf16_t* Bt; int lda, K, pm0, nMs, nN, ways, ntp, G, c;
    __device__ __forceinline__ int nt() const { return ntp; }
    __device__ __forceinline__ bool next(int i, Unit& u) const {
        const long j = (long)i * G + c; if (j >= (long)nMs * nN * ways) return false;
        const int ui = (int)(j / ways); u.kp = (int)(j % ways) * ntp; u.ri = (int)j; u.pm = pm0 + ui / nN; u.pn = ui % nN; u.e = 0; u.rl = u.pm; return true;
    }
    __device__ __forceinline__ const char* a_base(const Unit& u) const { return (const char*)A + (size_t)u.pm * BM * lda * 2 + (size_t)u.kp * (BK * 2); }
    __device__ __forceinline__ const char* b_base(const Unit& u) const { return (const char*)Bt + (size_t)u.pn * BM * K * 2 + (size_t)u.kp * (BK * 2); }
    __device__ __forceinline__ unsigned a_off(const Unit&, int r, int C) const { return (unsigned)(r * lda + C) * 2u; }
};
template <bool GATHER_, bool FP8_ = false> struct MoeSched {
    static constexpr bool GATHER = GATHER_, FP8 = FP8_;
    const bf16_t* A; const bf16_t* Bt; int lda, K, nN, G, c; size_t bstride;
    const int* list;
    const PG8_LAS int* tab;
    int ulo, uhi, ways, ntp;
    __device__ __forceinline__ int nt() const { return ntp; }
    __device__ __forceinline__ bool next(int i, Unit& u) const {
        const int nM = __builtin_amdgcn_readfirstlane(tab[16]);
        const long j = (long)i * G + c; const int L = ulo + (int)(j / ways);
        if (L >= uhi) return false;
        u.kp = (int)(j % ways) * ntp; u.ri = (int)j;
        static_order_L(L, nM, nN, u.pm, u.pn);
        int e = 0, t0 = 0;
#pragma unroll
        for (int k = 1; k < 8; ++k) { const int tk = tab[8 + k]; if (u.pm >= tk) { e = k; t0 = tk; } }
        u.e = __builtin_amdgcn_readfirstlane(e); u.rl = u.pm - __builtin_amdgcn_readfirstlane(t0); return true;
    }
    __device__ __forceinline__ const char* a_base(const Unit& u) const { return (GATHER ? (const char*)A : (const char*)A + (size_t)u.pm * BM * lda * 2) + (size_t)u.kp * (BK * 2); }
    __device__ __forceinline__ const char* b_base(const Unit& u) const { return (const char*)(Bt + (size_t)u.e * bstride) + (size_t)u.pn * BM * K * 2 + (size_t)u.kp * (BK * 2); }
    __device__ __forceinline__ unsigned a_off(const Unit& u, int r, int C) const {
        if (!GATHER) return (unsigned)(r * lda + C) * 2u;
        const int lr = u.rl * BM + r, c1 = tab[u.e] - 1;
        const int tok = list[(size_t)u.e * 32768 + (lr < c1 ? lr : c1)];
        return (unsigned)(tok * lda + C) * 2u;
    }
};

__device__ __forceinline__ unsigned pk2(float lo, float hi) { typedef float f32x2_t __attribute__((ext_vector_type(2))); typedef __bf16 bf16x2_t __attribute__((ext_vector_type(2)));
    f32x2_t v = {lo, hi}; bf16x2_t b = __builtin_convertvector(v, bf16x2_t); return __builtin_bit_cast(unsigned, b); }

struct EpiBf16 {
    static constexpr bool PERM = true;
    bf16_t* O; int ldc;
    __device__ __forceinline__ void operator()(const f32x4 (&acc)[2][2][4][2], const Unit& u, int wr, int wc, int fr, int fq) const {
        const int row0 = u.pm * BM + wr * 64 + fr, col0 = u.pn * BM + wc * 32 + 8 * fq;
#pragma unroll
        for (int ai = 0; ai < 2; ++ai)
#pragma unroll
            for (int m = 0; m < 4; ++m) { bf16_t* rowp = O + (size_t)(row0 + ai * HALF + m * 16) * ldc + col0;
#pragma unroll
                for (int bj = 0; bj < 2; ++bj) { const f32x4 v0 = acc[ai][bj][m][0], v1 = acc[ai][bj][m][1];
                    u32x4 w; w[0] = pk2(v0[0], v0[1]); w[1] = pk2(v0[2], v0[3]); w[2] = pk2(v1[0], v1[1]); w[3] = pk2(v1[2], v1[3]);
                    *(u32x4*)(rowp + bj * HALF) = w; } }
    }
};
struct EpiBf16Norm {
    static constexpr bool PERM = true, HAS_POST = true;
    bf16_t* O; int ldc; unsigned obytes; unsigned* cnt; float sc;
    __device__ __forceinline__ void operator()(const f32x4 (&acc)[2][2][4][2], const Unit& u, int wr, int wc, int fr, int fq) const {
        const auto rsrc = __builtin_amdgcn_make_buffer_rsrc((void*)O, 0, (int)obytes, 0x00020000);
        const int row0 = u.pm * BM + wr * 64 + fr, col0 = u.pn * BM + wc * 32 + 8 * fq;
#pragma unroll
        for (int ai = 0; ai < 2; ++ai)
#pragma unroll
            for (int m = 0; m < 4; ++m) { const unsigned ro = (unsigned)((row0 + ai * HALF + m * 16) * ldc + col0) * 2u;
#pragma unroll
                for (int bj = 0; bj < 2; ++bj) { const f32x4 v0 = acc[ai][bj][m][0] * sc, v1 = acc[ai][bj][m][1] * sc;
                    u32x4 w; w[0] = pk2(v0[0], v0[1]); w[1] = pk2(v0[2], v0[3]); w[2] = pk2(v1[0], v1[1]); w[3] = pk2(v1[2], v1[3]);
                    __builtin_amdgcn_raw_buffer_store_b128(w, rsrc, ro + bj * HALF * 2, 0, 16); } }
    }
    __device__ __forceinline__ void post(const Unit& u) const {
        asm volatile("s_waitcnt vmcnt(0)" ::: "memory");
        if ((threadIdx.x & 63) == 0) __hip_atomic_fetch_add(cnt + 64 * u.pm, 1u, __ATOMIC_RELAXED, __HIP_MEMORY_SCOPE_AGENT);
    }
};
template <bool F8IN, bool F8> struct EpiSwigluT {
    static constexpr bool PERM = true;
    bf16_t* O; int ldc;
    __device__ __forceinline__ void operator()(const f32x4 (&acc)[2][2][4][2], const Unit& u, int wr, int wc, int fr, int fq) const {
        const int row0 = u.pm * BM + wr * 64 + fr, col0 = u.pn * HALF + wc * 32 + 8 * fq;
#pragma unroll
        for (int ai = 0; ai < 2; ++ai)
#pragma unroll
            for (int m = 0; m < 4; ++m) { bf16_t* rowp = O + (size_t)(row0 + ai * HALF + m * 16) * ldc + col0;
                float o[8];
                typedef float f32x2_t __attribute__((ext_vector_type(2)));
#pragma unroll
                for (int n = 0; n < 2; ++n)
#pragma unroll
                    for (int j = 0; j < 4; j += 2) {
                        f32x2_t gg = {acc[ai][0][m][n][j], acc[ai][0][m][n][j + 1]}, uu = {acc[ai][1][m][n][j], acc[ai][1][m][n][j + 1]};
                        if constexpr (F8IN) { gg = gg * (1.f / (F8_SH * F8_SW)); uu = uu * ((F8 ? F8_SA : 1.f) / (F8_SH * F8_SW)); } else if constexpr (F8) uu = uu * F8_SA;
                        const f32x2_t t = gg * (-1.4426950408889634f); f32x2_t e;
                        e[0] = __builtin_amdgcn_exp2f(t[0]); e[1] = __builtin_amdgcn_exp2f(t[1]);
                        e = e + 1.0f; f32x2_t r; r[0] = __builtin_amdgcn_rcpf(e[0]); r[1] = __builtin_amdgcn_rcpf(e[1]);
                        const f32x2_t v = (gg * uu) * r; o[n * 4 + j] = v[0]; o[n * 4 + j + 1] = v[1]; }
                if constexpr (F8) { int w0 = 0, w1 = 0;
                    w0 = __builtin_amdgcn_cvt_pk_fp8_f32(f8clamp(o[0]), f8clamp(o[1]), w0, false); w0 = __builtin_amdgcn_cvt_pk_fp8_f32(f8clamp(o[2]), f8clamp(o[3]), w0, true);
                    w1 = __builtin_amdgcn_cvt_pk_fp8_f32(f8clamp(o[4]), f8clamp(o[5]), w1, false); w1 = __builtin_amdgcn_cvt_pk_fp8_f32(f8clamp(o[6]), f8clamp(o[7]), w1, true);
                    typedef unsigned u32x2v __attribute__((ext_vector_type(2))); u32x2v w = {(unsigned)w0, (unsigned)w1};
                    *(u32x2v*)((unsigned char*)O + (size_t)(row0 + ai * HALF + m * 16) * ldc + col0) = w; }
                else { u32x4 w; w[0] = pk2(o[0], o[1]); w[1] = pk2(o[2], o[3]); w[2] = pk2(o[4], o[5]); w[3] = pk2(o[6], o[7]);
                *(u32x4*)rowp = w; } }
    }
};
typedef EpiSwigluT<false, false> EpiSwiglu;
struct EpiSwigluI8 {
    static constexpr bool PERM = true;
    bf16_t* O; int ldc; const float* rsc; const float* csc;
    __device__ __forceinline__ void operator()(const f32x4 (&acc)[2][2][4][2], const Unit& u, int wr, int wc, int fr, int fq) const {
        const int row0 = u.pm * BM + wr * 64 + fr, col0 = u.pn * HALF + wc * 32 + 8 * fq;
        const float* cg = csc + u.pn * BM + wc * 32 + 8 * fq;
        const f32x4 cg0 = *(const f32x4*)cg, cg1 = *(const f32x4*)(cg + 4), cu0 = *(const f32x4*)(cg + HALF), cu1 = *(const f32x4*)(cg + HALF + 4);
        float rs8[8];
#pragma unroll
        for (int i = 0; i < 8; ++i) rs8[i] = rsc[row0 + (i >> 2) * HALF + (i & 3) * 16];
#pragma unroll
        for (int ai = 0; ai < 2; ++ai)
#pragma unroll
            for (int m = 0; m < 4; ++m) { const int row = row0 + ai * HALF + m * 16; const float rsv = rs8[ai * 4 + m];
                float o[8];
#pragma unroll
                for (int n = 0; n < 2; ++n)
#pragma unroll
                    for (int j = 0; j < 4; ++j) {
                        const float gg = (float)__float_as_int(acc[ai][0][m][n][j]) * (rsv * (n ? cg1[j] : cg0[j])), uu = (float)__float_as_int(acc[ai][1][m][n][j]) * (rsv * F8_SA * (n ? cu1[j] : cu0[j]));
                        const float e = __builtin_amdgcn_exp2f(gg * (-1.4426950408889634f)) + 1.0f;
                        o[n * 4 + j] = (gg * uu) * __builtin_amdgcn_rcpf(e); }
                int w0 = 0, w1 = 0;
                w0 = __builtin_amdgcn_cvt_pk_fp8_f32(f8clamp(o[0]), f8clamp(o[1]), w0, false); w0 = __builtin_amdgcn_cvt_pk_fp8_f32(f8clamp(o[2]), f8clamp(o[3]), w0, true);
                w1 = __builtin_amdgcn_cvt_pk_fp8_f32(f8clamp(o[4]), f8clamp(o[5]), w1, false); w1 = __builtin_amdgcn_cvt_pk_fp8_f32(f8clamp(o[6]), f8clamp(o[7]), w1, true);
                typedef unsigned u32x2v __attribute__((ext_vector_type(2))); u32x2v w = {(unsigned)w0, (unsigned)w1};
                *(u32x2v*)((unsigned char*)O + (size_t)row * ldc + col0) = w; }
    }
};
struct EpiRes {
    static constexpr bool PERM = false;
    const float* in_lat; const float* in_ctx; float* out_lat; float* out_ctx; const float* modl; int goff;
    __device__ __forceinline__ void operator()(const f32x4 (&acc)[2][2][4][2], const Unit& u, int wr, int wc, int fr, int fq) const {
        const bool lat = u.pm < T_LAT / BM; const int r = lat ? (u.pm >> 4) : 8;
        const size_t rbase = (size_t)(lat ? u.pm : u.pm - T_LAT / BM) * BM + wr * 64 + fr;
        const float* src = (lat ? in_lat : in_ctx); float* dst = (lat ? out_lat : out_ctx);
        const int col0 = u.pn * BM + wc * 32 + 4 * fq;
        f32x4 gv[2][2];
#pragma unroll
        for (int bj = 0; bj < 2; ++bj)
#pragma unroll
            for (int n = 0; n < 2; ++n) gv[bj][n] = *(const f32x4*)(modl + r * 6144 + goff + col0 + bj * HALF + n * 16);
#pragma unroll
        for (int ai = 0; ai < 2; ++ai)
#pragma unroll
            for (int m = 0; m < 4; ++m) { const size_t ro = (rbase + ai * HALF + m * 16) * 1024 + col0;
#pragma unroll
                for (int bj = 0; bj < 2; ++bj)
#pragma unroll
                    for (int n = 0; n < 2; ++n) { const f32x4 x = *(const f32x4*)(src + ro + bj * HALF + n * 16);
                        *(f32x4*)(dst + ro + bj * HALF + n * 16) = x + gv[bj][n] * acc[ai][bj][m][n]; } }
    }
};
struct EpiBf16S {
    static constexpr bool PERM = true;
    bf16_t* O; int ldc; float sc;
    __device__ __forceinline__ void operator()(const f32x4 (&acc)[2][2][4][2], const Unit& u, int wr, int wc, int fr, int fq) const {
        const int row0 = u.pm * BM + wr * 64 + fr, col0 = u.pn * BM + wc * 32 + 8 * fq;
#pragma unroll
        for (int ai = 0; ai < 2; ++ai)
#pragma unroll
            for (int m = 0; m < 4; ++m) { bf16_t* rowp = O + (size_t)(row0 + ai * HALF + m * 16) * ldc + col0;
#pragma unroll
                for (int bj = 0; bj < 2; ++bj) { const f32x4 v0 = acc[ai][bj][m][0] * sc, v1 = acc[ai][bj][m][1] * sc;
                    u32x4 w; w[0] = pk2(v0[0], v0[1]); w[1] = pk2(v0[2], v0[3]); w[2] = pk2(v1[0], v1[1]); w[3] = pk2(v1[2], v1[3]);
                    *(u32x4*)(rowp + bj * HALF) = w; } }
    }
};
struct EpiPart {
    static constexpr bool PERM = false;
    float* PART;
    __device__ __forceinline__ void operator()(const f32x4 (&acc)[2][2][4][2], const Unit& u, int wr, int wc, int fr, int fq) const {
        float* tp = PART + (size_t)u.ri * 65536 + (wr * 64 + fr) * 256 + wc * 32 + 4 * fq;
#pragma unroll
        for (int ai = 0; ai < 2; ++ai)
#pragma unroll
            for (int m = 0; m < 4; ++m)
#pragma unroll
                for (int bj = 0; bj < 2; ++bj)
#pragma unroll
                    for (int n = 0; n < 2; ++n) *(f32x4*)(tp + (ai * HALF + m * 16) * 256 + bj * HALF + n * 16) = acc[ai][bj][m][n];
    }
};
__device__ __forceinline__ void moe_combine(bf16_t* YM, const float* PART, const PG8_LAS int* tab, int nN, float sc) {
    const int nTm = __builtin_amdgcn_readfirstlane(tab[16]), G = gridDim.x, U = nTm * nN, rem = U % G;
    if (!(rem > 0 && rem * MOE_WAYS <= G)) return;
    int tid_ = threadIdx.x; asm volatile("" : "+v"(tid_));
    const int umain = U - rem, wave = tid_ >> 6, lane = tid_ & 63;
    for (int task = blockIdx.x * 8 + wave; task < rem * 256; task += G * 8) {
        const int r = task >> 8, i = task & 255; int pm, pn; static_order_L(umain + r, nTm, nN, pm, pn);
        const float* pp = PART + (size_t)(r * MOE_WAYS) * 65536 + i * 256 + lane * 4;
        f32x4 s = *(const f32x4*)pp;
#pragma unroll
        for (int q = 1; q < MOE_WAYS; ++q) s = s + *(const f32x4*)(pp + q * 65536);
        s = s * sc;
        typedef unsigned u32x2v __attribute__((ext_vector_type(2))); u32x2v w = {pk2(s[0], s[1]), pk2(s[2], s[3])};
        *(u32x2v*)(YM + (size_t)(pm * BM + i) * 1024 + pn * BM + lane * 4) = w;
    }
}

template <class T, class = void> struct sched_i8 { static constexpr bool value = false; };
template <class T> struct sched_i8<T, decltype((void)T::I8)> { static constexpr bool value = T::I8; };
template <class T, class = void> struct sched_fp8 { static constexpr bool value = false; };
template <class T> struct sched_fp8<T, decltype((void)T::FP8)> { static constexpr bool value = T::FP8; };
template <class T, class = void> struct epi_has_post { static constexpr bool value = false; };
template <class T> struct epi_has_post<T, decltype((void)T::HAS_POST)> { static constexpr bool value = T::HAS_POST; };
template <class Epi, class Sched>
__device__ __forceinline__ void gemm_phase(PG8_LAS unsigned char* lds, const Sched& S, const Epi& E) {
    int tid_ = threadIdx.x; asm volatile("" : "+v"(tid_));
    const int tid = tid_, wid = __builtin_amdgcn_readfirstlane(tid >> 6), lane = tid & 63, wr = wid >> 2, wc = wid & 3, fr = lane & 15, fq = lane >> 4;
    const int K = S.K, nt = S.nt();
    int RA[2], CA[2]; unsigned voffB;
    { int R, C; stage_rc(tid * 16, R, C); const int Rb = Epi::PERM ? ((R & ~31) + perm32(R & 31)) : R;
      RA[0] = R; CA[0] = C; RA[1] = R + 64; CA[1] = C; voffB = (unsigned)(Rb * K + C) * 2u; }
    const unsigned incB = (unsigned)(64 * K * 2), incA = (unsigned)(64 * S.lda * 2);
    const unsigned kstep = (unsigned)(BK * 2);
    const unsigned hstepB = (unsigned)(HALF * K * 2);
    const auto rsA = __builtin_amdgcn_make_buffer_rsrc((void*)S.A, 0, 0x7fffffff, 0x00020000), rsB = __builtin_amdgcn_make_buffer_rsrc((void*)S.Bt, 0, 0x7fffffff, 0x00020000);
    const unsigned ldsw = (unsigned)wid * 1024u;
    const int aoff = lds_byte(wr * 64 + fr, fq * 8), boff = lds_byte(wc * 32 + fr, fq * 8);
#define PG8_SA(b, h) (((b) * 2 + (h)) * HTB)
#define PG8_SB(b, h) ((4 + (b) * 2 + (h)) * HTB)
  \

#define PG8_STAGE_B(bufoff, soff) do { _Pragma("unroll") for (int _i = 0; _i < 2; ++_i) \
        __builtin_amdgcn_raw_ptr_buffer_load_lds(rsB, (PG8_LAS void*)(lds + (bufoff) + ldsw + _i * 8192), 16, voffB, (soff) + _i * incB, 0, 0); } while (0)
#define PG8_STAGE_A(bufoff, soff, h) do { _Pragma("unroll") for (int _i = 0; _i < 2; ++_i) { \
        if constexpr (Sched::GATHER) __builtin_amdgcn_raw_ptr_buffer_load_lds(rsA, (PG8_LAS void*)(lds + (bufoff) + ldsw + _i * 8192), 16, vA[h][_i], (soff), 0, 0); \
        else __builtin_amdgcn_raw_ptr_buffer_load_lds(rsA, (PG8_LAS void*)(lds + (bufoff) + ldsw + _i * 8192), 16, vA[0][0], (soff) + ((h) * 2 + _i) * incA, 0, 0); } } while (0)
#define PG8_LDA(dst, b, h) do { _Pragma("unroll") for (int m = 0; m < 4; ++m) _Pragma("unroll") for (int k = 0; k < 2; ++k) dst[m][k] = *(const PG8_LAS bf16x8*)(lds + PG8_SA(b, h) + aoff + m * 2048 + k * 1024); } while (0)
#define PG8_LDB(dst, b, h) do { _Pragma("unroll") for (int n = 0; n < 2; ++n) _Pragma("unroll") for (int k = 0; k < 2; ++k) dst[n][k] = *(const PG8_LAS bf16x8*)(lds + PG8_SB(b, h) + boff + n * 2048 + k * 1024); } while (0)
#define PG8_CAT8(x, y) __builtin_shufflevector(__builtin_bit_cast(i32x4v, x), __builtin_bit_cast(i32x4v, y), 0, 1, 2, 3, 4, 5, 6, 7)
#define PG8_MMA(ai, bj, At, Bt) do { __builtin_amdgcn_s_setprio(1); _Pragma("unroll") for (int m = 0; m < 4; ++m) _Pragma("unroll") for (int n = 0; n < 2; ++n) { \
        if constexpr (sched_fp8<Sched>::value)   \
              \
              \
            asm volatile("v_mfma_f32_16x16x128_f8f6f4 %0, %1, %2, %0" : "+v"(acc[ai][bj][m][n]) : "v"(PG8_CAT8(Bt[n][0], Bt[n][1])), "v"(PG8_CAT8(At[m][0], At[m][1]))); \
        else if constexpr (sched_i8<Sched>::value) { _Pragma("unroll") for (int k = 0; k < 2; ++k)   \
            acc[ai][bj][m][n] = __builtin_bit_cast(f32x4, __builtin_amdgcn_mfma_i32_16x16x64_i8(__builtin_bit_cast(i32x4v, Bt[n][k]), __builtin_bit_cast(i32x4v, At[m][k]), __builtin_bit_cast(i32x4v, acc[ai][bj][m][n]), 0, 0, 0)); } \
        else { _Pragma("unroll") for (int k = 0; k < 2; ++k) acc[ai][bj][m][n] = __builtin_amdgcn_mfma_f32_16x16x32_bf16(Bt[n][k], At[m][k], acc[ai][bj][m][n], 0, 0, 0); } } __builtin_amdgcn_s_setprio(0); } while (0)
#define PG8_WAIT_V(n) asm volatile("s_waitcnt vmcnt(" #n ")" ::: "memory")
#define PG8_WAIT_L(n) asm volatile("s_waitcnt lgkmcnt(" #n ")" ::: "memory")
#define PG8_BAR __builtin_amdgcn_s_barrier()
#define PG8_SCHED __builtin_amdgcn_sched_barrier(0)
#define PG8_AOFFS(dst, U) do { _Pragma("unroll") for (int _h = 0; _h < 2; ++_h) _Pragma("unroll") for (int _i = 0; _i < 2; ++_i) dst[_h][_i] = S.a_off(U, _h * HALF + RA[_i], CA[_i]); } while (0)
    Unit cur, nxt; int ui = 0;
    if (!S.next(0, cur)) return;
    f32x4 acc[2][2][4][2];
#pragma unroll
    for (int a = 0; a < 2; ++a)
#pragma unroll
        for (int b = 0; b < 2; ++b)
#pragma unroll
            for (int m = 0; m < 4; ++m)
#pragma unroll
                for (int n = 0; n < 2; ++n) acc[a][b][m][n] = (f32x4){0.f, 0.f, 0.f, 0.f};
    bf16x8 At[4][2], B0[2][2], B1[2][2];
    unsigned vA[2][2], vN[2][2];
    PG8_AOFFS(vA, cur);
    unsigned cA = (unsigned)(S.a_base(cur) - (const char*)S.A), cB = (unsigned)(S.b_base(cur) - (const char*)S.Bt);
    PG8_STAGE_B(PG8_SB(0, 0), cB); PG8_STAGE_B(PG8_SB(0, 1), cB + hstepB); PG8_STAGE_A(PG8_SA(0, 0), cA, 0); PG8_STAGE_A(PG8_SA(0, 1), cA, 1);
    if (wr == 1) PG8_BAR;
    PG8_WAIT_V(2); PG8_BAR;
    PG8_STAGE_B(PG8_SB(1, 0), cB + kstep); PG8_STAGE_A(PG8_SA(1, 0), cA + kstep, 0); PG8_STAGE_B(PG8_SB(1, 1), cB + hstepB + kstep);
    PG8_WAIT_V(6); PG8_BAR;
    for (;;) {
        const bool has_next = S.next(ui + 1, nxt);
        const unsigned nA = has_next ? (unsigned)(S.a_base(nxt) - (const char*)S.A) : cA, nB = has_next ? (unsigned)(S.b_base(nxt) - (const char*)S.Bt) : cB;
        for (int t = 0; t < nt; t += 2) {
            const bool last = (t == nt - 2);
            const bool sw = Sched::GATHER && last && has_next;
            if constexpr (Sched::GATHER) { if (sw) { PG8_AOFFS(vN, nxt); } }
            const unsigned a1 = cA + (unsigned)(t + 1) * kstep;
            const unsigned a2 = last ? nA : cA + (unsigned)(t + 2) * kstep, b2 = last ? nB : cB + (unsigned)(t + 2) * kstep;
            const unsigned a3 = a2 + kstep, b3 = b2 + kstep;
            PG8_LDB(B0, 0, 0); PG8_LDB(B1, 0, 1); PG8_SCHED; PG8_LDA(At, 0, 0); PG8_STAGE_A(PG8_SA(1, 1), a1, 1);
            if constexpr (Sched::GATHER) { if (sw) {
#pragma unroll
                for (int _h = 0; _h < 2; ++_h)
#pragma unroll
                    for (int _i = 0; _i < 2; ++_i) vA[_h][_i] = vN[_h][_i]; } }
            PG8_WAIT_V(8); PG8_WAIT_L(0); PG8_BAR; PG8_MMA(0, 0, At, B0); PG8_MMA(0, 1, At, B1); PG8_BAR; PG8_SCHED;
            PG8_LDA(At, 0, 1); PG8_STAGE_B(PG8_SB(0, 0), b2); PG8_STAGE_B(PG8_SB(0, 1), b2 + hstepB); PG8_STAGE_A(PG8_SA(0, 0), a2, 0);
            PG8_WAIT_V(8); PG8_WAIT_L(0); PG8_BAR; PG8_MMA(1, 0, At, B0); PG8_MMA(1, 1, At, B1); PG8_BAR; PG8_SCHED;
            PG8_LDB(B0, 1, 0); PG8_LDB(B1, 1, 1); PG8_SCHED; PG8_LDA(At, 1, 0); PG8_STAGE_A(PG8_SA(0, 1), a2, 1);
            PG8_WAIT_V(8); PG8_WAIT_L(0); PG8_BAR; PG8_MMA(0, 0, At, B0); PG8_MMA(0, 1, At, B1); PG8_BAR; PG8_SCHED;
            PG8_LDA(At, 1, 1); PG8_STAGE_B(PG8_SB(1, 0), b3); PG8_STAGE_B(PG8_SB(1, 1), b3 + hstepB); PG8_STAGE_A(PG8_SA(1, 0), a3, 0);
            PG8_WAIT_V(8); PG8_WAIT_L(0); PG8_BAR; PG8_MMA(1, 0, At, B0); PG8_MMA(1, 1, At, B1); PG8_BAR; PG8_SCHED;
        }
        if constexpr (sched_fp8<Sched>::value) asm volatile("s_nop 15\n\ts_nop 7" ::: "memory");
        if (wr == 0) PG8_BAR;
        { int te_ = threadIdx.x; asm volatile("" : "+v"(te_));
          E(acc, cur, wr, wc, te_ & 15, (te_ & 63) >> 4); }
        if constexpr (epi_has_post<Epi>::value) E.post(cur);
        if (!has_next) break;
#pragma unroll
        for (int a = 0; a < 2; ++a)
#pragma unroll
            for (int b = 0; b < 2; ++b)
#pragma unroll
                for (int m = 0; m < 4; ++m)
#pragma unroll
                    for (int n = 0; n < 2; ++n) acc[a][b][m][n] = (f32x4){0.f, 0.f, 0.f, 0.f};
        cur = nxt; cA = nA; cB = nB; ++ui;
        if (wr == 1) PG8_BAR;
    }
    PG8_WAIT_V(0);
    PG8_BAR;
#undef PG8_SA
#undef PG8_SB
#undef PG8_STAGE_A
#undef PG8_STAGE_B
#undef PG8_LDA
#undef PG8_LDB
#undef PG8_MMA
#undef PG8_CAT8
#undef PG8_WAIT_V
#undef PG8_WAIT_L
#undef PG8_BAR
#undef PG8_SCHED
#undef PG8_AOFFS
}
}

__device__ __forceinline__ float rope_inv(int i2, int dim) { return powf(10000.0f, -(float)i2 / (float)dim); }

__device__ __forceinline__ void ph_final(const P& p) {
    int tid_ = threadIdx.x; asm volatile("" : "+v"(tid_));
    const int wave = tid_ >> 6, lane = tid_ & 63;
    const float* gain = p.in[24];
    for (int row = blockIdx.x * 8 + wave; row < T_LAT; row += gridDim.x * 8) {
        float* src = p.out + (size_t)row * 1024;
        float4 v[4]; float ss = 0.f;
#pragma unroll
        for (int i = 0; i < 4; ++i) { v[i] = *(const float4*)(src + i * 256 + lane * 4); ss += v[i].x * v[i].x + v[i].y * v[i].y + v[i].z * v[i].z + v[i].w * v[i].w; }
        ss = wave_sum(ss);
        const float rs = rsqrtf(ss * (1.f / 1024.f) + NORM_EPS);
#pragma unroll
        for (int i = 0; i < 4; ++i) { const int col = i * 256 + lane * 4; const float4 g = *(const float4*)(gain + col);
            *(float4*)(src + col) = make_float4(v[i].x * rs * g.x, v[i].y * rs * g.y, v[i].z * rs * g.z, v[i].w * rs * g.w); }
    }
}


__device__ __forceinline__ void ph_final_moe(const P& p, const LAS int* tab0, const LAS int* tab1) {
    int tid_ = threadIdx.x; asm volatile("" : "+v"(tid_));
    const int wave = tid_ >> 6, lane = tid_ & 63;
    const float* gain = p.in[24];
    const bf16_t* YM0 = (const bf16_t*)(p.ws + OFF_YM); const bf16_t* YM1 = YM0 + (size_t)ACT_ROWS * 1024;
    const float* MODL = (const float*)(p.ws + OFF_MOD) + 9 * 6144 + 5120;
    int row = blockIdx.x * 8 + wave; const int stride = gridDim.x * 8;
    int4 ep = make_int4(0, 0, 0, 0), nep = ep; float2 ww = make_float2(0.f, 0.f), nww = ww;
    if (row < T_LAT) { const int* iv = (const int*)(p.ws + OFF_INV) + (size_t)row * 8; ep = *(const int4*)iv; ww = *(const float2*)(iv + 4); }
    for (; row < T_LAT; row += stride) {
        if (row + stride < T_LAT) { const int* iv = (const int*)(p.ws + OFF_INV) + (size_t)(row + stride) * 8; nep = *(const int4*)iv; nww = *(const float2*)(iv + 4); }
        const size_t r0 = (size_t)(tab0[8 + ep.x] * 256 + ep.y) * 1024, r1 = (size_t)(tab1[8 + ep.z] * 256 + ep.w) * 1024;
        float* src = p.out + (size_t)row * 1024;
        const float* gt = MODL + (row >> 12) * 6144;
        float4 v[4]; uint2 y0[4], y1[4]; float4 gg[4]; float ss = 0.f;
#pragma unroll
        for (int i = 0; i < 4; ++i) { const int col = i * 256 + lane * 4; v[i] = *(const float4*)(src + col); y0[i] = *(const uint2*)(YM0 + r0 + col); y1[i] = *(const uint2*)(YM1 + r1 + col); gg[i] = *(const float4*)(gt + col); }
#pragma unroll
        for (int i = 0; i < 4; ++i) {
            v[i].x += gg[i].x * (ww.x * __uint_as_float(y0[i].x << 16) + ww.y * __uint_as_float(y1[i].x << 16));
            v[i].y += gg[i].y * (ww.x * __uint_as_float(y0[i].x & 0xFFFF0000u) + ww.y * __uint_as_float(y1[i].x & 0xFFFF0000u));
            v[i].z += gg[i].z * (ww.x * __uint_as_float(y0[i].y << 16) + ww.y * __uint_as_float(y1[i].y << 16));
            v[i].w += gg[i].w * (ww.x * __uint_as_float(y0[i].y & 0xFFFF0000u) + ww.y * __uint_as_float(y1[i].y & 0xFFFF0000u));
            ss += v[i].x * v[i].x + v[i].y * v[i].y + v[i].z * v[i].z + v[i].w * v[i].w; }
        ss = wave_sum(ss);
        const float rs = rsqrtf(ss * (1.f / 1024.f) + NORM_EPS);
#pragma unroll
        for (int i = 0; i < 4; ++i) { const int col = i * 256 + lane * 4; const float4 g = *(const float4*)(gain + col);
            *(float4*)(src + col) = make_float4(v[i].x * rs * g.x, v[i].y * rs * g.y, v[i].z * rs * g.z, v[i].w * rs * g.w); }
        ep = nep; ww = nww;
    }
}
typedef short bf16x8_t __attribute__((ext_vector_type(8)));
typedef short s16x4_t __attribute__((ext_vector_type(4)));
typedef float f32x16_t __attribute__((ext_vector_type(16)));
typedef unsigned u32x4_t __attribute__((ext_vector_type(4)));
typedef float f32x4_t __attribute__((ext_vector_type(4)));
__device__ __forceinline__ s16x4_t lds_tr16(LAS const unsigned char* p) { typedef short v4i16_t __attribute__((ext_vector_type(4))); return __builtin_bit_cast(s16x4_t, __builtin_amdgcn_ds_read_tr16_b64_v4i16((LAS v4i16_t*)p)); }
__device__ __forceinline__ unsigned pkbf(float lo, float hi) { typedef float f32x2_t __attribute__((ext_vector_type(2))); typedef __bf16 bf16x2_t __attribute__((ext_vector_type(2)));
    f32x2_t v = {lo, hi}; bf16x2_t b = __builtin_convertvector(v, bf16x2_t); return __builtin_bit_cast(unsigned, b); }
__device__ __forceinline__ float max3f(float a, float b, float c) { return fmaxf(fmaxf(a, b), c); }

#define ATT_VP 192
#define ATT_THR 6.0f
template <int DQK, bool SWA, bool GQA = false>
__device__ __forceinline__ void attn_unit(LAS unsigned char* lds, const bf16_t* POST, const bf16_t* VBUF, int vld, bf16_t* MIX, int b, int q0, int qcol, int kcol, int vcol, int ocol,
                                          int band_lo, int band_hi, float sinkl2, float qscale, const float* sinkp, float sinkmul) {
    constexpr int KP = DQK * 2 + 16, NPK = DQK / 8, NKL = NPK / 4, STAGE = 128 * KP + 128 * ATT_VP, NS = DQK / 16;
    int tid_ = threadIdx.x; asm volatile("" : "+v"(tid_));
    const int tid = tid_, wid = __builtin_amdgcn_readfirstlane(tid >> 6), lane = tid & 63, r = lane & 31, h = lane >> 5;
    const int nb = (band_hi - band_lo) >> 7, ntiles = nb + 2;
    const int qw0 = GQA ? q0 + 32 * (wid & 1) : q0 + 32 * wid;
    const int qi = qw0 + r;
    const int qrow = tok_row(b, qi);
    if (GQA) { qcol += (wid >> 1) * 64; ocol += (wid >> 1) * 64; sinkl2 = sinkp[wid >> 1] * sinkmul; }
    bf16x8_t qf[NS];
    { const bf16_t* qp = POST + (size_t)qrow * POST_LD + qcol + 8 * h;
#pragma unroll
      for (int s = 0; s < NS; ++s) { float f[8]; unpack8(*(const uint4*)(qp + 16 * s), f);
          const unsigned w0 = pkbf(f[0] * qscale, f[1] * qscale), w1 = pkbf(f[2] * qscale, f[3] * qscale), w2 = pkbf(f[4] * qscale, f[5] * qscale), w3 = pkbf(f[6] * qscale, f[7] * qscale);
          qf[s] = __builtin_bit_cast(bf16x8_t, make_uint4(w0, w1, w2, w3)); } }
    f32x16_t O0, O1;
#pragma unroll
    for (int i = 0; i < 16; ++i) { O0[i] = 0.f; O1[i] = 0.f; }
    float m = SWA ? sinkl2 : -1e30f, l = 0.f;
    u32x4_t kreg[NKL], vreg[2];
    const int vrow = tid >> 3, vpc = tid & 7;
#define ATT_KS(t) ((t) < nb ? band_lo + 128 * (t) : SEQ + 128 * ((t) - nb))
#define ATT_LOAD(t) do { const int ks_ = ATT_KS(t); const bf16_t* base_ = POST + (size_t)tok_row(b, ks_) * POST_LD; \
        _Pragma("unroll") for (int i_ = 0; i_ < NKL; ++i_) { const int idx_ = tid + 512 * i_, row_ = idx_ / NPK, pc_ = idx_ % NPK; kreg[i_] = *(const u32x4_t*)(base_ + (size_t)row_ * POST_LD + kcol + pc_ * 8); } \
        const bf16_t* vbase_ = VBUF + (size_t)tok_row(b, ks_) * vld; \
        _Pragma("unroll") for (int i_ = 0; i_ < 2; ++i_) vreg[i_] = *(const u32x4_t*)(vbase_ + (size_t)(vrow + 64 * i_) * vld + vcol + vpc * 8); } while (0)
#define ATT_WRITE(buf) do { LAS unsigned char* kb_ = lds + (buf) * STAGE; LAS unsigned char* vb_ = kb_ + 128 * KP; \
        _Pragma("unroll") for (int i_ = 0; i_ < NKL; ++i_) { const int idx_ = tid + 512 * i_, row_ = idx_ / NPK, pc_ = idx_ % NPK; *(LAS u32x4_t*)(kb_ + row_ * KP + pc_ * 16) = kreg[i_]; } \
        _Pragma("unroll") for (int i_ = 0; i_ < 2; ++i_) *(LAS u32x4_t*)(vb_ + (vrow + 64 * i_) * ATT_VP + vpc * 16) = vreg[i_]; } while (0)
    const int koff = r * KP + 16 * h;
    const int voff = (4 * h + ((lane & 15) >> 2)) * ATT_VP + (16 * ((lane >> 4) & 1) + 4 * (lane & 3)) * 2;
    __syncthreads();
    ATT_LOAD(0); ATT_WRITE(0);
    __syncthreads();
    for (int t = 0; t < ntiles; ++t) {
        if (t + 1 < ntiles) ATT_LOAD(t + 1);
        LAS const unsigned char* kb = lds + (t & 1) * STAGE; LAS const unsigned char* vb = kb + 128 * KP;
        const int ks = ATT_KS(t);
        bool skip[2] = {false, false}, need_mask[2] = {false, false};
        if (SWA && t < nb) {
#pragma unroll
            for (int sub = 0; sub < 2; ++sub) { const int kb0 = ks + sub * 64, qlo = qw0, qhi = qlo + 31;
                skip[sub] = (kb0 > qhi + 128) || (kb0 + 63 < qlo - 128);
                need_mask[sub] = !((kb0 >= qhi - 128) && (kb0 + 63 <= qlo + 128)); }
        }
        f32x16_t S[4];
#pragma unroll
        for (int blk = 0; blk < 4; ++blk)
#pragma unroll
            for (int i = 0; i < 16; ++i) S[blk][i] = 0.f;
#pragma unroll
        for (int sub = 0; sub < 2; ++sub) {
            if (!skip[sub]) {
#pragma unroll
                for (int s = 0; s < NS; ++s) {
                    const bf16x8_t k0 = *(LAS const bf16x8_t*)(kb + (sub * 64) * KP + koff + 32 * s), k1 = *(LAS const bf16x8_t*)(kb + (sub * 64 + 32) * KP + koff + 32 * s);
                    S[2 * sub] = __builtin_amdgcn_mfma_f32_32x32x16_bf16(k0, qf[s], S[2 * sub], 0, 0, 0);
                    S[2 * sub + 1] = __builtin_amdgcn_mfma_f32_32x32x16_bf16(k1, qf[s], S[2 * sub + 1], 0, 0, 0);
                }
            }
        }
#pragma unroll
        for (int sub = 0; sub < 2; ++sub) {
            if (!skip[sub]) {
                const int kb0 = ks + sub * 64;
                f32x16_t& S0 = S[2 * sub]; f32x16_t& S1 = S[2 * sub + 1];
                bf16x8_t va[8];
#pragma unroll
                for (int g = 0; g < 4; ++g) { LAS const unsigned char* vp = vb + (sub * 64 + 16 * g) * ATT_VP + voff;
                    const s16x4_t l0 = lds_tr16(vp), h0 = lds_tr16(vp + 8 * ATT_VP), l1 = lds_tr16(vp + 64), h1 = lds_tr16(vp + 8 * ATT_VP + 64);
                    va[2 * g] = __builtin_shufflevector(l0, h0, 0, 1, 2, 3, 4, 5, 6, 7); va[2 * g + 1] = __builtin_shufflevector(l1, h1, 0, 1, 2, 3, 4, 5, 6, 7); }
                if (SWA && need_mask[sub]) {
#pragma unroll
                    for (int i = 0; i < 16; ++i) { const int d0 = kb0 + (i & 3) + 8 * (i >> 2) + 4 * h - qi, d1 = d0 + 32;
                        if (d0 > 128 || d0 < -128) S0[i] = -1e30f;
                        if (d1 > 128 || d1 < -128) S1[i] = -1e30f; }
                }
                float mx = max3f(S0[0], S0[1], S1[0]), mx2 = max3f(S0[2], S0[3], S1[1]);
                mx = max3f(mx, S1[2], S1[3]);
#pragma unroll
                for (int i = 4; i < 16; i += 4) { mx = max3f(mx, S0[i], S0[i + 1]); mx2 = max3f(mx2, S0[i + 2], S0[i + 3]); mx = max3f(mx, S1[i], S1[i + 1]); mx2 = max3f(mx2, S1[i + 2], S1[i + 3]); }
                mx = fmaxf(mx, mx2);
                { const auto rr_ = __builtin_amdgcn_permlane32_swap(__float_as_uint(mx), __float_as_uint(mx), false, false); mx = fmaxf(__uint_as_float(rr_[0]), __uint_as_float(rr_[1])); }
                if (__any(mx > m + ATT_THR)) {
                    const float mn = fmaxf(m, mx), al = __builtin_amdgcn_exp2f(m - mn);
                    m = mn; l *= al;
#pragma unroll
                    for (int i = 0; i < 16; ++i) { O0[i] *= al; O1[i] *= al; }
                }
                typedef float f32x2_t __attribute__((ext_vector_type(2)));
                const f32x2_t m2 = {m, m}; f32x2_t ps2 = {0.f, 0.f};
#pragma unroll
                for (int i = 0; i < 16; i += 2) {
                    f32x2_t a = (f32x2_t){S0[i], S0[i + 1]} - m2, c = (f32x2_t){S1[i], S1[i + 1]} - m2;
                    a[0] = __builtin_amdgcn_exp2f(a[0]); a[1] = __builtin_amdgcn_exp2f(a[1]); c[0] = __builtin_amdgcn_exp2f(c[0]); c[1] = __builtin_amdgcn_exp2f(c[1]);
                    S0[i] = a[0]; S0[i + 1] = a[1]; S1[i] = c[0]; S1[i + 1] = c[1];
                    ps2 += a; ps2 += c;
                }
                l += ps2[0] + ps2[1];
#pragma unroll
                for (int g = 0; g < 4; ++g) { const f32x16_t& Sx = (g >> 1) ? S1 : S0; const int o8 = 8 * (g & 1);
                    const bf16x8_t pf = __builtin_bit_cast(bf16x8_t, make_uint4(pkbf(Sx[o8 + 0], Sx[o8 + 1]), pkbf(Sx[o8 + 2], Sx[o8 + 3]), pkbf(Sx[o8 + 4], Sx[o8 + 5]), pkbf(Sx[o8 + 6], Sx[o8 + 7])));
                    O0 = __builtin_amdgcn_mfma_f32_32x32x16_bf16(va[2 * g], pf, O0, 0, 0, 0);
                    O1 = __builtin_amdgcn_mfma_f32_32x32x16_bf16(va[2 * g + 1], pf, O1, 0, 0, 0);
                }
            }
        }
        if (t + 1 < ntiles) ATT_WRITE((t + 1) & 1);
        __syncthreads();
    }
#undef ATT_LOAD
#undef ATT_KS
#undef ATT_WRITE
    float lt = l + __shfl_xor(l, 32);
    if (SWA) lt += __builtin_amdgcn_exp2f(sinkl2 - m);
    const float inv = 1.f / lt;
    bf16_t* op = MIX + (size_t)qrow * 1024 + ocol + 4 * h;
#pragma unroll
    for (int g = 0; g < 4; ++g) {
        *(uint2*)(op + 8 * g) = make_uint2(pkbf(O0[4 * g] * inv, O0[4 * g + 1] * inv), pkbf(O0[4 * g + 2] * inv, O0[4 * g + 3] * inv));
        *(uint2*)(op + 32 + 8 * g) = make_uint2(pkbf(O1[4 * g] * inv, O1[4 * g + 1] * inv), pkbf(O1[4 * g + 2] * inv, O1[4 * g + 3] * inv));
    }
}


typedef int i32x8_t __attribute__((ext_vector_type(8)));
typedef int i32x4_t __attribute__((ext_vector_type(4)));
#define A8_KP 144
__device__ __forceinline__ i32x8_t lds_frag32(LAS const unsigned char* p) { const i32x4_t lo = *(LAS const i32x4_t*)p, hi = *(LAS const i32x4_t*)(p + 16); return __builtin_shufflevector(lo, hi, 0, 1, 2, 3, 4, 5, 6, 7); }
__device__ __forceinline__ int cvt4_f8(float a, float b, float c, float d) { return __builtin_amdgcn_cvt_pk_fp8_f32(c, d, __builtin_amdgcn_cvt_pk_fp8_f32(a, b, 0, false), true); }
__device__ __forceinline__ void attn_unit_f8(LAS unsigned char* lds, const unsigned char* QK8, const unsigned char* V8T, bf16_t* MIX, int b, int q0, int head, int band_lo, int band_hi, float qscale) {
    constexpr int STAGE = 128 * A8_KP + 64 * A8_KP;
    int tid_ = threadIdx.x; asm volatile("" : "+v"(tid_));
    const int tid = tid_, wid = __builtin_amdgcn_readfirstlane(tid >> 6), lane = tid & 63, r = lane & 31, h = lane >> 5;
    const int nb = (band_hi - band_lo) >> 7, ntiles = nb + 2;
    const int qi = q0 + 32 * wid + r, qrow = tok_row(b, qi);
    i32x8_t qf[2];
    { const unsigned char* qp = QK8 + (size_t)qrow * 1024 + head * 128 + 32 * h;
#pragma unroll
      for (int s = 0; s < 2; ++s) { const i32x4_t lo = *(const i32x4_t*)(qp + 64 * s), hi = *(const i32x4_t*)(qp + 64 * s + 16); qf[s] = __builtin_shufflevector(lo, hi, 0, 1, 2, 3, 4, 5, 6, 7); } }
    f32x16_t O0, O1;
#pragma unroll
    for (int i = 0; i < 16; ++i) { O0[i] = 0.f; O1[i] = 0.f; }
    float m = -1e30f;
    f32x16_t Ls;
#pragma unroll
    for (int i = 0; i < 16; ++i) Ls[i] = 0.f;
    const i32x8_t ones8 = {0x38383838, 0x38383838, 0x38383838, 0x38383838, 0x38383838, 0x38383838, 0x38383838, 0x38383838};
    u32x4_t kreg[2], vreg;
    const unsigned char* vbase = V8T + (size_t)((b * 4 + head) * 64 + (tid >> 3)) * 4352 + (tid & 7) * 16;
#define A8_KS(t) ((t) < nb ? band_lo + 128 * (t) : SEQ + 128 * ((t) - nb))
#define A8_LOAD(t) do { const int ks_ = A8_KS(t); const unsigned char* base_ = QK8 + (size_t)tok_row(b, ks_) * 1024 + 512 + head * 128; \
        _Pragma("unroll") for (int i_ = 0; i_ < 2; ++i_) { const int idx_ = tid + 512 * i_; kreg[i_] = *(const u32x4_t*)(base_ + (size_t)(idx_ >> 3) * 1024 + (idx_ & 7) * 16); } \
        vreg = *(const u32x4_t*)(vbase + ks_); } while (0)
#define A8_WRITE(buf) do { LAS unsigned char* kb_ = lds + (buf) * STAGE; \
        _Pragma("unroll") for (int i_ = 0; i_ < 2; ++i_) { const int idx_ = tid + 512 * i_; *(LAS u32x4_t*)(kb_ + (idx_ >> 3) * A8_KP + (idx_ & 7) * 16) = kreg[i_]; } \
        *(LAS u32x4_t*)(kb_ + 128 * A8_KP + (tid >> 3) * A8_KP + (tid & 7) * 16) = vreg; } while (0)
    const int foff = r * A8_KP + 32 * h;
    __syncthreads();
    A8_LOAD(0); A8_WRITE(0);
    __syncthreads();
    typedef float f32x2_t __attribute__((ext_vector_type(2)));
    const f32x2_t qs2 = {qscale, qscale};
    for (int t = 0; t < ntiles; ++t) {
        if (t + 1 < ntiles) A8_LOAD(t + 1);
        LAS const unsigned char* kb = lds + (t & 1) * STAGE; LAS const unsigned char* vb = kb + 128 * A8_KP;
        f32x16_t S[4];
#pragma unroll
        for (int blk = 0; blk < 4; ++blk)
#pragma unroll
            for (int i = 0; i < 16; ++i) S[blk][i] = 0.f;
#pragma unroll
        for (int blk = 0; blk < 4; ++blk)
#pragma unroll
            for (int s = 0; s < 2; ++s) S[blk] = __builtin_amdgcn_mfma_scale_f32_32x32x64_f8f6f4(lds_frag32(kb + (blk * 32) * A8_KP + foff + 64 * s), qf[s], S[blk], 0, 0, 0, 0, 0, 0);
#pragma unroll
        for (int sub = 0; sub < 2; ++sub) {
            f32x16_t& S0 = S[2 * sub]; f32x16_t& S1 = S[2 * sub + 1];
            const i32x8_t va0 = lds_frag32(vb + foff + 64 * sub), va1 = lds_frag32(vb + 32 * A8_KP + foff + 64 * sub);
            float mx = max3f(S0[0], S0[1], S1[0]), mx2 = max3f(S0[2], S0[3], S1[1]);
            mx = max3f(mx, S1[2], S1[3]);
#pragma unroll
            for (int i = 4; i < 16; i += 4) { mx = max3f(mx, S0[i], S0[i + 1]); mx2 = max3f(mx2, S0[i + 2], S0[i + 3]); mx = max3f(mx, S1[i], S1[i + 1]); mx2 = max3f(mx2, S1[i + 2], S1[i + 3]); }
            mx = fmaxf(mx, mx2);
            { const auto rr_ = __builtin_amdgcn_permlane32_swap(__float_as_uint(mx), __float_as_uint(mx), false, false); mx = fmaxf(__uint_as_float(rr_[0]), __uint_as_float(rr_[1])); }
            mx *= qscale;
            if (__any(mx > m + ATT_THR)) {
                const float mn = fmaxf(m, mx), al = __builtin_amdgcn_exp2f(m - mn);
                m = mn; Ls[0] *= al;
#pragma unroll
                for (int i = 0; i < 16; ++i) { O0[i] *= al; O1[i] *= al; }
            }
            const f32x2_t m2 = {-m, -m};
#pragma unroll
            for (int i = 0; i < 16; i += 2) {
                f32x2_t a = (f32x2_t){S0[i], S0[i + 1]} * qs2 + m2, c = (f32x2_t){S1[i], S1[i + 1]} * qs2 + m2;
                a[0] = __builtin_amdgcn_exp2f(a[0]); a[1] = __builtin_amdgcn_exp2f(a[1]); c[0] = __builtin_amdgcn_exp2f(c[0]); c[1] = __builtin_amdgcn_exp2f(c[1]);
                S0[i] = a[0]; S0[i + 1] = a[1]; S1[i] = c[0]; S1[i + 1] = c[1];
            }
            i32x8_t pf;
#pragma unroll
            for (int w = 0; w < 4; ++w) { pf[w] = cvt4_f8(S0[4 * w], S0[4 * w + 1], S0[4 * w + 2], S0[4 * w + 3]); pf[4 + w] = cvt4_f8(S1[4 * w], S1[4 * w + 1], S1[4 * w + 2], S1[4 * w + 3]); }
            O0 = __builtin_amdgcn_mfma_scale_f32_32x32x64_f8f6f4(va0, pf, O0, 0, 0, 0, 0, 0, 0);
            O1 = __builtin_amdgcn_mfma_scale_f32_32x32x64_f8f6f4(va1, pf, O1, 0, 0, 0, 0, 0, 0);
            Ls = __builtin_amdgcn_mfma_scale_f32_32x32x64_f8f6f4(ones8, pf, Ls, 0, 0, 0, 0, 0, 0);
        }
        if (t + 1 < ntiles) A8_WRITE((t + 1) & 1);
        __syncthreads();
    }
#undef A8_LOAD
#undef A8_KS
#undef A8_WRITE
    const float inv = 1.f / Ls[0];
    bf16_t* op = MIX + (size_t)qrow * 1024 + head * 64 + 4 * h;
#pragma unroll
    for (int g = 0; g < 4; ++g) {
        *(uint2*)(op + 8 * g) = make_uint2(pkbf(O0[4 * g] * inv, O0[4 * g + 1] * inv), pkbf(O0[4 * g + 2] * inv, O0[4 * g + 3] * inv));
        *(uint2*)(op + 32 + 8 * g) = make_uint2(pkbf(O1[4 * g] * inv, O1[4 * g + 1] * inv), pkbf(O1[4 * g + 2] * inv, O1[4 * g + 3] * inv));
    }
}
__device__ __forceinline__ float log2_sigmoid(float x) { return log2f(1.f / (1.f + expf(-x))); }

__device__ __forceinline__ void ph_ret_T(const P& p, int layer, LAS unsigned char* lds) {
    const bf16_t* POST = (const bf16_t*)(p.ws + OFF_POST); const bf16_t* PROJB = (const bf16_t*)(p.ws + OFF_PROJ);
    bf16_t* TT = (bf16_t*)(p.ws + OFF_TT);
    int tid_ = threadIdx.x; asm volatile("" : "+v"(tid_));
    const int tid = tid_, wid = __builtin_amdgcn_readfirstlane(tid >> 6), lane = tid & 63, h2 = lane >> 5;
    const int G = gridDim.x, bid = blockIdx.x;
    const int trq = (lane & 15) >> 2, trc = (16 * ((lane >> 4) & 1) + 4 * (lane & 3)) * 2;
    for (int u = bid; u < BATCH * 34 * 2; u += G) {
        const int hp = u & 1, c = (u >> 1) % 34, b = u / 68;
        const int row0 = c < 32 ? b * SEQ + c * 128 : T_LAT + b * CTXL + (c - 32) * 128;
        __syncthreads();
#pragma unroll
        for (int i = 0; i < 8; ++i) {
            const int idx = tid + 512 * i, arr = idx >> 10, rem = idx & 1023, row = rem >> 3, pc = rem & 7;
            const u32x4_t v = arr < 2 ? *(const u32x4_t*)(POST + (size_t)(row0 + row) * POST_LD + PC_RK + (2 * hp + (arr & 1)) * 64 + pc * 8)
                                      : *(const u32x4_t*)(PROJB + (size_t)(row0 + row) * PROJ_LD + PJ_RV + (2 * hp + (arr & 1)) * 64 + pc * 8);
            *(LAS u32x4_t*)(lds + arr * 24576 + row * 192 + pc * 16) = v;
        }
        __syncthreads();
        const int hh = wid >> 2, head = 2 * hp + hh, dir = (wid >> 1) & 1, dvb = wid & 1;
        const float lg = log2_sigmoid(dir ? p.in[15][layer * 4 + head] : p.in[14][layer * 4 + head]);
        f32x16_t acc0, acc1;
#pragma unroll
        for (int i = 0; i < 16; ++i) { acc0[i] = 0.f; acc1[i] = 0.f; }
        LAS const unsigned char* kt = lds + hh * 24576; LAS const unsigned char* vt = lds + (2 + hh) * 24576;
#pragma unroll
        for (int s = 0; s < 8; ++s) {
            const int kr = 16 * s + 8 * h2;
            LAS const unsigned char* vp = vt + (kr + trq) * 192 + dvb * 64 + trc;
            const s16x4_t vlo = lds_tr16(vp), vhi = lds_tr16(vp + 4 * 192);
            const bf16x8_t a = {vlo[0], vlo[1], vlo[2], vlo[3], vhi[0], vhi[1], vhi[2], vhi[3]};
            float w[8];
#pragma unroll
            for (int j = 0; j < 8; ++j) w[j] = __builtin_amdgcn_exp2f(lg * (float)(dir ? (kr + j) : (127 - kr - j)));
#pragma unroll
            for (int dkb = 0; dkb < 2; ++dkb) {
                LAS const unsigned char* kp = kt + (kr + trq) * 192 + dkb * 64 + trc;
                const s16x4_t klo = lds_tr16(kp), khi = lds_tr16(kp + 4 * 192);
                float f[8];
#pragma unroll
                for (int j = 0; j < 4; ++j) { f[j] = bf2f((bf16_t)klo[j]) * w[j]; f[4 + j] = bf2f((bf16_t)khi[j]) * w[4 + j]; }
                const bf16x8_t bb = __builtin_bit_cast(bf16x8_t, make_uint4(pkbf(f[0], f[1]), pkbf(f[2], f[3]), pkbf(f[4], f[5]), pkbf(f[6], f[7])));
                if (dkb == 0) acc0 = __builtin_amdgcn_mfma_f32_32x32x16_bf16(a, bb, acc0, 0, 0, 0);
                else acc1 = __builtin_amdgcn_mfma_f32_32x32x16_bf16(a, bb, acc1, 0, 0, 0);
            }
        }
        bf16_t* tp = TT + ((((size_t)(b * 4 + head) * 34 + c) * 2 + dir) * 4096) + (lane & 31);
#pragma unroll
        for (int i = 0; i < 16; ++i) { const int dv = 32 * dvb + (i & 3) + 8 * (i >> 2) + 4 * h2; tp[dv * 64] = f2bf(acc0[i]); tp[dv * 64 + 32] = f2bf(acc1[i]); }
    }
}

__device__ __forceinline__ void ret_unit(LAS unsigned char* lds, const P& p, int layer, int b, int c, int hp) {
    const bf16_t* POST = (const bf16_t*)(p.ws + OFF_POST); const bf16_t* PROJB = (const bf16_t*)(p.ws + OFF_PROJ);
    bf16_t* MIX = (bf16_t*)(p.ws + OFF_H);
    const bf16_t* TT = (const bf16_t*)(p.ws + OFF_TT);
    int tid_ = threadIdx.x; asm volatile("" : "+v"(tid_));
    const int tid = tid_, wid = __builtin_amdgcn_readfirstlane(tid >> 6), lane = tid & 63, r = lane & 31, h2 = lane >> 5;
    const bool isctx = c >= 32;
    const int row0 = !isctx ? b * SEQ + c * 128 : T_LAT + b * CTXL + (c - 32) * 128;
    constexpr int L_ST = 0, L_K = 36864, L_V = 73728;
    __syncthreads();
#pragma unroll
    for (int i = 0; i < 8; ++i) {
        const int idx = tid + 512 * i, arr = idx >> 10, rem = idx & 1023, row = rem >> 3, pc = rem & 7;
        const u32x4_t v = arr < 2 ? *(const u32x4_t*)(POST + (size_t)(row0 + row) * POST_LD + PC_RK + (2 * hp + (arr & 1)) * 64 + pc * 8)
                                      : *(const u32x4_t*)(PROJB + (size_t)(row0 + row) * PROJ_LD + PJ_RV + (2 * hp + (arr & 1)) * 64 + pc * 8);
        if (arr < 2) *(LAS u32x4_t*)(lds + L_K + (arr & 1) * 18432 + row * 144 + pc * 16) = v;
        else *(LAS u32x4_t*)(lds + L_V + (arr & 1) * 24576 + row * 192 + pc * 16) = v;
    }
    {
        const int hd = tid >> 7, hh = hd >> 1, dir = hd & 1, head = 2 * hp + hh;
        const float g128 = 128.f * log2_sigmoid(dir ? p.in[15][layer * 4 + head] : p.in[14][layer * 4 + head]);
        const bf16_t* tb = TT + (size_t)(b * 4 + head) * 34 * 2 * 4096 + dir * 4096 + (tid & 127) * 4;
        f32x4_t acc[8];
#pragma unroll
        for (int i = 0; i < 8; ++i) acc[i] = (f32x4_t){0.f, 0.f, 0.f, 0.f};
        int v0, v1;
        if (!isctx) { if (dir == 0) { v0 = -2; v1 = c - 1; } else { v0 = c + 1; v1 = 33; } }
        else { const int cc = c - 32; if (dir == 0) { v0 = -2; v1 = cc - 3; } else { v0 = 33 + cc; v1 = 33; } }
        for (int v = v0; v <= v1; ++v) {
            const int idxT = v < 0 ? 34 + v : v;
            const float coef = __builtin_amdgcn_exp2f(g128 * (float)(dir == 0 ? (v1 - v) : (v - v0)));
            const bf16_t* tp = tb + (size_t)idxT * 2 * 4096;
#pragma unroll
            for (int i = 0; i < 8; ++i) { const uint2 r_ = *(const uint2*)(tp + 512 * i);
                const f32x4_t x = {__uint_as_float(r_.x << 16), __uint_as_float(r_.x & 0xFFFF0000u), __uint_as_float(r_.y << 16), __uint_as_float(r_.y & 0xFFFF0000u)}; acc[i] += x * coef; }
        }
#pragma unroll
        for (int i = 0; i < 8; ++i) { const int e = (tid & 127) * 4 + 512 * i, dv = e >> 6, dk = e & 63;
            typedef unsigned u32x2_t __attribute__((ext_vector_type(2))); *(LAS u32x2_t*)(lds + L_ST + hd * 9216 + dv * 144 + dk * 2) = (u32x2_t){pkbf(acc[i][0], acc[i][1]), pkbf(acc[i][2], acc[i][3])}; }
    }
    __syncthreads();
    const int hh = wid >> 2, head = 2 * hp + hh, qb = wid & 3, qi = 32 * qb + r;
    const int qrow = row0 + qi;
    const float lgf = log2_sigmoid(p.in[14][layer * 4 + head]), lgb = log2_sigmoid(p.in[15][layer * 4 + head]);
    bf16x8_t qf[4];
    { const bf16_t* qp = POST + (size_t)qrow * POST_LD + PC_RQ + head * 64 + 8 * h2;
#pragma unroll
      for (int s = 0; s < 4; ++s) qf[s] = *(const bf16x8_t*)(qp + 16 * s); }
    f32x16_t O0, O1;
#pragma unroll
    for (int i = 0; i < 16; ++i) { O0[i] = 0.f; O1[i] = 0.f; }
    LAS const unsigned char* kt = lds + L_K + hh * 18432; LAS const unsigned char* vt = lds + L_V + hh * 24576;
    const int voff = (4 * h2 + ((lane & 15) >> 2)) * 192 + (16 * ((lane >> 4) & 1) + 4 * (lane & 3)) * 2;
#pragma unroll
    for (int blk = 0; blk < 4; ++blk) {
        f32x16_t S;
#pragma unroll
        for (int i = 0; i < 16; ++i) S[i] = 0.f;
#pragma unroll
        for (int s = 0; s < 4; ++s) { const bf16x8_t a = *(LAS const bf16x8_t*)(kt + (32 * blk + r) * 144 + 32 * s + 16 * h2); S = __builtin_amdgcn_mfma_f32_32x32x16_bf16(a, qf[s], S, 0, 0, 0); }
#pragma unroll
        for (int i = 0; i < 16; ++i) { const int d = qi - (32 * blk + (i & 3) + 8 * (i >> 2) + 4 * h2);
            const float w = d > 0 ? __builtin_amdgcn_exp2f(lgf * (float)d) : (d == 0 ? 2.f : __builtin_amdgcn_exp2f(lgb * (float)(-d)));
            S[i] *= w; }
#pragma unroll
        for (int s2 = 0; s2 < 2; ++s2) {
            const bf16x8_t pf = __builtin_bit_cast(bf16x8_t, make_uint4(pkbf(S[8 * s2 + 0], S[8 * s2 + 1]), pkbf(S[8 * s2 + 2], S[8 * s2 + 3]), pkbf(S[8 * s2 + 4], S[8 * s2 + 5]), pkbf(S[8 * s2 + 6], S[8 * s2 + 7])));
            LAS const unsigned char* vp = vt + (32 * blk + 16 * s2) * 192 + voff;
            const s16x4_t lo0 = lds_tr16(vp), hi0 = lds_tr16(vp + 8 * 192), lo1 = lds_tr16(vp + 64), hi1 = lds_tr16(vp + 8 * 192 + 64);
            const bf16x8_t a0 = {lo0[0], lo0[1], lo0[2], lo0[3], hi0[0], hi0[1], hi0[2], hi0[3]};
            const bf16x8_t a1 = {lo1[0], lo1[1], lo1[2], lo1[3], hi1[0], hi1[1], hi1[2], hi1[3]};
            O0 = __builtin_amdgcn_mfma_f32_32x32x16_bf16(a0, pf, O0, 0, 0, 0);
            O1 = __builtin_amdgcn_mfma_f32_32x32x16_bf16(a1, pf, O1, 0, 0, 0);
        }
    }
#pragma unroll
    for (int dir = 0; dir < 2; ++dir) {
        f32x16_t T0, T1;
#pragma unroll
        for (int i = 0; i < 16; ++i) { T0[i] = 0.f; T1[i] = 0.f; }
        LAS const unsigned char* st = lds + L_ST + (hh * 2 + dir) * 9216;
#pragma unroll
        for (int s = 0; s < 4; ++s) {
            const bf16x8_t a0 = *(LAS const bf16x8_t*)(st + r * 144 + 32 * s + 16 * h2), a1 = *(LAS const bf16x8_t*)(st + (32 + r) * 144 + 32 * s + 16 * h2);
            T0 = __builtin_amdgcn_mfma_f32_32x32x16_bf16(a0, qf[s], T0, 0, 0, 0);
            T1 = __builtin_amdgcn_mfma_f32_32x32x16_bf16(a1, qf[s], T1, 0, 0, 0);
        }
        const float coef = dir == 0 ? __builtin_amdgcn_exp2f(lgf * (float)(qi + 1)) : __builtin_amdgcn_exp2f(lgb * (float)(128 - qi));
#pragma unroll
        for (int i = 0; i < 16; ++i) { O0[i] += coef * T0[i]; O1[i] += coef * T1[i]; }
    }
    float ss = 0.f;
#pragma unroll
    for (int i = 0; i < 16; ++i) ss += O0[i] * O0[i] + O1[i] * O1[i];
    ss += __shfl_xor(ss, 32);
    const float rs = rsqrtf(ss * (1.f / 64.f) + NORM_EPS);
    const bf16_t* gp = PROJB + (size_t)qrow * PROJ_LD + PJ_RG + head * 64 + 4 * h2;
    bf16_t* op = MIX + (size_t)qrow * 1024 + 768 + head * 64 + 4 * h2;
#pragma unroll
    for (int g = 0; g < 4; ++g) {
        const uint2 g0 = *(const uint2*)(gp + 8 * g), g1 = *(const uint2*)(gp + 32 + 8 * g);
        float gv[8] = {__uint_as_float(g0.x << 16), __uint_as_float(g0.x & 0xFFFF0000u), __uint_as_float(g0.y << 16), __uint_as_float(g0.y & 0xFFFF0000u),
                       __uint_as_float(g1.x << 16), __uint_as_float(g1.x & 0xFFFF0000u), __uint_as_float(g1.y << 16), __uint_as_float(g1.y & 0xFFFF0000u)};
        float o[8];
#pragma unroll
        for (int j = 0; j < 4; ++j) { o[j] = O0[4 * g + j] * rs * silu_f(gv[j]); o[4 + j] = O1[4 * g + j] * rs * silu_f(gv[4 + j]); }
        *(uint2*)(op + 8 * g) = make_uint2(pkbf(o[0], o[1]), pkbf(o[2], o[3]));
        *(uint2*)(op + 32 + 8 * g) = make_uint2(pkbf(o[4], o[5]), pkbf(o[6], o[7]));
    }
}

__device__ __forceinline__ void ph_mixer_mfma(const P& p, int layer, bool ctxq, LAS unsigned char* lds) {
    const bf16_t* POST = (const bf16_t*)(p.ws + OFF_POST); const bf16_t* PROJB = (const bf16_t*)(p.ws + OFF_PROJ);
    bf16_t* MIX = (bf16_t*)(p.ws + OFF_H);
    const int G = gridDim.x, bid = blockIdx.x;
    const float L2E = 1.4426950408889634f;
    const int n_mla = BATCH * 4 * 16, n_swa = BATCH * 8 * 16, n_mlac = ctxq ? BATCH * 4 : 0, n_swac = ctxq ? BATCH * 8 : 0;
    const int n_ret = BATCH * 32 * 2, n_retc = ctxq ? BATCH * 2 * 2 : 0;
    const int total = n_mla + n_swa + n_mlac + n_swac + n_ret + n_retc;
    const int nmine = (total - bid + G - 1) / G;
    for (int k = 0; k < nmine; ++k) { const int u = bid + ((bid & 1) ? (nmine - 1 - k) : k) * G;
        if (u < n_mla) {
            const int qb = u & 15, h = (u >> 4) & 3, b = u >> 6;
            attn_unit_f8(lds, p.ws + OFF_QK8, p.ws + OFF_V8T, MIX, b, qb * 256, h, 0, SEQ, 0.10206207261596575f * L2E);
        } else if (u < n_mla + n_swa) {
            const int v = u - n_mla, qb = v & 63, kvh = (v >> 6) & 1, b = v >> 7;
            const int q0 = qb * 64; int lo = (q0 - 128) & ~127; lo = lo < 0 ? 0 : lo; int hi = (q0 + 192 + 127) & ~127; hi = hi > SEQ ? SEQ : hi;
            attn_unit<64, true, true>(lds, POST, PROJB, PROJ_LD, MIX, b, q0, PC_QB + kvh * 256, PC_KB + kvh * 64, 992 + kvh * 64, 256 + kvh * 256, lo, hi, 0.f, 0.125f * L2E, p.in[13] + layer * 8 + kvh * 4, L2E);
        } else if (u < n_mla + n_swa + n_mlac) {
            const int v = u - n_mla - n_swa, h = v & 3, b = v >> 2;
            attn_unit_f8(lds, p.ws + OFF_QK8, p.ws + OFF_V8T, MIX, b, SEQ, h, 0, 0, 0.10206207261596575f * L2E);
        } else if (u < n_mla + n_swa + n_mlac + n_swac) {
            const int v = u - n_mla - n_swa - n_mlac, qb = v & 3, kvh = (v >> 2) & 1, b = v >> 3;
            attn_unit<64, true, true>(lds, POST, PROJB, PROJ_LD, MIX, b, SEQ + qb * 64, PC_QB + kvh * 256, PC_KB + kvh * 64, 992 + kvh * 64, 256 + kvh * 256, 0, 0, 0.f, 0.125f * L2E, p.in[13] + layer * 8 + kvh * 4, L2E);
        } else if (u < n_mla + n_swa + n_mlac + n_swac + n_ret) {
            const int v = u - n_mla - n_swa - n_mlac - n_swac;
            ret_unit(lds, p, layer, v >> 6, (v >> 1) & 31, v & 1);
        } else {
            const int v = u - n_mla - n_swa - n_mlac - n_swac - n_ret;
            ret_unit(lds, p, layer, v >> 2, 32 + ((v >> 1) & 1), v & 1);
        }
    }
}

__device__ __forceinline__ void ph_tables(const P& p) {
    float2* tr = (float2*)(p.ws + OFF_TAB); float2* t32 = tr + 4096 * 32; float2* t16 = t32 + 64 * 16;
    const int n = 4096 * 32 + 64 * 16 + 64 * 8;
    for (int i = blockIdx.x * NT + threadIdx.x; i < n; i += gridDim.x * NT) {
        float ang;
        if (i < 4096 * 32) ang = (float)(i >> 5) * rope_inv(2 * (i & 31), 64);
        else if (i < 4096 * 32 + 64 * 16) { const int j = i - 4096 * 32; ang = (float)(j >> 4) * rope_inv(2 * (j & 15), 32); }
        else { const int j = i - 4096 * 32 - 64 * 16; ang = (float)(j >> 3) * rope_inv(2 * (j & 7), 16); }
        tr[i] = make_float2(cosf(ang), sinf(ang));
    }
}

__device__ __forceinline__ void ph_prep2(const P& p, int layer, LAS unsigned char* lds) {
    const bf16_t* PROJ = (const bf16_t*)(p.ws + OFF_PROJ);
    bf16_t* POST = (bf16_t*)(p.ws + OFF_POST);
    unsigned char* QK8 = p.ws + OFF_QK8; unsigned char* V8T = p.ws + OFF_V8T;
#define CVT4_F8(a_, b_, c_, d_) __builtin_amdgcn_cvt_pk_fp8_f32(f8clamp(c_), f8clamp(d_), __builtin_amdgcn_cvt_pk_fp8_f32(f8clamp(a_), f8clamp(b_), 0, false), true)
    const bf16_t* WUQ = (const bf16_t*)(p.ws + OFF_WUQ) + (size_t)layer * 384 * 192;
    const bf16_t* WUKV = (const bf16_t*)(p.ws + OFF_WUKV) + (size_t)layer * 512 * 128;
    const float* qn = p.in[9] + layer * 192; const float* kvn = p.in[11] + layer * 128;
    const float2* tab_ret = (const float2*)(p.ws + OFF_TAB); const float2* tab32 = tab_ret + 4096 * 32; const float2* tab16 = tab32 + 64 * 16;
    int tid_ = threadIdx.x; asm volatile("" : "+v"(tid_));
    const int tid = tid_, wid = __builtin_amdgcn_readfirstlane(tid >> 6), lane = tid & 63, fr = lane & 15, fq = lane >> 4;
    constexpr int QP = 400, KVP = 272, L_CQ = 0, L_CKV = 32 * QP;
    constexpr int SQP = 1040, L_SQ = L_CKV + 32 * KVP, L_SV = L_SQ + 32 * SQP;
#define PREP_LOADS(RA, RB, RC, RK, P1, P2, UNIT) do { const int R0_ = (UNIT) * 32; int tidA = tid; asm volatile("" : "+v"(tidA)); const int tk_ = tidA >> 4, sub_ = tidA & 15; \
        { const bf16_t* pr_ = PROJ + (size_t)(R0_ + tk_) * PROJ_LD; RA = *(const uint2*)(pr_ + sub_ * 12); RB = *(const uint2*)(pr_ + sub_ * 12 + 4); RC = *(const uint2*)(pr_ + sub_ * 12 + 8); RK = *(const u32x4_t*)(pr_ + 192 + sub_ * 8); } \
        _Pragma("unroll") for (int it_ = 0; it_ < 5; ++it_) { const int w_ = it_ * NT + tidA; \
            if (w_ < 32 * 74) { const int tok_ = w_ / 74, task_ = w_ % 74; int src_, dist_; \
                if (task_ < 40) { const int hd_ = task_ >> 2, half_ = (task_ >> 1) & 1, cp_ = task_ & 1; src_ = (task_ < 32 ? 352 : 864 - 8 * 64) + hd_ * 64 + half_ * 32 + cp_ * 8; dist_ = 16; } \
                else if (task_ < 72) { const int q_ = task_ - 40, hd_ = q_ >> 2, cp_ = q_ & 3; src_ = (hd_ < 4 ? PJ_RQ + hd_ * 64 : PJ_RK + (hd_ - 4) * 64) + cp_ * 8; dist_ = 32; } \
                else { src_ = 320 + (task_ - 72) * 16; dist_ = 8; } \
                const bf16_t* pr_ = PROJ + (size_t)(R0_ + tok_) * PROJ_LD + src_; P1[it_] = *(const u32x4_t*)pr_; P2[it_] = *(const u32x4_t*)(pr_ + dist_); } \
            else { P1[it_] = (u32x4_t){0u, 0u, 0u, 0u}; P2[it_] = P1[it_]; } } } while (0)
    uint2 ra, rb, rc, na_, nb_, nc_; u32x4_t rk, nk_; u32x4_t p1[5], p2[5], n1[5], n2[5];
    if ((int)blockIdx.x < T_ALL / 32) PREP_LOADS(ra, rb, rc, rk, p1, p2, (int)blockIdx.x);
    for (int u = blockIdx.x; u < T_ALL / 32; u += gridDim.x) {
        const int R0 = u * 32; const bool isctx = R0 >= T_LAT;
        const int t0 = isctx ? (R0 - T_LAT) % CTXL : R0 % SEQ;
        const int tk = tid >> 4, sub = tid & 15;
        const bool has_next = u + (int)gridDim.x < T_ALL / 32;
        if (has_next) PREP_LOADS(na_, nb_, nc_, nk_, n1, n2, u + (int)gridDim.x);
        __syncthreads();
        *(LAS u32x4_t*)(lds + L_SQ + tk * SQP + (sub >> 3) * 512 + ((sub >> 1) & 3) * 128 + 96 + (sub & 1) * 16) = (u32x4_t){0u, 0u, 0u, 0u};
        {
            float c[12], k[8];
            c[0] = __uint_as_float(ra.x << 16); c[1] = __uint_as_float(ra.x & 0xFFFF0000u); c[2] = __uint_as_float(ra.y << 16); c[3] = __uint_as_float(ra.y & 0xFFFF0000u);
            c[4] = __uint_as_float(rb.x << 16); c[5] = __uint_as_float(rb.x & 0xFFFF0000u); c[6] = __uint_as_float(rb.y << 16); c[7] = __uint_as_float(rb.y & 0xFFFF0000u);
            c[8] = __uint_as_float(rc.x << 16); c[9] = __uint_as_float(rc.x & 0xFFFF0000u); c[10] = __uint_as_float(rc.y << 16); c[11] = __uint_as_float(rc.y & 0xFFFF0000u);
            unpack8(make_uint4(rk[0], rk[1], rk[2], rk[3]), k);
            float s1 = 0.f, s2 = 0.f;
#pragma unroll
            for (int i = 0; i < 12; ++i) s1 += c[i] * c[i];
#pragma unroll
            for (int i = 0; i < 8; ++i) s2 += k[i] * k[i];
#pragma unroll
            for (int o = 1; o < 16; o <<= 1) { s1 += __shfl_xor(s1, o); s2 += __shfl_xor(s2, o); }
            const float r1 = rsqrtf(s1 * (1.f / 192.f) + NORM_EPS), r2 = rsqrtf(s2 * (1.f / 128.f) + NORM_EPS);
            typedef unsigned u32x2_t __attribute__((ext_vector_type(2)));
#pragma unroll
            for (int i = 0; i < 3; ++i) { const int e = sub * 12 + 4 * i;
                *(LAS u32x2_t*)(lds + L_CQ + tk * QP + e * 2) = (u32x2_t){pkbf(c[4 * i] * r1 * qn[e], c[4 * i + 1] * r1 * qn[e + 1]), pkbf(c[4 * i + 2] * r1 * qn[e + 2], c[4 * i + 3] * r1 * qn[e + 3])}; }
            { const int e = sub * 8;
              *(LAS u32x4_t*)(lds + L_CKV + tk * KVP + e * 2) = (u32x4_t){pkbf(k[0] * r2 * kvn[e], k[1] * r2 * kvn[e + 1]), pkbf(k[2] * r2 * kvn[e + 2], k[3] * r2 * kvn[e + 3]),
                                                                        pkbf(k[4] * r2 * kvn[e + 4], k[5] * r2 * kvn[e + 5]), pkbf(k[6] * r2 * kvn[e + 6], k[7] * r2 * kvn[e + 7])}; }
        }
        __syncthreads();
        {
            pg8::f32x4 acc[3][2];
#pragma unroll
            for (int a = 0; a < 3; ++a)
#pragma unroll
                for (int m = 0; m < 2; ++m) acc[a][m] = (pg8::f32x4){0.f, 0.f, 0.f, 0.f};
#pragma unroll
            for (int ks = 0; ks < 6; ++ks) {
                bf16x8_t af[2];
#pragma unroll
                for (int m = 0; m < 2; ++m) af[m] = *(LAS const bf16x8_t*)(lds + L_CQ + (m * 16 + fr) * QP + (32 * ks + 8 * fq) * 2);
#pragma unroll
                for (int a = 0; a < 3; ++a) {
                    const bf16x8_t bfrag = *(const bf16x8_t*)(WUQ + (size_t)((3 * wid + a) * 16 + fr) * 192 + 32 * ks + 8 * fq);
#pragma unroll
                    for (int m = 0; m < 2; ++m) acc[a][m] = __builtin_amdgcn_mfma_f32_16x16x32_bf16(bfrag, af[m], acc[a][m], 0, 0, 0);
                }
            }
#pragma unroll
            for (int a = 0; a < 3; ++a) {
                const int nt = 3 * wid + a, t6 = nt % 6, col = nt * 16 + 4 * fq;
#pragma unroll
                for (int m = 0; m < 2; ++m) {
                    const int tok = m * 16 + fr, t = t0 + tok;
                    pg8::f32x4 v = acc[a][m];
                    if (t6 >= 4) {
                        pg8::f32x4 pv; pv[0] = __shfl_xor(v[0], 32); pv[1] = __shfl_xor(v[1], 32); pv[2] = __shfl_xor(v[2], 32); pv[3] = __shfl_xor(v[3], 32);
                        if (!isctx) { const int pos = t6 == 4 ? (t >> 6) : (t & 63);
#pragma unroll
                            for (int j = 0; j < 4; ++j) { const float2 cs = tab16[pos * 8 + 4 * (fq & 1) + j]; v[j] = v[j] * cs.x + (fq < 2 ? -pv[j] : pv[j]) * cs.y; } }
                    }
                    *(LAS int*)(lds + L_SQ + tok * SQP + (nt / 6) * 128 + t6 * 16 + 4 * fq) = CVT4_F8(v[0], v[1], v[2], v[3]);
                }
            }
        }
        {
            pg8::f32x4 acc[4][2];
#pragma unroll
            for (int a = 0; a < 4; ++a)
#pragma unroll
                for (int m = 0; m < 2; ++m) acc[a][m] = (pg8::f32x4){0.f, 0.f, 0.f, 0.f};
#pragma unroll
            for (int ks = 0; ks < 4; ++ks) {
                bf16x8_t af[2];
#pragma unroll
                for (int m = 0; m < 2; ++m) af[m] = *(LAS const bf16x8_t*)(lds + L_CKV + (m * 16 + fr) * KVP + (32 * ks + 8 * fq) * 2);
#pragma unroll
                for (int a = 0; a < 4; ++a) {
                    const bf16x8_t bfrag = *(const bf16x8_t*)(WUKV + (size_t)((4 * wid + a) * 16 + fr) * 128 + 32 * ks + 8 * fq);
#pragma unroll
                    for (int m = 0; m < 2; ++m) acc[a][m] = __builtin_amdgcn_mfma_f32_16x16x32_bf16(bfrag, af[m], acc[a][m], 0, 0, 0);
                }
            }
#pragma unroll
            for (int a = 0; a < 4; ++a) {
                const int n = (4 * wid + a) * 16 + 4 * fq, hh = n >> 7, d = n & 127;
                const int dst = d < 64 ? PC_KA + hh * 96 + d : PC_VA + hh * 64 + (d - 64);
#pragma unroll
                for (int m = 0; m < 2; ++m) { const pg8::f32x4 v = acc[a][m]; const int row = R0 + m * 16 + fr;
                    const int w8 = CVT4_F8(v[0], v[1], v[2], v[3]);
                    const int tl = m * 16 + fr; (void)row;
                    if (d < 64) *(LAS int*)(lds + L_SQ + tl * SQP + 512 + hh * 128 + d) = w8;
                    else { LAS unsigned char* vp = lds + L_SV + (hh * 64 + (d - 64)) * 32 + 16 * ((tl >> 2) & 1) + 4 * (tl >> 3) + (tl & 3);
                        vp[0] = (unsigned char)w8; vp[32] = (unsigned char)(w8 >> 8); vp[64] = (unsigned char)(w8 >> 16); vp[96] = (unsigned char)((unsigned)w8 >> 24); } }
                (void)dst;
            }
        }
        int tidB = tid; asm volatile("" : "+v"(tidB));
#pragma unroll
        for (int it = 0; it < 5; ++it) {
            const int w = it * NT + tidB;
            if (w < 32 * 74) {
                const int tok = w / 74, task = w % 74, t = t0 + tok;
                bf16_t* po = POST + (size_t)(R0 + tok) * POST_LD;
                int dst, dist; const float2* tb; float scl = 1.f; bool bc = false;
                if (task < 40) { const int hd = task >> 2, half = (task >> 1) & 1, cp = task & 1;
                    dst = (task < 32 ? PC_QB : PC_KB - 8 * 64) + hd * 64 + half * 32 + cp * 8; dist = 16; tb = tab32 + (half ? (t & 63) : (t >> 6)) * 16 + cp * 8; }
                else if (task < 72) { const int q = task - 40, hd = q >> 2, cp = q & 3;
                    dst = PC_RQ + hd * 64 + cp * 8; dist = 32; tb = tab_ret + t * 32 + cp * 8; if (hd >= 4) scl = 0.125f; }
                else { const int half = task - 72; dst = PC_KA + 64 + half * 16; dist = 8; bc = true; tb = tab16 + (half ? (t & 63) : (t >> 6)) * 8; }
                float x1[8], x2[8]; unpack8(make_uint4(p1[it][0], p1[it][1], p1[it][2], p1[it][3]), x1); unpack8(make_uint4(p2[it][0], p2[it][1], p2[it][2], p2[it][3]), x2);
                if (!isctx) {
                    const float4 c0 = *(const float4*)(tb), c1 = *(const float4*)(tb + 2), c2 = *(const float4*)(tb + 4), c3 = *(const float4*)(tb + 6);
                    const float cs[8] = {c0.x, c0.z, c1.x, c1.z, c2.x, c2.z, c3.x, c3.z}, sn[8] = {c0.y, c0.w, c1.y, c1.w, c2.y, c2.w, c3.y, c3.w};
#pragma unroll
                    for (int j = 0; j < 8; ++j) { const float a = x1[j], b2 = x2[j]; x1[j] = a * cs[j] - b2 * sn[j]; x2[j] = b2 * cs[j] + a * sn[j]; }
                }
#pragma unroll
                for (int j = 0; j < 8; ++j) { x1[j] *= scl; x2[j] *= scl; }
                const uint4 o1 = make_uint4(pkbf(x1[0], x1[1]), pkbf(x1[2], x1[3]), pkbf(x1[4], x1[5]), pkbf(x1[6], x1[7]));
                const uint4 o2 = make_uint4(pkbf(x2[0], x2[1]), pkbf(x2[2], x2[3]), pkbf(x2[4], x2[5]), pkbf(x2[6], x2[7]));
                if (bc) {
                    LAS unsigned char* k8 = lds + L_SQ + tok * SQP + 512 + 64 + (task - 72) * 16;
                    typedef unsigned u32x2_t __attribute__((ext_vector_type(2)));
                    const uint2 f1 = make_uint2((unsigned)CVT4_F8(x1[0], x1[1], x1[2], x1[3]), (unsigned)CVT4_F8(x1[4], x1[5], x1[6], x1[7]));
                    const uint2 f2 = make_uint2((unsigned)CVT4_F8(x2[0], x2[1], x2[2], x2[3]), (unsigned)CVT4_F8(x2[4], x2[5], x2[6], x2[7]));
#pragma unroll
                    for (int hh = 0; hh < 4; ++hh) { *(LAS u32x2_t*)(k8 + hh * 128) = (u32x2_t){f1.x, f1.y}; *(LAS u32x2_t*)(k8 + hh * 128 + 8) = (u32x2_t){f2.x, f2.y}; }
                } else { *(uint4*)(po + dst) = o1; *(uint4*)(po + dst + dist) = o2; }
            }
        }
        __syncthreads();
        {
            const int rr = tid >> 4, pc = tid & 15;
            uint4* qd = (uint4*)(QK8 + (size_t)(R0 + rr) * 1024 + pc * 64);
#pragma unroll
            for (int j = 0; j < 4; ++j) { const u32x4_t t4 = *(LAS const u32x4_t*)(lds + L_SQ + rr * SQP + pc * 64 + j * 16); qd[j] = make_uint4(t4[0], t4[1], t4[2], t4[3]); }
            int bb, key0; if (R0 < T_LAT) { bb = R0 >> 12; key0 = R0 & (SEQ - 1); } else { bb = (R0 - T_LAT) >> 8; key0 = SEQ + ((R0 - T_LAT) & (CTXL - 1)); }
            const int vr = tid >> 1, hf = tid & 1;
            const u32x4_t t4 = *(LAS const u32x4_t*)(lds + L_SV + vr * 32 + hf * 16);
            *(uint4*)(V8T + (size_t)((bb * 4 + (vr >> 6)) * 64 + (vr & 63)) * 4352 + (key0 & ~63) + 32 * hf + 16 * ((key0 >> 5) & 1)) = make_uint4(t4[0], t4[1], t4[2], t4[3]);
        }
        if (has_next) { ra = na_; rb = nb_; rc = nc_; rk = nk_;
#pragma unroll
            for (int it = 0; it < 5; ++it) { p1[it] = n1[it]; p2[it] = n2[it]; } }
    }
#undef PREP_LOADS
#undef CVT4_F8
}
#define N_PHASES 23
#define LDS_BYTES 147456
#define LDS_MISC 131072
__device__ __forceinline__ P load_p() {
#if defined(__HIP_DEVICE_COMPILE__)
    const __attribute__((address_space(4))) P* kq = (const __attribute__((address_space(4))) P*)__builtin_amdgcn_kernarg_segment_ptr();
    asm volatile("" : "+s"(kq));
    return *kq;
#else
    return P{};
#endif
}
__global__ void __launch_bounds__(NT, 2) fwd_kernel(P p0, int lo, int hi) {
    extern __shared__ __attribute__((aligned(16))) unsigned char lds_raw[];
    float* lds = (float*)lds_raw;
    LAS unsigned char* ldsl = (LAS unsigned char*)lds_raw;
    volatile LAS unsigned* st = (volatile LAS unsigned*)(ldsl + LDS_MISC);
    if (threadIdx.x < 4) st[threadIdx.x] = 0u;
    __syncthreads();
    XcdBarrier bar; bar.bar = (unsigned*)(p0.ws + OFF_CTL); bar.x = 0; bar.st = st;
    if (hi - lo > 1) bar = xcd_barrier_post((unsigned*)(p0.ws + OFF_CTL), st);
#define IN(k) (lo <= (k) && (k) < hi)
#define PH(k) if (IN(k)) if (const P p = load_p(); true)
#define SEAM(k) do { if (IN(k) && IN((k) + 1)) xcd_barrier(bar); } while (0)
#define MOD ((const float*)(p.ws + OFF_MOD))
#define H ((bf16_t*)(p.ws + OFF_H))
#define XC ((float*)(p.ws + OFF_XC))
#define PROJ ((bf16_t*)(p.ws + OFF_PROJ))
#define ACT ((bf16_t*)(p.ws + OFF_ACT))
#define CNT ((int*)(p.ws + OFF_CNT))
#define LIST ((const int*)(p.ws + OFF_LIST))
#define WL ((const float*)(p.ws + OFF_WL))
#define WIN ((const bf16_t*)(p.ws + OFF_WIN))
#define WOUT ((const bf16_t*)(p.ws + OFF_WOUT))
#define FGU ((const bf16_t*)(p.ws + OFF_FGU))
#define FD ((const bf16_t*)(p.ws + OFF_FD))
#define MGU ((const bf16_t*)(p.ws + OFF_MGU))
#define MDW ((const bf16_t*)(p.ws + OFF_MD))
#define YB ((bf16_t*)(p.ws + OFF_Y))
#define YB2 ((bf16_t*)(p.ws + OFF_Y2))
#define PARTB ((float*)(p.ws + OFF_PART))
    const int G = gridDim.x, bid = blockIdx.x;

    PH(0) { ph_mod(p, lds); ph_tables(p); ph_conv_early(p, lds); ph_fgu_colmax(p); }
    SEAM(0);
    PH(1) { ph_norm(p, 0, 1, T_ALL, false, true, nullptr, 0, 0, 0, p.ws + OFF_QK8, true); __syncthreads(); ph_conv_fgu_i8(p, lds); }
    SEAM(1);
#define WINL WIN
    PH(2) {
        { pg8::DenseSched S{H, WINL + (size_t)PJ_F8 * 1024, 1024, 1024, T_ALL / 256, (PROJ_LD - PJ_F8) / 256, G, bid}; pg8::EpiBf16 E{PROJ + PJ_F8, PROJ_LD}; pg8::gemm_phase(ldsl, S, E); }
        const int U2 = (T_ALL / 256) * ((PROJ_LD - PJ_F8) / 256), U8 = (T_ALL / 256) * (PJ_F8 / 256), x3 = U2 - 2 * G;
        const pg8::EpiBf16S E8{PROJ, PROJ_LD, 1.f / (F8_SH * F8_SW)};
        if (x3 > 0 && x3 < G && 3 * (G - x3) <= U8 && U8 - 3 * (G - x3) <= x3) {
            if (bid >= x3) { pg8::DenseSchedT<true> S{(const bf16_t*)(p.ws + OFF_QK8), WINL, 512, 512, T_ALL / 256, PJ_F8 / 256, G - x3, bid - x3, 0, 3 * (G - x3)}; pg8::gemm_phase(ldsl, S, E8); }
            else { pg8::DenseSchedT<true> S{(const bf16_t*)(p.ws + OFF_QK8), WINL, 512, 512, T_ALL / 256, PJ_F8 / 256, x3, bid, 3 * (G - x3), U8}; pg8::gemm_phase(ldsl, S, E8); }
        } else { pg8::DenseSchedT<true> S{(const bf16_t*)(p.ws + OFF_QK8), WINL, 512, 512, T_ALL / 256, PJ_F8 / 256, G, bid}; pg8::gemm_phase(ldsl, S, E8); } }
#undef WINL
    SEAM(2);
    PH(3) ph_prep2(p, 0, ldsl);
    SEAM(3);
    PH(4) ph_ret_T(p, 0, ldsl);
    SEAM(4);
    PH(5) ph_mixer_mfma(p, 0, true, ldsl);
    SEAM(5);
    PH(6) {
        { pg8::DenseSched S{H, WOUT, 1024, 1024, T_ALL / 256, 4, G, bid};
          pg8::EpiBf16Norm E{YB, 1024, (unsigned)((size_t)T_ALL * 1024 * 2), (unsigned*)(p.ws + OFF_PCNT), 1.f};
          pg8::gemm_phase(ldsl, S, E); }
        norm_help(p, NormArgs{0, 2, false, true, YB, 0, 2048, 0, p.ws + OFF_H8D, false, (float*)(p.ws + OFF_RS8)}, (unsigned*)(p.ws + OFF_PCNT), 32u, (unsigned*)(p.ws + OFF_CLAIM), T_ALL / 256, (LAS unsigned*)(ldsl + LDS_MISC + 32));
    }
    SEAM(6);
    PH(8) { pg8::DenseSchedT<false, true> S{(const bf16_t*)(p.ws + OFF_H8D), FGU, 512, 512, T_ALL / 256, 2 * D_FF / 256, G, bid};
            pg8::EpiSwigluI8 E{ACT, D_FF, (const float*)(p.ws + OFF_RS8), (const float*)(p.ws + OFF_CS8)}; pg8::gemm_phase(ldsl, S, E); }
    SEAM(8);
    PH(9) {
        { pg8::DenseSchedT<true> S{ACT, FD, D_FF / 2, D_FF / 2, T_ALL / 256, 4, G, bid};
          pg8::EpiBf16Norm E{YB2, 1024, (unsigned)((size_t)T_ALL * 1024 * 2), (unsigned*)(p.ws + OFF_PCNT) + 136 * 64, 1.f / (F8_SA * F8_SW)};
          pg8::gemm_phase(ldsl, S, E); }
        norm_help(p, NormArgs{1, 1, false, false, YB2, 0, 5120, 0, p.ws + OFF_QK8, true}, (unsigned*)(p.ws + OFF_PCNT) + 136 * 64, 32u, (unsigned*)(p.ws + OFF_CLAIM) + 64, T_ALL / 256, (LAS unsigned*)(ldsl + LDS_MISC + 32));
    }
    SEAM(9);
#define WINL (WIN + (size_t)PROJ_LD * 1024)
    PH(11) {
        { pg8::DenseSched S{H, WINL + (size_t)PJ_F8 * 1024, 1024, 1024, T_ALL / 256, (PROJ_LD - PJ_F8) / 256, G, bid}; pg8::EpiBf16 E{PROJ + PJ_F8, PROJ_LD}; pg8::gemm_phase(ldsl, S, E); }
        const int U2 = (T_ALL / 256) * ((PROJ_LD - PJ_F8) / 256), U8 = (T_ALL / 256) * (PJ_F8 / 256), x3 = U2 - 2 * G;
        const pg8::EpiBf16S E8{PROJ, PROJ_LD, 1.f / (F8_SH * F8_SW)};
        if (x3 > 0 && x3 < G && 3 * (G - x3) <= U8 && U8 - 3 * (G - x3) <= x3) {
            if (bid >= x3) { pg8::DenseSchedT<true> S{(const bf16_t*)(p.ws + OFF_QK8), WINL, 512, 512, T_ALL / 256, PJ_F8 / 256, G - x3, bid - x3, 0, 3 * (G - x3)}; pg8::gemm_phase(ldsl, S, E8); }
            else { pg8::DenseSchedT<true> S{(const bf16_t*)(p.ws + OFF_QK8), WINL, 512, 512, T_ALL / 256, PJ_F8 / 256, x3, bid, 3 * (G - x3), U8}; pg8::gemm_phase(ldsl, S, E8); }
        } else { pg8::DenseSchedT<true> S{(const bf16_t*)(p.ws + OFF_QK8), WINL, 512, 512, T_ALL / 256, PJ_F8 / 256, G, bid}; pg8::gemm_phase(ldsl, S, E8); } }
#undef WINL
    SEAM(11);
    PH(12) ph_prep2(p, 1, ldsl);
    SEAM(12);
    PH(13) ph_ret_T(p, 1, ldsl);
    SEAM(13);
    PH(14) ph_mixer_mfma(p, 1, false, ldsl);
    SEAM(14);
    PH(15) { pg8::DenseSched S{H, WOUT + (size_t)1024 * 1024, 1024, 1024, T_LAT / 256, 4, G, bid}; pg8::EpiBf16 E{YB, 1024}; pg8::gemm_phase(ldsl, S, E); }
    SEAM(15);
    PH(16) { ph_norm(p, 1, 2, T_LAT, true, false, YB, 1, 2048, 0, p.ws + OFF_H, false); ph_conv_late(p, lds); }
    SEAM(16);
#pragma unroll
    for (int s = 0; s < 2; ++s) {
        if (IN(17 + 2 * s) || IN(18 + 2 * s)) {
            LAS int* tab = (LAS int*)(ldsl + LDS_MISC + 64 + 128 * s);
            { const P p = load_p();
            __syncthreads();
            if (threadIdx.x == 0) { int tbv = 0; tab[8] = 0;
                for (int e = 0; e < 8; ++e) { const int ce = __hip_atomic_load(CNT + s * 8 + e, __ATOMIC_RELAXED, __HIP_MEMORY_SCOPE_AGENT); tab[e] = ce; tbv += (ce + 255) >> 8; tab[9 + e] = tbv; } }
            __syncthreads(); }
            const int nTm = tab[16];
            PH(17 + 2 * s) {
                if (s == 1) pg8::moe_combine((bf16_t*)(p.ws + OFF_YM), PARTB, (const LAS int*)(ldsl + LDS_MISC + 64), 4, 1.f / (F8_SA * F8_SW));
                pg8::MoeSched<true, true> S{H, MGU, 512, 512, 2 * D_FFE / 256, G, bid, (size_t)D_FFE * 1024, LIST + (size_t)s * 8 * 32768, tab, 0, nTm * (2 * D_FFE / 256), 1, 512 / 64};
                pg8::EpiSwigluT<true, true> E{ACT, D_FFE}; pg8::gemm_phase(ldsl, S, E);
            }
            SEAM(17 + 2 * s);
            PH(18 + 2 * s) {
                const int U = nTm * 4, rem = U % G, split = (rem > 0 && rem * MOE_WAYS <= G) ? 1 : 0, umain = split ? U - rem : U;
                { pg8::MoeSched<false, true> S{ACT, MDW, D_FFE / 2, D_FFE / 2, 4, G, bid, (size_t)512 * D_FFE, nullptr, tab, 0, umain, 1, D_FFE / 128};
                  pg8::EpiBf16S E{(bf16_t*)(p.ws + OFF_YM) + (size_t)s * ACT_ROWS * 1024, 1024, 1.f / (F8_SA * F8_SW)};
                  pg8::gemm_phase(ldsl, S, E); }
                if (split) { pg8::MoeSched<false, true> S{ACT, MDW, D_FFE / 2, D_FFE / 2, 4, G, bid, (size_t)512 * D_FFE, nullptr, tab, umain, U, MOE_WAYS, D_FFE / 128 / MOE_WAYS};
                  pg8::EpiPart E{PARTB}; pg8::gemm_phase(ldsl, S, E); }
            }
        }
        SEAM(18 + 2 * s);
    }
    PH(21) { const LAS int* tab1 = (const LAS int*)(ldsl + LDS_MISC + 64 + 128);
        pg8::moe_combine((bf16_t*)(p.ws + OFF_YM) + (size_t)ACT_ROWS * 1024, PARTB, tab1, 4, 1.f / (F8_SA * F8_SW)); }
    SEAM(21);
    PH(22) ph_final_moe(p, (const LAS int*)(ldsl + LDS_MISC + 64), (const LAS int*)(ldsl + LDS_MISC + 64 + 128));
}

extern "C" void kernel_launch(void* const* d_in, const int* in_sizes, int n_in, void* d_out, int out_size, void* d_ws, size_t ws_size, hipStream_t stream) {
    static int grid = 0;
    if (!grid) {
        if (n_in != 25 || out_size != T_LAT * 1024 || ws_size < WS_END) { fprintf(stderr, "kernel_launch: unexpected shapes (n_in %d out %d ws %zu need %zu)\n", n_in, out_size, ws_size, (size_t)WS_END); grid = -1; return; }
        int dev = 0, cus = 0, per_cu = 0;
        (void)hipGetDevice(&dev); (void)hipDeviceGetAttribute(&cus, hipDeviceAttributeMultiprocessorCount, dev);
        (void)hipFuncSetAttribute((const void*)fwd_kernel, hipFuncAttributeMaxDynamicSharedMemorySize, LDS_BYTES);
        (void)hipOccupancyMaxActiveBlocksPerMultiprocessor(&per_cu, (const void*)fwd_kernel, NT, LDS_BYTES);
        if (per_cu < 1) { fprintf(stderr, "kernel_launch: occupancy query says %d\n", per_cu); }
        grid = cus > 0 ? cus : 256;
    }
    if (grid < 0) return;
    (void)hipMemsetAsync((char*)d_ws + OFF_CTL, 0, CTL_BYTES, stream);
    P p{};
    for (int i = 0; i < 25; ++i) p.in[i] = (const float*)d_in[i];
    p.out = (float*)d_out; p.ws = (unsigned char*)d_ws;
    hipLaunchKernelGGL(fwd_kernel, dim3(grid), dim3(NT), LDS_BYTES, stream, p, 0, N_PHASES);
}
```

```cpp
#include <hip/hip_runtime.h>
#include <stdint.h>
#include <stdio.h>

#define D_MODEL 1024
#define BATCH 8
#define SEQ 4096
#define CTXL 256
#define T_LAT (BATCH * SEQ)
#define T_CTX (BATCH * CTXL)
#define T_ALL (T_LAT + T_CTX)
#define IN_DIM 2144
#define PROJ_LD 2304
#define POST_LD 2816
#define D_FF 2816
#define D_FFE 3584
#define NEXP 8
#define NT 512
#define NORM_EPS 1e-6f

typedef unsigned short bf16_t;
__device__ __forceinline__ float bf2f(bf16_t v) { return __uint_as_float(((unsigned)v) << 16); }
__device__ __forceinline__ bf16_t f2bf(float f) { unsigned u = __float_as_uint(f); u += 0x7FFFu + ((u >> 16) & 1u); return (bf16_t)(u >> 16); }
__device__ __forceinline__ float silu_f(float v) { return v / (1.f + expf(-v)); }

#define PJ_RQ 1280
#define PJ_RK 1536
#define PJ_RV 1792
#define PJ_RG 2048
#define PJ_F8 1280
#define PC_QA 0
#define PC_KA 384
#define PC_VA 768
#define PC_QB 1024
#define PC_KB 1536
#define PC_VB 1664
#define PC_RQ 1792
#define PC_RK 2048
#define PC_RV 2304
#define PC_RG 2560

constexpr size_t AL256(size_t x) { return (x + 255) & ~(size_t)255; }
constexpr size_t OFF_CTL  = 0;
constexpr size_t CTL_BYTES = 294912;
constexpr size_t OFF_PCNT = 32768;
constexpr size_t OFF_CLAIM = 20480;
constexpr size_t OFF_CMAX = 196608;
constexpr size_t OFF_CS8  = OFF_CMAX + 5632 * 4;
constexpr size_t OFF_CMAXW = OFF_CS8 + 5632 * 4;
constexpr size_t OFF_CSW  = 262144;
constexpr size_t OFF_RSW  = 294912;
static_assert(OFF_RSW + (size_t)T_ALL * 4 <= (1u << 20), "row scales fit below OFF_MOD");
constexpr size_t OFF_CNT  = 16384;
constexpr size_t OFF_MOD  = 1u << 20;
constexpr size_t OFF_TAB  = 3u << 19;
constexpr size_t OFF_WIN  = 3u << 20;
constexpr size_t OFF_WOUT = OFF_WIN + (size_t)2 * PROJ_LD * 1024 * 2;
constexpr size_t OFF_FGU  = OFF_WOUT + (size_t)2 * 1024 * 1024 * 2;
constexpr size_t OFF_FD   = OFF_FGU + (size_t)2 * D_FF * 1024 * 2;
constexpr size_t OFF_WUQ  = OFF_FD + (size_t)1024 * D_FF * 2;
constexpr size_t OFF_WUKV = OFF_WUQ + (size_t)2 * 384 * 192 * 2;
constexpr size_t OFF_H    = OFF_WUKV + (size_t)2 * 512 * 128 * 2;
constexpr size_t OFF_XC   = OFF_H + (size_t)T_ALL * 1024 * 2;
constexpr size_t OFF_LIST = OFF_XC + (size_t)T_CTX * 1024 * 4;
constexpr size_t OFF_WL   = OFF_LIST + (size_t)2 * 8 * 32768 * 4;
constexpr size_t OFF_R    = OFF_WL + (size_t)2 * 8 * 32768 * 4;
constexpr size_t OFF_PROJ = OFF_R;
constexpr size_t OFF_POST = OFF_PROJ + (size_t)T_ALL * PROJ_LD * 2;
constexpr size_t OFF_TT   = OFF_POST + (size_t)T_ALL * POST_LD * 2;
constexpr size_t R1_END   = OFF_TT + (size_t)BATCH * 4 * 34 * 2 * 4096 * 4;
constexpr size_t OFF_ACT  = OFF_R;
constexpr size_t OFF_Y    = OFF_PROJ;
constexpr size_t OFF_H8D  = OFF_ACT + (size_t)T_ALL * D_FF;
constexpr size_t OFF_RS8   = OFF_H8D + (size_t)T_ALL * 1024;
constexpr size_t OFF_Y2   = OFF_ACT + (size_t)T_ALL * D_FF * 2;
constexpr size_t ACT_ROWS = T_LAT + NEXP * 256;
constexpr size_t OFF_MGU  = OFF_ACT + ACT_ROWS * D_FFE;
constexpr size_t OFF_MD   = OFF_MGU + (size_t)NEXP * 2 * D_FFE * 1024;
constexpr size_t OFF_PART = OFF_MD + (size_t)NEXP * 1024 * D_FFE;
constexpr size_t PART_END = OFF_PART + (size_t)256 * 65536 * 4;
constexpr size_t OFF_YM   = PART_END;
constexpr size_t OFF_INV  = OFF_YM + (size_t)2 * ACT_ROWS * 1024 * 2;
constexpr size_t YM_END   = OFF_INV + (size_t)T_LAT * 32;
constexpr size_t OFF_QK8  = YM_END;
constexpr size_t OFF_V8T  = OFF_QK8 + (size_t)T_ALL * 1024;
constexpr size_t F8_END   = OFF_V8T + (size_t)BATCH * 4 * 64 * 4352;
constexpr size_t WS_END   = F8_END > R1_END ? F8_END : R1_END;
static_assert(R1_END <= WS_END, "phase-1 buffers fit");
static_assert(WS_END <= 607070848, "workspace budget");
static_assert(OFF_Y2 + (size_t)T_ALL * 1024 * 2 <= WS_END, "Y2 fits");
static_assert(OFF_MGU >= OFF_Y + (size_t)T_ALL * 1024 * 2, "expert weights are converted while norm2(L1) still reads Y");

struct P { const float* in[25]; float* out; unsigned char* ws; };

#define XB_TMO      128
#define XB_XCNT(j)  (256  + 64 * (j))
#define XB_XSUB(j)  (1280 + 64 * (j))
#define XB_XGEN(j)  (2304 + 64 * (j))
#define XB_TOP      3328
#define XB_TOPGEN   3392
#define XCD_BAR_WORDS 3456
#define XB_SPIN_CAP (1u << 22)
#define LAS __attribute__((address_space(3)))

__device__ __forceinline__ unsigned xb_ld(unsigned* p)              { return __hip_atomic_load(p, __ATOMIC_RELAXED, __HIP_MEMORY_SCOPE_AGENT); }
__device__ __forceinline__ unsigned xb_add(unsigned* p, unsigned v) { return __hip_atomic_fetch_add(p, v, __ATOMIC_RELAXED, __HIP_MEMORY_SCOPE_AGENT); }
__device__ __forceinline__ unsigned xb_xcc_id() { return (unsigned)__builtin_amdgcn_s_getreg((3 << 11) | 20) & 0xFu; }
#define XB_SPIN(cond, bar) do { unsigned _sp = 0; while (cond) { __builtin_amdgcn_s_sleep(1); \
    if ((++_sp & 255u) == 0u) { if (xb_ld(&(bar)[XB_TMO])) break; if (_sp > XB_SPIN_CAP) { atomicAdd(&(bar)[XB_TMO], 1u); break; } } } } while (0)

struct XcdBarrier { unsigned* bar; unsigned x; volatile LAS unsigned* st; };

__device__ __forceinline__ XcdBarrier xcd_barrier_post(unsigned* bar, volatile LAS unsigned* st) {
    XcdBarrier b; b.bar = bar; b.x = xb_xcc_id(); b.st = st;
    if (threadIdx.x == 0) (void)xb_add(&bar[XB_XCNT(b.x)], 1u);
    return b;
}
__device__ __forceinline__ void xcd_barrier_complete(unsigned* bar, unsigned x, unsigned& nloc, unsigned& nx) {
    const unsigned G = gridDim.x * gridDim.y * gridDim.z;
    unsigned sum, cnt, mine, sp = 0u;
    for (;;) {
        sum = 0u; cnt = 0u; mine = 0u;
#pragma unroll
        for (unsigned j = 0; j < 16; ++j) { const unsigned c = xb_ld(&bar[XB_XCNT(j)]); sum += c; cnt += (c > 0u) ? 1u : 0u; mine = (j == x) ? c : mine; }
        if (sum == G) break;
        __builtin_amdgcn_s_sleep(1);
        if ((++sp & 255u) == 0u) { if (xb_ld(&bar[XB_TMO])) break; if (sp > XB_SPIN_CAP) { atomicAdd(&bar[XB_TMO], 1u); break; } }
    }
    nloc = mine > 0u ? mine : 1u; nx = cnt > 0u ? cnt : 1u;
}
__device__ __forceinline__ void xcd_barrier(const XcdBarrier& b) {
    asm volatile("s_waitcnt vmcnt(0)" ::: "memory");
    __syncthreads();
    if (threadIdx.x == 0) {
        unsigned* bar = b.bar;
        __builtin_amdgcn_s_waitcnt(0);
        unsigned nloc = b.st[0], nx = b.st[1];
        if (nloc == 0u) { xcd_barrier_complete(bar, b.x, nloc, nx); b.st[0] = nloc; b.st[1] = nx; }
        const unsigned old = xb_add(&bar[XB_XSUB(b.x)], 1u);
        const unsigned gen = old / nloc;
        if (old + 1u == (gen + 1u) * nloc) {
            __builtin_amdgcn_fence(__ATOMIC_RELEASE, "agent");
            asm volatile("s_waitcnt vmcnt(0)" ::: "memory");
            const unsigned og = xb_add(&bar[XB_TOP], 1u);
            const unsigned tg = og / nx;
            if (og + 1u == (tg + 1u) * nx) xb_add(&bar[XB_TOPGEN], 1u);
            else XB_SPIN(xb_ld(&bar[XB_TOPGEN]) == tg, bar);
            __builtin_amdgcn_fence(__ATOMIC_ACQUIRE, "agent");
            xb_add(&bar[XB_XGEN(b.x)], 1u);
            asm volatile("s_waitcnt vmcnt(0)" ::: "memory");
        } else {
            XB_SPIN(xb_ld(&bar[XB_XGEN(b.x)]) == gen, bar);
            __builtin_amdgcn_fence(__ATOMIC_ACQUIRE, "agent");
            asm volatile("s_waitcnt vmcnt(0)" ::: "memory");
        }
    }
    __syncthreads();
}

__device__ __forceinline__ float wave_sum(float v) {
#pragma unroll
    for (int o = 32; o > 0; o >>= 1) v += __shfl_xor(v, o);
    return v;
}
__device__ __forceinline__ void unpack8(const uint4 r, float* f) {
    f[0] = __uint_as_float(r.x << 16); f[1] = __uint_as_float(r.x & 0xFFFF0000u);
    f[2] = __uint_as_float(r.y << 16); f[3] = __uint_as_float(r.y & 0xFFFF0000u);
    f[4] = __uint_as_float(r.z << 16); f[5] = __uint_as_float(r.z & 0xFFFF0000u);
    f[6] = __uint_as_float(r.w << 16); f[7] = __uint_as_float(r.w & 0xFFFF0000u);
}
__device__ __forceinline__ int tok_row(int b, int i) { return i < SEQ ? b * SEQ + i : T_LAT + b * CTXL + (i - SEQ); }

__device__ __forceinline__ void ph_mod(const P& p, float* lds) {
    float* MOD = (float*)(p.ws + OFF_MOD);
    float* sl = lds; float* part = lds + 9 * 1024;
    int tid_ = threadIdx.x; asm volatile("" : "+v"(tid_));
    const int t = tid_, col = t & 63, ks = t >> 6;
    __syncthreads();
    for (int i = t; i < 9 * 1024; i += NT) { const int r = i >> 10, k = i & 1023; sl[i] = silu_f(r < 8 ? p.in[1][r * 1024 + k] : p.in[3][k]); }
    __syncthreads();
    for (int u = blockIdx.x; u < 2 * 96; u += gridDim.x) {
        const int l = u / 96, n = (u % 96) * 64 + col;
        const float* w = p.in[4] + (size_t)l * 1024 * 6144 + (size_t)(ks * 128) * 6144 + n;
        float acc[9];
#pragma unroll
        for (int r = 0; r < 9; ++r) acc[r] = 0.f;
#pragma unroll 8
        for (int k = 0; k < 128; ++k) { const float wv = w[(size_t)k * 6144];
#pragma unroll
            for (int r = 0; r < 9; ++r) acc[r] += sl[r * 1024 + ks * 128 + k] * wv; }
        __syncthreads();
#pragma unroll
        for (int r = 0; r < 9; ++r) part[(ks * 9 + r) * 64 + col] = acc[r];
        __syncthreads();
        for (int i = t; i < 9 * 64; i += NT) { const int r = i >> 6, c2 = i & 63; float s = 0.f;
#pragma unroll
            for (int q = 0; q < 8; ++q) s += part[(q * 9 + r) * 64 + c2];
            const int nn = (u % 96) * 64 + c2; MOD[(l * 9 + r) * 6144 + nn] = s + p.in[5][l * 6144 + nn]; }
    }
}

#define F8_SH 8.f
#define F8_SW 64.f
#define F8_SA 4.f
#define MOE_WAYS 7
__device__ __forceinline__ float f8clamp(float x) { return fminf(fmaxf(x, -448.f), 448.f); }
struct NormArgs { int layer, which; bool router, from_input; const bf16_t* resY; int res_layer, res_goff, ctx_ways; unsigned char* h8; bool both; float* i8s = nullptr; };
__device__ __forceinline__ void norm_row(const P& p, const NormArgs& a, int row, int lane) {
    const int layer = a.layer, which = a.which, res_layer = a.res_layer, res_goff = a.res_goff, ctx_ways = a.ctx_ways; const bool router = a.router, from_input = a.from_input; const bf16_t* resY = a.resY;
    const float* MOD = (const float*)(p.ws + OFF_MOD);
    const float* gain = (which == 1 ? p.in[6] : p.in[7]) + layer * 1024;
    bf16_t* H = (bf16_t*)(p.ws + OFF_H);
    float* XC = (float*)(p.ws + OFF_XC);
    int* CNT = (int*)(p.ws + OFF_CNT);
    int* LIST = (int*)(p.ws + OFF_LIST);
    float* WL = (float*)(p.ws + OFF_WL);
    {
        const float* src; float* dstx; int r;
        if (row < T_LAT) { r = row >> 12; src = (from_input ? p.in[0] : p.out) + (size_t)row * 1024; dstx = p.out + (size_t)row * 1024; }
        else { r = 8; src = (from_input ? p.in[2] : XC) + (size_t)(row - T_LAT) * 1024; dstx = XC + (size_t)(row - T_LAT) * 1024; }
        const float* md = MOD + (layer * 9 + r) * 6144 + (which == 1 ? 0 : 3072);
        float4 v[4]; float ss = 0.f;
#pragma unroll
        for (int i = 0; i < 4; ++i) v[i] = *(const float4*)(src + i * 256 + lane * 4);
        if (resY) {
            const float* gt = MOD + (res_layer * 9 + r) * 6144 + res_goff;
#pragma unroll
            for (int i = 0; i < 4; ++i) { const int col = i * 256 + lane * 4;
                const float4 g = *(const float4*)(gt + col); float4 y;
                if (row >= T_LAT && ctx_ways > 0) {
                    const int cr = row - T_LAT; const float* pp = (const float*)(p.ws + OFF_PART) + (size_t)(((cr >> 8) * 4 + i) * ctx_ways) * 65536 + (cr & 255) * 256 + lane * 4;
                    y = *(const float4*)pp;
                    for (int q = 1; q < ctx_ways; ++q) { const float4 z = *(const float4*)(pp + (size_t)q * 65536); y.x += z.x; y.y += z.y; y.z += z.z; y.w += z.w; }
                } else { const uint2 yr = *(const uint2*)(resY + (size_t)row * 1024 + col);
                    y = make_float4(__uint_as_float(yr.x << 16), __uint_as_float(yr.x & 0xFFFF0000u), __uint_as_float(yr.y << 16), __uint_as_float(yr.y & 0xFFFF0000u)); }
                v[i].x += g.x * y.x; v[i].y += g.y * y.y; v[i].z += g.z * y.z; v[i].w += g.w * y.w;
                *(float4*)(dstx + col) = v[i]; }
        }
#pragma unroll
        for (int i = 0; i < 4; ++i) ss += v[i].x * v[i].x + v[i].y * v[i].y + v[i].z * v[i].z + v[i].w * v[i].w;
        ss = wave_sum(ss);
        const float rs = rsqrtf(ss * (1.f / 1024.f) + NORM_EPS);
        if (a.i8s) {
            float oo[4][4]; float amax = 0.f;
#pragma unroll
            for (int i = 0; i < 4; ++i) { const int col = i * 256 + lane * 4;
                const float4 g = *(const float4*)(gain + col), sh = *(const float4*)(md + col), sc = *(const float4*)(md + 1024 + col);
                oo[i][0] = (v[i].x * rs * g.x) * (1.f + sc.x) + sh.x; oo[i][1] = (v[i].y * rs * g.y) * (1.f + sc.y) + sh.y;
                oo[i][2] = (v[i].z * rs * g.z) * (1.f + sc.z) + sh.z; oo[i][3] = (v[i].w * rs * g.w) * (1.f + sc.w) + sh.w;
                amax = fmaxf(fmaxf(amax, fmaxf(fabsf(oo[i][0]), fabsf(oo[i][1]))), fmaxf(fabsf(oo[i][2]), fabsf(oo[i][3]))); }
#pragma unroll
            for (int o_ = 1; o_ < 64; o_ <<= 1) amax = fmaxf(amax, __shfl_xor(amax, o_));
            amax = fmaxf(amax, 1e-20f);
            const float qs = 127.f / amax;
#pragma unroll
            for (int i = 0; i < 4; ++i) { const int q0 = (int)rintf(oo[i][0] * qs), q1 = (int)rintf(oo[i][1] * qs), q2 = (int)rintf(oo[i][2] * qs), q3 = (int)rintf(oo[i][3] * qs);
                *(int*)(a.h8 + (size_t)row * 1024 + i * 256 + lane * 4) = (int)((unsigned)(q0 & 255) | ((unsigned)(q1 & 255) << 8) | ((unsigned)(q2 & 255) << 16) | ((unsigned)q3 << 24)); }
            if (lane == 0) a.i8s[row] = amax * (1.f / 127.f);
            return;
        }
        float lg[8] = {0.f, 0.f, 0.f, 0.f, 0.f, 0.f, 0.f, 0.f};
#pragma unroll
        for (int i = 0; i < 4; ++i) {
            const int col = i * 256 + lane * 4;
            const float4 g = *(const float4*)(gain + col), sh = *(const float4*)(md + col), sc = *(const float4*)(md + 1024 + col);
            float o[4];
            o[0] = (v[i].x * rs * g.x) * (1.f + sc.x) + sh.x; o[1] = (v[i].y * rs * g.y) * (1.f + sc.y) + sh.y;
            o[2] = (v[i].z * rs * g.z) * (1.f + sc.z) + sh.z; o[3] = (v[i].w * rs * g.w) * (1.f + sc.w) + sh.w;
            if (a.h8) {
                int w8 = 0; w8 = __builtin_amdgcn_cvt_pk_fp8_f32(f8clamp(o[0] * F8_SH), f8clamp(o[1] * F8_SH), w8, false); w8 = __builtin_amdgcn_cvt_pk_fp8_f32(f8clamp(o[2] * F8_SH), f8clamp(o[3] * F8_SH), w8, true);
                *(int*)(a.h8 + (size_t)row * 1024 + col) = w8;
            }
            if (!a.h8 || a.both) {
            uint2 pk; pk.x = (unsigned)f2bf(o[0]) | ((unsigned)f2bf(o[1]) << 16); pk.y = (unsigned)f2bf(o[2]) | ((unsigned)f2bf(o[3]) << 16);
            *(uint2*)(H + (size_t)row * 1024 + col) = pk; }
            if (router) {
                const float* rw = p.in[20] + (size_t)col * 8;
#pragma unroll
                for (int j = 0; j < 4; ++j) {
                    const float4 w0 = *(const float4*)(rw + j * 8), w1 = *(const float4*)(rw + j * 8 + 4);
                    lg[0] += o[j] * w0.x; lg[1] += o[j] * w0.y; lg[2] += o[j] * w0.z; lg[3] += o[j] * w0.w;
                    lg[4] += o[j] * w1.x; lg[5] += o[j] * w1.y; lg[6] += o[j] * w1.z; lg[7] += o[j] * w1.w;
                }
            }
        }
        if (router) {
#pragma unroll
            for (int e = 0; e < 8; ++e) lg[e] = wave_sum(lg[e]);
            if (lane == 0) {
                int e0 = 0; float v0 = lg[0];
#pragma unroll
                for (int e = 1; e < 8; ++e) if (lg[e] > v0) { v0 = lg[e]; e0 = e; }
                int e1 = -1; float v1 = -3.0e38f;
#pragma unroll
                for (int e = 0; e < 8; ++e) if (e != e0 && lg[e] > v1) { v1 = lg[e]; e1 = e; }
                const float x1 = expf(v1 - v0), inv = 1.f / (1.f + x1);
                const float w0 = inv, w1 = x1 * inv;
                const int p0 = atomicAdd(&CNT[e0], 1), p1 = atomicAdd(&CNT[8 + e1], 1);
                LIST[(size_t)e0 * 32768 + p0] = row; WL[(size_t)e0 * 32768 + p0] = w0;
                LIST[(size_t)(8 + e1) * 32768 + p1] = row; WL[(size_t)(8 + e1) * 32768 + p1] = w1;
                { int* iv = (int*)(p.ws + OFF_INV) + (size_t)row * 8; *(int4*)iv = make_int4(e0, p0, e1, p1); *(float2*)(iv + 4) = make_float2(w0, w1); }
            }
        }
    }
}
__device__ __forceinline__ void norm_rows4(const P& p, const NormArgs& a, int row0, int lane) {
    const float* MOD = (const float*)(p.ws + OFF_MOD);
    bf16_t* H = (bf16_t*)(p.ws + OFF_H); float* XC = (float*)(p.ws + OFF_XC);
    const bool lat = row0 < T_LAT; const int r = lat ? (row0 >> 12) : 8;
    const float* srcb = lat ? (a.from_input ? p.in[0] : p.out) + (size_t)row0 * 1024 : (a.from_input ? p.in[2] : XC) + (size_t)(row0 - T_LAT) * 1024;
    float* dstb = lat ? p.out + (size_t)row0 * 1024 : XC + (size_t)(row0 - T_LAT) * 1024;
    float4 v[4][4]; uint2 y[4][4];
#pragma unroll
    for (int q = 0; q < 4; ++q)
#pragma unroll
        for (int i = 0; i < 4; ++i) { v[q][i] = *(const float4*)(srcb + q * 1024 + i * 256 + lane * 4); y[q][i] = *(const uint2*)(a.resY + (size_t)(row0 + q) * 1024 + i * 256 + lane * 4); }
    const float* gt = MOD + (a.res_layer * 9 + r) * 6144 + a.res_goff;
    const float* md = MOD + (a.layer * 9 + r) * 6144 + (a.which == 1 ? 0 : 3072);
    const float* gain = (a.which == 1 ? p.in[6] : p.in[7]) + a.layer * 1024;
    float4 gg[4], gn[4], sh[4], sc[4];
#pragma unroll
    for (int i = 0; i < 4; ++i) { const int col = i * 256 + lane * 4; gg[i] = *(const float4*)(gt + col); gn[i] = *(const float4*)(gain + col); sh[i] = *(const float4*)(md + col); sc[i] = *(const float4*)(md + 1024 + col); }
#pragma unroll
    for (int q = 0; q < 4; ++q) {
        float ss = 0.f;
#pragma unroll
        for (int i = 0; i < 4; ++i) { const uint2 yr = y[q][i];
            v[q][i].x += gg[i].x * __uint_as_float(yr.x << 16); v[q][i].y += gg[i].y * __uint_as_float(yr.x & 0xFFFF0000u);
            v[q][i].z += gg[i].z * __uint_as_float(yr.y << 16); v[q][i].w += gg[i].w * __uint_as_float(yr.y & 0xFFFF0000u);
            *(float4*)(dstb + q * 1024 + i * 256 + lane * 4) = v[q][i];
            ss += v[q][i].x * v[q][i].x + v[q][i].y * v[q][i].y + v[q][i].z * v[q][i].z + v[q][i].w * v[q][i].w; }
        ss = wave_sum(ss);
        const float rs = rsqrtf(ss * (1.f / 1024.f) + NORM_EPS);
        if (a.i8s) {
            float oo[4][4]; float amax = 0.f;
#pragma unroll
            for (int i = 0; i < 4; ++i) {
                oo[i][0] = (v[q][i].x * rs * gn[i].x) * (1.f + sc[i].x) + sh[i].x; oo[i][1] = (v[q][i].y * rs * gn[i].y) * (1.f + sc[i].y) + sh[i].y;
                oo[i][2] = (v[q][i].z * rs * gn[i].z) * (1.f + sc[i].z) + sh[i].z; oo[i][3] = (v[q][i].w * rs * gn[i].w) * (1.f + sc[i].w) + sh[i].w;
                amax = fmaxf(fmaxf(amax, fmaxf(fabsf(oo[i][0]), fabsf(oo[i][1]))), fmaxf(fabsf(oo[i][2]), fabsf(oo[i][3]))); }
#pragma unroll
            for (int o_ = 1; o_ < 64; o_ <<= 1) amax = fmaxf(amax, __shfl_xor(amax, o_));
            amax = fmaxf(amax, 1e-20f);
            const float qs = 127.f / amax;
#pragma unroll
            for (int i = 0; i < 4; ++i) { const int q0 = (int)rintf(oo[i][0] * qs), q1 = (int)rintf(oo[i][1] * qs), q2 = (int)rintf(oo[i][2] * qs), q3 = (int)rintf(oo[i][3] * qs);
                *(int*)(a.h8 + (size_t)(row0 + q) * 1024 + i * 256 + lane * 4) = (int)((unsigned)(q0 & 255) | ((unsigned)(q1 & 255) << 8) | ((unsigned)(q2 & 255) << 16) | ((unsigned)q3 << 24)); }
            if (lane == 0) a.i8s[row0 + q] = amax * (1.f / 127.f);
        } else
#pragma unroll
        for (int i = 0; i < 4; ++i) { float o[4];
            o[0] = (v[q][i].x * rs * gn[i].x) * (1.f + sc[i].x) + sh[i].x; o[1] = (v[q][i].y * rs * gn[i].y) * (1.f + sc[i].y) + sh[i].y;
            o[2] = (v[q][i].z * rs * gn[i].z) * (1.f + sc[i].z) + sh[i].z; o[3] = (v[q][i].w * rs * gn[i].w) * (1.f + sc[i].w) + sh[i].w;
            if (a.h8) { int w8 = 0; w8 = __builtin_amdgcn_cvt_pk_fp8_f32(f8clamp(o[0] * F8_SH), f8clamp(o[1] * F8_SH), w8, false); w8 = __builtin_amdgcn_cvt_pk_fp8_f32(f8clamp(o[2] * F8_SH), f8clamp(o[3] * F8_SH), w8, true);
                *(int*)(a.h8 + (size_t)(row0 + q) * 1024 + i * 256 + lane * 4) = w8; }
            if (!a.h8 || a.both) { uint2 pk; pk.x = (unsigned)f2bf(o[0]) | ((unsigned)f2bf(o[1]) << 16); pk.y = (unsigned)f2bf(o[2]) | ((unsigned)f2bf(o[3]) << 16);
            *(uint2*)(H + (size_t)(row0 + q) * 1024 + i * 256 + lane * 4) = pk; } }
    }
}
__device__ __forceinline__ void norm_help(const P& p, const NormArgs& a, unsigned* cnt, unsigned need, unsigned* claim, int npanels, LAS unsigned* lw) {
    int tid_ = threadIdx.x; asm volatile("" : "+v"(tid_));
    const int wave = __builtin_amdgcn_readfirstlane(tid_ >> 6), lane = tid_ & 63;
    for (;;) {
        __syncthreads();
        if (threadIdx.x == 0) {
            const unsigned part = __hip_atomic_fetch_add(claim, 1u, __ATOMIC_RELAXED, __HIP_MEMORY_SCOPE_AGENT);
            if (part < (unsigned)npanels * 4u) {
                unsigned sp = 0;
                while (__hip_atomic_load(cnt + 64 * (part >> 2), __ATOMIC_RELAXED, __HIP_MEMORY_SCOPE_AGENT) < need) { __builtin_amdgcn_s_sleep(8); if (++sp > (1u << 22)) break; }
                __builtin_amdgcn_fence(__ATOMIC_ACQUIRE, "agent");
                asm volatile("s_waitcnt vmcnt(0)" ::: "memory");
            }
            lw[0] = part;
        }
        __syncthreads();
        const unsigned part = lw[0];
        if (part >= (unsigned)npanels * 4u) break;
        const int base = (int)(part >> 2) * 256 + (int)(part & 3u) * 64 + wave * 8;
        norm_rows4(p, a, base, lane); norm_rows4(p, a, base + 4, lane);
    }
}
__device__ __forceinline__ void ph_norm(const P& p, int layer, int which, int nrows, bool router, bool from_input, const bf16_t* resY, int res_layer, int res_goff, int ctx_ways, unsigned char* h8, bool both, float* i8s = nullptr) {
    int tid_ = threadIdx.x; asm volatile("" : "+v"(tid_));
    const int wave = tid_ >> 6, lane = tid_ & 63;
    const NormArgs a{layer, which, router, from_input, resY, res_layer, res_goff, ctx_ways, h8, both, i8s};
    for (int row = blockIdx.x * 8 + wave; row < nrows; row += gridDim.x * 8) norm_row(p, a, row, lane);
}

struct ConvJob { const float* src; bf16_t* dst; int K, N, map, f8; const unsigned* cmax = nullptr; float* cs = nullptr; };
__device__ __forceinline__ void conv_tiles4(const ConvJob& j, int tile, int step, int ntl, float* T  ) {
    int tid_ = threadIdx.x; asm volatile("" : "+v"(tid_));
    const int ntn = (j.N + 63) >> 6, t = tid_;
    float4 v[4][2];
#pragma unroll
    for (int q = 0; q < 4; ++q) { const int tl = tile + q * step, tk = tl / ntn, tn = tl % ntn;
#pragma unroll
        for (int i = 0; i < 2; ++i) { const int kr = (t >> 4) + 32 * i, c4 = (t & 15) * 4, n = tn * 64 + c4;
            v[q][i] = make_float4(0.f, 0.f, 0.f, 0.f);
            if (tl < ntl && n < j.N) v[q][i] = *(const float4*)(j.src + (size_t)(tk * 64 + kr) * j.N + n); } }
    __syncthreads();
#pragma unroll
    for (int q = 0; q < 4; ++q)
#pragma unroll
        for (int i = 0; i < 2; ++i) { const int kr = (t >> 4) + 32 * i, c4 = (t & 15) * 4; float* Tq = T + q * (64 * 65);
            Tq[kr * 65 + c4 + 0] = v[q][i].x; Tq[kr * 65 + c4 + 1] = v[q][i].y; Tq[kr * 65 + c4 + 2] = v[q][i].z; Tq[kr * 65 + c4 + 3] = v[q][i].w; }
    __syncthreads();
#pragma unroll
    for (int q = 0; q < 4; ++q) { const int tl = tile + q * step, tk = tl / ntn, tn = tl % ntn; const float* Tq = T + q * (64 * 65);
        const int nl = t >> 3, ks = (t & 7) * 8, n = tn * 64 + nl;
        if (tl < ntl && n < j.N) {
            int nd = j.map == 0 ? n : ((n >> 7) * 256 + (n & 127) + (j.map == 2 ? 128 : 0)); bool f8 = j.f8 != 0;
            if (j.map == 3) {
                nd = n < 1120 ? n : PJ_RQ + (n - 1120);
                f8 = nd < PJ_F8 && !j.cmax; }
            if (j.cmax) {
                const float am = fmaxf(__uint_as_float(j.cmax[nd]), 1e-30f), qs = 127.f / am;
                int q[8];
#pragma unroll
                for (int i = 0; i < 8; ++i) q[i] = (int)rintf(Tq[(ks + i) * 65 + nl] * qs) & 255;
                *(uint2*)((unsigned char*)j.dst + (size_t)nd * j.K + tk * 64 + ks) = make_uint2((unsigned)(q[0] | (q[1] << 8) | (q[2] << 16) | (q[3] << 24)), (unsigned)(q[4] | (q[5] << 8) | (q[6] << 16) | (q[7] << 24)));
                if (tk == 0 && ks == 0) j.cs[nd] = am * (1.f / 127.f);
            } else if (f8) {
                int w0 = 0, w1 = 0;
                w0 = __builtin_amdgcn_cvt_pk_fp8_f32(f8clamp(Tq[(ks + 0) * 65 + nl] * F8_SW), f8clamp(Tq[(ks + 1) * 65 + nl] * F8_SW), w0, false);
                w0 = __builtin_amdgcn_cvt_pk_fp8_f32(f8clamp(Tq[(ks + 2) * 65 + nl] * F8_SW), f8clamp(Tq[(ks + 3) * 65 + nl] * F8_SW), w0, true);
                w1 = __builtin_amdgcn_cvt_pk_fp8_f32(f8clamp(Tq[(ks + 4) * 65 + nl] * F8_SW), f8clamp(Tq[(ks + 5) * 65 + nl] * F8_SW), w1, false);
                w1 = __builtin_amdgcn_cvt_pk_fp8_f32(f8clamp(Tq[(ks + 6) * 65 + nl] * F8_SW), f8clamp(Tq[(ks + 7) * 65 + nl] * F8_SW), w1, true);
                *(uint2*)((unsigned char*)j.dst + (size_t)nd * j.K + tk * 64 + ks) = make_uint2((unsigned)w0, (unsigned)w1);
            } else {
            unsigned w[4];
#pragma unroll
            for (int i = 0; i < 4; ++i) w[i] = (unsigned)f2bf(Tq[(ks + 2 * i) * 65 + nl]) | ((unsigned)f2bf(Tq[(ks + 2 * i + 1) * 65 + nl]) << 16);
            *(uint4*)(j.dst + (size_t)nd * j.K + tk * 64 + ks) = make_uint4(w[0], w[1], w[2], w[3]);
            }
        } }
}
__device__ __forceinline__ int conv_ntiles(int K, int N) { return (K >> 6) * ((N + 63) >> 6); }

#define CONV_F8 0
__device__ __forceinline__ void ph_conv_early(const P& p, float* lds) {
    const int G = gridDim.x, bid = blockIdx.x;
    int base = 0;
#define CONV_RUN(SRC, DST, K_, N_, MAP_) do { ConvJob j{SRC, DST, K_, N_, MAP_, CONV_F8}; const int nt_ = conv_ntiles(K_, N_), ns_ = (nt_ + 3) >> 2; \
          \
        for (int u = (((bid - base % G) + G) % G); u < ns_; u += G) conv_tiles4(j, 4 * u, 1, nt_, lds); base += ns_; } while (0)
    for (int l = 0; l < 2; ++l) {
        CONV_RUN(p.in[16] + (size_t)l * 1024 * 1024, (bf16_t*)(p.ws + OFF_WOUT) + (size_t)l * 1024 * 1024, 1024, 1024, 0);
        CONV_RUN(p.in[10] + (size_t)l * 192 * 384, (bf16_t*)(p.ws + OFF_WUQ) + (size_t)l * 384 * 192, 192, 384, 0);
        CONV_RUN(p.in[12] + (size_t)l * 128 * 512, (bf16_t*)(p.ws + OFF_WUKV) + (size_t)l * 512 * 128, 128, 512, 0);
    }
#undef CONV_F8
#define CONV_F8 1
    CONV_RUN(p.in[19], (bf16_t*)(p.ws + OFF_FD), D_FF, 1024, 0);
    for (int l = 0; l < 2; ++l) {
        uint4* z = (uint4*)((unsigned char*)((bf16_t*)(p.ws + OFF_WIN) + (size_t)l * PROJ_LD * 1024) + (size_t)1120 * 1024);
        const int n16 = (PJ_F8 - 1120) * 1024 / 16;
        for (int i = bid * NT + threadIdx.x; i < n16; i += G * NT) z[i] = make_uint4(0u, 0u, 0u, 0u);
    }
}
#undef CONV_F8
#define CONV_F8 1
__device__ __forceinline__ void ph_fgu_colmax(const P& p) {
    const int G = gridDim.x, bid = blockIdx.x;
    unsigned* cmax = (unsigned*)(p.ws + OFF_CMAX);
    for (int u = bid; u < 2 * 8 * 6; u += G) {
        const int mat = u / 48, kc = (u % 48) / 6, nc = u % 6, n = nc * 512 + (int)threadIdx.x;
        if (n < D_FF) { const float* s = (mat ? p.in[18] : p.in[17]) + (size_t)(kc * 128) * D_FF + n; float am = 0.f;
#pragma unroll 8
            for (int k = 0; k < 128; ++k) am = fmaxf(am, fabsf(s[(size_t)k * D_FF]));
            atomicMax(cmax + ((n >> 7) * 256 + (n & 127) + (mat ? 128 : 0)), __float_as_uint(am)); }
    }
}
__device__ __forceinline__ void ph_win_colmax(const P& p) {
    const int G = gridDim.x, bid = blockIdx.x;
    for (int u = G - 1 - bid; u < 2 * 8 * 5; u += G) {
        const int l = u / 40, kc = (u % 40) / 5, nc = u % 5, n = nc * 512 + (int)threadIdx.x;
        if (n < IN_DIM) { const float* s = p.in[8] + (size_t)l * 1024 * IN_DIM + (size_t)(kc * 128) * IN_DIM + n; float am = 0.f;
#pragma unroll 8
            for (int k = 0; k < 128; ++k) am = fmaxf(am, fabsf(s[(size_t)k * IN_DIM]));
            atomicMax((unsigned*)(p.ws + OFF_CMAXW) + l * PROJ_LD + (n < 1120 ? n : PJ_RQ + (n - 1120)), __float_as_uint(am)); }
    }
}
__device__ __forceinline__ void ph_conv_fgu_i8(const P& p, float* lds) {
    const int G = gridDim.x, bid = blockIdx.x;
    int base = 0;
#define CONV_RUN_I8(SRC, MAP_) do { ConvJob j{SRC, (bf16_t*)(p.ws + OFF_FGU), 1024, D_FF, MAP_, 0, (const unsigned*)(p.ws + OFF_CMAX), (float*)(p.ws + OFF_CS8)}; const int nt_ = conv_ntiles(1024, D_FF), ns_ = (nt_ + 3) >> 2; \
        for (int u = (((bid - base % G) + G) % G); u < ns_; u += G) conv_tiles4(j, 4 * u, 1, nt_, lds); base += ns_; } while (0)
    CONV_RUN_I8(p.in[17], 1);
    CONV_RUN_I8(p.in[18], 2);
#undef CONV_RUN_I8
    for (int l = 0; l < 2; ++l) {
        ConvJob j{p.in[8] + (size_t)l * 1024 * IN_DIM, (bf16_t*)(p.ws + OFF_WIN) + (size_t)l * PROJ_LD * 1024, 1024, IN_DIM, 3, 0, (const unsigned*)(p.ws + OFF_CMAXW) + l * PROJ_LD, (float*)(p.ws + OFF_CSW) + l * PROJ_LD};
        const int nt_ = conv_ntiles(1024, IN_DIM), ns_ = (nt_ + 3) >> 2;
        for (int u = (((bid - base % G) + G) % G); u < ns_; u += G) conv_tiles4(j, 4 * u, 1, nt_, lds); base += ns_; }
}
__device__ __forceinline__ void ph_conv_late(const P& p, float* lds) {
    const int G = gridDim.x, bid = blockIdx.x;
    int base = 0;
    for (int e = 0; e < NEXP; ++e) {
        CONV_RUN(p.in[21] + (size_t)e * 1024 * D_FFE, (bf16_t*)(p.ws + OFF_MGU + (size_t)e * 2 * D_FFE * 1024), 1024, D_FFE, 1);
        CONV_RUN(p.in[22] + (size_t)e * 1024 * D_FFE, (bf16_t*)(p.ws + OFF_MGU + (size_t)e * 2 * D_FFE * 1024), 1024, D_FFE, 2);
        CONV_RUN(p.in[23] + (size_t)e * D_FFE * 1024, (bf16_t*)(p.ws + OFF_MD + (size_t)e * 1024 * D_FFE), D_FFE, 1024, 0);
    }
}

namespace pg8 {
#define PG8_LAS __attribute__((address_space(3)))
typedef short bf16x8 __attribute__((ext_vector_type(8)));
typedef float f32x4 __attribute__((ext_vector_type(4)));
typedef unsigned u32x4 __attribute__((ext_vector_type(4)));
typedef int i32x4v __attribute__((ext_vector_type(4)));
constexpr int BM = 256, BK = 64, HALF = 128, HTB = HALF * BK * 2, STAGE_BYTES = 8 * HTB, NXCD = 8, WGM = 8;

__host__ __device__ __forceinline__ int lds_byte(int r, int c) { const int st = (r >> 4) * 2 + (c >> 5), rr = r & 15, cc = c & 31, ob = rr * 64 + cc * 2; return st * 1024 + (ob ^ (((ob >> 9) & 1) << 5)); }
__host__ __device__ __forceinline__ void stage_rc(int b, int& R, int& C) { const int st = b / 1024, sb = b % 1024, swz = sb ^ (((sb >> 9) & 1) << 5); R = (st >> 1) * 16 + swz / 64; C = (st & 1) * 32 + (swz % 64) / 2; }
__host__ __device__ __forceinline__ int perm32(int rho) { const int n = rho >> 4, i = rho & 15; return 8 * (i >> 2) + 4 * n + (i & 3); }

struct Unit { int pm, pn, e, rl, kp, ri; };

__device__ __forceinline__ void static_order_L(int L, int nM, int nN, int& pm, int& pn) {
    const int nwg = nM * nN;
    int wgid = L; { const int q = nwg / NXCD, r = nwg % NXCD, xcd = wgid % NXCD, off = wgid / NXCD; wgid = (xcd < r ? xcd * (q + 1) : r * (q + 1) + (xcd - r) * q) + off; }
    const int nig = WGM * nN, gid = wgid / nig, fm = gid * WGM, gsz = (nM - fm) < WGM ? (nM - fm) : WGM;
    pm = fm + ((wgid % nig) % gsz); pn = (wgid % nig) / gsz;
}
__device__ __forceinline__ bool static_order(int i, int G, int c, int nM, int nN, int& pm, int& pn) {
    const int nwg = nM * nN; const long L = (long)i * G + c; if (L >= nwg) return false;
    static_order_L((int)L, nM, nN, pm, pn); return true;
}

template <bool FP8_, bool I8_ = false> struct DenseSchedT {
    static constexpr bool GATHER = false, FP8 = FP8_, I8 = I8_;
    const bf16_t* A; const bf16_t* Bt; int lda, K, nM, nN, G, c; int L0 = 0, Lend = 1 << 30;
    __device__ __forceinline__ int nt() const { return K / BK; }
    __device__ __forceinline__ bool next(int i, Unit& u) const { u.e = 0; u.kp = 0; u.ri = 0; const long L = L0 + (long)i * G + c; const int nwg = nM * nN;
        if (L >= nwg || L >= Lend) return false; static_order_L((int)L, nM, nN, u.pm, u.pn); u.rl = u.pm; return true; }
    __device__ __forceinline__ const char* a_base(const Unit& u) const { return (const char*)A + (size_t)u.pm * BM * lda * 2; }
    __device__ __forceinline__ const char* b_base(const Unit& u) const { return (const char*)Bt + (size_t)u.pn * BM * K * 2; }
    __device__ __forceinline__ unsigned a_off(const Unit&, int r, int C) const { return (unsigned)(r * lda + C) * 2u; }
};
typedef DenseSchedT<false> DenseSched;
struct DenseSplitSched {
    static constexpr bool GATHER = false;
    const bf16_t* A; const bf16_t* Bt; int lda, K, pm0, nMs, nN, ways, ntp, G, c;
    __device__ __forceinline__ int nt() const { return ntp; }
    __device__ __forceinline__ bool next(int i, Unit& u) const {
        const long j = (long)i * G + c; if (j >= (long)nMs * nN * ways) return false;
        const int ui = (int)(j / ways); u.kp = (int)(j % ways) * ntp; u.ri = (int)j; u.pm = pm0 + ui / nN; u.pn = ui % nN; u.e = 0; u.rl = u.pm; return true;
    }
    __device__ __forceinline__ const char* a_base(const Unit& u) const { return (const char*)A + (size_t)u.pm * BM * lda * 2 + (size_t)u.kp * (BK * 2); }
    __device__ __forceinline__ const char* b_base(const Unit& u) const { return (const char*)Bt + (size_t)u.pn * BM * K * 2 + (size_t)u.kp * (BK * 2); }
    __device__ __forceinline__ unsigned a_off(const Unit&, int r, int C) const { return (unsigned)(r * lda + C) * 2u; }
};
template <bool GATHER_, bool FP8_ = false> struct MoeSched {
    static constexpr bool GATHER = GATHER_, FP8 = FP8_;
    const bf16_t* A; const bf16_t* Bt; int lda, K, nN, G, c; size_t bstride;
    const int* list;
    const PG8_LAS int* tab;
    int ulo, uhi, ways, ntp;
    __device__ __forceinline__ int nt() const { return ntp; }
    __device__ __forceinline__ bool next(int i, Unit& u) const {
        const int nM = __builtin_amdgcn_readfirstlane(tab[16]);
        const long j = (long)i * G + c; const int L = ulo + (int)(j / ways);
        if (L >= uhi) return false;
        u.kp = (int)(j % ways) * ntp; u.ri = (int)j;
        static_order_L(L, nM, nN, u.pm, u.pn);
        int e = 0, t0 = 0;
#pragma unroll
        for (int k = 1; k < 8; ++k) { const int tk = tab[8 + k]; if (u.pm >= tk) { e = k; t0 = tk; } }
        u.e = __builtin_amdgcn_readfirstlane(e); u.rl = u.pm - __builtin_amdgcn_readfirstlane(t0); return true;
    }
    __device__ __forceinline__ const char* a_base(const Unit& u) const { return (GATHER ? (const char*)A : (const char*)A + (size_t)u.pm * BM * lda * 2) + (size_t)u.kp * (BK * 2); }
    __device__ __forceinline__ const char* b_base(const Unit& u) const { return (const char*)(Bt + (size_t)u.e * bstride) + (size_t)u.pn * BM * K * 2 + (size_t)u.kp * (BK * 2); }
    __device__ __forceinline__ unsigned a_off(const Unit& u, int r, int C) const {
        if (!GATHER) return (unsigned)(r * lda + C) * 2u;
        const int lr = u.rl * BM + r, c1 = tab[u.e] - 1;
        const int tok = list[(size_t)u.e * 32768 + (lr < c1 ? lr : c1)];
        return (unsigned)(tok * lda + C) * 2u;
    }
};

__device__ __forceinline__ unsigned pk2(float lo, float hi) { typedef float f32x2_t __attribute__((ext_vector_type(2))); typedef __bf16 bf16x2_t __attribute__((ext_vector_type(2)));
    f32x2_t v = {lo, hi}; bf16x2_t b = __builtin_convertvector(v, bf16x2_t); return __builtin_bit_cast(unsigned, b); }

struct EpiBf16 {
    static constexpr bool PERM = true;
    bf16_t* O; int ldc;
    __device__ __forceinline__ void operator()(const f32x4 (&acc)[2][2][4][2], const Unit& u, int wr, int wc, int fr, int fq) const {
        const int row0 = u.pm * BM + wr * 64 + fr, col0 = u.pn * BM + wc * 32 + 8 * fq;
#pragma unroll
        for (int ai = 0; ai < 2; ++ai)
#pragma unroll
            for (int m = 0; m < 4; ++m) { bf16_t* rowp = O + (size_t)(row0 + ai * HALF + m * 16) * ldc + col0;
#pragma unroll
                for (int bj = 0; bj < 2; ++bj) { const f32x4 v0 = acc[ai][bj][m][0], v1 = acc[ai][bj][m][1];
                    u32x4 w; w[0] = pk2(v0[0], v0[1]); w[1] = pk2(v0[2], v0[3]); w[2] = pk2(v1[0], v1[1]); w[3] = pk2(v1[2], v1[3]);
                    *(u32x4*)(rowp + bj * HALF) = w; } }
    }
};
struct EpiBf16Norm {
    static constexpr bool PERM = true, HAS_POST = true;
    bf16_t* O; int ldc; unsigned obytes; unsigned* cnt; float sc;
    __device__ __forceinline__ void operator()(const f32x4 (&acc)[2][2][4][2], const Unit& u, int wr, int wc, int fr, int fq) const {
        const auto rsrc = __builtin_amdgcn_make_buffer_rsrc((void*)O, 0, (int)obytes, 0x00020000);
        const int row0 = u.pm * BM + wr * 64 + fr, col0 = u.pn * BM + wc * 32 + 8 * fq;
#pragma unroll
        for (int ai = 0; ai < 2; ++ai)
#pragma unroll
            for (int m = 0; m < 4; ++m) { const unsigned ro = (unsigned)((row0 + ai * HALF + m * 16) * ldc + col0) * 2u;
#pragma unroll
                for (int bj = 0; bj < 2; ++bj) { const f32x4 v0 = acc[ai][bj][m][0] * sc, v1 = acc[ai][bj][m][1] * sc;
                    u32x4 w; w[0] = pk2(v0[0], v0[1]); w[1] = pk2(v0[2], v0[3]); w[2] = pk2(v1[0], v1[1]); w[3] = pk2(v1[2], v1[3]);
                    __builtin_amdgcn_raw_buffer_store_b128(w, rsrc, ro + bj * HALF * 2, 0, 16); } }
    }
    __device__ __forceinline__ void post(const Unit& u) const {
        asm volatile("s_waitcnt vmcnt(0)" ::: "memory");
        if ((threadIdx.x & 63) == 0) __hip_atomic_fetch_add(cnt + 64 * u.pm, 1u, __ATOMIC_RELAXED, __HIP_MEMORY_SCOPE_AGENT);
    }
};
template <bool F8IN, bool F8> struct EpiSwigluT {
    static constexpr bool PERM = true;
    bf16_t* O; int ldc;
    __device__ __forceinline__ void operator()(const f32x4 (&acc)[2][2][4][2], const Unit& u, int wr, int wc, int fr, int fq) const {
        const int row0 = u.pm * BM + wr * 64 + fr, col0 = u.pn * HALF + wc * 32 + 8 * fq;
#pragma unroll
        for (int ai = 0; ai < 2; ++ai)
#pragma unroll
            for (int m = 0; m < 4; ++m) { bf16_t* rowp = O + (size_t)(row0 + ai * HALF + m * 16) * ldc + col0;
                float o[8];
                typedef float f32x2_t __attribute__((ext_vector_type(2)));
#pragma unroll
                for (int n = 0; n < 2; ++n)
#pragma unroll
                    for (int j = 0; j < 4; j += 2) {
                        f32x2_t gg = {acc[ai][0][m][n][j], acc[ai][0][m][n][j + 1]}, uu = {acc[ai][1][m][n][j], acc[ai][1][m][n][j + 1]};
                        if constexpr (F8IN) { gg = gg * (1.f / (F8_SH * F8_SW)); uu = uu * ((F8 ? F8_SA : 1.f) / (F8_SH * F8_SW)); } else if constexpr (F8) uu = uu * F8_SA;
                        const f32x2_t t = gg * (-1.4426950408889634f); f32x2_t e;
                        e[0] = __builtin_amdgcn_exp2f(t[0]); e[1] = __builtin_amdgcn_exp2f(t[1]);
                        e = e + 1.0f; f32x2_t r; r[0] = __builtin_amdgcn_rcpf(e[0]); r[1] = __builtin_amdgcn_rcpf(e[1]);
                        const f32x2_t v = (gg * uu) * r; o[n * 4 + j] = v[0]; o[n * 4 + j + 1] = v[1]; }
                if constexpr (F8) { int w0 = 0, w1 = 0;
                    w0 = __builtin_amdgcn_cvt_pk_fp8_f32(f8clamp(o[0]), f8clamp(o[1]), w0, false); w0 = __builtin_amdgcn_cvt_pk_fp8_f32(f8clamp(o[2]), f8clamp(o[3]), w0, true);
                    w1 = __builtin_amdgcn_cvt_pk_fp8_f32(f8clamp(o[4]), f8clamp(o[5]), w1, false); w1 = __builtin_amdgcn_cvt_pk_fp8_f32(f8clamp(o[6]), f8clamp(o[7]), w1, true);
                    typedef unsigned u32x2v __attribute__((ext_vector_type(2))); u32x2v w = {(unsigned)w0, (unsigned)w1};
                    *(u32x2v*)((unsigned char*)O + (size_t)(row0 + ai * HALF + m * 16) * ldc + col0) = w; }
                else { u32x4 w; w[0] = pk2(o[0], o[1]); w[1] = pk2(o[2], o[3]); w[2] = pk2(o[4], o[5]); w[3] = pk2(o[6], o[7]);
                *(u32x4*)rowp = w; } }
    }
};
typedef EpiSwigluT<false, false> EpiSwiglu;
struct EpiSwigluI8 {
    static constexpr bool PERM = true;
    bf16_t* O; int ldc; const float* rsc; const float* csc;
    __device__ __forceinline__ void operator()(const f32x4 (&acc)[2][2][4][2], const Unit& u, int wr, int wc, int fr, int fq) const {
        const int row0 = u.pm * BM + wr * 64 + fr, col0 = u.pn * HALF + wc * 32 + 8 * fq;
        const float* cg = csc + u.pn * BM + wc * 32 + 8 * fq;
        const f32x4 cg0 = *(const f32x4*)cg, cg1 = *(const f32x4*)(cg + 4), cu0 = *(const f32x4*)(cg + HALF), cu1 = *(const f32x4*)(cg + HALF + 4);
        float rs8[8];
#pragma unroll
        for (int i = 0; i < 8; ++i) rs8[i] = rsc[row0 + (i >> 2) * HALF + (i & 3) * 16];
#pragma unroll
        for (int ai = 0; ai < 2; ++ai)
#pragma unroll
            for (int m = 0; m < 4; ++m) { const int row = row0 + ai * HALF + m * 16; const float rsv = rs8[ai * 4 + m];
                float o[8];
#pragma unroll
                for (int n = 0; n < 2; ++n)
#pragma unroll
                    for (int j = 0; j < 4; ++j) {
                        const float gg = (float)__float_as_int(acc[ai][0][m][n][j]) * (rsv * (n ? cg1[j] : cg0[j])), uu = (float)__float_as_int(acc[ai][1][m][n][j]) * (rsv * F8_SA * (n ? cu1[j] : cu0[j]));
                        const float e = __builtin_amdgcn_exp2f(gg * (-1.4426950408889634f)) + 1.0f;
                        o[n * 4 + j] = (gg * uu) * __builtin_amdgcn_rcpf(e); }
                int w0 = 0, w1 = 0;
                w0 = __builtin_amdgcn_cvt_pk_fp8_f32(f8clamp(o[0]), f8clamp(o[1]), w0, false); w0 = __builtin_amdgcn_cvt_pk_fp8_f32(f8clamp(o[2]), f8clamp(o[3]), w0, true);
                w1 = __builtin_amdgcn_cvt_pk_fp8_f32(f8clamp(o[4]), f8clamp(o[5]), w1, false); w1 = __builtin_amdgcn_cvt_pk_fp8_f32(f8clamp(o[6]), f8clamp(o[7]), w1, true);
                typedef unsigned u32x2v __attribute__((ext_vector_type(2))); u32x2v w = {(unsigned)w0, (unsigned)w1};
                *(u32x2v*)((unsigned char*)O + (size_t)row * ldc + col0) = w; }
    }
};
struct EpiRes {
    static constexpr bool PERM = false;
    const float* in_lat; const float* in_ctx; float* out_lat; float* out_ctx; const float* modl; int goff;
    __device__ __forceinline__ void operator()(const f32x4 (&acc)[2][2][4][2], const Unit& u, int wr, int wc, int fr, int fq) const {
        const bool lat = u.pm < T_LAT / BM; const int r = lat ? (u.pm >> 4) : 8;
        const size_t rbase = (size_t)(lat ? u.pm : u.pm - T_LAT / BM) * BM + wr * 64 + fr;
        const float* src = (lat ? in_lat : in_ctx); float* dst = (lat ? out_lat : out_ctx);
        const int col0 = u.pn * BM + wc * 32 + 4 * fq;
        f32x4 gv[2][2];
#pragma unroll
        for (int bj = 0; bj < 2; ++bj)
#pragma unroll
            for (int n = 0; n < 2; ++n) gv[bj][n] = *(const f32x4*)(modl + r * 6144 + goff + col0 + bj * HALF + n * 16);
#pragma unroll
        for (int ai = 0; ai < 2; ++ai)
#pragma unroll
            for (int m = 0; m < 4; ++m) { const size_t ro = (rbase + ai * HALF + m * 16) * 1024 + col0;
#pragma unroll
                for (int bj = 0; bj < 2; ++bj)
#pragma unroll
                    for (int n = 0; n < 2; ++n) { const f32x4 x = *(const f32x4*)(src + ro + bj * HALF + n * 16);
                        *(f32x4*)(dst + ro + bj * HALF + n * 16) = x + gv[bj][n] * acc[ai][bj][m][n]; } }
    }
};
struct EpiBf16I8 {
    static constexpr bool PERM = true;
    bf16_t* O; int ldc; const float* rsc; const float* csc;
    __device__ __forceinline__ void operator()(const f32x4 (&acc)[2][2][4][2], const Unit& u, int wr, int wc, int fr, int fq) const {
        const int row0 = u.pm * BM + wr * 64 + fr, col0 = u.pn * BM + wc * 32 + 8 * fq;
        f32x4 cs[2][2];
#pragma unroll
        for (int bj = 0; bj < 2; ++bj) { cs[bj][0] = *(const f32x4*)(csc + col0 + bj * HALF); cs[bj][1] = *(const f32x4*)(csc + col0 + bj * HALF + 4); }
        float rs8[8];
#pragma unroll
        for (int i = 0; i < 8; ++i) rs8[i] = rsc[row0 + (i >> 2) * HALF + (i & 3) * 16];
#pragma unroll
        for (int ai = 0; ai < 2; ++ai)
#pragma unroll
            for (int m = 0; m < 4; ++m) { bf16_t* rowp = O + (size_t)(row0 + ai * HALF + m * 16) * ldc + col0; const float rsv = rs8[ai * 4 + m];
#pragma unroll
                for (int bj = 0; bj < 2; ++bj) { float o[8];
#pragma unroll
                    for (int n = 0; n < 2; ++n)
#pragma unroll
                        for (int j = 0; j < 4; ++j) o[n * 4 + j] = (float)__float_as_int(acc[ai][bj][m][n][j]) * (rsv * cs[bj][n][j]);
                    u32x4 w; w[0] = pk2(o[0], o[1]); w[1] = pk2(o[2], o[3]); w[2] = pk2(o[4], o[5]); w[3] = pk2(o[6], o[7]);
                    *(u32x4*)(rowp + bj * HALF) = w; } }
    }
};
struct EpiBf16S {
    static constexpr bool PERM = true;
    bf16_t* O; int ldc; float sc;
    __device__ __forceinline__ void operator()(const f32x4 (&acc)[2][2][4][2], const Unit& u, int wr, int wc, int fr, int fq) const {
        const int row0 = u.pm * BM + wr * 64 + fr, col0 = u.pn * BM + wc * 32 + 8 * fq;
#pragma unroll
        for (int ai = 0; ai < 2; ++ai)
#pragma unroll
            for (int m = 0; m < 4; ++m) { bf16_t* rowp = O + (size_t)(row0 + ai * HALF + m * 16) * ldc + col0;
#pragma unroll
                for (int bj = 0; bj < 2; ++bj) { const f32x4 v0 = acc[ai][bj][m][0] * sc, v1 = acc[ai][bj][m][1] * sc;
                    u32x4 w; w[0] = pk2(v0[0], v0[1]); w[1] = pk2(v0[2], v0[3]); w[2] = pk2(v1[0], v1[1]); w[3] = pk2(v1[2], v1[3]);
                    *(u32x4*)(rowp + bj * HALF) = w; } }
    }
};
struct EpiPart {
    static constexpr bool PERM = false;
    float* PART;
    __device__ __forceinline__ void operator()(const f32x4 (&acc)[2][2][4][2], const Unit& u, int wr, int wc, int fr, int fq) const {
        float* tp = PART + (size_t)u.ri * 65536 + (wr * 64 + fr) * 256 + wc * 32 + 4 * fq;
#pragma unroll
        for (int ai = 0; ai < 2; ++ai)
#pragma unroll
            for (int m = 0; m < 4; ++m)
#pragma unroll
                for (int bj = 0; bj < 2; ++bj)
#pragma unroll
                    for (int n = 0; n < 2; ++n) *(f32x4*)(tp + (ai * HALF + m * 16) * 256 + bj * HALF + n * 16) = acc[ai][bj][m][n];
    }
};
__device__ __forceinline__ void moe_combine(bf16_t* YM, const float* PART, const PG8_LAS int* tab, int nN, float sc) {
    const int nTm = __builtin_amdgcn_readfirstlane(tab[16]), G = gridDim.x, U = nTm * nN, rem = U % G;
    if (!(rem > 0 && rem * MOE_WAYS <= G)) return;
    int tid_ = threadIdx.x; asm volatile("" : "+v"(tid_));
    const int umain = U - rem, wave = tid_ >> 6, lane = tid_ & 63;
    for (int task = blockIdx.x * 8 + wave; task < rem * 256; task += G * 8) {
        const int r = task >> 8, i = task & 255; int pm, pn; static_order_L(umain + r, nTm, nN, pm, pn);
        const float* pp = PART + (size_t)(r * MOE_WAYS) * 65536 + i * 256 + lane * 4;
        f32x4 s = *(const f32x4*)pp;
#pragma unroll
        for (int q = 1; q < MOE_WAYS; ++q) s = s + *(const f32x4*)(pp + q * 65536);
        s = s * sc;
        typedef unsigned u32x2v __attribute__((ext_vector_type(2))); u32x2v w = {pk2(s[0], s[1]), pk2(s[2], s[3])};
        *(u32x2v*)(YM + (size_t)(pm * BM + i) * 1024 + pn * BM + lane * 4) = w;
    }
}

template <class T, class = void> struct sched_i8 { static constexpr bool value = false; };
template <class T> struct sched_i8<T, decltype((void)T::I8)> { static constexpr bool value = T::I8; };
template <class T, class = void> struct sched_fp8 { static constexpr bool value = false; };
template <class T> struct sched_fp8<T, decltype((void)T::FP8)> { static constexpr bool value = T::FP8; };
template <class T, class = void> struct epi_has_post { static constexpr bool value = false; };
template <class T> struct epi_has_post<T, decltype((void)T::HAS_POST)> { static constexpr bool value = T::HAS_POST; };
template <class Epi, class Sched>
__device__ __forceinline__ void gemm_phase(PG8_LAS unsigned char* lds, const Sched& S, const Epi& E) {
    int tid_ = threadIdx.x; asm volatile("" : "+v"(tid_));
    const int tid = tid_, wid = __builtin_amdgcn_readfirstlane(tid >> 6), lane = tid & 63, wr = wid >> 2, wc = wid & 3, fr = lane & 15, fq = lane >> 4;
    const int K = S.K, nt = S.nt();
    int RA[2], CA[2]; unsigned voffB;
    { int R, C; stage_rc(tid * 16, R, C); const int Rb = Epi::PERM ? ((R & ~31) + perm32(R & 31)) : R;
      RA[0] = R; CA[0] = C; RA[1] = R + 64; CA[1] = C; voffB = (unsigned)(Rb * K + C) * 2u; }
    const unsigned incB = (unsigned)(64 * K * 2), incA = (unsigned)(64 * S.lda * 2);
    const unsigned kstep = (unsigned)(BK * 2);
    const unsigned hstepB = (unsigned)(HALF * K * 2);
    const auto rsA = __builtin_amdgcn_make_buffer_rsrc((void*)S.A, 0, 0x7fffffff, 0x00020000), rsB = __builtin_amdgcn_make_buffer_rsrc((void*)S.Bt, 0, 0x7fffffff, 0x00020000);
    const unsigned ldsw = (unsigned)wid * 1024u;
    const int aoff = lds_byte(wr * 64 + fr, fq * 8), boff = lds_byte(wc * 32 + fr, fq * 8);
#define PG8_SA(b, h) (((b) * 2 + (h)) * HTB)
#define PG8_SB(b, h) ((4 + (b) * 2 + (h)) * HTB)
  \

#define PG8_STAGE_B(bufoff, soff) do { _Pragma("unroll") for (int _i = 0; _i < 2; ++_i) \
        __builtin_amdgcn_raw_ptr_buffer_load_lds(rsB, (PG8_LAS void*)(lds + (bufoff) + ldsw + _i * 8192), 16, voffB, (soff) + _i * incB, 0, 0); } while (0)
#define PG8_STAGE_A(bufoff, soff, h) do { _Pragma("unroll") for (int _i = 0; _i < 2; ++_i) { \
        if constexpr (Sched::GATHER) __builtin_amdgcn_raw_ptr_buffer_load_lds(rsA, (PG8_LAS void*)(lds + (bufoff) + ldsw + _i * 8192), 16, vA[h][_i], (soff), 0, 0); \
        else __builtin_amdgcn_raw_ptr_buffer_load_lds(rsA, (PG8_LAS void*)(lds + (bufoff) + ldsw + _i * 8192), 16, vA[0][0], (soff) + ((h) * 2 + _i) * incA, 0, 0); } } while (0)
#define PG8_LDA(dst, b, h) do { _Pragma("unroll") for (int m = 0; m < 4; ++m) _Pragma("unroll") for (int k = 0; k < 2; ++k) dst[m][k] = *(const PG8_LAS bf16x8*)(lds + PG8_SA(b, h) + aoff + m * 2048 + k * 1024); } while (0)
#define PG8_LDB(dst, b, h) do { _Pragma("unroll") for (int n = 0; n < 2; ++n) _Pragma("unroll") for (int k = 0; k < 2; ++k) dst[n][k] = *(const PG8_LAS bf16x8*)(lds + PG8_SB(b, h) + boff + n * 2048 + k * 1024); } while (0)
#define PG8_CAT8(x, y) __builtin_shufflevector(__builtin_bit_cast(i32x4v, x), __builtin_bit_cast(i32x4v, y), 0, 1, 2, 3, 4, 5, 6, 7)
#define PG8_MMA(ai, bj, At, Bt) do { __builtin_amdgcn_s_setprio(1); _Pragma("unroll") for (int m = 0; m < 4; ++m) _Pragma("unroll") for (int n = 0; n < 2; ++n) { \
        if constexpr (sched_fp8<Sched>::value)   \
              \
              \
            asm volatile("v_mfma_f32_16x16x128_f8f6f4 %0, %1, %2, %0" : "+v"(acc[ai][bj][m][n]) : "v"(PG8_CAT8(Bt[n][0], Bt[n][1])), "v"(PG8_CAT8(At[m][0], At[m][1]))); \
        else if constexpr (sched_i8<Sched>::value) { _Pragma("unroll") for (int k = 0; k < 2; ++k)   \
            acc[ai][bj][m][n] = __builtin_bit_cast(f32x4, __builtin_amdgcn_mfma_i32_16x16x64_i8(__builtin_bit_cast(i32x4v, Bt[n][k]), __builtin_bit_cast(i32x4v, At[m][k]), __builtin_bit_cast(i32x4v, acc[ai][bj][m][n]), 0, 0, 0)); } \
        else { _Pragma("unroll") for (int k = 0; k < 2; ++k) acc[ai][bj][m][n] = __builtin_amdgcn_mfma_f32_16x16x32_bf16(Bt[n][k], At[m][k], acc[ai][bj][m][n], 0, 0, 0); } } __builtin_amdgcn_s_setprio(0); } while (0)
#define PG8_WAIT_V(n) asm volatile("s_waitcnt vmcnt(" #n ")" ::: "memory")
#define PG8_WAIT_L(n) asm volatile("s_waitcnt lgkmcnt(" #n ")" ::: "memory")
#define PG8_BAR __builtin_amdgcn_s_barrier()
#define PG8_SCHED __builtin_amdgcn_sched_barrier(0)
#define PG8_AOFFS(dst, U) do { _Pragma("unroll") for (int _h = 0; _h < 2; ++_h) _Pragma("unroll") for (int _i = 0; _i < 2; ++_i) dst[_h][_i] = S.a_off(U, _h * HALF + RA[_i], CA[_i]); } while (0)
    Unit cur, nxt; int ui = 0;
    if (!S.next(0, cur)) return;
    f32x4 acc[2][2][4][2];
#pragma unroll
    for (int a = 0; a < 2; ++a)
#pragma unroll
        for (int b = 0; b < 2; ++b)
#pragma unroll
            for (int m = 0; m < 4; ++m)
#pragma unroll
                for (int n = 0; n < 2; ++n) acc[a][b][m][n] = (f32x4){0.f, 0.f, 0.f, 0.f};
    bf16x8 At[4][2], B0[2][2], B1[2][2];
    unsigned vA[2][2], vN[2][2];
    PG8_AOFFS(vA, cur);
    unsigned cA = (unsigned)(S.a_base(cur) - (const char*)S.A), cB = (unsigned)(S.b_base(cur) - (const char*)S.Bt);
    PG8_STAGE_B(PG8_SB(0, 0), cB); PG8_STAGE_B(PG8_SB(0, 1), cB + hstepB); PG8_STAGE_A(PG8_SA(0, 0), cA, 0); PG8_STAGE_A(PG8_SA(0, 1), cA, 1);
    if (wr == 1) PG8_BAR;
    PG8_WAIT_V(2); PG8_BAR;
    PG8_STAGE_B(PG8_SB(1, 0), cB + kstep); PG8_STAGE_A(PG8_SA(1, 0), cA + kstep, 0); PG8_STAGE_B(PG8_SB(1, 1), cB + hstepB + kstep);
    PG8_WAIT_V(6); PG8_BAR;
    for (;;) {
        const bool has_next = S.next(ui + 1, nxt);
        const unsigned nA = has_next ? (unsigned)(S.a_base(nxt) - (const char*)S.A) : cA, nB = has_next ? (unsigned)(S.b_base(nxt) - (const char*)S.Bt) : cB;
        for (int t = 0; t < nt; t += 2) {
            const bool last = (t == nt - 2);
            const bool sw = Sched::GATHER && last && has_next;
            if constexpr (Sched::GATHER) { if (sw) { PG8_AOFFS(vN, nxt); } }
            const unsigned a1 = cA + (unsigned)(t + 1) * kstep;
            const unsigned a2 = last ? nA : cA + (unsigned)(t + 2) * kstep, b2 = last ? nB : cB + (unsigned)(t + 2) * kstep;
            const unsigned a3 = a2 + kstep, b3 = b2 + kstep;
            PG8_LDB(B0, 0, 0); PG8_LDB(B1, 0, 1); PG8_SCHED; PG8_LDA(At, 0, 0); PG8_STAGE_A(PG8_SA(1, 1), a1, 1);
            if constexpr (Sched::GATHER) { if (sw) {
#pragma unroll
                for (int _h = 0; _h < 2; ++_h)
#pragma unroll
                    for (int _i = 0; _i < 2; ++_i) vA[_h][_i] = vN[_h][_i]; } }
            PG8_WAIT_V(8); PG8_WAIT_L(0); PG8_BAR; PG8_MMA(0, 0, At, B0); PG8_MMA(0, 1, At, B1); PG8_BAR; PG8_SCHED;
            PG8_LDA(At, 0, 1); PG8_STAGE_B(PG8_SB(0, 0), b2); PG8_STAGE_B(PG8_SB(0, 1), b2 + hstepB); PG8_STAGE_A(PG8_SA(0, 0), a2, 0);
            PG8_WAIT_V(8); PG8_WAIT_L(0); PG8_BAR; PG8_MMA(1, 0, At, B0); PG8_MMA(1, 1, At, B1); PG8_BAR; PG8_SCHED;
            PG8_LDB(B0, 1, 0); PG8_LDB(B1, 1, 1); PG8_SCHED; PG8_LDA(At, 1, 0); PG8_STAGE_A(PG8_SA(0, 1), a2, 1);
            PG8_WAIT_V(8); PG8_WAIT_L(0); PG8_BAR; PG8_MMA(0, 0, At, B0); PG8_MMA(0, 1, At, B1); PG8_BAR; PG8_SCHED;
            PG8_LDA(At, 1, 1); PG8_STAGE_B(PG8_SB(1, 0), b3); PG8_STAGE_B(PG8_SB(1, 1), b3 + hstepB); PG8_STAGE_A(PG8_SA(1, 0), a3, 0);
            PG8_WAIT_V(8); PG8_WAIT_L(0); PG8_BAR; PG8_MMA(1, 0, At, B0); PG8_MMA(1, 1, At, B1); PG8_BAR; PG8_SCHED;
        }
        if constexpr (sched_fp8<Sched>::value) asm volatile("s_nop 15\n\ts_nop 7" ::: "memory");
        if (wr == 0) PG8_BAR;
        { int te_ = threadIdx.x; asm volatile("" : "+v"(te_));
          E(acc, cur, wr, wc, te_ & 15, (te_ & 63) >> 4); }
        if constexpr (epi_has_post<Epi>::value) E.post(cur);
        if (!has_next) break;
#pragma unroll
        for (int a = 0; a < 2; ++a)
#pragma unroll
            for (int b = 0; b < 2; ++b)
#pragma unroll
                for (int m = 0; m < 4; ++m)
#pragma unroll
                    for (int n = 0; n < 2; ++n) acc[a][b][m][n] = (f32x4){0.f, 0.f, 0.f, 0.f};
        cur = nxt; cA = nA; cB = nB; ++ui;
        if (wr == 1) PG8_BAR;
    }
    PG8_WAIT_V(0);
    PG8_BAR;
#undef PG8_SA
#undef PG8_SB
#undef PG8_STAGE_A
#undef PG8_STAGE_B
#undef PG8_LDA
#undef PG8_LDB
#undef PG8_MMA
#undef PG8_CAT8
#undef PG8_WAIT_V
#undef PG8_WAIT_L
#undef PG8_BAR
#undef PG8_SCHED
#undef PG8_AOFFS
}
}

__device__ __forceinline__ float rope_inv(int i2, int dim) { return powf(10000.0f, -(float)i2 / (float)dim); }

__device__ __forceinline__ void ph_final(const P& p) {
    int tid_ = threadIdx.x; asm volatile("" : "+v"(tid_));
    const int wave = tid_ >> 6, lane = tid_ & 63;
    const float* gain = p.in[24];
    for (int row = blockIdx.x * 8 + wave; row < T_LAT; row += gridDim.x * 8) {
        float* src = p.out + (size_t)row * 1024;
        float4 v[4]; float ss = 0.f;
#pragma unroll
        for (int i = 0; i < 4; ++i) { v[i] = *(const float4*)(src + i * 256 + lane * 4); ss += v[i].x * v[i].x + v[i].y * v[i].y + v[i].z * v[i].z + v[i].w * v[i].w; }
        ss = wave_sum(ss);
        const float rs = rsqrtf(ss * (1.f / 1024.f) + NORM_EPS);
#pragma unroll
        for (int i = 0; i < 4; ++i) { const int col = i * 256 + lane * 4; const float4 g = *(const float4*)(gain + col);
            *(float4*)(src + col) = make_float4(v[i].x * rs * g.x, v[i].y * rs * g.y, v[i].z * rs * g.z, v[i].w * rs * g.w); }
    }
}


__device__ __forceinline__ void ph_final_moe(const P& p, const LAS int* tab0, const LAS int* tab1) {
    int tid_ = threadIdx.x; asm volatile("" : "+v"(tid_));
    const int wave = tid_ >> 6, lane = tid_ & 63;
    const float* gain = p.in[24];
    const bf16_t* YM0 = (const bf16_t*)(p.ws + OFF_YM); const bf16_t* YM1 = YM0 + (size_t)ACT_ROWS * 1024;
    const float* MODL = (const float*)(p.ws + OFF_MOD) + 9 * 6144 + 5120;
    int row = blockIdx.x * 8 + wave; const int stride = gridDim.x * 8;
    int4 ep = make_int4(0, 0, 0, 0), nep = ep; float2 ww = make_float2(0.f, 0.f), nww = ww;
    if (row < T_LAT) { const int* iv = (const int*)(p.ws + OFF_INV) + (size_t)row * 8; ep = *(const int4*)iv; ww = *(const float2*)(iv + 4); }
    for (; row < T_LAT; row += stride) {
        if (row + stride < T_LAT) { const int* iv = (const int*)(p.ws + OFF_INV) + (size_t)(row + stride) * 8; nep = *(const int4*)iv; nww = *(const float2*)(iv + 4); }
        const size_t r0 = (size_t)(tab0[8 + ep.x] * 256 + ep.y) * 1024, r1 = (size_t)(tab1[8 + ep.z] * 256 + ep.w) * 1024;
        float* src = p.out + (size_t)row * 1024;
        const float* gt = MODL + (row >> 12) * 6144;
        float4 v[4]; uint2 y0[4], y1[4]; float4 gg[4]; float ss = 0.f;
#pragma unroll
        for (int i = 0; i < 4; ++i) { const int col = i * 256 + lane * 4; v[i] = *(const float4*)(src + col); y0[i] = *(const uint2*)(YM0 + r0 + col); y1[i] = *(const uint2*)(YM1 + r1 + col); gg[i] = *(const float4*)(gt + col); }
#pragma unroll
        for (int i = 0; i < 4; ++i) {
            v[i].x += gg[i].x * (ww.x * __uint_as_float(y0[i].x << 16) + ww.y * __uint_as_float(y1[i].x << 16));
            v[i].y += gg[i].y * (ww.x * __uint_as_float(y0[i].x & 0xFFFF0000u) + ww.y * __uint_as_float(y1[i].x & 0xFFFF0000u));
            v[i].z += gg[i].z * (ww.x * __uint_as_float(y0[i].y << 16) + ww.y * __uint_as_float(y1[i].y << 16));
            v[i].w += gg[i].w * (ww.x * __uint_as_float(y0[i].y & 0xFFFF0000u) + ww.y * __uint_as_float(y1[i].y & 0xFFFF0000u));
            ss += v[i].x * v[i].x + v[i].y * v[i].y + v[i].z * v[i].z + v[i].w * v[i].w; }
        ss = wave_sum(ss);
        const float rs = rsqrtf(ss * (1.f / 1024.f) + NORM_EPS);
#pragma unroll
        for (int i = 0; i < 4; ++i) { const int col = i * 256 + lane * 4; const float4 g = *(const float4*)(gain + col);
            *(float4*)(src + col) = make_float4(v[i].x * rs * g.x, v[i].y * rs * g.y, v[i].z * rs * g.z, v[i].w * rs * g.w); }
        ep = nep; ww = nww;
    }
}
typedef short bf16x8_t __attribute__((ext_vector_type(8)));
typedef short s16x4_t __attribute__((ext_vector_type(4)));
typedef float f32x16_t __attribute__((ext_vector_type(16)));
typedef unsigned u32x4_t __attribute__((ext_vector_type(4)));
typedef float f32x4_t __attribute__((ext_vector_type(4)));
__device__ __forceinline__ s16x4_t lds_tr16(LAS const unsigned char* p) { typedef short v4i16_t __attribute__((ext_vector_type(4))); return __builtin_bit_cast(s16x4_t, __builtin_amdgcn_ds_read_tr16_b64_v4i16((LAS v4i16_t*)p)); }
__device__ __forceinline__ unsigned pkbf(float lo, float hi) { typedef float f32x2_t __attribute__((ext_vector_type(2))); typedef __bf16 bf16x2_t __attribute__((ext_vector_type(2)));
    f32x2_t v = {lo, hi}; bf16x2_t b = __builtin_convertvector(v, bf16x2_t); return __builtin_bit_cast(unsigned, b); }
__device__ __forceinline__ float max3f(float a, float b, float c) { return fmaxf(fmaxf(a, b), c); }

#define ATT_VP 192
#define ATT_THR 6.0f
template <int DQK, bool SWA, bool GQA = false>
__device__ __forceinline__ void attn_unit(LAS unsigned char* lds, const bf16_t* POST, const bf16_t* VBUF, int vld, bf16_t* MIX, int b, int q0, int qcol, int kcol, int vcol, int ocol,
                                          int band_lo, int band_hi, float sinkl2, float qscale, const float* sinkp, float sinkmul) {
    constexpr int KP = DQK * 2 + 16, NPK = DQK / 8, NKL = NPK / 4, STAGE = 128 * KP + 128 * ATT_VP, NS = DQK / 16;
    int tid_ = threadIdx.x; asm volatile("" : "+v"(tid_));
    const int tid = tid_, wid = __builtin_amdgcn_readfirstlane(tid >> 6), lane = tid & 63, r = lane & 31, h = lane >> 5;
    const int nb = (band_hi - band_lo) >> 7, ntiles = nb + 2;
    const int qw0 = GQA ? q0 + 32 * (wid & 1) : q0 + 32 * wid;
    const int qi = qw0 + r;
    const int qrow = tok_row(b, qi);
    if (GQA) { qcol += (wid >> 1) * 64; ocol += (wid >> 1) * 64; sinkl2 = sinkp[wid >> 1] * sinkmul; }
    bf16x8_t qf[NS];
    { const bf16_t* qp = POST + (size_t)qrow * POST_LD + qcol + 8 * h;
#pragma unroll
      for (int s = 0; s < NS; ++s) { float f[8]; unpack8(*(const uint4*)(qp + 16 * s), f);
          const unsigned w0 = pkbf(f[0] * qscale, f[1] * qscale), w1 = pkbf(f[2] * qscale, f[3] * qscale), w2 = pkbf(f[4] * qscale, f[5] * qscale), w3 = pkbf(f[6] * qscale, f[7] * qscale);
          qf[s] = __builtin_bit_cast(bf16x8_t, make_uint4(w0, w1, w2, w3)); } }
    f32x16_t O0, O1;
#pragma unroll
    for (int i = 0; i < 16; ++i) { O0[i] = 0.f; O1[i] = 0.f; }
    float m = SWA ? sinkl2 : -1e30f, l = 0.f;
    u32x4_t kreg[NKL], vreg[2];
    const int vrow = tid >> 3, vpc = tid & 7;
#define ATT_KS(t) ((t) < nb ? band_lo + 128 * (t) : SEQ + 128 * ((t) - nb))
#define ATT_LOAD(t) do { const int ks_ = ATT_KS(t); const bf16_t* base_ = POST + (size_t)tok_row(b, ks_) * POST_LD; \
        _Pragma("unroll") for (int i_ = 0; i_ < NKL; ++i_) { const int idx_ = tid + 512 * i_, row_ = idx_ / NPK, pc_ = idx_ % NPK; kreg[i_] = *(const u32x4_t*)(base_ + (size_t)row_ * POST_LD + kcol + pc_ * 8); } \
        const bf16_t* vbase_ = VBUF + (size_t)tok_row(b, ks_) * vld; \
        _Pragma("unroll") for (int i_ = 0; i_ < 2; ++i_) vreg[i_] = *(const u32x4_t*)(vbase_ + (size_t)(vrow + 64 * i_) * vld + vcol + vpc * 8); } while (0)
#define ATT_WRITE(buf) do { LAS unsigned char* kb_ = lds + (buf) * STAGE; LAS unsigned char* vb_ = kb_ + 128 * KP; \
        _Pragma("unroll") for (int i_ = 0; i_ < NKL; ++i_) { const int idx_ = tid + 512 * i_, row_ = idx_ / NPK, pc_ = idx_ % NPK; *(LAS u32x4_t*)(kb_ + row_ * KP + pc_ * 16) = kreg[i_]; } \
        _Pragma("unroll") for (int i_ = 0; i_ < 2; ++i_) *(LAS u32x4_t*)(vb_ + (vrow + 64 * i_) * ATT_VP + vpc * 16) = vreg[i_]; } while (0)
    const int koff = r * KP + 16 * h;
    const int voff = (4 * h + ((lane & 15) >> 2)) * ATT_VP + (16 * ((lane >> 4) & 1) + 4 * (lane & 3)) * 2;
    __syncthreads();
    ATT_LOAD(0); ATT_WRITE(0);
    __syncthreads();
    for (int t = 0; t < ntiles; ++t) {
        if (t + 1 < ntiles) ATT_LOAD(t + 1);
        LAS const unsigned char* kb = lds + (t & 1) * STAGE; LAS const unsigned char* vb = kb + 128 * KP;
        const int ks = ATT_KS(t);
        bool skip[2] = {false, false}, need_mask[2] = {false, false};
        if (SWA && t < nb) {
#pragma unroll
            for (int sub = 0; sub < 2; ++sub) { const int kb0 = ks + sub * 64, qlo = qw0, qhi = qlo + 31;
                skip[sub] = (kb0 > qhi + 128) || (kb0 + 63 < qlo - 128);
                need_mask[sub] = !((kb0 >= qhi - 128) && (kb0 + 63 <= qlo + 128)); }
        }
        f32x16_t S[4];
#pragma unroll
        for (int blk = 0; blk < 4; ++blk)
#pragma unroll
            for (int i = 0; i < 16; ++i) S[blk][i] = 0.f;
#pragma unroll
        for (int sub = 0; sub < 2; ++sub) {
            if (!skip[sub]) {
#pragma unroll
                for (int s = 0; s < NS; ++s) {
                    const bf16x8_t k0 = *(LAS const bf16x8_t*)(kb + (sub * 64) * KP + koff + 32 * s), k1 = *(LAS const bf16x8_t*)(kb + (sub * 64 + 32) * KP + koff + 32 * s);
                    S[2 * sub] = __builtin_amdgcn_mfma_f32_32x32x16_bf16(k0, qf[s], S[2 * sub], 0, 0, 0);
                    S[2 * sub + 1] = __builtin_amdgcn_mfma_f32_32x32x16_bf16(k1, qf[s], S[2 * sub + 1], 0, 0, 0);
                }
            }
        }
#pragma unroll
        for (int sub = 0; sub < 2; ++sub) {
            if (!skip[sub]) {
                const int kb0 = ks + sub * 64;
                f32x16_t& S0 = S[2 * sub]; f32x16_t& S1 = S[2 * sub + 1];
                bf16x8_t va[8];
#pragma unroll
                for (int g = 0; g < 4; ++g) { LAS const unsigned char* vp = vb + (sub * 64 + 16 * g) * ATT_VP + voff;
                    const s16x4_t l0 = lds_tr16(vp), h0 = lds_tr16(vp + 8 * ATT_VP), l1 = lds_tr16(vp + 64), h1 = lds_tr16(vp + 8 * ATT_VP + 64);
                    va[2 * g] = __builtin_shufflevector(l0, h0, 0, 1, 2, 3, 4, 5, 6, 7); va[2 * g + 1] = __builtin_shufflevector(l1, h1, 0, 1, 2, 3, 4, 5, 6, 7); }
                if (SWA && need_mask[sub]) {
#pragma unroll
                    for (int i = 0; i < 16; ++i) { const int d0 = kb0 + (i & 3) + 8 * (i >> 2) + 4 * h - qi, d1 = d0 + 32;
                        if (d0 > 128 || d0 < -128) S0[i] = -1e30f;
                        if (d1 > 128 || d1 < -128) S1[i] = -1e30f; }
                }
                float mx = max3f(S0[0], S0[1], S1[0]), mx2 = max3f(S0[2], S0[3], S1[1]);
                mx = max3f(mx, S1[2], S1[3]);
#pragma unroll
                for (int i = 4; i < 16; i += 4) { mx = max3f(mx, S0[i], S0[i + 1]); mx2 = max3f(mx2, S0[i + 2], S0[i + 3]); mx = max3f(mx, S1[i], S1[i + 1]); mx2 = max3f(mx2, S1[i + 2], S1[i + 3]); }
                mx = fmaxf(mx, mx2);
                { const auto rr_ = __builtin_amdgcn_permlane32_swap(__float_as_uint(mx), __float_as_uint(mx), false, false); mx = fmaxf(__uint_as_float(rr_[0]), __uint_as_float(rr_[1])); }
                if (__any(mx > m + ATT_THR)) {
                    const float mn = fmaxf(m, mx), al = __builtin_amdgcn_exp2f(m - mn);
                    m = mn; l *= al;
#pragma unroll
                    for (int i = 0; i < 16; ++i) { O0[i] *= al; O1[i] *= al; }
                }
                typedef float f32x2_t __attribute__((ext_vector_type(2)));
                const f32x2_t m2 = {m, m}; f32x2_t ps2 = {0.f, 0.f};
#pragma unroll
                for (int i = 0; i < 16; i += 2) {
                    f32x2_t a = (f32x2_t){S0[i], S0[i + 1]} - m2, c = (f32x2_t){S1[i], S1[i + 1]} - m2;
                    a[0] = __builtin_amdgcn_exp2f(a[0]); a[1] = __builtin_amdgcn_exp2f(a[1]); c[0] = __builtin_amdgcn_exp2f(c[0]); c[1] = __builtin_amdgcn_exp2f(c[1]);
                    S0[i] = a[0]; S0[i + 1] = a[1]; S1[i] = c[0]; S1[i + 1] = c[1];
                    ps2 += a; ps2 += c;
                }
                l += ps2[0] + ps2[1];
#pragma unroll
                for (int g = 0; g < 4; ++g) { const f32x16_t& Sx = (g >> 1) ? S1 : S0; const int o8 = 8 * (g & 1);
                    const bf16x8_t pf = __builtin_bit_cast(bf16x8_t, make_uint4(pkbf(Sx[o8 + 0], Sx[o8 + 1]), pkbf(Sx[o8 + 2], Sx[o8 + 3]), pkbf(Sx[o8 + 4], Sx[o8 + 5]), pkbf(Sx[o8 + 6], Sx[o8 + 7])));
                    O0 = __builtin_amdgcn_mfma_f32_32x32x16_bf16(va[2 * g], pf, O0, 0, 0, 0);
                    O1 = __builtin_amdgcn_mfma_f32_32x32x16_bf16(va[2 * g + 1], pf, O1, 0, 0, 0);
                }
            }
        }
        if (t + 1 < ntiles) ATT_WRITE((t + 1) & 1);
        __syncthreads();
    }
#undef ATT_LOAD
#undef ATT_KS
#undef ATT_WRITE
    float lt = l + __shfl_xor(l, 32);
    if (SWA) lt += __builtin_amdgcn_exp2f(sinkl2 - m);
    const float inv = 1.f / lt;
    bf16_t* op = MIX + (size_t)qrow * 1024 + ocol + 4 * h;
#pragma unroll
    for (int g = 0; g < 4; ++g) {
        *(uint2*)(op + 8 * g) = make_uint2(pkbf(O0[4 * g] * inv, O0[4 * g + 1] * inv), pkbf(O0[4 * g + 2] * inv, O0[4 * g + 3] * inv));
        *(uint2*)(op + 32 + 8 * g) = make_uint2(pkbf(O1[4 * g] * inv, O1[4 * g + 1] * inv), pkbf(O1[4 * g + 2] * inv, O1[4 * g + 3] * inv));
    }
}


typedef int i32x8_t __attribute__((ext_vector_type(8)));
typedef int i32x4_t __attribute__((ext_vector_type(4)));
#define A8_KP 144
__device__ __forceinline__ i32x8_t lds_frag32(LAS const unsigned char* p) { const i32x4_t lo = *(LAS const i32x4_t*)p, hi = *(LAS const i32x4_t*)(p + 16); return __builtin_shufflevector(lo, hi, 0, 1, 2, 3, 4, 5, 6, 7); }
__device__ __forceinline__ int cvt4_f8(float a, float b, float c, float d) { return __builtin_amdgcn_cvt_pk_fp8_f32(c, d, __builtin_amdgcn_cvt_pk_fp8_f32(a, b, 0, false), true); }
__device__ __forceinline__ void attn_unit_f8(LAS unsigned char* lds, const unsigned char* QK8, const unsigned char* V8T, bf16_t* MIX, int b, int q0, int head, int band_lo, int band_hi, float qscale) {
    constexpr int STAGE = 128 * A8_KP + 64 * A8_KP;
    int tid_ = threadIdx.x; asm volatile("" : "+v"(tid_));
    const int tid = tid_, wid = __builtin_amdgcn_readfirstlane(tid >> 6), lane = tid & 63, r = lane & 31, h = lane >> 5;
    const int nb = (band_hi - band_lo) >> 7, ntiles = nb + 2;
    const int qi = q0 + 32 * wid + r, qrow = tok_row(b, qi);
    i32x8_t qf[2];
    { const unsigned char* qp = QK8 + (size_t)qrow * 1024 + head * 128 + 32 * h;
#pragma unroll
      for (int s = 0; s < 2; ++s) { const i32x4_t lo = *(const i32x4_t*)(qp + 64 * s), hi = *(const i32x4_t*)(qp + 64 * s + 16); qf[s] = __builtin_shufflevector(lo, hi, 0, 1, 2, 3, 4, 5, 6, 7); } }
    f32x16_t O0, O1;
#pragma unroll
    for (int i = 0; i < 16; ++i) { O0[i] = 0.f; O1[i] = 0.f; }
    float m = -1e30f;
    f32x16_t Ls;
#pragma unroll
    for (int i = 0; i < 16; ++i) Ls[i] = 0.f;
    const i32x8_t ones8 = {0x38383838, 0x38383838, 0x38383838, 0x38383838, 0x38383838, 0x38383838, 0x38383838, 0x38383838};
    u32x4_t kreg[2], vreg;
    const unsigned char* vbase = V8T + (size_t)((b * 4 + head) * 64 + (tid >> 3)) * 4352 + (tid & 7) * 16;
#define A8_KS(t) ((t) < nb ? band_lo + 128 * (t) : SEQ + 128 * ((t) - nb))
#define A8_LOAD(t) do { const int ks_ = A8_KS(t); const unsigned char* base_ = QK8 + (size_t)tok_row(b, ks_) * 1024 + 512 + head * 128; \
        _Pragma("unroll") for (int i_ = 0; i_ < 2; ++i_) { const int idx_ = tid + 512 * i_; kreg[i_] = *(const u32x4_t*)(base_ + (size_t)(idx_ >> 3) * 1024 + (idx_ & 7) * 16); } \
        vreg = *(const u32x4_t*)(vbase + ks_); } while (0)
#define A8_WRITE(buf) do { LAS unsigned char* kb_ = lds + (buf) * STAGE; \
        _Pragma("unroll") for (int i_ = 0; i_ < 2; ++i_) { const int idx_ = tid + 512 * i_; *(LAS u32x4_t*)(kb_ + (idx_ >> 3) * A8_KP + (idx_ & 7) * 16) = kreg[i_]; } \
        *(LAS u32x4_t*)(kb_ + 128 * A8_KP + (tid >> 3) * A8_KP + (tid & 7) * 16) = vreg; } while (0)
    const int foff = r * A8_KP + 32 * h;
    __syncthreads();
    A8_LOAD(0); A8_WRITE(0);
    __syncthreads();
    typedef float f32x2_t __attribute__((ext_vector_type(2)));
    const f32x2_t qs2 = {qscale, qscale};
    for (int t = 0; t < ntiles; ++t) {
        if (t + 1 < ntiles) A8_LOAD(t + 1);
        LAS const unsigned char* kb = lds + (t & 1) * STAGE; LAS const unsigned char* vb = kb + 128 * A8_KP;
        f32x16_t S[4];
#pragma unroll
        for (int blk = 0; blk < 4; ++blk)
#pragma unroll
            for (int i = 0; i < 16; ++i) S[blk][i] = 0.f;
#pragma unroll
        for (int blk = 0; blk < 4; ++blk)
#pragma unroll
            for (int s = 0; s < 2; ++s) S[blk] = __builtin_amdgcn_mfma_scale_f32_32x32x64_f8f6f4(lds_frag32(kb + (blk * 32) * A8_KP + foff + 64 * s), qf[s], S[blk], 0, 0, 0, 0, 0, 0);
#pragma unroll
        for (int sub = 0; sub < 2; ++sub) {
            f32x16_t& S0 = S[2 * sub]; f32x16_t& S1 = S[2 * sub + 1];
            const i32x8_t va0 = lds_frag32(vb + foff + 64 * sub), va1 = lds_frag32(vb + 32 * A8_KP + foff + 64 * sub);
            float mx = max3f(S0[0], S0[1], S1[0]), mx2 = max3f(S0[2], S0[3], S1[1]);
            mx = max3f(mx, S1[2], S1[3]);
#pragma unroll
            for (int i = 4; i < 16; i += 4) { mx = max3f(mx, S0[i], S0[i + 1]); mx2 = max3f(mx2, S0[i + 2], S0[i + 3]); mx = max3f(mx, S1[i], S1[i + 1]); mx2 = max3f(mx2, S1[i + 2], S1[i + 3]); }
            mx = fmaxf(mx, mx2);
            { const auto rr_ = __builtin_amdgcn_permlane32_swap(__float_as_uint(mx), __float_as_uint(mx), false, false); mx = fmaxf(__uint_as_float(rr_[0]), __uint_as_float(rr_[1])); }
            mx *= qscale;
            if (__any(mx > m + ATT_THR)) {
                const float mn = fmaxf(m, mx), al = __builtin_amdgcn_exp2f(m - mn);
                m = mn; Ls[0] *= al;
#pragma unroll
                for (int i = 0; i < 16; ++i) { O0[i] *= al; O1[i] *= al; }
            }
            const f32x2_t m2 = {-m, -m};
#pragma unroll
            for (int i = 0; i < 16; i += 2) {
                f32x2_t a = (f32x2_t){S0[i], S0[i + 1]} * qs2 + m2, c = (f32x2_t){S1[i], S1[i + 1]} * qs2 + m2;
                a[0] = __builtin_amdgcn_exp2f(a[0]); a[1] = __builtin_amdgcn_exp2f(a[1]); c[0] = __builtin_amdgcn_exp2f(c[0]); c[1] = __builtin_amdgcn_exp2f(c[1]);
                S0[i] = a[0]; S0[i + 1] = a[1]; S1[i] = c[0]; S1[i + 1] = c[1];
            }
            i32x8_t pf;
#pragma unroll
            for (int w = 0; w < 4; ++w) { pf[w] = cvt4_f8(S0[4 * w], S0[4 * w + 1], S0[4 * w + 2], S0[4 * w + 3]); pf[4 + w] = cvt4_f8(S1[4 * w], S1[4 * w + 1], S1[4 * w + 2], S1[4 * w + 3]); }
            O0 = __builtin_amdgcn_mfma_scale_f32_32x32x64_f8f6f4(va0, pf, O0, 0, 0, 0, 0, 0, 0);
            O1 = __builtin_amdgcn_mfma_scale_f32_32x32x64_f8f6f4(va1, pf, O1, 0, 0, 0, 0, 0, 0);
            Ls = __builtin_amdgcn_mfma_scale_f32_32x32x64_f8f6f4(ones8, pf, Ls, 0, 0, 0, 0, 0, 0);
        }
        if (t + 1 < ntiles) A8_WRITE((t + 1) & 1);
        __syncthreads();
    }
#undef A8_LOAD
#undef A8_KS
#undef A8_WRITE
    const float inv = 1.f / Ls[0];
    bf16_t* op = MIX + (size_t)qrow * 1024 + head * 64 + 4 * h;
#pragma unroll
    for (int g = 0; g < 4; ++g) {
        *(uint2*)(op + 8 * g) = make_uint2(pkbf(O0[4 * g] * inv, O0[4 * g + 1] * inv), pkbf(O0[4 * g + 2] * inv, O0[4 * g + 3] * inv));
        *(uint2*)(op + 32 + 8 * g) = make_uint2(pkbf(O1[4 * g] * inv, O1[4 * g + 1] * inv), pkbf(O1[4 * g + 2] * inv, O1[4 * g + 3] * inv));
    }
}
__device__ __forceinline__ float log2_sigmoid(float x) { return log2f(1.f / (1.f + expf(-x))); }

__device__ __forceinline__ void ph_ret_T(const P& p, int layer, LAS unsigned char* lds) {
    const bf16_t* POST = (const bf16_t*)(p.ws + OFF_POST); const bf16_t* PROJB = (const bf16_t*)(p.ws + OFF_PROJ);
    bf16_t* TT = (bf16_t*)(p.ws + OFF_TT);
    int tid_ = threadIdx.x; asm volatile("" : "+v"(tid_));
    const int tid = tid_, wid = __builtin_amdgcn_readfirstlane(tid >> 6), lane = tid & 63, h2 = lane >> 5;
    const int G = gridDim.x, bid = blockIdx.x;
    const int trq = (lane & 15) >> 2, trc = (16 * ((lane >> 4) & 1) + 4 * (lane & 3)) * 2;
    for (int u = bid; u < BATCH * 34 * 2; u += G) {
        const int hp = u & 1, c = (u >> 1) % 34, b = u / 68;
        const int row0 = c < 32 ? b * SEQ + c * 128 : T_LAT + b * CTXL + (c - 32) * 128;
        __syncthreads();
#pragma unroll
        for (int i = 0; i < 8; ++i) {
            const int idx = tid + 512 * i, arr = idx >> 10, rem = idx & 1023, row = rem >> 3, pc = rem & 7;
            const u32x4_t v = arr < 2 ? *(const u32x4_t*)(POST + (size_t)(row0 + row) * POST_LD + PC_RK + (2 * hp + (arr & 1)) * 64 + pc * 8)
                                      : *(const u32x4_t*)(PROJB + (size_t)(row0 + row) * PROJ_LD + PJ_RV + (2 * hp + (arr & 1)) * 64 + pc * 8);
            *(LAS u32x4_t*)(lds + arr * 24576 + row * 192 + pc * 16) = v;
        }
        __syncthreads();
        const int hh = wid >> 2, head = 2 * hp + hh, dir = (wid >> 1) & 1, dvb = wid & 1;
        const float lg = log2_sigmoid(dir ? p.in[15][layer * 4 + head] : p.in[14][layer * 4 + head]);
        f32x16_t acc0, acc1;
#pragma unroll
        for (int i = 0; i < 16; ++i) { acc0[i] = 0.f; acc1[i] = 0.f; }
        LAS const unsigned char* kt = lds + hh * 24576; LAS const unsigned char* vt = lds + (2 + hh) * 24576;
#pragma unroll
        for (int s = 0; s < 8; ++s) {
            const int kr = 16 * s + 8 * h2;
            LAS const unsigned char* vp = vt + (kr + trq) * 192 + dvb * 64 + trc;
            const s16x4_t vlo = lds_tr16(vp), vhi = lds_tr16(vp + 4 * 192);
            const bf16x8_t a = {vlo[0], vlo[1], vlo[2], vlo[3], vhi[0], vhi[1], vhi[2], vhi[3]};
            float w[8];
#pragma unroll
            for (int j = 0; j < 8; ++j) w[j] = __builtin_amdgcn_exp2f(lg * (float)(dir ? (kr + j) : (127 - kr - j)));
#pragma unroll
            for (int dkb = 0; dkb < 2; ++dkb) {
                LAS const unsigned char* kp = kt + (kr + trq) * 192 + dkb * 64 + trc;
                const s16x4_t klo = lds_tr16(kp), khi = lds_tr16(kp + 4 * 192);
                float f[8];
#pragma unroll
                for (int j = 0; j < 4; ++j) { f[j] = bf2f((bf16_t)klo[j]) * w[j]; f[4 + j] = bf2f((bf16_t)khi[j]) * w[4 + j]; }
                const bf16x8_t bb = __builtin_bit_cast(bf16x8_t, make_uint4(pkbf(f[0], f[1]), pkbf(f[2], f[3]), pkbf(f[4], f[5]), pkbf(f[6], f[7])));
                if (dkb == 0) acc0 = __builtin_amdgcn_mfma_f32_32x32x16_bf16(a, bb, acc0, 0, 0, 0);
                else acc1 = __builtin_amdgcn_mfma_f32_32x32x16_bf16(a, bb, acc1, 0, 0, 0);
            }
        }
        bf16_t* tp = TT + ((((size_t)(b * 4 + head) * 34 + c) * 2 + dir) * 4096) + (lane & 31);
#pragma unroll
        for (int i = 0; i < 16; ++i) { const int dv = 32 * dvb + (i & 3) + 8 * (i >> 2) + 4 * h2; tp[dv * 64] = f2bf(acc0[i]); tp[dv * 64 + 32] = f2bf(acc1[i]); }
    }
}

__device__ __forceinline__ void ret_unit(LAS unsigned char* lds, const P& p, int layer, int b, int c, int hp) {
    const bf16_t* POST = (const bf16_t*)(p.ws + OFF_POST); const bf16_t* PROJB = (const bf16_t*)(p.ws + OFF_PROJ);
    bf16_t* MIX = (bf16_t*)(p.ws + OFF_H);
    const bf16_t* TT = (const bf16_t*)(p.ws + OFF_TT);
    int tid_ = threadIdx.x; asm volatile("" : "+v"(tid_));
    const int tid = tid_, wid = __builtin_amdgcn_readfirstlane(tid >> 6), lane = tid & 63, r = lane & 31, h2 = lane >> 5;
    const bool isctx = c >= 32;
    const int row0 = !isctx ? b * SEQ + c * 128 : T_LAT + b * CTXL + (c - 32) * 128;
    constexpr int L_ST = 0, L_K = 36864, L_V = 73728;
    __syncthreads();
#pragma unroll
    for (int i = 0; i < 8; ++i) {
        const int idx = tid + 512 * i, arr = idx >> 10, rem = idx & 1023, row = rem >> 3, pc = rem & 7;
        const u32x4_t v = arr < 2 ? *(const u32x4_t*)(POST + (size_t)(row0 + row) * POST_LD + PC_RK + (2 * hp + (arr & 1)) * 64 + pc * 8)
                                      : *(const u32x4_t*)(PROJB + (size_t)(row0 + row) * PROJ_LD + PJ_RV + (2 * hp + (arr & 1)) * 64 + pc * 8);
        if (arr < 2) *(LAS u32x4_t*)(lds + L_K + (arr & 1) * 18432 + row * 144 + pc * 16) = v;
        else *(LAS u32x4_t*)(lds + L_V + (arr & 1) * 24576 + row * 192 + pc * 16) = v;
    }
    {
        const int hd = tid >> 7, hh = hd >> 1, dir = hd & 1, head = 2 * hp + hh;
        const float g128 = 128.f * log2_sigmoid(dir ? p.in[15][layer * 4 + head] : p.in[14][layer * 4 + head]);
        const bf16_t* tb = TT + (size_t)(b * 4 + head) * 34 * 2 * 4096 + dir * 4096 + (tid & 127) * 4;
        f32x4_t acc[8];
#pragma unroll
        for (int i = 0; i < 8; ++i) acc[i] = (f32x4_t){0.f, 0.f, 0.f, 0.f};
        int v0, v1;
        if (!isctx) { if (dir == 0) { v0 = -2; v1 = c - 1; } else { v0 = c + 1; v1 = 33; } }
        else { const int cc = c - 32; if (dir == 0) { v0 = -2; v1 = cc - 3; } else { v0 = 33 + cc; v1 = 33; } }
        for (int v = v0; v <= v1; ++v) {
            const int idxT = v < 0 ? 34 + v : v;
            const float coef = __builtin_amdgcn_exp2f(g128 * (float)(dir == 0 ? (v1 - v) : (v - v0)));
            const bf16_t* tp = tb + (size_t)idxT * 2 * 4096;
#pragma unroll
            for (int i = 0; i < 8; ++i) { const uint2 r_ = *(const uint2*)(tp + 512 * i);
                const f32x4_t x = {__uint_as_float(r_.x << 16), __uint_as_float(r_.x & 0xFFFF0000u), __uint_as_float(r_.y << 16), __uint_as_float(r_.y & 0xFFFF0000u)}; acc[i] += x * coef; }
        }
#pragma unroll
        for (int i = 0; i < 8; ++i) { const int e = (tid & 127) * 4 + 512 * i, dv = e >> 6, dk = e & 63;
            typedef unsigned u32x2_t __attribute__((ext_vector_type(2))); *(LAS u32x2_t*)(lds + L_ST + hd * 9216 + dv * 144 + dk * 2) = (u32x2_t){pkbf(acc[i][0], acc[i][1]), pkbf(acc[i][2], acc[i][3])}; }
    }
    __syncthreads();
    const int hh = wid >> 2, head = 2 * hp + hh, qb = wid & 3, qi = 32 * qb + r;
    const int qrow = row0 + qi;
    const float lgf = log2_sigmoid(p.in[14][layer * 4 + head]), lgb = log2_sigmoid(p.in[15][layer * 4 + head]);
    bf16x8_t qf[4];
    { const bf16_t* qp = POST + (size_t)qrow * POST_LD + PC_RQ + head * 64 + 8 * h2;
#pragma unroll
      for (int s = 0; s < 4; ++s) qf[s] = *(const bf16x8_t*)(qp + 16 * s); }
    f32x16_t O0, O1;
#pragma unroll
    for (int i = 0; i < 16; ++i) { O0[i] = 0.f; O1[i] = 0.f; }
    LAS const unsigned char* kt = lds + L_K + hh * 18432; LAS const unsigned char* vt = lds + L_V + hh * 24576;
    const int voff = (4 * h2 + ((lane & 15) >> 2)) * 192 + (16 * ((lane >> 4) & 1) + 4 * (lane & 3)) * 2;
#pragma unroll
    for (int blk = 0; blk < 4; ++blk) {
        f32x16_t S;
#pragma unroll
        for (int i = 0; i < 16; ++i) S[i] = 0.f;
#pragma unroll
        for (int s = 0; s < 4; ++s) { const bf16x8_t a = *(LAS const bf16x8_t*)(kt + (32 * blk + r) * 144 + 32 * s + 16 * h2); S = __builtin_amdgcn_mfma_f32_32x32x16_bf16(a, qf[s], S, 0, 0, 0); }
#pragma unroll
        for (int i = 0; i < 16; ++i) { const int d = qi - (32 * blk + (i & 3) + 8 * (i >> 2) + 4 * h2);
            const float w = d > 0 ? __builtin_amdgcn_exp2f(lgf * (float)d) : (d == 0 ? 2.f : __builtin_amdgcn_exp2f(lgb * (float)(-d)));
            S[i] *= w; }
#pragma unroll
        for (int s2 = 0; s2 < 2; ++s2) {
            const bf16x8_t pf = __builtin_bit_cast(bf16x8_t, make_uint4(pkbf(S[8 * s2 + 0], S[8 * s2 + 1]), pkbf(S[8 * s2 + 2], S[8 * s2 + 3]), pkbf(S[8 * s2 + 4], S[8 * s2 + 5]), pkbf(S[8 * s2 + 6], S[8 * s2 + 7])));
            LAS const unsigned char* vp = vt + (32 * blk + 16 * s2) * 192 + voff;
            const s16x4_t lo0 = lds_tr16(vp), hi0 = lds_tr16(vp + 8 * 192), lo1 = lds_tr16(vp + 64), hi1 = lds_tr16(vp + 8 * 192 + 64);
            const bf16x8_t a0 = {lo0[0], lo0[1], lo0[2], lo0[3], hi0[0], hi0[1], hi0[2], hi0[3]};
            const bf16x8_t a1 = {lo1[0], lo1[1], lo1[2], lo1[3], hi1[0], hi1[1], hi1[2], hi1[3]};
            O0 = __builtin_amdgcn_mfma_f32_32x32x16_bf16(a0, pf, O0, 0, 0, 0);
            O1 = __builtin_amdgcn_mfma_f32_32x32x16_bf16(a1, pf, O1, 0, 0, 0);
        }
    }
#pragma unroll
    for (int dir = 0; dir < 2; ++dir) {
        f32x16_t T0, T1;
#pragma unroll
        for (int i = 0; i < 16; ++i) { T0[i] = 0.f; T1[i] = 0.f; }
        LAS const unsigned char* st = lds + L_ST + (hh * 2 + dir) * 9216;
#pragma unroll
        for (int s = 0; s < 4; ++s) {
            const bf16x8_t a0 = *(LAS const bf16x8_t*)(st + r * 144 + 32 * s + 16 * h2), a1 = *(LAS const bf16x8_t*)(st + (32 + r) * 144 + 32 * s + 16 * h2);
            T0 = __builtin_amdgcn_mfma_f32_32x32x16_bf16(a0, qf[s], T0, 0, 0, 0);
            T1 = __builtin_amdgcn_mfma_f32_32x32x16_bf16(a1, qf[s], T1, 0, 0, 0);
        }
        const float coef = dir == 0 ? __builtin_amdgcn_exp2f(lgf * (float)(qi + 1)) : __builtin_amdgcn_exp2f(lgb * (float)(128 - qi));
#pragma unroll
        for (int i = 0; i < 16; ++i) { O0[i] += coef * T0[i]; O1[i] += coef * T1[i]; }
    }
    float ss = 0.f;
#pragma unroll
    for (int i = 0; i < 16; ++i) ss += O0[i] * O0[i] + O1[i] * O1[i];
    ss += __shfl_xor(ss, 32);
    const float rs = rsqrtf(ss * (1.f / 64.f) + NORM_EPS);
    const bf16_t* gp = PROJB + (size_t)qrow * PROJ_LD + PJ_RG + head * 64 + 4 * h2;
    bf16_t* op = MIX + (size_t)qrow * 1024 + 768 + head * 64 + 4 * h2;
#pragma unroll
    for (int g = 0; g < 4; ++g) {
        const uint2 g0 = *(const uint2*)(gp + 8 * g), g1 = *(const uint2*)(gp + 32 + 8 * g);
        float gv[8] = {__uint_as_float(g0.x << 16), __uint_as_float(g0.x & 0xFFFF0000u), __uint_as_float(g0.y << 16), __uint_as_float(g0.y & 0xFFFF0000u),
                       __uint_as_float(g1.x << 16), __uint_as_float(g1.x & 0xFFFF0000u), __uint_as_float(g1.y << 16), __uint_as_float(g1.y & 0xFFFF0000u)};
        float o[8];
#pragma unroll
        for (int j = 0; j < 4; ++j) { o[j] = O0[4 * g + j] * rs * silu_f(gv[j]); o[4 + j] = O1[4 * g + j] * rs * silu_f(gv[4 + j]); }
        *(uint2*)(op + 8 * g) = make_uint2(pkbf(o[0], o[1]), pkbf(o[2], o[3]));
        *(uint2*)(op + 32 + 8 * g) = make_uint2(pkbf(o[4], o[5]), pkbf(o[6], o[7]));
    }
}

__device__ __forceinline__ void ph_mixer_mfma(const P& p, int layer, bool ctxq, LAS unsigned char* lds) {
    const bf16_t* POST = (const bf16_t*)(p.ws + OFF_POST); const bf16_t* PROJB = (const bf16_t*)(p.ws + OFF_PROJ);
    bf16_t* MIX = (bf16_t*)(p.ws + OFF_H);
    const int G = gridDim.x, bid = blockIdx.x;
    const float L2E = 1.4426950408889634f;
    const int n_mla = BATCH * 4 * 16, n_swa = BATCH * 8 * 16, n_mlac = ctxq ? BATCH * 4 : 0, n_swac = ctxq ? BATCH * 8 : 0;
    const int n_ret = BATCH * 32 * 2, n_retc = ctxq ? BATCH * 2 * 2 : 0;
    const int total = n_mla + n_swa + n_mlac + n_swac + n_ret + n_retc;
    const int nmine = (total - bid + G - 1) / G;
    for (int k = 0; k < nmine; ++k) { const int u = bid + ((bid & 1) ? (nmine - 1 - k) : k) * G;
        if (u < n_mla) {
            const int qb = u & 15, h = (u >> 4) & 3, b = u >> 6;
            attn_unit_f8(lds, p.ws + OFF_QK8, p.ws + OFF_V8T, MIX, b, qb * 256, h, 0, SEQ, 0.10206207261596575f * L2E);
        } else if (u < n_mla + n_swa) {
            const int v = u - n_mla, qb = v & 63, kvh = (v >> 6) & 1, b = v >> 7;
            const int q0 = qb * 64; int lo = (q0 - 128) & ~127; lo = lo < 0 ? 0 : lo; int hi = (q0 + 192 + 127) & ~127; hi = hi > SEQ ? SEQ : hi;
            attn_unit<64, true, true>(lds, POST, PROJB, PROJ_LD, MIX, b, q0, PC_QB + kvh * 256, PC_KB + kvh * 64, 992 + kvh * 64, 256 + kvh * 256, lo, hi, 0.f, 0.125f * L2E, p.in[13] + layer * 8 + kvh * 4, L2E);
        } else if (u < n_mla + n_swa + n_mlac) {
            const int v = u - n_mla - n_swa, h = v & 3, b = v >> 2;
            attn_unit_f8(lds, p.ws + OFF_QK8, p.ws + OFF_V8T, MIX, b, SEQ, h, 0, 0, 0.10206207261596575f * L2E);
        } else if (u < n_mla + n_swa + n_mlac + n_swac) {
            const int v = u - n_mla - n_swa - n_mlac, qb = v & 3, kvh = (v >> 2) & 1, b = v >> 3;
            attn_unit<64, true, true>(lds, POST, PROJB, PROJ_LD, MIX, b, SEQ + qb * 64, PC_QB + kvh * 256, PC_KB + kvh * 64, 992 + kvh * 64, 256 + kvh * 256, 0, 0, 0.f, 0.125f * L2E, p.in[13] + layer * 8 + kvh * 4, L2E);
        } else if (u < n_mla + n_swa + n_mlac + n_swac + n_ret) {
            const int v = u - n_mla - n_swa - n_mlac - n_swac;
            ret_unit(lds, p, layer, v >> 6, (v >> 1) & 31, v & 1);
        } else {
            const int v = u - n_mla - n_swa - n_mlac - n_swac - n_ret;
            ret_unit(lds, p, layer, v >> 2, 32 + ((v >> 1) & 1), v & 1);
        }
    }
}

__device__ __forceinline__ void ph_tables(const P& p) {
    float2* tr = (float2*)(p.ws + OFF_TAB); float2* t32 = tr + 4096 * 32; float2* t16 = t32 + 64 * 16;
    const int n = 4096 * 32 + 64 * 16 + 64 * 8;
    for (int i = blockIdx.x * NT + threadIdx.x; i < n; i += gridDim.x * NT) {
        float ang;
        if (i < 4096 * 32) ang = (float)(i >> 5) * rope_inv(2 * (i & 31), 64);
        else if (i < 4096 * 32 + 64 * 16) { const int j = i - 4096 * 32; ang = (float)(j >> 4) * rope_inv(2 * (j & 15), 32); }
        else { const int j = i - 4096 * 32 - 64 * 16; ang = (float)(j >> 3) * rope_inv(2 * (j & 7), 16); }
        tr[i] = make_float2(cosf(ang), sinf(ang));
    }
}

__device__ __forceinline__ void ph_prep2(const P& p, int layer, LAS unsigned char* lds) {
    const bf16_t* PROJ = (const bf16_t*)(p.ws + OFF_PROJ);
    bf16_t* POST = (bf16_t*)(p.ws + OFF_POST);
    unsigned char* QK8 = p.ws + OFF_QK8; unsigned char* V8T = p.ws + OFF_V8T;
#define CVT4_F8(a_, b_, c_, d_) __builtin_amdgcn_cvt_pk_fp8_f32(f8clamp(c_), f8clamp(d_), __builtin_amdgcn_cvt_pk_fp8_f32(f8clamp(a_), f8clamp(b_), 0, false), true)
    const bf16_t* WUQ = (const bf16_t*)(p.ws + OFF_WUQ) + (size_t)layer * 384 * 192;
    const bf16_t* WUKV = (const bf16_t*)(p.ws + OFF_WUKV) + (size_t)layer * 512 * 128;
    const float* qn = p.in[9] + layer * 192; const float* kvn = p.in[11] + layer * 128;
    const float2* tab_ret = (const float2*)(p.ws + OFF_TAB); const float2* tab32 = tab_ret + 4096 * 32; const float2* tab16 = tab32 + 64 * 16;
    int tid_ = threadIdx.x; asm volatile("" : "+v"(tid_));
    const int tid = tid_, wid = __builtin_amdgcn_readfirstlane(tid >> 6), lane = tid & 63, fr = lane & 15, fq = lane >> 4;
    constexpr int QP = 400, KVP = 272, L_CQ = 0, L_CKV = 32 * QP;
    constexpr int SQP = 1040, L_SQ = L_CKV + 32 * KVP, L_SV = L_SQ + 32 * SQP;
#define PREP_LOADS(RA, RB, RC, RK, P1, P2, UNIT) do { const int R0_ = (UNIT) * 32; int tidA = tid; asm volatile("" : "+v"(tidA)); const int tk_ = tidA >> 4, sub_ = tidA & 15; \
        { const bf16_t* pr_ = PROJ + (size_t)(R0_ + tk_) * PROJ_LD; RA = *(const uint2*)(pr_ + sub_ * 12); RB = *(const uint2*)(pr_ + sub_ * 12 + 4); RC = *(const uint2*)(pr_ + sub_ * 12 + 8); RK = *(const u32x4_t*)(pr_ + 192 + sub_ * 8); } \
        _Pragma("unroll") for (int it_ = 0; it_ < 5; ++it_) { const int w_ = it_ * NT + tidA; \
            if (w_ < 32 * 74) { const int tok_ = w_ / 74, task_ = w_ % 74; int src_, dist_; \
                if (task_ < 40) { const int hd_ = task_ >> 2, half_ = (task_ >> 1) & 1, cp_ = task_ & 1; src_ = (task_ < 32 ? 352 : 864 - 8 * 64) + hd_ * 64 + half_ * 32 + cp_ * 8; dist_ = 16; } \
                else if (task_ < 72) { const int q_ = task_ - 40, hd_ = q_ >> 2, cp_ = q_ & 3; src_ = (hd_ < 4 ? PJ_RQ + hd_ * 64 : PJ_RK + (hd_ - 4) * 64) + cp_ * 8; dist_ = 32; } \
                else { src_ = 320 + (task_ - 72) * 16; dist_ = 8; } \
                const bf16_t* pr_ = PROJ + (size_t)(R0_ + tok_) * PROJ_LD + src_; P1[it_] = *(const u32x4_t*)pr_; P2[it_] = *(const u32x4_t*)(pr_ + dist_); } \
            else { P1[it_] = (u32x4_t){0u, 0u, 0u, 0u}; P2[it_] = P1[it_]; } } } while (0)
    uint2 ra, rb, rc, na_, nb_, nc_; u32x4_t rk, nk_; u32x4_t p1[5], p2[5], n1[5], n2[5];
    if ((int)blockIdx.x < T_ALL / 32) PREP_LOADS(ra, rb, rc, rk, p1, p2, (int)blockIdx.x);
    for (int u = blockIdx.x; u < T_ALL / 32; u += gridDim.x) {
        const int R0 = u * 32; const bool isctx = R0 >= T_LAT;
        const int t0 = isctx ? (R0 - T_LAT) % CTXL : R0 % SEQ;
        const int tk = tid >> 4, sub = tid & 15;
        const bool has_next = u + (int)gridDim.x < T_ALL / 32;
        if (has_next) PREP_LOADS(na_, nb_, nc_, nk_, n1, n2, u + (int)gridDim.x);
        __syncthreads();
        *(LAS u32x4_t*)(lds + L_SQ + tk * SQP + (sub >> 3) * 512 + ((sub >> 1) & 3) * 128 + 96 + (sub & 1) * 16) = (u32x4_t){0u, 0u, 0u, 0u};
        {
            float c[12], k[8];
            c[0] = __uint_as_float(ra.x << 16); c[1] = __uint_as_float(ra.x & 0xFFFF0000u); c[2] = __uint_as_float(ra.y << 16); c[3] = __uint_as_float(ra.y & 0xFFFF0000u);
            c[4] = __uint_as_float(rb.x << 16); c[5] = __uint_as_float(rb.x & 0xFFFF0000u); c[6] = __uint_as_float(rb.y << 16); c[7] = __uint_as_float(rb.y & 0xFFFF0000u);
            c[8] = __uint_as_float(rc.x << 16); c[9] = __uint_as_float(rc.x & 0xFFFF0000u); c[10] = __uint_as_float(rc.y << 16); c[11] = __uint_as_float(rc.y & 0xFFFF0000u);
            unpack8(make_uint4(rk[0], rk[1], rk[2], rk[3]), k);
            float s1 = 0.f, s2 = 0.f;
#pragma unroll
            for (int i = 0; i < 12; ++i) s1 += c[i] * c[i];
#pragma unroll
            for (int i = 0; i < 8; ++i) s2 += k[i] * k[i];
#pragma unroll
            for (int o = 1; o < 16; o <<= 1) { s1 += __shfl_xor(s1, o); s2 += __shfl_xor(s2, o); }
            const float r1 = rsqrtf(s1 * (1.f / 192.f) + NORM_EPS), r2 = rsqrtf(s2 * (1.f / 128.f) + NORM_EPS);
            typedef unsigned u32x2_t __attribute__((ext_vector_type(2)));
#pragma unroll
            for (int i = 0; i < 3; ++i) { const int e = sub * 12 + 4 * i;
                *(LAS u32x2_t*)(lds + L_CQ + tk * QP + e * 2) = (u32x2_t){pkbf(c[4 * i] * r1 * qn[e], c[4 * i + 1] * r1 * qn[e + 1]), pkbf(c[4 * i + 2] * r1 * qn[e + 2], c[4 * i + 3] * r1 * qn[e + 3])}; }
            { const int e = sub * 8;
              *(LAS u32x4_t*)(lds + L_CKV + tk * KVP + e * 2) = (u32x4_t){pkbf(k[0] * r2 * kvn[e], k[1] * r2 * kvn[e + 1]), pkbf(k[2] * r2 * kvn[e + 2], k[3] * r2 * kvn[e + 3]),
                                                                        pkbf(k[4] * r2 * kvn[e + 4], k[5] * r2 * kvn[e + 5]), pkbf(k[6] * r2 * kvn[e + 6], k[7] * r2 * kvn[e + 7])}; }
        }
        __syncthreads();
        {
            pg8::f32x4 acc[3][2];
#pragma unroll
            for (int a = 0; a < 3; ++a)
#pragma unroll
                for (int m = 0; m < 2; ++m) acc[a][m] = (pg8::f32x4){0.f, 0.f, 0.f, 0.f};
#pragma unroll
            for (int ks = 0; ks < 6; ++ks) {
                bf16x8_t af[2];
#pragma unroll
                for (int m = 0; m < 2; ++m) af[m] = *(LAS const bf16x8_t*)(lds + L_CQ + (m * 16 + fr) * QP + (32 * ks + 8 * fq) * 2);
#pragma unroll
                for (int a = 0; a < 3; ++a) {
                    const bf16x8_t bfrag = *(const bf16x8_t*)(WUQ + (size_t)((3 * wid + a) * 16 + fr) * 192 + 32 * ks + 8 * fq);
#pragma unroll
                    for (int m = 0; m < 2; ++m) acc[a][m] = __builtin_amdgcn_mfma_f32_16x16x32_bf16(bfrag, af[m], acc[a][m], 0, 0, 0);
                }
            }
#pragma unroll
            for (int a = 0; a < 3; ++a) {
                const int nt = 3 * wid + a, t6 = nt % 6, col = nt * 16 + 4 * fq;
#pragma unroll
                for (int m = 0; m < 2; ++m) {
                    const int tok = m * 16 + fr, t = t0 + tok;
                    pg8::f32x4 v = acc[a][m];
                    if (t6 >= 4) {
                        pg8::f32x4 pv; pv[0] = __shfl_xor(v[0], 32); pv[1] = __shfl_xor(v[1], 32); pv[2] = __shfl_xor(v[2], 32); pv[3] = __shfl_xor(v[3], 32);
                        if (!isctx) { const int pos = t6 == 4 ? (t >> 6) : (t & 63);
#pragma unroll
                            for (int j = 0; j < 4; ++j) { const float2 cs = tab16[pos * 8 + 4 * (fq & 1) + j]; v[j] = v[j] * cs.x + (fq < 2 ? -pv[j] : pv[j]) * cs.y; } }
                    }
                    *(LAS int*)(lds + L_SQ + tok * SQP + (nt / 6) * 128 + t6 * 16 + 4 * fq) = CVT4_F8(v[0], v[1], v[2], v[3]);
                }
            }
        }
        {
            pg8::f32x4 acc[4][2];
#pragma unroll
            for (int a = 0; a < 4; ++a)
#pragma unroll
                for (int m = 0; m < 2; ++m) acc[a][m] = (pg8::f32x4){0.f, 0.f, 0.f, 0.f};
#pragma unroll
            for (int ks = 0; ks < 4; ++ks) {
                bf16x8_t af[2];
#pragma unroll
                for (int m = 0; m < 2; ++m) af[m] = *(LAS const bf16x8_t*)(lds + L_CKV + (m * 16 + fr) * KVP + (32 * ks + 8 * fq) * 2);
#pragma unroll
                for (int a = 0; a < 4; ++a) {
                    const bf16x8_t bfrag = *(const bf16x8_t*)(WUKV + (size_t)((4 * wid + a) * 16 + fr) * 128 + 32 * ks + 8 * fq);
#pragma unroll
                    for (int m = 0; m < 2; ++m) acc[a][m] = __builtin_amdgcn_mfma_f32_16x16x32_bf16(bfrag, af[m], acc[a][m], 0, 0, 0);
                }
            }
#pragma unroll
            for (int a = 0; a < 4; ++a) {
                const int n = (4 * wid + a) * 16 + 4 * fq, hh = n >> 7, d = n & 127;
                const int dst = d < 64 ? PC_KA + hh * 96 + d : PC_VA + hh * 64 + (d - 64);
#pragma unroll
                for (int m = 0; m < 2; ++m) { const pg8::f32x4 v = acc[a][m]; const int row = R0 + m * 16 + fr;
                    const int w8 = CVT4_F8(v[0], v[1], v[2], v[3]);
                    const int tl = m * 16 + fr; (void)row;
                    if (d < 64) *(LAS int*)(lds + L_SQ + tl * SQP + 512 + hh * 128 + d) = w8;
                    else { LAS unsigned char* vp = lds + L_SV + (hh * 64 + (d - 64)) * 32 + 16 * ((tl >> 2) & 1) + 4 * (tl >> 3) + (tl & 3);
                        vp[0] = (unsigned char)w8; vp[32] = (unsigned char)(w8 >> 8); vp[64] = (unsigned char)(w8 >> 16); vp[96] = (unsigned char)((unsigned)w8 >> 24); } }
                (void)dst;
            }
        }
        int tidB = tid; asm volatile("" : "+v"(tidB));
#pragma unroll
        for (int it = 0; it < 5; ++it) {
            const int w = it * NT + tidB;
            if (w < 32 * 74) {
                const int tok = w / 74, task = w % 74, t = t0 + tok;
                bf16_t* po = POST + (size_t)(R0 + tok) * POST_LD;
                int dst, dist; const float2* tb; float scl = 1.f; bool bc = false;
                if (task < 40) { const int hd = task >> 2, half = (task >> 1) & 1, cp = task & 1;
                    dst = (task < 32 ? PC_QB : PC_KB - 8 * 64) + hd * 64 + half * 32 + cp * 8; dist = 16; tb = tab32 + (half ? (t & 63) : (t >> 6)) * 16 + cp * 8; }
                else if (task < 72) { const int q = task - 40, hd = q >> 2, cp = q & 3;
                    dst = PC_RQ + hd * 64 + cp * 8; dist = 32; tb = tab_ret + t * 32 + cp * 8; if (hd >= 4) scl = 0.125f; }
                else { const int half = task - 72; dst = PC_KA + 64 + half * 16; dist = 8; bc = true; tb = tab16 + (half ? (t & 63) : (t >> 6)) * 8; }
                float x1[8], x2[8]; unpack8(make_uint4(p1[it][0], p1[it][1], p1[it][2], p1[it][3]), x1); unpack8(make_uint4(p2[it][0], p2[it][1], p2[it][2], p2[it][3]), x2);
                if (!isctx) {
                    const float4 c0 = *(const float4*)(tb), c1 = *(const float4*)(tb + 2), c2 = *(const float4*)(tb + 4), c3 = *(const float4*)(tb + 6);
                    const float cs[8] = {c0.x, c0.z, c1.x, c1.z, c2.x, c2.z, c3.x, c3.z}, sn[8] = {c0.y, c0.w, c1.y, c1.w, c2.y, c2.w, c3.y, c3.w};
#pragma unroll
                    for (int j = 0; j < 8; ++j) { const float a = x1[j], b2 = x2[j]; x1[j] = a * cs[j] - b2 * sn[j]; x2[j] = b2 * cs[j] + a * sn[j]; }
                }
#pragma unroll
                for (int j = 0; j < 8; ++j) { x1[j] *= scl; x2[j] *= scl; }
                const uint4 o1 = make_uint4(pkbf(x1[0], x1[1]), pkbf(x1[2], x1[3]), pkbf(x1[4], x1[5]), pkbf(x1[6], x1[7]));
                const uint4 o2 = make_uint4(pkbf(x2[0], x2[1]), pkbf(x2[2], x2[3]), pkbf(x2[4], x2[5]), pkbf(x2[6], x2[7]));
                if (bc) {
                    LAS unsigned char* k8 = lds + L_SQ + tok * SQP + 512 + 64 + (task - 72) * 16;
                    typedef unsigned u32x2_t __attribute__((ext_vector_type(2)));
                    const uint2 f1 = make_uint2((unsigned)CVT4_F8(x1[0], x1[1], x1[2], x1[3]), (unsigned)CVT4_F8(x1[4], x1[5], x1[6], x1[7]));
                    const uint2 f2 = make_uint2((unsigned)CVT4_F8(x2[0], x2[1], x2[2], x2[3]), (unsigned)CVT4_F8(x2[4], x2[5], x2[6], x2[7]));
#pragma unroll
                    for (int hh = 0; hh < 4; ++hh) { *(LAS u32x2_t*)(k8 + hh * 128) = (u32x2_t){f1.x, f1.y}; *(LAS u32x2_t*)(k8 + hh * 128 + 8) = (u32x2_t){f2.x, f2.y}; }
                } else { *(uint4*)(po + dst) = o1; *(uint4*)(po + dst + dist) = o2; }
            }
        }
        __syncthreads();
        {
            const int rr = tid >> 4, pc = tid & 15;
            uint4* qd = (uint4*)(QK8 + (size_t)(R0 + rr) * 1024 + pc * 64);
#pragma unroll
            for (int j = 0; j < 4; ++j) { const u32x4_t t4 = *(LAS const u32x4_t*)(lds + L_SQ + rr * SQP + pc * 64 + j * 16); qd[j] = make_uint4(t4[0], t4[1], t4[2], t4[3]); }
            int bb, key0; if (R0 < T_LAT) { bb = R0 >> 12; key0 = R0 & (SEQ - 1); } else { bb = (R0 - T_LAT) >> 8; key0 = SEQ + ((R0 - T_LAT) & (CTXL - 1)); }
            const int vr = tid >> 1, hf = tid & 1;
            const u32x4_t t4 = *(LAS const u32x4_t*)(lds + L_SV + vr * 32 + hf * 16);
            *(uint4*)(V8T + (size_t)((bb * 4 + (vr >> 6)) * 64 + (vr & 63)) * 4352 + (key0 & ~63) + 32 * hf + 16 * ((key0 >> 5) & 1)) = make_uint4(t4[0], t4[1], t4[2], t4[3]);
        }
        if (has_next) { ra = na_; rb = nb_; rc = nc_; rk = nk_;
#pragma unroll
            for (int it = 0; it < 5; ++it) { p1[it] = n1[it]; p2[it] = n2[it]; } }
    }
#undef PREP_LOADS
#undef CVT4_F8
}
#define N_PHASES 23
#define LDS_BYTES 147456
#define LDS_MISC 131072
__device__ __forceinline__ P load_p() {
#if defined(__HIP_DEVICE_COMPILE__)
    const __attribute__((address_space(4))) P* kq = (const __attribute__((address_space(4))) P*)__builtin_amdgcn_kernarg_segment_ptr();
    asm volatile("" : "+s"(kq));
    return *kq;
#else
    return P{};
#endif
}
__global__ void __launch_bounds__(NT, 2) fwd_kernel(P p0, int lo, int hi) {
    extern __shared__ __attribute__((aligned(16))) unsigned char lds_raw[];
    float* lds = (float*)lds_raw;
    LAS unsigned char* ldsl = (LAS unsigned char*)lds_raw;
    volatile LAS unsigned* st = (volatile LAS unsigned*)(ldsl + LDS_MISC);
    if (threadIdx.x < 4) st[threadIdx.x] = 0u;
    __syncthreads();
    XcdBarrier bar; bar.bar = (unsigned*)(p0.ws + OFF_CTL); bar.x = 0; bar.st = st;
    if (hi - lo > 1) bar = xcd_barrier_post((unsigned*)(p0.ws + OFF_CTL), st);
#define IN(k) (lo <= (k) && (k) < hi)
#define PH(k) if (IN(k)) if (const P p = load_p(); true)
#define SEAM(k) do { if (IN(k) && IN((k) + 1)) xcd_barrier(bar); } while (0)
#define MOD ((const float*)(p.ws + OFF_MOD))
#define H ((bf16_t*)(p.ws + OFF_H))
#define XC ((float*)(p.ws + OFF_XC))
#define PROJ ((bf16_t*)(p.ws + OFF_PROJ))
#define ACT ((bf16_t*)(p.ws + OFF_ACT))
#define CNT ((int*)(p.ws + OFF_CNT))
#define LIST ((const int*)(p.ws + OFF_LIST))
#define WL ((const float*)(p.ws + OFF_WL))
#define WIN ((const bf16_t*)(p.ws + OFF_WIN))
#define WOUT ((const bf16_t*)(p.ws + OFF_WOUT))
#define FGU ((const bf16_t*)(p.ws + OFF_FGU))
#define FD ((const bf16_t*)(p.ws + OFF_FD))
#define MGU ((const bf16_t*)(p.ws + OFF_MGU))
#define MDW ((const bf16_t*)(p.ws + OFF_MD))
#define YB ((bf16_t*)(p.ws + OFF_Y))
#define YB2 ((bf16_t*)(p.ws + OFF_Y2))
#define PARTB ((float*)(p.ws + OFF_PART))
    const int G = gridDim.x, bid = blockIdx.x;

    PH(0) { ph_mod(p, lds); ph_tables(p); ph_conv_early(p, lds); ph_fgu_colmax(p); ph_win_colmax(p); }
    SEAM(0);
    PH(1) { ph_norm(p, 0, 1, T_ALL, false, true, nullptr, 0, 0, 0, p.ws + OFF_QK8, false, (float*)(p.ws + OFF_RSW)); __syncthreads(); ph_conv_fgu_i8(p, lds); }
    SEAM(1);
    PH(2) { pg8::DenseSchedT<false, true> S{(const bf16_t*)(p.ws + OFF_QK8), WIN, 512, 512, T_ALL / 256, PROJ_LD / 256, G, bid};
            pg8::EpiBf16I8 E{PROJ, PROJ_LD, (const float*)(p.ws + OFF_RSW), (const float*)(p.ws + OFF_CSW) + 0 * PROJ_LD}; pg8::gemm_phase(ldsl, S, E); }
    SEAM(2);
    PH(3) ph_prep2(p, 0, ldsl);
    SEAM(3);
    PH(4) ph_ret_T(p, 0, ldsl);
    SEAM(4);
    PH(5) ph_mixer_mfma(p, 0, true, ldsl);
    SEAM(5);
    PH(6) {
        { pg8::DenseSched S{H, WOUT, 1024, 1024, T_ALL / 256, 4, G, bid};
          pg8::EpiBf16Norm E{YB, 1024, (unsigned)((size_t)T_ALL * 1024 * 2), (unsigned*)(p.ws + OFF_PCNT), 1.f};
          pg8::gemm_phase(ldsl, S, E); }
        norm_help(p, NormArgs{0, 2, false, true, YB, 0, 2048, 0, p.ws + OFF_H8D, false, (float*)(p.ws + OFF_RS8)}, (unsigned*)(p.ws + OFF_PCNT), 32u, (unsigned*)(p.ws + OFF_CLAIM), T_ALL / 256, (LAS unsigned*)(ldsl + LDS_MISC + 32));
    }
    SEAM(6);
    PH(8) { pg8::DenseSchedT<false, true> S{(const bf16_t*)(p.ws + OFF_H8D), FGU, 512, 512, T_ALL / 256, 2 * D_FF / 256, G, bid};
            pg8::EpiSwigluI8 E{ACT, D_FF, (const float*)(p.ws + OFF_RS8), (const float*)(p.ws + OFF_CS8)}; pg8::gemm_phase(ldsl, S, E); }
    SEAM(8);
    PH(9) {
        { pg8::DenseSchedT<true> S{ACT, FD, D_FF / 2, D_FF / 2, T_ALL / 256, 4, G, bid};
          pg8::EpiBf16Norm E{YB2, 1024, (unsigned)((size_t)T_ALL * 1024 * 2), (unsigned*)(p.ws + OFF_PCNT) + 136 * 64, 1.f / (F8_SA * F8_SW)};
          pg8::gemm_phase(ldsl, S, E); }
        norm_help(p, NormArgs{1, 1, false, false, YB2, 0, 5120, 0, p.ws + OFF_QK8, false, (float*)(p.ws + OFF_RSW)}, (unsigned*)(p.ws + OFF_PCNT) + 136 * 64, 32u, (unsigned*)(p.ws + OFF_CLAIM) + 64, T_ALL / 256, (LAS unsigned*)(ldsl + LDS_MISC + 32));
    }
    SEAM(9);
    PH(11) { pg8::DenseSchedT<false, true> S{(const bf16_t*)(p.ws + OFF_QK8), (WIN + (size_t)PROJ_LD * 1024), 512, 512, T_ALL / 256, PROJ_LD / 256, G, bid};
            pg8::EpiBf16I8 E{PROJ, PROJ_LD, (const float*)(p.ws + OFF_RSW), (const float*)(p.ws + OFF_CSW) + 1 * PROJ_LD}; pg8::gemm_phase(ldsl, S, E); }
    SEAM(11);
    PH(12) ph_prep2(p, 1, ldsl);
    SEAM(12);
    PH(13) ph_ret_T(p, 1, ldsl);
    SEAM(13);
    PH(14) ph_mixer_mfma(p, 1, false, ldsl);
    SEAM(14);
    PH(15) { pg8::DenseSched S{H, WOUT + (size_t)1024 * 1024, 1024, 1024, T_LAT / 256, 4, G, bid}; pg8::EpiBf16 E{YB, 1024}; pg8::gemm_phase(ldsl, S, E); }
    SEAM(15);
    PH(16) { ph_norm(p, 1, 2, T_LAT, true, false, YB, 1, 2048, 0, p.ws + OFF_H, false); ph_conv_late(p, lds); }
    SEAM(16);
#pragma unroll
    for (int s = 0; s < 2; ++s) {
        if (IN(17 + 2 * s) || IN(18 + 2 * s)) {
            LAS int* tab = (LAS int*)(ldsl + LDS_MISC + 64 + 128 * s);
            { const P p = load_p();
            __syncthreads();
            if (threadIdx.x == 0) { int tbv = 0; tab[8] = 0;
                for (int e = 0; e < 8; ++e) { const int ce = __hip_atomic_load(CNT + s * 8 + e, __ATOMIC_RELAXED, __HIP_MEMORY_SCOPE_AGENT); tab[e] = ce; tbv += (ce + 255) >> 8; tab[9 + e] = tbv; } }
            __syncthreads(); }
            const int nTm = tab[16];
            PH(17 + 2 * s) {
                if (s == 1) pg8::moe_combine((bf16_t*)(p.ws + OFF_YM), PARTB, (const LAS int*)(ldsl + LDS_MISC + 64), 4, 1.f / (F8_SA * F8_SW));
                pg8::MoeSched<true, true> S{H, MGU, 512, 512, 2 * D_FFE / 256, G, bid, (size_t)D_FFE * 1024, LIST + (size_t)s * 8 * 32768, tab, 0, nTm * (2 * D_FFE / 256), 1, 512 / 64};
                pg8::EpiSwigluT<true, true> E{ACT, D_FFE}; pg8::gemm_phase(ldsl, S, E);
            }
            SEAM(17 + 2 * s);
            PH(18 + 2 * s) {
                const int U = nTm * 4, rem = U % G, split = (rem > 0 && rem * MOE_WAYS <= G) ? 1 : 0, umain = split ? U - rem : U;
                { pg8::MoeSched<false, true> S{ACT, MDW, D_FFE / 2, D_FFE / 2, 4, G, bid, (size_t)512 * D_FFE, nullptr, tab, 0, umain, 1, D_FFE / 128};
                  pg8::EpiBf16S E{(bf16_t*)(p.ws + OFF_YM) + (size_t)s * ACT_ROWS * 1024, 1024, 1.f / (F8_SA * F8_SW)};
                  pg8::gemm_phase(ldsl, S, E); }
                if (split) { pg8::MoeSched<false, true> S{ACT, MDW, D_FFE / 2, D_FFE / 2, 4, G, bid, (size_t)512 * D_FFE, nullptr, tab, umain, U, MOE_WAYS, D_FFE / 128 / MOE_WAYS};
                  pg8::EpiPart E{PARTB}; pg8::gemm_phase(ldsl, S, E); }
            }
        }
        SEAM(18 + 2 * s);
    }
    PH(21) { const LAS int* tab1 = (const LAS int*)(ldsl + LDS_MISC + 64 + 128);
        pg8::moe_combine((bf16_t*)(p.ws + OFF_YM) + (size_t)ACT_ROWS * 1024, PARTB, tab1, 4, 1.f / (F8_SA * F8_SW)); }
    SEAM(21);
    PH(22) ph_final_moe(p, (const LAS int*)(ldsl + LDS_MISC + 64), (const LAS int*)(ldsl + LDS_MISC + 64 + 128));
}

extern "C" void kernel_launch(void* const* d_in, const int* in_sizes, int n_in, void* d_out, int out_size, void* d_ws, size_t ws_size, hipStream_t stream) {
    static int grid = 0;
    if (!grid) {
        if (n_in != 25 || out_size != T_LAT * 1024 || ws_size < WS_END) { fprintf(stderr, "kernel_launch: unexpected shapes (n_in %d out %d ws %zu need %zu)\n", n_in, out_size, ws_size, (size_t)WS_END); grid = -1; return; }
        int dev = 0, cus = 0, per_cu = 0;
        (void)hipGetDevice(&dev); (void)hipDeviceGetAttribute(&cus, hipDeviceAttributeMultiprocessorCount, dev);
        (void)hipFuncSetAttribute((const void*)fwd_kernel, hipFuncAttributeMaxDynamicSharedMemorySize, LDS_BYTES);
        (void)hipOccupancyMaxActiveBlocksPerMultiprocessor(&per_cu, (const void*)fwd_kernel, NT, LDS_BYTES);
        if (per_cu < 1) { fprintf(stderr, "kernel_launch: occupancy query says %d\n", per_cu); }
        grid = cus > 0 ? cus : 256;
    }
    if (grid < 0) return;
    (void)hipMemsetAsync((char*)d_ws + OFF_CTL, 0, CTL_BYTES, stream);
    P p{};
    for (int i = 0; i < 25; ++i) p.in[i] = (const float*)d_in[i];
    p.out = (float*)d_out; p.ws = (unsigned char*)d_ws;
    hipLaunchKernelGGL(fwd_kernel, dim3(grid), dim3(NT), LDS_BYTES, stream, p, 0, N_PHASES);
}
```

```cpp
#include <hip/hip_runtime.h>
#include <stdint.h>
#include <stdio.h>

#define D_MODEL 1024
#define BATCH 8
#define SEQ 4096
#define CTXL 256
#define T_LAT (BATCH * SEQ)
#define T_CTX (BATCH * CTXL)
#define T_ALL (T_LAT + T_CTX)
#define IN_DIM 2144
#define PROJ_LD 2304
#define POST_LD 2816
#define D_FF 2816
#define D_FFE 3584
#define NEXP 8
#define NT 512
#define NORM_EPS 1e-6f

typedef unsigned short bf16_t;
__device__ __forceinline__ float bf2f(bf16_t v) { return __uint_as_float(((unsigned)v) << 16); }
__device__ __forceinline__ bf16_t f2bf(float f) { unsigned u = __float_as_uint(f); u += 0x7FFFu + ((u >> 16) & 1u); return (bf16_t)(u >> 16); }
__device__ __forceinline__ float silu_f(float v) { return v / (1.f + expf(-v)); }

#define PJ_RQ 1280
#define PJ_RK 1536
#define PJ_RV 1792
#define PJ_RG 2048
#define PJ_F8 1280
#define PC_QA 0
#define PC_KA 384
#define PC_VA 768
#define PC_QB 1024
#define PC_KB 1536
#define PC_VB 1664
#define PC_RQ 1792
#define PC_RK 2048
#define PC_RV 2304
#define PC_RG 2560

constexpr size_t AL256(size_t x) { return (x + 255) & ~(size_t)255; }
constexpr size_t OFF_CTL  = 0;
constexpr size_t CTL_BYTES = 294912;
constexpr size_t OFF_PCNT = 32768;
constexpr size_t OFF_CLAIM = 20480;
constexpr size_t OFF_CMAX = 196608;
constexpr size_t OFF_CS8  = OFF_CMAX + 5632 * 4;
constexpr size_t OFF_CMAXW = OFF_CS8 + 5632 * 4;
constexpr size_t OFF_CSW  = 262144;
constexpr size_t OFF_RSW  = 294912;
static_assert(OFF_RSW + (size_t)T_ALL * 4 <= (1u << 20), "row scales fit below OFF_MOD");
constexpr size_t OFF_CNT  = 16384;
constexpr size_t OFF_MOD  = 1u << 20;
constexpr size_t OFF_TAB  = 3u << 19;
constexpr size_t OFF_WIN  = 3u << 20;
constexpr size_t OFF_WOUT = OFF_WIN + (size_t)2 * PROJ_LD * 1024 * 2;
constexpr size_t OFF_FGU  = OFF_WOUT + (size_t)2 * 1024 * 1024 * 2;
constexpr size_t OFF_FD   = OFF_FGU + (size_t)2 * D_FF * 1024 * 2;
constexpr size_t OFF_WUQ  = OFF_FD + (size_t)1024 * D_FF * 2;
constexpr size_t OFF_WUKV = OFF_WUQ + (size_t)2 * 384 * 192 * 2;
constexpr size_t OFF_H    = OFF_WUKV + (size_t)2 * 512 * 128 * 2;
constexpr size_t OFF_XC   = OFF_H + (size_t)T_ALL * 1024 * 2;
constexpr size_t OFF_LIST = OFF_XC + (size_t)T_CTX * 1024 * 4;
constexpr size_t OFF_WL   = OFF_LIST + (size_t)2 * 8 * 32768 * 4;
constexpr size_t OFF_R    = OFF_WL + (size_t)2 * 8 * 32768 * 4;
constexpr size_t OFF_PROJ = OFF_R;
constexpr size_t OFF_POST = OFF_PROJ + (size_t)T_ALL * PROJ_LD * 2;
constexpr size_t OFF_TT   = OFF_POST + (size_t)T_ALL * POST_LD * 2;
constexpr size_t R1_END   = OFF_TT + (size_t)BATCH * 4 * 34 * 2 * 4096 * 4;
constexpr size_t OFF_ACT  = OFF_R;
constexpr size_t OFF_Y    = OFF_PROJ;
constexpr size_t OFF_H8D  = OFF_ACT + (size_t)T_ALL * D_FF;
constexpr size_t OFF_RS8   = OFF_H8D + (size_t)T_ALL * 1024;
constexpr size_t OFF_Y2   = OFF_ACT + (size_t)T_ALL * D_FF * 2;
constexpr size_t ACT_ROWS = T_LAT + NEXP * 256;
constexpr size_t OFF_MGU  = OFF_ACT + ACT_ROWS * D_FFE;
constexpr size_t OFF_MD   = OFF_MGU + (size_t)NEXP * 2 * D_FFE * 1024;
constexpr size_t OFF_PART = OFF_MD + (size_t)NEXP * 1024 * D_FFE;
constexpr size_t PART_END = OFF_PART + (size_t)256 * 65536 * 4;
constexpr size_t OFF_YM   = PART_END;
constexpr size_t OFF_INV  = OFF_YM + (size_t)2 * ACT_ROWS * 1024 * 2;
constexpr size_t YM_END   = OFF_INV + (size_t)T_LAT * 32;
constexpr size_t OFF_QK8  = YM_END;
constexpr size_t OFF_V8T  = OFF_QK8 + (size_t)T_ALL * 1024;
constexpr size_t F8_END   = OFF_V8T + (size_t)BATCH * 4 * 64 * 4352;
constexpr size_t WS_END   = F8_END > R1_END ? F8_END : R1_END;
static_assert(R1_END <= WS_END, "phase-1 buffers fit");
static_assert(WS_END <= 607070848, "workspace budget");
static_assert(OFF_Y2 + (size_t)T_ALL * 1024 * 2 <= WS_END, "Y2 fits");
static_assert(OFF_MGU >= OFF_Y + (size_t)T_ALL * 1024 * 2, "expert weights are converted while norm2(L1) still reads Y");

struct P { const float* in[25]; float* out; unsigned char* ws; };

#define XB_TMO      128
#define XB_XCNT(j)  (256  + 64 * (j))
#define XB_XSUB(j)  (1280 + 64 * (j))
#define XB_XGEN(j)  (2304 + 64 * (j))
#define XB_TOP      3328
#define XB_TOPGEN   3392
#define XCD_BAR_WORDS 3456
#define XB_SPIN_CAP (1u << 22)
#define LAS __attribute__((address_space(3)))

__device__ __forceinline__ unsigned xb_ld(unsigned* p)              { return __hip_atomic_load(p, __ATOMIC_RELAXED, __HIP_MEMORY_SCOPE_AGENT); }
__device__ __forceinline__ unsigned xb_add(unsigned* p, unsigned v) { return __hip_atomic_fetch_add(p, v, __ATOMIC_RELAXED, __HIP_MEMORY_SCOPE_AGENT); }
__device__ __forceinline__ unsigned xb_xcc_id() { return (unsigned)__builtin_amdgcn_s_getreg((3 << 11) | 20) & 0xFu; }
#define XB_SPIN(cond, bar) do { unsigned _sp = 0; while (cond) { __builtin_amdgcn_s_sleep(1); \
    if ((++_sp & 255u) == 0u) { if (xb_ld(&(bar)[XB_TMO])) break; if (_sp > XB_SPIN_CAP) { atomicAdd(&(bar)[XB_TMO], 1u); break; } } } } while (0)

struct XcdBarrier { unsigned* bar; unsigned x; volatile LAS unsigned* st; };

__device__ __forceinline__ XcdBarrier xcd_barrier_post(unsigned* bar, volatile LAS unsigned* st) {
    XcdBarrier b; b.bar = bar; b.x = xb_xcc_id(); b.st = st;
    if (threadIdx.x == 0) (void)xb_add(&bar[XB_XCNT(b.x)], 1u);
    return b;
}
__device__ __forceinline__ void xcd_barrier_complete(unsigned* bar, unsigned x, unsigned& nloc, unsigned& nx) {
    const unsigned G = gridDim.x * gridDim.y * gridDim.z;
    unsigned sum, cnt, mine, sp = 0u;
    for (;;) {
        sum = 0u; cnt = 0u; mine = 0u;
#pragma unroll
        for (unsigned j = 0; j < 16; ++j) { const unsigned c = xb_ld(&bar[XB_XCNT(j)]); sum += c; cnt += (c > 0u) ? 1u : 0u; mine = (j == x) ? c : mine; }
        if (sum == G) break;
        __builtin_amdgcn_s_sleep(1);
        if ((++sp & 255u) == 0u) { if (xb_ld(&bar[XB_TMO])) break; if (sp > XB_SPIN_CAP) { atomicAdd(&bar[XB_TMO], 1u); break; } }
    }
    nloc = mine > 0u ? mine : 1u; nx = cnt > 0u ? cnt : 1u;
}
__device__ __forceinline__ void xcd_barrier(const XcdBarrier& b) {
    asm volatile("s_waitcnt vmcnt(0)" ::: "memory");
    __syncthreads();
    if (threadIdx.x == 0) {
        unsigned* bar = b.bar;
        __builtin_amdgcn_s_waitcnt(0);
        unsigned nloc = b.st[0], nx = b.st[1];
        if (nloc == 0u) { xcd_barrier_complete(bar, b.x, nloc, nx); b.st[0] = nloc; b.st[1] = nx; }
        const unsigned old = xb_add(&bar[XB_XSUB(b.x)], 1u);
        const unsigned gen = old / nloc;
        if (old + 1u == (gen + 1u) * nloc) {
            __builtin_amdgcn_fence(__ATOMIC_RELEASE, "agent");
            asm volatile("s_waitcnt vmcnt(0)" ::: "memory");
            const unsigned og = xb_add(&bar[XB_TOP], 1u);
            const unsigned tg = og / nx;
            if (og + 1u == (tg + 1u) * nx) xb_add(&bar[XB_TOPGEN], 1u);
            else XB_SPIN(xb_ld(&bar[XB_TOPGEN]) == tg, bar);
            __builtin_amdgcn_fence(__ATOMIC_ACQUIRE, "agent");
            xb_add(&bar[XB_XGEN(b.x)], 1u);
            asm volatile("s_waitcnt vmcnt(0)" ::: "memory");
        } else {
            XB_SPIN(xb_ld(&bar[XB_XGEN(b.x)]) == gen, bar);
            __builtin_amdgcn_fence(__ATOMIC_ACQUIRE, "agent");
            asm volatile("s_waitcnt vmcnt(0)" ::: "memory");
        }
    }
    __syncthreads();
}

__device__ __forceinline__ float wave_sum(float v) {
#pragma unroll
    for (int o = 32; o > 0; o >>= 1) v += __shfl_xor(v, o);
    return v;
}
__device__ __forceinline__ void unpack8(const uint4 r, float* f) {
    f[0] = __uint_as_float(r.x << 16); f[1] = __uint_as_float(r.x & 0xFFFF0000u);
    f[2] = __uint_as_float(r.y << 16); f[3] = __uint_as_float(r.y & 0xFFFF0000u);
    f[4] = __uint_as_float(r.z << 16); f[5] = __uint_as_float(r.z & 0xFFFF0000u);
    f[6] = __uint_as_float(r.w << 16); f[7] = __uint_as_float(r.w & 0xFFFF0000u);
}
__device__ __forceinline__ int tok_row(int b, int i) { return i < SEQ ? b * SEQ + i : T_LAT + b * CTXL + (i - SEQ); }

__device__ __forceinline__ void ph_mod(const P& p, float* lds) {
    float* MOD = (float*)(p.ws + OFF_MOD);
    float* sl = lds; float* part = lds + 9 * 1024;
    int tid_ = threadIdx.x; asm volatile("" : "+v"(tid_));
    const int t = tid_, col = t & 63, ks = t >> 6;
    __syncthreads();
    for (int i = t; i < 9 * 1024; i += NT) { const int r = i >> 10, k = i & 1023; sl[i] = silu_f(r < 8 ? p.in[1][r * 1024 + k] : p.in[3][k]); }
    __syncthreads();
    for (int u = blockIdx.x; u < 2 * 96; u += gridDim.x) {
        const int l = u / 96, n = (u % 96) * 64 + col;
        const float* w = p.in[4] + (size_t)l * 1024 * 6144 + (size_t)(ks * 128) * 6144 + n;
        float acc[9];
#pragma unroll
        for (int r = 0; r < 9; ++r) acc[r] = 0.f;
#pragma unroll 8
        for (int k = 0; k < 128; ++k) { const float wv = w[(size_t)k * 6144];
#pragma unroll
            for (int r = 0; r < 9; ++r) acc[r] += sl[r * 1024 + ks * 128 + k] * wv; }
        __syncthreads();
#pragma unroll
        for (int r = 0; r < 9; ++r) part[(ks * 9 + r) * 64 + col] = acc[r];
        __syncthreads();
        for (int i = t; i < 9 * 64; i += NT) { const int r = i >> 6, c2 = i & 63; float s = 0.f;
#pragma unroll
            for (int q = 0; q < 8; ++q) s += part[(q * 9 + r) * 64 + c2];
            const int nn = (u % 96) * 64 + c2; MOD[(l * 9 + r) * 6144 + nn] = s + p.in[5][l * 6144 + nn]; }
    }
}

#define F8_SH 8.f
#define F8_SW 64.f
#define F8_SA 4.f
#define MOE_WAYS 7
__device__ __forceinline__ float f8clamp(float x) { return fminf(fmaxf(x, -448.f), 448.f); }
struct NormArgs { int layer, which; bool router, from_input; const bf16_t* resY; int res_layer, res_goff, ctx_ways; unsigned char* h8; bool both; float* i8s = nullptr; };
__device__ __forceinline__ void norm_row(const P& p, const NormArgs& a, int row, int lane) {
    const int layer = a.layer, which = a.which, res_layer = a.res_layer, res_goff = a.res_goff, ctx_ways = a.ctx_ways; const bool router = a.router, from_input = a.from_input; const bf16_t* resY = a.resY;
    const float* MOD = (const float*)(p.ws + OFF_MOD);
    const float* gain = (which == 1 ? p.in[6] : p.in[7]) + layer * 1024;
    bf16_t* H = (bf16_t*)(p.ws + OFF_H);
    float* XC = (float*)(p.ws + OFF_XC);
    int* CNT = (int*)(p.ws + OFF_CNT);
    int* LIST = (int*)(p.ws + OFF_LIST);
    float* WL = (float*)(p.ws + OFF_WL);
    {
        const float* src; float* dstx; int r;
        if (row < T_LAT) { r = row >> 12; src = (from_input ? p.in[0] : p.out) + (size_t)row * 1024; dstx = p.out + (size_t)row * 1024; }
        else { r = 8; src = (from_input ? p.in[2] : XC) + (size_t)(row - T_LAT) * 1024; dstx = XC + (size_t)(row - T_LAT) * 1024; }
        const float* md = MOD + (layer * 9 + r) * 6144 + (which == 1 ? 0 : 3072);
        float4 v[4]; float ss = 0.f;
#pragma unroll
        for (int i = 0; i < 4; ++i) v[i] = *(const float4*)(src + i * 256 + lane * 4);
        if (resY) {
            const float* gt = MOD + (res_layer * 9 + r) * 6144 + res_goff;
#pragma unroll
            for (int i = 0; i < 4; ++i) { const int col = i * 256 + lane * 4;
                const float4 g = *(const float4*)(gt + col); float4 y;
                if (row >= T_LAT && ctx_ways > 0) {
                    const int cr = row - T_LAT; const float* pp = (const float*)(p.ws + OFF_PART) + (size_t)(((cr >> 8) * 4 + i) * ctx_ways) * 65536 + (cr & 255) * 256 + lane * 4;
                    y = *(const float4*)pp;
                    for (int q = 1; q < ctx_ways; ++q) { const float4 z = *(const float4*)(pp + (size_t)q * 65536); y.x += z.x; y.y += z.y; y.z += z.z; y.w += z.w; }
                } else { const uint2 yr = *(const uint2*)(resY + (size_t)row * 1024 + col);
                    y = make_float4(__uint_as_float(yr.x << 16), __uint_as_float(yr.x & 0xFFFF0000u), __uint_as_float(yr.y << 16), __uint_as_float(yr.y & 0xFFFF0000u)); }
                v[i].x += g.x * y.x; v[i].y += g.y * y.y; v[i].z += g.z * y.z; v[i].w += g.w * y.w;
                *(float4*)(dstx + col) = v[i]; }
        }
#pragma unroll
        for (int i = 0; i < 4; ++i) ss += v[i].x * v[i].x + v[i].y * v[i].y + v[i].z * v[i].z + v[i].w * v[i].w;
        ss = wave_sum(ss);
        const float rs = rsqrtf(ss * (1.f / 1024.f) + NORM_EPS);
        if (a.i8s) {
            float oo[4][4]; float amax = 0.f;
#pragma unroll
            for (int i = 0; i < 4; ++i) { const int col = i * 256 + lane * 4;
                const float4 g = *(const float4*)(gain + col), sh = *(const float4*)(md + col), sc = *(const float4*)(md + 1024 + col);
                oo[i][0] = (v[i].x * rs * g.x) * (1.f + sc.x) + sh.x; oo[i][1] = (v[i].y * rs * g.y) * (1.f + sc.y) + sh.y;
                oo[i][2] = (v[i].z * rs * g.z) * (1.f + sc.z) + sh.z; oo[i][3] = (v[i].w * rs * g.w) * (1.f + sc.w) + sh.w;
                amax = fmaxf(fmaxf(amax, fmaxf(fabsf(oo[i][0]), fabsf(oo[i][1]))), fmaxf(fabsf(oo[i][2]), fabsf(oo[i][3]))); }
#pragma unroll
            for (int o_ = 1; o_ < 64; o_ <<= 1) amax = fmaxf(amax, __shfl_xor(amax, o_));
            amax = fmaxf(amax, 1e-20f);
            const float qs = 127.f / amax;
#pragma unroll
            for (int i = 0; i < 4; ++i) { const int q0 = (int)rintf(oo[i][0] * qs), q1 = (int)rintf(oo[i][1] * qs), q2 = (int)rintf(oo[i][2] * qs), q3 = (int)rintf(oo[i][3] * qs);
                *(int*)(a.h8 + (size_t)row * 1024 + i * 256 + lane * 4) = (int)((unsigned)(q0 & 255) | ((unsigned)(q1 & 255) << 8) | ((unsigned)(q2 & 255) << 16) | ((unsigned)q3 << 24)); }
            if (lane == 0) a.i8s[row] = amax * (1.f / 127.f);
            return;
        }
        float lg[8] = {0.f, 0.f, 0.f, 0.f, 0.f, 0.f, 0.f, 0.f};
#pragma unroll
        for (int i = 0; i < 4; ++i) {
            const int col = i * 256 + lane * 4;
            const float4 g = *(const float4*)(gain + col), sh = *(const float4*)(md + col), sc = *(const float4*)(md + 1024 + col);
            float o[4];
            o[0] = (v[i].x * rs * g.x) * (1.f + sc.x) + sh.x; o[1] = (v[i].y * rs * g.y) * (1.f + sc.y) + sh.y;
            o[2] = (v[i].z * rs * g.z) * (1.f + sc.z) + sh.z; o[3] = (v[i].w * rs * g.w) * (1.f + sc.w) + sh.w;
            if (a.h8) {
                int w8 = 0; w8 = __builtin_amdgcn_cvt_pk_fp8_f32(f8clamp(o[0] * F8_SH), f8clamp(o[1] * F8_SH), w8, false); w8 = __builtin_amdgcn_cvt_pk_fp8_f32(f8clamp(o[2] * F8_SH), f8clamp(o[3] * F8_SH), w8, true);
                *(int*)(a.h8 + (size_t)row * 1024 + col) = w8;
            }
            if (!a.h8 || a.both) {
            uint2 pk; pk.x = (unsigned)f2bf(o[0]) | ((unsigned)f2bf(o[1]) << 16); pk.y = (unsigned)f2bf(o[2]) | ((unsigned)f2bf(o[3]) << 16);
            *(uint2*)(H + (size_t)row * 1024 + col) = pk; }
            if (router) {
                const float* rw = p.in[20] + (size_t)col * 8;
#pragma unroll
                for (int j = 0; j < 4; ++j) {
                    const float4 w0 = *(const float4*)(rw + j * 8), w1 = *(const float4*)(rw + j * 8 + 4);
                    lg[0] += o[j] * w0.x; lg[1] += o[j] * w0.y; lg[2] += o[j] * w0.z; lg[3] += o[j] * w0.w;
                    lg[4] += o[j] * w1.x; lg[5] += o[j] * w1.y; lg[6] += o[j] * w1.z; lg[7] += o[j] * w1.w;
                }
            }
        }
        if (router) {
#pragma unroll
            for (int e = 0; e < 8; ++e) lg[e] = wave_sum(lg[e]);
            if (lane == 0) {
                int e0 = 0; float v0 = lg[0];
#pragma unroll
                for (int e = 1; e < 8; ++e) if (lg[e] > v0) { v0 = lg[e]; e0 = e; }
                int e1 = -1; float v1 = -3.0e38f;
#pragma unroll
                for (int e = 0; e < 8; ++e) if (e != e0 && lg[e] > v1) { v1 = lg[e]; e1 = e; }
                const float x1 = expf(v1 - v0), inv = 1.f / (1.f + x1);
                const float w0 = inv, w1 = x1 * inv;
                const int p0 = atomicAdd(&CNT[e0], 1), p1 = atomicAdd(&CNT[8 + e1], 1);
                LIST[(size_t)e0 * 32768 + p0] = row; WL[(size_t)e0 * 32768 + p0] = w0;
                LIST[(size_t)(8 + e1) * 32768 + p1] = row; WL[(size_t)(8 + e1) * 32768 + p1] = w1;
                { int* iv = (int*)(p.ws + OFF_INV) + (size_t)row * 8; *(int4*)iv = make_int4(e0, p0, e1, p1); *(float2*)(iv + 4) = make_float2(w0, w1); }
            }
        }
    }
}
__device__ __forceinline__ void norm_rows4(const P& p, const NormArgs& a, int row0, int lane) {
    const float* MOD = (const float*)(p.ws + OFF_MOD);
    bf16_t* H = (bf16_t*)(p.ws + OFF_H); float* XC = (float*)(p.ws + OFF_XC);
    const bool lat = row0 < T_LAT; const int r = lat ? (row0 >> 12) : 8;
    const float* srcb = lat ? (a.from_input ? p.in[0] : p.out) + (size_t)row0 * 1024 : (a.from_input ? p.in[2] : XC) + (size_t)(row0 - T_LAT) * 1024;
    float* dstb = lat ? p.out + (size_t)row0 * 1024 : XC + (size_t)(row0 - T_LAT) * 1024;
    float4 v[4][4]; uint2 y[4][4];
#pragma unroll
    for (int q = 0; q < 4; ++q)
#pragma unroll
        for (int i = 0; i < 4; ++i) { v[q][i] = *(const float4*)(srcb + q * 1024 + i * 256 + lane * 4); y[q][i] = *(const uint2*)(a.resY + (size_t)(row0 + q) * 1024 + i * 256 + lane * 4); }
    const float* gt = MOD + (a.res_layer * 9 + r) * 6144 + a.res_goff;
    const float* md = MOD + (a.layer * 9 + r) * 6144 + (a.which == 1 ? 0 : 3072);
    const float* gain = (a.which == 1 ? p.in[6] : p.in[7]) + a.layer * 1024;
    float4 gg[4], gn[4], sh[4], sc[4];
#pragma unroll
    for (int i = 0; i < 4; ++i) { const int col = i * 256 + lane * 4; gg[i] = *(const float4*)(gt + col); gn[i] = *(const float4*)(gain + col); sh[i] = *(const float4*)(md + col); sc[i] = *(const float4*)(md + 1024 + col); }
#pragma unroll
    for (int q = 0; q < 4; ++q) {
        float ss = 0.f;
#pragma unroll
        for (int i = 0; i < 4; ++i) { const uint2 yr = y[q][i];
            v[q][i].x += gg[i].x * __uint_as_float(yr.x << 16); v[q][i].y += gg[i].y * __uint_as_float(yr.x & 0xFFFF0000u);
            v[q][i].z += gg[i].z * __uint_as_float(yr.y << 16); v[q][i].w += gg[i].w * __uint_as_float(yr.y & 0xFFFF0000u);
            *(float4*)(dstb + q * 1024 + i * 256 + lane * 4) = v[q][i];
            ss += v[q][i].x * v[q][i].x + v[q][i].y * v[q][i].y + v[q][i].z * v[q][i].z + v[q][i].w * v[q][i].w; }
        ss = wave_sum(ss);
        const float rs = rsqrtf(ss * (1.f / 1024.f) + NORM_EPS);
        if (a.i8s) {
            float oo[4][4]; float amax = 0.f;
#pragma unroll
            for (int i = 0; i < 4; ++i) {
                oo[i][0] = (v[q][i].x * rs * gn[i].x) * (1.f + sc[i].x) + sh[i].x; oo[i][1] = (v[q][i].y * rs * gn[i].y) * (1.f + sc[i].y) + sh[i].y;
                oo[i][2] = (v[q][i].z * rs * gn[i].z) * (1.f + sc[i].z) + sh[i].z; oo[i][3] = (v[q][i].w * rs * gn[i].w) * (1.f + sc[i].w) + sh[i].w;
                amax = fmaxf(fmaxf(amax, fmaxf(fabsf(oo[i][0]), fabsf(oo[i][1]))), fmaxf(fabsf(oo[i][2]), fabsf(oo[i][3]))); }
#pragma unroll
            for (int o_ = 1; o_ < 64; o_ <<= 1) amax = fmaxf(amax, __shfl_xor(amax, o_));
            amax = fmaxf(amax, 1e-20f);
            const float qs = 127.f / amax;
#pragma unroll
            for (int i = 0; i < 4; ++i) { const int q0 = (int)rintf(oo[i][0] * qs), q1 = (int)rintf(oo[i][1] * qs), q2 = (int)rintf(oo[i][2] * qs), q3 = (int)rintf(oo[i][3] * qs);
                *(int*)(a.h8 + (size_t)(row0 + q) * 1024 + i * 256 + lane * 4) = (int)((unsigned)(q0 & 255) | ((unsigned)(q1 & 255) << 8) | ((unsigned)(q2 & 255) << 16) | ((unsigned)q3 << 24)); }
            if (lane == 0) a.i8s[row0 + q] = amax * (1.f / 127.f);
        } else
#pragma unroll
        for (int i = 0; i < 4; ++i) { float o[4];
            o[0] = (v[q][i].x * rs * gn[i].x) * (1.f + sc[i].x) + sh[i].x; o[1] = (v[q][i].y * rs * gn[i].y) * (1.f + sc[i].y) + sh[i].y;
            o[2] = (v[q][i].z * rs * gn[i].z) * (1.f + sc[i].z) + sh[i].z; o[3] = (v[q][i].w * rs * gn[i].w) * (1.f + sc[i].w) + sh[i].w;
            if (a.h8) { int w8 = 0; w8 = __builtin_amdgcn_cvt_pk_fp8_f32(f8clamp(o[0] * F8_SH), f8clamp(o[1] * F8_SH), w8, false); w8 = __builtin_amdgcn_cvt_pk_fp8_f32(f8clamp(o[2] * F8_SH), f8clamp(o[3] * F8_SH), w8, true);
                *(int*)(a.h8 + (size_t)(row0 + q) * 1024 + i * 256 + lane * 4) = w8; }
            if (!a.h8 || a.both) { uint2 pk; pk.x = (unsigned)f2bf(o[0]) | ((unsigned)f2bf(o[1]) << 16); pk.y = (unsigned)f2bf(o[2]) | ((unsigned)f2bf(o[3]) << 16);
            *(uint2*)(H + (size_t)(row0 + q) * 1024 + i * 256 + lane * 4) = pk; } }
    }
}
__device__ __forceinline__ void norm_help(const P& p, const NormArgs& a, unsigned* cnt, unsigned need, unsigned* claim, int npanels, LAS unsigned* lw) {
    int tid_ = threadIdx.x; asm volatile("" : "+v"(tid_));
    const int wave = __builtin_amdgcn_readfirstlane(tid_ >> 6), lane = tid_ & 63;
    for (;;) {
        __syncthreads();
        if (threadIdx.x == 0) {
            const unsigned part = __hip_atomic_fetch_add(claim, 1u, __ATOMIC_RELAXED, __HIP_MEMORY_SCOPE_AGENT);
            if (part < (unsigned)npanels * 4u) {
                unsigned sp = 0;
                while (__hip_atomic_load(cnt + 64 * (part >> 2), __ATOMIC_RELAXED, __HIP_MEMORY_SCOPE_AGENT) < need) { __builtin_amdgcn_s_sleep(8); if (++sp > (1u << 22)) break; }
                __builtin_amdgcn_fence(__ATOMIC_ACQUIRE, "agent");
                asm volatile("s_waitcnt vmcnt(0)" ::: "memory");
            }
            lw[0] = part;
        }
        __syncthreads();
        const unsigned part = lw[0];
        if (part >= (unsigned)npanels * 4u) break;
        const int base = (int)(part >> 2) * 256 + (int)(part & 3u) * 64 + wave * 8;
        norm_rows4(p, a, base, lane); norm_rows4(p, a, base + 4, lane);
    }
}
__device__ __forceinline__ void ph_norm(const P& p, int layer, int which, int nrows, bool router, bool from_input, const bf16_t* resY, int res_layer, int res_goff, int ctx_ways, unsigned char* h8, bool both, float* i8s = nullptr) {
    int tid_ = threadIdx.x; asm volatile("" : "+v"(tid_));
    const int wave = tid_ >> 6, lane = tid_ & 63;
    const NormArgs a{layer, which, router, from_input, resY, res_layer, res_goff, ctx_ways, h8, both, i8s};
    for (int row = blockIdx.x * 8 + wave; row < nrows; row += gridDim.x * 8) norm_row(p, a, row, lane);
}

__host__ __device__ __forceinline__ int win_col(int n) {
    if (n < 352) return n;
    if (n < 992) { const int d = (n - 352) & 63, e = d & 31; return n - d + (d & 32) + (e < 16 ? 2 * e : 2 * (e - 16) + 1); }
    if (n < 1120) return n;
    if (n < 1632) { const int d = (n - 1120) & 63; return PJ_RQ + (n - 1120) - d + (d < 32 ? 2 * d : 2 * (d - 32) + 1); }
    return PJ_RQ + (n - 1120);
}
struct ConvJob { const float* src; bf16_t* dst; int K, N, map, f8; const unsigned* cmax = nullptr; float* cs = nullptr; };
__device__ __forceinline__ void conv_tiles4(const ConvJob& j, int tile, int step, int ntl, float* T  ) {
    int tid_ = threadIdx.x; asm volatile("" : "+v"(tid_));
    const int ntn = (j.N + 63) >> 6, t = tid_;
    float4 v[4][2];
#pragma unroll
    for (int q = 0; q < 4; ++q) { const int tl = tile + q * step, tk = tl / ntn, tn = tl % ntn;
#pragma unroll
        for (int i = 0; i < 2; ++i) { const int kr = (t >> 4) + 32 * i, c4 = (t & 15) * 4, n = tn * 64 + c4;
            v[q][i] = make_float4(0.f, 0.f, 0.f, 0.f);
            if (tl < ntl && n < j.N) v[q][i] = *(const float4*)(j.src + (size_t)(tk * 64 + kr) * j.N + n); } }
    __syncthreads();
#pragma unroll
    for (int q = 0; q < 4; ++q)
#pragma unroll
        for (int i = 0; i < 2; ++i) { const int kr = (t >> 4) + 32 * i, c4 = (t & 15) * 4; float* Tq = T + q * (64 * 65);
            Tq[kr * 65 + c4 + 0] = v[q][i].x; Tq[kr * 65 + c4 + 1] = v[q][i].y; Tq[kr * 65 + c4 + 2] = v[q][i].z; Tq[kr * 65 + c4 + 3] = v[q][i].w; }
    __syncthreads();
#pragma unroll
    for (int q = 0; q < 4; ++q) { const int tl = tile + q * step, tk = tl / ntn, tn = tl % ntn; const float* Tq = T + q * (64 * 65);
        const int nl = t >> 3, ks = (t & 7) * 8, n = tn * 64 + nl;
        if (tl < ntl && n < j.N) {
            int nd = j.map == 0 ? n : ((n >> 7) * 256 + (n & 127) + (j.map == 2 ? 128 : 0)); bool f8 = j.f8 != 0;
            if (j.map == 3) {
                nd = win_col(n);
                f8 = nd < PJ_F8 && !j.cmax; }
            if (j.cmax) {
                const float am = fmaxf(__uint_as_float(j.cmax[nd]), 1e-30f), qs = 127.f / am;
                int q[8];
#pragma unroll
                for (int i = 0; i < 8; ++i) q[i] = (int)rintf(Tq[(ks + i) * 65 + nl] * qs) & 255;
                *(uint2*)((unsigned char*)j.dst + (size_t)nd * j.K + tk * 64 + ks) = make_uint2((unsigned)(q[0] | (q[1] << 8) | (q[2] << 16) | (q[3] << 24)), (unsigned)(q[4] | (q[5] << 8) | (q[6] << 16) | (q[7] << 24)));
                if (tk == 0 && ks == 0) j.cs[nd] = am * (1.f / 127.f);
            } else if (f8) {
                int w0 = 0, w1 = 0;
                w0 = __builtin_amdgcn_cvt_pk_fp8_f32(f8clamp(Tq[(ks + 0) * 65 + nl] * F8_SW), f8clamp(Tq[(ks + 1) * 65 + nl] * F8_SW), w0, false);
                w0 = __builtin_amdgcn_cvt_pk_fp8_f32(f8clamp(Tq[(ks + 2) * 65 + nl] * F8_SW), f8clamp(Tq[(ks + 3) * 65 + nl] * F8_SW), w0, true);
                w1 = __builtin_amdgcn_cvt_pk_fp8_f32(f8clamp(Tq[(ks + 4) * 65 + nl] * F8_SW), f8clamp(Tq[(ks + 5) * 65 + nl] * F8_SW), w1, false);
                w1 = __builtin_amdgcn_cvt_pk_fp8_f32(f8clamp(Tq[(ks + 6) * 65 + nl] * F8_SW), f8clamp(Tq[(ks + 7) * 65 + nl] * F8_SW), w1, true);
                *(uint2*)((unsigned char*)j.dst + (size_t)nd * j.K + tk * 64 + ks) = make_uint2((unsigned)w0, (unsigned)w1);
            } else {
            unsigned w[4];
#pragma unroll
            for (int i = 0; i < 4; ++i) w[i] = (unsigned)f2bf(Tq[(ks + 2 * i) * 65 + nl]) | ((unsigned)f2bf(Tq[(ks + 2 * i + 1) * 65 + nl]) << 16);
            *(uint4*)(j.dst + (size_t)nd * j.K + tk * 64 + ks) = make_uint4(w[0], w[1], w[2], w[3]);
            }
        } }
}
__device__ __forceinline__ int conv_ntiles(int K, int N) { return (K >> 6) * ((N + 63) >> 6); }

#define CONV_F8 0
__device__ __forceinline__ void ph_conv_early(const P& p, float* lds) {
    const int G = gridDim.x, bid = blockIdx.x;
    int base = 0;
#define CONV_RUN(SRC, DST, K_, N_, MAP_) do { ConvJob j{SRC, DST, K_, N_, MAP_, CONV_F8}; const int nt_ = conv_ntiles(K_, N_), ns_ = (nt_ + 3) >> 2; \
          \
        for (int u = (((bid - base % G) + G) % G); u < ns_; u += G) conv_tiles4(j, 4 * u, 1, nt_, lds); base += ns_; } while (0)
    for (int l = 0; l < 2; ++l) {
        CONV_RUN(p.in[16] + (size_t)l * 1024 * 1024, (bf16_t*)(p.ws + OFF_WOUT) + (size_t)l * 1024 * 1024, 1024, 1024, 0);
        CONV_RUN(p.in[10] + (size_t)l * 192 * 384, (bf16_t*)(p.ws + OFF_WUQ) + (size_t)l * 384 * 192, 192, 384, 0);
        CONV_RUN(p.in[12] + (size_t)l * 128 * 512, (bf16_t*)(p.ws + OFF_WUKV) + (size_t)l * 512 * 128, 128, 512, 0);
    }
#undef CONV_F8
#define CONV_F8 1
    CONV_RUN(p.in[19], (bf16_t*)(p.ws + OFF_FD), D_FF, 1024, 0);
    for (int l = 0; l < 2; ++l) {
        uint4* z = (uint4*)((unsigned char*)((bf16_t*)(p.ws + OFF_WIN) + (size_t)l * PROJ_LD * 1024) + (size_t)1120 * 1024);
        const int n16 = (PJ_F8 - 1120) * 1024 / 16;
        for (int i = bid * NT + threadIdx.x; i < n16; i += G * NT) z[i] = make_uint4(0u, 0u, 0u, 0u);
    }
}
#undef CONV_F8
#define CONV_F8 1
__device__ __forceinline__ void ph_fgu_colmax(const P& p) {
    const int G = gridDim.x, bid = blockIdx.x;
    unsigned* cmax = (unsigned*)(p.ws + OFF_CMAX);
    for (int u = bid; u < 2 * 8 * 6; u += G) {
        const int mat = u / 48, kc = (u % 48) / 6, nc = u % 6, n = nc * 512 + (int)threadIdx.x;
        if (n < D_FF) { const float* s = (mat ? p.in[18] : p.in[17]) + (size_t)(kc * 128) * D_FF + n; float am = 0.f;
#pragma unroll 8
            for (int k = 0; k < 128; ++k) am = fmaxf(am, fabsf(s[(size_t)k * D_FF]));
            atomicMax(cmax + ((n >> 7) * 256 + (n & 127) + (mat ? 128 : 0)), __float_as_uint(am)); }
    }
}
__device__ __forceinline__ void ph_win_colmax(const P& p) {
    const int G = gridDim.x, bid = blockIdx.x;
    for (int u = G - 1 - bid; u < 2 * 8 * 5; u += G) {
        const int l = u / 40, kc = (u % 40) / 5, nc = u % 5, n = nc * 512 + (int)threadIdx.x;
        if (n < IN_DIM) { const float* s = p.in[8] + (size_t)l * 1024 * IN_DIM + (size_t)(kc * 128) * IN_DIM + n; float am = 0.f;
#pragma unroll 8
            for (int k = 0; k < 128; ++k) am = fmaxf(am, fabsf(s[(size_t)k * IN_DIM]));
            atomicMax((unsigned*)(p.ws + OFF_CMAXW) + l * PROJ_LD + win_col(n), __float_as_uint(am)); }
    }
}
__device__ __forceinline__ void ph_conv_fgu_i8(const P& p, float* lds) {
    const int G = gridDim.x, bid = blockIdx.x;
    int base = 0;
#define CONV_RUN_I8(SRC, MAP_) do { ConvJob j{SRC, (bf16_t*)(p.ws + OFF_FGU), 1024, D_FF, MAP_, 0, (const unsigned*)(p.ws + OFF_CMAX), (float*)(p.ws + OFF_CS8)}; const int nt_ = conv_ntiles(1024, D_FF), ns_ = (nt_ + 3) >> 2; \
        for (int u = (((bid - base % G) + G) % G); u < ns_; u += G) conv_tiles4(j, 4 * u, 1, nt_, lds); base += ns_; } while (0)
    CONV_RUN_I8(p.in[17], 1);
    CONV_RUN_I8(p.in[18], 2);
#undef CONV_RUN_I8
    for (int l = 0; l < 2; ++l) {
        ConvJob j{p.in[8] + (size_t)l * 1024 * IN_DIM, (bf16_t*)(p.ws + OFF_WIN) + (size_t)l * PROJ_LD * 1024, 1024, IN_DIM, 3, 0, (const unsigned*)(p.ws + OFF_CMAXW) + l * PROJ_LD, (float*)(p.ws + OFF_CSW) + l * PROJ_LD};
        const int nt_ = conv_ntiles(1024, IN_DIM), ns_ = (nt_ + 3) >> 2;
        for (int u = (((bid - base % G) + G) % G); u < ns_; u += G) conv_tiles4(j, 4 * u, 1, nt_, lds); base += ns_; }
}
__device__ __forceinline__ void ph_conv_late(const P& p, float* lds) {
    const int G = gridDim.x, bid = blockIdx.x;
    int base = 0;
    for (int e = 0; e < NEXP; ++e) {
        CONV_RUN(p.in[21] + (size_t)e * 1024 * D_FFE, (bf16_t*)(p.ws + OFF_MGU + (size_t)e * 2 * D_FFE * 1024), 1024, D_FFE, 1);
        CONV_RUN(p.in[22] + (size_t)e * 1024 * D_FFE, (bf16_t*)(p.ws + OFF_MGU + (size_t)e * 2 * D_FFE * 1024), 1024, D_FFE, 2);
        CONV_RUN(p.in[23] + (size_t)e * D_FFE * 1024, (bf16_t*)(p.ws + OFF_MD + (size_t)e * 1024 * D_FFE), D_FFE, 1024, 0);
    }
}

namespace pg8 {
#define PG8_LAS __attribute__((address_space(3)))
typedef short bf16x8 __attribute__((ext_vector_type(8)));
typedef float f32x4 __attribute__((ext_vector_type(4)));
typedef unsigned u32x4 __attribute__((ext_vector_type(4)));
typedef int i32x4v __attribute__((ext_vector_type(4)));
constexpr int BM = 256, BK = 64, HALF = 128, HTB = HALF * BK * 2, STAGE_BYTES = 8 * HTB, NXCD = 8, WGM = 8;

__host__ __device__ __forceinline__ int lds_byte(int r, int c) { const int st = (r >> 4) * 2 + (c >> 5), rr = r & 15, cc = c & 31, ob = rr * 64 + cc * 2; return st * 1024 + (ob ^ (((ob >> 9) & 1) << 5)); }
__host__ __device__ __forceinline__ void stage_rc(int b, int& R, int& C) { const int st = b / 1024, sb = b % 1024, swz = sb ^ (((sb >> 9) & 1) << 5); R = (st >> 1) * 16 + swz / 64; C = (st & 1) * 32 + (swz % 64) / 2; }
__host__ __device__ __forceinline__ int perm32(int rho) { const int n = rho >> 4, i = rho & 15; return 8 * (i >> 2) + 4 * n + (i & 3); }

struct Unit { int pm, pn, e, rl, kp, ri; };

__device__ __forceinline__ void static_order_L(int L, int nM, int nN, int& pm, int& pn) {
    const int nwg = nM * nN;
    int wgid = L; { const int q = nwg / NXCD, r = nwg % NXCD, xcd = wgid % NXCD, off = wgid / NXCD; wgid = (xcd < r ? xcd * (q + 1) : r * (q + 1) + (xcd - r) * q) + off; }
    const int nig = WGM * nN, gid = wgid / nig, fm = gid * WGM, gsz = (nM - fm) < WGM ? (nM - fm) : WGM;
    pm = fm + ((wgid % nig) % gsz); pn = (wgid % nig) / gsz;
}
__device__ __forceinline__ bool static_order(int i, int G, int c, int nM, int nN, int& pm, int& pn) {
    const int nwg = nM * nN; const long L = (long)i * G + c; if (L >= nwg) return false;
    static_order_L((int)L, nM, nN, pm, pn); return true;
}

template <bool FP8_, bool I8_ = false> struct DenseSchedT {
    static constexpr bool GATHER = false, FP8 = FP8_, I8 = I8_;
    const bf16_t* A; const bf16_t* Bt; int lda, K, nM, nN, G, c; int L0 = 0, Lend = 1 << 30;
    __device__ __forceinline__ int nt() const { return K / BK; }
    __device__ __forceinline__ bool next(int i, Unit& u) const { u.e = 0; u.kp = 0; u.ri = 0; const long L = L0 + (long)i * G + c; const int nwg = nM * nN;
        if (L >= nwg || L >= Lend) return false; static_order_L((int)L, nM, nN, u.pm, u.pn); u.rl = u.pm; return true; }
    __device__ __forceinline__ const char* a_base(const Unit& u) const { return (const char*)A + (size_t)u.pm * BM * lda * 2; }
    __device__ __forceinline__ const char* b_base(const Unit& u) const { return (const char*)Bt + (size_t)u.pn * BM * K * 2; }
    __device__ __forceinline__ unsigned a_off(const Unit&, int r, int C) const { return (unsigned)(r * lda + C) * 2u; }
};
typedef DenseSchedT<false> DenseSched;
struct DenseSplitSched {
    static constexpr bool GATHER = false;
    const bf16_t* A; const bf16_t* Bt; int lda, K, pm0, nMs, nN, ways, ntp, G, c;
    __device__ __forceinline__ int nt() const { return ntp; }
    __device__ __forceinline__ bool next(int i, Unit& u) const {
        const long j = (long)i * G + c; if (j >= (long)nMs * nN * ways) return false;
        const int ui = (int)(j / ways); u.kp = (int)(j % ways) * ntp; u.ri = (int)j; u.pm = pm0 + ui / nN; u.pn = ui % nN; u.e = 0; u.rl = u.pm; return true;
    }
    __device__ __forceinline__ const char* a_base(const Unit& u) const { return (const char*)A + (size_t)u.pm * BM * lda * 2 + (size_t)u.kp * (BK * 2); }
    __device__ __forceinline__ const char* b_base(const Unit& u) const { return (const char*)Bt + (size_t)u.pn * BM * K * 2 + (size_t)u.kp * (BK * 2); }
    __device__ __forceinline__ unsigned a_off(const Unit&, int r, int C) const { return (unsigned)(r * lda + C) * 2u; }
};
template <bool GATHER_, bool FP8_ = false> struct MoeSched {
    static constexpr bool GATHER = GATHER_, FP8 = FP8_;
    const bf16_t* A; const bf16_t* Bt; int lda, K, nN, G, c; size_t bstride;
    const int* list;
    const PG8_LAS int* tab;
    int ulo, uhi, ways, ntp;
    __device__ __forceinline__ int nt() const { return ntp; }
    __device__ __forceinline__ bool next(int i, Unit& u) const {
        const int nM = __builtin_amdgcn_readfirstlane(tab[16]);
        const long j = (long)i * G + c; const int L = ulo + (int)(j / ways);
        if (L >= uhi) return false;
        u.kp = (int)(j % ways) * ntp; u.ri = (int)j;
        static_order_L(L, nM, nN, u.pm, u.pn);
        int e = 0, t0 = 0;
#pragma unroll
        for (int k = 1; k < 8; ++k) { const int tk = tab[8 + k]; if (u.pm >= tk) { e = k; t0 = tk; } }
        u.e = __builtin_amdgcn_readfirstlane(e); u.rl = u.pm - __builtin_amdgcn_readfirstlane(t0); return true;
    }
    __device__ __forceinline__ const char* a_base(const Unit& u) const { return (GATHER ? (const char*)A : (const char*)A + (size_t)u.pm * BM * lda * 2) + (size_t)u.kp * (BK * 2); }
    __device__ __forceinline__ const char* b_base(const Unit& u) const { return (const char*)(Bt + (size_t)u.e * bstride) + (size_t)u.pn * BM * K * 2 + (size_t)u.kp * (BK * 2); }
    __device__ __forceinline__ unsigned a_off(const Unit& u, int r, int C) const {
        if (!GATHER) return (unsigned)(r * lda + C) * 2u;
        const int lr = u.rl * BM + r, c1 = tab[u.e] - 1;
        const int tok = list[(size_t)u.e * 32768 + (lr < c1 ? lr : c1)];
        return (unsigned)(tok * lda + C) * 2u;
    }
};

__device__ __forceinline__ unsigned pk2(float lo, float hi) { typedef float f32x2_t __attribute__((ext_vector_type(2))); typedef __bf16 bf16x2_t __attribute__((ext_vector_type(2)));
    f32x2_t v = {lo, hi}; bf16x2_t b = __builtin_convertvector(v, bf16x2_t); return __builtin_bit_cast(unsigned, b); }

struct EpiBf16 {
    static constexpr bool PERM = true;
    bf16_t* O; int ldc;
    __device__ __forceinline__ void operator()(const f32x4 (&acc)[2][2][4][2], const Unit& u, int wr, int wc, int fr, int fq) const {
        const int row0 = u.pm * BM + wr * 64 + fr, col0 = u.pn * BM + wc * 32 + 8 * fq;
#pragma unroll
        for (int ai = 0; ai < 2; ++ai)
#pragma unroll
            for (int m = 0; m < 4; ++m) { bf16_t* rowp = O + (size_t)(row0 + ai * HALF + m * 16) * ldc + col0;
#pragma unroll
                for (int bj = 0; bj < 2; ++bj) { const f32x4 v0 = acc[ai][bj][m][0], v1 = acc[ai][bj][m][1];
                    u32x4 w; w[0] = pk2(v0[0], v0[1]); w[1] = pk2(v0[2], v0[3]); w[2] = pk2(v1[0], v1[1]); w[3] = pk2(v1[2], v1[3]);
                    *(u32x4*)(rowp + bj * HALF) = w; } }
    }
};
struct EpiBf16Norm {
    static constexpr bool PERM = true, HAS_POST = true;
    bf16_t* O; int ldc; unsigned obytes; unsigned* cnt; float sc;
    __device__ __forceinline__ void operator()(const f32x4 (&acc)[2][2][4][2], const Unit& u, int wr, int wc, int fr, int fq) const {
        const auto rsrc = __builtin_amdgcn_make_buffer_rsrc((void*)O, 0, (int)obytes, 0x00020000);
        const int row0 = u.pm * BM + wr * 64 + fr, col0 = u.pn * BM + wc * 32 + 8 * fq;
#pragma unroll
        for (int ai = 0; ai < 2; ++ai)
#pragma unroll
            for (int m = 0; m < 4; ++m) { const unsigned ro = (unsigned)((row0 + ai * HALF + m * 16) * ldc + col0) * 2u;
#pragma unroll
                for (int bj = 0; bj < 2; ++bj) { const f32x4 v0 = acc[ai][bj][m][0] * sc, v1 = acc[ai][bj][m][1] * sc;
                    u32x4 w; w[0] = pk2(v0[0], v0[1]); w[1] = pk2(v0[2], v0[3]); w[2] = pk2(v1[0], v1[1]); w[3] = pk2(v1[2], v1[3]);
                    __builtin_amdgcn_raw_buffer_store_b128(w, rsrc, ro + bj * HALF * 2, 0, 16); } }
    }
    __device__ __forceinline__ void post(const Unit& u) const {
        asm volatile("s_waitcnt vmcnt(0)" ::: "memory");
        if ((threadIdx.x & 63) == 0) __hip_atomic_fetch_add(cnt + 64 * u.pm, 1u, __ATOMIC_RELAXED, __HIP_MEMORY_SCOPE_AGENT);
    }
};
template <bool F8IN, bool F8> struct EpiSwigluT {
    static constexpr bool PERM = true;
    bf16_t* O; int ldc;
    __device__ __forceinline__ void operator()(const f32x4 (&acc)[2][2][4][2], const Unit& u, int wr, int wc, int fr, int fq) const {
        const int row0 = u.pm * BM + wr * 64 + fr, col0 = u.pn * HALF + wc * 32 + 8 * fq;
#pragma unroll
        for (int ai = 0; ai < 2; ++ai)
#pragma unroll
            for (int m = 0; m < 4; ++m) { bf16_t* rowp = O + (size_t)(row0 + ai * HALF + m * 16) * ldc + col0;
                float o[8];
                typedef float f32x2_t __attribute__((ext_vector_type(2)));
#pragma unroll
                for (int n = 0; n < 2; ++n)
#pragma unroll
                    for (int j = 0; j < 4; j += 2) {
                        f32x2_t gg = {acc[ai][0][m][n][j], acc[ai][0][m][n][j + 1]}, uu = {acc[ai][1][m][n][j], acc[ai][1][m][n][j + 1]};
                        if constexpr (F8IN) { gg = gg * (1.f / (F8_SH * F8_SW)); uu = uu * ((F8 ? F8_SA : 1.f) / (F8_SH * F8_SW)); } else if constexpr (F8) uu = uu * F8_SA;
                        const f32x2_t t = gg * (-1.4426950408889634f); f32x2_t e;
                        e[0] = __builtin_amdgcn_exp2f(t[0]); e[1] = __builtin_amdgcn_exp2f(t[1]);
                        e = e + 1.0f; f32x2_t r; r[0] = __builtin_amdgcn_rcpf(e[0]); r[1] = __builtin_amdgcn_rcpf(e[1]);
                        const f32x2_t v = (gg * uu) * r; o[n * 4 + j] = v[0]; o[n * 4 + j + 1] = v[1]; }
                if constexpr (F8) { int w0 = 0, w1 = 0;
                    w0 = __builtin_amdgcn_cvt_pk_fp8_f32(f8clamp(o[0]), f8clamp(o[1]), w0, false); w0 = __builtin_amdgcn_cvt_pk_fp8_f32(f8clamp(o[2]), f8clamp(o[3]), w0, true);
                    w1 = __builtin_amdgcn_cvt_pk_fp8_f32(f8clamp(o[4]), f8clamp(o[5]), w1, false); w1 = __builtin_amdgcn_cvt_pk_fp8_f32(f8clamp(o[6]), f8clamp(o[7]), w1, true);
                    typedef unsigned u32x2v __attribute__((ext_vector_type(2))); u32x2v w = {(unsigned)w0, (unsigned)w1};
                    *(u32x2v*)((unsigned char*)O + (size_t)(row0 + ai * HALF + m * 16) * ldc + col0) = w; }
                else { u32x4 w; w[0] = pk2(o[0], o[1]); w[1] = pk2(o[2], o[3]); w[2] = pk2(o[4], o[5]); w[3] = pk2(o[6], o[7]);
                *(u32x4*)rowp = w; } }
    }
};
typedef EpiSwigluT<false, false> EpiSwiglu;
struct EpiSwigluI8 {
    static constexpr bool PERM = true;
    bf16_t* O; int ldc; const float* rsc; const float* csc;
    __device__ __forceinline__ void operator()(const f32x4 (&acc)[2][2][4][2], const Unit& u, int wr, int wc, int fr, int fq) const {
        const int row0 = u.pm * BM + wr * 64 + fr, col0 = u.pn * HALF + wc * 32 + 8 * fq;
        const float* cg = csc + u.pn * BM + wc * 32 + 8 * fq;
        const f32x4 cg0 = *(const f32x4*)cg, cg1 = *(const f32x4*)(cg + 4), cu0 = *(const f32x4*)(cg + HALF), cu1 = *(const f32x4*)(cg + HALF + 4);
        float rs8[8];
#pragma unroll
        for (int i = 0; i < 8; ++i) rs8[i] = rsc[row0 + (i >> 2) * HALF + (i & 3) * 16];
#pragma unroll
        for (int ai = 0; ai < 2; ++ai)
#pragma unroll
            for (int m = 0; m < 4; ++m) { const int row = row0 + ai * HALF + m * 16; const float rsv = rs8[ai * 4 + m];
                float o[8];
#pragma unroll
                for (int n = 0; n < 2; ++n)
#pragma unroll
                    for (int j = 0; j < 4; ++j) {
                        const float gg = (float)__float_as_int(acc[ai][0][m][n][j]) * (rsv * (n ? cg1[j] : cg0[j])), uu = (float)__float_as_int(acc[ai][1][m][n][j]) * (rsv * F8_SA * (n ? cu1[j] : cu0[j]));
                        const float e = __builtin_amdgcn_exp2f(gg * (-1.4426950408889634f)) + 1.0f;
                        o[n * 4 + j] = (gg * uu) * __builtin_amdgcn_rcpf(e); }
                int w0 = 0, w1 = 0;
                w0 = __builtin_amdgcn_cvt_pk_fp8_f32(f8clamp(o[0]), f8clamp(o[1]), w0, false); w0 = __builtin_amdgcn_cvt_pk_fp8_f32(f8clamp(o[2]), f8clamp(o[3]), w0, true);
                w1 = __builtin_amdgcn_cvt_pk_fp8_f32(f8clamp(o[4]), f8clamp(o[5]), w1, false); w1 = __builtin_amdgcn_cvt_pk_fp8_f32(f8clamp(o[6]), f8clamp(o[7]), w1, true);
                typedef unsigned u32x2v __attribute__((ext_vector_type(2))); u32x2v w = {(unsigned)w0, (unsigned)w1};
                *(u32x2v*)((unsigned char*)O + (size_t)row * ldc + col0) = w; }
    }
};
struct EpiRes {
    static constexpr bool PERM = false;
    const float* in_lat; const float* in_ctx; float* out_lat; float* out_ctx; const float* modl; int goff;
    __device__ __forceinline__ void operator()(const f32x4 (&acc)[2][2][4][2], const Unit& u, int wr, int wc, int fr, int fq) const {
        const bool lat = u.pm < T_LAT / BM; const int r = lat ? (u.pm >> 4) : 8;
        const size_t rbase = (size_t)(lat ? u.pm : u.pm - T_LAT / BM) * BM + wr * 64 + fr;
        const float* src = (lat ? in_lat : in_ctx); float* dst = (lat ? out_lat : out_ctx);
        const int col0 = u.pn * BM + wc * 32 + 4 * fq;
        f32x4 gv[2][2];
#pragma unroll
        for (int bj = 0; bj < 2; ++bj)
#pragma unroll
            for (int n = 0; n < 2; ++n) gv[bj][n] = *(const f32x4*)(modl + r * 6144 + goff + col0 + bj * HALF + n * 16);
#pragma unroll
        for (int ai = 0; ai < 2; ++ai)
#pragma unroll
            for (int m = 0; m < 4; ++m) { const size_t ro = (rbase + ai * HALF + m * 16) * 1024 + col0;
#pragma unroll
                for (int bj = 0; bj < 2; ++bj)
#pragma unroll
                    for (int n = 0; n < 2; ++n) { const f32x4 x = *(const f32x4*)(src + ro + bj * HALF + n * 16);
                        *(f32x4*)(dst + ro + bj * HALF + n * 16) = x + gv[bj][n] * acc[ai][bj][m][n]; } }
    }
};
struct EpiBf16I8 {
    static constexpr bool PERM = true;
    bf16_t* O; int ldc; const float* rsc; const float* csc;
    __device__ __forceinline__ void operator()(const f32x4 (&acc)[2][2][4][2], const Unit& u, int wr, int wc, int fr, int fq) const {
        const int row0 = u.pm * BM + wr * 64 + fr, col0 = u.pn * BM + wc * 32 + 8 * fq;
        f32x4 cs[2][2];
#pragma unroll
        for (int bj = 0; bj < 2; ++bj) { cs[bj][0] = *(const f32x4*)(csc + col0 + bj * HALF); cs[bj][1] = *(const f32x4*)(csc + col0 + bj * HALF + 4); }
        float rs8[8];
#pragma unroll
        for (int i = 0; i < 8; ++i) rs8[i] = rsc[row0 + (i >> 2) * HALF + (i & 3) * 16];
#pragma unroll
        for (int ai = 0; ai < 2; ++ai)
#pragma unroll
            for (int m = 0; m < 4; ++m) { bf16_t* rowp = O + (size_t)(row0 + ai * HALF + m * 16) * ldc + col0; const float rsv = rs8[ai * 4 + m];
#pragma unroll
                for (int bj = 0; bj < 2; ++bj) { float o[8];
#pragma unroll
                    for (int n = 0; n < 2; ++n)
#pragma unroll
                        for (int j = 0; j < 4; ++j) o[n * 4 + j] = (float)__float_as_int(acc[ai][bj][m][n][j]) * (rsv * cs[bj][n][j]);
                    u32x4 w; w[0] = pk2(o[0], o[1]); w[1] = pk2(o[2], o[3]); w[2] = pk2(o[4], o[5]); w[3] = pk2(o[6], o[7]);
                    *(u32x4*)(rowp + bj * HALF) = w; } }
    }
};
struct EpiWinRope {
    static constexpr bool PERM = true;
    bf16_t* PROJp; bf16_t* POSTp; const float* rsc; const float* csc; const float2* tab_ret; const float2* tab32;
    __device__ __forceinline__ void operator()(const f32x4 (&acc)[2][2][4][2], const Unit& u, int wr, int wc, int fr, int fq) const {
        const int row0 = u.pm * BM + wr * 64 + fr, col0 = u.pn * BM + wc * 32 + 8 * fq;
        float rs8[8];
#pragma unroll
        for (int i = 0; i < 8; ++i) rs8[i] = rsc[row0 + (i >> 2) * HALF + (i & 3) * 16];
#pragma unroll
        for (int bj = 0; bj < 2; ++bj) {
            const int c = col0 + bj * HALF;
            const f32x4 cs0 = *(const f32x4*)(csc + c), cs1 = *(const f32x4*)(csc + c + 4);
            int type = 0, hq = 0, dcol = c; float scl = 1.f;
            if (c >= 352 && c < 864) { type = 1; hq = (c - 352) & 63; dcol = PC_QB + (c - 352); }
            else if (c >= 864 && c < 992) { type = 1; hq = (c - 864) & 63; dcol = PC_KB + (c - 864); }
            else if (c >= PJ_RQ && c < PJ_RK) { type = 2; hq = (c - PJ_RQ) & 63; dcol = PC_RQ + (c - PJ_RQ); }
            else if (c >= PJ_RK && c < PJ_RV) { type = 2; hq = (c - PJ_RK) & 63; dcol = PC_RK + (c - PJ_RK); scl = 0.125f; }
            bf16_t* dbase = type ? POSTp + dcol : PROJp + dcol; const int dld = type ? POST_LD : PROJ_LD;
#pragma unroll
            for (int ai = 0; ai < 2; ++ai)
#pragma unroll
                for (int m = 0; m < 4; ++m) { const int row = row0 + ai * HALF + m * 16; const float rsv = rs8[ai * 4 + m];
                    float o[8];
#pragma unroll
                    for (int n = 0; n < 2; ++n)
#pragma unroll
                        for (int j = 0; j < 4; ++j) o[n * 4 + j] = (float)__float_as_int(acc[ai][bj][m][n][j]) * (rsv * (n ? cs1[j] : cs0[j]));
                    if (type != 0) {
                        if (row < T_LAT) { const int t = row & (SEQ - 1);
                            const float2* tb = type == 1 ? tab32 + ((hq & 32) ? (t & 63) : (t >> 6)) * 16 + ((hq & 31) >> 1) : tab_ret + t * 32 + (hq >> 1);
                            const float4 c0 = *(const float4*)tb, c1 = *(const float4*)(tb + 2);
                            const float cz[4] = {c0.x, c0.z, c1.x, c1.z}, sz[4] = {c0.y, c0.w, c1.y, c1.w};
#pragma unroll
                            for (int i = 0; i < 4; ++i) { const float x1 = o[2 * i], x2 = o[2 * i + 1]; o[2 * i] = x1 * cz[i] - x2 * sz[i]; o[2 * i + 1] = x2 * cz[i] + x1 * sz[i]; } }
#pragma unroll
                        for (int i = 0; i < 8; ++i) o[i] *= scl;
                    }
                    u32x4 w; w[0] = pk2(o[0], o[1]); w[1] = pk2(o[2], o[3]); w[2] = pk2(o[4], o[5]); w[3] = pk2(o[6], o[7]);
                    *(u32x4*)(dbase + (size_t)row * dld) = w; }
        }
    }
};
struct EpiBf16S {
    static constexpr bool PERM = true;
    bf16_t* O; int ldc; float sc;
    __device__ __forceinline__ void operator()(const f32x4 (&acc)[2][2][4][2], const Unit& u, int wr, int wc, int fr, int fq) const {
        const int row0 = u.pm * BM + wr * 64 + fr, col0 = u.pn * BM + wc * 32 + 8 * fq;
#pragma unroll
        for (int ai = 0; ai < 2; ++ai)
#pragma unroll
            for (int m = 0; m < 4; ++m) { bf16_t* rowp = O + (size_t)(row0 + ai * HALF + m * 16) * ldc + col0;
#pragma unroll
                for (int bj = 0; bj < 2; ++bj) { const f32x4 v0 = acc[ai][bj][m][0] * sc, v1 = acc[ai][bj][m][1] * sc;
                    u32x4 w; w[0] = pk2(v0[0], v0[1]); w[1] = pk2(v0[2], v0[3]); w[2] = pk2(v1[0], v1[1]); w[3] = pk2(v1[2], v1[3]);
                    *(u32x4*)(rowp + bj * HALF) = w; } }
    }
};
struct EpiPart {
    static constexpr bool PERM = false;
    float* PART;
    __device__ __forceinline__ void operator()(const f32x4 (&acc)[2][2][4][2], const Unit& u, int wr, int wc, int fr, int fq) const {
        float* tp = PART + (size_t)u.ri * 65536 + (wr * 64 + fr) * 256 + wc * 32 + 4 * fq;
#pragma unroll
        for (int ai = 0; ai < 2; ++ai)
#pragma unroll
            for (int m = 0; m < 4; ++m)
#pragma unroll
                for (int bj = 0; bj < 2; ++bj)
#pragma unroll
                    for (int n = 0; n < 2; ++n) *(f32x4*)(tp + (ai * HALF + m * 16) * 256 + bj * HALF + n * 16) = acc[ai][bj][m][n];
    }
};
__device__ __forceinline__ void moe_combine(bf16_t* YM, const float* PART, const PG8_LAS int* tab, int nN, float sc) {
    const int nTm = __builtin_amdgcn_readfirstlane(tab[16]), G = gridDim.x, U = nTm * nN, rem = U % G;
    if (!(rem > 0 && rem * MOE_WAYS <= G)) return;
    int tid_ = threadIdx.x; asm volatile("" : "+v"(tid_));
    const int umain = U - rem, wave = tid_ >> 6, lane = tid_ & 63;
    for (int task = blockIdx.x * 8 + wave; task < rem * 256; task += G * 8) {
        const int r = task >> 8, i = task & 255; int pm, pn; static_order_L(umain + r, nTm, nN, pm, pn);
        const float* pp = PART + (size_t)(r * MOE_WAYS) * 65536 + i * 256 + lane * 4;
        f32x4 s = *(const f32x4*)pp;
#pragma unroll
        for (int q = 1; q < MOE_WAYS; ++q) s = s + *(const f32x4*)(pp + q * 65536);
        s = s * sc;
        typedef unsigned u32x2v __attribute__((ext_vector_type(2))); u32x2v w = {pk2(s[0], s[1]), pk2(s[2], s[3])};
        *(u32x2v*)(YM + (size_t)(pm * BM + i) * 1024 + pn * BM + lane * 4) = w;
    }
}

template <class T, class = void> struct sched_i8 { static constexpr bool value = false; };
template <class T> struct sched_i8<T, decltype((void)T::I8)> { static constexpr bool value = T::I8; };
template <class T, class = void> struct sched_fp8 { static constexpr bool value = false; };
template <class T> struct sched_fp8<T, decltype((void)T::FP8)> { static constexpr bool value = T::FP8; };
template <class T, class = void> struct epi_has_post { static constexpr bool value = false; };
template <class T> struct epi_has_post<T, decltype((void)T::HAS_POST)> { static constexpr bool value = T::HAS_POST; };
template <class Epi, class Sched>
__device__ __forceinline__ void gemm_phase(PG8_LAS unsigned char* lds, const Sched& S, const Epi& E) {
    int tid_ = threadIdx.x; asm volatile("" : "+v"(tid_));
    const int tid = tid_, wid = __builtin_amdgcn_readfirstlane(tid >> 6), lane = tid & 63, wr = wid >> 2, wc = wid & 3, fr = lane & 15, fq = lane >> 4;
    const int K = S.K, nt = S.nt();
    int RA[2], CA[2]; unsigned voffB;
    { int R, C; stage_rc(tid * 16, R, C); const int Rb = Epi::PERM ? ((R & ~31) + perm32(R & 31)) : R;
      RA[0] = R; CA[0] = C; RA[1] = R + 64; CA[1] = C; voffB = (unsigned)(Rb * K + C) * 2u; }
    const unsigned incB = (unsigned)(64 * K * 2), incA = (unsigned)(64 * S.lda * 2);
    const unsigned kstep = (unsigned)(BK * 2);
    const unsigned hstepB = (unsigned)(HALF * K * 2);
    const auto rsA = __builtin_amdgcn_make_buffer_rsrc((void*)S.A, 0, 0x7fffffff, 0x00020000), rsB = __builtin_amdgcn_make_buffer_rsrc((void*)S.Bt, 0, 0x7fffffff, 0x00020000);
    const unsigned ldsw = (unsigned)wid * 1024u;
    const int aoff = lds_byte(wr * 64 + fr, fq * 8), boff = lds_byte(wc * 32 + fr, fq * 8);
#define PG8_SA(b, h) (((b) * 2 + (h)) * HTB)
#define PG8_SB(b, h) ((4 + (b) * 2 + (h)) * HTB)
  \

#define PG8_STAGE_B(bufoff, soff) do { _Pragma("unroll") for (int _i = 0; _i < 2; ++_i) \
        __builtin_amdgcn_raw_ptr_buffer_load_lds(rsB, (PG8_LAS void*)(lds + (bufoff) + ldsw + _i * 8192), 16, voffB, (soff) + _i * incB, 0, 0); } while (0)
#define PG8_STAGE_A(bufoff, soff, h) do { _Pragma("unroll") for (int _i = 0; _i < 2; ++_i) { \
        if constexpr (Sched::GATHER) __builtin_amdgcn_raw_ptr_buffer_load_lds(rsA, (PG8_LAS void*)(lds + (bufoff) + ldsw + _i * 8192), 16, vA[h][_i], (soff), 0, 0); \
        else __builtin_amdgcn_raw_ptr_buffer_load_lds(rsA, (PG8_LAS void*)(lds + (bufoff) + ldsw + _i * 8192), 16, vA[0][0], (soff) + ((h) * 2 + _i) * incA, 0, 0); } } while (0)
#define PG8_LDA(dst, b, h) do { _Pragma("unroll") for (int m = 0; m < 4; ++m) _Pragma("unroll") for (int k = 0; k < 2; ++k) dst[m][k] = *(const PG8_LAS bf16x8*)(lds + PG8_SA(b, h) + aoff + m * 2048 + k * 1024); } while (0)
#define PG8_LDB(dst, b, h) do { _Pragma("unroll") for (int n = 0; n < 2; ++n) _Pragma("unroll") for (int k = 0; k < 2; ++k) dst[n][k] = *(const PG8_LAS bf16x8*)(lds + PG8_SB(b, h) + boff + n * 2048 + k * 1024); } while (0)
#define PG8_CAT8(x, y) __builtin_shufflevector(__builtin_bit_cast(i32x4v, x), __builtin_bit_cast(i32x4v, y), 0, 1, 2, 3, 4, 5, 6, 7)
#define PG8_MMA(ai, bj, At, Bt) do { __builtin_amdgcn_s_setprio(1); _Pragma("unroll") for (int m = 0; m < 4; ++m) _Pragma("unroll") for (int n = 0; n < 2; ++n) { \
        if constexpr (sched_fp8<Sched>::value)   \
              \
              \
            asm volatile("v_mfma_f32_16x16x128_f8f6f4 %0, %1, %2, %0" : "+v"(acc[ai][bj][m][n]) : "v"(PG8_CAT8(Bt[n][0], Bt[n][1])), "v"(PG8_CAT8(At[m][0], At[m][1]))); \
        else if constexpr (sched_i8<Sched>::value) { _Pragma("unroll") for (int k = 0; k < 2; ++k)   \
            acc[ai][bj][m][n] = __builtin_bit_cast(f32x4, __builtin_amdgcn_mfma_i32_16x16x64_i8(__builtin_bit_cast(i32x4v, Bt[n][k]), __builtin_bit_cast(i32x4v, At[m][k]), __builtin_bit_cast(i32x4v, acc[ai][bj][m][n]), 0, 0, 0)); } \
        else { _Pragma("unroll") for (int k = 0; k < 2; ++k) acc[ai][bj][m][n] = __builtin_amdgcn_mfma_f32_16x16x32_bf16(Bt[n][k], At[m][k], acc[ai][bj][m][n], 0, 0, 0); } } __builtin_amdgcn_s_setprio(0); } while (0)
#define PG8_WAIT_V(n) asm volatile("s_waitcnt vmcnt(" #n ")" ::: "memory")
#define PG8_WAIT_L(n) asm volatile("s_waitcnt lgkmcnt(" #n ")" ::: "memory")
#define PG8_BAR __builtin_amdgcn_s_barrier()
#define PG8_SCHED __builtin_amdgcn_sched_barrier(0)
#define PG8_AOFFS(dst, U) do { _Pragma("unroll") for (int _h = 0; _h < 2; ++_h) _Pragma("unroll") for (int _i = 0; _i < 2; ++_i) dst[_h][_i] = S.a_off(U, _h * HALF + RA[_i], CA[_i]); } while (0)
    Unit cur, nxt; int ui = 0;
    if (!S.next(0, cur)) return;
    f32x4 acc[2][2][4][2];
#pragma unroll
    for (int a = 0; a < 2; ++a)
#pragma unroll
        for (int b = 0; b < 2; ++b)
#pragma unroll
            for (int m = 0; m < 4; ++m)
#pragma unroll
                for (int n = 0; n < 2; ++n) acc[a][b][m][n] = (f32x4){0.f, 0.f, 0.f, 0.f};
    bf16x8 At[4][2], B0[2][2], B1[2][2];
    unsigned vA[2][2], vN[2][2];
    PG8_AOFFS(vA, cur);
    unsigned cA = (unsigned)(S.a_base(cur) - (const char*)S.A), cB = (unsigned)(S.b_base(cur) - (const char*)S.Bt);
    PG8_STAGE_B(PG8_SB(0, 0), cB); PG8_STAGE_B(PG8_SB(0, 1), cB + hstepB); PG8_STAGE_A(PG8_SA(0, 0), cA, 0); PG8_STAGE_A(PG8_SA(0, 1), cA, 1);
    if (wr == 1) PG8_BAR;
    PG8_WAIT_V(2); PG8_BAR;
    PG8_STAGE_B(PG8_SB(1, 0), cB + kstep); PG8_STAGE_A(PG8_SA(1, 0), cA + kstep, 0); PG8_STAGE_B(PG8_SB(1, 1), cB + hstepB + kstep);
    PG8_WAIT_V(6); PG8_BAR;
    for (;;) {
        const bool has_next = S.next(ui + 1, nxt);
        const unsigned nA = has_next ? (unsigned)(S.a_base(nxt) - (const char*)S.A) : cA, nB = has_next ? (unsigned)(S.b_base(nxt) - (const char*)S.Bt) : cB;
        for (int t = 0; t < nt; t += 2) {
            const bool last = (t == nt - 2);
            const bool sw = Sched::GATHER && last && has_next;
            if constexpr (Sched::GATHER) { if (sw) { PG8_AOFFS(vN, nxt); } }
            const unsigned a1 = cA + (unsigned)(t + 1) * kstep;
            const unsigned a2 = last ? nA : cA + (unsigned)(t + 2) * kstep, b2 = last ? nB : cB + (unsigned)(t + 2) * kstep;
            const unsigned a3 = a2 + kstep, b3 = b2 + kstep;
            PG8_LDB(B0, 0, 0); PG8_LDB(B1, 0, 1); PG8_SCHED; PG8_LDA(At, 0, 0); PG8_STAGE_A(PG8_SA(1, 1), a1, 1);
            if constexpr (Sched::GATHER) { if (sw) {
#pragma unroll
                for (int _h = 0; _h < 2; ++_h)
#pragma unroll
                    for (int _i = 0; _i < 2; ++_i) vA[_h][_i] = vN[_h][_i]; } }
            PG8_WAIT_V(8); PG8_WAIT_L(0); PG8_BAR; PG8_MMA(0, 0, At, B0); PG8_MMA(0, 1, At, B1); PG8_BAR; PG8_SCHED;
            PG8_LDA(At, 0, 1); PG8_STAGE_B(PG8_SB(0, 0), b2); PG8_STAGE_B(PG8_SB(0, 1), b2 + hstepB); PG8_STAGE_A(PG8_SA(0, 0), a2, 0);
            PG8_WAIT_V(8); PG8_WAIT_L(0); PG8_BAR; PG8_MMA(1, 0, At, B0); PG8_MMA(1, 1, At, B1); PG8_BAR; PG8_SCHED;
            PG8_LDB(B0, 1, 0); PG8_LDB(B1, 1, 1); PG8_SCHED; PG8_LDA(At, 1, 0); PG8_STAGE_A(PG8_SA(0, 1), a2, 1);
            PG8_WAIT_V(8); PG8_WAIT_L(0); PG8_BAR; PG8_MMA(0, 0, At, B0); PG8_MMA(0, 1, At, B1); PG8_BAR; PG8_SCHED;
            PG8_LDA(At, 1, 1); PG8_STAGE_B(PG8_SB(1, 0), b3); PG8_STAGE_B(PG8_SB(1, 1), b3 + hstepB); PG8_STAGE_A(PG8_SA(1, 0), a3, 0);
            PG8_WAIT_V(8); PG8_WAIT_L(0); PG8_BAR; PG8_MMA(1, 0, At, B0); PG8_MMA(1, 1, At, B1); PG8_BAR; PG8_SCHED;
        }
        if constexpr (sched_fp8<Sched>::value) asm volatile("s_nop 15\n\ts_nop 7" ::: "memory");
        if (wr == 0) PG8_BAR;
        { int te_ = threadIdx.x; asm volatile("" : "+v"(te_));
          E(acc, cur, wr, wc, te_ & 15, (te_ & 63) >> 4); }
        if constexpr (epi_has_post<Epi>::value) E.post(cur);
        if (!has_next) break;
#pragma unroll
        for (int a = 0; a < 2; ++a)
#pragma unroll
            for (int b = 0; b < 2; ++b)
#pragma unroll
                for (int m = 0; m < 4; ++m)
#pragma unroll
                    for (int n = 0; n < 2; ++n) acc[a][b][m][n] = (f32x4){0.f, 0.f, 0.f, 0.f};
        cur = nxt; cA = nA; cB = nB; ++ui;
        if (wr == 1) PG8_BAR;
    }
    PG8_WAIT_V(0);
    PG8_BAR;
#undef PG8_SA
#undef PG8_SB
#undef PG8_STAGE_A
#undef PG8_STAGE_B
#undef PG8_LDA
#undef PG8_LDB
#undef PG8_MMA
#undef PG8_CAT8
#undef PG8_WAIT_V
#undef PG8_WAIT_L
#undef PG8_BAR
#undef PG8_SCHED
#undef PG8_AOFFS
}
}

__device__ __forceinline__ float rope_inv(int i2, int dim) { return powf(10000.0f, -(float)i2 / (float)dim); }

__device__ __forceinline__ void ph_final(const P& p) {
    int tid_ = threadIdx.x; asm volatile("" : "+v"(tid_));
    const int wave = tid_ >> 6, lane = tid_ & 63;
    const float* gain = p.in[24];
    for (int row = blockIdx.x * 8 + wave; row < T_LAT; row += gridDim.x * 8) {
        float* src = p.out + (size_t)row * 1024;
        float4 v[4]; float ss = 0.f;
#pragma unroll
        for (int i = 0; i < 4; ++i) { v[i] = *(const float4*)(src + i * 256 + lane * 4); ss += v[i].x * v[i].x + v[i].y * v[i].y + v[i].z * v[i].z + v[i].w * v[i].w; }
        ss = wave_sum(ss);
        const float rs = rsqrtf(ss * (1.f / 1024.f) + NORM_EPS);
#pragma unroll
        for (int i = 0; i < 4; ++i) { const int col = i * 256 + lane * 4; const float4 g = *(const float4*)(gain + col);
            *(float4*)(src + col) = make_float4(v[i].x * rs * g.x, v[i].y * rs * g.y, v[i].z * rs * g.z, v[i].w * rs * g.w); }
    }
}


__device__ __forceinline__ void ph_final_moe(const P& p, const LAS int* tab0, const LAS int* tab1) {
    int tid_ = threadIdx.x; asm volatile("" : "+v"(tid_));
    const int wave = tid_ >> 6, lane = tid_ & 63;
    const float* gain = p.in[24];
    const bf16_t* YM0 = (const bf16_t*)(p.ws + OFF_YM); const bf16_t* YM1 = YM0 + (size_t)ACT_ROWS * 1024;
    const float* MODL = (const float*)(p.ws + OFF_MOD) + 9 * 6144 + 5120;
    int row = blockIdx.x * 8 + wave; const int stride = gridDim.x * 8;
    int4 ep = make_int4(0, 0, 0, 0), nep = ep; float2 ww = make_float2(0.f, 0.f), nww = ww;
    if (row < T_LAT) { const int* iv = (const int*)(p.ws + OFF_INV) + (size_t)row * 8; ep = *(const int4*)iv; ww = *(const float2*)(iv + 4); }
    for (; row < T_LAT; row += stride) {
        if (row + stride < T_LAT) { const int* iv = (const int*)(p.ws + OFF_INV) + (size_t)(row + stride) * 8; nep = *(const int4*)iv; nww = *(const float2*)(iv + 4); }
        const size_t r0 = (size_t)(tab0[8 + ep.x] * 256 + ep.y) * 1024, r1 = (size_t)(tab1[8 + ep.z] * 256 + ep.w) * 1024;
        float* src = p.out + (size_t)row * 1024;
        const float* gt = MODL + (row >> 12) * 6144;
        float4 v[4]; uint2 y0[4], y1[4]; float4 gg[4]; float ss = 0.f;
#pragma unroll
        for (int i = 0; i < 4; ++i) { const int col = i * 256 + lane * 4; v[i] = *(const float4*)(src + col); y0[i] = *(const uint2*)(YM0 + r0 + col); y1[i] = *(const uint2*)(YM1 + r1 + col); gg[i] = *(const float4*)(gt + col); }
#pragma unroll
        for (int i = 0; i < 4; ++i) {
            v[i].x += gg[i].x * (ww.x * __uint_as_float(y0[i].x << 16) + ww.y * __uint_as_float(y1[i].x << 16));
            v[i].y += gg[i].y * (ww.x * __uint_as_float(y0[i].x & 0xFFFF0000u) + ww.y * __uint_as_float(y1[i].x & 0xFFFF0000u));
            v[i].z += gg[i].z * (ww.x * __uint_as_float(y0[i].y << 16) + ww.y * __uint_as_float(y1[i].y << 16));
            v[i].w += gg[i].w * (ww.x * __uint_as_float(y0[i].y & 0xFFFF0000u) + ww.y * __uint_as_float(y1[i].y & 0xFFFF0000u));
            ss += v[i].x * v[i].x + v[i].y * v[i].y + v[i].z * v[i].z + v[i].w * v[i].w; }
        ss = wave_sum(ss);
        const float rs = rsqrtf(ss * (1.f / 1024.f) + NORM_EPS);
#pragma unroll
        for (int i = 0; i < 4; ++i) { const int col = i * 256 + lane * 4; const float4 g = *(const float4*)(gain + col);
            *(float4*)(src + col) = make_float4(v[i].x * rs * g.x, v[i].y * rs * g.y, v[i].z * rs * g.z, v[i].w * rs * g.w); }
        ep = nep; ww = nww;
    }
}
typedef short bf16x8_t __attribute__((ext_vector_type(8)));
typedef short s16x4_t __attribute__((ext_vector_type(4)));
typedef float f32x16_t __attribute__((ext_vector_type(16)));
typedef unsigned u32x4_t __attribute__((ext_vector_type(4)));
typedef float f32x4_t __attribute__((ext_vector_type(4)));
__device__ __forceinline__ s16x4_t lds_tr16(LAS const unsigned char* p) { typedef short v4i16_t __attribute__((ext_vector_type(4))); return __builtin_bit_cast(s16x4_t, __builtin_amdgcn_ds_read_tr16_b64_v4i16((LAS v4i16_t*)p)); }
__device__ __forceinline__ unsigned pkbf(float lo, float hi) { typedef float f32x2_t __attribute__((ext_vector_type(2))); typedef __bf16 bf16x2_t __attribute__((ext_vector_type(2)));
    f32x2_t v = {lo, hi}; bf16x2_t b = __builtin_convertvector(v, bf16x2_t); return __builtin_bit_cast(unsigned, b); }
__device__ __forceinline__ float max3f(float a, float b, float c) { return fmaxf(fmaxf(a, b), c); }

#define ATT_VP 192
#define ATT_THR 6.0f
template <int DQK, bool SWA, bool GQA = false>
__device__ __forceinline__ void attn_unit(LAS unsigned char* lds, const bf16_t* POST, const bf16_t* VBUF, int vld, bf16_t* MIX, int b, int q0, int qcol, int kcol, int vcol, int ocol,
                                          int band_lo, int band_hi, float sinkl2, float qscale, const float* sinkp, float sinkmul) {
    constexpr int KP = DQK * 2 + 16, NPK = DQK / 8, NKL = NPK / 4, STAGE = 128 * KP + 128 * ATT_VP, NS = DQK / 16;
    int tid_ = threadIdx.x; asm volatile("" : "+v"(tid_));
    const int tid = tid_, wid = __builtin_amdgcn_readfirstlane(tid >> 6), lane = tid & 63, r = lane & 31, h = lane >> 5;
    const int nb = (band_hi - band_lo) >> 7, ntiles = nb + 2;
    const int qw0 = GQA ? q0 + 32 * (wid & 1) : q0 + 32 * wid;
    const int qi = qw0 + r;
    const int qrow = tok_row(b, qi);
    if (GQA) { qcol += (wid >> 1) * 64; ocol += (wid >> 1) * 64; sinkl2 = sinkp[wid >> 1] * sinkmul; }
    bf16x8_t qf[NS];
    { const bf16_t* qp = POST + (size_t)qrow * POST_LD + qcol + 8 * h;
#pragma unroll
      for (int s = 0; s < NS; ++s) { float f[8]; unpack8(*(const uint4*)(qp + 16 * s), f);
          const unsigned w0 = pkbf(f[0] * qscale, f[1] * qscale), w1 = pkbf(f[2] * qscale, f[3] * qscale), w2 = pkbf(f[4] * qscale, f[5] * qscale), w3 = pkbf(f[6] * qscale, f[7] * qscale);
          qf[s] = __builtin_bit_cast(bf16x8_t, make_uint4(w0, w1, w2, w3)); } }
    f32x16_t O0, O1;
#pragma unroll
    for (int i = 0; i < 16; ++i) { O0[i] = 0.f; O1[i] = 0.f; }
    float m = SWA ? sinkl2 : -1e30f, l = 0.f;
    u32x4_t kreg[NKL], vreg[2];
    const int vrow = tid >> 3, vpc = tid & 7;
#define ATT_KS(t) ((t) < nb ? band_lo + 128 * (t) : SEQ + 128 * ((t) - nb))
#define ATT_LOAD(t) do { const int ks_ = ATT_KS(t); const bf16_t* base_ = POST + (size_t)tok_row(b, ks_) * POST_LD; \
        _Pragma("unroll") for (int i_ = 0; i_ < NKL; ++i_) { const int idx_ = tid + 512 * i_, row_ = idx_ / NPK, pc_ = idx_ % NPK; kreg[i_] = *(const u32x4_t*)(base_ + (size_t)row_ * POST_LD + kcol + pc_ * 8); } \
        const bf16_t* vbase_ = VBUF + (size_t)tok_row(b, ks_) * vld; \
        _Pragma("unroll") for (int i_ = 0; i_ < 2; ++i_) vreg[i_] = *(const u32x4_t*)(vbase_ + (size_t)(vrow + 64 * i_) * vld + vcol + vpc * 8); } while (0)
#define ATT_WRITE(buf) do { LAS unsigned char* kb_ = lds + (buf) * STAGE; LAS unsigned char* vb_ = kb_ + 128 * KP; \
        _Pragma("unroll") for (int i_ = 0; i_ < NKL; ++i_) { const int idx_ = tid + 512 * i_, row_ = idx_ / NPK, pc_ = idx_ % NPK; *(LAS u32x4_t*)(kb_ + row_ * KP + pc_ * 16) = kreg[i_]; } \
        _Pragma("unroll") for (int i_ = 0; i_ < 2; ++i_) *(LAS u32x4_t*)(vb_ + (vrow + 64 * i_) * ATT_VP + vpc * 16) = vreg[i_]; } while (0)
    const int koff = r * KP + 16 * h;
    const int voff = (4 * h + ((lane & 15) >> 2)) * ATT_VP + (16 * ((lane >> 4) & 1) + 4 * (lane & 3)) * 2;
    __syncthreads();
    ATT_LOAD(0); ATT_WRITE(0);
    __syncthreads();
    for (int t = 0; t < ntiles; ++t) {
        if (t + 1 < ntiles) ATT_LOAD(t + 1);
        LAS const unsigned char* kb = lds + (t & 1) * STAGE; LAS const unsigned char* vb = kb + 128 * KP;
        const int ks = ATT_KS(t);
        bool skip[2] = {false, false}, need_mask[2] = {false, false};
        if (SWA && t < nb) {
#pragma unroll
            for (int sub = 0; sub < 2; ++sub) { const int kb0 = ks + sub * 64, qlo = qw0, qhi = qlo + 31;
                skip[sub] = (kb0 > qhi + 128) || (kb0 + 63 < qlo - 128);
                need_mask[sub] = !((kb0 >= qhi - 128) && (kb0 + 63 <= qlo + 128)); }
        }
        f32x16_t S[4];
#pragma unroll
        for (int blk = 0; blk < 4; ++blk)
#pragma unroll
            for (int i = 0; i < 16; ++i) S[blk][i] = 0.f;
#pragma unroll
        for (int sub = 0; sub < 2; ++sub) {
            if (!skip[sub]) {
#pragma unroll
                for (int s = 0; s < NS; ++s) {
                    const bf16x8_t k0 = *(LAS const bf16x8_t*)(kb + (sub * 64) * KP + koff + 32 * s), k1 = *(LAS const bf16x8_t*)(kb + (sub * 64 + 32) * KP + koff + 32 * s);
                    S[2 * sub] = __builtin_amdgcn_mfma_f32_32x32x16_bf16(k0, qf[s], S[2 * sub], 0, 0, 0);
                    S[2 * sub + 1] = __builtin_amdgcn_mfma_f32_32x32x16_bf16(k1, qf[s], S[2 * sub + 1], 0, 0, 0);
                }
            }
        }
#pragma unroll
        for (int sub = 0; sub < 2; ++sub) {
            if (!skip[sub]) {
                const int kb0 = ks + sub * 64;
                f32x16_t& S0 = S[2 * sub]; f32x16_t& S1 = S[2 * sub + 1];
                bf16x8_t va[8];
#pragma unroll
                for (int g = 0; g < 4; ++g) { LAS const unsigned char* vp = vb + (sub * 64 + 16 * g) * ATT_VP + voff;
                    const s16x4_t l0 = lds_tr16(vp), h0 = lds_tr16(vp + 8 * ATT_VP), l1 = lds_tr16(vp + 64), h1 = lds_tr16(vp + 8 * ATT_VP + 64);
                    va[2 * g] = __builtin_shufflevector(l0, h0, 0, 1, 2, 3, 4, 5, 6, 7); va[2 * g + 1] = __builtin_shufflevector(l1, h1, 0, 1, 2, 3, 4, 5, 6, 7); }
                if (SWA && need_mask[sub]) {
#pragma unroll
                    for (int i = 0; i < 16; ++i) { const int d0 = kb0 + (i & 3) + 8 * (i >> 2) + 4 * h - qi, d1 = d0 + 32;
                        if (d0 > 128 || d0 < -128) S0[i] = -1e30f;
                        if (d1 > 128 || d1 < -128) S1[i] = -1e30f; }
                }
                float mx = max3f(S0[0], S0[1], S1[0]), mx2 = max3f(S0[2], S0[3], S1[1]);
                mx = max3f(mx, S1[2], S1[3]);
#pragma unroll
                for (int i = 4; i < 16; i += 4) { mx = max3f(mx, S0[i], S0[i + 1]); mx2 = max3f(mx2, S0[i + 2], S0[i + 3]); mx = max3f(mx, S1[i], S1[i + 1]); mx2 = max3f(mx2, S1[i + 2], S1[i + 3]); }
                mx = fmaxf(mx, mx2);
                { const auto rr_ = __builtin_amdgcn_permlane32_swap(__float_as_uint(mx), __float_as_uint(mx), false, false); mx = fmaxf(__uint_as_float(rr_[0]), __uint_as_float(rr_[1])); }
                if (__any(mx > m + ATT_THR)) {
                    const float mn = fmaxf(m, mx), al = __builtin_amdgcn_exp2f(m - mn);
                    m = mn; l *= al;
#pragma unroll
                    for (int i = 0; i < 16; ++i) { O0[i] *= al; O1[i] *= al; }
                }
                typedef float f32x2_t __attribute__((ext_vector_type(2)));
                const f32x2_t m2 = {m, m}; f32x2_t ps2 = {0.f, 0.f};
#pragma unroll
                for (int i = 0; i < 16; i += 2) {
                    f32x2_t a = (f32x2_t){S0[i], S0[i + 1]} - m2, c = (f32x2_t){S1[i], S1[i + 1]} - m2;
                    a[0] = __builtin_amdgcn_exp2f(a[0]); a[1] = __builtin_amdgcn_exp2f(a[1]); c[0] = __builtin_amdgcn_exp2f(c[0]); c[1] = __builtin_amdgcn_exp2f(c[1]);
                    S0[i] = a[0]; S0[i + 1] = a[1]; S1[i] = c[0]; S1[i + 1] = c[1];
                    ps2 += a; ps2 += c;
                }
                l += ps2[0] + ps2[1];
#pragma unroll
                for (int g = 0; g < 4; ++g) { const f32x16_t& Sx = (g >> 1) ? S1 : S0; const int o8 = 8 * (g & 1);
                    const bf16x8_t pf = __builtin_bit_cast(bf16x8_t, make_uint4(pkbf(Sx[o8 + 0], Sx[o8 + 1]), pkbf(Sx[o8 + 2], Sx[o8 + 3]), pkbf(Sx[o8 + 4], Sx[o8 + 5]), pkbf(Sx[o8 + 6], Sx[o8 + 7])));
                    O0 = __builtin_amdgcn_mfma_f32_32x32x16_bf16(va[2 * g], pf, O0, 0, 0, 0);
                    O1 = __builtin_amdgcn_mfma_f32_32x32x16_bf16(va[2 * g + 1], pf, O1, 0, 0, 0);
                }
            }
        }
        if (t + 1 < ntiles) ATT_WRITE((t + 1) & 1);
        __syncthreads();
    }
#undef ATT_LOAD
#undef ATT_KS
#undef ATT_WRITE
    float lt = l + __shfl_xor(l, 32);
    if (SWA) lt += __builtin_amdgcn_exp2f(sinkl2 - m);
    const float inv = 1.f / lt;
    bf16_t* op = MIX + (size_t)qrow * 1024 + ocol + 4 * h;
#pragma unroll
    for (int g = 0; g < 4; ++g) {
        *(uint2*)(op + 8 * g) = make_uint2(pkbf(O0[4 * g] * inv, O0[4 * g + 1] * inv), pkbf(O0[4 * g + 2] * inv, O0[4 * g + 3] * inv));
        *(uint2*)(op + 32 + 8 * g) = make_uint2(pkbf(O1[4 * g] * inv, O1[4 * g + 1] * inv), pkbf(O1[4 * g + 2] * inv, O1[4 * g + 3] * inv));
    }
}


typedef int i32x8_t __attribute__((ext_vector_type(8)));
typedef int i32x4_t __attribute__((ext_vector_type(4)));
#define A8_KP 144
__device__ __forceinline__ i32x8_t lds_frag32(LAS const unsigned char* p) { const i32x4_t lo = *(LAS const i32x4_t*)p, hi = *(LAS const i32x4_t*)(p + 16); return __builtin_shufflevector(lo, hi, 0, 1, 2, 3, 4, 5, 6, 7); }
__device__ __forceinline__ int cvt4_f8(float a, float b, float c, float d) { return __builtin_amdgcn_cvt_pk_fp8_f32(c, d, __builtin_amdgcn_cvt_pk_fp8_f32(a, b, 0, false), true); }
__device__ __forceinline__ void attn_unit_f8(LAS unsigned char* lds, const unsigned char* QK8, const unsigned char* V8T, bf16_t* MIX, int b, int q0, int head, int band_lo, int band_hi, float qscale) {
    constexpr int STAGE = 128 * A8_KP + 64 * A8_KP;
    int tid_ = threadIdx.x; asm volatile("" : "+v"(tid_));
    const int tid = tid_, wid = __builtin_amdgcn_readfirstlane(tid >> 6), lane = tid & 63, r = lane & 31, h = lane >> 5;
    const int nb = (band_hi - band_lo) >> 7, ntiles = nb + 2;
    const int qi = q0 + 32 * wid + r, qrow = tok_row(b, qi);
    i32x8_t qf[2];
    { const unsigned char* qp = QK8 + (size_t)qrow * 1024 + head * 128 + 32 * h;
#pragma unroll
      for (int s = 0; s < 2; ++s) { const i32x4_t lo = *(const i32x4_t*)(qp + 64 * s), hi = *(const i32x4_t*)(qp + 64 * s + 16); qf[s] = __builtin_shufflevector(lo, hi, 0, 1, 2, 3, 4, 5, 6, 7); } }
    f32x16_t O0, O1;
#pragma unroll
    for (int i = 0; i < 16; ++i) { O0[i] = 0.f; O1[i] = 0.f; }
    float m = -1e30f;
    f32x16_t Ls;
#pragma unroll
    for (int i = 0; i < 16; ++i) Ls[i] = 0.f;
    const i32x8_t ones8 = {0x38383838, 0x38383838, 0x38383838, 0x38383838, 0x38383838, 0x38383838, 0x38383838, 0x38383838};
    u32x4_t kreg[2], vreg;
    const unsigned char* vbase = V8T + (size_t)((b * 4 + head) * 64 + (tid >> 3)) * 4352 + (tid & 7) * 16;
#define A8_KS(t) ((t) < nb ? band_lo + 128 * (t) : SEQ + 128 * ((t) - nb))
#define A8_LOAD(t) do { const int ks_ = A8_KS(t); const unsigned char* base_ = QK8 + (size_t)tok_row(b, ks_) * 1024 + 512 + head * 128; \
        _Pragma("unroll") for (int i_ = 0; i_ < 2; ++i_) { const int idx_ = tid + 512 * i_; kreg[i_] = *(const u32x4_t*)(base_ + (size_t)(idx_ >> 3) * 1024 + (idx_ & 7) * 16); } \
        vreg = *(const u32x4_t*)(vbase + ks_); } while (0)
#define A8_WRITE(buf) do { LAS unsigned char* kb_ = lds + (buf) * STAGE; \
        _Pragma("unroll") for (int i_ = 0; i_ < 2; ++i_) { const int idx_ = tid + 512 * i_; *(LAS u32x4_t*)(kb_ + (idx_ >> 3) * A8_KP + (idx_ & 7) * 16) = kreg[i_]; } \
        *(LAS u32x4_t*)(kb_ + 128 * A8_KP + (tid >> 3) * A8_KP + (tid & 7) * 16) = vreg; } while (0)
    const int foff = r * A8_KP + 32 * h;
    __syncthreads();
    A8_LOAD(0); A8_WRITE(0);
    __syncthreads();
    typedef float f32x2_t __attribute__((ext_vector_type(2)));
    const f32x2_t qs2 = {qscale, qscale};
    for (int t = 0; t < ntiles; ++t) {
        if (t + 1 < ntiles) A8_LOAD(t + 1);
        LAS const unsigned char* kb = lds + (t & 1) * STAGE; LAS const unsigned char* vb = kb + 128 * A8_KP;
        f32x16_t S[4];
#pragma unroll
        for (int blk = 0; blk < 4; ++blk)
#pragma unroll
            for (int i = 0; i < 16; ++i) S[blk][i] = 0.f;
#pragma unroll
        for (int blk = 0; blk < 4; ++blk)
#pragma unroll
            for (int s = 0; s < 2; ++s) S[blk] = __builtin_amdgcn_mfma_scale_f32_32x32x64_f8f6f4(lds_frag32(kb + (blk * 32) * A8_KP + foff + 64 * s), qf[s], S[blk], 0, 0, 0, 0, 0, 0);
#pragma unroll
        for (int sub = 0; sub < 2; ++sub) {
            f32x16_t& S0 = S[2 * sub]; f32x16_t& S1 = S[2 * sub + 1];
            const i32x8_t va0 = lds_frag32(vb + foff + 64 * sub), va1 = lds_frag32(vb + 32 * A8_KP + foff + 64 * sub);
            float mx = max3f(S0[0], S0[1], S1[0]), mx2 = max3f(S0[2], S0[3], S1[1]);
            mx = max3f(mx, S1[2], S1[3]);
#pragma unroll
            for (int i = 4; i < 16; i += 4) { mx = max3f(mx, S0[i], S0[i + 1]); mx2 = max3f(mx2, S0[i + 2], S0[i + 3]); mx = max3f(mx, S1[i], S1[i + 1]); mx2 = max3f(mx2, S1[i + 2], S1[i + 3]); }
            mx = fmaxf(mx, mx2);
            { const auto rr_ = __builtin_amdgcn_permlane32_swap(__float_as_uint(mx), __float_as_uint(mx), false, false); mx = fmaxf(__uint_as_float(rr_[0]), __uint_as_float(rr_[1])); }
            mx *= qscale;
            if (__any(mx > m + ATT_THR)) {
                const float mn = fmaxf(m, mx), al = __builtin_amdgcn_exp2f(m - mn);
                m = mn; Ls[0] *= al;
#pragma unroll
                for (int i = 0; i < 16; ++i) { O0[i] *= al; O1[i] *= al; }
            }
            const f32x2_t m2 = {-m, -m};
#pragma unroll
            for (int i = 0; i < 16; i += 2) {
                f32x2_t a = (f32x2_t){S0[i], S0[i + 1]} * qs2 + m2, c = (f32x2_t){S1[i], S1[i + 1]} * qs2 + m2;
                a[0] = __builtin_amdgcn_exp2f(a[0]); a[1] = __builtin_amdgcn_exp2f(a[1]); c[0] = __builtin_amdgcn_exp2f(c[0]); c[1] = __builtin_amdgcn_exp2f(c[1]);
                S0[i] = a[0]; S0[i + 1] = a[1]; S1[i] = c[0]; S1[i + 1] = c[1];
            }
            i32x8_t pf;
#pragma unroll
            for (int w = 0; w < 4; ++w) { pf[w] = cvt4_f8(S0[4 * w], S0[4 * w + 1], S0[4 * w + 2], S0[4 * w + 3]); pf[4 + w] = cvt4_f8(S1[4 * w], S1[4 * w + 1], S1[4 * w + 2], S1[4 * w + 3]); }
            O0 = __builtin_amdgcn_mfma_scale_f32_32x32x64_f8f6f4(va0, pf, O0, 0, 0, 0, 0, 0, 0);
            O1 = __builtin_amdgcn_mfma_scale_f32_32x32x64_f8f6f4(va1, pf, O1, 0, 0, 0, 0, 0, 0);
            Ls = __builtin_amdgcn_mfma_scale_f32_32x32x64_f8f6f4(ones8, pf, Ls, 0, 0, 0, 0, 0, 0);
        }
        if (t + 1 < ntiles) A8_WRITE((t + 1) & 1);
        __syncthreads();
    }
#undef A8_LOAD
#undef A8_KS
#undef A8_WRITE
    const float inv = 1.f / Ls[0];
    bf16_t* op = MIX + (size_t)qrow * 1024 + head * 64 + 4 * h;
#pragma unroll
    for (int g = 0; g < 4; ++g) {
        *(uint2*)(op + 8 * g) = make_uint2(pkbf(O0[4 * g] * inv, O0[4 * g + 1] * inv), pkbf(O0[4 * g + 2] * inv, O0[4 * g + 3] * inv));
        *(uint2*)(op + 32 + 8 * g) = make_uint2(pkbf(O1[4 * g] * inv, O1[4 * g + 1] * inv), pkbf(O1[4 * g + 2] * inv, O1[4 * g + 3] * inv));
    }
}
__device__ __forceinline__ float log2_sigmoid(float x) { return log2f(1.f / (1.f + expf(-x))); }

__device__ __forceinline__ void ph_ret_T(const P& p, int layer, LAS unsigned char* lds) {
    const bf16_t* POST = (const bf16_t*)(p.ws + OFF_POST); const bf16_t* PROJB = (const bf16_t*)(p.ws + OFF_PROJ);
    bf16_t* TT = (bf16_t*)(p.ws + OFF_TT);
    int tid_ = threadIdx.x; asm volatile("" : "+v"(tid_));
    const int tid = tid_, wid = __builtin_amdgcn_readfirstlane(tid >> 6), lane = tid & 63, h2 = lane >> 5;
    const int G = gridDim.x, bid = blockIdx.x;
    const int trq = (lane & 15) >> 2, trc = (16 * ((lane >> 4) & 1) + 4 * (lane & 3)) * 2;
    for (int u = bid; u < BATCH * 34 * 2; u += G) {
        const int hp = u & 1, c = (u >> 1) % 34, b = u / 68;
        const int row0 = c < 32 ? b * SEQ + c * 128 : T_LAT + b * CTXL + (c - 32) * 128;
        __syncthreads();
#pragma unroll
        for (int i = 0; i < 8; ++i) {
            const int idx = tid + 512 * i, arr = idx >> 10, rem = idx & 1023, row = rem >> 3, pc = rem & 7;
            const u32x4_t v = arr < 2 ? *(const u32x4_t*)(POST + (size_t)(row0 + row) * POST_LD + PC_RK + (2 * hp + (arr & 1)) * 64 + pc * 8)
                                      : *(const u32x4_t*)(PROJB + (size_t)(row0 + row) * PROJ_LD + PJ_RV + (2 * hp + (arr & 1)) * 64 + pc * 8);
            *(LAS u32x4_t*)(lds + arr * 24576 + row * 192 + pc * 16) = v;
        }
        __syncthreads();
        const int hh = wid >> 2, head = 2 * hp + hh, dir = (wid >> 1) & 1, dvb = wid & 1;
        const float lg = log2_sigmoid(dir ? p.in[15][layer * 4 + head] : p.in[14][layer * 4 + head]);
        f32x16_t acc0, acc1;
#pragma unroll
        for (int i = 0; i < 16; ++i) { acc0[i] = 0.f; acc1[i] = 0.f; }
        LAS const unsigned char* kt = lds + hh * 24576; LAS const unsigned char* vt = lds + (2 + hh) * 24576;
#pragma unroll
        for (int s = 0; s < 8; ++s) {
            const int kr = 16 * s + 8 * h2;
            LAS const unsigned char* vp = vt + (kr + trq) * 192 + dvb * 64 + trc;
            const s16x4_t vlo = lds_tr16(vp), vhi = lds_tr16(vp + 4 * 192);
            const bf16x8_t a = {vlo[0], vlo[1], vlo[2], vlo[3], vhi[0], vhi[1], vhi[2], vhi[3]};
            float w[8];
#pragma unroll
            for (int j = 0; j < 8; ++j) w[j] = __builtin_amdgcn_exp2f(lg * (float)(dir ? (kr + j) : (127 - kr - j)));
#pragma unroll
            for (int dkb = 0; dkb < 2; ++dkb) {
                LAS const unsigned char* kp = kt + (kr + trq) * 192 + dkb * 64 + trc;
                const s16x4_t klo = lds_tr16(kp), khi = lds_tr16(kp + 4 * 192);
                float f[8];
#pragma unroll
                for (int j = 0; j < 4; ++j) { f[j] = bf2f((bf16_t)klo[j]) * w[j]; f[4 + j] = bf2f((bf16_t)khi[j]) * w[4 + j]; }
                const bf16x8_t bb = __builtin_bit_cast(bf16x8_t, make_uint4(pkbf(f[0], f[1]), pkbf(f[2], f[3]), pkbf(f[4], f[5]), pkbf(f[6], f[7])));
                if (dkb == 0) acc0 = __builtin_amdgcn_mfma_f32_32x32x16_bf16(a, bb, acc0, 0, 0, 0);
                else acc1 = __builtin_amdgcn_mfma_f32_32x32x16_bf16(a, bb, acc1, 0, 0, 0);
            }
        }
        bf16_t* tp = TT + ((((size_t)(b * 4 + head) * 34 + c) * 2 + dir) * 4096) + (lane & 31);
#pragma unroll
        for (int i = 0; i < 16; ++i) { const int dv = 32 * dvb + (i & 3) + 8 * (i >> 2) + 4 * h2; tp[dv * 64] = f2bf(acc0[i]); tp[dv * 64 + 32] = f2bf(acc1[i]); }
    }
}

__device__ __forceinline__ void ret_unit(LAS unsigned char* lds, const P& p, int layer, int b, int c, int hp) {
    const bf16_t* POST = (const bf16_t*)(p.ws + OFF_POST); const bf16_t* PROJB = (const bf16_t*)(p.ws + OFF_PROJ);
    bf16_t* MIX = (bf16_t*)(p.ws + OFF_H);
    const bf16_t* TT = (const bf16_t*)(p.ws + OFF_TT);
    int tid_ = threadIdx.x; asm volatile("" : "+v"(tid_));
    const int tid = tid_, wid = __builtin_amdgcn_readfirstlane(tid >> 6), lane = tid & 63, r = lane & 31, h2 = lane >> 5;
    const bool isctx = c >= 32;
    const int row0 = !isctx ? b * SEQ + c * 128 : T_LAT + b * CTXL + (c - 32) * 128;
    constexpr int L_ST = 0, L_K = 36864, L_V = 73728;
    __syncthreads();
#pragma unroll
    for (int i = 0; i < 8; ++i) {
        const int idx = tid + 512 * i, arr = idx >> 10, rem = idx & 1023, row = rem >> 3, pc = rem & 7;
        const u32x4_t v = arr < 2 ? *(const u32x4_t*)(POST + (size_t)(row0 + row) * POST_LD + PC_RK + (2 * hp + (arr & 1)) * 64 + pc * 8)
                                      : *(const u32x4_t*)(PROJB + (size_t)(row0 + row) * PROJ_LD + PJ_RV + (2 * hp + (arr & 1)) * 64 + pc * 8);
        if (arr < 2) *(LAS u32x4_t*)(lds + L_K + (arr & 1) * 18432 + row * 144 + pc * 16) = v;
        else *(LAS u32x4_t*)(lds + L_V + (arr & 1) * 24576 + row * 192 + pc * 16) = v;
    }
    {
        const int hd = tid >> 7, hh = hd >> 1, dir = hd & 1, head = 2 * hp + hh;
        const float g128 = 128.f * log2_sigmoid(dir ? p.in[15][layer * 4 + head] : p.in[14][layer * 4 + head]);
        const bf16_t* tb = TT + (size_t)(b * 4 + head) * 34 * 2 * 4096 + dir * 4096 + (tid & 127) * 4;
        f32x4_t acc[8];
#pragma unroll
        for (int i = 0; i < 8; ++i) acc[i] = (f32x4_t){0.f, 0.f, 0.f, 0.f};
        int v0, v1;
        if (!isctx) { if (dir == 0) { v0 = -2; v1 = c - 1; } else { v0 = c + 1; v1 = 33; } }
        else { const int cc = c - 32; if (dir == 0) { v0 = -2; v1 = cc - 3; } else { v0 = 33 + cc; v1 = 33; } }
        for (int v = v0; v <= v1; ++v) {
            const int idxT = v < 0 ? 34 + v : v;
            const float coef = __builtin_amdgcn_exp2f(g128 * (float)(dir == 0 ? (v1 - v) : (v - v0)));
            const bf16_t* tp = tb + (size_t)idxT * 2 * 4096;
#pragma unroll
            for (int i = 0; i < 8; ++i) { const uint2 r_ = *(const uint2*)(tp + 512 * i);
                const f32x4_t x = {__uint_as_float(r_.x << 16), __uint_as_float(r_.x & 0xFFFF0000u), __uint_as_float(r_.y << 16), __uint_as_float(r_.y & 0xFFFF0000u)}; acc[i] += x * coef; }
        }
#pragma unroll
        for (int i = 0; i < 8; ++i) { const int e = (tid & 127) * 4 + 512 * i, dv = e >> 6, dk = e & 63;
            typedef unsigned u32x2_t __attribute__((ext_vector_type(2))); *(LAS u32x2_t*)(lds + L_ST + hd * 9216 + dv * 144 + dk * 2) = (u32x2_t){pkbf(acc[i][0], acc[i][1]), pkbf(acc[i][2], acc[i][3])}; }
    }
    __syncthreads();
    const int hh = wid >> 2, head = 2 * hp + hh, qb = wid & 3, qi = 32 * qb + r;
    const int qrow = row0 + qi;
    const float lgf = log2_sigmoid(p.in[14][layer * 4 + head]), lgb = log2_sigmoid(p.in[15][layer * 4 + head]);
    bf16x8_t qf[4];
    { const bf16_t* qp = POST + (size_t)qrow * POST_LD + PC_RQ + head * 64 + 8 * h2;
#pragma unroll
      for (int s = 0; s < 4; ++s) qf[s] = *(const bf16x8_t*)(qp + 16 * s); }
    f32x16_t O0, O1;
#pragma unroll
    for (int i = 0; i < 16; ++i) { O0[i] = 0.f; O1[i] = 0.f; }
    LAS const unsigned char* kt = lds + L_K + hh * 18432; LAS const unsigned char* vt = lds + L_V + hh * 24576;
    const int voff = (4 * h2 + ((lane & 15) >> 2)) * 192 + (16 * ((lane >> 4) & 1) + 4 * (lane & 3)) * 2;
#pragma unroll
    for (int blk = 0; blk < 4; ++blk) {
        f32x16_t S;
#pragma unroll
        for (int i = 0; i < 16; ++i) S[i] = 0.f;
#pragma unroll
        for (int s = 0; s < 4; ++s) { const bf16x8_t a = *(LAS const bf16x8_t*)(kt + (32 * blk + r) * 144 + 32 * s + 16 * h2); S = __builtin_amdgcn_mfma_f32_32x32x16_bf16(a, qf[s], S, 0, 0, 0); }
#pragma unroll
        for (int i = 0; i < 16; ++i) { const int d = qi - (32 * blk + (i & 3) + 8 * (i >> 2) + 4 * h2);
            const float w = d > 0 ? __builtin_amdgcn_exp2f(lgf * (float)d) : (d == 0 ? 2.f : __builtin_amdgcn_exp2f(lgb * (float)(-d)));
            S[i] *= w; }
#pragma unroll
        for (int s2 = 0; s2 < 2; ++s2) {
            const bf16x8_t pf = __builtin_bit_cast(bf16x8_t, make_uint4(pkbf(S[8 * s2 + 0], S[8 * s2 + 1]), pkbf(S[8 * s2 + 2], S[8 * s2 + 3]), pkbf(S[8 * s2 + 4], S[8 * s2 + 5]), pkbf(S[8 * s2 + 6], S[8 * s2 + 7])));
            LAS const unsigned char* vp = vt + (32 * blk + 16 * s2) * 192 + voff;
            const s16x4_t lo0 = lds_tr16(vp), hi0 = lds_tr16(vp + 8 * 192), lo1 = lds_tr16(vp + 64), hi1 = lds_tr16(vp + 8 * 192 + 64);
            const bf16x8_t a0 = {lo0[0], lo0[1], lo0[2], lo0[3], hi0[0], hi0[1], hi0[2], hi0[3]};
            const bf16x8_t a1 = {lo1[0], lo1[1], lo1[2], lo1[3], hi1[0], hi1[1], hi1[2], hi1[3]};
            O0 = __builtin_amdgcn_mfma_f32_32x32x16_bf16(a0, pf, O0, 0, 0, 0);
            O1 = __builtin_amdgcn_mfma_f32_32x32x16_bf16(a1, pf, O1, 0, 0, 0);
        }
    }
#pragma unroll
    for (int dir = 0; dir < 2; ++dir) {
        f32x16_t T0, T1;
#pragma unroll
        for (int i = 0; i < 16; ++i) { T0[i] = 0.f; T1[i] = 0.f; }
        LAS const unsigned char* st = lds + L_ST + (hh * 2 + dir) * 9216;
#pragma unroll
        for (int s = 0; s < 4; ++s) {
            const bf16x8_t a0 = *(LAS const bf16x8_t*)(st + r * 144 + 32 * s + 16 * h2), a1 = *(LAS const bf16x8_t*)(st + (32 + r) * 144 + 32 * s + 16 * h2);
            T0 = __builtin_amdgcn_mfma_f32_32x32x16_bf16(a0, qf[s], T0, 0, 0, 0);
            T1 = __builtin_amdgcn_mfma_f32_32x32x16_bf16(a1, qf[s], T1, 0, 0, 0);
        }
        const float coef = dir == 0 ? __builtin_amdgcn_exp2f(lgf * (float)(qi + 1)) : __builtin_amdgcn_exp2f(lgb * (float)(128 - qi));
#pragma unroll
        for (int i = 0; i < 16; ++i) { O0[i] += coef * T0[i]; O1[i] += coef * T1[i]; }
    }
    float ss = 0.f;
#pragma unroll
    for (int i = 0; i < 16; ++i) ss += O0[i] * O0[i] + O1[i] * O1[i];
    ss += __shfl_xor(ss, 32);
    const float rs = rsqrtf(ss * (1.f / 64.f) + NORM_EPS);
    const bf16_t* gp = PROJB + (size_t)qrow * PROJ_LD + PJ_RG + head * 64 + 4 * h2;
    bf16_t* op = MIX + (size_t)qrow * 1024 + 768 + head * 64 + 4 * h2;
#pragma unroll
    for (int g = 0; g < 4; ++g) {
        const uint2 g0 = *(const uint2*)(gp + 8 * g), g1 = *(const uint2*)(gp + 32 + 8 * g);
        float gv[8] = {__uint_as_float(g0.x << 16), __uint_as_float(g0.x & 0xFFFF0000u), __uint_as_float(g0.y << 16), __uint_as_float(g0.y & 0xFFFF0000u),
                       __uint_as_float(g1.x << 16), __uint_as_float(g1.x & 0xFFFF0000u), __uint_as_float(g1.y << 16), __uint_as_float(g1.y & 0xFFFF0000u)};
        float o[8];
#pragma unroll
        for (int j = 0; j < 4; ++j) { o[j] = O0[4 * g + j] * rs * silu_f(gv[j]); o[4 + j] = O1[4 * g + j] * rs * silu_f(gv[4 + j]); }
        *(uint2*)(op + 8 * g) = make_uint2(pkbf(o[0], o[1]), pkbf(o[2], o[3]));
        *(uint2*)(op + 32 + 8 * g) = make_uint2(pkbf(o[4], o[5]), pkbf(o[6], o[7]));
    }
}

__device__ __forceinline__ void ph_mixer_mfma(const P& p, int layer, bool ctxq, LAS unsigned char* lds) {
    const bf16_t* POST = (const bf16_t*)(p.ws + OFF_POST); const bf16_t* PROJB = (const bf16_t*)(p.ws + OFF_PROJ);
    bf16_t* MIX = (bf16_t*)(p.ws + OFF_H);
    const int G = gridDim.x, bid = blockIdx.x;
    const float L2E = 1.4426950408889634f;
    const int n_mla = BATCH * 4 * 16, n_swa = BATCH * 8 * 16, n_mlac = ctxq ? BATCH * 4 : 0, n_swac = ctxq ? BATCH * 8 : 0;
    const int n_ret = BATCH * 32 * 2, n_retc = ctxq ? BATCH * 2 * 2 : 0;
    const int total = n_mla + n_swa + n_mlac + n_swac + n_ret + n_retc;
    const int nmine = (total - bid + G - 1) / G;
    for (int k = 0; k < nmine; ++k) { const int u = bid + ((bid & 1) ? (nmine - 1 - k) : k) * G;
        if (u < n_mla) {
            const int qb = u & 15, h = (u >> 4) & 3, b = u >> 6;
            attn_unit_f8(lds, p.ws + OFF_QK8, p.ws + OFF_V8T, MIX, b, qb * 256, h, 0, SEQ, 0.10206207261596575f * L2E);
        } else if (u < n_mla + n_swa) {
            const int v = u - n_mla, qb = v & 63, kvh = (v >> 6) & 1, b = v >> 7;
            const int q0 = qb * 64; int lo = (q0 - 128) & ~127; lo = lo < 0 ? 0 : lo; int hi = (q0 + 192 + 127) & ~127; hi = hi > SEQ ? SEQ : hi;
            attn_unit<64, true, true>(lds, POST, PROJB, PROJ_LD, MIX, b, q0, PC_QB + kvh * 256, PC_KB + kvh * 64, 992 + kvh * 64, 256 + kvh * 256, lo, hi, 0.f, 0.125f * L2E, p.in[13] + layer * 8 + kvh * 4, L2E);
        } else if (u < n_mla + n_swa + n_mlac) {
            const int v = u - n_mla - n_swa, h = v & 3, b = v >> 2;
            attn_unit_f8(lds, p.ws + OFF_QK8, p.ws + OFF_V8T, MIX, b, SEQ, h, 0, 0, 0.10206207261596575f * L2E);
        } else if (u < n_mla + n_swa + n_mlac + n_swac) {
            const int v = u - n_mla - n_swa - n_mlac, qb = v & 3, kvh = (v >> 2) & 1, b = v >> 3;
            attn_unit<64, true, true>(lds, POST, PROJB, PROJ_LD, MIX, b, SEQ + qb * 64, PC_QB + kvh * 256, PC_KB + kvh * 64, 992 + kvh * 64, 256 + kvh * 256, 0, 0, 0.f, 0.125f * L2E, p.in[13] + layer * 8 + kvh * 4, L2E);
        } else if (u < n_mla + n_swa + n_mlac + n_swac + n_ret) {
            const int v = u - n_mla - n_swa - n_mlac - n_swac;
            ret_unit(lds, p, layer, v >> 6, (v >> 1) & 31, v & 1);
        } else {
            const int v = u - n_mla - n_swa - n_mlac - n_swac - n_ret;
            ret_unit(lds, p, layer, v >> 2, 32 + ((v >> 1) & 1), v & 1);
        }
    }
}

__device__ __forceinline__ void ph_tables(const P& p) {
    float2* tr = (float2*)(p.ws + OFF_TAB); float2* t32 = tr + 4096 * 32; float2* t16 = t32 + 64 * 16;
    const int n = 4096 * 32 + 64 * 16 + 64 * 8;
    for (int i = blockIdx.x * NT + threadIdx.x; i < n; i += gridDim.x * NT) {
        float ang;
        if (i < 4096 * 32) ang = (float)(i >> 5) * rope_inv(2 * (i & 31), 64);
        else if (i < 4096 * 32 + 64 * 16) { const int j = i - 4096 * 32; ang = (float)(j >> 4) * rope_inv(2 * (j & 15), 32); }
        else { const int j = i - 4096 * 32 - 64 * 16; ang = (float)(j >> 3) * rope_inv(2 * (j & 7), 16); }
        tr[i] = make_float2(cosf(ang), sinf(ang));
    }
}

__device__ __forceinline__ void ph_prep2(const P& p, int layer, LAS unsigned char* lds) {
    const bf16_t* PROJ = (const bf16_t*)(p.ws + OFF_PROJ);
    bf16_t* POST = (bf16_t*)(p.ws + OFF_POST);
    unsigned char* QK8 = p.ws + OFF_QK8; unsigned char* V8T = p.ws + OFF_V8T;
#define CVT4_F8(a_, b_, c_, d_) __builtin_amdgcn_cvt_pk_fp8_f32(f8clamp(c_), f8clamp(d_), __builtin_amdgcn_cvt_pk_fp8_f32(f8clamp(a_), f8clamp(b_), 0, false), true)
    const bf16_t* WUQ = (const bf16_t*)(p.ws + OFF_WUQ) + (size_t)layer * 384 * 192;
    const bf16_t* WUKV = (const bf16_t*)(p.ws + OFF_WUKV) + (size_t)layer * 512 * 128;
    const float* qn = p.in[9] + layer * 192; const float* kvn = p.in[11] + layer * 128;
    const float2* tab_ret = (const float2*)(p.ws + OFF_TAB); const float2* tab32 = tab_ret + 4096 * 32; const float2* tab16 = tab32 + 64 * 16;
    int tid_ = threadIdx.x; asm volatile("" : "+v"(tid_));
    const int tid = tid_, wid = __builtin_amdgcn_readfirstlane(tid >> 6), lane = tid & 63, fr = lane & 15, fq = lane >> 4;
    constexpr int QP = 400, KVP = 272, L_CQ = 0, L_CKV = 32 * QP;
    constexpr int SQP = 1040, L_SQ = L_CKV + 32 * KVP, L_SV = L_SQ + 32 * SQP;
#define PREP_LOADS(RA, RB, RC, RK, P1, P2, UNIT) do { const int R0_ = (UNIT) * 32; int tidA = tid; asm volatile("" : "+v"(tidA)); const int tk_ = tidA >> 4, sub_ = tidA & 15; \
        { const bf16_t* pr_ = PROJ + (size_t)(R0_ + tk_) * PROJ_LD; RA = *(const uint2*)(pr_ + sub_ * 12); RB = *(const uint2*)(pr_ + sub_ * 12 + 4); RC = *(const uint2*)(pr_ + sub_ * 12 + 8); RK = *(const u32x4_t*)(pr_ + 192 + sub_ * 8); } \
        _Pragma("unroll") for (int it_ = 0; it_ < 1; ++it_) { const int w_ = it_ * NT + tidA;   \
            if (w_ < 32 * 2) { const int tok_ = w_ / 2, task_ = 72 + (w_ & 1); int src_, dist_; \
                if (task_ < 40) { const int hd_ = task_ >> 2, half_ = (task_ >> 1) & 1, cp_ = task_ & 1; src_ = (task_ < 32 ? 352 : 864 - 8 * 64) + hd_ * 64 + half_ * 32 + cp_ * 8; dist_ = 16; } \
                else if (task_ < 72) { const int q_ = task_ - 40, hd_ = q_ >> 2, cp_ = q_ & 3; src_ = (hd_ < 4 ? PJ_RQ + hd_ * 64 : PJ_RK + (hd_ - 4) * 64) + cp_ * 8; dist_ = 32; } \
                else { src_ = 320 + (task_ - 72) * 16; dist_ = 8; } \
                const bf16_t* pr_ = PROJ + (size_t)(R0_ + tok_) * PROJ_LD + src_; P1[it_] = *(const u32x4_t*)pr_; P2[it_] = *(const u32x4_t*)(pr_ + dist_); } \
            else { P1[it_] = (u32x4_t){0u, 0u, 0u, 0u}; P2[it_] = P1[it_]; } } } while (0)
    uint2 ra, rb, rc, na_, nb_, nc_; u32x4_t rk, nk_; u32x4_t p1[1], p2[1], n1[1], n2[1];
    if ((int)blockIdx.x < T_ALL / 32) PREP_LOADS(ra, rb, rc, rk, p1, p2, (int)blockIdx.x);
    for (int u = blockIdx.x; u < T_ALL / 32; u += gridDim.x) {
        const int R0 = u * 32; const bool isctx = R0 >= T_LAT;
        const int t0 = isctx ? (R0 - T_LAT) % CTXL : R0 % SEQ;
        const int tk = tid >> 4, sub = tid & 15;
        const bool has_next = u + (int)gridDim.x < T_ALL / 32;
        if (has_next) PREP_LOADS(na_, nb_, nc_, nk_, n1, n2, u + (int)gridDim.x);
        __syncthreads();
        *(LAS u32x4_t*)(lds + L_SQ + tk * SQP + (sub >> 3) * 512 + ((sub >> 1) & 3) * 128 + 96 + (sub & 1) * 16) = (u32x4_t){0u, 0u, 0u, 0u};
        {
            float c[12], k[8];
            c[0] = __uint_as_float(ra.x << 16); c[1] = __uint_as_float(ra.x & 0xFFFF0000u); c[2] = __uint_as_float(ra.y << 16); c[3] = __uint_as_float(ra.y & 0xFFFF0000u);
            c[4] = __uint_as_float(rb.x << 16); c[5] = __uint_as_float(rb.x & 0xFFFF0000u); c[6] = __uint_as_float(rb.y << 16); c[7] = __uint_as_float(rb.y & 0xFFFF0000u);
            c[8] = __uint_as_float(rc.x << 16); c[9] = __uint_as_float(rc.x & 0xFFFF0000u); c[10] = __uint_as_float(rc.y << 16); c[11] = __uint_as_float(rc.y & 0xFFFF0000u);
            unpack8(make_uint4(rk[0], rk[1], rk[2], rk[3]), k);
            float s1 = 0.f, s2 = 0.f;
#pragma unroll
            for (int i = 0; i < 12; ++i) s1 += c[i] * c[i];
#pragma unroll
            for (int i = 0; i < 8; ++i) s2 += k[i] * k[i];
#pragma unroll
            for (int o = 1; o < 16; o <<= 1) { s1 += __shfl_xor(s1, o); s2 += __shfl_xor(s2, o); }
            const float r1 = rsqrtf(s1 * (1.f / 192.f) + NORM_EPS), r2 = rsqrtf(s2 * (1.f / 128.f) + NORM_EPS);
            typedef unsigned u32x2_t __attribute__((ext_vector_type(2)));
#pragma unroll
            for (int i = 0; i < 3; ++i) { const int e = sub * 12 + 4 * i;
                *(LAS u32x2_t*)(lds + L_CQ + tk * QP + e * 2) = (u32x2_t){pkbf(c[4 * i] * r1 * qn[e], c[4 * i + 1] * r1 * qn[e + 1]), pkbf(c[4 * i + 2] * r1 * qn[e + 2], c[4 * i + 3] * r1 * qn[e + 3])}; }
            { const int e = sub * 8;
              *(LAS u32x4_t*)(lds + L_CKV + tk * KVP + e * 2) = (u32x4_t){pkbf(k[0] * r2 * kvn[e], k[1] * r2 * kvn[e + 1]), pkbf(k[2] * r2 * kvn[e + 2], k[3] * r2 * kvn[e + 3]),
                                                                        pkbf(k[4] * r2 * kvn[e + 4], k[5] * r2 * kvn[e + 5]), pkbf(k[6] * r2 * kvn[e + 6], k[7] * r2 * kvn[e + 7])}; }
        }
        __syncthreads();
        {
            pg8::f32x4 acc[3][2];
#pragma unroll
            for (int a = 0; a < 3; ++a)
#pragma unroll
                for (int m = 0; m < 2; ++m) acc[a][m] = (pg8::f32x4){0.f, 0.f, 0.f, 0.f};
#pragma unroll
            for (int ks = 0; ks < 6; ++ks) {
                bf16x8_t af[2];
#pragma unroll
                for (int m = 0; m < 2; ++m) af[m] = *(LAS const bf16x8_t*)(lds + L_CQ + (m * 16 + fr) * QP + (32 * ks + 8 * fq) * 2);
#pragma unroll
                for (int a = 0; a < 3; ++a) {
                    const bf16x8_t bfrag = *(const bf16x8_t*)(WUQ + (size_t)((3 * wid + a) * 16 + fr) * 192 + 32 * ks + 8 * fq);
#pragma unroll
                    for (int m = 0; m < 2; ++m) acc[a][m] = __builtin_amdgcn_mfma_f32_16x16x32_bf16(bfrag, af[m], acc[a][m], 0, 0, 0);
                }
            }
#pragma unroll
            for (int a = 0; a < 3; ++a) {
                const int nt = 3 * wid + a, t6 = nt % 6, col = nt * 16 + 4 * fq;
#pragma unroll
                for (int m = 0; m < 2; ++m) {
                    const int tok = m * 16 + fr, t = t0 + tok;
                    pg8::f32x4 v = acc[a][m];
                    if (t6 >= 4) {
                        pg8::f32x4 pv; pv[0] = __shfl_xor(v[0], 32); pv[1] = __shfl_xor(v[1], 32); pv[2] = __shfl_xor(v[2], 32); pv[3] = __shfl_xor(v[3], 32);
                        if (!isctx) { const int pos = t6 == 4 ? (t >> 6) : (t & 63);
#pragma unroll
                            for (int j = 0; j < 4; ++j) { const float2 cs = tab16[pos * 8 + 4 * (fq & 1) + j]; v[j] = v[j] * cs.x + (fq < 2 ? -pv[j] : pv[j]) * cs.y; } }
                    }
                    *(LAS int*)(lds + L_SQ + tok * SQP + (nt / 6) * 128 + t6 * 16 + 4 * fq) = CVT4_F8(v[0], v[1], v[2], v[3]);
                }
            }
        }
        {
            pg8::f32x4 acc[4][2];
#pragma unroll
            for (int a = 0; a < 4; ++a)
#pragma unroll
                for (int m = 0; m < 2; ++m) acc[a][m] = (pg8::f32x4){0.f, 0.f, 0.f, 0.f};
#pragma unroll
            for (int ks = 0; ks < 4; ++ks) {
                bf16x8_t af[2];
#pragma unroll
                for (int m = 0; m < 2; ++m) af[m] = *(LAS const bf16x8_t*)(lds + L_CKV + (m * 16 + fr) * KVP + (32 * ks + 8 * fq) * 2);
#pragma unroll
                for (int a = 0; a < 4; ++a) {
                    const bf16x8_t bfrag = *(const bf16x8_t*)(WUKV + (size_t)((4 * wid + a) * 16 + fr) * 128 + 32 * ks + 8 * fq);
#pragma unroll
                    for (int m = 0; m < 2; ++m) acc[a][m] = __builtin_amdgcn_mfma_f32_16x16x32_bf16(bfrag, af[m], acc[a][m], 0, 0, 0);
                }
            }
#pragma unroll
            for (int a = 0; a < 4; ++a) {
                const int n = (4 * wid + a) * 16 + 4 * fq, hh = n >> 7, d = n & 127;
                const int dst = d < 64 ? PC_KA + hh * 96 + d : PC_VA + hh * 64 + (d - 64);
#pragma unroll
                for (int m = 0; m < 2; ++m) { const pg8::f32x4 v = acc[a][m]; const int row = R0 + m * 16 + fr;
                    const int w8 = CVT4_F8(v[0], v[1], v[2], v[3]);
                    const int tl = m * 16 + fr; (void)row;
                    if (d < 64) *(LAS int*)(lds + L_SQ + tl * SQP + 512 + hh * 128 + d) = w8;
                    else { LAS unsigned char* vp = lds + L_SV + (hh * 64 + (d - 64)) * 32 + 16 * ((tl >> 2) & 1) + 4 * (tl >> 3) + (tl & 3);
                        vp[0] = (unsigned char)w8; vp[32] = (unsigned char)(w8 >> 8); vp[64] = (unsigned char)(w8 >> 16); vp[96] = (unsigned char)((unsigned)w8 >> 24); } }
                (void)dst;
            }
        }
        int tidB = tid; asm volatile("" : "+v"(tidB));
#pragma unroll
        for (int it = 0; it < 1; ++it) {
            const int w = it * NT + tidB;
            if (w < 32 * 2) {
                const int tok = w / 2, task = 72 + (w & 1), t = t0 + tok;
                bf16_t* po = POST + (size_t)(R0 + tok) * POST_LD;
                int dst, dist; const float2* tb; float scl = 1.f; bool bc = false;
                if (task < 40) { const int hd = task >> 2, half = (task >> 1) & 1, cp = task & 1;
                    dst = (task < 32 ? PC_QB : PC_KB - 8 * 64) + hd * 64 + half * 32 + cp * 8; dist = 16; tb = tab32 + (half ? (t & 63) : (t >> 6)) * 16 + cp * 8; }
                else if (task < 72) { const int q = task - 40, hd = q >> 2, cp = q & 3;
                    dst = PC_RQ + hd * 64 + cp * 8; dist = 32; tb = tab_ret + t * 32 + cp * 8; if (hd >= 4) scl = 0.125f; }
                else { const int half = task - 72; dst = PC_KA + 64 + half * 16; dist = 8; bc = true; tb = tab16 + (half ? (t & 63) : (t >> 6)) * 8; }
                float x1[8], x2[8]; unpack8(make_uint4(p1[it][0], p1[it][1], p1[it][2], p1[it][3]), x1); unpack8(make_uint4(p2[it][0], p2[it][1], p2[it][2], p2[it][3]), x2);
                if (!isctx) {
                    const float4 c0 = *(const float4*)(tb), c1 = *(const float4*)(tb + 2), c2 = *(const float4*)(tb + 4), c3 = *(const float4*)(tb + 6);
                    const float cs[8] = {c0.x, c0.z, c1.x, c1.z, c2.x, c2.z, c3.x, c3.z}, sn[8] = {c0.y, c0.w, c1.y, c1.w, c2.y, c2.w, c3.y, c3.w};
#pragma unroll
                    for (int j = 0; j < 8; ++j) { const float a = x1[j], b2 = x2[j]; x1[j] = a * cs[j] - b2 * sn[j]; x2[j] = b2 * cs[j] + a * sn[j]; }
                }
#pragma unroll
                for (int j = 0; j < 8; ++j) { x1[j] *= scl; x2[j] *= scl; }
                const uint4 o1 = make_uint4(pkbf(x1[0], x1[1]), pkbf(x1[2], x1[3]), pkbf(x1[4], x1[5]), pkbf(x1[6], x1[7]));
                const uint4 o2 = make_uint4(pkbf(x2[0], x2[1]), pkbf(x2[2], x2[3]), pkbf(x2[4], x2[5]), pkbf(x2[6], x2[7]));
                if (bc) {
                    LAS unsigned char* k8 = lds + L_SQ + tok * SQP + 512 + 64 + (task - 72) * 16;
                    typedef unsigned u32x2_t __attribute__((ext_vector_type(2)));
                    const uint2 f1 = make_uint2((unsigned)CVT4_F8(x1[0], x1[1], x1[2], x1[3]), (unsigned)CVT4_F8(x1[4], x1[5], x1[6], x1[7]));
                    const uint2 f2 = make_uint2((unsigned)CVT4_F8(x2[0], x2[1], x2[2], x2[3]), (unsigned)CVT4_F8(x2[4], x2[5], x2[6], x2[7]));
#pragma unroll
                    for (int hh = 0; hh < 4; ++hh) { *(LAS u32x2_t*)(k8 + hh * 128) = (u32x2_t){f1.x, f1.y}; *(LAS u32x2_t*)(k8 + hh * 128 + 8) = (u32x2_t){f2.x, f2.y}; }
                } else { *(uint4*)(po + dst) = o1; *(uint4*)(po + dst + dist) = o2; }
            }
        }
        __syncthreads();
        {
            const int rr = tid >> 4, pc = tid & 15;
            uint4* qd = (uint4*)(QK8 + (size_t)(R0 + rr) * 1024 + pc * 64);
#pragma unroll
            for (int j = 0; j < 4; ++j) { const u32x4_t t4 = *(LAS const u32x4_t*)(lds + L_SQ + rr * SQP + pc * 64 + j * 16); qd[j] = make_uint4(t4[0], t4[1], t4[2], t4[3]); }
            int bb, key0; if (R0 < T_LAT) { bb = R0 >> 12; key0 = R0 & (SEQ - 1); } else { bb = (R0 - T_LAT) >> 8; key0 = SEQ + ((R0 - T_LAT) & (CTXL - 1)); }
            const int vr = tid >> 1, hf = tid & 1;
            const u32x4_t t4 = *(LAS const u32x4_t*)(lds + L_SV + vr * 32 + hf * 16);
            *(uint4*)(V8T + (size_t)((bb * 4 + (vr >> 6)) * 64 + (vr & 63)) * 4352 + (key0 & ~63) + 32 * hf + 16 * ((key0 >> 5) & 1)) = make_uint4(t4[0], t4[1], t4[2], t4[3]);
        }
        if (has_next) { ra = na_; rb = nb_; rc = nc_; rk = nk_;
#pragma unroll
            for (int it = 0; it < 1; ++it) { p1[it] = n1[it]; p2[it] = n2[it]; } }
    }
#undef PREP_LOADS
#undef CVT4_F8
}
#define N_PHASES 23
#define LDS_BYTES 147456
#define LDS_MISC 131072
__device__ __forceinline__ P load_p() {
#if defined(__HIP_DEVICE_COMPILE__)
    const __attribute__((address_space(4))) P* kq = (const __attribute__((address_space(4))) P*)__builtin_amdgcn_kernarg_segment_ptr();
    asm volatile("" : "+s"(kq));
    return *kq;
#else
    return P{};
#endif
}
__global__ void __launch_bounds__(NT, 2) fwd_kernel(P p0, int lo, int hi) {
    extern __shared__ __attribute__((aligned(16))) unsigned char lds_raw[];
    float* lds = (float*)lds_raw;
    LAS unsigned char* ldsl = (LAS unsigned char*)lds_raw;
    volatile LAS unsigned* st = (volatile LAS unsigned*)(ldsl + LDS_MISC);
    if (threadIdx.x < 4) st[threadIdx.x] = 0u;
    __syncthreads();
    XcdBarrier bar; bar.bar = (unsigned*)(p0.ws + OFF_CTL); bar.x = 0; bar.st = st;
    if (hi - lo > 1) bar = xcd_barrier_post((unsigned*)(p0.ws + OFF_CTL), st);
#define IN(k) (lo <= (k) && (k) < hi)
#define PH(k) if (IN(k)) if (const P p = load_p(); true)
#define SEAM(k) do { if (IN(k) && IN((k) + 1)) xcd_barrier(bar); } while (0)
#define MOD ((const float*)(p.ws + OFF_MOD))
#define H ((bf16_t*)(p.ws + OFF_H))
#define XC ((float*)(p.ws + OFF_XC))
#define PROJ ((bf16_t*)(p.ws + OFF_PROJ))
#define ACT ((bf16_t*)(p.ws + OFF_ACT))
#define CNT ((int*)(p.ws + OFF_CNT))
#define LIST ((const int*)(p.ws + OFF_LIST))
#define WL ((const float*)(p.ws + OFF_WL))
#define WIN ((const bf16_t*)(p.ws + OFF_WIN))
#define WOUT ((const bf16_t*)(p.ws + OFF_WOUT))
#define FGU ((const bf16_t*)(p.ws + OFF_FGU))
#define FD ((const bf16_t*)(p.ws + OFF_FD))
#define MGU ((const bf16_t*)(p.ws + OFF_MGU))
#define MDW ((const bf16_t*)(p.ws + OFF_MD))
#define YB ((bf16_t*)(p.ws + OFF_Y))
#define YB2 ((bf16_t*)(p.ws + OFF_Y2))
#define PARTB ((float*)(p.ws + OFF_PART))
    const int G = gridDim.x, bid = blockIdx.x;

    PH(0) { ph_mod(p, lds); ph_tables(p); ph_conv_early(p, lds); ph_fgu_colmax(p); ph_win_colmax(p); }
    SEAM(0);
    PH(1) { ph_norm(p, 0, 1, T_ALL, false, true, nullptr, 0, 0, 0, p.ws + OFF_QK8, false, (float*)(p.ws + OFF_RSW)); __syncthreads(); ph_conv_fgu_i8(p, lds); }
    SEAM(1);
    PH(2) { pg8::DenseSchedT<false, true> S{(const bf16_t*)(p.ws + OFF_QK8), WIN, 512, 512, T_ALL / 256, PROJ_LD / 256, G, bid};
            pg8::EpiWinRope E{PROJ, (bf16_t*)(p.ws + OFF_POST), (const float*)(p.ws + OFF_RSW), (const float*)(p.ws + OFF_CSW) + 0 * PROJ_LD, (const float2*)(p.ws + OFF_TAB), (const float2*)(p.ws + OFF_TAB) + 4096 * 32}; pg8::gemm_phase(ldsl, S, E); }
    SEAM(2);
    PH(3) ph_prep2(p, 0, ldsl);
    SEAM(3);
    PH(4) ph_ret_T(p, 0, ldsl);
    SEAM(4);
    PH(5) ph_mixer_mfma(p, 0, true, ldsl);
    SEAM(5);
    PH(6) {
        { pg8::DenseSched S{H, WOUT, 1024, 1024, T_ALL / 256, 4, G, bid};
          pg8::EpiBf16Norm E{YB, 1024, (unsigned)((size_t)T_ALL * 1024 * 2), (unsigned*)(p.ws + OFF_PCNT), 1.f};
          pg8::gemm_phase(ldsl, S, E); }
        norm_help(p, NormArgs{0, 2, false, true, YB, 0, 2048, 0, p.ws + OFF_H8D, false, (float*)(p.ws + OFF_RS8)}, (unsigned*)(p.ws + OFF_PCNT), 32u, (unsigned*)(p.ws + OFF_CLAIM), T_ALL / 256, (LAS unsigned*)(ldsl + LDS_MISC + 32));
    }
    SEAM(6);
    PH(8) { pg8::DenseSchedT<false, true> S{(const bf16_t*)(p.ws + OFF_H8D), FGU, 512, 512, T_ALL / 256, 2 * D_FF / 256, G, bid};
            pg8::EpiSwigluI8 E{ACT, D_FF, (const float*)(p.ws + OFF_RS8), (const float*)(p.ws + OFF_CS8)}; pg8::gemm_phase(ldsl, S, E); }
    SEAM(8);
    PH(9) {
        { pg8::DenseSchedT<true> S{ACT, FD, D_FF / 2, D_FF / 2, T_ALL / 256, 4, G, bid};
          pg8::EpiBf16Norm E{YB2, 1024, (unsigned)((size_t)T_ALL * 1024 * 2), (unsigned*)(p.ws + OFF_PCNT) + 136 * 64, 1.f / (F8_SA * F8_SW)};
          pg8::gemm_phase(ldsl, S, E); }
        norm_help(p, NormArgs{1, 1, false, false, YB2, 0, 5120, 0, p.ws + OFF_QK8, false, (float*)(p.ws + OFF_RSW)}, (unsigned*)(p.ws + OFF_PCNT) + 136 * 64, 32u, (unsigned*)(p.ws + OFF_CLAIM) + 64, T_ALL / 256, (LAS unsigned*)(ldsl + LDS_MISC + 32));
    }
    SEAM(9);
    PH(11) { pg8::DenseSchedT<false, true> S{(const bf16_t*)(p.ws + OFF_QK8), (WIN + (size_t)PROJ_LD * 1024), 512, 512, T_ALL / 256, PROJ_LD / 256, G, bid};
            pg8::EpiWinRope E{PROJ, (bf16_t*)(p.ws + OFF_POST), (const float*)(p.ws + OFF_RSW), (const float*)(p.ws + OFF_CSW) + 1 * PROJ_LD, (const float2*)(p.ws + OFF_TAB), (const float2*)(p.ws + OFF_TAB) + 4096 * 32}; pg8::gemm_phase(ldsl, S, E); }
    SEAM(11);
    PH(12) ph_prep2(p, 1, ldsl);
    SEAM(12);
    PH(13) ph_ret_T(p, 1, ldsl);
    SEAM(13);
    PH(14) ph_mixer_mfma(p, 1, false, ldsl);
    SEAM(14);
    PH(15) { pg8::DenseSched S{H, WOUT + (size_t)1024 * 1024, 1024, 1024, T_LAT / 256, 4, G, bid}; pg8::EpiBf16 E{YB, 1024}; pg8::gemm_phase(ldsl, S, E); }
    SEAM(15);
    PH(16) { ph_norm(p, 1, 2, T_LAT, true, false, YB, 1, 2048, 0, p.ws + OFF_H, false); ph_conv_late(p, lds); }
    SEAM(16);
#pragma unroll
    for (int s = 0; s < 2; ++s) {
        if (IN(17 + 2 * s) || IN(18 + 2 * s)) {
            LAS int* tab = (LAS int*)(ldsl + LDS_MISC + 64 + 128 * s);
            { const P p = load_p();
            __syncthreads();
            if (threadIdx.x == 0) { int tbv = 0; tab[8] = 0;
                for (int e = 0; e < 8; ++e) { const int ce = __hip_atomic_load(CNT + s * 8 + e, __ATOMIC_RELAXED, __HIP_MEMORY_SCOPE_AGENT); tab[e] = ce; tbv += (ce + 255) >> 8; tab[9 + e] = tbv; } }
            __syncthreads(); }
            const int nTm = tab[16];
            PH(17 + 2 * s) {
                if (s == 1) pg8::moe_combine((bf16_t*)(p.ws + OFF_YM), PARTB, (const LAS int*)(ldsl + LDS_MISC + 64), 4, 1.f / (F8_SA * F8_SW));
                pg8::MoeSched<true, true> S{H, MGU, 512, 512, 2 * D_FFE / 256, G, bid, (size_t)D_FFE * 1024, LIST + (size_t)s * 8 * 32768, tab, 0, nTm * (2 * D_FFE / 256), 1, 512 / 64};
                pg8::EpiSwigluT<true, true> E{ACT, D_FFE}; pg8::gemm_phase(ldsl, S, E);
            }
            SEAM(17 + 2 * s);
            PH(18 + 2 * s) {
                const int U = nTm * 4, rem = U % G, split = (rem > 0 && rem * MOE_WAYS <= G) ? 1 : 0, umain = split ? U - rem : U;
                { pg8::MoeSched<false, true> S{ACT, MDW, D_FFE / 2, D_FFE / 2, 4, G, bid, (size_t)512 * D_FFE, nullptr, tab, 0, umain, 1, D_FFE / 128};
                  pg8::EpiBf16S E{(bf16_t*)(p.ws + OFF_YM) + (size_t)s * ACT_ROWS * 1024, 1024, 1.f / (F8_SA * F8_SW)};
                  pg8::gemm_phase(ldsl, S, E); }
                if (split) { pg8::MoeSched<false, true> S{ACT, MDW, D_FFE / 2, D_FFE / 2, 4, G, bid, (size_t)512 * D_FFE, nullptr, tab, umain, U, MOE_WAYS, D_FFE / 128 / MOE_WAYS};
                  pg8::EpiPart E{PARTB}; pg8::gemm_phase(ldsl, S, E); }
            }
        }
        SEAM(18 + 2 * s);
    }
    PH(21) { const LAS int* tab1 = (const LAS int*)(ldsl + LDS_MISC + 64 + 128);
        pg8::moe_combine((bf16_t*)(p.ws + OFF_YM) + (size_t)ACT_ROWS * 1024, PARTB, tab1, 4, 1.f / (F8_SA * F8_SW)); }
    SEAM(21);
    PH(22) ph_final_moe(p, (const LAS int*)(ldsl + LDS_MISC + 64), (const LAS int*)(ldsl + LDS_MISC + 64 + 128));
}

extern "C" void kernel_launch(void* const* d_in, const int* in_sizes, int n_in, void* d_out, int out_size, void* d_ws, size_t ws_size, hipStream_t stream) {
    static int grid = 0;
    if (!grid) {
        if (n_in != 25 || out_size != T_LAT * 1024 || ws_size < WS_END) { fprintf(stderr, "kernel_launch: unexpected shapes (n_in %d out %d ws %zu need %zu)\n", n_in, out_size, ws_size, (size_t)WS_END); grid = -1; return; }
        int dev = 0, cus = 0, per_cu = 0;
        (void)hipGetDevice(&dev); (void)hipDeviceGetAttribute(&cus, hipDeviceAttributeMultiprocessorCount, dev);
        (void)hipFuncSetAttribute((const void*)fwd_kernel, hipFuncAttributeMaxDynamicSharedMemorySize, LDS_BYTES);
        (void)hipOccupancyMaxActiveBlocksPerMultiprocessor(&per_cu, (const void*)fwd_kernel, NT, LDS_BYTES);
        if (per_cu < 1) { fprintf(stderr, "kernel_launch: occupancy query says %d\n", per_cu); }
        grid = cus > 0 ? cus : 256;
    }
    if (grid < 0) return;
    (void)hipMemsetAsync((char*)d_ws + OFF_CTL, 0, CTL_BYTES, stream);
    P p{};
    for (int i = 0; i < 25; ++i) p.in[i] = (const float*)d_in[i];
    p.out = (float*)d_out; p.ws = (unsigned char*)d_ws;
    hipLaunchKernelGGL(fwd_kernel, dim3(grid), dim3(NT), LDS_BYTES, stream, p, 0, N_PHASES);
}
```

```cpp
#include <hip/hip_runtime.h>
#include <stdint.h>
#include <stdio.h>

#define D_MODEL 1024
#define BATCH 8
#define SEQ 4096
#define CTXL 256
#define T_LAT (BATCH * SEQ)
#define T_CTX (BATCH * CTXL)
#define T_ALL (T_LAT + T_CTX)
#define IN_DIM 2144
#define PROJ_LD 2304
#define POST_LD 2816
#define D_FF 2816
#define D_FFE 3584
#define NEXP 8
#define NT 512
#define NORM_EPS 1e-6f

typedef unsigned short bf16_t;
__device__ __forceinline__ float bf2f(bf16_t v) { return __uint_as_float(((unsigned)v) << 16); }
__device__ __forceinline__ bf16_t f2bf(float f) { unsigned u = __float_as_uint(f); u += 0x7FFFu + ((u >> 16) & 1u); return (bf16_t)(u >> 16); }
__device__ __forceinline__ float silu_f(float v) { return v / (1.f + expf(-v)); }

#define PJ_RQ 1280
#define PJ_RK 1536
#define PJ_RV 1792
#define PJ_RG 2048
#define PJ_F8 1280
#define PC_QA 0
#define PC_KA 384
#define PC_VA 768
#define PC_QB 1024
#define PC_KB 1536
#define PC_VB 1664
#define PC_RQ 1792
#define PC_RK 2048
#define PC_RV 2304
#define PC_RG 2560

constexpr size_t AL256(size_t x) { return (x + 255) & ~(size_t)255; }
constexpr size_t OFF_CTL  = 0;
constexpr size_t CTL_BYTES = 294912;
constexpr size_t OFF_PCNT = 32768;
constexpr size_t OFF_CLAIM = 20480;
constexpr size_t OFF_CMAX = 196608;
constexpr size_t OFF_CS8  = OFF_CMAX + 5632 * 4;
constexpr size_t OFF_CMAXW = OFF_CS8 + 5632 * 4;
constexpr size_t OFF_CSW  = 262144;
constexpr size_t OFF_RSW  = 294912;
static_assert(OFF_RSW + (size_t)T_ALL * 4 <= (1u << 20), "row scales fit below OFF_MOD");
constexpr size_t OFF_CNT  = 16384;
constexpr size_t OFF_MOD  = 1u << 20;
constexpr size_t OFF_TAB  = 3u << 19;
constexpr size_t OFF_WIN  = 3u << 20;
constexpr size_t OFF_WOUT = OFF_WIN + (size_t)2 * PROJ_LD * 1024 * 2;
constexpr size_t OFF_FGU  = OFF_WOUT + (size_t)2 * 1024 * 1024 * 2;
constexpr size_t OFF_FD   = OFF_FGU + (size_t)2 * D_FF * 1024 * 2;
constexpr size_t OFF_WUQ  = OFF_FD + (size_t)1024 * D_FF * 2;
constexpr size_t OFF_WUKV = OFF_WUQ + (size_t)2 * 384 * 192 * 2;
constexpr size_t OFF_H    = OFF_WUKV + (size_t)2 * 512 * 128 * 2;
constexpr size_t OFF_XC   = OFF_H + (size_t)T_ALL * 1024 * 2;
constexpr size_t OFF_LIST = OFF_XC + (size_t)T_CTX * 1024 * 4;
constexpr size_t OFF_WL   = OFF_LIST + (size_t)2 * 8 * 32768 * 4;
constexpr size_t OFF_R    = OFF_WL + (size_t)2 * 8 * 32768 * 4;
constexpr size_t OFF_PROJ = OFF_R;
constexpr size_t OFF_POST = OFF_PROJ + (size_t)T_ALL * PROJ_LD * 2;
constexpr size_t OFF_TT   = OFF_POST + (size_t)T_ALL * POST_LD * 2;
constexpr size_t R1_END   = OFF_TT + (size_t)BATCH * 4 * 34 * 2 * 4096 * 4;
constexpr size_t OFF_ACT  = OFF_R;
constexpr size_t OFF_Y    = OFF_PROJ;
constexpr size_t OFF_H8D  = OFF_ACT + (size_t)T_ALL * D_FF;
constexpr size_t OFF_RS8   = OFF_H8D + (size_t)T_ALL * 1024;
constexpr size_t OFF_Y2   = OFF_ACT + (size_t)T_ALL * D_FF * 2;
constexpr size_t ACT_ROWS = T_LAT + NEXP * 256;
constexpr size_t OFF_MGU  = OFF_ACT + ACT_ROWS * D_FFE;
constexpr size_t OFF_MD   = OFF_MGU + (size_t)NEXP * 2 * D_FFE * 1024;
constexpr size_t OFF_PART = OFF_MD + (size_t)NEXP * 1024 * D_FFE;
constexpr size_t PART_END = OFF_PART + (size_t)256 * 65536 * 4;
constexpr size_t OFF_YM   = PART_END;
constexpr size_t OFF_INV  = OFF_YM + (size_t)2 * ACT_ROWS * 1024 * 2;
constexpr size_t YM_END   = OFF_INV + (size_t)T_LAT * 32;
constexpr size_t OFF_QK8  = YM_END;
constexpr size_t OFF_V8T  = OFF_QK8 + (size_t)T_ALL * 1024;
constexpr size_t F8_END   = OFF_V8T + (size_t)BATCH * 4 * 64 * 4352;
constexpr size_t WS_END   = F8_END > R1_END ? F8_END : R1_END;
static_assert(R1_END <= WS_END, "phase-1 buffers fit");
static_assert(WS_END <= 607070848, "workspace budget");
static_assert(OFF_Y2 + (size_t)T_ALL * 1024 * 2 <= WS_END, "Y2 fits");
static_assert(OFF_MGU >= OFF_Y + (size_t)T_ALL * 1024 * 2, "expert weights are converted while norm2(L1) still reads Y");

struct P { const float* in[25]; float* out; unsigned char* ws; };

#define XB_TMO      128
#define XB_XCNT(j)  (256  + 64 * (j))
#define XB_XSUB(j)  (1280 + 64 * (j))
#define XB_XGEN(j)  (2304 + 64 * (j))
#define XB_TOP      3328
#define XB_TOPGEN   3392
#define XCD_BAR_WORDS 3456
#define XB_SPIN_CAP (1u << 22)
#define LAS __attribute__((address_space(3)))

__device__ __forceinline__ unsigned xb_ld(unsigned* p)              { return __hip_atomic_load(p, __ATOMIC_RELAXED, __HIP_MEMORY_SCOPE_AGENT); }
__device__ __forceinline__ unsigned xb_add(unsigned* p, unsigned v) { return __hip_atomic_fetch_add(p, v, __ATOMIC_RELAXED, __HIP_MEMORY_SCOPE_AGENT); }
__device__ __forceinline__ unsigned xb_xcc_id() { return (unsigned)__builtin_amdgcn_s_getreg((3 << 11) | 20) & 0xFu; }
#define XB_SPIN(cond, bar) do { unsigned _sp = 0; while (cond) { __builtin_amdgcn_s_sleep(1); \
    if ((++_sp & 255u) == 0u) { if (xb_ld(&(bar)[XB_TMO])) break; if (_sp > XB_SPIN_CAP) { atomicAdd(&(bar)[XB_TMO], 1u); break; } } } } while (0)

struct XcdBarrier { unsigned* bar; unsigned x; volatile LAS unsigned* st; };

__device__ __forceinline__ XcdBarrier xcd_barrier_post(unsigned* bar, volatile LAS unsigned* st) {
    XcdBarrier b; b.bar = bar; b.x = xb_xcc_id(); b.st = st;
    if (threadIdx.x == 0) (void)xb_add(&bar[XB_XCNT(b.x)], 1u);
    return b;
}
__device__ __forceinline__ void xcd_barrier_complete(unsigned* bar, unsigned x, unsigned& nloc, unsigned& nx) {
    const unsigned G = gridDim.x * gridDim.y * gridDim.z;
    unsigned sum, cnt, mine, sp = 0u;
    for (;;) {
        sum = 0u; cnt = 0u; mine = 0u;
#pragma unroll
        for (unsigned j = 0; j < 16; ++j) { const unsigned c = xb_ld(&bar[XB_XCNT(j)]); sum += c; cnt += (c > 0u) ? 1u : 0u; mine = (j == x) ? c : mine; }
        if (sum == G) break;
        __builtin_amdgcn_s_sleep(1);
        if ((++sp & 255u) == 0u) { if (xb_ld(&bar[XB_TMO])) break; if (sp > XB_SPIN_CAP) { atomicAdd(&bar[XB_TMO], 1u); break; } }
    }
    nloc = mine > 0u ? mine : 1u; nx = cnt > 0u ? cnt : 1u;
}
__device__ __forceinline__ void xcd_barrier(const XcdBarrier& b) {
    asm volatile("s_waitcnt vmcnt(0)" ::: "memory");
    __syncthreads();
    if (threadIdx.x == 0) {
        unsigned* bar = b.bar;
        __builtin_amdgcn_s_waitcnt(0);
        unsigned nloc = b.st[0], nx = b.st[1];
        if (nloc == 0u) { xcd_barrier_complete(bar, b.x, nloc, nx); b.st[0] = nloc; b.st[1] = nx; }
        const unsigned old = xb_add(&bar[XB_XSUB(b.x)], 1u);
        const unsigned gen = old / nloc;
        if (old + 1u == (gen + 1u) * nloc) {
            __builtin_amdgcn_fence(__ATOMIC_RELEASE, "agent");
            asm volatile("s_waitcnt vmcnt(0)" ::: "memory");
            const unsigned og = xb_add(&bar[XB_TOP], 1u);
            const unsigned tg = og / nx;
            if (og + 1u == (tg + 1u) * nx) xb_add(&bar[XB_TOPGEN], 1u);
            else XB_SPIN(xb_ld(&bar[XB_TOPGEN]) == tg, bar);
            __builtin_amdgcn_fence(__ATOMIC_ACQUIRE, "agent");
            xb_add(&bar[XB_XGEN(b.x)], 1u);
            asm volatile("s_waitcnt vmcnt(0)" ::: "memory");
        } else {
            XB_SPIN(xb_ld(&bar[XB_XGEN(b.x)]) == gen, bar);
            __builtin_amdgcn_fence(__ATOMIC_ACQUIRE, "agent");
            asm volatile("s_waitcnt vmcnt(0)" ::: "memory");
        }
    }
    __syncthreads();
}

__device__ __forceinline__ float wave_sum(float v) {
#pragma unroll
    for (int o = 32; o > 0; o >>= 1) v += __shfl_xor(v, o);
    return v;
}
__device__ __forceinline__ void unpack8(const uint4 r, float* f) {
    f[0] = __uint_as_float(r.x << 16); f[1] = __uint_as_float(r.x & 0xFFFF0000u);
    f[2] = __uint_as_float(r.y << 16); f[3] = __uint_as_float(r.y & 0xFFFF0000u);
    f[4] = __uint_as_float(r.z << 16); f[5] = __uint_as_float(r.z & 0xFFFF0000u);
    f[6] = __uint_as_float(r.w << 16); f[7] = __uint_as_float(r.w & 0xFFFF0000u);
}
__device__ __forceinline__ int tok_row(int b, int i) { return i < SEQ ? b * SEQ + i : T_LAT + b * CTXL + (i - SEQ); }

__device__ __forceinline__ void ph_mod(const P& p, float* lds) {
    float* MOD = (float*)(p.ws + OFF_MOD);
    float* sl = lds; float* part = lds + 9 * 1024;
    int tid_ = threadIdx.x; asm volatile("" : "+v"(tid_));
    const int t = tid_, col = t & 63, ks = t >> 6;
    __syncthreads();
    for (int i = t; i < 9 * 1024; i += NT) { const int r = i >> 10, k = i & 1023; sl[i] = silu_f(r < 8 ? p.in[1][r * 1024 + k] : p.in[3][k]); }
    __syncthreads();
    for (int u = blockIdx.x; u < 2 * 96; u += gridDim.x) {
        const int l = u / 96, n = (u % 96) * 64 + col;
        const float* w = p.in[4] + (size_t)l * 1024 * 6144 + (size_t)(ks * 128) * 6144 + n;
        float acc[9];
#pragma unroll
        for (int r = 0; r < 9; ++r) acc[r] = 0.f;
#pragma unroll 8
        for (int k = 0; k < 128; ++k) { const float wv = w[(size_t)k * 6144];
#pragma unroll
            for (int r = 0; r < 9; ++r) acc[r] += sl[r * 1024 + ks * 128 + k] * wv; }
        __syncthreads();
#pragma unroll
        for (int r = 0; r < 9; ++r) part[(ks * 9 + r) * 64 + col] = acc[r];
        __syncthreads();
        for (int i = t; i < 9 * 64; i += NT) { const int r = i >> 6, c2 = i & 63; float s = 0.f;
#pragma unroll
            for (int q = 0; q < 8; ++q) s += part[(q * 9 + r) * 64 + c2];
            const int nn = (u % 96) * 64 + c2; MOD[(l * 9 + r) * 6144 + nn] = s + p.in[5][l * 6144 + nn]; }
    }
}

#define F8_SH 8.f
#define F8_SW 64.f
#define F8_SA 4.f
#define MOE_WAYS 7
__device__ __forceinline__ float f8clamp(float x) { return fminf(fmaxf(x, -448.f), 448.f); }
struct NormArgs { int layer, which; bool router, from_input; const bf16_t* resY; int res_layer, res_goff, ctx_ways; unsigned char* h8; bool both; float* i8s = nullptr; };
__device__ __forceinline__ void norm_row(const P& p, const NormArgs& a, int row, int lane) {
    const int layer = a.layer, which = a.which, res_layer = a.res_layer, res_goff = a.res_goff, ctx_ways = a.ctx_ways; const bool router = a.router, from_input = a.from_input; const bf16_t* resY = a.resY;
    const float* MOD = (const float*)(p.ws + OFF_MOD);
    const float* gain = (which == 1 ? p.in[6] : p.in[7]) + layer * 1024;
    bf16_t* H = (bf16_t*)(p.ws + OFF_H);
    float* XC = (float*)(p.ws + OFF_XC);
    int* CNT = (int*)(p.ws + OFF_CNT);
    int* LIST = (int*)(p.ws + OFF_LIST);
    float* WL = (float*)(p.ws + OFF_WL);
    {
        const float* src; float* dstx; int r;
        if (row < T_LAT) { r = row >> 12; src = (from_input ? p.in[0] : p.out) + (size_t)row * 1024; dstx = p.out + (size_t)row * 1024; }
        else { r = 8; src = (from_input ? p.in[2] : XC) + (size_t)(row - T_LAT) * 1024; dstx = XC + (size_t)(row - T_LAT) * 1024; }
        const float* md = MOD + (layer * 9 + r) * 6144 + (which == 1 ? 0 : 3072);
        float4 v[4]; float ss = 0.f;
#pragma unroll
        for (int i = 0; i < 4; ++i) v[i] = *(const float4*)(src + i * 256 + lane * 4);
        if (resY) {
            const float* gt = MOD + (res_layer * 9 + r) * 6144 + res_goff;
#pragma unroll
            for (int i = 0; i < 4; ++i) { const int col = i * 256 + lane * 4;
                const float4 g = *(const float4*)(gt + col); float4 y;
                if (row >= T_LAT && ctx_ways > 0) {
                    const int cr = row - T_LAT; const float* pp = (const float*)(p.ws + OFF_PART) + (size_t)(((cr >> 8) * 4 + i) * ctx_ways) * 65536 + (cr & 255) * 256 + lane * 4;
                    y = *(const float4*)pp;
                    for (int q = 1; q < ctx_ways; ++q) { const float4 z = *(const float4*)(pp + (size_t)q * 65536); y.x += z.x; y.y += z.y; y.z += z.z; y.w += z.w; }
                } else { const uint2 yr = *(const uint2*)(resY + (size_t)row * 1024 + col);
                    y = make_float4(__uint_as_float(yr.x << 16), __uint_as_float(yr.x & 0xFFFF0000u), __uint_as_float(yr.y << 16), __uint_as_float(yr.y & 0xFFFF0000u)); }
                v[i].x += g.x * y.x; v[i].y += g.y * y.y; v[i].z += g.z * y.z; v[i].w += g.w * y.w;
                *(float4*)(dstx + col) = v[i]; }
        }
#pragma unroll
        for (int i = 0; i < 4; ++i) ss += v[i].x * v[i].x + v[i].y * v[i].y + v[i].z * v[i].z + v[i].w * v[i].w;
        ss = wave_sum(ss);
        const float rs = rsqrtf(ss * (1.f / 1024.f) + NORM_EPS);
        if (a.i8s) {
            float oo[4][4]; float amax = 0.f;
#pragma unroll
            for (int i = 0; i < 4; ++i) { const int col = i * 256 + lane * 4;
                const float4 g = *(const float4*)(gain + col), sh = *(const float4*)(md + col), sc = *(const float4*)(md + 1024 + col);
                oo[i][0] = (v[i].x * rs * g.x) * (1.f + sc.x) + sh.x; oo[i][1] = (v[i].y * rs * g.y) * (1.f + sc.y) + sh.y;
                oo[i][2] = (v[i].z * rs * g.z) * (1.f + sc.z) + sh.z; oo[i][3] = (v[i].w * rs * g.w) * (1.f + sc.w) + sh.w;
                amax = fmaxf(fmaxf(amax, fmaxf(fabsf(oo[i][0]), fabsf(oo[i][1]))), fmaxf(fabsf(oo[i][2]), fabsf(oo[i][3]))); }
#pragma unroll
            for (int o_ = 1; o_ < 64; o_ <<= 1) amax = fmaxf(amax, __shfl_xor(amax, o_));
            amax = fmaxf(amax, 1e-20f);
            const float qs = 127.f / amax;
#pragma unroll
            for (int i = 0; i < 4; ++i) { const int q0 = (int)rintf(oo[i][0] * qs), q1 = (int)rintf(oo[i][1] * qs), q2 = (int)rintf(oo[i][2] * qs), q3 = (int)rintf(oo[i][3] * qs);
                *(int*)(a.h8 + (size_t)row * 1024 + i * 256 + lane * 4) = (int)((unsigned)(q0 & 255) | ((unsigned)(q1 & 255) << 8) | ((unsigned)(q2 & 255) << 16) | ((unsigned)q3 << 24)); }
            if (lane == 0) a.i8s[row] = amax * (1.f / 127.f);
            return;
        }
        float lg[8] = {0.f, 0.f, 0.f, 0.f, 0.f, 0.f, 0.f, 0.f};
#pragma unroll
        for (int i = 0; i < 4; ++i) {
            const int col = i * 256 + lane * 4;
            const float4 g = *(const float4*)(gain + col), sh = *(const float4*)(md + col), sc = *(const float4*)(md + 1024 + col);
            float o[4];
            o[0] = (v[i].x * rs * g.x) * (1.f + sc.x) + sh.x; o[1] = (v[i].y * rs * g.y) * (1.f + sc.y) + sh.y;
            o[2] = (v[i].z * rs * g.z) * (1.f + sc.z) + sh.z; o[3] = (v[i].w * rs * g.w) * (1.f + sc.w) + sh.w;
            if (a.h8) {
                int w8 = 0; w8 = __builtin_amdgcn_cvt_pk_fp8_f32(f8clamp(o[0] * F8_SH), f8clamp(o[1] * F8_SH), w8, false); w8 = __builtin_amdgcn_cvt_pk_fp8_f32(f8clamp(o[2] * F8_SH), f8clamp(o[3] * F8_SH), w8, true);
                *(int*)(a.h8 + (size_t)row * 1024 + col) = w8;
            }
            if (!a.h8 || a.both) {
            uint2 pk; pk.x = (unsigned)f2bf(o[0]) | ((unsigned)f2bf(o[1]) << 16); pk.y = (unsigned)f2bf(o[2]) | ((unsigned)f2bf(o[3]) << 16);
            *(uint2*)(H + (size_t)row * 1024 + col) = pk; }
            if (router) {
                const float* rw = p.in[20] + (size_t)col * 8;
#pragma unroll
                for (int j = 0; j < 4; ++j) {
                    const float4 w0 = *(const float4*)(rw + j * 8), w1 = *(const float4*)(rw + j * 8 + 4);
                    lg[0] += o[j] * w0.x; lg[1] += o[j] * w0.y; lg[2] += o[j] * w0.z; lg[3] += o[j] * w0.w;
                    lg[4] += o[j] * w1.x; lg[5] += o[j] * w1.y; lg[6] += o[j] * w1.z; lg[7] += o[j] * w1.w;
                }
            }
        }
        if (router) {
#pragma unroll
            for (int e = 0; e < 8; ++e) lg[e] = wave_sum(lg[e]);
            if (lane == 0) {
                int e0 = 0; float v0 = lg[0];
#pragma unroll
                for (int e = 1; e < 8; ++e) if (lg[e] > v0) { v0 = lg[e]; e0 = e; }
                int e1 = -1; float v1 = -3.0e38f;
#pragma unroll
                for (int e = 0; e < 8; ++e) if (e != e0 && lg[e] > v1) { v1 = lg[e]; e1 = e; }
                const float x1 = expf(v1 - v0), inv = 1.f / (1.f + x1);
                const float w0 = inv, w1 = x1 * inv;
                const int p0 = atomicAdd(&CNT[e0], 1), p1 = atomicAdd(&CNT[8 + e1], 1);
                LIST[(size_t)e0 * 32768 + p0] = row; WL[(size_t)e0 * 32768 + p0] = w0;
                LIST[(size_t)(8 + e1) * 32768 + p1] = row; WL[(size_t)(8 + e1) * 32768 + p1] = w1;
                { int* iv = (int*)(p.ws + OFF_INV) + (size_t)row * 8; *(int4*)iv = make_int4(e0, p0, e1, p1); *(float2*)(iv + 4) = make_float2(w0, w1); }
            }
        }
    }
}
__device__ __forceinline__ void norm_rows4(const P& p, const NormArgs& a, int row0, int lane) {
    const float* MOD = (const float*)(p.ws + OFF_MOD);
    bf16_t* H = (bf16_t*)(p.ws + OFF_H); float* XC = (float*)(p.ws + OFF_XC);
    const bool lat = row0 < T_LAT; const int r = lat ? (row0 >> 12) : 8;
    const float* srcb = lat ? (a.from_input ? p.in[0] : p.out) + (size_t)row0 * 1024 : (a.from_input ? p.in[2] : XC) + (size_t)(row0 - T_LAT) * 1024;
    float* dstb = lat ? p.out + (size_t)row0 * 1024 : XC + (size_t)(row0 - T_LAT) * 1024;
    float4 v[4][4]; uint2 y[4][4];
#pragma unroll
    for (int q = 0; q < 4; ++q)
#pragma unroll
        for (int i = 0; i < 4; ++i) { v[q][i] = *(const float4*)(srcb + q * 1024 + i * 256 + lane * 4); y[q][i] = *(const uint2*)(a.resY + (size_t)(row0 + q) * 1024 + i * 256 + lane * 4); }
    const float* gt = MOD + (a.res_layer * 9 + r) * 6144 + a.res_goff;
    const float* md = MOD + (a.layer * 9 + r) * 6144 + (a.which == 1 ? 0 : 3072);
    const float* gain = (a.which == 1 ? p.in[6] : p.in[7]) + a.layer * 1024;
    float4 gg[4], gn[4], sh[4], sc[4];
#pragma unroll
    for (int i = 0; i < 4; ++i) { const int col = i * 256 + lane * 4; gg[i] = *(const float4*)(gt + col); gn[i] = *(const float4*)(gain + col); sh[i] = *(const float4*)(md + col); sc[i] = *(const float4*)(md + 1024 + col); }
#pragma unroll
    for (int q = 0; q < 4; ++q) {
        float ss = 0.f;
#pragma unroll
        for (int i = 0; i < 4; ++i) { const uint2 yr = y[q][i];
            v[q][i].x += gg[i].x * __uint_as_float(yr.x << 16); v[q][i].y += gg[i].y * __uint_as_float(yr.x & 0xFFFF0000u);
            v[q][i].z += gg[i].z * __uint_as_float(yr.y << 16); v[q][i].w += gg[i].w * __uint_as_float(yr.y & 0xFFFF0000u);
            *(float4*)(dstb + q * 1024 + i * 256 + lane * 4) = v[q][i];
            ss += v[q][i].x * v[q][i].x + v[q][i].y * v[q][i].y + v[q][i].z * v[q][i].z + v[q][i].w * v[q][i].w; }
        ss = wave_sum(ss);
        const float rs = rsqrtf(ss * (1.f / 1024.f) + NORM_EPS);
        if (a.i8s) {
            float oo[4][4]; float amax = 0.f;
#pragma unroll
            for (int i = 0; i < 4; ++i) {
                oo[i][0] = (v[q][i].x * rs * gn[i].x) * (1.f + sc[i].x) + sh[i].x; oo[i][1] = (v[q][i].y * rs * gn[i].y) * (1.f + sc[i].y) + sh[i].y;
                oo[i][2] = (v[q][i].z * rs * gn[i].z) * (1.f + sc[i].z) + sh[i].z; oo[i][3] = (v[q][i].w * rs * gn[i].w) * (1.f + sc[i].w) + sh[i].w;
                amax = fmaxf(fmaxf(amax, fmaxf(fabsf(oo[i][0]), fabsf(oo[i][1]))), fmaxf(fabsf(oo[i][2]), fabsf(oo[i][3]))); }
#pragma unroll
            for (int o_ = 1; o_ < 64; o_ <<= 1) amax = fmaxf(amax, __shfl_xor(amax, o_));
            amax = fmaxf(amax, 1e-20f);
            const float qs = 127.f / amax;
#pragma unroll
            for (int i = 0; i < 4; ++i) { const int q0 = (int)rintf(oo[i][0] * qs), q1 = (int)rintf(oo[i][1] * qs), q2 = (int)rintf(oo[i][2] * qs), q3 = (int)rintf(oo[i][3] * qs);
                *(int*)(a.h8 + (size_t)(row0 + q) * 1024 + i * 256 + lane * 4) = (int)((unsigned)(q0 & 255) | ((unsigned)(q1 & 255) << 8) | ((unsigned)(q2 & 255) << 16) | ((unsigned)q3 << 24)); }
            if (lane == 0) a.i8s[row0 + q] = amax * (1.f / 127.f);
        } else
#pragma unroll
        for (int i = 0; i < 4; ++i) { float o[4];
            o[0] = (v[q][i].x * rs * gn[i].x) * (1.f + sc[i].x) + sh[i].x; o[1] = (v[q][i].y * rs * gn[i].y) * (1.f + sc[i].y) + sh[i].y;
            o[2] = (v[q][i].z * rs * gn[i].z) * (1.f + sc[i].z) + sh[i].z; o[3] = (v[q][i].w * rs * gn[i].w) * (1.f + sc[i].w) + sh[i].w;
            if (a.h8) { int w8 = 0; w8 = __builtin_amdgcn_cvt_pk_fp8_f32(f8clamp(o[0] * F8_SH), f8clamp(o[1] * F8_SH), w8, false); w8 = __builtin_amdgcn_cvt_pk_fp8_f32(f8clamp(o[2] * F8_SH), f8clamp(o[3] * F8_SH), w8, true);
                *(int*)(a.h8 + (size_t)(row0 + q) * 1024 + i * 256 + lane * 4) = w8; }
            if (!a.h8 || a.both) { uint2 pk; pk.x = (unsigned)f2bf(o[0]) | ((unsigned)f2bf(o[1]) << 16); pk.y = (unsigned)f2bf(o[2]) | ((unsigned)f2bf(o[3]) << 16);
            *(uint2*)(H + (size_t)(row0 + q) * 1024 + i * 256 + lane * 4) = pk; } }
    }
}
__device__ __forceinline__ void norm_help(const P& p, const NormArgs& a, unsigned* cnt, unsigned need, unsigned* claim, int npanels, LAS unsigned* lw) {
    int tid_ = threadIdx.x; asm volatile("" : "+v"(tid_));
    const int wave = __builtin_amdgcn_readfirstlane(tid_ >> 6), lane = tid_ & 63;
    for (;;) {
        __syncthreads();
        if (threadIdx.x == 0) {
            const unsigned part = __hip_atomic_fetch_add(claim, 1u, __ATOMIC_RELAXED, __HIP_MEMORY_SCOPE_AGENT);
            if (part < (unsigned)npanels * 4u) {
                unsigned sp = 0;
                while (__hip_atomic_load(cnt + 64 * (part >> 2), __ATOMIC_RELAXED, __HIP_MEMORY_SCOPE_AGENT) < need) { __builtin_amdgcn_s_sleep(8); if (++sp > (1u << 22)) break; }
                __builtin_amdgcn_fence(__ATOMIC_ACQUIRE, "agent");
                asm volatile("s_waitcnt vmcnt(0)" ::: "memory");
            }
            lw[0] = part;
        }
        __syncthreads();
        const unsigned part = lw[0];
        if (part >= (unsigned)npanels * 4u) break;
        const int base = (int)(part >> 2) * 256 + (int)(part & 3u) * 64 + wave * 8;
        norm_rows4(p, a, base, lane); norm_rows4(p, a, base + 4, lane);
    }
}
__device__ __forceinline__ void ph_norm(const P& p, int layer, int which, int nrows, bool router, bool from_input, const bf16_t* resY, int res_layer, int res_goff, int ctx_ways, unsigned char* h8, bool both, float* i8s = nullptr) {
    int tid_ = threadIdx.x; asm volatile("" : "+v"(tid_));
    const int wave = tid_ >> 6, lane = tid_ & 63;
    const NormArgs a{layer, which, router, from_input, resY, res_layer, res_goff, ctx_ways, h8, both, i8s};
    for (int row = blockIdx.x * 8 + wave; row < nrows; row += gridDim.x * 8) norm_row(p, a, row, lane);
}

__host__ __device__ __forceinline__ int win_col(int n) {
    if (n < 352) return n;
    if (n < 992) { const int d = (n - 352) & 63, e = d & 31; return n - d + (d & 32) + (e < 16 ? 2 * e : 2 * (e - 16) + 1); }
    if (n < 1120) return n;
    if (n < 1632) { const int d = (n - 1120) & 63; return PJ_RQ + (n - 1120) - d + (d < 32 ? 2 * d : 2 * (d - 32) + 1); }
    return PJ_RQ + (n - 1120);
}
struct ConvJob { const float* src; bf16_t* dst; int K, N, map, f8; const unsigned* cmax = nullptr; float* cs = nullptr; };
__device__ __forceinline__ void conv_tiles4(const ConvJob& j, int tile, int step, int ntl, float* T  ) {
    int tid_ = threadIdx.x; asm volatile("" : "+v"(tid_));
    const int ntn = (j.N + 63) >> 6, t = tid_;
    float4 v[4][2];
#pragma unroll
    for (int q = 0; q < 4; ++q) { const int tl = tile + q * step, tk = tl / ntn, tn = tl % ntn;
#pragma unroll
        for (int i = 0; i < 2; ++i) { const int kr = (t >> 4) + 32 * i, c4 = (t & 15) * 4, n = tn * 64 + c4;
            v[q][i] = make_float4(0.f, 0.f, 0.f, 0.f);
            if (tl < ntl && n < j.N) v[q][i] = *(const float4*)(j.src + (size_t)(tk * 64 + kr) * j.N + n); } }
    __syncthreads();
#pragma unroll
    for (int q = 0; q < 4; ++q)
#pragma unroll
        for (int i = 0; i < 2; ++i) { const int kr = (t >> 4) + 32 * i, c4 = (t & 15) * 4; float* Tq = T + q * (64 * 65);
            Tq[kr * 65 + c4 + 0] = v[q][i].x; Tq[kr * 65 + c4 + 1] = v[q][i].y; Tq[kr * 65 + c4 + 2] = v[q][i].z; Tq[kr * 65 + c4 + 3] = v[q][i].w; }
    __syncthreads();
#pragma unroll
    for (int q = 0; q < 4; ++q) { const int tl = tile + q * step, tk = tl / ntn, tn = tl % ntn; const float* Tq = T + q * (64 * 65);
        const int nl = t >> 3, ks = (t & 7) * 8, n = tn * 64 + nl;
        if (tl < ntl && n < j.N) {
            int nd = j.map == 0 ? n : ((n >> 7) * 256 + (n & 127) + (j.map == 2 ? 128 : 0)); bool f8 = j.f8 != 0;
            if (j.map == 3) {
                nd = win_col(n);
                f8 = nd < PJ_F8 && !j.cmax; }
            if (j.cmax) {
                const float am = fmaxf(__uint_as_float(j.cmax[nd]), 1e-30f), qs = 127.f / am;
                int q[8];
#pragma unroll
                for (int i = 0; i < 8; ++i) q[i] = (int)rintf(Tq[(ks + i) * 65 + nl] * qs) & 255;
                *(uint2*)((unsigned char*)j.dst + (size_t)nd * j.K + tk * 64 + ks) = make_uint2((unsigned)(q[0] | (q[1] << 8) | (q[2] << 16) | (q[3] << 24)), (unsigned)(q[4] | (q[5] << 8) | (q[6] << 16) | (q[7] << 24)));
                if (tk == 0 && ks == 0) j.cs[nd] = am * (1.f / 127.f);
            } else if (f8) {
                int w0 = 0, w1 = 0;
                w0 = __builtin_amdgcn_cvt_pk_fp8_f32(f8clamp(Tq[(ks + 0) * 65 + nl] * F8_SW), f8clamp(Tq[(ks + 1) * 65 + nl] * F8_SW), w0, false);
                w0 = __builtin_amdgcn_cvt_pk_fp8_f32(f8clamp(Tq[(ks + 2) * 65 + nl] * F8_SW), f8clamp(Tq[(ks + 3) * 65 + nl] * F8_SW), w0, true);
                w1 = __builtin_amdgcn_cvt_pk_fp8_f32(f8clamp(Tq[(ks + 4) * 65 + nl] * F8_SW), f8clamp(Tq[(ks + 5) * 65 + nl] * F8_SW), w1, false);
                w1 = __builtin_amdgcn_cvt_pk_fp8_f32(f8clamp(Tq[(ks + 6) * 65 + nl] * F8_SW), f8clamp(Tq[(ks + 7) * 65 + nl] * F8_SW), w1, true);
                *(uint2*)((unsigned char*)j.dst + (size_t)nd * j.K + tk * 64 + ks) = make_uint2((unsigned)w0, (unsigned)w1);
            } else {
            unsigned w[4];
#pragma unroll
            for (int i = 0; i < 4; ++i) w[i] = (unsigned)f2bf(Tq[(ks + 2 * i) * 65 + nl]) | ((unsigned)f2bf(Tq[(ks + 2 * i + 1) * 65 + nl]) << 16);
            *(uint4*)(j.dst + (size_t)nd * j.K + tk * 64 + ks) = make_uint4(w[0], w[1], w[2], w[3]);
            }
        } }
}
__device__ __forceinline__ int conv_ntiles(int K, int N) { return (K >> 6) * ((N + 63) >> 6); }

#define CONV_F8 0
__device__ __forceinline__ void ph_conv_early(const P& p, float* lds) {
    const int G = gridDim.x, bid = blockIdx.x;
    int base = 0;
#define CONV_RUN(SRC, DST, K_, N_, MAP_) do { ConvJob j{SRC, DST, K_, N_, MAP_, CONV_F8}; const int nt_ = conv_ntiles(K_, N_), ns_ = (nt_ + 3) >> 2; \
          \
        for (int u = (((bid - base % G) + G) % G); u < ns_; u += G) conv_tiles4(j, 4 * u, 1, nt_, lds); base += ns_; } while (0)
    for (int l = 0; l < 2; ++l) {
        CONV_RUN(p.in[16] + (size_t)l * 1024 * 1024, (bf16_t*)(p.ws + OFF_WOUT) + (size_t)l * 1024 * 1024, 1024, 1024, 0);
        CONV_RUN(p.in[10] + (size_t)l * 192 * 384, (bf16_t*)(p.ws + OFF_WUQ) + (size_t)l * 384 * 192, 192, 384, 0);
        CONV_RUN(p.in[12] + (size_t)l * 128 * 512, (bf16_t*)(p.ws + OFF_WUKV) + (size_t)l * 512 * 128, 128, 512, 0);
    }
#undef CONV_F8
#define CONV_F8 1
    CONV_RUN(p.in[19], (bf16_t*)(p.ws + OFF_FD), D_FF, 1024, 0);
    for (int l = 0; l < 2; ++l) {
        uint4* z = (uint4*)((unsigned char*)((bf16_t*)(p.ws + OFF_WIN) + (size_t)l * PROJ_LD * 1024) + (size_t)1120 * 1024);
        const int n16 = (PJ_F8 - 1120) * 1024 / 16;
        for (int i = bid * NT + threadIdx.x; i < n16; i += G * NT) z[i] = make_uint4(0u, 0u, 0u, 0u);
    }
}
#undef CONV_F8
#define CONV_F8 1
__device__ __forceinline__ void ph_fgu_colmax(const P& p) {
    const int G = gridDim.x, bid = blockIdx.x;
    unsigned* cmax = (unsigned*)(p.ws + OFF_CMAX);
    for (int u = bid; u < 2 * 8 * 6; u += G) {
        const int mat = u / 48, kc = (u % 48) / 6, nc = u % 6, n = nc * 512 + (int)threadIdx.x;
        if (n < D_FF) { const float* s = (mat ? p.in[18] : p.in[17]) + (size_t)(kc * 128) * D_FF + n; float am = 0.f;
#pragma unroll 8
            for (int k = 0; k < 128; ++k) am = fmaxf(am, fabsf(s[(size_t)k * D_FF]));
            atomicMax(cmax + ((n >> 7) * 256 + (n & 127) + (mat ? 128 : 0)), __float_as_uint(am)); }
    }
}
__device__ __forceinline__ void ph_win_colmax(const P& p) {
    const int G = gridDim.x, bid = blockIdx.x;
    for (int u = G - 1 - bid; u < 2 * 8 * 5; u += G) {
        const int l = u / 40, kc = (u % 40) / 5, nc = u % 5, n = nc * 512 + (int)threadIdx.x;
        if (n < IN_DIM) { const float* s = p.in[8] + (size_t)l * 1024 * IN_DIM + (size_t)(kc * 128) * IN_DIM + n; float am = 0.f;
#pragma unroll 8
            for (int k = 0; k < 128; ++k) am = fmaxf(am, fabsf(s[(size_t)k * IN_DIM]));
            atomicMax((unsigned*)(p.ws + OFF_CMAXW) + l * PROJ_LD + win_col(n), __float_as_uint(am)); }
    }
}
__device__ __forceinline__ void ph_conv_fgu_i8(const P& p, float* lds) {
    const int G = gridDim.x, bid = blockIdx.x;
    int base = 0;
#define CONV_RUN_I8(SRC, MAP_) do { ConvJob j{SRC, (bf16_t*)(p.ws + OFF_FGU), 1024, D_FF, MAP_, 0, (const unsigned*)(p.ws + OFF_CMAX), (float*)(p.ws + OFF_CS8)}; const int nt_ = conv_ntiles(1024, D_FF), ns_ = (nt_ + 3) >> 2; \
        for (int u = (((bid - base % G) + G) % G); u < ns_; u += G) conv_tiles4(j, 4 * u, 1, nt_, lds); base += ns_; } while (0)
    CONV_RUN_I8(p.in[17], 1);
    CONV_RUN_I8(p.in[18], 2);
#undef CONV_RUN_I8
    for (int l = 0; l < 2; ++l) {
        ConvJob j{p.in[8] + (size_t)l * 1024 * IN_DIM, (bf16_t*)(p.ws + OFF_WIN) + (size_t)l * PROJ_LD * 1024, 1024, IN_DIM, 3, 0, (const unsigned*)(p.ws + OFF_CMAXW) + l * PROJ_LD, (float*)(p.ws + OFF_CSW) + l * PROJ_LD};
        const int nt_ = conv_ntiles(1024, IN_DIM), ns_ = (nt_ + 3) >> 2;
        for (int u = (((bid - base % G) + G) % G); u < ns_; u += G) conv_tiles4(j, 4 * u, 1, nt_, lds); base += ns_; }
}
__device__ __forceinline__ void ph_conv_late(const P& p, float* lds) {
    const int G = gridDim.x, bid = blockIdx.x;
    int base = 0;
    for (int e = 0; e < NEXP; ++e) {
        CONV_RUN(p.in[21] + (size_t)e * 1024 * D_FFE, (bf16_t*)(p.ws + OFF_MGU + (size_t)e * 2 * D_FFE * 1024), 1024, D_FFE, 1);
        CONV_RUN(p.in[22] + (size_t)e * 1024 * D_FFE, (bf16_t*)(p.ws + OFF_MGU + (size_t)e * 2 * D_FFE * 1024), 1024, D_FFE, 2);
        CONV_RUN(p.in[23] + (size_t)e * D_FFE * 1024, (bf16_t*)(p.ws + OFF_MD + (size_t)e * 1024 * D_FFE), D_FFE, 1024, 0);
    }
}

namespace pg8 {
#define PG8_LAS __attribute__((address_space(3)))
typedef short bf16x8 __attribute__((ext_vector_type(8)));
typedef float f32x4 __attribute__((ext_vector_type(4)));
typedef unsigned u32x4 __attribute__((ext_vector_type(4)));
typedef int i32x4v __attribute__((ext_vector_type(4)));
constexpr int BM = 256, BK = 64, HALF = 128, HTB = HALF * BK * 2, STAGE_BYTES = 8 * HTB, NXCD = 8, WGM = 8;

__host__ __device__ __forceinline__ int lds_byte(int r, int c) { const int st = (r >> 4) * 2 + (c >> 5), rr = r & 15, cc = c & 31, ob = rr * 64 + cc * 2; return st * 1024 + (ob ^ (((ob >> 9) & 1) << 5)); }
__host__ __device__ __forceinline__ void stage_rc(int b, int& R, int& C) { const int st = b / 1024, sb = b % 1024, swz = sb ^ (((sb >> 9) & 1) << 5); R = (st >> 1) * 16 + swz / 64; C = (st & 1) * 32 + (swz % 64) / 2; }
__host__ __device__ __forceinline__ int perm32(int rho) { const int n = rho >> 4, i = rho & 15; return 8 * (i >> 2) + 4 * n + (i & 3); }

struct Unit { int pm, pn, e, rl, kp, ri; };

__device__ __forceinline__ void static_order_L(int L, int nM, int nN, int& pm, int& pn) {
    const int nwg = nM * nN;
    int wgid = L; { const int q = nwg / NXCD, r = nwg % NXCD, xcd = wgid % NXCD, off = wgid / NXCD; wgid = (xcd < r ? xcd * (q + 1) : r * (q + 1) + (xcd - r) * q) + off; }
    const int nig = WGM * nN, gid = wgid / nig, fm = gid * WGM, gsz = (nM - fm) < WGM ? (nM - fm) : WGM;
    pm = fm + ((wgid % nig) % gsz); pn = (wgid % nig) / gsz;
}
__device__ __forceinline__ bool static_order(int i, int G, int c, int nM, int nN, int& pm, int& pn) {
    const int nwg = nM * nN; const long L = (long)i * G + c; if (L >= nwg) return false;
    static_order_L((int)L, nM, nN, pm, pn); return true;
}

template <bool FP8_, bool I8_ = false> struct DenseSchedT {
    static constexpr bool GATHER = false, FP8 = FP8_, I8 = I8_;
    const bf16_t* A; const bf16_t* Bt; int lda, K, nM, nN, G, c; int L0 = 0, Lend = 1 << 30;
    __device__ __forceinline__ int nt() const { return K / BK; }
    __device__ __forceinline__ bool next(int i, Unit& u) const { u.e = 0; u.kp = 0; u.ri = 0; const long L = L0 + (long)i * G + c; const int nwg = nM * nN;
        if (L >= nwg || L >= Lend) return false; static_order_L((int)L, nM, nN, u.pm, u.pn); u.rl = u.pm; return true; }
    __device__ __forceinline__ const char* a_base(const Unit& u) const { return (const char*)A + (size_t)u.pm * BM * lda * 2; }
    __device__ __forceinline__ const char* b_base(const Unit& u) const { return (const char*)Bt + (size_t)u.pn * BM * K * 2; }
    __device__ __forceinline__ unsigned a_off(const Unit&, int r, int C) const { return (unsigned)(r * lda + C) * 2u; }
};
typedef DenseSchedT<false> DenseSched;
struct DenseSplitSched {
    static constexpr bool GATHER = false;
    const bf16_t* A; const bf16_t* Bt; int lda, K, pm0, nMs, nN, ways, ntp, G, c;
    __device__ __forceinline__ int nt() const { return ntp; }
    __device__ __forceinline__ bool next(int i, Unit& u) const {
        const long j = (long)i * G + c; if (j >= (long)nMs * nN * ways) return false;
        const int ui = (int)(j / ways); u.kp = (int)(j % ways) * ntp; u.ri = (int)j; u.pm = pm0 + ui / nN; u.pn = ui % nN; u.e = 0; u.rl = u.pm; return true;
    }
    __device__ __forceinline__ const char* a_base(const Unit& u) const { return (const char*)A + (size_t)u.pm * BM * lda * 2 + (size_t)u.kp * (BK * 2); }
    __device__ __forceinline__ const char* b_base(const Unit& u) const { return (const char*)Bt + (size_t)u.pn * BM * K * 2 + (size_t)u.kp * (BK * 2); }
    __device__ __forceinline__ unsigned a_off(const Unit&, int r, int C) const { return (unsigned)(r * lda + C) * 2u; }
};
template <bool GATHER_, bool FP8_ = false> struct MoeSched {
    static constexpr bool GATHER = GATHER_, FP8 = FP8_;
    const bf16_t* A; const bf16_t* Bt; int lda, K, nN, G, c; size_t bstride;
    const int* list;
    const PG8_LAS int* tab;
    int ulo, uhi, ways, ntp;
    __device__ __forceinline__ int nt() const { return ntp; }
    __device__ __forceinline__ bool next(int i, Unit& u) const {
        const int nM = __builtin_amdgcn_readfirstlane(tab[16]);
        const long j = (long)i * G + c; const int L = ulo + (int)(j / ways);
        if (L >= uhi) return false;
        u.kp = (int)(j % ways) * ntp; u.ri = (int)j;
        static_order_L(L, nM, nN, u.pm, u.pn);
        int e = 0, t0 = 0;
#pragma unroll
        for (int k = 1; k < 8; ++k) { const int tk = tab[8 + k]; if (u.pm >= tk) { e = k; t0 = tk; } }
        u.e = __builtin_amdgcn_readfirstlane(e); u.rl = u.pm - __builtin_amdgcn_readfirstlane(t0); return true;
    }
    __device__ __forceinline__ const char* a_base(const Unit& u) const { return (GATHER ? (const char*)A : (const char*)A + (size_t)u.pm * BM * lda * 2) + (size_t)u.kp * (BK * 2); }
    __device__ __forceinline__ const char* b_base(const Unit& u) const { return (const char*)(Bt + (size_t)u.e * bstride) + (size_t)u.pn * BM * K * 2 + (size_t)u.kp * (BK * 2); }
    __device__ __forceinline__ unsigned a_off(const Unit& u, int r, int C) const {
        if (!GATHER) return (unsigned)(r * lda + C) * 2u;
        const int lr = u.rl * BM + r, c1 = tab[u.e] - 1;
        const int tok = list[(size_t)u.e * 32768 + (lr < c1 ? lr : c1)];
        return (unsigned)(tok * lda + C) * 2u;
    }
};

__device__ __forceinline__ unsigned pk2(float lo, float hi) { typedef float f32x2_t __attribute__((ext_vector_type(2))); typedef __bf16 bf16x2_t __attribute__((ext_vector_type(2)));
    f32x2_t v = {lo, hi}; bf16x2_t b = __builtin_convertvector(v, bf16x2_t); return __builtin_bit_cast(unsigned, b); }

struct EpiBf16 {
    static constexpr bool PERM = true;
    bf16_t* O; int ldc;
    __device__ __forceinline__ void operator()(const f32x4 (&acc)[2][2][4][2], const Unit& u, int wr, int wc, int fr, int fq) const {
        const int row0 = u.pm * BM + wr * 64 + fr, col0 = u.pn * BM + wc * 32 + 8 * fq;
#pragma unroll
        for (int ai = 0; ai < 2; ++ai)
#pragma unroll
            for (int m = 0; m < 4; ++m) { bf16_t* rowp = O + (size_t)(row0 + ai * HALF + m * 16) * ldc + col0;
#pragma unroll
                for (int bj = 0; bj < 2; ++bj) { const f32x4 v0 = acc[ai][bj][m][0], v1 = acc[ai][bj][m][1];
                    u32x4 w; w[0] = pk2(v0[0], v0[1]); w[1] = pk2(v0[2], v0[3]); w[2] = pk2(v1[0], v1[1]); w[3] = pk2(v1[2], v1[3]);
                    *(u32x4*)(rowp + bj * HALF) = w; } }
    }
};
struct EpiBf16Norm {
    static constexpr bool PERM = true, HAS_POST = true;
    bf16_t* O; int ldc; unsigned obytes; unsigned* cnt; float sc;
    __device__ __forceinline__ void operator()(const f32x4 (&acc)[2][2][4][2], const Unit& u, int wr, int wc, int fr, int fq) const {
        const auto rsrc = __builtin_amdgcn_make_buffer_rsrc((void*)O, 0, (int)obytes, 0x00020000);
        const int row0 = u.pm * BM + wr * 64 + fr, col0 = u.pn * BM + wc * 32 + 8 * fq;
#pragma unroll
        for (int ai = 0; ai < 2; ++ai)
#pragma unroll
            for (int m = 0; m < 4; ++m) { const unsigned ro = (unsigned)((row0 + ai * HALF + m * 16) * ldc + col0) * 2u;
#pragma unroll
                for (int bj = 0; bj < 2; ++bj) { const f32x4 v0 = acc[ai][bj][m][0] * sc, v1 = acc[ai][bj][m][1] * sc;
                    u32x4 w; w[0] = pk2(v0[0], v0[1]); w[1] = pk2(v0[2], v0[3]); w[2] = pk2(v1[0], v1[1]); w[3] = pk2(v1[2], v1[3]);
                    __builtin_amdgcn_raw_buffer_store_b128(w, rsrc, ro + bj * HALF * 2, 0, 16); } }
    }
    __device__ __forceinline__ void post(const Unit& u) const {
        asm volatile("s_waitcnt vmcnt(0)" ::: "memory");
        if ((threadIdx.x & 63) == 0) __hip_atomic_fetch_add(cnt + 64 * u.pm, 1u, __ATOMIC_RELAXED, __HIP_MEMORY_SCOPE_AGENT);
    }
};
template <bool F8IN, bool F8> struct EpiSwigluT {
    static constexpr bool PERM = true;
    bf16_t* O; int ldc;
    __device__ __forceinline__ void operator()(const f32x4 (&acc)[2][2][4][2], const Unit& u, int wr, int wc, int fr, int fq) const {
        const int row0 = u.pm * BM + wr * 64 + fr, col0 = u.pn * HALF + wc * 32 + 8 * fq;
#pragma unroll
        for (int ai = 0; ai < 2; ++ai)
#pragma unroll
            for (int m = 0; m < 4; ++m) { bf16_t* rowp = O + (size_t)(row0 + ai * HALF + m * 16) * ldc + col0;
                float o[8];
                typedef float f32x2_t __attribute__((ext_vector_type(2)));
#pragma unroll
                for (int n = 0; n < 2; ++n)
#pragma unroll
                    for (int j = 0; j < 4; j += 2) {
                        f32x2_t gg = {acc[ai][0][m][n][j], acc[ai][0][m][n][j + 1]}, uu = {acc[ai][1][m][n][j], acc[ai][1][m][n][j + 1]};
                        if constexpr (F8IN) { gg = gg * (1.f / (F8_SH * F8_SW)); uu = uu * ((F8 ? F8_SA : 1.f) / (F8_SH * F8_SW)); } else if constexpr (F8) uu = uu * F8_SA;
                        const f32x2_t t = gg * (-1.4426950408889634f); f32x2_t e;
                        e[0] = __builtin_amdgcn_exp2f(t[0]); e[1] = __builtin_amdgcn_exp2f(t[1]);
                        e = e + 1.0f; f32x2_t r; r[0] = __builtin_amdgcn_rcpf(e[0]); r[1] = __builtin_amdgcn_rcpf(e[1]);
                        const f32x2_t v = (gg * uu) * r; o[n * 4 + j] = v[0]; o[n * 4 + j + 1] = v[1]; }
                if constexpr (F8) { int w0 = 0, w1 = 0;
                    w0 = __builtin_amdgcn_cvt_pk_fp8_f32(f8clamp(o[0]), f8clamp(o[1]), w0, false); w0 = __builtin_amdgcn_cvt_pk_fp8_f32(f8clamp(o[2]), f8clamp(o[3]), w0, true);
                    w1 = __builtin_amdgcn_cvt_pk_fp8_f32(f8clamp(o[4]), f8clamp(o[5]), w1, false); w1 = __builtin_amdgcn_cvt_pk_fp8_f32(f8clamp(o[6]), f8clamp(o[7]), w1, true);
                    typedef unsigned u32x2v __attribute__((ext_vector_type(2))); u32x2v w = {(unsigned)w0, (unsigned)w1};
                    *(u32x2v*)((unsigned char*)O + (size_t)(row0 + ai * HALF + m * 16) * ldc + col0) = w; }
                else { u32x4 w; w[0] = pk2(o[0], o[1]); w[1] = pk2(o[2], o[3]); w[2] = pk2(o[4], o[5]); w[3] = pk2(o[6], o[7]);
                *(u32x4*)rowp = w; } }
    }
};
typedef EpiSwigluT<false, false> EpiSwiglu;
struct EpiSwigluI8 {
    static constexpr bool PERM = true;
    bf16_t* O; int ldc; const float* rsc; const float* csc;
    __device__ __forceinline__ void operator()(const f32x4 (&acc)[2][2][4][2], const Unit& u, int wr, int wc, int fr, int fq) const {
        const int row0 = u.pm * BM + wr * 64 + fr, col0 = u.pn * HALF + wc * 32 + 8 * fq;
        const float* cg = csc + u.pn * BM + wc * 32 + 8 * fq;
        const f32x4 cg0 = *(const f32x4*)cg, cg1 = *(const f32x4*)(cg + 4), cu0 = *(const f32x4*)(cg + HALF), cu1 = *(const f32x4*)(cg + HALF + 4);
        float rs8[8];
#pragma unroll
        for (int i = 0; i < 8; ++i) rs8[i] = rsc[row0 + (i >> 2) * HALF + (i & 3) * 16];
#pragma unroll
        for (int ai = 0; ai < 2; ++ai)
#pragma unroll
            for (int m = 0; m < 4; ++m) { const int row = row0 + ai * HALF + m * 16; const float rsv = rs8[ai * 4 + m];
                float o[8];
#pragma unroll
                for (int n = 0; n < 2; ++n)
#pragma unroll
                    for (int j = 0; j < 4; ++j) {
                        const float gg = (float)__float_as_int(acc[ai][0][m][n][j]) * (rsv * (n ? cg1[j] : cg0[j])), uu = (float)__float_as_int(acc[ai][1][m][n][j]) * (rsv * F8_SA * (n ? cu1[j] : cu0[j]));
                        const float e = __builtin_amdgcn_exp2f(gg * (-1.4426950408889634f)) + 1.0f;
                        o[n * 4 + j] = (gg * uu) * __builtin_amdgcn_rcpf(e); }
                int w0 = 0, w1 = 0;
                w0 = __builtin_amdgcn_cvt_pk_fp8_f32(f8clamp(o[0]), f8clamp(o[1]), w0, false); w0 = __builtin_amdgcn_cvt_pk_fp8_f32(f8clamp(o[2]), f8clamp(o[3]), w0, true);
                w1 = __builtin_amdgcn_cvt_pk_fp8_f32(f8clamp(o[4]), f8clamp(o[5]), w1, false); w1 = __builtin_amdgcn_cvt_pk_fp8_f32(f8clamp(o[6]), f8clamp(o[7]), w1, true);
                typedef unsigned u32x2v __attribute__((ext_vector_type(2))); u32x2v w = {(unsigned)w0, (unsigned)w1};
                *(u32x2v*)((unsigned char*)O + (size_t)row * ldc + col0) = w; }
    }
};
struct EpiRes {
    static constexpr bool PERM = false;
    const float* in_lat; const float* in_ctx; float* out_lat; float* out_ctx; const float* modl; int goff;
    __device__ __forceinline__ void operator()(const f32x4 (&acc)[2][2][4][2], const Unit& u, int wr, int wc, int fr, int fq) const {
        const bool lat = u.pm < T_LAT / BM; const int r = lat ? (u.pm >> 4) : 8;
        const size_t rbase = (size_t)(lat ? u.pm : u.pm - T_LAT / BM) * BM + wr * 64 + fr;
        const float* src = (lat ? in_lat : in_ctx); float* dst = (lat ? out_lat : out_ctx);
        const int col0 = u.pn * BM + wc * 32 + 4 * fq;
        f32x4 gv[2][2];
#pragma unroll
        for (int bj = 0; bj < 2; ++bj)
#pragma unroll
            for (int n = 0; n < 2; ++n) gv[bj][n] = *(const f32x4*)(modl + r * 6144 + goff + col0 + bj * HALF + n * 16);
#pragma unroll
        for (int ai = 0; ai < 2; ++ai)
#pragma unroll
            for (int m = 0; m < 4; ++m) { const size_t ro = (rbase + ai * HALF + m * 16) * 1024 + col0;
#pragma unroll
                for (int bj = 0; bj < 2; ++bj)
#pragma unroll
                    for (int n = 0; n < 2; ++n) { const f32x4 x = *(const f32x4*)(src + ro + bj * HALF + n * 16);
                        *(f32x4*)(dst + ro + bj * HALF + n * 16) = x + gv[bj][n] * acc[ai][bj][m][n]; } }
    }
};
struct EpiBf16I8 {
    static constexpr bool PERM = true;
    bf16_t* O; int ldc; const float* rsc; const float* csc;
    __device__ __forceinline__ void operator()(const f32x4 (&acc)[2][2][4][2], const Unit& u, int wr, int wc, int fr, int fq) const {
        const int row0 = u.pm * BM + wr * 64 + fr, col0 = u.pn * BM + wc * 32 + 8 * fq;
        f32x4 cs[2][2];
#pragma unroll
        for (int bj = 0; bj < 2; ++bj) { cs[bj][0] = *(const f32x4*)(csc + col0 + bj * HALF); cs[bj][1] = *(const f32x4*)(csc + col0 + bj * HALF + 4); }
        float rs8[8];
#pragma unroll
        for (int i = 0; i < 8; ++i) rs8[i] = rsc[row0 + (i >> 2) * HALF + (i & 3) * 16];
#pragma unroll
        for (int ai = 0; ai < 2; ++ai)
#pragma unroll
            for (int m = 0; m < 4; ++m) { bf16_t* rowp = O + (size_t)(row0 + ai * HALF + m * 16) * ldc + col0; const float rsv = rs8[ai * 4 + m];
#pragma unroll
                for (int bj = 0; bj < 2; ++bj) { float o[8];
#pragma unroll
                    for (int n = 0; n < 2; ++n)
#pragma unroll
                        for (int j = 0; j < 4; ++j) o[n * 4 + j] = (float)__float_as_int(acc[ai][bj][m][n][j]) * (rsv * cs[bj][n][j]);
                    u32x4 w; w[0] = pk2(o[0], o[1]); w[1] = pk2(o[2], o[3]); w[2] = pk2(o[4], o[5]); w[3] = pk2(o[6], o[7]);
                    *(u32x4*)(rowp + bj * HALF) = w; } }
    }
};
struct EpiWinRope {
    static constexpr bool PERM = true;
    bf16_t* PROJp; bf16_t* POSTp; const float* rsc; const float* csc; const float2* tab_ret; const float2* tab32;
    __device__ __forceinline__ void operator()(const f32x4 (&acc)[2][2][4][2], const Unit& u, int wr, int wc, int fr, int fq) const {
        const int row0 = u.pm * BM + wr * 64 + fr, col0 = u.pn * BM + wc * 32 + 8 * fq;
        float rs8[8];
#pragma unroll
        for (int i = 0; i < 8; ++i) rs8[i] = rsc[row0 + (i >> 2) * HALF + (i & 3) * 16];
#pragma unroll
        for (int bj = 0; bj < 2; ++bj) {
            const int c = col0 + bj * HALF;
            const f32x4 cs0 = *(const f32x4*)(csc + c), cs1 = *(const f32x4*)(csc + c + 4);
            int type = 0, hq = 0, dcol = c; float scl = 1.f;
            if (c >= 352 && c < 864) { type = 1; hq = (c - 352) & 63; dcol = PC_QB + (c - 352); }
            else if (c >= 864 && c < 992) { type = 1; hq = (c - 864) & 63; dcol = PC_KB + (c - 864); }
            else if (c >= PJ_RQ && c < PJ_RK) { type = 2; hq = (c - PJ_RQ) & 63; dcol = PC_RQ + (c - PJ_RQ); }
            else if (c >= PJ_RK && c < PJ_RV) { type = 2; hq = (c - PJ_RK) & 63; dcol = PC_RK + (c - PJ_RK); scl = 0.125f; }
            bf16_t* dbase = type ? POSTp + dcol : PROJp + dcol; const int dld = type ? POST_LD : PROJ_LD;
#pragma unroll
            for (int ai = 0; ai < 2; ++ai)
#pragma unroll
                for (int m = 0; m < 4; ++m) { const int row = row0 + ai * HALF + m * 16; const float rsv = rs8[ai * 4 + m];
                    float o[8];
#pragma unroll
                    for (int n = 0; n < 2; ++n)
#pragma unroll
                        for (int j = 0; j < 4; ++j) o[n * 4 + j] = (float)__float_as_int(acc[ai][bj][m][n][j]) * (rsv * (n ? cs1[j] : cs0[j]));
                    if (type != 0) {
                        if (row < T_LAT) { const int t = row & (SEQ - 1);
                            const float2* tb = type == 1 ? tab32 + ((hq & 32) ? (t & 63) : (t >> 6)) * 16 + ((hq & 31) >> 1) : tab_ret + t * 32 + (hq >> 1);
                            const float4 c0 = *(const float4*)tb, c1 = *(const float4*)(tb + 2);
                            const float cz[4] = {c0.x, c0.z, c1.x, c1.z}, sz[4] = {c0.y, c0.w, c1.y, c1.w};
#pragma unroll
                            for (int i = 0; i < 4; ++i) { const float x1 = o[2 * i], x2 = o[2 * i + 1]; o[2 * i] = x1 * cz[i] - x2 * sz[i]; o[2 * i + 1] = x2 * cz[i] + x1 * sz[i]; } }
#pragma unroll
                        for (int i = 0; i < 8; ++i) o[i] *= scl;
                    }
                    u32x4 w; w[0] = pk2(o[0], o[1]); w[1] = pk2(o[2], o[3]); w[2] = pk2(o[4], o[5]); w[3] = pk2(o[6], o[7]);
                    *(u32x4*)(dbase + (size_t)row * dld) = w; }
        }
    }
};
struct EpiBf16S {
    static constexpr bool PERM = true;
    bf16_t* O; int ldc; float sc;
    __device__ __forceinline__ void operator()(const f32x4 (&acc)[2][2][4][2], const Unit& u, int wr, int wc, int fr, int fq) const {
        const int row0 = u.pm * BM + wr * 64 + fr, col0 = u.pn * BM + wc * 32 + 8 * fq;
#pragma unroll
        for (int ai = 0; ai < 2; ++ai)
#pragma unroll
            for (int m = 0; m < 4; ++m) { bf16_t* rowp = O + (size_t)(row0 + ai * HALF + m * 16) * ldc + col0;
#pragma unroll
                for (int bj = 0; bj < 2; ++bj) { const f32x4 v0 = acc[ai][bj][m][0] * sc, v1 = acc[ai][bj][m][1] * sc;
                    u32x4 w; w[0] = pk2(v0[0], v0[1]); w[1] = pk2(v0[2], v0[3]); w[2] = pk2(v1[0], v1[1]); w[3] = pk2(v1[2], v1[3]);
                    *(u32x4*)(rowp + bj * HALF) = w; } }
    }
};
struct EpiPart {
    static constexpr bool PERM = false;
    float* PART;
    __device__ __forceinline__ void operator()(const f32x4 (&acc)[2][2][4][2], const Unit& u, int wr, int wc, int fr, int fq) const {
        float* tp = PART + (size_t)u.ri * 65536 + (wr * 64 + fr) * 256 + wc * 32 + 4 * fq;
#pragma unroll
        for (int ai = 0; ai < 2; ++ai)
#pragma unroll
            for (int m = 0; m < 4; ++m)
#pragma unroll
                for (int bj = 0; bj < 2; ++bj)
#pragma unroll
                    for (int n = 0; n < 2; ++n) *(f32x4*)(tp + (ai * HALF + m * 16) * 256 + bj * HALF + n * 16) = acc[ai][bj][m][n];
    }
};
__device__ __forceinline__ void moe_combine(bf16_t* YM, const float* PART, const PG8_LAS int* tab, int nN, float sc) {
    const int nTm = __builtin_amdgcn_readfirstlane(tab[16]), G = gridDim.x, U = nTm * nN, rem = U % G;
    if (!(rem > 0 && rem * MOE_WAYS <= G)) return;
    int tid_ = threadIdx.x; asm volatile("" : "+v"(tid_));
    const int umain = U - rem, wave = tid_ >> 6, lane = tid_ & 63;
    for (int task = blockIdx.x * 8 + wave; task < rem * 256; task += G * 8) {
        const int r = task >> 8, i = task & 255; int pm, pn; static_order_L(umain + r, nTm, nN, pm, pn);
        const float* pp = PART + (size_t)(r * MOE_WAYS) * 65536 + i * 256 + lane * 4;
        f32x4 s = *(const f32x4*)pp;
#pragma unroll
        for (int q = 1; q < MOE_WAYS; ++q) s = s + *(const f32x4*)(pp + q * 65536);
        s = s * sc;
        typedef unsigned u32x2v __attribute__((ext_vector_type(2))); u32x2v w = {pk2(s[0], s[1]), pk2(s[2], s[3])};
        *(u32x2v*)(YM + (size_t)(pm * BM + i) * 1024 + pn * BM + lane * 4) = w;
    }
}

template <class T, class = void> struct sched_i8 { static constexpr bool value = false; };
template <class T> struct sched_i8<T, decltype((void)T::I8)> { static constexpr bool value = T::I8; };
template <class T, class = void> struct sched_fp8 { static constexpr bool value = false; };
template <class T> struct sched_fp8<T, decltype((void)T::FP8)> { static constexpr bool value = T::FP8; };
template <class T, class = void> struct epi_has_post { static constexpr bool value = false; };
template <class T> struct epi_has_post<T, decltype((void)T::HAS_POST)> { static constexpr bool value = T::HAS_POST; };
template <class Epi, class Sched>
__device__ __forceinline__ void gemm_phase(PG8_LAS unsigned char* lds, const Sched& S, const Epi& E) {
    int tid_ = threadIdx.x; asm volatile("" : "+v"(tid_));
    const int tid = tid_, wid = __builtin_amdgcn_readfirstlane(tid >> 6), lane = tid & 63, wr = wid >> 2, wc = wid & 3, fr = lane & 15, fq = lane >> 4;
    const int K = S.K, nt = S.nt();
    int RA[2], CA[2]; unsigned voffB;
    { int R, C; stage_rc(tid * 16, R, C); const int Rb = Epi::PERM ? ((R & ~31) + perm32(R & 31)) : R;
      RA[0] = R; CA[0] = C; RA[1] = R + 64; CA[1] = C; voffB = (unsigned)(Rb * K + C) * 2u; }
    const unsigned incB = (unsigned)(64 * K * 2), incA = (unsigned)(64 * S.lda * 2);
    const unsigned kstep = (unsigned)(BK * 2);
    const unsigned hstepB = (unsigned)(HALF * K * 2);
    const auto rsA = __builtin_amdgcn_make_buffer_rsrc((void*)S.A, 0, 0x7fffffff, 0x00020000), rsB = __builtin_amdgcn_make_buffer_rsrc((void*)S.Bt, 0, 0x7fffffff, 0x00020000);
    const unsigned ldsw = (unsigned)wid * 1024u;
    const int aoff = lds_byte(wr * 64 + fr, fq * 8), boff = lds_byte(wc * 32 + fr, fq * 8);
#define PG8_SA(b, h) (((b) * 2 + (h)) * HTB)
#define PG8_SB(b, h) ((4 + (b) * 2 + (h)) * HTB)
  \

#define PG8_STAGE_B(bufoff, soff) do { _Pragma("unroll") for (int _i = 0; _i < 2; ++_i) \
        __builtin_amdgcn_raw_ptr_buffer_load_lds(rsB, (PG8_LAS void*)(lds + (bufoff) + ldsw + _i * 8192), 16, voffB, (soff) + _i * incB, 0, 0); } while (0)
#define PG8_STAGE_A(bufoff, soff, h) do { _Pragma("unroll") for (int _i = 0; _i < 2; ++_i) { \
        if constexpr (Sched::GATHER) __builtin_amdgcn_raw_ptr_buffer_load_lds(rsA, (PG8_LAS void*)(lds + (bufoff) + ldsw + _i * 8192), 16, vA[h][_i], (soff), 0, 0); \
        else __builtin_amdgcn_raw_ptr_buffer_load_lds(rsA, (PG8_LAS void*)(lds + (bufoff) + ldsw + _i * 8192), 16, vA[0][0], (soff) + ((h) * 2 + _i) * incA, 0, 0); } } while (0)
#define PG8_LDA(dst, b, h) do { _Pragma("unroll") for (int m = 0; m < 4; ++m) _Pragma("unroll") for (int k = 0; k < 2; ++k) dst[m][k] = *(const PG8_LAS bf16x8*)(lds + PG8_SA(b, h) + aoff + m * 2048 + k * 1024); } while (0)
#define PG8_LDB(dst, b, h) do { _Pragma("unroll") for (int n = 0; n < 2; ++n) _Pragma("unroll") for (int k = 0; k < 2; ++k) dst[n][k] = *(const PG8_LAS bf16x8*)(lds + PG8_SB(b, h) + boff + n * 2048 + k * 1024); } while (0)
#define PG8_CAT8(x, y) __builtin_shufflevector(__builtin_bit_cast(i32x4v, x), __builtin_bit_cast(i32x4v, y), 0, 1, 2, 3, 4, 5, 6, 7)
#define PG8_MMA(ai, bj, At, Bt) do { __builtin_amdgcn_s_setprio(1); _Pragma("unroll") for (int m = 0; m < 4; ++m) _Pragma("unroll") for (int n = 0; n < 2; ++n) { \
        if constexpr (sched_fp8<Sched>::value)   \
              \
              \
            asm volatile("v_mfma_f32_16x16x128_f8f6f4 %0, %1, %2, %0" : "+v"(acc[ai][bj][m][n]) : "v"(PG8_CAT8(Bt[n][0], Bt[n][1])), "v"(PG8_CAT8(At[m][0], At[m][1]))); \
        else if constexpr (sched_i8<Sched>::value) { _Pragma("unroll") for (int k = 0; k < 2; ++k)   \
            acc[ai][bj][m][n] = __builtin_bit_cast(f32x4, __builtin_amdgcn_mfma_i32_16x16x64_i8(__builtin_bit_cast(i32x4v, Bt[n][k]), __builtin_bit_cast(i32x4v, At[m][k]), __builtin_bit_cast(i32x4v, acc[ai][bj][m][n]), 0, 0, 0)); } \
        else { _Pragma("unroll") for (int k = 0; k < 2; ++k) acc[ai][bj][m][n] = __builtin_amdgcn_mfma_f32_16x16x32_bf16(Bt[n][k], At[m][k], acc[ai][bj][m][n], 0, 0, 0); } } __builtin_amdgcn_s_setprio(0); } while (0)
#define PG8_WAIT_V(n) asm volatile("s_waitcnt vmcnt(" #n ")" ::: "memory")
#define PG8_WAIT_L(n) asm volatile("s_waitcnt lgkmcnt(" #n ")" ::: "memory")
#define PG8_BAR __builtin_amdgcn_s_barrier()
#define PG8_SCHED __builtin_amdgcn_sched_barrier(0)
#define PG8_AOFFS(dst, U) do { _Pragma("unroll") for (int _h = 0; _h < 2; ++_h) _Pragma("unroll") for (int _i = 0; _i < 2; ++_i) dst[_h][_i] = S.a_off(U, _h * HALF + RA[_i], CA[_i]); } while (0)
    Unit cur, nxt; int ui = 0;
    if (!S.next(0, cur)) return;
    f32x4 acc[2][2][4][2];
#pragma unroll
    for (int a = 0; a < 2; ++a)
#pragma unroll
        for (int b = 0; b < 2; ++b)
#pragma unroll
            for (int m = 0; m < 4; ++m)
#pragma unroll
                for (int n = 0; n < 2; ++n) acc[a][b][m][n] = (f32x4){0.f, 0.f, 0.f, 0.f};
    bf16x8 At[4][2], B0[2][2], B1[2][2];
    unsigned vA[2][2], vN[2][2];
    PG8_AOFFS(vA, cur);
    unsigned cA = (unsigned)(S.a_base(cur) - (const char*)S.A), cB = (unsigned)(S.b_base(cur) - (const char*)S.Bt);
    PG8_STAGE_B(PG8_SB(0, 0), cB); PG8_STAGE_B(PG8_SB(0, 1), cB + hstepB); PG8_STAGE_A(PG8_SA(0, 0), cA, 0); PG8_STAGE_A(PG8_SA(0, 1), cA, 1);
    if (wr == 1) PG8_BAR;
    PG8_WAIT_V(2); PG8_BAR;
    PG8_STAGE_B(PG8_SB(1, 0), cB + kstep); PG8_STAGE_A(PG8_SA(1, 0), cA + kstep, 0); PG8_STAGE_B(PG8_SB(1, 1), cB + hstepB + kstep);
    PG8_WAIT_V(6); PG8_BAR;
    for (;;) {
        const bool has_next = S.next(ui + 1, nxt);
        const unsigned nA = has_next ? (unsigned)(S.a_base(nxt) - (const char*)S.A) : cA, nB = has_next ? (unsigned)(S.b_base(nxt) - (const char*)S.Bt) : cB;
        for (int t = 0; t < nt; t += 2) {
            const bool last = (t == nt - 2);
            const bool sw = Sched::GATHER && last && has_next;
            if constexpr (Sched::GATHER) { if (sw) { PG8_AOFFS(vN, nxt); } }
            const unsigned a1 = cA + (unsigned)(t + 1) * kstep;
            const unsigned a2 = last ? nA : cA + (unsigned)(t + 2) * kstep, b2 = last ? nB : cB + (unsigned)(t + 2) * kstep;
            const unsigned a3 = a2 + kstep, b3 = b2 + kstep;
            PG8_LDB(B0, 0, 0); PG8_LDB(B1, 0, 1); PG8_SCHED; PG8_LDA(At, 0, 0); PG8_STAGE_A(PG8_SA(1, 1), a1, 1);
            if constexpr (Sched::GATHER) { if (sw) {
#pragma unroll
                for (int _h = 0; _h < 2; ++_h)
#pragma unroll
                    for (int _i = 0; _i < 2; ++_i) vA[_h][_i] = vN[_h][_i]; } }
            PG8_WAIT_V(8); PG8_WAIT_L(0); PG8_BAR; PG8_MMA(0, 0, At, B0); PG8_MMA(0, 1, At, B1); PG8_BAR; PG8_SCHED;
            PG8_LDA(At, 0, 1); PG8_STAGE_B(PG8_SB(0, 0), b2); PG8_STAGE_B(PG8_SB(0, 1), b2 + hstepB); PG8_STAGE_A(PG8_SA(0, 0), a2, 0);
            PG8_WAIT_V(8); PG8_WAIT_L(0); PG8_BAR; PG8_MMA(1, 0, At, B0); PG8_MMA(1, 1, At, B1); PG8_BAR; PG8_SCHED;
            PG8_LDB(B0, 1, 0); PG8_LDB(B1, 1, 1); PG8_SCHED; PG8_LDA(At, 1, 0); PG8_STAGE_A(PG8_SA(0, 1), a2, 1);
            PG8_WAIT_V(8); PG8_WAIT_L(0); PG8_BAR; PG8_MMA(0, 0, At, B0); PG8_MMA(0, 1, At, B1); PG8_BAR; PG8_SCHED;
            PG8_LDA(At, 1, 1); PG8_STAGE_B(PG8_SB(1, 0), b3); PG8_STAGE_B(PG8_SB(1, 1), b3 + hstepB); PG8_STAGE_A(PG8_SA(1, 0), a3, 0);
            PG8_WAIT_V(8); PG8_WAIT_L(0); PG8_BAR; PG8_MMA(1, 0, At, B0); PG8_MMA(1, 1, At, B1); PG8_BAR; PG8_SCHED;
        }
        if constexpr (sched_fp8<Sched>::value) asm volatile("s_nop 15\n\ts_nop 7" ::: "memory");
        if (wr == 0) PG8_BAR;
        { int te_ = threadIdx.x; asm volatile("" : "+v"(te_));
          E(acc, cur, wr, wc, te_ & 15, (te_ & 63) >> 4); }
        if constexpr (epi_has_post<Epi>::value) E.post(cur);
        if (!has_next) break;
#pragma unroll
        for (int a = 0; a < 2; ++a)
#pragma unroll
            for (int b = 0; b < 2; ++b)
#pragma unroll
                for (int m = 0; m < 4; ++m)
#pragma unroll
                    for (int n = 0; n < 2; ++n) acc[a][b][m][n] = (f32x4){0.f, 0.f, 0.f, 0.f};
        cur = nxt; cA = nA; cB = nB; ++ui;
        if (wr == 1) PG8_BAR;
    }
    PG8_WAIT_V(0);
    PG8_BAR;
#undef PG8_SA
#undef PG8_SB
#undef PG8_STAGE_A
#undef PG8_STAGE_B
#undef PG8_LDA
#undef PG8_LDB
#undef PG8_MMA
#undef PG8_CAT8
#undef PG8_WAIT_V
#undef PG8_WAIT_L
#undef PG8_BAR
#undef PG8_SCHED
#undef PG8_AOFFS
}
}

__device__ __forceinline__ float rope_inv(int i2, int dim) { return powf(10000.0f, -(float)i2 / (float)dim); }

__device__ __forceinline__ void ph_final(const P& p) {
    int tid_ = threadIdx.x; asm volatile("" : "+v"(tid_));
    const int wave = tid_ >> 6, lane = tid_ & 63;
    const float* gain = p.in[24];
    for (int row = blockIdx.x * 8 + wave; row < T_LAT; row += gridDim.x * 8) {
        float* src = p.out + (size_t)row * 1024;
        float4 v[4]; float ss = 0.f;
#pragma unroll
        for (int i = 0; i < 4; ++i) { v[i] = *(const float4*)(src + i * 256 + lane * 4); ss += v[i].x * v[i].x + v[i].y * v[i].y + v[i].z * v[i].z + v[i].w * v[i].w; }
        ss = wave_sum(ss);
        const float rs = rsqrtf(ss * (1.f / 1024.f) + NORM_EPS);
#pragma unroll
        for (int i = 0; i < 4; ++i) { const int col = i * 256 + lane * 4; const float4 g = *(const float4*)(gain + col);
            *(float4*)(src + col) = make_float4(v[i].x * rs * g.x, v[i].y * rs * g.y, v[i].z * rs * g.z, v[i].w * rs * g.w); }
    }
}


__device__ __forceinline__ void ph_final_moe(const P& p, const LAS int* tab0, const LAS int* tab1) {
    int tid_ = threadIdx.x; asm volatile("" : "+v"(tid_));
    const int wave = tid_ >> 6, lane = tid_ & 63;
    const float* gain = p.in[24];
    const bf16_t* YM0 = (const bf16_t*)(p.ws + OFF_YM); const bf16_t* YM1 = YM0 + (size_t)ACT_ROWS * 1024;
    const float* MODL = (const float*)(p.ws + OFF_MOD) + 9 * 6144 + 5120;
    int row = blockIdx.x * 8 + wave; const int stride = gridDim.x * 8;
    int4 ep = make_int4(0, 0, 0, 0), nep = ep; float2 ww = make_float2(0.f, 0.f), nww = ww;
    if (row < T_LAT) { const int* iv = (const int*)(p.ws + OFF_INV) + (size_t)row * 8; ep = *(const int4*)iv; ww = *(const float2*)(iv + 4); }
    for (; row < T_LAT; row += stride) {
        if (row + stride < T_LAT) { const int* iv = (const int*)(p.ws + OFF_INV) + (size_t)(row + stride) * 8; nep = *(const int4*)iv; nww = *(const float2*)(iv + 4); }
        const size_t r0 = (size_t)(tab0[8 + ep.x] * 256 + ep.y) * 1024, r1 = (size_t)(tab1[8 + ep.z] * 256 + ep.w) * 1024;
        float* src = p.out + (size_t)row * 1024;
        const float* gt = MODL + (row >> 12) * 6144;
        float4 v[4]; uint2 y0[4], y1[4]; float4 gg[4]; float ss = 0.f;
#pragma unroll
        for (int i = 0; i < 4; ++i) { const int col = i * 256 + lane * 4; v[i] = *(const float4*)(src + col); y0[i] = *(const uint2*)(YM0 + r0 + col); y1[i] = *(const uint2*)(YM1 + r1 + col); gg[i] = *(const float4*)(gt + col); }
#pragma unroll
        for (int i = 0; i < 4; ++i) {
            v[i].x += gg[i].x * (ww.x * __uint_as_float(y0[i].x << 16) + ww.y * __uint_as_float(y1[i].x << 16));
            v[i].y += gg[i].y * (ww.x * __uint_as_float(y0[i].x & 0xFFFF0000u) + ww.y * __uint_as_float(y1[i].x & 0xFFFF0000u));
            v[i].z += gg[i].z * (ww.x * __uint_as_float(y0[i].y << 16) + ww.y * __uint_as_float(y1[i].y << 16));
            v[i].w += gg[i].w * (ww.x * __uint_as_float(y0[i].y & 0xFFFF0000u) + ww.y * __uint_as_float(y1[i].y & 0xFFFF0000u));
            ss += v[i].x * v[i].x + v[i].y * v[i].y + v[i].z * v[i].z + v[i].w * v[i].w; }
        ss = wave_sum(ss);
        const float rs = rsqrtf(ss * (1.f / 1024.f) + NORM_EPS);
#pragma unroll
        for (int i = 0; i < 4; ++i) { const int col = i * 256 + lane * 4; const float4 g = *(const float4*)(gain + col);
            *(float4*)(src + col) = make_float4(v[i].x * rs * g.x, v[i].y * rs * g.y, v[i].z * rs * g.z, v[i].w * rs * g.w); }
        ep = nep; ww = nww;
    }
}
typedef short bf16x8_t __attribute__((ext_vector_type(8)));
typedef short s16x4_t __attribute__((ext_vector_type(4)));
typedef float f32x16_t __attribute__((ext_vector_type(16)));
typedef unsigned u32x4_t __attribute__((ext_vector_type(4)));
typedef float f32x4_t __attribute__((ext_vector_type(4)));
__device__ __forceinline__ s16x4_t lds_tr16(LAS const unsigned char* p) { typedef short v4i16_t __attribute__((ext_vector_type(4))); return __builtin_bit_cast(s16x4_t, __builtin_amdgcn_ds_read_tr16_b64_v4i16((LAS v4i16_t*)p)); }
__device__ __forceinline__ unsigned pkbf(float lo, float hi) { typedef float f32x2_t __attribute__((ext_vector_type(2))); typedef __bf16 bf16x2_t __attribute__((ext_vector_type(2)));
    f32x2_t v = {lo, hi}; bf16x2_t b = __builtin_convertvector(v, bf16x2_t); return __builtin_bit_cast(unsigned, b); }
__device__ __forceinline__ float max3f(float a, float b, float c) { return fmaxf(fmaxf(a, b), c); }

#define ATT_VP 192
#define ATT_THR 6.0f
template <int DQK, bool SWA, bool GQA = false>
__device__ __forceinline__ void attn_unit(LAS unsigned char* lds, const bf16_t* POST, const bf16_t* VBUF, int vld, bf16_t* MIX, int b, int q0, int qcol, int kcol, int vcol, int ocol,
                                          int band_lo, int band_hi, float sinkl2, float qscale, const float* sinkp, float sinkmul) {
    constexpr int KP = DQK * 2 + 16, NPK = DQK / 8, NKL = NPK / 4, STAGE = 128 * KP + 128 * ATT_VP, NS = DQK / 16;
    int tid_ = threadIdx.x; asm volatile("" : "+v"(tid_));
    const int tid = tid_, wid = __builtin_amdgcn_readfirstlane(tid >> 6), lane = tid & 63, r = lane & 31, h = lane >> 5;
    const int nb = (band_hi - band_lo) >> 7, ntiles = nb + 2;
    const int qw0 = GQA ? q0 + 32 * (wid & 1) : q0 + 32 * wid;
    const int qi = qw0 + r;
    const int qrow = tok_row(b, qi);
    if (GQA) { qcol += (wid >> 1) * 64; ocol += (wid >> 1) * 64; sinkl2 = sinkp[wid >> 1] * sinkmul; }
    bf16x8_t qf[NS];
    { const bf16_t* qp = POST + (size_t)qrow * POST_LD + qcol + 8 * h;
#pragma unroll
      for (int s = 0; s < NS; ++s) { float f[8]; unpack8(*(const uint4*)(qp + 16 * s), f);
          const unsigned w0 = pkbf(f[0] * qscale, f[1] * qscale), w1 = pkbf(f[2] * qscale, f[3] * qscale), w2 = pkbf(f[4] * qscale, f[5] * qscale), w3 = pkbf(f[6] * qscale, f[7] * qscale);
          qf[s] = __builtin_bit_cast(bf16x8_t, make_uint4(w0, w1, w2, w3)); } }
    f32x16_t O0, O1;
#pragma unroll
    for (int i = 0; i < 16; ++i) { O0[i] = 0.f; O1[i] = 0.f; }
    float m = SWA ? sinkl2 : -1e30f, l = 0.f;
    u32x4_t kreg[NKL], vreg[2];
    const int vrow = tid >> 3, vpc = tid & 7;
#define ATT_KS(t) ((t) < nb ? band_lo + 128 * (t) : SEQ + 128 * ((t) - nb))
#define ATT_LOAD(t) do { const int ks_ = ATT_KS(t); const bf16_t* base_ = POST + (size_t)tok_row(b, ks_) * POST_LD; \
        _Pragma("unroll") for (int i_ = 0; i_ < NKL; ++i_) { const int idx_ = tid + 512 * i_, row_ = idx_ / NPK, pc_ = idx_ % NPK; kreg[i_] = *(const u32x4_t*)(base_ + (size_t)row_ * POST_LD + kcol + pc_ * 8); } \
        const bf16_t* vbase_ = VBUF + (size_t)tok_row(b, ks_) * vld; \
        _Pragma("unroll") for (int i_ = 0; i_ < 2; ++i_) vreg[i_] = *(const u32x4_t*)(vbase_ + (size_t)(vrow + 64 * i_) * vld + vcol + vpc * 8); } while (0)
#define ATT_WRITE(buf) do { LAS unsigned char* kb_ = lds + (buf) * STAGE; LAS unsigned char* vb_ = kb_ + 128 * KP; \
        _Pragma("unroll") for (int i_ = 0; i_ < NKL; ++i_) { const int idx_ = tid + 512 * i_, row_ = idx_ / NPK, pc_ = idx_ % NPK; *(LAS u32x4_t*)(kb_ + row_ * KP + pc_ * 16) = kreg[i_]; } \
        _Pragma("unroll") for (int i_ = 0; i_ < 2; ++i_) *(LAS u32x4_t*)(vb_ + (vrow + 64 * i_) * ATT_VP + vpc * 16) = vreg[i_]; } while (0)
    const int koff = r * KP + 16 * h;
    const int voff = (4 * h + ((lane & 15) >> 2)) * ATT_VP + (16 * ((lane >> 4) & 1) + 4 * (lane & 3)) * 2;
    __syncthreads();
    ATT_LOAD(0); ATT_WRITE(0);
    __syncthreads();
    for (int t = 0; t < ntiles; ++t) {
        if (t + 1 < ntiles) ATT_LOAD(t + 1);
        LAS const unsigned char* kb = lds + (t & 1) * STAGE; LAS const unsigned char* vb = kb + 128 * KP;
        const int ks = ATT_KS(t);
        bool skip[2] = {false, false}, need_mask[2] = {false, false};
        if (SWA && t < nb) {
#pragma unroll
            for (int sub = 0; sub < 2; ++sub) { const int kb0 = ks + sub * 64, qlo = qw0, qhi = qlo + 31;
                skip[sub] = (kb0 > qhi + 128) || (kb0 + 63 < qlo - 128);
                need_mask[sub] = !((kb0 >= qhi - 128) && (kb0 + 63 <= qlo + 128)); }
        }
        f32x16_t S[4];
#pragma unroll
        for (int blk = 0; blk < 4; ++blk)
#pragma unroll
            for (int i = 0; i < 16; ++i) S[blk][i] = 0.f;
#pragma unroll
        for (int sub = 0; sub < 2; ++sub) {
            if (!skip[sub]) {
#pragma unroll
                for (int s = 0; s < NS; ++s) {
                    const bf16x8_t k0 = *(LAS const bf16x8_t*)(kb + (sub * 64) * KP + koff + 32 * s), k1 = *(LAS const bf16x8_t*)(kb + (sub * 64 + 32) * KP + koff + 32 * s);
                    S[2 * sub] = __builtin_amdgcn_mfma_f32_32x32x16_bf16(k0, qf[s], S[2 * sub], 0, 0, 0);
                    S[2 * sub + 1] = __builtin_amdgcn_mfma_f32_32x32x16_bf16(k1, qf[s], S[2 * sub + 1], 0, 0, 0);
                }
            }
        }
#pragma unroll
        for (int sub = 0; sub < 2; ++sub) {
            if (!skip[sub]) {
                const int kb0 = ks + sub * 64;
                f32x16_t& S0 = S[2 * sub]; f32x16_t& S1 = S[2 * sub + 1];
                bf16x8_t va[8];
#pragma unroll
                for (int g = 0; g < 4; ++g) { LAS const unsigned char* vp = vb + (sub * 64 + 16 * g) * ATT_VP + voff;
                    const s16x4_t l0 = lds_tr16(vp), h0 = lds_tr16(vp + 8 * ATT_VP), l1 = lds_tr16(vp + 64), h1 = lds_tr16(vp + 8 * ATT_VP + 64);
                    va[2 * g] = __builtin_shufflevector(l0, h0, 0, 1, 2, 3, 4, 5, 6, 7); va[2 * g + 1] = __builtin_shufflevector(l1, h1, 0, 1, 2, 3, 4, 5, 6, 7); }
                if (SWA && need_mask[sub]) {
#pragma unroll
                    for (int i = 0; i < 16; ++i) { const int d0 = kb0 + (i & 3) + 8 * (i >> 2) + 4 * h - qi, d1 = d0 + 32;
                        if (d0 > 128 || d0 < -128) S0[i] = -1e30f;
                        if (d1 > 128 || d1 < -128) S1[i] = -1e30f; }
                }
                float mx = max3f(S0[0], S0[1], S1[0]), mx2 = max3f(S0[2], S0[3], S1[1]);
                mx = max3f(mx, S1[2], S1[3]);
#pragma unroll
                for (int i = 4; i < 16; i += 4) { mx = max3f(mx, S0[i], S0[i + 1]); mx2 = max3f(mx2, S0[i + 2], S0[i + 3]); mx = max3f(mx, S1[i], S1[i + 1]); mx2 = max3f(mx2, S1[i + 2], S1[i + 3]); }
                mx = fmaxf(mx, mx2);
                { const auto rr_ = __builtin_amdgcn_permlane32_swap(__float_as_uint(mx), __float_as_uint(mx), false, false); mx = fmaxf(__uint_as_float(rr_[0]), __uint_as_float(rr_[1])); }
                if (__any(mx > m + ATT_THR)) {
                    const float mn = fmaxf(m, mx), al = __builtin_amdgcn_exp2f(m - mn);
                    m = mn; l *= al;
#pragma unroll
                    for (int i = 0; i < 16; ++i) { O0[i] *= al; O1[i] *= al; }
                }
                typedef float f32x2_t __attribute__((ext_vector_type(2)));
                const f32x2_t m2 = {m, m}; f32x2_t ps2 = {0.f, 0.f};
#pragma unroll
                for (int i = 0; i < 16; i += 2) {
                    f32x2_t a = (f32x2_t){S0[i], S0[i + 1]} - m2, c = (f32x2_t){S1[i], S1[i + 1]} - m2;
                    a[0] = __builtin_amdgcn_exp2f(a[0]); a[1] = __builtin_amdgcn_exp2f(a[1]); c[0] = __builtin_amdgcn_exp2f(c[0]); c[1] = __builtin_amdgcn_exp2f(c[1]);
                    S0[i] = a[0]; S0[i + 1] = a[1]; S1[i] = c[0]; S1[i + 1] = c[1];
                    ps2 += a; ps2 += c;
                }
                l += ps2[0] + ps2[1];
#pragma unroll
                for (int g = 0; g < 4; ++g) { const f32x16_t& Sx = (g >> 1) ? S1 : S0; const int o8 = 8 * (g & 1);
                    const bf16x8_t pf = __builtin_bit_cast(bf16x8_t, make_uint4(pkbf(Sx[o8 + 0], Sx[o8 + 1]), pkbf(Sx[o8 + 2], Sx[o8 + 3]), pkbf(Sx[o8 + 4], Sx[o8 + 5]), pkbf(Sx[o8 + 6], Sx[o8 + 7])));
                    O0 = __builtin_amdgcn_mfma_f32_32x32x16_bf16(va[2 * g], pf, O0, 0, 0, 0);
                    O1 = __builtin_amdgcn_mfma_f32_32x32x16_bf16(va[2 * g + 1], pf, O1, 0, 0, 0);
                }
            }
        }
        if (t + 1 < ntiles) ATT_WRITE((t + 1) & 1);
        __syncthreads();
    }
#undef ATT_LOAD
#undef ATT_KS
#undef ATT_WRITE
    float lt = l + __shfl_xor(l, 32);
    if (SWA) lt += __builtin_amdgcn_exp2f(sinkl2 - m);
    const float inv = 1.f / lt;
    bf16_t* op = MIX + (size_t)qrow * 1024 + ocol + 4 * h;
#pragma unroll
    for (int g = 0; g < 4; ++g) {
        *(uint2*)(op + 8 * g) = make_uint2(pkbf(O0[4 * g] * inv, O0[4 * g + 1] * inv), pkbf(O0[4 * g + 2] * inv, O0[4 * g + 3] * inv));
        *(uint2*)(op + 32 + 8 * g) = make_uint2(pkbf(O1[4 * g] * inv, O1[4 * g + 1] * inv), pkbf(O1[4 * g + 2] * inv, O1[4 * g + 3] * inv));
    }
}


typedef int i32x8_t __attribute__((ext_vector_type(8)));
typedef int i32x4_t __attribute__((ext_vector_type(4)));
#define A8_KP 144
__device__ __forceinline__ i32x8_t lds_frag32(LAS const unsigned char* p) { const i32x4_t lo = *(LAS const i32x4_t*)p, hi = *(LAS const i32x4_t*)(p + 16); return __builtin_shufflevector(lo, hi, 0, 1, 2, 3, 4, 5, 6, 7); }
__device__ __forceinline__ int cvt4_f8(float a, float b, float c, float d) { return __builtin_amdgcn_cvt_pk_fp8_f32(c, d, __builtin_amdgcn_cvt_pk_fp8_f32(a, b, 0, false), true); }
__device__ __forceinline__ void attn_unit_f8(LAS unsigned char* lds, const unsigned char* QK8, const unsigned char* V8T, bf16_t* MIX, int b, int q0, int head, int band_lo, int band_hi, float qscale) {
    constexpr int STAGE = 128 * A8_KP + 64 * A8_KP;
    int tid_ = threadIdx.x; asm volatile("" : "+v"(tid_));
    const int tid = tid_, wid = __builtin_amdgcn_readfirstlane(tid >> 6), lane = tid & 63, r = lane & 31, h = lane >> 5;
    const int nb = (band_hi - band_lo) >> 7, ntiles = nb + 2;
    const int qi = q0 + 32 * wid + r, qrow = tok_row(b, qi);
    i32x8_t qf[2];
    { const unsigned char* qp = QK8 + (size_t)qrow * 1024 + head * 128 + 32 * h;
#pragma unroll
      for (int s = 0; s < 2; ++s) { const i32x4_t lo = *(const i32x4_t*)(qp + 64 * s), hi = *(const i32x4_t*)(qp + 64 * s + 16); qf[s] = __builtin_shufflevector(lo, hi, 0, 1, 2, 3, 4, 5, 6, 7); } }
    f32x16_t O0, O1;
#pragma unroll
    for (int i = 0; i < 16; ++i) { O0[i] = 0.f; O1[i] = 0.f; }
    float m = -1e30f;
    f32x16_t Ls;
#pragma unroll
    for (int i = 0; i < 16; ++i) Ls[i] = 0.f;
    const i32x8_t ones8 = {0x38383838, 0x38383838, 0x38383838, 0x38383838, 0x38383838, 0x38383838, 0x38383838, 0x38383838};
    u32x4_t kreg[2], vreg;
    const unsigned char* vbase = V8T + (size_t)((b * 4 + head) * 64 + (tid >> 3)) * 4352 + (tid & 7) * 16;
#define A8_KS(t) ((t) < nb ? band_lo + 128 * (t) : SEQ + 128 * ((t) - nb))
#define A8_LOAD(t) do { const int ks_ = A8_KS(t); const unsigned char* base_ = QK8 + (size_t)tok_row(b, ks_) * 1024 + 512 + head * 128; \
        _Pragma("unroll") for (int i_ = 0; i_ < 2; ++i_) { const int idx_ = tid + 512 * i_; kreg[i_] = *(const u32x4_t*)(base_ + (size_t)(idx_ >> 3) * 1024 + (idx_ & 7) * 16); } \
        vreg = *(const u32x4_t*)(vbase + ks_); } while (0)
#define A8_WRITE(buf) do { LAS unsigned char* kb_ = lds + (buf) * STAGE; \
        _Pragma("unroll") for (int i_ = 0; i_ < 2; ++i_) { const int idx_ = tid + 512 * i_; *(LAS u32x4_t*)(kb_ + (idx_ >> 3) * A8_KP + (idx_ & 7) * 16) = kreg[i_]; } \
        *(LAS u32x4_t*)(kb_ + 128 * A8_KP + (tid >> 3) * A8_KP + (tid & 7) * 16) = vreg; } while (0)
    const int foff = r * A8_KP + 32 * h;
    __syncthreads();
    A8_LOAD(0); A8_WRITE(0);
    __syncthreads();
    typedef float f32x2_t __attribute__((ext_vector_type(2)));
    const f32x2_t qs2 = {qscale, qscale};
    for (int t = 0; t < ntiles; ++t) {
        if (t + 1 < ntiles) A8_LOAD(t + 1);
        LAS const unsigned char* kb = lds + (t & 1) * STAGE; LAS const unsigned char* vb = kb + 128 * A8_KP;
        f32x16_t S[4];
#pragma unroll
        for (int blk = 0; blk < 4; ++blk)
#pragma unroll
            for (int i = 0; i < 16; ++i) S[blk][i] = 0.f;
#pragma unroll
        for (int blk = 0; blk < 4; ++blk)
#pragma unroll
            for (int s = 0; s < 2; ++s) S[blk] = __builtin_amdgcn_mfma_scale_f32_32x32x64_f8f6f4(lds_frag32(kb + (blk * 32) * A8_KP + foff + 64 * s), qf[s], S[blk], 0, 0, 0, 0, 0, 0);
#pragma unroll
        for (int sub = 0; sub < 2; ++sub) {
            f32x16_t& S0 = S[2 * sub]; f32x16_t& S1 = S[2 * sub + 1];
            const i32x8_t va0 = lds_frag32(vb + foff + 64 * sub), va1 = lds_frag32(vb + 32 * A8_KP + foff + 64 * sub);
            float mx = max3f(S0[0], S0[1], S1[0]), mx2 = max3f(S0[2], S0[3], S1[1]);
            mx = max3f(mx, S1[2], S1[3]);
#pragma unroll
            for (int i = 4; i < 16; i += 4) { mx = max3f(mx, S0[i], S0[i + 1]); mx2 = max3f(mx2, S0[i + 2], S0[i + 3]); mx = max3f(mx, S1[i], S1[i + 1]); mx2 = max3f(mx2, S1[i + 2], S1[i + 3]); }
            mx = fmaxf(mx, mx2);
            { const auto rr_ = __builtin_amdgcn_permlane32_swap(__float_as_uint(mx), __float_as_uint(mx), false, false); mx = fmaxf(__uint_as_float(rr_[0]), __uint_as_float(rr_[1])); }
            mx *= qscale;
            if (__any(mx > m + ATT_THR)) {
                const float mn = fmaxf(m, mx), al = __builtin_amdgcn_exp2f(m - mn);
                m = mn; Ls[0] *= al;
#pragma unroll
                for (int i = 0; i < 16; ++i) { O0[i] *= al; O1[i] *= al; }
            }
            const f32x2_t m2 = {-m, -m};
#pragma unroll
            for (int i = 0; i < 16; i += 2) {
                f32x2_t a = (f32x2_t){S0[i], S0[i + 1]} * qs2 + m2, c = (f32x2_t){S1[i], S1[i + 1]} * qs2 + m2;
                a[0] = __builtin_amdgcn_exp2f(a[0]); a[1] = __builtin_amdgcn_exp2f(a[1]); c[0] = __builtin_amdgcn_exp2f(c[0]); c[1] = __builtin_amdgcn_exp2f(c[1]);
                S0[i] = a[0]; S0[i + 1] = a[1]; S1[i] = c[0]; S1[i + 1] = c[1];
            }
            i32x8_t pf;
#pragma unroll
            for (int w = 0; w < 4; ++w) { pf[w] = cvt4_f8(S0[4 * w], S0[4 * w + 1], S0[4 * w + 2], S0[4 * w + 3]); pf[4 + w] = cvt4_f8(S1[4 * w], S1[4 * w + 1], S1[4 * w + 2], S1[4 * w + 3]); }
            O0 = __builtin_amdgcn_mfma_scale_f32_32x32x64_f8f6f4(va0, pf, O0, 0, 0, 0, 0, 0, 0);
            O1 = __builtin_amdgcn_mfma_scale_f32_32x32x64_f8f6f4(va1, pf, O1, 0, 0, 0, 0, 0, 0);
            Ls = __builtin_amdgcn_mfma_scale_f32_32x32x64_f8f6f4(ones8, pf, Ls, 0, 0, 0, 0, 0, 0);
        }
        if (t + 1 < ntiles) A8_WRITE((t + 1) & 1);
        __syncthreads();
    }
#undef A8_LOAD
#undef A8_KS
#undef A8_WRITE
    const float inv = 1.f / Ls[0];
    bf16_t* op = MIX + (size_t)qrow * 1024 + head * 64 + 4 * h;
#pragma unroll
    for (int g = 0; g < 4; ++g) {
        *(uint2*)(op + 8 * g) = make_uint2(pkbf(O0[4 * g] * inv, O0[4 * g + 1] * inv), pkbf(O0[4 * g + 2] * inv, O0[4 * g + 3] * inv));
        *(uint2*)(op + 32 + 8 * g) = make_uint2(pkbf(O1[4 * g] * inv, O1[4 * g + 1] * inv), pkbf(O1[4 * g + 2] * inv, O1[4 * g + 3] * inv));
    }
}
__device__ __forceinline__ float log2_sigmoid(float x) { return log2f(1.f / (1.f + expf(-x))); }

__device__ __forceinline__ void ph_ret_T(const P& p, int layer, LAS unsigned char* lds) {
    const bf16_t* POST = (const bf16_t*)(p.ws + OFF_POST); const bf16_t* PROJB = (const bf16_t*)(p.ws + OFF_PROJ);
    bf16_t* TT = (bf16_t*)(p.ws + OFF_TT);
    int tid_ = threadIdx.x; asm volatile("" : "+v"(tid_));
    const int tid = tid_, wid = __builtin_amdgcn_readfirstlane(tid >> 6), lane = tid & 63, h2 = lane >> 5;
    const int G = gridDim.x, bid = blockIdx.x;
    const int trq = (lane & 15) >> 2, trc = (16 * ((lane >> 4) & 1) + 4 * (lane & 3)) * 2;
    for (int u = bid; u < BATCH * 34 * 2; u += G) {
        const int hp = u & 1, c = (u >> 1) % 34, b = u / 68;
        const int row0 = c < 32 ? b * SEQ + c * 128 : T_LAT + b * CTXL + (c - 32) * 128;
        __syncthreads();
#pragma unroll
        for (int i = 0; i < 8; ++i) {
            const int idx = tid + 512 * i, arr = idx >> 10, rem = idx & 1023, row = rem >> 3, pc = rem & 7;
            const u32x4_t v = arr < 2 ? *(const u32x4_t*)(POST + (size_t)(row0 + row) * POST_LD + PC_RK + (2 * hp + (arr & 1)) * 64 + pc * 8)
                                      : *(const u32x4_t*)(PROJB + (size_t)(row0 + row) * PROJ_LD + PJ_RV + (2 * hp + (arr & 1)) * 64 + pc * 8);
            *(LAS u32x4_t*)(lds + arr * 24576 + row * 192 + pc * 16) = v;
        }
        __syncthreads();
        const int hh = wid >> 2, head = 2 * hp + hh, dir = (wid >> 1) & 1, dvb = wid & 1;
        const float lg = log2_sigmoid(dir ? p.in[15][layer * 4 + head] : p.in[14][layer * 4 + head]);
        f32x16_t acc0, acc1;
#pragma unroll
        for (int i = 0; i < 16; ++i) { acc0[i] = 0.f; acc1[i] = 0.f; }
        LAS const unsigned char* kt = lds + hh * 24576; LAS const unsigned char* vt = lds + (2 + hh) * 24576;
#pragma unroll
        for (int s = 0; s < 8; ++s) {
            const int kr = 16 * s + 8 * h2;
            LAS const unsigned char* vp = vt + (kr + trq) * 192 + dvb * 64 + trc;
            const s16x4_t vlo = lds_tr16(vp), vhi = lds_tr16(vp + 4 * 192);
            const bf16x8_t a = {vlo[0], vlo[1], vlo[2], vlo[3], vhi[0], vhi[1], vhi[2], vhi[3]};
            float w[8];
#pragma unroll
            for (int j = 0; j < 8; ++j) w[j] = __builtin_amdgcn_exp2f(lg * (float)(dir ? (kr + j) : (127 - kr - j)));
#pragma unroll
            for (int dkb = 0; dkb < 2; ++dkb) {
                LAS const unsigned char* kp = kt + (kr + trq) * 192 + dkb * 64 + trc;
                const s16x4_t klo = lds_tr16(kp), khi = lds_tr16(kp + 4 * 192);
                float f[8];
#pragma unroll
                for (int j = 0; j < 4; ++j) { f[j] = bf2f((bf16_t)klo[j]) * w[j]; f[4 + j] = bf2f((bf16_t)khi[j]) * w[4 + j]; }
                const bf16x8_t bb = __builtin_bit_cast(bf16x8_t, make_uint4(pkbf(f[0], f[1]), pkbf(f[2], f[3]), pkbf(f[4], f[5]), pkbf(f[6], f[7])));
                if (dkb == 0) acc0 = __builtin_amdgcn_mfma_f32_32x32x16_bf16(a, bb, acc0, 0, 0, 0);
                else acc1 = __builtin_amdgcn_mfma_f32_32x32x16_bf16(a, bb, acc1, 0, 0, 0);
            }
        }
        bf16_t* tp = TT + ((((size_t)(b * 4 + head) * 34 + c) * 2 + dir) * 4096) + (lane & 31);
#pragma unroll
        for (int i = 0; i < 16; ++i) { const int dv = 32 * dvb + (i & 3) + 8 * (i >> 2) + 4 * h2; tp[dv * 64] = f2bf(acc0[i]); tp[dv * 64 + 32] = f2bf(acc1[i]); }
    }
}

__device__ __forceinline__ void ret_unit(LAS unsigned char* lds, const P& p, int layer, int b, int c, int hp) {
    const bf16_t* POST = (const bf16_t*)(p.ws + OFF_POST); const bf16_t* PROJB = (const bf16_t*)(p.ws + OFF_PROJ);
    bf16_t* MIX = (bf16_t*)(p.ws + OFF_H);
    const bf16_t* TT = (const bf16_t*)(p.ws + OFF_TT);
    int tid_ = threadIdx.x; asm volatile("" : "+v"(tid_));
    const int tid = tid_, wid = __builtin_amdgcn_readfirstlane(tid >> 6), lane = tid & 63, r = lane & 31, h2 = lane >> 5;
    const bool isctx = c >= 32;
    const int row0 = !isctx ? b * SEQ + c * 128 : T_LAT + b * CTXL + (c - 32) * 128;
    constexpr int L_ST = 0, L_K = 36864, L_V = 73728;
    __syncthreads();
#pragma unroll
    for (int i = 0; i < 8; ++i) {
        const int idx = tid + 512 * i, arr = idx >> 10, rem = idx & 1023, row = rem >> 3, pc = rem & 7;
        const u32x4_t v = arr < 2 ? *(const u32x4_t*)(POST + (size_t)(row0 + row) * POST_LD + PC_RK + (2 * hp + (arr & 1)) * 64 + pc * 8)
                                      : *(const u32x4_t*)(PROJB + (size_t)(row0 + row) * PROJ_LD + PJ_RV + (2 * hp + (arr & 1)) * 64 + pc * 8);
        if (arr < 2) *(LAS u32x4_t*)(lds + L_K + (arr & 1) * 18432 + row * 144 + pc * 16) = v;
        else *(LAS u32x4_t*)(lds + L_V + (arr & 1) * 24576 + row * 192 + pc * 16) = v;
    }
    {
        const int hd = tid >> 7, hh = hd >> 1, dir = hd & 1, head = 2 * hp + hh;
        const float g128 = 128.f * log2_sigmoid(dir ? p.in[15][layer * 4 + head] : p.in[14][layer * 4 + head]);
        const bf16_t* tb = TT + (size_t)(b * 4 + head) * 34 * 2 * 4096 + dir * 4096 + (tid & 127) * 4;
        f32x4_t acc[8];
#pragma unroll
        for (int i = 0; i < 8; ++i) acc[i] = (f32x4_t){0.f, 0.f, 0.f, 0.f};
        int v0, v1;
        if (!isctx) { if (dir == 0) { v0 = -2; v1 = c - 1; } else { v0 = c + 1; v1 = 33; } }
        else { const int cc = c - 32; if (dir == 0) { v0 = -2; v1 = cc - 3; } else { v0 = 33 + cc; v1 = 33; } }
        for (int v = v0; v <= v1; ++v) {
            const int idxT = v < 0 ? 34 + v : v;
            const float coef = __builtin_amdgcn_exp2f(g128 * (float)(dir == 0 ? (v1 - v) : (v - v0)));
            const bf16_t* tp = tb + (size_t)idxT * 2 * 4096;
#pragma unroll
            for (int i = 0; i < 8; ++i) { const uint2 r_ = *(const uint2*)(tp + 512 * i);
                const f32x4_t x = {__uint_as_float(r_.x << 16), __uint_as_float(r_.x & 0xFFFF0000u), __uint_as_float(r_.y << 16), __uint_as_float(r_.y & 0xFFFF0000u)}; acc[i] += x * coef; }
        }
#pragma unroll
        for (int i = 0; i < 8; ++i) { const int e = (tid & 127) * 4 + 512 * i, dv = e >> 6, dk = e & 63;
            typedef unsigned u32x2_t __attribute__((ext_vector_type(2))); *(LAS u32x2_t*)(lds + L_ST + hd * 9216 + dv * 144 + dk * 2) = (u32x2_t){pkbf(acc[i][0], acc[i][1]), pkbf(acc[i][2], acc[i][3])}; }
    }
    __syncthreads();
    const int hh = wid >> 2, head = 2 * hp + hh, qb = wid & 3, qi = 32 * qb + r;
    const int qrow = row0 + qi;
    const float lgf = log2_sigmoid(p.in[14][layer * 4 + head]), lgb = log2_sigmoid(p.in[15][layer * 4 + head]);
    bf16x8_t qf[4];
    { const bf16_t* qp = POST + (size_t)qrow * POST_LD + PC_RQ + head * 64 + 8 * h2;
#pragma unroll
      for (int s = 0; s < 4; ++s) qf[s] = *(const bf16x8_t*)(qp + 16 * s); }
    f32x16_t O0, O1;
#pragma unroll
    for (int i = 0; i < 16; ++i) { O0[i] = 0.f; O1[i] = 0.f; }
    LAS const unsigned char* kt = lds + L_K + hh * 18432; LAS const unsigned char* vt = lds + L_V + hh * 24576;
    const int voff = (4 * h2 + ((lane & 15) >> 2)) * 192 + (16 * ((lane >> 4) & 1) + 4 * (lane & 3)) * 2;
#pragma unroll
    for (int blk = 0; blk < 4; ++blk) {
        f32x16_t S;
#pragma unroll
        for (int i = 0; i < 16; ++i) S[i] = 0.f;
#pragma unroll
        for (int s = 0; s < 4; ++s) { const bf16x8_t a = *(LAS const bf16x8_t*)(kt + (32 * blk + r) * 144 + 32 * s + 16 * h2); S = __builtin_amdgcn_mfma_f32_32x32x16_bf16(a, qf[s], S, 0, 0, 0); }
#pragma unroll
        for (int i = 0; i < 16; ++i) { const int d = qi - (32 * blk + (i & 3) + 8 * (i >> 2) + 4 * h2);
            const float w = d > 0 ? __builtin_amdgcn_exp2f(lgf * (float)d) : (d == 0 ? 2.f : __builtin_amdgcn_exp2f(lgb * (float)(-d)));
            S[i] *= w; }
#pragma unroll
        for (int s2 = 0; s2 < 2; ++s2) {
            const bf16x8_t pf = __builtin_bit_cast(bf16x8_t, make_uint4(pkbf(S[8 * s2 + 0], S[8 * s2 + 1]), pkbf(S[8 * s2 + 2], S[8 * s2 + 3]), pkbf(S[8 * s2 + 4], S[8 * s2 + 5]), pkbf(S[8 * s2 + 6], S[8 * s2 + 7])));
            LAS const unsigned char* vp = vt + (32 * blk + 16 * s2) * 192 + voff;
            const s16x4_t lo0 = lds_tr16(vp), hi0 = lds_tr16(vp + 8 * 192), lo1 = lds_tr16(vp + 64), hi1 = lds_tr16(vp + 8 * 192 + 64);
            const bf16x8_t a0 = {lo0[0], lo0[1], lo0[2], lo0[3], hi0[0], hi0[1], hi0[2], hi0[3]};
            const bf16x8_t a1 = {lo1[0], lo1[1], lo1[2], lo1[3], hi1[0], hi1[1], hi1[2], hi1[3]};
            O0 = __builtin_amdgcn_mfma_f32_32x32x16_bf16(a0, pf, O0, 0, 0, 0);
            O1 = __builtin_amdgcn_mfma_f32_32x32x16_bf16(a1, pf, O1, 0, 0, 0);
        }
    }
#pragma unroll
    for (int dir = 0; dir < 2; ++dir) {
        f32x16_t T0, T1;
#pragma unroll
        for (int i = 0; i < 16; ++i) { T0[i] = 0.f; T1[i] = 0.f; }
        LAS const unsigned char* st = lds + L_ST + (hh * 2 + dir) * 9216;
#pragma unroll
        for (int s = 0; s < 4; ++s) {
            const bf16x8_t a0 = *(LAS const bf16x8_t*)(st + r * 144 + 32 * s + 16 * h2), a1 = *(LAS const bf16x8_t*)(st + (32 + r) * 144 + 32 * s + 16 * h2);
            T0 = __builtin_amdgcn_mfma_f32_32x32x16_bf16(a0, qf[s], T0, 0, 0, 0);
            T1 = __builtin_amdgcn_mfma_f32_32x32x16_bf16(a1, qf[s], T1, 0, 0, 0);
        }
        const float coef = dir == 0 ? __builtin_amdgcn_exp2f(lgf * (float)(qi + 1)) : __builtin_amdgcn_exp2f(lgb * (float)(128 - qi));
#pragma unroll
        for (int i = 0; i < 16; ++i) { O0[i] += coef * T0[i]; O1[i] += coef * T1[i]; }
    }
    float ss = 0.f;
#pragma unroll
    for (int i = 0; i < 16; ++i) ss += O0[i] * O0[i] + O1[i] * O1[i];
    ss += __shfl_xor(ss, 32);
    const float rs = rsqrtf(ss * (1.f / 64.f) + NORM_EPS);
    const bf16_t* gp = PROJB + (size_t)qrow * PROJ_LD + PJ_RG + head * 64 + 4 * h2;
    bf16_t* op = MIX + (size_t)qrow * 1024 + 768 + head * 64 + 4 * h2;
#pragma unroll
    for (int g = 0; g < 4; ++g) {
        const uint2 g0 = *(const uint2*)(gp + 8 * g), g1 = *(const uint2*)(gp + 32 + 8 * g);
        float gv[8] = {__uint_as_float(g0.x << 16), __uint_as_float(g0.x & 0xFFFF0000u), __uint_as_float(g0.y << 16), __uint_as_float(g0.y & 0xFFFF0000u),
                       __uint_as_float(g1.x << 16), __uint_as_float(g1.x & 0xFFFF0000u), __uint_as_float(g1.y << 16), __uint_as_float(g1.y & 0xFFFF0000u)};
        float o[8];
#pragma unroll
        for (int j = 0; j < 4; ++j) { o[j] = O0[4 * g + j] * rs * silu_f(gv[j]); o[4 + j] = O1[4 * g + j] * rs * silu_f(gv[4 + j]); }
        *(uint2*)(op + 8 * g) = make_uint2(pkbf(o[0], o[1]), pkbf(o[2], o[3]));
        *(uint2*)(op + 32 + 8 * g) = make_uint2(pkbf(o[4], o[5]), pkbf(o[6], o[7]));
    }
}

__device__ __forceinline__ void ph_mixer_mfma(const P& p, int layer, bool ctxq, LAS unsigned char* lds) {
    const bf16_t* POST = (const bf16_t*)(p.ws + OFF_POST); const bf16_t* PROJB = (const bf16_t*)(p.ws + OFF_PROJ);
    bf16_t* MIX = (bf16_t*)(p.ws + OFF_H);
    const int G = gridDim.x, bid = blockIdx.x;
    const float L2E = 1.4426950408889634f;
    const int n_mla = BATCH * 4 * 16, n_swa = BATCH * 8 * 16, n_mlac = ctxq ? BATCH * 4 : 0, n_swac = ctxq ? BATCH * 8 : 0;
    const int n_ret = BATCH * 32 * 2, n_retc = ctxq ? BATCH * 2 * 2 : 0;
    const int total = n_mla + n_swa + n_mlac + n_swac + n_ret + n_retc;
    const int nmine = (total - bid + G - 1) / G;
    for (int k = 0; k < nmine; ++k) { const int u = bid + ((bid & 1) ? (nmine - 1 - k) : k) * G;
        if (u < n_mla) {
            const int qb = u & 15, h = (u >> 4) & 3, b = u >> 6;
            attn_unit_f8(lds, p.ws + OFF_QK8, p.ws + OFF_V8T, MIX, b, qb * 256, h, 0, SEQ, 0.10206207261596575f * L2E);
        } else if (u < n_mla + n_swa) {
            const int v = u - n_mla, qb = v & 63, kvh = (v >> 6) & 1, b = v >> 7;
            const int q0 = qb * 64; int lo = (q0 - 128) & ~127; lo = lo < 0 ? 0 : lo; int hi = (q0 + 192 + 127) & ~127; hi = hi > SEQ ? SEQ : hi;
            attn_unit<64, true, true>(lds, POST, PROJB, PROJ_LD, MIX, b, q0, PC_QB + kvh * 256, PC_KB + kvh * 64, 992 + kvh * 64, 256 + kvh * 256, lo, hi, 0.f, 0.125f * L2E, p.in[13] + layer * 8 + kvh * 4, L2E);
        } else if (u < n_mla + n_swa + n_mlac) {
            const int v = u - n_mla - n_swa, h = v & 3, b = v >> 2;
            attn_unit_f8(lds, p.ws + OFF_QK8, p.ws + OFF_V8T, MIX, b, SEQ, h, 0, 0, 0.10206207261596575f * L2E);
        } else if (u < n_mla + n_swa + n_mlac + n_swac) {
            const int v = u - n_mla - n_swa - n_mlac, qb = v & 3, kvh = (v >> 2) & 1, b = v >> 3;
            attn_unit<64, true, true>(lds, POST, PROJB, PROJ_LD, MIX, b, SEQ + qb * 64, PC_QB + kvh * 256, PC_KB + kvh * 64, 992 + kvh * 64, 256 + kvh * 256, 0, 0, 0.f, 0.125f * L2E, p.in[13] + layer * 8 + kvh * 4, L2E);
        } else if (u < n_mla + n_swa + n_mlac + n_swac + n_ret) {
            const int v = u - n_mla - n_swa - n_mlac - n_swac;
            ret_unit(lds, p, layer, v >> 6, (v >> 1) & 31, v & 1);
        } else {
            const int v = u - n_mla - n_swa - n_mlac - n_swac - n_ret;
            ret_unit(lds, p, layer, v >> 2, 32 + ((v >> 1) & 1), v & 1);
        }
    }
}

__device__ __forceinline__ void ph_tables(const P& p) {
    float2* tr = (float2*)(p.ws + OFF_TAB); float2* t32 = tr + 4096 * 32; float2* t16 = t32 + 64 * 16;
    const int n = 4096 * 32 + 64 * 16 + 64 * 8;
    for (int i = blockIdx.x * NT + threadIdx.x; i < n; i += gridDim.x * NT) {
        float ang;
        if (i < 4096 * 32) ang = (float)(i >> 5) * rope_inv(2 * (i & 31), 64);
        else if (i < 4096 * 32 + 64 * 16) { const int j = i - 4096 * 32; ang = (float)(j >> 4) * rope_inv(2 * (j & 15), 32); }
        else { const int j = i - 4096 * 32 - 64 * 16; ang = (float)(j >> 3) * rope_inv(2 * (j & 7), 16); }
        tr[i] = make_float2(cosf(ang), sinf(ang));
    }
}

__device__ __forceinline__ void ph_prep2(const P& p, int layer, LAS unsigned char* lds) {
    const bf16_t* PROJ = (const bf16_t*)(p.ws + OFF_PROJ);
    bf16_t* POST = (bf16_t*)(p.ws + OFF_POST);
    unsigned char* QK8 = p.ws + OFF_QK8; unsigned char* V8T = p.ws + OFF_V8T;
#define CVT4_F8(a_, b_, c_, d_) __builtin_amdgcn_cvt_pk_fp8_f32(f8clamp(c_), f8clamp(d_), __builtin_amdgcn_cvt_pk_fp8_f32(f8clamp(a_), f8clamp(b_), 0, false), true)
    const bf16_t* WUQ = (const bf16_t*)(p.ws + OFF_WUQ) + (size_t)layer * 384 * 192;
    const bf16_t* WUKV = (const bf16_t*)(p.ws + OFF_WUKV) + (size_t)layer * 512 * 128;
    const float* qn = p.in[9] + layer * 192; const float* kvn = p.in[11] + layer * 128;
    const float2* tab_ret = (const float2*)(p.ws + OFF_TAB); const float2* tab32 = tab_ret + 4096 * 32; const float2* tab16 = tab32 + 64 * 16;
    int tid_ = threadIdx.x; asm volatile("" : "+v"(tid_));
    const int tid = tid_, wid = __builtin_amdgcn_readfirstlane(tid >> 6), lane = tid & 63, fr = lane & 15, fq = lane >> 4;
    constexpr int QP = 400, KVP = 272, L_CQ = 0, L_CKV = 32 * QP;
    constexpr int SQP = 1040, L_SQ = L_CKV + 32 * KVP, L_SV = L_SQ + 32 * SQP;
#define PREP_LOADS(RA, RB, RC, RK, P1, P2, UNIT) do { const int R0_ = (UNIT) * 32; int tidA = tid; asm volatile("" : "+v"(tidA)); const int tk_ = tidA >> 4, sub_ = tidA & 15; \
        { const bf16_t* pr_ = PROJ + (size_t)(R0_ + tk_) * PROJ_LD; RA = *(const uint2*)(pr_ + sub_ * 12); RB = *(const uint2*)(pr_ + sub_ * 12 + 4); RC = *(const uint2*)(pr_ + sub_ * 12 + 8); RK = *(const u32x4_t*)(pr_ + 192 + sub_ * 8); } \
        _Pragma("unroll") for (int it_ = 0; it_ < 1; ++it_) { const int w_ = it_ * NT + tidA;   \
            if (w_ < 32 * 2) { const int tok_ = w_ / 2, task_ = 72 + (w_ & 1); int src_, dist_; \
                if (task_ < 40) { const int hd_ = task_ >> 2, half_ = (task_ >> 1) & 1, cp_ = task_ & 1; src_ = (task_ < 32 ? 352 : 864 - 8 * 64) + hd_ * 64 + half_ * 32 + cp_ * 8; dist_ = 16; } \
                else if (task_ < 72) { const int q_ = task_ - 40, hd_ = q_ >> 2, cp_ = q_ & 3; src_ = (hd_ < 4 ? PJ_RQ + hd_ * 64 : PJ_RK + (hd_ - 4) * 64) + cp_ * 8; dist_ = 32; } \
                else { src_ = 320 + (task_ - 72) * 16; dist_ = 8; } \
                const bf16_t* pr_ = PROJ + (size_t)(R0_ + tok_) * PROJ_LD + src_; P1[it_] = *(const u32x4_t*)pr_; P2[it_] = *(const u32x4_t*)(pr_ + dist_); } \
            else { P1[it_] = (u32x4_t){0u, 0u, 0u, 0u}; P2[it_] = P1[it_]; } } } while (0)
    uint2 ra, rb, rc, na_, nb_, nc_; u32x4_t rk, nk_; u32x4_t p1[1], p2[1], n1[1], n2[1];
    if ((int)blockIdx.x < T_ALL / 32) PREP_LOADS(ra, rb, rc, rk, p1, p2, (int)blockIdx.x);
    for (int u = blockIdx.x; u < T_ALL / 32; u += gridDim.x) {
        const int R0 = u * 32; const bool isctx = R0 >= T_LAT;
        const int t0 = isctx ? (R0 - T_LAT) % CTXL : R0 % SEQ;
        const int tk = tid >> 4, sub = tid & 15;
        const bool has_next = u + (int)gridDim.x < T_ALL / 32;
        if (has_next) PREP_LOADS(na_, nb_, nc_, nk_, n1, n2, u + (int)gridDim.x);
        __syncthreads();
        *(LAS u32x4_t*)(lds + L_SQ + tk * SQP + (sub >> 3) * 512 + ((sub >> 1) & 3) * 128 + 96 + (sub & 1) * 16) = (u32x4_t){0u, 0u, 0u, 0u};
        {
            float c[12], k[8];
            c[0] = __uint_as_float(ra.x << 16); c[1] = __uint_as_float(ra.x & 0xFFFF0000u); c[2] = __uint_as_float(ra.y << 16); c[3] = __uint_as_float(ra.y & 0xFFFF0000u);
            c[4] = __uint_as_float(rb.x << 16); c[5] = __uint_as_float(rb.x & 0xFFFF0000u); c[6] = __uint_as_float(rb.y << 16); c[7] = __uint_as_float(rb.y & 0xFFFF0000u);
            c[8] = __uint_as_float(rc.x << 16); c[9] = __uint_as_float(rc.x & 0xFFFF0000u); c[10] = __uint_as_float(rc.y << 16); c[11] = __uint_as_float(rc.y & 0xFFFF0000u);
            unpack8(make_uint4(rk[0], rk[1], rk[2], rk[3]), k);
            float s1 = 0.f, s2 = 0.f;
#pragma unroll
            for (int i = 0; i < 12; ++i) s1 += c[i] * c[i];
#pragma unroll
            for (int i = 0; i < 8; ++i) s2 += k[i] * k[i];
#pragma unroll
            for (int o = 1; o < 16; o <<= 1) { s1 += __shfl_xor(s1, o); s2 += __shfl_xor(s2, o); }
            const float r1 = rsqrtf(s1 * (1.f / 192.f) + NORM_EPS), r2 = rsqrtf(s2 * (1.f / 128.f) + NORM_EPS);
            typedef unsigned u32x2_t __attribute__((ext_vector_type(2)));
#pragma unroll
            for (int i = 0; i < 3; ++i) { const int e = sub * 12 + 4 * i;
                *(LAS u32x2_t*)(lds + L_CQ + tk * QP + e * 2) = (u32x2_t){pkbf(c[4 * i] * r1 * qn[e], c[4 * i + 1] * r1 * qn[e + 1]), pkbf(c[4 * i + 2] * r1 * qn[e + 2], c[4 * i + 3] * r1 * qn[e + 3])}; }
            { const int e = sub * 8;
              *(LAS u32x4_t*)(lds + L_CKV + tk * KVP + e * 2) = (u32x4_t){pkbf(k[0] * r2 * kvn[e], k[1] * r2 * kvn[e + 1]), pkbf(k[2] * r2 * kvn[e + 2], k[3] * r2 * kvn[e + 3]),
                                                                        pkbf(k[4] * r2 * kvn[e + 4], k[5] * r2 * kvn[e + 5]), pkbf(k[6] * r2 * kvn[e + 6], k[7] * r2 * kvn[e + 7])}; }
        }
        __syncthreads();
        {
            pg8::f32x4 acc[3][2];
#pragma unroll
            for (int a = 0; a < 3; ++a)
#pragma unroll
                for (int m = 0; m < 2; ++m) acc[a][m] = (pg8::f32x4){0.f, 0.f, 0.f, 0.f};
#pragma unroll
            for (int ks = 0; ks < 6; ++ks) {
                bf16x8_t af[2];
#pragma unroll
                for (int m = 0; m < 2; ++m) af[m] = *(LAS const bf16x8_t*)(lds + L_CQ + (m * 16 + fr) * QP + (32 * ks + 8 * fq) * 2);
#pragma unroll
                for (int a = 0; a < 3; ++a) {
                    const bf16x8_t bfrag = *(const bf16x8_t*)(WUQ + (size_t)((3 * wid + a) * 16 + fr) * 192 + 32 * ks + 8 * fq);
#pragma unroll
                    for (int m = 0; m < 2; ++m) acc[a][m] = __builtin_amdgcn_mfma_f32_16x16x32_bf16(bfrag, af[m], acc[a][m], 0, 0, 0);
                }
            }
#pragma unroll
            for (int a = 0; a < 3; ++a) {
                const int nt = 3 * wid + a, t6 = nt % 6, col = nt * 16 + 4 * fq;
#pragma unroll
                for (int m = 0; m < 2; ++m) {
                    const int tok = m * 16 + fr, t = t0 + tok;
                    pg8::f32x4 v = acc[a][m];
                    if (t6 >= 4) {
                        pg8::f32x4 pv; pv[0] = __shfl_xor(v[0], 32); pv[1] = __shfl_xor(v[1], 32); pv[2] = __shfl_xor(v[2], 32); pv[3] = __shfl_xor(v[3], 32);
                        if (!isctx) { const int pos = t6 == 4 ? (t >> 6) : (t & 63);
#pragma unroll
                            for (int j = 0; j < 4; ++j) { const float2 cs = tab16[pos * 8 + 4 * (fq & 1) + j]; v[j] = v[j] * cs.x + (fq < 2 ? -pv[j] : pv[j]) * cs.y; } }
                    }
                    *(LAS int*)(lds + L_SQ + tok * SQP + (nt / 6) * 128 + t6 * 16 + 4 * fq) = CVT4_F8(v[0], v[1], v[2], v[3]);
                }
            }
        }
        {
            pg8::f32x4 acc[4][2];
#pragma unroll
            for (int a = 0; a < 4; ++a)
#pragma unroll
                for (int m = 0; m < 2; ++m) acc[a][m] = (pg8::f32x4){0.f, 0.f, 0.f, 0.f};
#pragma unroll
            for (int ks = 0; ks < 4; ++ks) {
                bf16x8_t af[2];
#pragma unroll
                for (int m = 0; m < 2; ++m) af[m] = *(LAS const bf16x8_t*)(lds + L_CKV + (m * 16 + fr) * KVP + (32 * ks + 8 * fq) * 2);
#pragma unroll
                for (int a = 0; a < 4; ++a) {
                    const bf16x8_t bfrag = *(const bf16x8_t*)(WUKV + (size_t)((4 * wid + a) * 16 + fr) * 128 + 32 * ks + 8 * fq);
#pragma unroll
                    for (int m = 0; m < 2; ++m) acc[a][m] = __builtin_amdgcn_mfma_f32_16x16x32_bf16(bfrag, af[m], acc[a][m], 0, 0, 0);
                }
            }
#pragma unroll
            for (int a = 0; a < 4; ++a) {
                const int n = (4 * wid + a) * 16 + 4 * fq, hh = n >> 7, d = n & 127;
                const int dst = d < 64 ? PC_KA + hh * 96 + d : PC_VA + hh * 64 + (d - 64);
#pragma unroll
                for (int m = 0; m < 2; ++m) { const pg8::f32x4 v = acc[a][m]; const int row = R0 + m * 16 + fr;
                    const int w8 = CVT4_F8(v[0], v[1], v[2], v[3]);
                    const int tl = m * 16 + fr; (void)row;
                    if (d < 64) *(LAS int*)(lds + L_SQ + tl * SQP + 512 + hh * 128 + d) = w8;
                    else { LAS unsigned char* vp = lds + L_SV + (hh * 64 + (d - 64)) * 32 + 16 * ((tl >> 2) & 1) + 4 * (tl >> 3) + (tl & 3);
                        vp[0] = (unsigned char)w8; vp[32] = (unsigned char)(w8 >> 8); vp[64] = (unsigned char)(w8 >> 16); vp[96] = (unsigned char)((unsigned)w8 >> 24); } }
                (void)dst;
            }
        }
        int tidB = tid; asm volatile("" : "+v"(tidB));
#pragma unroll
        for (int it = 0; it < 1; ++it) {
            const int w = it * NT + tidB;
            if (w < 32 * 2) {
                const int tok = w / 2, task = 72 + (w & 1), t = t0 + tok;
                bf16_t* po = POST + (size_t)(R0 + tok) * POST_LD;
                int dst, dist; const float2* tb; float scl = 1.f; bool bc = false;
                if (task < 40) { const int hd = task >> 2, half = (task >> 1) & 1, cp = task & 1;
                    dst = (task < 32 ? PC_QB : PC_KB - 8 * 64) + hd * 64 + half * 32 + cp * 8; dist = 16; tb = tab32 + (half ? (t & 63) : (t >> 6)) * 16 + cp * 8; }
                else if (task < 72) { const int q = task - 40, hd = q >> 2, cp = q & 3;
                    dst = PC_RQ + hd * 64 + cp * 8; dist = 32; tb = tab_ret + t * 32 + cp * 8; if (hd >= 4) scl = 0.125f; }
                else { const int half = task - 72; dst = PC_KA + 64 + half * 16; dist = 8; bc = true; tb = tab16 + (half ? (t & 63) : (t >> 6)) * 8; }
                float x1[8], x2[8]; unpack8(make_uint4(p1[it][0], p1[it][1], p1[it][2], p1[it][3]), x1); unpack8(make_uint4(p2[it][0], p2[it][1], p2[it][2], p2[it][3]), x2);
                if (!isctx) {
                    const float4 c0 = *(const float4*)(tb), c1 = *(const float4*)(tb + 2), c2 = *(const float4*)(tb + 4), c3 = *(const float4*)(tb + 6);
                    const float cs[8] = {c0.x, c0.z, c1.x, c1.z, c2.x, c2.z, c3.x, c3.z}, sn[8] = {c0.y, c0.w, c1.y, c1.w, c2.y, c2.w, c3.y, c3.w};
#pragma unroll
                    for (int j = 0; j < 8; ++j) { const float a = x1[j], b2 = x2[j]; x1[j] = a * cs[j] - b2 * sn[j]; x2[j] = b2 * cs[j] + a * sn[j]; }
                }
#pragma unroll
                for (int j = 0; j < 8; ++j) { x1[j] *= scl; x2[j] *= scl; }
                const uint4 o1 = make_uint4(pkbf(x1[0], x1[1]), pkbf(x1[2], x1[3]), pkbf(x1[4], x1[5]), pkbf(x1[6], x1[7]));
                const uint4 o2 = make_uint4(pkbf(x2[0], x2[1]), pkbf(x2[2], x2[3]), pkbf(x2[4], x2[5]), pkbf(x2[6], x2[7]));
                if (bc) {
                    LAS unsigned char* k8 = lds + L_SQ + tok * SQP + 512 + 64 + (task - 72) * 16;
                    typedef unsigned u32x2_t __attribute__((ext_vector_type(2)));
                    const uint2 f1 = make_uint2((unsigned)CVT4_F8(x1[0], x1[1], x1[2], x1[3]), (unsigned)CVT4_F8(x1[4], x1[5], x1[6], x1[7]));
                    const uint2 f2 = make_uint2((unsigned)CVT4_F8(x2[0], x2[1], x2[2], x2[3]), (unsigned)CVT4_F8(x2[4], x2[5], x2[6], x2[7]));
#pragma unroll
                    for (int hh = 0; hh < 4; ++hh) { *(LAS u32x2_t*)(k8 + hh * 128) = (u32x2_t){f1.x, f1.y}; *(LAS u32x2_t*)(k8 + hh * 128 + 8) = (u32x2_t){f2.x, f2.y}; }
                } else { *(uint4*)(po + dst) = o1; *(uint4*)(po + dst + dist) = o2; }
            }
        }
        __syncthreads();
        {
            const int rr = tid >> 4, pc = tid & 15;
            uint4* qd = (uint4*)(QK8 + (size_t)(R0 + rr) * 1024 + pc * 64);
#pragma unroll
            for (int j = 0; j < 4; ++j) { const u32x4_t t4 = *(LAS const u32x4_t*)(lds + L_SQ + rr * SQP + pc * 64 + j * 16); qd[j] = make_uint4(t4[0], t4[1], t4[2], t4[3]); }
            int bb, key0; if (R0 < T_LAT) { bb = R0 >> 12; key0 = R0 & (SEQ - 1); } else { bb = (R0 - T_LAT) >> 8; key0 = SEQ + ((R0 - T_LAT) & (CTXL - 1)); }
            const int vr = tid >> 1, hf = tid & 1;
            const u32x4_t t4 = *(LAS const u32x4_t*)(lds + L_SV + vr * 32 + hf * 16);
            *(uint4*)(V8T + (size_t)((bb * 4 + (vr >> 6)) * 64 + (vr & 63)) * 4352 + (key0 & ~63) + 32 * hf + 16 * ((key0 >> 5) & 1)) = make_uint4(t4[0], t4[1], t4[2], t4[3]);
        }
        if (has_next) { ra = na_; rb = nb_; rc = nc_; rk = nk_;
#pragma unroll
            for (int it = 0; it < 1; ++it) { p1[it] = n1[it]; p2[it] = n2[it]; } }
    }
#undef PREP_LOADS
#undef CVT4_F8
}
#define N_PHASES 23
#define LDS_BYTES 147456
#define LDS_MISC 131072
__device__ __forceinline__ P load_p() {
#if defined(__HIP_DEVICE_COMPILE__)
    const __attribute__((address_space(4))) P* kq = (const __attribute__((address_space(4))) P*)__builtin_amdgcn_kernarg_segment_ptr();
    asm volatile("" : "+s"(kq));
    return *kq;
#else
    return P{};
#endif
}
__global__ void __launch_bounds__(NT, 2) fwd_kernel(P p0, int lo, int hi) {
    extern __shared__ __attribute__((aligned(16))) unsigned char lds_raw[];
    float* lds = (float*)lds_raw;
    LAS unsigned char* ldsl = (LAS unsigned char*)lds_raw;
    volatile LAS unsigned* st = (volatile LAS unsigned*)(ldsl + LDS_MISC);
    if (threadIdx.x < 4) st[threadIdx.x] = 0u;
    __syncthreads();
    XcdBarrier bar; bar.bar = (unsigned*)(p0.ws + OFF_CTL); bar.x = 0; bar.st = st;
    if (hi - lo > 1) bar = xcd_barrier_post((unsigned*)(p0.ws + OFF_CTL), st);
#define IN(k) (lo <= (k) && (k) < hi)
#define PH(k) if (IN(k)) if (const P p = load_p(); true)
#define SEAM(k) do { if (IN(k) && IN((k) + 1)) xcd_barrier(bar); } while (0)
#define MOD ((const float*)(p.ws + OFF_MOD))
#define H ((bf16_t*)(p.ws + OFF_H))
#define XC ((float*)(p.ws + OFF_XC))
#define PROJ ((bf16_t*)(p.ws + OFF_PROJ))
#define ACT ((bf16_t*)(p.ws + OFF_ACT))
#define CNT ((int*)(p.ws + OFF_CNT))
#define LIST ((const int*)(p.ws + OFF_LIST))
#define WL ((const float*)(p.ws + OFF_WL))
#define WIN ((const bf16_t*)(p.ws + OFF_WIN))
#define WOUT ((const bf16_t*)(p.ws + OFF_WOUT))
#define FGU ((const bf16_t*)(p.ws + OFF_FGU))
#define FD ((const bf16_t*)(p.ws + OFF_FD))
#define MGU ((const bf16_t*)(p.ws + OFF_MGU))
#define MDW ((const bf16_t*)(p.ws + OFF_MD))
#define YB ((bf16_t*)(p.ws + OFF_Y))
#define YB2 ((bf16_t*)(p.ws + OFF_Y2))
#define PARTB ((float*)(p.ws + OFF_PART))
    const int G = gridDim.x, bid = blockIdx.x;

    PH(0) { ph_mod(p, lds); ph_tables(p); ph_conv_early(p, lds); ph_fgu_colmax(p); ph_win_colmax(p); }
    SEAM(0);
    PH(1) { ph_norm(p, 0, 1, T_ALL, false, true, nullptr, 0, 0, 0, p.ws + OFF_QK8, false, (float*)(p.ws + OFF_RSW)); __syncthreads(); ph_conv_fgu_i8(p, lds); }
    SEAM(1);
    PH(2) { pg8::DenseSchedT<false, true> S{(const bf16_t*)(p.ws + OFF_QK8), WIN, 512, 512, T_ALL / 256, PROJ_LD / 256, G, bid};
            pg8::EpiWinRope E{PROJ, (bf16_t*)(p.ws + OFF_POST), (const float*)(p.ws + OFF_RSW), (const float*)(p.ws + OFF_CSW) + 0 * PROJ_LD, (const float2*)(p.ws + OFF_TAB), (const float2*)(p.ws + OFF_TAB) + 4096 * 32}; pg8::gemm_phase(ldsl, S, E); }
    SEAM(2);
    PH(3) { ph_prep2(p, 0, ldsl); __syncthreads(); ph_ret_T(p, 0, ldsl); }
    SEAM(3);
    PH(5) ph_mixer_mfma(p, 0, true, ldsl);
    SEAM(5);
    PH(6) {
        { pg8::DenseSched S{H, WOUT, 1024, 1024, T_ALL / 256, 4, G, bid};
          pg8::EpiBf16Norm E{YB, 1024, (unsigned)((size_t)T_ALL * 1024 * 2), (unsigned*)(p.ws + OFF_PCNT), 1.f};
          pg8::gemm_phase(ldsl, S, E); }
        norm_help(p, NormArgs{0, 2, false, true, YB, 0, 2048, 0, p.ws + OFF_H8D, false, (float*)(p.ws + OFF_RS8)}, (unsigned*)(p.ws + OFF_PCNT), 32u, (unsigned*)(p.ws + OFF_CLAIM), T_ALL / 256, (LAS unsigned*)(ldsl + LDS_MISC + 32));
    }
    SEAM(6);
    PH(8) { pg8::DenseSchedT<false, true> S{(const bf16_t*)(p.ws + OFF_H8D), FGU, 512, 512, T_ALL / 256, 2 * D_FF / 256, G, bid};
            pg8::EpiSwigluI8 E{ACT, D_FF, (const float*)(p.ws + OFF_RS8), (const float*)(p.ws + OFF_CS8)}; pg8::gemm_phase(ldsl, S, E); }
    SEAM(8);
    PH(9) {
        { pg8::DenseSchedT<true> S{ACT, FD, D_FF / 2, D_FF / 2, T_ALL / 256, 4, G, bid};
          pg8::EpiBf16Norm E{YB2, 1024, (unsigned)((size_t)T_ALL * 1024 * 2), (unsigned*)(p.ws + OFF_PCNT) + 136 * 64, 1.f / (F8_SA * F8_SW)};
          pg8::gemm_phase(ldsl, S, E); }
        norm_help(p, NormArgs{1, 1, false, false, YB2, 0, 5120, 0, p.ws + OFF_QK8, false, (float*)(p.ws + OFF_RSW)}, (unsigned*)(p.ws + OFF_PCNT) + 136 * 64, 32u, (unsigned*)(p.ws + OFF_CLAIM) + 64, T_ALL / 256, (LAS unsigned*)(ldsl + LDS_MISC + 32));
    }
    SEAM(9);
    PH(11) { pg8::DenseSchedT<false, true> S{(const bf16_t*)(p.ws + OFF_QK8), (WIN + (size_t)PROJ_LD * 1024), 512, 512, T_ALL / 256, PROJ_LD / 256, G, bid};
            pg8::EpiWinRope E{PROJ, (bf16_t*)(p.ws + OFF_POST), (const float*)(p.ws + OFF_RSW), (const float*)(p.ws + OFF_CSW) + 1 * PROJ_LD, (const float2*)(p.ws + OFF_TAB), (const float2*)(p.ws + OFF_TAB) + 4096 * 32}; pg8::gemm_phase(ldsl, S, E); }
    SEAM(11);
    PH(12) { ph_prep2(p, 1, ldsl); __syncthreads(); ph_ret_T(p, 1, ldsl); }
    SEAM(12);
    PH(14) ph_mixer_mfma(p, 1, false, ldsl);
    SEAM(14);
    PH(15) { pg8::DenseSched S{H, WOUT + (size_t)1024 * 1024, 1024, 1024, T_LAT / 256, 4, G, bid}; pg8::EpiBf16 E{YB, 1024}; pg8::gemm_phase(ldsl, S, E); }
    SEAM(15);
    PH(16) { ph_norm(p, 1, 2, T_LAT, true, false, YB, 1, 2048, 0, p.ws + OFF_H, false); ph_conv_late(p, lds); }
    SEAM(16);
#pragma unroll
    for (int s = 0; s < 2; ++s) {
        if (IN(17 + 2 * s) || IN(18 + 2 * s)) {
            LAS int* tab = (LAS int*)(ldsl + LDS_MISC + 64 + 128 * s);
            { const P p = load_p();
            __syncthreads();
            if (threadIdx.x == 0) { int tbv = 0; tab[8] = 0;
                for (int e = 0; e < 8; ++e) { const int ce = __hip_atomic_load(CNT + s * 8 + e, __ATOMIC_RELAXED, __HIP_MEMORY_SCOPE_AGENT); tab[e] = ce; tbv += (ce + 255) >> 8; tab[9 + e] = tbv; } }
            __syncthreads(); }
            const int nTm = tab[16];
            PH(17 + 2 * s) {
                if (s == 1) pg8::moe_combine((bf16_t*)(p.ws + OFF_YM), PARTB, (const LAS int*)(ldsl + LDS_MISC + 64), 4, 1.f / (F8_SA * F8_SW));
                pg8::MoeSched<true, true> S{H, MGU, 512, 512, 2 * D_FFE / 256, G, bid, (size_t)D_FFE * 1024, LIST + (size_t)s * 8 * 32768, tab, 0, nTm * (2 * D_FFE / 256), 1, 512 / 64};
                pg8::EpiSwigluT<true, true> E{ACT, D_FFE}; pg8::gemm_phase(ldsl, S, E);
            }
            SEAM(17 + 2 * s);
            PH(18 + 2 * s) {
                const int U = nTm * 4, rem = U % G, split = (rem > 0 && rem * MOE_WAYS <= G) ? 1 : 0, umain = split ? U - rem : U;
                { pg8::MoeSched<false, true> S{ACT, MDW, D_FFE / 2, D_FFE / 2, 4, G, bid, (size_t)512 * D_FFE, nullptr, tab, 0, umain, 1, D_FFE / 128};
                  pg8::EpiBf16S E{(bf16_t*)(p.ws + OFF_YM) + (size_t)s * ACT_ROWS * 1024, 1024, 1.f / (F8_SA * F8_SW)};
                  pg8::gemm_phase(ldsl, S, E); }
                if (split) { pg8::MoeSched<false, true> S{ACT, MDW, D_FFE / 2, D_FFE / 2, 4, G, bid, (size_t)512 * D_FFE, nullptr, tab, umain, U, MOE_WAYS, D_FFE / 128 / MOE_WAYS};
                  pg8::EpiPart E{PARTB}; pg8::gemm_phase(ldsl, S, E); }
            }
        }
        SEAM(18 + 2 * s);
    }
    PH(21) { const LAS int* tab1 = (const LAS int*)(ldsl + LDS_MISC + 64 + 128);
        pg8::moe_combine((bf16_t*)(p.ws + OFF_YM) + (size_t)ACT_ROWS * 1024, PARTB, tab1, 4, 1.f / (F8_SA * F8_SW)); }
    SEAM(21);
    PH(22) ph_final_moe(p, (const LAS int*)(ldsl + LDS_MISC + 64), (const LAS int*)(ldsl + LDS_MISC + 64 + 128));
}

extern "C" void kernel_launch(void* const* d_in, const int* in_sizes, int n_in, void* d_out, int out_size, void* d_ws, size_t ws_size, hipStream_t stream) {
    static int grid = 0;
    if (!grid) {
        if (n_in != 25 || out_size != T_LAT * 1024 || ws_size < WS_END) { fprintf(stderr, "kernel_launch: unexpected shapes (n_in %d out %d ws %zu need %zu)\n", n_in, out_size, ws_size, (size_t)WS_END); grid = -1; return; }
        int dev = 0, cus = 0, per_cu = 0;
        (void)hipGetDevice(&dev); (void)hipDeviceGetAttribute(&cus, hipDeviceAttributeMultiprocessorCount, dev);
        (void)hipFuncSetAttribute((const void*)fwd_kernel, hipFuncAttributeMaxDynamicSharedMemorySize, LDS_BYTES);
        (void)hipOccupancyMaxActiveBlocksPerMultiprocessor(&per_cu, (const void*)fwd_kernel, NT, LDS_BYTES);
        if (per_cu < 1) { fprintf(stderr, "kernel_launch: occupancy query says %d\n", per_cu); }
        grid = cus > 0 ? cus : 256;
    }
    if (grid < 0) return;
    (void)hipMemsetAsync((char*)d_ws + OFF_CTL, 0, CTL_BYTES, stream);
    P p{};
    for (int i = 0; i < 25; ++i) p.in[i] = (const float*)d_in[i];
    p.out = (float*)d_out; p.ws = (unsigned char*)d_ws;
    hipLaunchKernelGGL(fwd_kernel, dim3(grid), dim3(NT), LDS_BYTES, stream, p, 0, N_PHASES);
}
```

```cpp
#include <hip/hip_runtime.h>
#include <stdint.h>
#include <stdio.h>

#define D_MODEL 1024
#define BATCH 8
#define SEQ 4096
#define CTXL 256
#define T_LAT (BATCH * SEQ)
#define T_CTX (BATCH * CTXL)
#define T_ALL (T_LAT + T_CTX)
#define IN_DIM 2144
#define PROJ_LD 2304
#define POST_LD 2816
#define D_FF 2816
#define D_FFE 3584
#define NEXP 8
#define NT 512
#define NORM_EPS 1e-6f

typedef unsigned short bf16_t;
__device__ __forceinline__ float bf2f(bf16_t v) { return __uint_as_float(((unsigned)v) << 16); }
__device__ __forceinline__ bf16_t f2bf(float f) { unsigned u = __float_as_uint(f); u += 0x7FFFu + ((u >> 16) & 1u); return (bf16_t)(u >> 16); }
__device__ __forceinline__ float silu_f(float v) { return v / (1.f + expf(-v)); }

#define PJ_RQ 1280
#define PJ_RK 1536
#define PJ_RV 1792
#define PJ_RG 2048
#define PJ_F8 1280
#define PC_QA 0
#define PC_KA 384
#define PC_VA 768
#define PC_QB 1024
#define PC_KB 1536
#define PC_VB 1664
#define PC_RQ 1792
#define PC_RK 2048
#define PC_RV 2304
#define PC_RG 2560

constexpr size_t AL256(size_t x) { return (x + 255) & ~(size_t)255; }
constexpr size_t OFF_CTL  = 0;
constexpr size_t CTL_BYTES = 294912;
constexpr size_t OFF_PCNT = 32768;
constexpr size_t OFF_CLAIM = 20480;
constexpr size_t OFF_CMAX = 196608;
constexpr size_t OFF_CS8  = OFF_CMAX + 5632 * 4;
constexpr size_t OFF_CMAXW = OFF_CS8 + 5632 * 4;
constexpr size_t OFF_CSW  = 262144;
constexpr size_t OFF_RSW  = 294912;
static_assert(OFF_RSW + (size_t)T_ALL * 4 <= (1u << 20), "row scales fit below OFF_MOD");
constexpr size_t OFF_CNT  = 16384;
constexpr size_t OFF_MOD  = 1u << 20;
constexpr size_t OFF_TAB  = 3u << 19;
constexpr size_t OFF_WIN  = 3u << 20;
constexpr size_t OFF_WOUT = OFF_WIN + (size_t)2 * PROJ_LD * 1024 * 2;
constexpr size_t OFF_FGU  = OFF_WOUT + (size_t)2 * 1024 * 1024 * 2;
constexpr size_t OFF_FD   = OFF_FGU + (size_t)2 * D_FF * 1024 * 2;
constexpr size_t OFF_WUQ  = OFF_FD + (size_t)1024 * D_FF * 2;
constexpr size_t OFF_WUKV = OFF_WUQ + (size_t)2 * 384 * 192 * 2;
constexpr size_t OFF_H    = OFF_WUKV + (size_t)2 * 512 * 128 * 2;
constexpr size_t OFF_XC   = OFF_H + (size_t)T_ALL * 1024 * 2;
constexpr size_t OFF_LIST = OFF_XC + (size_t)T_CTX * 1024 * 4;
constexpr size_t OFF_WL   = OFF_LIST + (size_t)2 * 8 * 32768 * 4;
constexpr size_t OFF_R    = OFF_WL + (size_t)2 * 8 * 32768 * 4;
constexpr size_t OFF_PROJ = OFF_R;
constexpr size_t OFF_POST = OFF_PROJ + (size_t)T_ALL * PROJ_LD * 2;
constexpr size_t OFF_TT   = OFF_POST + (size_t)T_ALL * POST_LD * 2;
constexpr size_t R1_END   = OFF_TT + (size_t)BATCH * 4 * 34 * 2 * 4096 * 4;
constexpr size_t OFF_ACT  = OFF_R;
constexpr size_t OFF_Y    = OFF_PROJ;
constexpr size_t OFF_H8D  = OFF_ACT + (size_t)T_ALL * D_FF;
constexpr size_t OFF_RS8   = OFF_H8D + (size_t)T_ALL * 1024;
constexpr size_t OFF_Y2   = OFF_ACT + (size_t)T_ALL * D_FF * 2;
constexpr size_t ACT_ROWS = T_LAT + NEXP * 256;
constexpr size_t OFF_MGU  = OFF_ACT + ACT_ROWS * D_FFE;
constexpr size_t OFF_MD   = OFF_MGU + (size_t)NEXP * 2 * D_FFE * 1024;
constexpr size_t OFF_PART = OFF_MD + (size_t)NEXP * 1024 * D_FFE;
constexpr size_t PART_END = OFF_PART + (size_t)256 * 65536 * 4;
constexpr size_t OFF_YM   = PART_END;
constexpr size_t OFF_INV  = OFF_YM + (size_t)2 * ACT_ROWS * 1024 * 2;
constexpr size_t YM_END   = OFF_INV + (size_t)T_LAT * 32;
constexpr size_t OFF_QK8  = YM_END;
constexpr size_t OFF_V8T  = OFF_QK8 + (size_t)T_ALL * 1024;
constexpr size_t F8_END   = OFF_V8T + (size_t)BATCH * 4 * 64 * 4352;
constexpr size_t WS_END   = F8_END > R1_END ? F8_END : R1_END;
static_assert(R1_END <= WS_END, "phase-1 buffers fit");
static_assert(WS_END <= 607070848, "workspace budget");
static_assert(OFF_Y2 + (size_t)T_ALL * 1024 * 2 <= WS_END, "Y2 fits");
static_assert(OFF_MGU >= OFF_Y + (size_t)T_ALL * 1024 * 2, "expert weights are converted while norm2(L1) still reads Y");

struct P { const float* in[25]; float* out; unsigned char* ws; };

#define XB_TMO      128
#define XB_XCNT(j)  (256  + 64 * (j))
#define XB_XSUB(j)  (1280 + 64 * (j))
#define XB_XGEN(j)  (2304 + 64 * (j))
#define XB_TOP      3328
#define XB_TOPGEN   3392
#define XCD_BAR_WORDS 3456
#define XB_SPIN_CAP (1u << 22)
#define LAS __attribute__((address_space(3)))

__device__ __forceinline__ unsigned xb_ld(unsigned* p)              { return __hip_atomic_load(p, __ATOMIC_RELAXED, __HIP_MEMORY_SCOPE_AGENT); }
__device__ __forceinline__ unsigned xb_add(unsigned* p, unsigned v) { return __hip_atomic_fetch_add(p, v, __ATOMIC_RELAXED, __HIP_MEMORY_SCOPE_AGENT); }
__device__ __forceinline__ unsigned xb_xcc_id() { return (unsigned)__builtin_amdgcn_s_getreg((3 << 11) | 20) & 0xFu; }
#define XB_SPIN(cond, bar) do { unsigned _sp = 0; while (cond) { __builtin_amdgcn_s_sleep(1); \
    if ((++_sp & 255u) == 0u) { if (xb_ld(&(bar)[XB_TMO])) break; if (_sp > XB_SPIN_CAP) { atomicAdd(&(bar)[XB_TMO], 1u); break; } } } } while (0)

struct XcdBarrier { unsigned* bar; unsigned x; volatile LAS unsigned* st; };

__device__ __forceinline__ XcdBarrier xcd_barrier_post(unsigned* bar, volatile LAS unsigned* st) {
    XcdBarrier b; b.bar = bar; b.x = xb_xcc_id(); b.st = st;
    if (threadIdx.x == 0) (void)xb_add(&bar[XB_XCNT(b.x)], 1u);
    return b;
}
__device__ __forceinline__ void xcd_barrier_complete(unsigned* bar, unsigned x, unsigned& nloc, unsigned& nx) {
    const unsigned G = gridDim.x * gridDim.y * gridDim.z;
    unsigned sum, cnt, mine, sp = 0u;
    for (;;) {
        sum = 0u; cnt = 0u; mine = 0u;
#pragma unroll
        for (unsigned j = 0; j < 16; ++j) { const unsigned c = xb_ld(&bar[XB_XCNT(j)]); sum += c; cnt += (c > 0u) ? 1u : 0u; mine = (j == x) ? c : mine; }
        if (sum == G) break;
        __builtin_amdgcn_s_sleep(1);
        if ((++sp & 255u) == 0u) { if (xb_ld(&bar[XB_TMO])) break; if (sp > XB_SPIN_CAP) { atomicAdd(&bar[XB_TMO], 1u); break; } }
    }
    nloc = mine > 0u ? mine : 1u; nx = cnt > 0u ? cnt : 1u;
}
__device__ __forceinline__ void xcd_barrier(const XcdBarrier& b) {
    asm volatile("s_waitcnt vmcnt(0)" ::: "memory");
    __syncthreads();
    if (threadIdx.x == 0) {
        unsigned* bar = b.bar;
        __builtin_amdgcn_s_waitcnt(0);
        unsigned nloc = b.st[0], nx = b.st[1];
        if (nloc == 0u) { xcd_barrier_complete(bar, b.x, nloc, nx); b.st[0] = nloc; b.st[1] = nx; }
        const unsigned old = xb_add(&bar[XB_XSUB(b.x)], 1u);
        const unsigned gen = old / nloc;
        if (old + 1u == (gen + 1u) * nloc) {
            __builtin_amdgcn_fence(__ATOMIC_RELEASE, "agent");
            asm volatile("s_waitcnt vmcnt(0)" ::: "memory");
            const unsigned og = xb_add(&bar[XB_TOP], 1u);
            const unsigned tg = og / nx;
            if (og + 1u == (tg + 1u) * nx) xb_add(&bar[XB_TOPGEN], 1u);
            else XB_SPIN(xb_ld(&bar[XB_TOPGEN]) == tg, bar);
            __builtin_amdgcn_fence(__ATOMIC_ACQUIRE, "agent");
            xb_add(&bar[XB_XGEN(b.x)], 1u);
            asm volatile("s_waitcnt vmcnt(0)" ::: "memory");
        } else {
            XB_SPIN(xb_ld(&bar[XB_XGEN(b.x)]) == gen, bar);
            __builtin_amdgcn_fence(__ATOMIC_ACQUIRE, "agent");
            asm volatile("s_waitcnt vmcnt(0)" ::: "memory");
        }
    }
    __syncthreads();
}

__device__ __forceinline__ float wave_sum(float v) {
#pragma unroll
    for (int o = 32; o > 0; o >>= 1) v += __shfl_xor(v, o);
    return v;
}
__device__ __forceinline__ void unpack8(const uint4 r, float* f) {
    f[0] = __uint_as_float(r.x << 16); f[1] = __uint_as_float(r.x & 0xFFFF0000u);
    f[2] = __uint_as_float(r.y << 16); f[3] = __uint_as_float(r.y & 0xFFFF0000u);
    f[4] = __uint_as_float(r.z << 16); f[5] = __uint_as_float(r.z & 0xFFFF0000u);
    f[6] = __uint_as_float(r.w << 16); f[7] = __uint_as_float(r.w & 0xFFFF0000u);
}
__device__ __forceinline__ int tok_row(int b, int i) { return i < SEQ ? b * SEQ + i : T_LAT + b * CTXL + (i - SEQ); }

__device__ __forceinline__ void ph_mod(const P& p, float* lds) {
    float* MOD = (float*)(p.ws + OFF_MOD);
    float* sl = lds; float* part = lds + 9 * 1024;
    int tid_ = threadIdx.x; asm volatile("" : "+v"(tid_));
    const int t = tid_, col = t & 63, ks = t >> 6;
    __syncthreads();
    for (int i = t; i < 9 * 1024; i += NT) { const int r = i >> 10, k = i & 1023; sl[i] = silu_f(r < 8 ? p.in[1][r * 1024 + k] : p.in[3][k]); }
    __syncthreads();
    for (int u = blockIdx.x; u < 2 * 96; u += gridDim.x) {
        const int l = u / 96, n = (u % 96) * 64 + col;
        const float* w = p.in[4] + (size_t)l * 1024 * 6144 + (size_t)(ks * 128) * 6144 + n;
        float acc[9];
#pragma unroll
        for (int r = 0; r < 9; ++r) acc[r] = 0.f;
#pragma unroll 8
        for (int k = 0; k < 128; ++k) { const float wv = w[(size_t)k * 6144];
#pragma unroll
            for (int r = 0; r < 9; ++r) acc[r] += sl[r * 1024 + ks * 128 + k] * wv; }
        __syncthreads();
#pragma unroll
        for (int r = 0; r < 9; ++r) part[(ks * 9 + r) * 64 + col] = acc[r];
        __syncthreads();
        for (int i = t; i < 9 * 64; i += NT) { const int r = i >> 6, c2 = i & 63; float s = 0.f;
#pragma unroll
            for (int q = 0; q < 8; ++q) s += part[(q * 9 + r) * 64 + c2];
            const int nn = (u % 96) * 64 + c2; MOD[(l * 9 + r) * 6144 + nn] = s + p.in[5][l * 6144 + nn]; }
    }
}

#define F8_SH 8.f
#define F8_SW 64.f
#define F8_SA 4.f
#define MOE_WAYS 7
__device__ __forceinline__ float f8clamp(float x) { return fminf(fmaxf(x, -448.f), 448.f); }
struct NormArgs { int layer, which; bool router, from_input; const bf16_t* resY; int res_layer, res_goff, ctx_ways; unsigned char* h8; bool both; float* i8s = nullptr; };
__device__ __forceinline__ void norm_row(const P& p, const NormArgs& a, int row, int lane) {
    const int layer = a.layer, which = a.which, res_layer = a.res_layer, res_goff = a.res_goff, ctx_ways = a.ctx_ways; const bool router = a.router, from_input = a.from_input; const bf16_t* resY = a.resY;
    const float* MOD = (const float*)(p.ws + OFF_MOD);
    const float* gain = (which == 1 ? p.in[6] : p.in[7]) + layer * 1024;
    bf16_t* H = (bf16_t*)(p.ws + OFF_H);
    float* XC = (float*)(p.ws + OFF_XC);
    int* CNT = (int*)(p.ws + OFF_CNT);
    int* LIST = (int*)(p.ws + OFF_LIST);
    float* WL = (float*)(p.ws + OFF_WL);
    {
        const float* src; float* dstx; int r;
        if (row < T_LAT) { r = row >> 12; src = (from_input ? p.in[0] : p.out) + (size_t)row * 1024; dstx = p.out + (size_t)row * 1024; }
        else { r = 8; src = (from_input ? p.in[2] : XC) + (size_t)(row - T_LAT) * 1024; dstx = XC + (size_t)(row - T_LAT) * 1024; }
        const float* md = MOD + (layer * 9 + r) * 6144 + (which == 1 ? 0 : 3072);
        float4 v[4]; float ss = 0.f;
#pragma unroll
        for (int i = 0; i < 4; ++i) v[i] = *(const float4*)(src + i * 256 + lane * 4);
        if (resY) {
            const float* gt = MOD + (res_layer * 9 + r) * 6144 + res_goff;
#pragma unroll
            for (int i = 0; i < 4; ++i) { const int col = i * 256 + lane * 4;
                const float4 g = *(const float4*)(gt + col); float4 y;
                if (row >= T_LAT && ctx_ways > 0) {
                    const int cr = row - T_LAT; const float* pp = (const float*)(p.ws + OFF_PART) + (size_t)(((cr >> 8) * 4 + i) * ctx_ways) * 65536 + (cr & 255) * 256 + lane * 4;
                    y = *(const float4*)pp;
                    for (int q = 1; q < ctx_ways; ++q) { const float4 z = *(const float4*)(pp + (size_t)q * 65536); y.x += z.x; y.y += z.y; y.z += z.z; y.w += z.w; }
                } else { const uint2 yr = *(const uint2*)(resY + (size_t)row * 1024 + col);
                    y = make_float4(__uint_as_float(yr.x << 16), __uint_as_float(yr.x & 0xFFFF0000u), __uint_as_float(yr.y << 16), __uint_as_float(yr.y & 0xFFFF0000u)); }
                v[i].x += g.x * y.x; v[i].y += g.y * y.y; v[i].z += g.z * y.z; v[i].w += g.w * y.w;
                *(float4*)(dstx + col) = v[i]; }
        }
#pragma unroll
        for (int i = 0; i < 4; ++i) ss += v[i].x * v[i].x + v[i].y * v[i].y + v[i].z * v[i].z + v[i].w * v[i].w;
        ss = wave_sum(ss);
        const float rs = rsqrtf(ss * (1.f / 1024.f) + NORM_EPS);
        if (a.i8s) {
            float oo[4][4]; float amax = 0.f;
#pragma unroll
            for (int i = 0; i < 4; ++i) { const int col = i * 256 + lane * 4;
                const float4 g = *(const float4*)(gain + col), sh = *(const float4*)(md + col), sc = *(const float4*)(md + 1024 + col);
                oo[i][0] = (v[i].x * rs * g.x) * (1.f + sc.x) + sh.x; oo[i][1] = (v[i].y * rs * g.y) * (1.f + sc.y) + sh.y;
                oo[i][2] = (v[i].z * rs * g.z) * (1.f + sc.z) + sh.z; oo[i][3] = (v[i].w * rs * g.w) * (1.f + sc.w) + sh.w;
                amax = fmaxf(fmaxf(amax, fmaxf(fabsf(oo[i][0]), fabsf(oo[i][1]))), fmaxf(fabsf(oo[i][2]), fabsf(oo[i][3]))); }
#pragma unroll
            for (int o_ = 1; o_ < 64; o_ <<= 1) amax = fmaxf(amax, __shfl_xor(amax, o_));
            amax = fmaxf(amax, 1e-20f);
            const float qs = 127.f / amax;
#pragma unroll
            for (int i = 0; i < 4; ++i) { const int q0 = (int)rintf(oo[i][0] * qs), q1 = (int)rintf(oo[i][1] * qs), q2 = (int)rintf(oo[i][2] * qs), q3 = (int)rintf(oo[i][3] * qs);
                *(int*)(a.h8 + (size_t)row * 1024 + i * 256 + lane * 4) = (int)((unsigned)(q0 & 255) | ((unsigned)(q1 & 255) << 8) | ((unsigned)(q2 & 255) << 16) | ((unsigned)q3 << 24)); }
            if (lane == 0) a.i8s[row] = amax * (1.f / 127.f);
            return;
        }
        float lg[8] = {0.f, 0.f, 0.f, 0.f, 0.f, 0.f, 0.f, 0.f};
#pragma unroll
        for (int i = 0; i < 4; ++i) {
            const int col = i * 256 + lane * 4;
            const float4 g = *(const float4*)(gain + col), sh = *(const float4*)(md + col), sc = *(const float4*)(md + 1024 + col);
            float o[4];
            o[0] = (v[i].x * rs * g.x) * (1.f + sc.x) + sh.x; o[1] = (v[i].y * rs * g.y) * (1.f + sc.y) + sh.y;
            o[2] = (v[i].z * rs * g.z) * (1.f + sc.z) + sh.z; o[3] = (v[i].w * rs * g.w) * (1.f + sc.w) + sh.w;
            if (a.h8) {
                int w8 = 0; w8 = __builtin_amdgcn_cvt_pk_fp8_f32(f8clamp(o[0] * F8_SH), f8clamp(o[1] * F8_SH), w8, false); w8 = __builtin_amdgcn_cvt_pk_fp8_f32(f8clamp(o[2] * F8_SH), f8clamp(o[3] * F8_SH), w8, true);
                *(int*)(a.h8 + (size_t)row * 1024 + col) = w8;
            }
            if (!a.h8 || a.both) {
            uint2 pk; pk.x = (unsigned)f2bf(o[0]) | ((unsigned)f2bf(o[1]) << 16); pk.y = (unsigned)f2bf(o[2]) | ((unsigned)f2bf(o[3]) << 16);
            *(uint2*)(H + (size_t)row * 1024 + col) = pk; }
            if (router) {
                const float* rw = p.in[20] + (size_t)col * 8;
#pragma unroll
                for (int j = 0; j < 4; ++j) {
                    const float4 w0 = *(const float4*)(rw + j * 8), w1 = *(const float4*)(rw + j * 8 + 4);
                    lg[0] += o[j] * w0.x; lg[1] += o[j] * w0.y; lg[2] += o[j] * w0.z; lg[3] += o[j] * w0.w;
                    lg[4] += o[j] * w1.x; lg[5] += o[j] * w1.y; lg[6] += o[j] * w1.z; lg[7] += o[j] * w1.w;
                }
            }
        }
        if (router) {
#pragma unroll
            for (int e = 0; e < 8; ++e) lg[e] = wave_sum(lg[e]);
            if (lane == 0) {
                int e0 = 0; float v0 = lg[0];
#pragma unroll
                for (int e = 1; e < 8; ++e) if (lg[e] > v0) { v0 = lg[e]; e0 = e; }
                int e1 = -1; float v1 = -3.0e38f;
#pragma unroll
                for (int e = 0; e < 8; ++e) if (e != e0 && lg[e] > v1) { v1 = lg[e]; e1 = e; }
                const float x1 = expf(v1 - v0), inv = 1.f / (1.f + x1);
                const float w0 = inv, w1 = x1 * inv;
                const int p0 = atomicAdd(&CNT[e0], 1), p1 = atomicAdd(&CNT[8 + e1], 1);
                LIST[(size_t)e0 * 32768 + p0] = row; WL[(size_t)e0 * 32768 + p0] = w0;
                LIST[(size_t)(8 + e1) * 32768 + p1] = row; WL[(size_t)(8 + e1) * 32768 + p1] = w1;
                { int* iv = (int*)(p.ws + OFF_INV) + (size_t)row * 8; *(int4*)iv = make_int4(e0, p0, e1, p1); *(float2*)(iv + 4) = make_float2(w0, w1); }
            }
        }
    }
}
__device__ __forceinline__ void norm_rows4(const P& p, const NormArgs& a, int row0, int lane) {
    const float* MOD = (const float*)(p.ws + OFF_MOD);
    bf16_t* H = (bf16_t*)(p.ws + OFF_H); float* XC = (float*)(p.ws + OFF_XC);
    const bool lat = row0 < T_LAT; const int r = lat ? (row0 >> 12) : 8;
    const float* srcb = lat ? (a.from_input ? p.in[0] : p.out) + (size_t)row0 * 1024 : (a.from_input ? p.in[2] : XC) + (size_t)(row0 - T_LAT) * 1024;
    float* dstb = lat ? p.out + (size_t)row0 * 1024 : XC + (size_t)(row0 - T_LAT) * 1024;
    float4 v[4][4]; uint2 y[4][4];
#pragma unroll
    for (int q = 0; q < 4; ++q)
#pragma unroll
        for (int i = 0; i < 4; ++i) { v[q][i] = *(const float4*)(srcb + q * 1024 + i * 256 + lane * 4); y[q][i] = *(const uint2*)(a.resY + (size_t)(row0 + q) * 1024 + i * 256 + lane * 4); }
    const float* gt = MOD + (a.res_layer * 9 + r) * 6144 + a.res_goff;
    const float* md = MOD + (a.layer * 9 + r) * 6144 + (a.which == 1 ? 0 : 3072);
    const float* gain = (a.which == 1 ? p.in[6] : p.in[7]) + a.layer * 1024;
    float4 gg[4], gn[4], sh[4], sc[4];
#pragma unroll
    for (int i = 0; i < 4; ++i) { const int col = i * 256 + lane * 4; gg[i] = *(const float4*)(gt + col); gn[i] = *(const float4*)(gain + col); sh[i] = *(const float4*)(md + col); sc[i] = *(const float4*)(md + 1024 + col); }
#pragma unroll
    for (int q = 0; q < 4; ++q) {
        float ss = 0.f;
#pragma unroll
        for (int i = 0; i < 4; ++i) { const uint2 yr = y[q][i];
            v[q][i].x += gg[i].x * __uint_as_float(yr.x << 16); v[q][i].y += gg[i].y * __uint_as_float(yr.x & 0xFFFF0000u);
            v[q][i].z += gg[i].z * __uint_as_float(yr.y << 16); v[q][i].w += gg[i].w * __uint_as_float(yr.y & 0xFFFF0000u);
            *(float4*)(dstb + q * 1024 + i * 256 + lane * 4) = v[q][i];
            ss += v[q][i].x * v[q][i].x + v[q][i].y * v[q][i].y + v[q][i].z * v[q][i].z + v[q][i].w * v[q][i].w; }
        ss = wave_sum(ss);
        const float rs = rsqrtf(ss * (1.f / 1024.f) + NORM_EPS);
        if (a.i8s) {
            float oo[4][4]; float amax = 0.f;
#pragma unroll
            for (int i = 0; i < 4; ++i) {
                oo[i][0] = (v[q][i].x * rs * gn[i].x) * (1.f + sc[i].x) + sh[i].x; oo[i][1] = (v[q][i].y * rs * gn[i].y) * (1.f + sc[i].y) + sh[i].y;
                oo[i][2] = (v[q][i].z * rs * gn[i].z) * (1.f + sc[i].z) + sh[i].z; oo[i][3] = (v[q][i].w * rs * gn[i].w) * (1.f + sc[i].w) + sh[i].w;
                amax = fmaxf(fmaxf(amax, fmaxf(fabsf(oo[i][0]), fabsf(oo[i][1]))), fmaxf(fabsf(oo[i][2]), fabsf(oo[i][3]))); }
#pragma unroll
            for (int o_ = 1; o_ < 64; o_ <<= 1) amax = fmaxf(amax, __shfl_xor(amax, o_));
            amax = fmaxf(amax, 1e-20f);
            const float qs = 127.f / amax;
#pragma unroll
            for (int i = 0; i < 4; ++i) { const int q0 = (int)rintf(oo[i][0] * qs), q1 = (int)rintf(oo[i][1] * qs), q2 = (int)rintf(oo[i][2] * qs), q3 = (int)rintf(oo[i][3] * qs);
                *(int*)(a.h8 + (size_t)(row0 + q) * 1024 + i * 256 + lane * 4) = (int)((unsigned)(q0 & 255) | ((unsigned)(q1 & 255) << 8) | ((unsigned)(q2 & 255) << 16) | ((unsigned)q3 << 24)); }
            if (lane == 0) a.i8s[row0 + q] = amax * (1.f / 127.f);
        } else
#pragma unroll
        for (int i = 0; i < 4; ++i) { float o[4];
            o[0] = (v[q][i].x * rs * gn[i].x) * (1.f + sc[i].x) + sh[i].x; o[1] = (v[q][i].y * rs * gn[i].y) * (1.f + sc[i].y) + sh[i].y;
            o[2] = (v[q][i].z * rs * gn[i].z) * (1.f + sc[i].z) + sh[i].z; o[3] = (v[q][i].w * rs * gn[i].w) * (1.f + sc[i].w) + sh[i].w;
            if (a.h8) { int w8 = 0; w8 = __builtin_amdgcn_cvt_pk_fp8_f32(f8clamp(o[0] * F8_SH), f8clamp(o[1] * F8_SH), w8, false); w8 = __builtin_amdgcn_cvt_pk_fp8_f32(f8clamp(o[2] * F8_SH), f8clamp(o[3] * F8_SH), w8, true);
                *(int*)(a.h8 + (size_t)(row0 + q) * 1024 + i * 256 + lane * 4) = w8; }
            if (!a.h8 || a.both) { uint2 pk; pk.x = (unsigned)f2bf(o[0]) | ((unsigned)f2bf(o[1]) << 16); pk.y = (unsigned)f2bf(o[2]) | ((unsigned)f2bf(o[3]) << 16);
            *(uint2*)(H + (size_t)(row0 + q) * 1024 + i * 256 + lane * 4) = pk; } }
    }
}
__device__ __forceinline__ void norm_help(const P& p, const NormArgs& a, unsigned* cnt, unsigned need, unsigned* claim, int npanels, LAS unsigned* lw) {
    int tid_ = threadIdx.x; asm volatile("" : "+v"(tid_));
    const int wave = __builtin_amdgcn_readfirstlane(tid_ >> 6), lane = tid_ & 63;
    for (;;) {
        __syncthreads();
        if (threadIdx.x == 0) {
            const unsigned part = __hip_atomic_fetch_add(claim, 1u, __ATOMIC_RELAXED, __HIP_MEMORY_SCOPE_AGENT);
            if (part < (unsigned)npanels * 4u) {
                unsigned sp = 0;
                while (__hip_atomic_load(cnt + 64 * (part >> 2), __ATOMIC_RELAXED, __HIP_MEMORY_SCOPE_AGENT) < need) { __builtin_amdgcn_s_sleep(8); if (++sp > (1u << 22)) break; }
                __builtin_amdgcn_fence(__ATOMIC_ACQUIRE, "agent");
                asm volatile("s_waitcnt vmcnt(0)" ::: "memory");
            }
            lw[0] = part;
        }
        __syncthreads();
        const unsigned part = lw[0];
        if (part >= (unsigned)npanels * 4u) break;
        const int base = (int)(part >> 2) * 256 + (int)(part & 3u) * 64 + wave * 8;
        norm_rows4(p, a, base, lane); norm_rows4(p, a, base + 4, lane);
    }
}
__device__ __forceinline__ void ph_norm(const P& p, int layer, int which, int nrows, bool router, bool from_input, const bf16_t* resY, int res_layer, int res_goff, int ctx_ways, unsigned char* h8, bool both, float* i8s = nullptr) {
    int tid_ = threadIdx.x; asm volatile("" : "+v"(tid_));
    const int wave = tid_ >> 6, lane = tid_ & 63;
    const NormArgs a{layer, which, router, from_input, resY, res_layer, res_goff, ctx_ways, h8, both, i8s};
    for (int row = blockIdx.x * 8 + wave; row < nrows; row += gridDim.x * 8) norm_row(p, a, row, lane);
}

__host__ __device__ __forceinline__ int win_col(int n) {
    if (n < 352) return n;
    if (n < 992) { const int d = (n - 352) & 63, e = d & 31; return n - d + (d & 32) + (e < 16 ? 2 * e : 2 * (e - 16) + 1); }
    if (n < 1120) return n;
    if (n < 1632) { const int d = (n - 1120) & 63; return PJ_RQ + (n - 1120) - d + (d < 32 ? 2 * d : 2 * (d - 32) + 1); }
    return PJ_RQ + (n - 1120);
}
struct ConvJob { const float* src; bf16_t* dst; int K, N, map, f8; const unsigned* cmax = nullptr; float* cs = nullptr; };
__device__ __forceinline__ void conv_tiles4(const ConvJob& j, int tile, int step, int ntl, float* T  ) {
    int tid_ = threadIdx.x; asm volatile("" : "+v"(tid_));
    const int ntn = (j.N + 63) >> 6, t = tid_;
    float4 v[4][2];
#pragma unroll
    for (int q = 0; q < 4; ++q) { const int tl = tile + q * step, tk = tl / ntn, tn = tl % ntn;
#pragma unroll
        for (int i = 0; i < 2; ++i) { const int kr = (t >> 4) + 32 * i, c4 = (t & 15) * 4, n = tn * 64 + c4;
            v[q][i] = make_float4(0.f, 0.f, 0.f, 0.f);
            if (tl < ntl && n < j.N) v[q][i] = *(const float4*)(j.src + (size_t)(tk * 64 + kr) * j.N + n); } }
    __syncthreads();
#pragma unroll
    for (int q = 0; q < 4; ++q)
#pragma unroll
        for (int i = 0; i < 2; ++i) { const int kr = (t >> 4) + 32 * i, c4 = (t & 15) * 4; float* Tq = T + q * (64 * 65);
            Tq[kr * 65 + c4 + 0] = v[q][i].x; Tq[kr * 65 + c4 + 1] = v[q][i].y; Tq[kr * 65 + c4 + 2] = v[q][i].z; Tq[kr * 65 + c4 + 3] = v[q][i].w; }
    __syncthreads();
#pragma unroll
    for (int q = 0; q < 4; ++q) { const int tl = tile + q * step, tk = tl / ntn, tn = tl % ntn; const float* Tq = T + q * (64 * 65);
        const int nl = t >> 3, ks = (t & 7) * 8, n = tn * 64 + nl;
        if (tl < ntl && n < j.N) {
            int nd = j.map == 0 ? n : ((n >> 7) * 256 + (n & 127) + (j.map == 2 ? 128 : 0)); bool f8 = j.f8 != 0;
            if (j.map == 3) {
                nd = win_col(n);
                f8 = nd < PJ_F8 && !j.cmax; }
            if (j.cmax) {
                const float am = fmaxf(__uint_as_float(j.cmax[nd]), 1e-30f), qs = 127.f / am;
                int q[8];
#pragma unroll
                for (int i = 0; i < 8; ++i) q[i] = (int)rintf(Tq[(ks + i) * 65 + nl] * qs) & 255;
                *(uint2*)((unsigned char*)j.dst + (size_t)nd * j.K + tk * 64 + ks) = make_uint2((unsigned)(q[0] | (q[1] << 8) | (q[2] << 16) | (q[3] << 24)), (unsigned)(q[4] | (q[5] << 8) | (q[6] << 16) | (q[7] << 24)));
                if (tk == 0 && ks == 0) j.cs[nd] = am * (1.f / 127.f);
            } else if (f8) {
                int w0 = 0, w1 = 0;
                w0 = __builtin_amdgcn_cvt_pk_fp8_f32(f8clamp(Tq[(ks + 0) * 65 + nl] * F8_SW), f8clamp(Tq[(ks + 1) * 65 + nl] * F8_SW), w0, false);
                w0 = __builtin_amdgcn_cvt_pk_fp8_f32(f8clamp(Tq[(ks + 2) * 65 + nl] * F8_SW), f8clamp(Tq[(ks + 3) * 65 + nl] * F8_SW), w0, true);
                w1 = __builtin_amdgcn_cvt_pk_fp8_f32(f8clamp(Tq[(ks + 4) * 65 + nl] * F8_SW), f8clamp(Tq[(ks + 5) * 65 + nl] * F8_SW), w1, false);
                w1 = __builtin_amdgcn_cvt_pk_fp8_f32(f8clamp(Tq[(ks + 6) * 65 + nl] * F8_SW), f8clamp(Tq[(ks + 7) * 65 + nl] * F8_SW), w1, true);
                *(uint2*)((unsigned char*)j.dst + (size_t)nd * j.K + tk * 64 + ks) = make_uint2((unsigned)w0, (unsigned)w1);
            } else {
            unsigned w[4];
#pragma unroll
            for (int i = 0; i < 4; ++i) w[i] = (unsigned)f2bf(Tq[(ks + 2 * i) * 65 + nl]) | ((unsigned)f2bf(Tq[(ks + 2 * i + 1) * 65 + nl]) << 16);
            *(uint4*)(j.dst + (size_t)nd * j.K + tk * 64 + ks) = make_uint4(w[0], w[1], w[2], w[3]);
            }
        } }
}
__device__ __forceinline__ int conv_ntiles(int K, int N) { return (K >> 6) * ((N + 63) >> 6); }

#define CONV_F8 0
__device__ __forceinline__ void ph_conv_early(const P& p, float* lds) {
    const int G = gridDim.x, bid = blockIdx.x;
    int base = 0;
#define CONV_RUN(SRC, DST, K_, N_, MAP_) do { ConvJob j{SRC, DST, K_, N_, MAP_, CONV_F8}; const int nt_ = conv_ntiles(K_, N_), ns_ = (nt_ + 3) >> 2; \
          \
        for (int u = (((bid - base % G) + G) % G); u < ns_; u += G) conv_tiles4(j, 4 * u, 1, nt_, lds); base += ns_; } while (0)
    for (int l = 0; l < 2; ++l) {
        CONV_RUN(p.in[16] + (size_t)l * 1024 * 1024, (bf16_t*)(p.ws + OFF_WOUT) + (size_t)l * 1024 * 1024, 1024, 1024, 0);
        CONV_RUN(p.in[10] + (size_t)l * 192 * 384, (bf16_t*)(p.ws + OFF_WUQ) + (size_t)l * 384 * 192, 192, 384, 0);
        CONV_RUN(p.in[12] + (size_t)l * 128 * 512, (bf16_t*)(p.ws + OFF_WUKV) + (size_t)l * 512 * 128, 128, 512, 0);
    }
#undef CONV_F8
#define CONV_F8 1
    CONV_RUN(p.in[19], (bf16_t*)(p.ws + OFF_FD), D_FF, 1024, 0);
    for (int l = 0; l < 2; ++l) {
        uint4* z = (uint4*)((unsigned char*)((bf16_t*)(p.ws + OFF_WIN) + (size_t)l * PROJ_LD * 1024) + (size_t)1120 * 1024);
        const int n16 = (PJ_F8 - 1120) * 1024 / 16;
        for (int i = bid * NT + threadIdx.x; i < n16; i += G * NT) z[i] = make_uint4(0u, 0u, 0u, 0u);
    }
}
#undef CONV_F8
#define CONV_F8 1
__device__ __forceinline__ void ph_fgu_colmax(const P& p) {
    const int G = gridDim.x, bid = blockIdx.x;
    unsigned* cmax = (unsigned*)(p.ws + OFF_CMAX);
    for (int u = bid; u < 2 * 8 * 6; u += G) {
        const int mat = u / 48, kc = (u % 48) / 6, nc = u % 6, n = nc * 512 + (int)threadIdx.x;
        if (n < D_FF) { const float* s = (mat ? p.in[18] : p.in[17]) + (size_t)(kc * 128) * D_FF + n; unsigned am = 0u;
            for (int k0 = 0; k0 < 128; k0 += 16) { float vv[16];
#pragma unroll
                for (int j = 0; j < 16; ++j) vv[j] = s[(size_t)(k0 + j) * D_FF];
#pragma unroll
                for (int j = 0; j < 16; ++j) { const unsigned b_ = __float_as_uint(vv[j]) & 0x7FFFFFFFu; am = am > b_ ? am : b_; } }
            atomicMax(cmax + ((n >> 7) * 256 + (n & 127) + (mat ? 128 : 0)), am); }
    }
}
__device__ __forceinline__ void ph_win_colmax(const P& p) {
    const int G = gridDim.x, bid = blockIdx.x;
    for (int u = G - 1 - bid; u < 2 * 8 * 5; u += G) {
        const int l = u / 40, kc = (u % 40) / 5, nc = u % 5, n = nc * 512 + (int)threadIdx.x;
        if (n < IN_DIM) { const float* s = p.in[8] + (size_t)l * 1024 * IN_DIM + (size_t)(kc * 128) * IN_DIM + n; unsigned am = 0u;
            for (int k0 = 0; k0 < 128; k0 += 16) { float vv[16];
#pragma unroll
                for (int j = 0; j < 16; ++j) vv[j] = s[(size_t)(k0 + j) * IN_DIM];
#pragma unroll
                for (int j = 0; j < 16; ++j) { const unsigned b_ = __float_as_uint(vv[j]) & 0x7FFFFFFFu; am = am > b_ ? am : b_; } }
            atomicMax((unsigned*)(p.ws + OFF_CMAXW) + l * PROJ_LD + win_col(n), am); }
    }
}
__device__ __forceinline__ void ph_conv_fgu_i8(const P& p, float* lds) {
    const int G = gridDim.x, bid = blockIdx.x;
    int base = 0;
#define CONV_RUN_I8(SRC, MAP_) do { ConvJob j{SRC, (bf16_t*)(p.ws + OFF_FGU), 1024, D_FF, MAP_, 0, (const unsigned*)(p.ws + OFF_CMAX), (float*)(p.ws + OFF_CS8)}; const int nt_ = conv_ntiles(1024, D_FF), ns_ = (nt_ + 3) >> 2; \
        for (int u = (((bid - base % G) + G) % G); u < ns_; u += G) conv_tiles4(j, 4 * u, 1, nt_, lds); base += ns_; } while (0)
    CONV_RUN_I8(p.in[17], 1);
    CONV_RUN_I8(p.in[18], 2);
#undef CONV_RUN_I8
    for (int l = 0; l < 2; ++l) {
        ConvJob j{p.in[8] + (size_t)l * 1024 * IN_DIM, (bf16_t*)(p.ws + OFF_WIN) + (size_t)l * PROJ_LD * 1024, 1024, IN_DIM, 3, 0, (const unsigned*)(p.ws + OFF_CMAXW) + l * PROJ_LD, (float*)(p.ws + OFF_CSW) + l * PROJ_LD};
        const int nt_ = conv_ntiles(1024, IN_DIM), ns_ = (nt_ + 3) >> 2;
        for (int u = (((bid - base % G) + G) % G); u < ns_; u += G) conv_tiles4(j, 4 * u, 1, nt_, lds); base += ns_; }
}
__device__ __forceinline__ void ph_conv_late(const P& p, float* lds) {
    const int G = gridDim.x, bid = blockIdx.x;
    int base = 0;
    for (int e = 0; e < NEXP; ++e) {
        CONV_RUN(p.in[21] + (size_t)e * 1024 * D_FFE, (bf16_t*)(p.ws + OFF_MGU + (size_t)e * 2 * D_FFE * 1024), 1024, D_FFE, 1);
        CONV_RUN(p.in[22] + (size_t)e * 1024 * D_FFE, (bf16_t*)(p.ws + OFF_MGU + (size_t)e * 2 * D_FFE * 1024), 1024, D_FFE, 2);
        CONV_RUN(p.in[23] + (size_t)e * D_FFE * 1024, (bf16_t*)(p.ws + OFF_MD + (size_t)e * 1024 * D_FFE), D_FFE, 1024, 0);
    }
}

namespace pg8 {
#define PG8_LAS __attribute__((address_space(3)))
typedef short bf16x8 __attribute__((ext_vector_type(8)));
typedef float f32x4 __attribute__((ext_vector_type(4)));
typedef unsigned u32x4 __attribute__((ext_vector_type(4)));
typedef int i32x4v __attribute__((ext_vector_type(4)));
constexpr int BM = 256, BK = 64, HALF = 128, HTB = HALF * BK * 2, STAGE_BYTES = 8 * HTB, NXCD = 8, WGM = 8;

__host__ __device__ __forceinline__ int lds_byte(int r, int c) { const int st = (r >> 4) * 2 + (c >> 5), rr = r & 15, cc = c & 31, ob = rr * 64 + cc * 2; return st * 1024 + (ob ^ (((ob >> 9) & 1) << 5)); }
__host__ __device__ __forceinline__ void stage_rc(int b, int& R, int& C) { const int st = b / 1024, sb = b % 1024, swz = sb ^ (((sb >> 9) & 1) << 5); R = (st >> 1) * 16 + swz / 64; C = (st & 1) * 32 + (swz % 64) / 2; }
__host__ __device__ __forceinline__ int perm32(int rho) { const int n = rho >> 4, i = rho & 15; return 8 * (i >> 2) + 4 * n + (i & 3); }

struct Unit { int pm, pn, e, rl, kp, ri; };

__device__ __forceinline__ void static_order_L(int L, int nM, int nN, int& pm, int& pn) {
    const int nwg = nM * nN;
    int wgid = L; { const int q = nwg / NXCD, r = nwg % NXCD, xcd = wgid % NXCD, off = wgid / NXCD; wgid = (xcd < r ? xcd * (q + 1) : r * (q + 1) + (xcd - r) * q) + off; }
    const int nig = WGM * nN, gid = wgid / nig, fm = gid * WGM, gsz = (nM - fm) < WGM ? (nM - fm) : WGM;
    pm = fm + ((wgid % nig) % gsz); pn = (wgid % nig) / gsz;
}
__device__ __forceinline__ bool static_order(int i, int G, int c, int nM, int nN, int& pm, int& pn) {
    const int nwg = nM * nN; const long L = (long)i * G + c; if (L >= nwg) return false;
    static_order_L((int)L, nM, nN, pm, pn); return true;
}

template <bool FP8_, bool I8_ = false> struct DenseSchedT {
    static constexpr bool GATHER = false, FP8 = FP8_, I8 = I8_;
    const bf16_t* A; const bf16_t* Bt; int lda, K, nM, nN, G, c; int L0 = 0, Lend = 1 << 30;
    __device__ __forceinline__ int nt() const { return K / BK; }
    __device__ __forceinline__ bool next(int i, Unit& u) const { u.e = 0; u.kp = 0; u.ri = 0; const long L = L0 + (long)i * G + c; const int nwg = nM * nN;
        if (L >= nwg || L >= Lend) return false; static_order_L((int)L, nM, nN, u.pm, u.pn); u.rl = u.pm; return true; }
    __device__ __forceinline__ const char* a_base(const Unit& u) const { return (const char*)A + (size_t)u.pm * BM * lda * 2; }
    __device__ __forceinline__ const char* b_base(const Unit& u) const { return (const char*)Bt + (size_t)u.pn * BM * K * 2; }
    __device__ __forceinline__ unsigned a_off(const Unit&, int r, int C) const { return (unsigned)(r * lda + C) * 2u; }
};
typedef DenseSchedT<false> DenseSched;
struct DenseSplitSched {
    static constexpr bool GATHER = false;
    const bf16_t* A; const bf16_t* Bt; int lda, K, pm0, nMs, nN, ways, ntp, G, c;
    __device__ __forceinline__ int nt() const { return ntp; }
    __device__ __forceinline__ bool next(int i, Unit& u) const {
        const long j = (long)i * G + c; if (j >= (long)nMs * nN * ways) return false;
        const int ui = (int)(j / ways); u.kp = (int)(j % ways) * ntp; u.ri = (int)j; u.pm = pm0 + ui / nN; u.pn = ui % nN; u.e = 0; u.rl = u.pm; return true;
    }
    __device__ __forceinline__ const char* a_base(const Unit& u) const { return (const char*)A + (size_t)u.pm * BM * lda * 2 + (size_t)u.kp * (BK * 2); }
    __device__ __forceinline__ const char* b_base(const Unit& u) const { return (const char*)Bt + (size_t)u.pn * BM * K * 2 + (size_t)u.kp * (BK * 2); }
    __device__ __forceinline__ unsigned a_off(const Unit&, int r, int C) const { return (unsigned)(r * lda + C) * 2u; }
};
template <bool GATHER_, bool FP8_ = false> struct MoeSched {
    static constexpr bool GATHER = GATHER_, FP8 = FP8_;
    const bf16_t* A; const bf16_t* Bt; int lda, K, nN, G, c; size_t bstride;
    const int* list;
    const PG8_LAS int* tab;
    int ulo, uhi, ways, ntp;
    __device__ __forceinline__ int nt() const { return ntp; }
    __device__ __forceinline__ bool next(int i, Unit& u) const {
        const int nM = __builtin_amdgcn_readfirstlane(tab[16]);
        const long j = (long)i * G + c; const int L = ulo + (int)(j / ways);
        if (L >= uhi) return false;
        u.kp = (int)(j % ways) * ntp; u.ri = (int)j;
        static_order_L(L, nM, nN, u.pm, u.pn);
        int e = 0, t0 = 0;
#pragma unroll
        for (int k = 1; k < 8; ++k) { const int tk = tab[8 + k]; if (u.pm >= tk) { e = k; t0 = tk; } }
        u.e = __builtin_amdgcn_readfirstlane(e); u.rl = u.pm - __builtin_amdgcn_readfirstlane(t0); return true;
    }
    __device__ __forceinline__ const char* a_base(const Unit& u) const { return (GATHER ? (const char*)A : (const char*)A + (size_t)u.pm * BM * lda * 2) + (size_t)u.kp * (BK * 2); }
    __device__ __forceinline__ const char* b_base(const Unit& u) const { return (const char*)(Bt + (size_t)u.e * bstride) + (size_t)u.pn * BM * K * 2 + (size_t)u.kp * (BK * 2); }
    __device__ __forceinline__ unsigned a_off(const Unit& u, int r, int C) const {
        if (!GATHER) return (unsigned)(r * lda + C) * 2u;
        const int lr = u.rl * BM + r, c1 = tab[u.e] - 1;
        const int tok = list[(size_t)u.e * 32768 + (lr < c1 ? lr : c1)];
        return (unsigned)(tok * lda + C) * 2u;
    }
    __device__ __forceinline__ int a_tok(const Unit& u, int r) const { if (!GATHER) return 0; const int lr = u.rl * BM + r, c1 = tab[u.e] - 1;
        const int* ptr = list + (size_t)u.e * 32768 + (lr < c1 ? lr : c1); int tok;
        asm volatile("global_load_dword %0, %1, off" : "=v"(tok) : "v"(ptr) : "memory"); return tok; }
    __device__ __forceinline__ unsigned a_fin(int tok, int C) const { return (unsigned)(tok * lda + C) * 2u; }
};

__device__ __forceinline__ unsigned pk2(float lo, float hi) { typedef float f32x2_t __attribute__((ext_vector_type(2))); typedef __bf16 bf16x2_t __attribute__((ext_vector_type(2)));
    f32x2_t v = {lo, hi}; bf16x2_t b = __builtin_convertvector(v, bf16x2_t); return __builtin_bit_cast(unsigned, b); }

struct EpiBf16 {
    static constexpr bool PERM = true;
    bf16_t* O; int ldc;
    __device__ __forceinline__ void operator()(const f32x4 (&acc)[2][2][4][2], const Unit& u, int wr, int wc, int fr, int fq) const {
        const int row0 = u.pm * BM + wr * 64 + fr, col0 = u.pn * BM + wc * 32 + 8 * fq;
#pragma unroll
        for (int ai = 0; ai < 2; ++ai)
#pragma unroll
            for (int m = 0; m < 4; ++m) { bf16_t* rowp = O + (size_t)(row0 + ai * HALF + m * 16) * ldc + col0;
#pragma unroll
                for (int bj = 0; bj < 2; ++bj) { const f32x4 v0 = acc[ai][bj][m][0], v1 = acc[ai][bj][m][1];
                    u32x4 w; w[0] = pk2(v0[0], v0[1]); w[1] = pk2(v0[2], v0[3]); w[2] = pk2(v1[0], v1[1]); w[3] = pk2(v1[2], v1[3]);
                    *(u32x4*)(rowp + bj * HALF) = w; } }
    }
};
struct EpiBf16Norm {
    static constexpr bool PERM = true, HAS_POST = true;
    bf16_t* O; int ldc; unsigned obytes; unsigned* cnt; float sc;
    __device__ __forceinline__ void operator()(const f32x4 (&acc)[2][2][4][2], const Unit& u, int wr, int wc, int fr, int fq) const {
        const auto rsrc = __builtin_amdgcn_make_buffer_rsrc((void*)O, 0, (int)obytes, 0x00020000);
        const int row0 = u.pm * BM + wr * 64 + fr, col0 = u.pn * BM + wc * 32 + 8 * fq;
#pragma unroll
        for (int ai = 0; ai < 2; ++ai)
#pragma unroll
            for (int m = 0; m < 4; ++m) { const unsigned ro = (unsigned)((row0 + ai * HALF + m * 16) * ldc + col0) * 2u;
#pragma unroll
                for (int bj = 0; bj < 2; ++bj) { const f32x4 v0 = acc[ai][bj][m][0] * sc, v1 = acc[ai][bj][m][1] * sc;
                    u32x4 w; w[0] = pk2(v0[0], v0[1]); w[1] = pk2(v0[2], v0[3]); w[2] = pk2(v1[0], v1[1]); w[3] = pk2(v1[2], v1[3]);
                    __builtin_amdgcn_raw_buffer_store_b128(w, rsrc, ro + bj * HALF * 2, 0, 16); } }
    }
    __device__ __forceinline__ void post(const Unit& u) const {
        asm volatile("s_waitcnt vmcnt(0)" ::: "memory");
        if ((threadIdx.x & 63) == 0) __hip_atomic_fetch_add(cnt + 64 * u.pm, 1u, __ATOMIC_RELAXED, __HIP_MEMORY_SCOPE_AGENT);
    }
};
template <bool F8IN, bool F8> struct EpiSwigluT {
    static constexpr bool PERM = true;
    bf16_t* O; int ldc;
    __device__ __forceinline__ void operator()(const f32x4 (&acc)[2][2][4][2], const Unit& u, int wr, int wc, int fr, int fq) const {
        const int row0 = u.pm * BM + wr * 64 + fr, col0 = u.pn * HALF + wc * 32 + 8 * fq;
#pragma unroll
        for (int ai = 0; ai < 2; ++ai)
#pragma unroll
            for (int m = 0; m < 4; ++m) { bf16_t* rowp = O + (size_t)(row0 + ai * HALF + m * 16) * ldc + col0;
                float o[8];
                typedef float f32x2_t __attribute__((ext_vector_type(2)));
#pragma unroll
                for (int n = 0; n < 2; ++n)
#pragma unroll
                    for (int j = 0; j < 4; j += 2) {
                        f32x2_t gg = {acc[ai][0][m][n][j], acc[ai][0][m][n][j + 1]}, uu = {acc[ai][1][m][n][j], acc[ai][1][m][n][j + 1]};
                        if constexpr (F8IN && F8) {
                            constexpr float S_ = F8_SH * F8_SW, IC_ = S_ * S_ / F8_SA;
                            const f32x2_t t = gg * (-1.4426950408889634f / S_); f32x2_t e;
                            e[0] = __builtin_amdgcn_exp2f(t[0]); e[1] = __builtin_amdgcn_exp2f(t[1]);
                            e = e * IC_ + IC_; f32x2_t r; r[0] = __builtin_amdgcn_rcpf(e[0]); r[1] = __builtin_amdgcn_rcpf(e[1]);
                            const f32x2_t v = (gg * uu) * r; o[n * 4 + j] = v[0]; o[n * 4 + j + 1] = v[1]; continue; }
                        if constexpr (F8IN) { gg = gg * (1.f / (F8_SH * F8_SW)); uu = uu * ((F8 ? F8_SA : 1.f) / (F8_SH * F8_SW)); } else if constexpr (F8) uu = uu * F8_SA;
                        const f32x2_t t = gg * (-1.4426950408889634f); f32x2_t e;
                        e[0] = __builtin_amdgcn_exp2f(t[0]); e[1] = __builtin_amdgcn_exp2f(t[1]);
                        e = e + 1.0f; f32x2_t r; r[0] = __builtin_amdgcn_rcpf(e[0]); r[1] = __builtin_amdgcn_rcpf(e[1]);
                        const f32x2_t v = (gg * uu) * r; o[n * 4 + j] = v[0]; o[n * 4 + j + 1] = v[1]; }
                if constexpr (F8) { int w0 = 0, w1 = 0;
#define F8C_(x) __builtin_amdgcn_fmed3f((x), -448.f, 448.f)
                    w0 = __builtin_amdgcn_cvt_pk_fp8_f32(F8C_(o[0]), F8C_(o[1]), w0, false); w0 = __builtin_amdgcn_cvt_pk_fp8_f32(F8C_(o[2]), F8C_(o[3]), w0, true);
                    w1 = __builtin_amdgcn_cvt_pk_fp8_f32(F8C_(o[4]), F8C_(o[5]), w1, false); w1 = __builtin_amdgcn_cvt_pk_fp8_f32(F8C_(o[6]), F8C_(o[7]), w1, true);
#undef F8C_
                    typedef unsigned u32x2v __attribute__((ext_vector_type(2))); u32x2v w = {(unsigned)w0, (unsigned)w1};
                    *(u32x2v*)((unsigned char*)O + (size_t)(row0 + ai * HALF + m * 16) * ldc + col0) = w; }
                else { u32x4 w; w[0] = pk2(o[0], o[1]); w[1] = pk2(o[2], o[3]); w[2] = pk2(o[4], o[5]); w[3] = pk2(o[6], o[7]);
                *(u32x4*)rowp = w; } }
    }
};
typedef EpiSwigluT<false, false> EpiSwiglu;
struct EpiSwigluI8 {
    static constexpr bool PERM = true;
    bf16_t* O; int ldc; const float* rsc; const float* csc;
    __device__ __forceinline__ void operator()(const f32x4 (&acc)[2][2][4][2], const Unit& u, int wr, int wc, int fr, int fq) const {
        const int row0 = u.pm * BM + wr * 64 + fr, col0 = u.pn * HALF + wc * 32 + 8 * fq;
        const float* cg = csc + u.pn * BM + wc * 32 + 8 * fq;
        const f32x4 cg0 = *(const f32x4*)cg, cg1 = *(const f32x4*)(cg + 4), cu0 = *(const f32x4*)(cg + HALF), cu1 = *(const f32x4*)(cg + HALF + 4);
        float cgl[8], cgu[8];
#pragma unroll
        for (int j = 0; j < 4; ++j) { cgl[j] = cg0[j] * -1.4426950408889634f; cgl[4 + j] = cg1[j] * -1.4426950408889634f; cgu[j] = cg0[j] * cu0[j] * F8_SA; cgu[4 + j] = cg1[j] * cu1[j] * F8_SA; }
        float rs8[8];
#pragma unroll
        for (int i = 0; i < 8; ++i) rs8[i] = rsc[row0 + (i >> 2) * HALF + (i & 3) * 16];
#pragma unroll
        for (int ai = 0; ai < 2; ++ai)
#pragma unroll
            for (int m = 0; m < 4; ++m) { const int row = row0 + ai * HALF + m * 16; const float rsv = rs8[ai * 4 + m];
                float o[8];
                const float rsv2 = rsv * rsv;
#pragma unroll
                for (int n = 0; n < 2; ++n)
#pragma unroll
                    for (int j = 0; j < 4; ++j) {
                        const float gf = (float)__float_as_int(acc[ai][0][m][n][j]), uf = (float)__float_as_int(acc[ai][1][m][n][j]);
                        const float e = __builtin_amdgcn_exp2f(gf * (rsv * cgl[n * 4 + j])) + 1.0f;
                        o[n * 4 + j] = (gf * uf) * ((rsv2 * cgu[n * 4 + j]) * __builtin_amdgcn_rcpf(e)); }
                int w0 = 0, w1 = 0;
#define F8C_(x) __builtin_amdgcn_fmed3f((x), -448.f, 448.f)
                w0 = __builtin_amdgcn_cvt_pk_fp8_f32(F8C_(o[0]), F8C_(o[1]), w0, false); w0 = __builtin_amdgcn_cvt_pk_fp8_f32(F8C_(o[2]), F8C_(o[3]), w0, true);
                w1 = __builtin_amdgcn_cvt_pk_fp8_f32(F8C_(o[4]), F8C_(o[5]), w1, false); w1 = __builtin_amdgcn_cvt_pk_fp8_f32(F8C_(o[6]), F8C_(o[7]), w1, true);
#undef F8C_
                typedef unsigned u32x2v __attribute__((ext_vector_type(2))); u32x2v w = {(unsigned)w0, (unsigned)w1};
                *(u32x2v*)((unsigned char*)O + (size_t)row * ldc + col0) = w; }
    }
};
struct EpiRes {
    static constexpr bool PERM = false;
    const float* in_lat; const float* in_ctx; float* out_lat; float* out_ctx; const float* modl; int goff;
    __device__ __forceinline__ void operator()(const f32x4 (&acc)[2][2][4][2], const Unit& u, int wr, int wc, int fr, int fq) const {
        const bool lat = u.pm < T_LAT / BM; const int r = lat ? (u.pm >> 4) : 8;
        const size_t rbase = (size_t)(lat ? u.pm : u.pm - T_LAT / BM) * BM + wr * 64 + fr;
        const float* src = (lat ? in_lat : in_ctx); float* dst = (lat ? out_lat : out_ctx);
        const int col0 = u.pn * BM + wc * 32 + 4 * fq;
        f32x4 gv[2][2];
#pragma unroll
        for (int bj = 0; bj < 2; ++bj)
#pragma unroll
            for (int n = 0; n < 2; ++n) gv[bj][n] = *(const f32x4*)(modl + r * 6144 + goff + col0 + bj * HALF + n * 16);
#pragma unroll
        for (int ai = 0; ai < 2; ++ai)
#pragma unroll
            for (int m = 0; m < 4; ++m) { const size_t ro = (rbase + ai * HALF + m * 16) * 1024 + col0;
#pragma unroll
                for (int bj = 0; bj < 2; ++bj)
#pragma unroll
                    for (int n = 0; n < 2; ++n) { const f32x4 x = *(const f32x4*)(src + ro + bj * HALF + n * 16);
                        *(f32x4*)(dst + ro + bj * HALF + n * 16) = x + gv[bj][n] * acc[ai][bj][m][n]; } }
    }
};
struct EpiBf16I8 {
    static constexpr bool PERM = true;
    bf16_t* O; int ldc; const float* rsc; const float* csc;
    __device__ __forceinline__ void operator()(const f32x4 (&acc)[2][2][4][2], const Unit& u, int wr, int wc, int fr, int fq) const {
        const int row0 = u.pm * BM + wr * 64 + fr, col0 = u.pn * BM + wc * 32 + 8 * fq;
        f32x4 cs[2][2];
#pragma unroll
        for (int bj = 0; bj < 2; ++bj) { cs[bj][0] = *(const f32x4*)(csc + col0 + bj * HALF); cs[bj][1] = *(const f32x4*)(csc + col0 + bj * HALF + 4); }
        float rs8[8];
#pragma unroll
        for (int i = 0; i < 8; ++i) rs8[i] = rsc[row0 + (i >> 2) * HALF + (i & 3) * 16];
#pragma unroll
        for (int ai = 0; ai < 2; ++ai)
#pragma unroll
            for (int m = 0; m < 4; ++m) { bf16_t* rowp = O + (size_t)(row0 + ai * HALF + m * 16) * ldc + col0; const float rsv = rs8[ai * 4 + m];
#pragma unroll
                for (int bj = 0; bj < 2; ++bj) { float o[8];
#pragma unroll
                    for (int n = 0; n < 2; ++n)
#pragma unroll
                        for (int j = 0; j < 4; ++j) o[n * 4 + j] = (float)__float_as_int(acc[ai][bj][m][n][j]) * (rsv * cs[bj][n][j]);
                    u32x4 w; w[0] = pk2(o[0], o[1]); w[1] = pk2(o[2], o[3]); w[2] = pk2(o[4], o[5]); w[3] = pk2(o[6], o[7]);
                    *(u32x4*)(rowp + bj * HALF) = w; } }
    }
};
struct EpiWinRope {
    static constexpr bool PERM = true;
    bf16_t* PROJp; bf16_t* POSTp; const float* rsc; const float* csc; const float2* tab_ret; const float2* tab32;
    __device__ __forceinline__ void operator()(const f32x4 (&acc)[2][2][4][2], const Unit& u, int wr, int wc, int fr, int fq) const {
        const int row0 = u.pm * BM + wr * 64 + fr, col0 = u.pn * BM + wc * 32 + 8 * fq;
        float rs8[8];
#pragma unroll
        for (int i = 0; i < 8; ++i) rs8[i] = rsc[row0 + (i >> 2) * HALF + (i & 3) * 16];
#pragma unroll
        for (int bj = 0; bj < 2; ++bj) {
            const int c = col0 + bj * HALF;
            const f32x4 cs0 = *(const f32x4*)(csc + c), cs1 = *(const f32x4*)(csc + c + 4);
            int type = 0, hq = 0, dcol = c; float scl = 1.f;
            if (c >= 352 && c < 864) { type = 1; hq = (c - 352) & 63; dcol = PC_QB + (c - 352); }
            else if (c >= 864 && c < 992) { type = 1; hq = (c - 864) & 63; dcol = PC_KB + (c - 864); }
            else if (c >= PJ_RQ && c < PJ_RK) { type = 2; hq = (c - PJ_RQ) & 63; dcol = PC_RQ + (c - PJ_RQ); }
            else if (c >= PJ_RK && c < PJ_RV) { type = 2; hq = (c - PJ_RK) & 63; dcol = PC_RK + (c - PJ_RK); scl = 0.125f; }
            bf16_t* dbase = type ? POSTp + dcol : PROJp + dcol; const int dld = type ? POST_LD : PROJ_LD;
#pragma unroll
            for (int ai = 0; ai < 2; ++ai)
#pragma unroll
                for (int m = 0; m < 4; ++m) { const int row = row0 + ai * HALF + m * 16; const float rsv = rs8[ai * 4 + m];
                    float o[8];
#pragma unroll
                    for (int n = 0; n < 2; ++n)
#pragma unroll
                        for (int j = 0; j < 4; ++j) o[n * 4 + j] = (float)__float_as_int(acc[ai][bj][m][n][j]) * (rsv * (n ? cs1[j] : cs0[j]));
                    if (type != 0) {
                        if (row < T_LAT) { const int t = row & (SEQ - 1);
                            const float2* tb = type == 1 ? tab32 + ((hq & 32) ? (t & 63) : (t >> 6)) * 16 + ((hq & 31) >> 1) : tab_ret + t * 32 + (hq >> 1);
                            const float4 c0 = *(const float4*)tb, c1 = *(const float4*)(tb + 2);
                            const float cz[4] = {c0.x, c0.z, c1.x, c1.z}, sz[4] = {c0.y, c0.w, c1.y, c1.w};
#pragma unroll
                            for (int i = 0; i < 4; ++i) { const float x1 = o[2 * i], x2 = o[2 * i + 1]; o[2 * i] = x1 * cz[i] - x2 * sz[i]; o[2 * i + 1] = x2 * cz[i] + x1 * sz[i]; } }
#pragma unroll
                        for (int i = 0; i < 8; ++i) o[i] *= scl;
                    }
                    u32x4 w; w[0] = pk2(o[0], o[1]); w[1] = pk2(o[2], o[3]); w[2] = pk2(o[4], o[5]); w[3] = pk2(o[6], o[7]);
                    *(u32x4*)(dbase + (size_t)row * dld) = w; }
        }
    }
};
struct EpiBf16S {
    static constexpr bool PERM = true;
    bf16_t* O; int ldc; float sc;
    __device__ __forceinline__ void operator()(const f32x4 (&acc)[2][2][4][2], const Unit& u, int wr, int wc, int fr, int fq) const {
        const int row0 = u.pm * BM + wr * 64 + fr, col0 = u.pn * BM + wc * 32 + 8 * fq;
#pragma unroll
        for (int ai = 0; ai < 2; ++ai)
#pragma unroll
            for (int m = 0; m < 4; ++m) { bf16_t* rowp = O + (size_t)(row0 + ai * HALF + m * 16) * ldc + col0;
#pragma unroll
                for (int bj = 0; bj < 2; ++bj) { const f32x4 v0 = acc[ai][bj][m][0] * sc, v1 = acc[ai][bj][m][1] * sc;
                    u32x4 w; w[0] = pk2(v0[0], v0[1]); w[1] = pk2(v0[2], v0[3]); w[2] = pk2(v1[0], v1[1]); w[3] = pk2(v1[2], v1[3]);
                    *(u32x4*)(rowp + bj * HALF) = w; } }
    }
};
struct EpiPart {
    static constexpr bool PERM = false;
    float* PART;
    __device__ __forceinline__ void operator()(const f32x4 (&acc)[2][2][4][2], const Unit& u, int wr, int wc, int fr, int fq) const {
        float* tp = PART + (size_t)u.ri * 65536 + (wr * 64 + fr) * 256 + wc * 32 + 4 * fq;
#pragma unroll
        for (int ai = 0; ai < 2; ++ai)
#pragma unroll
            for (int m = 0; m < 4; ++m)
#pragma unroll
                for (int bj = 0; bj < 2; ++bj)
#pragma unroll
                    for (int n = 0; n < 2; ++n) *(f32x4*)(tp + (ai * HALF + m * 16) * 256 + bj * HALF + n * 16) = acc[ai][bj][m][n];
    }
};
__device__ __forceinline__ void moe_combine(bf16_t* YM, const float* PART, const PG8_LAS int* tab, int nN, float sc) {
    const int nTm = __builtin_amdgcn_readfirstlane(tab[16]), G = gridDim.x, U = nTm * nN, rem = U % G;
    if (!(rem > 0 && rem * MOE_WAYS <= G)) return;
    int tid_ = threadIdx.x; asm volatile("" : "+v"(tid_));
    const int umain = U - rem, wave = tid_ >> 6, lane = tid_ & 63;
    for (int task = blockIdx.x * 8 + wave; task < rem * 256; task += G * 8) {
        const int r = task >> 8, i = task & 255; int pm, pn; static_order_L(umain + r, nTm, nN, pm, pn);
        const float* pp = PART + (size_t)(r * MOE_WAYS) * 65536 + i * 256 + lane * 4;
        f32x4 s = *(const f32x4*)pp;
#pragma unroll
        for (int q = 1; q < MOE_WAYS; ++q) s = s + *(const f32x4*)(pp + q * 65536);
        s = s * sc;
        typedef unsigned u32x2v __attribute__((ext_vector_type(2))); u32x2v w = {pk2(s[0], s[1]), pk2(s[2], s[3])};
        *(u32x2v*)(YM + (size_t)(pm * BM + i) * 1024 + pn * BM + lane * 4) = w;
    }
}

template <class T, class = void> struct sched_i8 { static constexpr bool value = false; };
template <class T> struct sched_i8<T, decltype((void)T::I8)> { static constexpr bool value = T::I8; };
template <class T, class = void> struct sched_fp8 { static constexpr bool value = false; };
template <class T> struct sched_fp8<T, decltype((void)T::FP8)> { static constexpr bool value = T::FP8; };
template <class T, class = void> struct epi_has_post { static constexpr bool value = false; };
template <class T> struct epi_has_post<T, decltype((void)T::HAS_POST)> { static constexpr bool value = T::HAS_POST; };
template <class Epi, class Sched>
__device__ __forceinline__ void gemm_phase(PG8_LAS unsigned char* lds, const Sched& S, const Epi& E) {
    int tid_ = threadIdx.x; asm volatile("" : "+v"(tid_));
    const int tid = tid_, wid = __builtin_amdgcn_readfirstlane(tid >> 6), lane = tid & 63, wr = wid >> 2, wc = wid & 3, fr = lane & 15, fq = lane >> 4;
    const int K = S.K, nt = S.nt();
    int RA[2], CA[2]; unsigned voffB;
    { int R, C; stage_rc(tid * 16, R, C); const int Rb = Epi::PERM ? ((R & ~31) + perm32(R & 31)) : R;
      RA[0] = R; CA[0] = C; RA[1] = R + 64; CA[1] = C; voffB = (unsigned)(Rb * K + C) * 2u; }
    const unsigned incB = (unsigned)(64 * K * 2), incA = (unsigned)(64 * S.lda * 2);
    const unsigned kstep = (unsigned)(BK * 2);
    const unsigned hstepB = (unsigned)(HALF * K * 2);
    const auto rsA = __builtin_amdgcn_make_buffer_rsrc((void*)S.A, 0, 0x7fffffff, 0x00020000), rsB = __builtin_amdgcn_make_buffer_rsrc((void*)S.Bt, 0, 0x7fffffff, 0x00020000);
    const unsigned ldsw = (unsigned)wid * 1024u;
    const int aoff = lds_byte(wr * 64 + fr, fq * 8), boff = lds_byte(wc * 32 + fr, fq * 8);
#define PG8_SA(b, h) (((b) * 2 + (h)) * HTB)
#define PG8_SB(b, h) ((4 + (b) * 2 + (h)) * HTB)
  \

#define PG8_STAGE_B(bufoff, soff) do { _Pragma("unroll") for (int _i = 0; _i < 2; ++_i) \
        __builtin_amdgcn_raw_ptr_buffer_load_lds(rsB, (PG8_LAS void*)(lds + (bufoff) + ldsw + _i * 8192), 16, voffB, (soff) + _i * incB, 0, 0); } while (0)
#define PG8_STAGE_A(bufoff, soff, h) do { _Pragma("unroll") for (int _i = 0; _i < 2; ++_i) { \
        if constexpr (Sched::GATHER) __builtin_amdgcn_raw_ptr_buffer_load_lds(rsA, (PG8_LAS void*)(lds + (bufoff) + ldsw + _i * 8192), 16, vA[h][_i], (soff), 0, 0); \
        else __builtin_amdgcn_raw_ptr_buffer_load_lds(rsA, (PG8_LAS void*)(lds + (bufoff) + ldsw + _i * 8192), 16, vA[0][0], (soff) + ((h) * 2 + _i) * incA, 0, 0); } } while (0)
#define PG8_LDA(dst, b, h) do { _Pragma("unroll") for (int m = 0; m < 4; ++m) _Pragma("unroll") for (int k = 0; k < 2; ++k) dst[m][k] = *(const PG8_LAS bf16x8*)(lds + PG8_SA(b, h) + aoff + m * 2048 + k * 1024); } while (0)
#define PG8_LDB(dst, b, h) do { _Pragma("unroll") for (int n = 0; n < 2; ++n) _Pragma("unroll") for (int k = 0; k < 2; ++k) dst[n][k] = *(const PG8_LAS bf16x8*)(lds + PG8_SB(b, h) + boff + n * 2048 + k * 1024); } while (0)
#define PG8_CAT8(x, y) __builtin_shufflevector(__builtin_bit_cast(i32x4v, x), __builtin_bit_cast(i32x4v, y), 0, 1, 2, 3, 4, 5, 6, 7)
#define PG8_MMA(ai, bj, At, Bt) do { __builtin_amdgcn_s_setprio(1); _Pragma("unroll") for (int m = 0; m < 4; ++m) _Pragma("unroll") for (int n = 0; n < 2; ++n) { \
        if constexpr (sched_fp8<Sched>::value)   \
              \
              \
            asm volatile("v_mfma_f32_16x16x128_f8f6f4 %0, %1, %2, %0" : "+v"(acc[ai][bj][m][n]) : "v"(PG8_CAT8(Bt[n][0], Bt[n][1])), "v"(PG8_CAT8(At[m][0], At[m][1]))); \
        else if constexpr (sched_i8<Sched>::value) { _Pragma("unroll") for (int k = 0; k < 2; ++k)   \
            acc[ai][bj][m][n] = __builtin_bit_cast(f32x4, __builtin_amdgcn_mfma_i32_16x16x64_i8(__builtin_bit_cast(i32x4v, Bt[n][k]), __builtin_bit_cast(i32x4v, At[m][k]), __builtin_bit_cast(i32x4v, acc[ai][bj][m][n]), 0, 0, 0)); } \
        else { _Pragma("unroll") for (int k = 0; k < 2; ++k) acc[ai][bj][m][n] = __builtin_amdgcn_mfma_f32_16x16x32_bf16(Bt[n][k], At[m][k], acc[ai][bj][m][n], 0, 0, 0); } } __builtin_amdgcn_s_setprio(0); } while (0)
#define PG8_WAIT_V(n) asm volatile("s_waitcnt vmcnt(" #n ")" ::: "memory")
#define PG8_WAIT_L(n) asm volatile("s_waitcnt lgkmcnt(" #n ")" ::: "memory")
#define PG8_BAR __builtin_amdgcn_s_barrier()
#define PG8_SCHED __builtin_amdgcn_sched_barrier(0)
#define PG8_AOFFS(dst, U) do { _Pragma("unroll") for (int _h = 0; _h < 2; ++_h) _Pragma("unroll") for (int _i = 0; _i < 2; ++_i) dst[_h][_i] = S.a_off(U, _h * HALF + RA[_i], CA[_i]); } while (0)
    Unit cur, nxt; int ui = 0;
    if (!S.next(0, cur)) return;
    f32x4 acc[2][2][4][2];
#pragma unroll
    for (int a = 0; a < 2; ++a)
#pragma unroll
        for (int b = 0; b < 2; ++b)
#pragma unroll
            for (int m = 0; m < 4; ++m)
#pragma unroll
                for (int n = 0; n < 2; ++n) acc[a][b][m][n] = (f32x4){0.f, 0.f, 0.f, 0.f};
    bf16x8 At[4][2], B0[2][2], B1[2][2];
    unsigned vA[2][2], vN[2][2];
    PG8_AOFFS(vA, cur);
    unsigned cA = (unsigned)(S.a_base(cur) - (const char*)S.A), cB = (unsigned)(S.b_base(cur) - (const char*)S.Bt);
    PG8_STAGE_B(PG8_SB(0, 0), cB); PG8_STAGE_B(PG8_SB(0, 1), cB + hstepB); PG8_STAGE_A(PG8_SA(0, 0), cA, 0); PG8_STAGE_A(PG8_SA(0, 1), cA, 1);
    if (wr == 1) PG8_BAR;
    PG8_WAIT_V(2); PG8_BAR;
    PG8_STAGE_B(PG8_SB(1, 0), cB + kstep); PG8_STAGE_A(PG8_SA(1, 0), cA + kstep, 0); PG8_STAGE_B(PG8_SB(1, 1), cB + hstepB + kstep);
    PG8_WAIT_V(6); PG8_BAR;
    for (;;) {
        const bool has_next = S.next(ui + 1, nxt);
        int tokN[2][2] = {{0, 0}, {0, 0}};
        if constexpr (Sched::GATHER) { if (has_next) {
#pragma unroll
            for (int _h = 0; _h < 2; ++_h)
#pragma unroll
                for (int _i = 0; _i < 2; ++_i) tokN[_h][_i] = S.a_tok(nxt, _h * HALF + RA[_i]);
            if (nt <= 2) { asm volatile("s_waitcnt vmcnt(0)" ::: "memory");
#pragma unroll
                for (int _h = 0; _h < 2; ++_h)
#pragma unroll
                    for (int _i = 0; _i < 2; ++_i) vN[_h][_i] = S.a_fin(tokN[_h][_i], CA[_i]); } } }
        const unsigned nA = has_next ? (unsigned)(S.a_base(nxt) - (const char*)S.A) : cA, nB = has_next ? (unsigned)(S.b_base(nxt) - (const char*)S.Bt) : cB;
        for (int t = 0; t < nt; t += 2) {
            const bool last = (t == nt - 2);
            const bool sw = Sched::GATHER && last && has_next;
            const unsigned a1 = cA + (unsigned)(t + 1) * kstep;
            const unsigned a2 = last ? nA : cA + (unsigned)(t + 2) * kstep, b2 = last ? nB : cB + (unsigned)(t + 2) * kstep;
            const unsigned a3 = a2 + kstep, b3 = b2 + kstep;
            PG8_LDB(B0, 0, 0); PG8_LDB(B1, 0, 1); PG8_SCHED; PG8_LDA(At, 0, 0); PG8_STAGE_A(PG8_SA(1, 1), a1, 1);
            if constexpr (Sched::GATHER) { if (sw) {
#pragma unroll
                for (int _h = 0; _h < 2; ++_h)
#pragma unroll
                    for (int _i = 0; _i < 2; ++_i) vA[_h][_i] = vN[_h][_i]; } }
            PG8_WAIT_V(8); PG8_WAIT_L(0); PG8_BAR; PG8_MMA(0, 0, At, B0); PG8_MMA(0, 1, At, B1); PG8_BAR; PG8_SCHED;
            PG8_LDA(At, 0, 1); PG8_STAGE_B(PG8_SB(0, 0), b2); PG8_STAGE_B(PG8_SB(0, 1), b2 + hstepB); PG8_STAGE_A(PG8_SA(0, 0), a2, 0);
            PG8_WAIT_V(8); PG8_WAIT_L(0); PG8_BAR; PG8_MMA(1, 0, At, B0); PG8_MMA(1, 1, At, B1); PG8_BAR; PG8_SCHED;
            PG8_LDB(B0, 1, 0); PG8_LDB(B1, 1, 1); PG8_SCHED; PG8_LDA(At, 1, 0); PG8_STAGE_A(PG8_SA(0, 1), a2, 1);
            PG8_WAIT_V(8); PG8_WAIT_L(0); PG8_BAR; PG8_MMA(0, 0, At, B0); PG8_MMA(0, 1, At, B1); PG8_BAR; PG8_SCHED;
            PG8_LDA(At, 1, 1); PG8_STAGE_B(PG8_SB(1, 0), b3); PG8_STAGE_B(PG8_SB(1, 1), b3 + hstepB); PG8_STAGE_A(PG8_SA(1, 0), a3, 0);
            PG8_WAIT_V(8); PG8_WAIT_L(0); PG8_BAR; PG8_MMA(1, 0, At, B0); PG8_MMA(1, 1, At, B1); PG8_BAR; PG8_SCHED;
            if constexpr (Sched::GATHER) { if (has_next && t == 0 && nt > 2) {
#pragma unroll
                for (int _h = 0; _h < 2; ++_h)
#pragma unroll
                    for (int _i = 0; _i < 2; ++_i) { asm volatile("" : "+v"(tokN[_h][_i])); vN[_h][_i] = S.a_fin(tokN[_h][_i], CA[_i]); } } }
        }
        if constexpr (sched_fp8<Sched>::value) asm volatile("s_nop 15\n\ts_nop 7" ::: "memory");
        if (wr == 0) PG8_BAR;
        { int te_ = threadIdx.x; asm volatile("" : "+v"(te_));
          E(acc, cur, wr, wc, te_ & 15, (te_ & 63) >> 4); }
        if constexpr (epi_has_post<Epi>::value) E.post(cur);
        if (!has_next) break;
#pragma unroll
        for (int a = 0; a < 2; ++a)
#pragma unroll
            for (int b = 0; b < 2; ++b)
#pragma unroll
                for (int m = 0; m < 4; ++m)
#pragma unroll
                    for (int n = 0; n < 2; ++n) acc[a][b][m][n] = (f32x4){0.f, 0.f, 0.f, 0.f};
        cur = nxt; cA = nA; cB = nB; ++ui;
        if (wr == 1) PG8_BAR;
    }
    PG8_WAIT_V(0);
    PG8_BAR;
#undef PG8_SA
#undef PG8_SB
#undef PG8_STAGE_A
#undef PG8_STAGE_B
#undef PG8_LDA
#undef PG8_LDB
#undef PG8_MMA
#undef PG8_CAT8
#undef PG8_WAIT_V
#undef PG8_WAIT_L
#undef PG8_BAR
#undef PG8_SCHED
#undef PG8_AOFFS
}
}

__device__ __forceinline__ float rope_inv(int i2, int dim) { return powf(10000.0f, -(float)i2 / (float)dim); }

__device__ __forceinline__ void ph_final(const P& p) {
    int tid_ = threadIdx.x; asm volatile("" : "+v"(tid_));
    const int wave = tid_ >> 6, lane = tid_ & 63;
    const float* gain = p.in[24];
    for (int row = blockIdx.x * 8 + wave; row < T_LAT; row += gridDim.x * 8) {
        float* src = p.out + (size_t)row * 1024;
        float4 v[4]; float ss = 0.f;
#pragma unroll
        for (int i = 0; i < 4; ++i) { v[i] = *(const float4*)(src + i * 256 + lane * 4); ss += v[i].x * v[i].x + v[i].y * v[i].y + v[i].z * v[i].z + v[i].w * v[i].w; }
        ss = wave_sum(ss);
        const float rs = rsqrtf(ss * (1.f / 1024.f) + NORM_EPS);
#pragma unroll
        for (int i = 0; i < 4; ++i) { const int col = i * 256 + lane * 4; const float4 g = *(const float4*)(gain + col);
            *(float4*)(src + col) = make_float4(v[i].x * rs * g.x, v[i].y * rs * g.y, v[i].z * rs * g.z, v[i].w * rs * g.w); }
    }
}


__device__ __forceinline__ void ph_final_moe(const P& p, const LAS int* tab0, const LAS int* tab1) {
    int tid_ = threadIdx.x; asm volatile("" : "+v"(tid_));
    const int wave = tid_ >> 6, lane = tid_ & 63;
    const float* gain = p.in[24];
    const bf16_t* YM0 = (const bf16_t*)(p.ws + OFF_YM); const bf16_t* YM1 = YM0 + (size_t)ACT_ROWS * 1024;
    const float* MODL = (const float*)(p.ws + OFF_MOD) + 9 * 6144 + 5120;
    int row = blockIdx.x * 8 + wave; const int stride = gridDim.x * 8;
    int4 ep = make_int4(0, 0, 0, 0), nep = ep; float2 ww = make_float2(0.f, 0.f), nww = ww;
    if (row < T_LAT) { const int* iv = (const int*)(p.ws + OFF_INV) + (size_t)row * 8; ep = *(const int4*)iv; ww = *(const float2*)(iv + 4); }
    for (; row < T_LAT; row += stride) {
        if (row + stride < T_LAT) { const int* iv = (const int*)(p.ws + OFF_INV) + (size_t)(row + stride) * 8; nep = *(const int4*)iv; nww = *(const float2*)(iv + 4); }
        const size_t r0 = (size_t)(tab0[8 + ep.x] * 256 + ep.y) * 1024, r1 = (size_t)(tab1[8 + ep.z] * 256 + ep.w) * 1024;
        float* src = p.out + (size_t)row * 1024;
        const float* gt = MODL + (row >> 12) * 6144;
        float4 v[4]; uint2 y0[4], y1[4]; float4 gg[4]; float ss = 0.f;
#pragma unroll
        for (int i = 0; i < 4; ++i) { const int col = i * 256 + lane * 4; v[i] = *(const float4*)(src + col); y0[i] = *(const uint2*)(YM0 + r0 + col); y1[i] = *(const uint2*)(YM1 + r1 + col); gg[i] = *(const float4*)(gt + col); }
#pragma unroll
        for (int i = 0; i < 4; ++i) {
            v[i].x += gg[i].x * (ww.x * __uint_as_float(y0[i].x << 16) + ww.y * __uint_as_float(y1[i].x << 16));
            v[i].y += gg[i].y * (ww.x * __uint_as_float(y0[i].x & 0xFFFF0000u) + ww.y * __uint_as_float(y1[i].x & 0xFFFF0000u));
            v[i].z += gg[i].z * (ww.x * __uint_as_float(y0[i].y << 16) + ww.y * __uint_as_float(y1[i].y << 16));
            v[i].w += gg[i].w * (ww.x * __uint_as_float(y0[i].y & 0xFFFF0000u) + ww.y * __uint_as_float(y1[i].y & 0xFFFF0000u));
            ss += v[i].x * v[i].x + v[i].y * v[i].y + v[i].z * v[i].z + v[i].w * v[i].w; }
        ss = wave_sum(ss);
        const float rs = rsqrtf(ss * (1.f / 1024.f) + NORM_EPS);
#pragma unroll
        for (int i = 0; i < 4; ++i) { const int col = i * 256 + lane * 4; const float4 g = *(const float4*)(gain + col);
            *(float4*)(src + col) = make_float4(v[i].x * rs * g.x, v[i].y * rs * g.y, v[i].z * rs * g.z, v[i].w * rs * g.w); }
        ep = nep; ww = nww;
    }
}
typedef short bf16x8_t __attribute__((ext_vector_type(8)));
typedef short s16x4_t __attribute__((ext_vector_type(4)));
typedef float f32x16_t __attribute__((ext_vector_type(16)));
typedef unsigned u32x4_t __attribute__((ext_vector_type(4)));
typedef float f32x4_t __attribute__((ext_vector_type(4)));
__device__ __forceinline__ s16x4_t lds_tr16(LAS const unsigned char* p) { typedef short v4i16_t __attribute__((ext_vector_type(4))); return __builtin_bit_cast(s16x4_t, __builtin_amdgcn_ds_read_tr16_b64_v4i16((LAS v4i16_t*)p)); }
__device__ __forceinline__ unsigned pkbf(float lo, float hi) { typedef float f32x2_t __attribute__((ext_vector_type(2))); typedef __bf16 bf16x2_t __attribute__((ext_vector_type(2)));
    f32x2_t v = {lo, hi}; bf16x2_t b = __builtin_convertvector(v, bf16x2_t); return __builtin_bit_cast(unsigned, b); }
__device__ __forceinline__ float max3f(float a, float b, float c) { return fmaxf(fmaxf(a, b), c); }

#define ATT_VP 192
#define ATT_THR 8.0f
#define ATT_THR_BF16 16.0f
template <int DQK, bool SWA, bool GQA = false>
__device__ __forceinline__ void attn_unit(LAS unsigned char* lds, const bf16_t* POST, const bf16_t* VBUF, int vld, bf16_t* MIX, int b, int q0, int qcol, int kcol, int vcol, int ocol,
                                          int band_lo, int band_hi, float sinkl2, float qscale, const float* sinkp, float sinkmul) {
    constexpr int KP = DQK * 2 + 16, NPK = DQK / 8, NKL = NPK / 4, STAGE = 128 * KP + 128 * ATT_VP, NS = DQK / 16;
    int tid_ = threadIdx.x; asm volatile("" : "+v"(tid_));
    const int tid = tid_, wid = __builtin_amdgcn_readfirstlane(tid >> 6), lane = tid & 63, r = lane & 31, h = lane >> 5;
    const int nb = (band_hi - band_lo) >> 7, ntiles = nb + 2;
    const int qw0 = GQA ? q0 + 32 * (wid & 1) : q0 + 32 * wid;
    const int qi = qw0 + r;
    const int qrow = tok_row(b, qi);
    if (GQA) { qcol += (wid >> 1) * 64; ocol += (wid >> 1) * 64; sinkl2 = sinkp[wid >> 1] * sinkmul; }
    bf16x8_t qf[NS];
    { const bf16_t* qp = POST + (size_t)qrow * POST_LD + qcol + 8 * h;
#pragma unroll
      for (int s = 0; s < NS; ++s) { float f[8]; unpack8(*(const uint4*)(qp + 16 * s), f);
          const unsigned w0 = pkbf(f[0] * qscale, f[1] * qscale), w1 = pkbf(f[2] * qscale, f[3] * qscale), w2 = pkbf(f[4] * qscale, f[5] * qscale), w3 = pkbf(f[6] * qscale, f[7] * qscale);
          qf[s] = __builtin_bit_cast(bf16x8_t, make_uint4(w0, w1, w2, w3)); } }
    f32x16_t O0, O1;
#pragma unroll
    for (int i = 0; i < 16; ++i) { O0[i] = 0.f; O1[i] = 0.f; }
    float m = SWA ? sinkl2 : -1e30f, l = 0.f;
    u32x4_t kreg[NKL], vreg[2];
    const int vrow = tid >> 3, vpc = tid & 7;
#define ATT_KS(t) ((t) < nb ? band_lo + 128 * (t) : SEQ + 128 * ((t) - nb))
#define ATT_LOAD(t) do { const int ks_ = ATT_KS(t); const bf16_t* base_ = POST + (size_t)tok_row(b, ks_) * POST_LD; \
        _Pragma("unroll") for (int i_ = 0; i_ < NKL; ++i_) { const int idx_ = tid + 512 * i_, row_ = idx_ / NPK, pc_ = idx_ % NPK; kreg[i_] = *(const u32x4_t*)(base_ + (size_t)row_ * POST_LD + kcol + pc_ * 8); } \
        const bf16_t* vbase_ = VBUF + (size_t)tok_row(b, ks_) * vld; \
        _Pragma("unroll") for (int i_ = 0; i_ < 2; ++i_) vreg[i_] = *(const u32x4_t*)(vbase_ + (size_t)(vrow + 64 * i_) * vld + vcol + vpc * 8); } while (0)
#define ATT_WRITE(buf) do { LAS unsigned char* kb_ = lds + (buf) * STAGE; LAS unsigned char* vb_ = kb_ + 128 * KP; \
        _Pragma("unroll") for (int i_ = 0; i_ < NKL; ++i_) { const int idx_ = tid + 512 * i_, row_ = idx_ / NPK, pc_ = idx_ % NPK; *(LAS u32x4_t*)(kb_ + row_ * KP + pc_ * 16) = kreg[i_]; } \
        _Pragma("unroll") for (int i_ = 0; i_ < 2; ++i_) *(LAS u32x4_t*)(vb_ + (vrow + 64 * i_) * ATT_VP + vpc * 16) = vreg[i_]; } while (0)
    const int koff = r * KP + 16 * h;
    const int voff = (4 * h + ((lane & 15) >> 2)) * ATT_VP + (16 * ((lane >> 4) & 1) + 4 * (lane & 3)) * 2;
    __syncthreads();
    ATT_LOAD(0); ATT_WRITE(0);
    __syncthreads();
    for (int t = 0; t < ntiles; ++t) {
        if (t + 1 < ntiles) ATT_LOAD(t + 1);
        LAS const unsigned char* kb = lds + (t & 1) * STAGE; LAS const unsigned char* vb = kb + 128 * KP;
        const int ks = ATT_KS(t);
        bool skip[2] = {false, false}, need_mask[2] = {false, false};
        if (SWA && t < nb) {
#pragma unroll
            for (int sub = 0; sub < 2; ++sub) { const int kb0 = ks + sub * 64, qlo = qw0, qhi = qlo + 31;
                skip[sub] = (kb0 > qhi + 128) || (kb0 + 63 < qlo - 128);
                need_mask[sub] = !((kb0 >= qhi - 128) && (kb0 + 63 <= qlo + 128)); }
        }
        f32x16_t S[4];
#pragma unroll
        for (int blk = 0; blk < 4; ++blk)
#pragma unroll
            for (int i = 0; i < 16; ++i) S[blk][i] = 0.f;
#pragma unroll
        for (int sub = 0; sub < 2; ++sub) {
            if (!skip[sub]) {
#pragma unroll
                for (int s = 0; s < NS; ++s) {
                    const bf16x8_t k0 = *(LAS const bf16x8_t*)(kb + (sub * 64) * KP + koff + 32 * s), k1 = *(LAS const bf16x8_t*)(kb + (sub * 64 + 32) * KP + koff + 32 * s);
                    S[2 * sub] = __builtin_amdgcn_mfma_f32_32x32x16_bf16(k0, qf[s], S[2 * sub], 0, 0, 0);
                    S[2 * sub + 1] = __builtin_amdgcn_mfma_f32_32x32x16_bf16(k1, qf[s], S[2 * sub + 1], 0, 0, 0);
                }
            }
        }
#pragma unroll
        for (int sub = 0; sub < 2; ++sub) {
            if (!skip[sub]) {
                const int kb0 = ks + sub * 64;
                f32x16_t& S0 = S[2 * sub]; f32x16_t& S1 = S[2 * sub + 1];
                bf16x8_t va[8];
#pragma unroll
                for (int g = 0; g < 4; ++g) { LAS const unsigned char* vp = vb + (sub * 64 + 16 * g) * ATT_VP + voff;
                    const s16x4_t l0 = lds_tr16(vp), h0 = lds_tr16(vp + 8 * ATT_VP), l1 = lds_tr16(vp + 64), h1 = lds_tr16(vp + 8 * ATT_VP + 64);
                    va[2 * g] = __builtin_shufflevector(l0, h0, 0, 1, 2, 3, 4, 5, 6, 7); va[2 * g + 1] = __builtin_shufflevector(l1, h1, 0, 1, 2, 3, 4, 5, 6, 7); }
                if (SWA && need_mask[sub]) {
#pragma unroll
                    for (int i = 0; i < 16; ++i) { const int d0 = kb0 + (i & 3) + 8 * (i >> 2) + 4 * h - qi, d1 = d0 + 32;
                        if (d0 > 128 || d0 < -128) S0[i] = -1e30f;
                        if (d1 > 128 || d1 < -128) S1[i] = -1e30f; }
                }
                float mx = max3f(S0[0], S0[1], S1[0]), mx2 = max3f(S0[2], S0[3], S1[1]);
                mx = max3f(mx, S1[2], S1[3]);
#pragma unroll
                for (int i = 4; i < 16; i += 4) { mx = max3f(mx, S0[i], S0[i + 1]); mx2 = max3f(mx2, S0[i + 2], S0[i + 3]); mx = max3f(mx, S1[i], S1[i + 1]); mx2 = max3f(mx2, S1[i + 2], S1[i + 3]); }
                mx = fmaxf(mx, mx2);
                { const auto rr_ = __builtin_amdgcn_permlane32_swap(__float_as_uint(mx), __float_as_uint(mx), false, false); mx = fmaxf(__uint_as_float(rr_[0]), __uint_as_float(rr_[1])); }
                if (__any(mx > m + ATT_THR_BF16)) {
                    const float mn = fmaxf(m, mx), al = __builtin_amdgcn_exp2f(m - mn);
                    m = mn; l *= al;
#pragma unroll
                    for (int i = 0; i < 16; ++i) { O0[i] *= al; O1[i] *= al; }
                }
                typedef float f32x2_t __attribute__((ext_vector_type(2)));
                const f32x2_t m2 = {m, m}; f32x2_t ps2 = {0.f, 0.f};
#pragma unroll
                for (int i = 0; i < 16; i += 2) {
                    f32x2_t a = (f32x2_t){S0[i], S0[i + 1]} - m2, c = (f32x2_t){S1[i], S1[i + 1]} - m2;
                    a[0] = __builtin_amdgcn_exp2f(a[0]); a[1] = __builtin_amdgcn_exp2f(a[1]); c[0] = __builtin_amdgcn_exp2f(c[0]); c[1] = __builtin_amdgcn_exp2f(c[1]);
                    S0[i] = a[0]; S0[i + 1] = a[1]; S1[i] = c[0]; S1[i + 1] = c[1];
                    ps2 += a; ps2 += c;
                }
                l += ps2[0] + ps2[1];
#pragma unroll
                for (int g = 0; g < 4; ++g) { const f32x16_t& Sx = (g >> 1) ? S1 : S0; const int o8 = 8 * (g & 1);
                    const bf16x8_t pf = __builtin_bit_cast(bf16x8_t, make_uint4(pkbf(Sx[o8 + 0], Sx[o8 + 1]), pkbf(Sx[o8 + 2], Sx[o8 + 3]), pkbf(Sx[o8 + 4], Sx[o8 + 5]), pkbf(Sx[o8 + 6], Sx[o8 + 7])));
                    O0 = __builtin_amdgcn_mfma_f32_32x32x16_bf16(va[2 * g], pf, O0, 0, 0, 0);
                    O1 = __builtin_amdgcn_mfma_f32_32x32x16_bf16(va[2 * g + 1], pf, O1, 0, 0, 0);
                }
            }
        }
        if (t + 1 < ntiles) ATT_WRITE((t + 1) & 1);
        __syncthreads();
    }
#undef ATT_LOAD
#undef ATT_KS
#undef ATT_WRITE
    float lt = l + __shfl_xor(l, 32);
    if (SWA) lt += __builtin_amdgcn_exp2f(sinkl2 - m);
    const float inv = 1.f / lt;
    bf16_t* op = MIX + (size_t)qrow * 1024 + ocol + 4 * h;
#pragma unroll
    for (int g = 0; g < 4; ++g) {
        *(uint2*)(op + 8 * g) = make_uint2(pkbf(O0[4 * g] * inv, O0[4 * g + 1] * inv), pkbf(O0[4 * g + 2] * inv, O0[4 * g + 3] * inv));
        *(uint2*)(op + 32 + 8 * g) = make_uint2(pkbf(O1[4 * g] * inv, O1[4 * g + 1] * inv), pkbf(O1[4 * g + 2] * inv, O1[4 * g + 3] * inv));
    }
}


typedef int i32x8_t __attribute__((ext_vector_type(8)));
typedef int i32x4_t __attribute__((ext_vector_type(4)));
#define A8_KP 144
__device__ __forceinline__ i32x8_t lds_frag32(LAS const unsigned char* p) { const i32x4_t lo = *(LAS const i32x4_t*)p, hi = *(LAS const i32x4_t*)(p + 16); return __builtin_shufflevector(lo, hi, 0, 1, 2, 3, 4, 5, 6, 7); }
__device__ __forceinline__ int cvt4_f8(float a, float b, float c, float d) { return __builtin_amdgcn_cvt_pk_fp8_f32(c, d, __builtin_amdgcn_cvt_pk_fp8_f32(a, b, 0, false), true); }
__device__ __forceinline__ void attn_unit_f8(LAS unsigned char* lds, const unsigned char* QK8, const unsigned char* V8T, bf16_t* MIX, int b, int q0, int head, int band_lo, int band_hi, float qscale) {
    constexpr int STAGE = 128 * A8_KP + 64 * A8_KP;
    int tid_ = threadIdx.x; asm volatile("" : "+v"(tid_));
    const int tid = tid_, wid = __builtin_amdgcn_readfirstlane(tid >> 6), lane = tid & 63, r = lane & 31, h = lane >> 5;
    const int nb = (band_hi - band_lo) >> 7, ntiles = nb + 2;
    const int qi = q0 + 32 * wid + r, qrow = tok_row(b, qi);
    i32x8_t qf[2];
    { const unsigned char* qp = QK8 + (size_t)qrow * 1024 + head * 128 + 32 * h;
#pragma unroll
      for (int s = 0; s < 2; ++s) { const i32x4_t lo = *(const i32x4_t*)(qp + 64 * s), hi = *(const i32x4_t*)(qp + 64 * s + 16); qf[s] = __builtin_shufflevector(lo, hi, 0, 1, 2, 3, 4, 5, 6, 7); } }
    f32x16_t O0, O1;
#pragma unroll
    for (int i = 0; i < 16; ++i) { O0[i] = 0.f; O1[i] = 0.f; }
    float m = -1e30f;
    f32x16_t Ls;
#pragma unroll
    for (int i = 0; i < 16; ++i) Ls[i] = 0.f;
    const i32x8_t ones8 = {0x38383838, 0x38383838, 0x38383838, 0x38383838, 0x38383838, 0x38383838, 0x38383838, 0x38383838};
    u32x4_t kreg[2], vreg;
    const unsigned char* vbase = V8T + (size_t)((b * 4 + head) * 64 + (tid >> 3)) * 4352 + (tid & 7) * 16;
#define A8_KS(t) ((t) < nb ? band_lo + 128 * (t) : SEQ + 128 * ((t) - nb))
#define A8_LOAD(t) do { const int ks_ = A8_KS(t); const unsigned char* base_ = QK8 + (size_t)tok_row(b, ks_) * 1024 + 512 + head * 128; \
        _Pragma("unroll") for (int i_ = 0; i_ < 2; ++i_) { const int idx_ = tid + 512 * i_; kreg[i_] = *(const u32x4_t*)(base_ + (size_t)(idx_ >> 3) * 1024 + (idx_ & 7) * 16); } \
        vreg = *(const u32x4_t*)(vbase + ks_); } while (0)
#define A8_WRITE(buf) do { LAS unsigned char* kb_ = lds + (buf) * STAGE; \
        _Pragma("unroll") for (int i_ = 0; i_ < 2; ++i_) { const int idx_ = tid + 512 * i_; *(LAS u32x4_t*)(kb_ + (idx_ >> 3) * A8_KP + (idx_ & 7) * 16) = kreg[i_]; } \
        *(LAS u32x4_t*)(kb_ + 128 * A8_KP + (tid >> 3) * A8_KP + (tid & 7) * 16) = vreg; } while (0)
    const int foff = r * A8_KP + 32 * h;
    __syncthreads();
    A8_LOAD(0); A8_WRITE(0);
    __syncthreads();
    typedef float f32x2_t __attribute__((ext_vector_type(2)));
    const f32x2_t qs2 = {qscale, qscale};
    for (int t = 0; t < ntiles; ++t) {
        if (t + 1 < ntiles) A8_LOAD(t + 1);
        LAS const unsigned char* kb = lds + (t & 1) * STAGE; LAS const unsigned char* vb = kb + 128 * A8_KP;
        f32x16_t S[4];
#pragma unroll
        for (int blk = 0; blk < 4; ++blk)
#pragma unroll
            for (int i = 0; i < 16; ++i) S[blk][i] = 0.f;
#pragma unroll
        for (int blk = 0; blk < 4; ++blk)
#pragma unroll
            for (int s = 0; s < 2; ++s) S[blk] = __builtin_amdgcn_mfma_scale_f32_32x32x64_f8f6f4(lds_frag32(kb + (blk * 32) * A8_KP + foff + 64 * s), qf[s], S[blk], 0, 0, 0, 0, 0, 0);
#pragma unroll
        for (int sub = 0; sub < 2; ++sub) {
            f32x16_t& S0 = S[2 * sub]; f32x16_t& S1 = S[2 * sub + 1];
            const i32x8_t va0 = lds_frag32(vb + foff + 64 * sub), va1 = lds_frag32(vb + 32 * A8_KP + foff + 64 * sub);
            float mx = max3f(S0[0], S0[1], S1[0]), mx2 = max3f(S0[2], S0[3], S1[1]);
            mx = max3f(mx, S1[2], S1[3]);
#pragma unroll
            for (int i = 4; i < 16; i += 4) { mx = max3f(mx, S0[i], S0[i + 1]); mx2 = max3f(mx2, S0[i + 2], S0[i + 3]); mx = max3f(mx, S1[i], S1[i + 1]); mx2 = max3f(mx2, S1[i + 2], S1[i + 3]); }
            mx = fmaxf(mx, mx2);
            { const auto rr_ = __builtin_amdgcn_permlane32_swap(__float_as_uint(mx), __float_as_uint(mx), false, false); mx = fmaxf(__uint_as_float(rr_[0]), __uint_as_float(rr_[1])); }
            mx *= qscale;
            if (__any(mx > m + ATT_THR)) {
                const float mn = fmaxf(m, mx), al = __builtin_amdgcn_exp2f(m - mn);
                m = mn; Ls[0] *= al;
#pragma unroll
                for (int i = 0; i < 16; ++i) { O0[i] *= al; O1[i] *= al; }
            }
            const f32x2_t m2 = {-m, -m};
#pragma unroll
            for (int i = 0; i < 16; i += 2) {
                f32x2_t a = (f32x2_t){S0[i], S0[i + 1]} * qs2 + m2, c = (f32x2_t){S1[i], S1[i + 1]} * qs2 + m2;
                a[0] = __builtin_amdgcn_exp2f(a[0]); a[1] = __builtin_amdgcn_exp2f(a[1]); c[0] = __builtin_amdgcn_exp2f(c[0]); c[1] = __builtin_amdgcn_exp2f(c[1]);
                S0[i] = a[0]; S0[i + 1] = a[1]; S1[i] = c[0]; S1[i + 1] = c[1];
            }
            i32x8_t pf;
#pragma unroll
            for (int w = 0; w < 4; ++w) { pf[w] = cvt4_f8(S0[4 * w], S0[4 * w + 1], S0[4 * w + 2], S0[4 * w + 3]); pf[4 + w] = cvt4_f8(S1[4 * w], S1[4 * w + 1], S1[4 * w + 2], S1[4 * w + 3]); }
            O0 = __builtin_amdgcn_mfma_scale_f32_32x32x64_f8f6f4(va0, pf, O0, 0, 0, 0, 0, 0, 0);
            O1 = __builtin_amdgcn_mfma_scale_f32_32x32x64_f8f6f4(va1, pf, O1, 0, 0, 0, 0, 0, 0);
            Ls = __builtin_amdgcn_mfma_scale_f32_32x32x64_f8f6f4(ones8, pf, Ls, 0, 0, 0, 0, 0, 0);
        }
        if (t + 1 < ntiles) A8_WRITE((t + 1) & 1);
        __syncthreads();
    }
#undef A8_LOAD
#undef A8_KS
#undef A8_WRITE
    const float inv = 1.f / Ls[0];
    bf16_t* op = MIX + (size_t)qrow * 1024 + head * 64 + 4 * h;
#pragma unroll
    for (int g = 0; g < 4; ++g) {
        *(uint2*)(op + 8 * g) = make_uint2(pkbf(O0[4 * g] * inv, O0[4 * g + 1] * inv), pkbf(O0[4 * g + 2] * inv, O0[4 * g + 3] * inv));
        *(uint2*)(op + 32 + 8 * g) = make_uint2(pkbf(O1[4 * g] * inv, O1[4 * g + 1] * inv), pkbf(O1[4 * g + 2] * inv, O1[4 * g + 3] * inv));
    }
}
__device__ __forceinline__ float log2_sigmoid(float x) { return log2f(1.f / (1.f + expf(-x))); }

__device__ __forceinline__ void ph_ret_T(const P& p, int layer, LAS unsigned char* lds) {
    const bf16_t* POST = (const bf16_t*)(p.ws + OFF_POST); const bf16_t* PROJB = (const bf16_t*)(p.ws + OFF_PROJ);
    bf16_t* TT = (bf16_t*)(p.ws + OFF_TT);
    int tid_ = threadIdx.x; asm volatile("" : "+v"(tid_));
    const int tid = tid_, wid = __builtin_amdgcn_readfirstlane(tid >> 6), lane = tid & 63, h2 = lane >> 5;
    const int G = gridDim.x, bid = blockIdx.x;
    const int trq = (lane & 15) >> 2, trc = (16 * ((lane >> 4) & 1) + 4 * (lane & 3)) * 2;
    for (int u = bid; u < BATCH * 34 * 2; u += G) {
        const int hp = u & 1, c = (u >> 1) % 34, b = u / 68;
        const int row0 = c < 32 ? b * SEQ + c * 128 : T_LAT + b * CTXL + (c - 32) * 128;
        __syncthreads();
#pragma unroll
        for (int i = 0; i < 8; ++i) {
            const int idx = tid + 512 * i, arr = idx >> 10, rem = idx & 1023, row = rem >> 3, pc = rem & 7;
            const u32x4_t v = arr < 2 ? *(const u32x4_t*)(POST + (size_t)(row0 + row) * POST_LD + PC_RK + (2 * hp + (arr & 1)) * 64 + pc * 8)
                                      : *(const u32x4_t*)(PROJB + (size_t)(row0 + row) * PROJ_LD + PJ_RV + (2 * hp + (arr & 1)) * 64 + pc * 8);
            *(LAS u32x4_t*)(lds + arr * 24576 + row * 192 + pc * 16) = v;
        }
        __syncthreads();
        const int hh = wid >> 2, head = 2 * hp + hh, dir = (wid >> 1) & 1, dvb = wid & 1;
        const float lg = log2_sigmoid(dir ? p.in[15][layer * 4 + head] : p.in[14][layer * 4 + head]);
        f32x16_t acc0, acc1;
#pragma unroll
        for (int i = 0; i < 16; ++i) { acc0[i] = 0.f; acc1[i] = 0.f; }
        LAS const unsigned char* kt = lds + hh * 24576; LAS const unsigned char* vt = lds + (2 + hh) * 24576;
#pragma unroll
        for (int s = 0; s < 8; ++s) {
            const int kr = 16 * s + 8 * h2;
            LAS const unsigned char* vp = vt + (kr + trq) * 192 + dvb * 64 + trc;
            const s16x4_t vlo = lds_tr16(vp), vhi = lds_tr16(vp + 4 * 192);
            const bf16x8_t a = {vlo[0], vlo[1], vlo[2], vlo[3], vhi[0], vhi[1], vhi[2], vhi[3]};
            float w[8];
#pragma unroll
            for (int j = 0; j < 8; ++j) w[j] = __builtin_amdgcn_exp2f(lg * (float)(dir ? (kr + j) : (127 - kr - j)));
#pragma unroll
            for (int dkb = 0; dkb < 2; ++dkb) {
                LAS const unsigned char* kp = kt + (kr + trq) * 192 + dkb * 64 + trc;
                const s16x4_t klo = lds_tr16(kp), khi = lds_tr16(kp + 4 * 192);
                float f[8];
#pragma unroll
                for (int j = 0; j < 4; ++j) { f[j] = bf2f((bf16_t)klo[j]) * w[j]; f[4 + j] = bf2f((bf16_t)khi[j]) * w[4 + j]; }
                const bf16x8_t bb = __builtin_bit_cast(bf16x8_t, make_uint4(pkbf(f[0], f[1]), pkbf(f[2], f[3]), pkbf(f[4], f[5]), pkbf(f[6], f[7])));
                if (dkb == 0) acc0 = __builtin_amdgcn_mfma_f32_32x32x16_bf16(a, bb, acc0, 0, 0, 0);
                else acc1 = __builtin_amdgcn_mfma_f32_32x32x16_bf16(a, bb, acc1, 0, 0, 0);
            }
        }
        bf16_t* tp = TT + ((((size_t)(b * 4 + head) * 34 + c) * 2 + dir) * 4096) + (lane & 31);
#pragma unroll
        for (int i = 0; i < 16; ++i) { const int dv = 32 * dvb + (i & 3) + 8 * (i >> 2) + 4 * h2; tp[dv * 64] = f2bf(acc0[i]); tp[dv * 64 + 32] = f2bf(acc1[i]); }
    }
}

__device__ __forceinline__ void ret_unit(LAS unsigned char* lds, const P& p, int layer, int b, int c, int hp, int mode, f32x4_t (&keep)[8]) {
    const bf16_t* POST = (const bf16_t*)(p.ws + OFF_POST); const bf16_t* PROJB = (const bf16_t*)(p.ws + OFF_PROJ);
    bf16_t* MIX = (bf16_t*)(p.ws + OFF_H);
    const bf16_t* TT = (const bf16_t*)(p.ws + OFF_TT);
    int tid_ = threadIdx.x; asm volatile("" : "+v"(tid_));
    const int tid = tid_, wid = __builtin_amdgcn_readfirstlane(tid >> 6), lane = tid & 63, r = lane & 31, h2 = lane >> 5;
    const bool isctx = c >= 32;
    const int row0 = !isctx ? b * SEQ + c * 128 : T_LAT + b * CTXL + (c - 32) * 128;
    constexpr int L_ST = 0, L_K = 36864, L_V = 73728;
    __syncthreads();
#pragma unroll
    for (int i = 0; i < 8; ++i) {
        const int idx = tid + 512 * i, arr = idx >> 10, rem = idx & 1023, row = rem >> 3, pc = rem & 7;
        const u32x4_t v = arr < 2 ? *(const u32x4_t*)(POST + (size_t)(row0 + row) * POST_LD + PC_RK + (2 * hp + (arr & 1)) * 64 + pc * 8)
                                      : *(const u32x4_t*)(PROJB + (size_t)(row0 + row) * PROJ_LD + PJ_RV + (2 * hp + (arr & 1)) * 64 + pc * 8);
        if (arr < 2) *(LAS u32x4_t*)(lds + L_K + (arr & 1) * 18432 + row * 144 + pc * 16) = v;
        else *(LAS u32x4_t*)(lds + L_V + (arr & 1) * 24576 + row * 192 + pc * 16) = v;
    }
    {
        const int hd = tid >> 7, hh = hd >> 1, dir = hd & 1, head = 2 * hp + hh;
        const float g128 = 128.f * log2_sigmoid(dir ? p.in[15][layer * 4 + head] : p.in[14][layer * 4 + head]);
        const bf16_t* tb = TT + (size_t)(b * 4 + head) * 34 * 2 * 4096 + dir * 4096 + (tid & 127) * 4;
        f32x4_t acc[8];
#pragma unroll
        for (int i = 0; i < 8; ++i) acc[i] = (f32x4_t){0.f, 0.f, 0.f, 0.f};
        int v0, v1;
        if (!isctx) { if (dir == 0) { v0 = -2; v1 = c - 1; } else { v0 = c + 1; v1 = 33; } }
        else { const int cc = c - 32; if (dir == 0) { v0 = -2; v1 = cc - 3; } else { v0 = 33 + cc; v1 = 33; } }
        if (mode == 1 && dir == 1) v0 = c + 2;
        if (mode == 2) { v0 = 0; v1 = -1; }
        for (int v = v0; v <= v1; ++v) {
            const int idxT = v < 0 ? 34 + v : v;
            const float coef = __builtin_amdgcn_exp2f(g128 * (float)(dir == 0 ? (v1 - v) : (v - v0)));
            const bf16_t* tp = tb + (size_t)idxT * 2 * 4096;
#pragma unroll
            for (int i = 0; i < 8; ++i) { const uint2 r_ = *(const uint2*)(tp + 512 * i);
                const f32x4_t x = {__uint_as_float(r_.x << 16), __uint_as_float(r_.x & 0xFFFF0000u), __uint_as_float(r_.y << 16), __uint_as_float(r_.y & 0xFFFF0000u)}; acc[i] += x * coef; }
        }
        if (mode != 0) {
            const float g1 = __builtin_amdgcn_exp2f(g128);
            if (mode == 1) {
#pragma unroll
                for (int i = 0; i < 8; ++i) keep[i] = acc[i];
            }
            const bool step = (mode == 1 && dir == 1) || (mode == 2 && dir == 0);
            if (mode == 2) {
#pragma unroll
                for (int i = 0; i < 8; ++i) acc[i] = keep[i];
            }
            if (step) { const bf16_t* tp = tb + (size_t)(dir == 1 ? c + 1 : c - 1) * 2 * 4096;
#pragma unroll
                for (int i = 0; i < 8; ++i) { const uint2 r_ = *(const uint2*)(tp + 512 * i);
                    const f32x4_t x = {__uint_as_float(r_.x << 16), __uint_as_float(r_.x & 0xFFFF0000u), __uint_as_float(r_.y << 16), __uint_as_float(r_.y & 0xFFFF0000u)}; acc[i] = acc[i] * g1 + x; } }
        }
#pragma unroll
        for (int i = 0; i < 8; ++i) { const int e = (tid & 127) * 4 + 512 * i, dv = e >> 6, dk = e & 63;
            typedef unsigned u32x2_t __attribute__((ext_vector_type(2))); *(LAS u32x2_t*)(lds + L_ST + hd * 9216 + dv * 144 + dk * 2) = (u32x2_t){pkbf(acc[i][0], acc[i][1]), pkbf(acc[i][2], acc[i][3])}; }
    }
    __syncthreads();
    const int hh = wid >> 2, head = 2 * hp + hh, qb = wid & 3, qi = 32 * qb + r;
    const int qrow = row0 + qi;
    const float lgf = log2_sigmoid(p.in[14][layer * 4 + head]), lgb = log2_sigmoid(p.in[15][layer * 4 + head]);
    bf16x8_t qf[4];
    { const bf16_t* qp = POST + (size_t)qrow * POST_LD + PC_RQ + head * 64 + 8 * h2;
#pragma unroll
      for (int s = 0; s < 4; ++s) qf[s] = *(const bf16x8_t*)(qp + 16 * s); }
    f32x16_t O0, O1;
#pragma unroll
    for (int i = 0; i < 16; ++i) { O0[i] = 0.f; O1[i] = 0.f; }
    LAS const unsigned char* kt = lds + L_K + hh * 18432; LAS const unsigned char* vt = lds + L_V + hh * 24576;
    const int voff = (4 * h2 + ((lane & 15) >> 2)) * 192 + (16 * ((lane >> 4) & 1) + 4 * (lane & 3)) * 2;
#pragma unroll
    for (int blk = 0; blk < 4; ++blk) {
        f32x16_t S;
#pragma unroll
        for (int i = 0; i < 16; ++i) S[i] = 0.f;
#pragma unroll
        for (int s = 0; s < 4; ++s) { const bf16x8_t a = *(LAS const bf16x8_t*)(kt + (32 * blk + r) * 144 + 32 * s + 16 * h2); S = __builtin_amdgcn_mfma_f32_32x32x16_bf16(a, qf[s], S, 0, 0, 0); }
#pragma unroll
        for (int i = 0; i < 16; ++i) { const int d = qi - (32 * blk + (i & 3) + 8 * (i >> 2) + 4 * h2);
            const float w = d > 0 ? __builtin_amdgcn_exp2f(lgf * (float)d) : (d == 0 ? 2.f : __builtin_amdgcn_exp2f(lgb * (float)(-d)));
            S[i] *= w; }
#pragma unroll
        for (int s2 = 0; s2 < 2; ++s2) {
            const bf16x8_t pf = __builtin_bit_cast(bf16x8_t, make_uint4(pkbf(S[8 * s2 + 0], S[8 * s2 + 1]), pkbf(S[8 * s2 + 2], S[8 * s2 + 3]), pkbf(S[8 * s2 + 4], S[8 * s2 + 5]), pkbf(S[8 * s2 + 6], S[8 * s2 + 7])));
            LAS const unsigned char* vp = vt + (32 * blk + 16 * s2) * 192 + voff;
            const s16x4_t lo0 = lds_tr16(vp), hi0 = lds_tr16(vp + 8 * 192), lo1 = lds_tr16(vp + 64), hi1 = lds_tr16(vp + 8 * 192 + 64);
            const bf16x8_t a0 = {lo0[0], lo0[1], lo0[2], lo0[3], hi0[0], hi0[1], hi0[2], hi0[3]};
            const bf16x8_t a1 = {lo1[0], lo1[1], lo1[2], lo1[3], hi1[0], hi1[1], hi1[2], hi1[3]};
            O0 = __builtin_amdgcn_mfma_f32_32x32x16_bf16(a0, pf, O0, 0, 0, 0);
            O1 = __builtin_amdgcn_mfma_f32_32x32x16_bf16(a1, pf, O1, 0, 0, 0);
        }
    }
#pragma unroll
    for (int dir = 0; dir < 2; ++dir) {
        f32x16_t T0, T1;
#pragma unroll
        for (int i = 0; i < 16; ++i) { T0[i] = 0.f; T1[i] = 0.f; }
        LAS const unsigned char* st = lds + L_ST + (hh * 2 + dir) * 9216;
#pragma unroll
        for (int s = 0; s < 4; ++s) {
            const bf16x8_t a0 = *(LAS const bf16x8_t*)(st + r * 144 + 32 * s + 16 * h2), a1 = *(LAS const bf16x8_t*)(st + (32 + r) * 144 + 32 * s + 16 * h2);
            T0 = __builtin_amdgcn_mfma_f32_32x32x16_bf16(a0, qf[s], T0, 0, 0, 0);
            T1 = __builtin_amdgcn_mfma_f32_32x32x16_bf16(a1, qf[s], T1, 0, 0, 0);
        }
        const float coef = dir == 0 ? __builtin_amdgcn_exp2f(lgf * (float)(qi + 1)) : __builtin_amdgcn_exp2f(lgb * (float)(128 - qi));
#pragma unroll
        for (int i = 0; i < 16; ++i) { O0[i] += coef * T0[i]; O1[i] += coef * T1[i]; }
    }
    float ss = 0.f;
#pragma unroll
    for (int i = 0; i < 16; ++i) ss += O0[i] * O0[i] + O1[i] * O1[i];
    ss += __shfl_xor(ss, 32);
    const float rs = rsqrtf(ss * (1.f / 64.f) + NORM_EPS);
    const bf16_t* gp = PROJB + (size_t)qrow * PROJ_LD + PJ_RG + head * 64 + 4 * h2;
    bf16_t* op = MIX + (size_t)qrow * 1024 + 768 + head * 64 + 4 * h2;
#pragma unroll
    for (int g = 0; g < 4; ++g) {
        const uint2 g0 = *(const uint2*)(gp + 8 * g), g1 = *(const uint2*)(gp + 32 + 8 * g);
        float gv[8] = {__uint_as_float(g0.x << 16), __uint_as_float(g0.x & 0xFFFF0000u), __uint_as_float(g0.y << 16), __uint_as_float(g0.y & 0xFFFF0000u),
                       __uint_as_float(g1.x << 16), __uint_as_float(g1.x & 0xFFFF0000u), __uint_as_float(g1.y << 16), __uint_as_float(g1.y & 0xFFFF0000u)};
        float o[8];
#pragma unroll
        for (int j = 0; j < 4; ++j) { o[j] = O0[4 * g + j] * rs * silu_f(gv[j]); o[4 + j] = O1[4 * g + j] * rs * silu_f(gv[4 + j]); }
        *(uint2*)(op + 8 * g) = make_uint2(pkbf(o[0], o[1]), pkbf(o[2], o[3]));
        *(uint2*)(op + 32 + 8 * g) = make_uint2(pkbf(o[4], o[5]), pkbf(o[6], o[7]));
    }
}

__device__ __forceinline__ void ph_mixer_mfma(const P& p, int layer, bool ctxq, LAS unsigned char* lds) {
    const bf16_t* POST = (const bf16_t*)(p.ws + OFF_POST); const bf16_t* PROJB = (const bf16_t*)(p.ws + OFF_PROJ);
    bf16_t* MIX = (bf16_t*)(p.ws + OFF_H);
    const int G = gridDim.x, bid = blockIdx.x;
    const float L2E = 1.4426950408889634f;
    const int n_mla = BATCH * 4 * 16, n_swa = BATCH * 8 * 16, n_mlac = ctxq ? BATCH * 4 : 0, n_swac = ctxq ? BATCH * 8 : 0;
    const int n_ret = BATCH * 32 * 2, n_retc = ctxq ? BATCH * 2 * 2 : 0;
    const int total = n_mla + n_swa + n_mlac + n_swac + n_ret + n_retc;
    const int nmine = (total - bid + G - 1) / G;
    for (int k = 0; k < nmine; ++k) { const int u = bid + ((bid & 1) ? (nmine - 1 - k) : k) * G;
        if (u < n_mla) {
            int qb = u & 15, h = (u >> 4) & 3, b = u >> 6;
            if (G == 256) { const int x = bid & 7, j = bid >> 3, combo = 16 * (u >> 8) + 4 * (x >> 1) + (j >> 3);
                qb = (x & 1) * 8 + (j & 7); h = combo & 3; b = combo >> 2; }
            attn_unit_f8(lds, p.ws + OFF_QK8, p.ws + OFF_V8T, MIX, b, qb * 256, h, 0, SEQ, 0.10206207261596575f * L2E);
        } else if (u < n_mla + n_swa) {
            const int v = u - n_mla, qb = v & 63, kvh = (v >> 6) & 1, b = v >> 7;
            const int q0 = qb * 64; int lo = (q0 - 128) & ~127; lo = lo < 0 ? 0 : lo; int hi = (q0 + 192 + 127) & ~127; hi = hi > SEQ ? SEQ : hi;
            attn_unit<64, true, true>(lds, POST, PROJB, PROJ_LD, MIX, b, q0, PC_QB + kvh * 256, PC_KB + kvh * 64, 992 + kvh * 64, 256 + kvh * 256, lo, hi, 0.f, 0.125f * L2E, p.in[13] + layer * 8 + kvh * 4, L2E);
        } else if (u < n_mla + n_swa + n_mlac) {
            const int v = u - n_mla - n_swa, h = v & 3, b = v >> 2;
            attn_unit_f8(lds, p.ws + OFF_QK8, p.ws + OFF_V8T, MIX, b, SEQ, h, 0, 0, 0.10206207261596575f * L2E);
        } else if (u < n_mla + n_swa + n_mlac + n_swac) {
            const int v = u - n_mla - n_swa - n_mlac, qb = v & 3, kvh = (v >> 2) & 1, b = v >> 3;
            attn_unit<64, true, true>(lds, POST, PROJB, PROJ_LD, MIX, b, SEQ + qb * 64, PC_QB + kvh * 256, PC_KB + kvh * 64, 992 + kvh * 64, 256 + kvh * 256, 0, 0, 0.f, 0.125f * L2E, p.in[13] + layer * 8 + kvh * 4, L2E);
        } else if (u < n_mla + n_swa + n_mlac + n_swac + n_ret) {
            const int v = u - n_mla - n_swa - n_mlac - n_swac;
            f32x4_t keep[8];
#pragma unroll
            for (int i = 0; i < 8; ++i) keep[i] = (f32x4_t){0.f, 0.f, 0.f, 0.f};
            if (G == 256) {
                if ((v >> 8) == 0) { const int combo = (bid & 7) + 8 * (bid >> 7), c0 = 2 * ((bid >> 3) & 15);
                    ret_unit(lds, p, layer, combo >> 1, c0, combo & 1, 1, keep); ret_unit(lds, p, layer, combo >> 1, c0 + 1, combo & 1, 2, keep); } }
            else ret_unit(lds, p, layer, v >> 6, (v >> 1) & 31, v & 1, 0, keep);
        } else {
            const int v = u - n_mla - n_swa - n_mlac - n_swac - n_ret;
            f32x4_t keep[8];
#pragma unroll
            for (int i = 0; i < 8; ++i) keep[i] = (f32x4_t){0.f, 0.f, 0.f, 0.f};
            ret_unit(lds, p, layer, v >> 2, 32 + ((v >> 1) & 1), v & 1, 0, keep);
        }
    }
}

__device__ __forceinline__ void ph_tables(const P& p) {
    float2* tr = (float2*)(p.ws + OFF_TAB); float2* t32 = tr + 4096 * 32; float2* t16 = t32 + 64 * 16;
    const int n = 4096 * 32 + 64 * 16 + 64 * 8;
    for (int i = blockIdx.x * NT + threadIdx.x; i < n; i += gridDim.x * NT) {
        float ang;
        if (i < 4096 * 32) ang = (float)(i >> 5) * rope_inv(2 * (i & 31), 64);
        else if (i < 4096 * 32 + 64 * 16) { const int j = i - 4096 * 32; ang = (float)(j >> 4) * rope_inv(2 * (j & 15), 32); }
        else { const int j = i - 4096 * 32 - 64 * 16; ang = (float)(j >> 3) * rope_inv(2 * (j & 7), 16); }
        tr[i] = make_float2(cosf(ang), sinf(ang));
    }
}

__device__ __forceinline__ void ph_prep2(const P& p, int layer, LAS unsigned char* lds) {
    const bf16_t* PROJ = (const bf16_t*)(p.ws + OFF_PROJ);
    bf16_t* POST = (bf16_t*)(p.ws + OFF_POST);
    unsigned char* QK8 = p.ws + OFF_QK8; unsigned char* V8T = p.ws + OFF_V8T;
#define CVT4_F8(a_, b_, c_, d_) __builtin_amdgcn_cvt_pk_fp8_f32(f8clamp(c_), f8clamp(d_), __builtin_amdgcn_cvt_pk_fp8_f32(f8clamp(a_), f8clamp(b_), 0, false), true)
    const bf16_t* WUQ = (const bf16_t*)(p.ws + OFF_WUQ) + (size_t)layer * 384 * 192;
    const bf16_t* WUKV = (const bf16_t*)(p.ws + OFF_WUKV) + (size_t)layer * 512 * 128;
    const float* qn = p.in[9] + layer * 192; const float* kvn = p.in[11] + layer * 128;
    const float2* tab_ret = (const float2*)(p.ws + OFF_TAB); const float2* tab32 = tab_ret + 4096 * 32; const float2* tab16 = tab32 + 64 * 16;
    int tid_ = threadIdx.x; asm volatile("" : "+v"(tid_));
    const int tid = tid_, wid = __builtin_amdgcn_readfirstlane(tid >> 6), lane = tid & 63, fr = lane & 15, fq = lane >> 4;
    constexpr int QP = 400, KVP = 272, L_CQ = 0, L_CKV = 32 * QP;
    constexpr int SQP = 1040, L_SQ = L_CKV + 32 * KVP, L_SV = L_SQ + 32 * SQP;
#define PREP_LOADS(RA, RB, RC, RK, P1, P2, UNIT) do { const int R0_ = (UNIT) * 32; int tidA = tid; asm volatile("" : "+v"(tidA)); const int tk_ = tidA >> 4, sub_ = tidA & 15; \
        { const bf16_t* pr_ = PROJ + (size_t)(R0_ + tk_) * PROJ_LD; RA = *(const uint2*)(pr_ + sub_ * 12); RB = *(const uint2*)(pr_ + sub_ * 12 + 4); RC = *(const uint2*)(pr_ + sub_ * 12 + 8); RK = *(const u32x4_t*)(pr_ + 192 + sub_ * 8); } \
        _Pragma("unroll") for (int it_ = 0; it_ < 1; ++it_) { const int w_ = it_ * NT + tidA;   \
            if (w_ < 32 * 2) { const int tok_ = w_ / 2, task_ = 72 + (w_ & 1); int src_, dist_; \
                if (task_ < 40) { const int hd_ = task_ >> 2, half_ = (task_ >> 1) & 1, cp_ = task_ & 1; src_ = (task_ < 32 ? 352 : 864 - 8 * 64) + hd_ * 64 + half_ * 32 + cp_ * 8; dist_ = 16; } \
                else if (task_ < 72) { const int q_ = task_ - 40, hd_ = q_ >> 2, cp_ = q_ & 3; src_ = (hd_ < 4 ? PJ_RQ + hd_ * 64 : PJ_RK + (hd_ - 4) * 64) + cp_ * 8; dist_ = 32; } \
                else { src_ = 320 + (task_ - 72) * 16; dist_ = 8; } \
                const bf16_t* pr_ = PROJ + (size_t)(R0_ + tok_) * PROJ_LD + src_; P1[it_] = *(const u32x4_t*)pr_; P2[it_] = *(const u32x4_t*)(pr_ + dist_); } \
            else { P1[it_] = (u32x4_t){0u, 0u, 0u, 0u}; P2[it_] = P1[it_]; } } } while (0)
    uint2 ra, rb, rc, na_, nb_, nc_; u32x4_t rk, nk_; u32x4_t p1[1], p2[1], n1[1], n2[1];
    if ((int)blockIdx.x < T_ALL / 32) PREP_LOADS(ra, rb, rc, rk, p1, p2, (int)blockIdx.x);
    for (int u = blockIdx.x; u < T_ALL / 32; u += gridDim.x) {
        const int R0 = u * 32; const bool isctx = R0 >= T_LAT;
        const int t0 = isctx ? (R0 - T_LAT) % CTXL : R0 % SEQ;
        const int tk = tid >> 4, sub = tid & 15;
        const bool has_next = u + (int)gridDim.x < T_ALL / 32;
        if (has_next) PREP_LOADS(na_, nb_, nc_, nk_, n1, n2, u + (int)gridDim.x);
        __syncthreads();
        *(LAS u32x4_t*)(lds + L_SQ + tk * SQP + (sub >> 3) * 512 + ((sub >> 1) & 3) * 128 + 96 + (sub & 1) * 16) = (u32x4_t){0u, 0u, 0u, 0u};
        {
            float c[12], k[8];
            c[0] = __uint_as_float(ra.x << 16); c[1] = __uint_as_float(ra.x & 0xFFFF0000u); c[2] = __uint_as_float(ra.y << 16); c[3] = __uint_as_float(ra.y & 0xFFFF0000u);
            c[4] = __uint_as_float(rb.x << 16); c[5] = __uint_as_float(rb.x & 0xFFFF0000u); c[6] = __uint_as_float(rb.y << 16); c[7] = __uint_as_float(rb.y & 0xFFFF0000u);
            c[8] = __uint_as_float(rc.x << 16); c[9] = __uint_as_float(rc.x & 0xFFFF0000u); c[10] = __uint_as_float(rc.y << 16); c[11] = __uint_as_float(rc.y & 0xFFFF0000u);
            unpack8(make_uint4(rk[0], rk[1], rk[2], rk[3]), k);
            float s1 = 0.f, s2 = 0.f;
#pragma unroll
            for (int i = 0; i < 12; ++i) s1 += c[i] * c[i];
#pragma unroll
            for (int i = 0; i < 8; ++i) s2 += k[i] * k[i];
#pragma unroll
            for (int o = 1; o < 16; o <<= 1) { s1 += __shfl_xor(s1, o); s2 += __shfl_xor(s2, o); }
            const float r1 = rsqrtf(s1 * (1.f / 192.f) + NORM_EPS), r2 = rsqrtf(s2 * (1.f / 128.f) + NORM_EPS);
            typedef unsigned u32x2_t __attribute__((ext_vector_type(2)));
#pragma unroll
            for (int i = 0; i < 3; ++i) { const int e = sub * 12 + 4 * i;
                *(LAS u32x2_t*)(lds + L_CQ + tk * QP + e * 2) = (u32x2_t){pkbf(c[4 * i] * r1 * qn[e], c[4 * i + 1] * r1 * qn[e + 1]), pkbf(c[4 * i + 2] * r1 * qn[e + 2], c[4 * i + 3] * r1 * qn[e + 3])}; }
            { const int e = sub * 8;
              *(LAS u32x4_t*)(lds + L_CKV + tk * KVP + e * 2) = (u32x4_t){pkbf(k[0] * r2 * kvn[e], k[1] * r2 * kvn[e + 1]), pkbf(k[2] * r2 * kvn[e + 2], k[3] * r2 * kvn[e + 3]),
                                                                        pkbf(k[4] * r2 * kvn[e + 4], k[5] * r2 * kvn[e + 5]), pkbf(k[6] * r2 * kvn[e + 6], k[7] * r2 * kvn[e + 7])}; }
        }
        __syncthreads();
        {
            pg8::f32x4 acc[3][2];
#pragma unroll
            for (int a = 0; a < 3; ++a)
#pragma unroll
                for (int m = 0; m < 2; ++m) acc[a][m] = (pg8::f32x4){0.f, 0.f, 0.f, 0.f};
#pragma unroll
            for (int ks = 0; ks < 6; ++ks) {
                bf16x8_t af[2];
#pragma unroll
                for (int m = 0; m < 2; ++m) af[m] = *(LAS const bf16x8_t*)(lds + L_CQ + (m * 16 + fr) * QP + (32 * ks + 8 * fq) * 2);
#pragma unroll
                for (int a = 0; a < 3; ++a) {
                    const bf16x8_t bfrag = *(const bf16x8_t*)(WUQ + (size_t)((3 * wid + a) * 16 + fr) * 192 + 32 * ks + 8 * fq);
#pragma unroll
                    for (int m = 0; m < 2; ++m) acc[a][m] = __builtin_amdgcn_mfma_f32_16x16x32_bf16(bfrag, af[m], acc[a][m], 0, 0, 0);
                }
            }
#pragma unroll
            for (int a = 0; a < 3; ++a) {
                const int nt = 3 * wid + a, t6 = nt % 6, col = nt * 16 + 4 * fq;
#pragma unroll
                for (int m = 0; m < 2; ++m) {
                    const int tok = m * 16 + fr, t = t0 + tok;
                    pg8::f32x4 v = acc[a][m];
                    if (t6 >= 4) {
                        pg8::f32x4 pv; pv[0] = __shfl_xor(v[0], 32); pv[1] = __shfl_xor(v[1], 32); pv[2] = __shfl_xor(v[2], 32); pv[3] = __shfl_xor(v[3], 32);
                        if (!isctx) { const int pos = t6 == 4 ? (t >> 6) : (t & 63);
#pragma unroll
                            for (int j = 0; j < 4; ++j) { const float2 cs = tab16[pos * 8 + 4 * (fq & 1) + j]; v[j] = v[j] * cs.x + (fq < 2 ? -pv[j] : pv[j]) * cs.y; } }
                    }
                    *(LAS int*)(lds + L_SQ + tok * SQP + (nt / 6) * 128 + t6 * 16 + 4 * fq) = CVT4_F8(v[0], v[1], v[2], v[3]);
                }
            }
        }
        {
            pg8::f32x4 acc[4][2];
#pragma unroll
            for (int a = 0; a < 4; ++a)
#pragma unroll
                for (int m = 0; m < 2; ++m) acc[a][m] = (pg8::f32x4){0.f, 0.f, 0.f, 0.f};
#pragma unroll
            for (int ks = 0; ks < 4; ++ks) {
                bf16x8_t af[2];
#pragma unroll
                for (int m = 0; m < 2; ++m) af[m] = *(LAS const bf16x8_t*)(lds + L_CKV + (m * 16 + fr) * KVP + (32 * ks + 8 * fq) * 2);
#pragma unroll
                for (int a = 0; a < 4; ++a) {
                    const bf16x8_t bfrag = *(const bf16x8_t*)(WUKV + (size_t)((4 * wid + a) * 16 + fr) * 128 + 32 * ks + 8 * fq);
#pragma unroll
                    for (int m = 0; m < 2; ++m) acc[a][m] = __builtin_amdgcn_mfma_f32_16x16x32_bf16(bfrag, af[m], acc[a][m], 0, 0, 0);
                }
            }
#pragma unroll
            for (int a = 0; a < 4; ++a) {
                const int n = (4 * wid + a) * 16 + 4 * fq, hh = n >> 7, d = n & 127;
                const int dst = d < 64 ? PC_KA + hh * 96 + d : PC_VA + hh * 64 + (d - 64);
#pragma unroll
                for (int m = 0; m < 2; ++m) { const pg8::f32x4 v = acc[a][m]; const int row = R0 + m * 16 + fr;
                    const int w8 = CVT4_F8(v[0], v[1], v[2], v[3]);
                    const int tl = m * 16 + fr; (void)row;
                    if (d < 64) *(LAS int*)(lds + L_SQ + tl * SQP + 512 + hh * 128 + d) = w8;
                    else { LAS unsigned char* vp = lds + L_SV + (hh * 64 + (d - 64)) * 32 + 16 * ((tl >> 2) & 1) + 4 * (tl >> 3) + (tl & 3);
                        vp[0] = (unsigned char)w8; vp[32] = (unsigned char)(w8 >> 8); vp[64] = (unsigned char)(w8 >> 16); vp[96] = (unsigned char)((unsigned)w8 >> 24); } }
                (void)dst;
            }
        }
        int tidB = tid; asm volatile("" : "+v"(tidB));
#pragma unroll
        for (int it = 0; it < 1; ++it) {
            const int w = it * NT + tidB;
            if (w < 32 * 2) {
                const int tok = w / 2, task = 72 + (w & 1), t = t0 + tok;
                bf16_t* po = POST + (size_t)(R0 + tok) * POST_LD;
                int dst, dist; const float2* tb; float scl = 1.f; bool bc = false;
                if (task < 40) { const int hd = task >> 2, half = (task >> 1) & 1, cp = task & 1;
                    dst = (task < 32 ? PC_QB : PC_KB - 8 * 64) + hd * 64 + half * 32 + cp * 8; dist = 16; tb = tab32 + (half ? (t & 63) : (t >> 6)) * 16 + cp * 8; }
                else if (task < 72) { const int q = task - 40, hd = q >> 2, cp = q & 3;
                    dst = PC_RQ + hd * 64 + cp * 8; dist = 32; tb = tab_ret + t * 32 + cp * 8; if (hd >= 4) scl = 0.125f; }
                else { const int half = task - 72; dst = PC_KA + 64 + half * 16; dist = 8; bc = true; tb = tab16 + (half ? (t & 63) : (t >> 6)) * 8; }
                float x1[8], x2[8]; unpack8(make_uint4(p1[it][0], p1[it][1], p1[it][2], p1[it][3]), x1); unpack8(make_uint4(p2[it][0], p2[it][1], p2[it][2], p2[it][3]), x2);
                if (!isctx) {
                    const float4 c0 = *(const float4*)(tb), c1 = *(const float4*)(tb + 2), c2 = *(const float4*)(tb + 4), c3 = *(const float4*)(tb + 6);
                    const float cs[8] = {c0.x, c0.z, c1.x, c1.z, c2.x, c2.z, c3.x, c3.z}, sn[8] = {c0.y, c0.w, c1.y, c1.w, c2.y, c2.w, c3.y, c3.w};
#pragma unroll
                    for (int j = 0; j < 8; ++j) { const float a = x1[j], b2 = x2[j]; x1[j] = a * cs[j] - b2 * sn[j]; x2[j] = b2 * cs[j] + a * sn[j]; }
                }
#pragma unroll
                for (int j = 0; j < 8; ++j) { x1[j] *= scl; x2[j] *= scl; }
                const uint4 o1 = make_uint4(pkbf(x1[0], x1[1]), pkbf(x1[2], x1[3]), pkbf(x1[4], x1[5]), pkbf(x1[6], x1[7]));
                const uint4 o2 = make_uint4(pkbf(x2[0], x2[1]), pkbf(x2[2], x2[3]), pkbf(x2[4], x2[5]), pkbf(x2[6], x2[7]));
                if (bc) {
                    LAS unsigned char* k8 = lds + L_SQ + tok * SQP + 512 + 64 + (task - 72) * 16;
                    typedef unsigned u32x2_t __attribute__((ext_vector_type(2)));
                    const uint2 f1 = make_uint2((unsigned)CVT4_F8(x1[0], x1[1], x1[2], x1[3]), (unsigned)CVT4_F8(x1[4], x1[5], x1[6], x1[7]));
                    const uint2 f2 = make_uint2((unsigned)CVT4_F8(x2[0], x2[1], x2[2], x2[3]), (unsigned)CVT4_F8(x2[4], x2[5], x2[6], x2[7]));
#pragma unroll
                    for (int hh = 0; hh < 4; ++hh) { *(LAS u32x2_t*)(k8 + hh * 128) = (u32x2_t){f1.x, f1.y}; *(LAS u32x2_t*)(k8 + hh * 128 + 8) = (u32x2_t){f2.x, f2.y}; }
                } else { *(uint4*)(po + dst) = o1; *(uint4*)(po + dst + dist) = o2; }
            }
        }
        __syncthreads();
        {
            const int rr = tid >> 4, pc = tid & 15;
            uint4* qd = (uint4*)(QK8 + (size_t)(R0 + rr) * 1024 + pc * 64);
#pragma unroll
            for (int j = 0; j < 4; ++j) { const u32x4_t t4 = *(LAS const u32x4_t*)(lds + L_SQ + rr * SQP + pc * 64 + j * 16); qd[j] = make_uint4(t4[0], t4[1], t4[2], t4[3]); }
            int bb, key0; if (R0 < T_LAT) { bb = R0 >> 12; key0 = R0 & (SEQ - 1); } else { bb = (R0 - T_LAT) >> 8; key0 = SEQ + ((R0 - T_LAT) & (CTXL - 1)); }
            const int vr = tid >> 1, hf = tid & 1;
            const u32x4_t t4 = *(LAS const u32x4_t*)(lds + L_SV + vr * 32 + hf * 16);
            *(uint4*)(V8T + (size_t)((bb * 4 + (vr >> 6)) * 64 + (vr & 63)) * 4352 + (key0 & ~63) + 32 * hf + 16 * ((key0 >> 5) & 1)) = make_uint4(t4[0], t4[1], t4[2], t4[3]);
        }
        if (has_next) { ra = na_; rb = nb_; rc = nc_; rk = nk_;
#pragma unroll
            for (int it = 0; it < 1; ++it) { p1[it] = n1[it]; p2[it] = n2[it]; } }
    }
#undef PREP_LOADS
#undef CVT4_F8
}
#define N_PHASES 23
#define LDS_BYTES 147456
#define LDS_MISC 131072
__device__ __forceinline__ P load_p() {
#if defined(__HIP_DEVICE_COMPILE__)
    const __attribute__((address_space(4))) P* kq = (const __attribute__((address_space(4))) P*)__builtin_amdgcn_kernarg_segment_ptr();
    asm volatile("" : "+s"(kq));
    return *kq;
#else
    return P{};
#endif
}
__global__ void __launch_bounds__(NT, 2) fwd_kernel(P p0, int lo, int hi) {
    extern __shared__ __attribute__((aligned(16))) unsigned char lds_raw[];
    float* lds = (float*)lds_raw;
    LAS unsigned char* ldsl = (LAS unsigned char*)lds_raw;
    volatile LAS unsigned* st = (volatile LAS unsigned*)(ldsl + LDS_MISC);
    if (threadIdx.x < 4) st[threadIdx.x] = 0u;
    __syncthreads();
    XcdBarrier bar; bar.bar = (unsigned*)(p0.ws + OFF_CTL); bar.x = 0; bar.st = st;
    if (hi - lo > 1) bar = xcd_barrier_post((unsigned*)(p0.ws + OFF_CTL), st);
#define IN(k) (lo <= (k) && (k) < hi)
#define PH(k) if (IN(k)) if (const P p = load_p(); true)
#define SEAM(k) do { if (IN(k) && IN((k) + 1)) xcd_barrier(bar); } while (0)
#define MOD ((const float*)(p.ws + OFF_MOD))
#define H ((bf16_t*)(p.ws + OFF_H))
#define XC ((float*)(p.ws + OFF_XC))
#define PROJ ((bf16_t*)(p.ws + OFF_PROJ))
#define ACT ((bf16_t*)(p.ws + OFF_ACT))
#define CNT ((int*)(p.ws + OFF_CNT))
#define LIST ((const int*)(p.ws + OFF_LIST))
#define WL ((const float*)(p.ws + OFF_WL))
#define WIN ((const bf16_t*)(p.ws + OFF_WIN))
#define WOUT ((const bf16_t*)(p.ws + OFF_WOUT))
#define FGU ((const bf16_t*)(p.ws + OFF_FGU))
#define FD ((const bf16_t*)(p.ws + OFF_FD))
#define MGU ((const bf16_t*)(p.ws + OFF_MGU))
#define MDW ((const bf16_t*)(p.ws + OFF_MD))
#define YB ((bf16_t*)(p.ws + OFF_Y))
#define YB2 ((bf16_t*)(p.ws + OFF_Y2))
#define PARTB ((float*)(p.ws + OFF_PART))
    const int G = gridDim.x, bid = blockIdx.x;

    PH(0) { if (bid & 1) { ph_conv_early(p, lds); ph_fgu_colmax(p); ph_win_colmax(p); __syncthreads(); ph_mod(p, lds); ph_tables(p); }
            else { ph_mod(p, lds); ph_tables(p); ph_conv_early(p, lds); ph_fgu_colmax(p); ph_win_colmax(p); } }
    SEAM(0);
    PH(1) { if (bid & 1) { ph_conv_fgu_i8(p, lds); __syncthreads(); }
            ph_norm(p, 0, 1, T_ALL, false, true, nullptr, 0, 0, 0, p.ws + OFF_QK8, false, (float*)(p.ws + OFF_RSW));
            if (!(bid & 1)) { __syncthreads(); ph_conv_fgu_i8(p, lds); } }
    SEAM(1);
    PH(2) { pg8::DenseSchedT<false, true> S{(const bf16_t*)(p.ws + OFF_QK8), WIN, 512, 512, T_ALL / 256, PROJ_LD / 256, G, bid};
            pg8::EpiWinRope E{PROJ, (bf16_t*)(p.ws + OFF_POST), (const float*)(p.ws + OFF_RSW), (const float*)(p.ws + OFF_CSW) + 0 * PROJ_LD, (const float2*)(p.ws + OFF_TAB), (const float2*)(p.ws + OFF_TAB) + 4096 * 32}; pg8::gemm_phase(ldsl, S, E); }
    SEAM(2);
    PH(3) { if (bid & 1) { ph_ret_T(p, 0, ldsl); __syncthreads(); ph_prep2(p, 0, ldsl); } else { ph_prep2(p, 0, ldsl); __syncthreads(); ph_ret_T(p, 0, ldsl); } }
    SEAM(3);
    PH(5) ph_mixer_mfma(p, 0, true, ldsl);
    SEAM(5);
    PH(6) {
        { pg8::DenseSched S{H, WOUT, 1024, 1024, T_ALL / 256, 4, G, bid};
          pg8::EpiBf16Norm E{YB, 1024, (unsigned)((size_t)T_ALL * 1024 * 2), (unsigned*)(p.ws + OFF_PCNT), 1.f};
          pg8::gemm_phase(ldsl, S, E); }
        norm_help(p, NormArgs{0, 2, false, true, YB, 0, 2048, 0, p.ws + OFF_H8D, false, (float*)(p.ws + OFF_RS8)}, (unsigned*)(p.ws + OFF_PCNT), 32u, (unsigned*)(p.ws + OFF_CLAIM), T_ALL / 256, (LAS unsigned*)(ldsl + LDS_MISC + 32));
    }
    SEAM(6);
    PH(8) { pg8::DenseSchedT<false, true> S{(const bf16_t*)(p.ws + OFF_H8D), FGU, 512, 512, T_ALL / 256, 2 * D_FF / 256, G, bid};
            pg8::EpiSwigluI8 E{ACT, D_FF, (const float*)(p.ws + OFF_RS8), (const float*)(p.ws + OFF_CS8)}; pg8::gemm_phase(ldsl, S, E); }
    SEAM(8);
    PH(9) {
        { pg8::DenseSchedT<true> S{ACT, FD, D_FF / 2, D_FF / 2, T_ALL / 256, 4, G, bid};
          pg8::EpiBf16Norm E{YB2, 1024, (unsigned)((size_t)T_ALL * 1024 * 2), (unsigned*)(p.ws + OFF_PCNT) + 136 * 64, 1.f / (F8_SA * F8_SW)};
          pg8::gemm_phase(ldsl, S, E); }
        norm_help(p, NormArgs{1, 1, false, false, YB2, 0, 5120, 0, p.ws + OFF_QK8, false, (float*)(p.ws + OFF_RSW)}, (unsigned*)(p.ws + OFF_PCNT) + 136 * 64, 32u, (unsigned*)(p.ws + OFF_CLAIM) + 64, T_ALL / 256, (LAS unsigned*)(ldsl + LDS_MISC + 32));
    }
    SEAM(9);
    PH(11) { pg8::DenseSchedT<false, true> S{(const bf16_t*)(p.ws + OFF_QK8), (WIN + (size_t)PROJ_LD * 1024), 512, 512, T_ALL / 256, PROJ_LD / 256, G, bid};
            pg8::EpiWinRope E{PROJ, (bf16_t*)(p.ws + OFF_POST), (const float*)(p.ws + OFF_RSW), (const float*)(p.ws + OFF_CSW) + 1 * PROJ_LD, (const float2*)(p.ws + OFF_TAB), (const float2*)(p.ws + OFF_TAB) + 4096 * 32}; pg8::gemm_phase(ldsl, S, E); }
    SEAM(11);
    PH(12) { if (bid & 1) { ph_ret_T(p, 1, ldsl); __syncthreads(); ph_prep2(p, 1, ldsl); } else { ph_prep2(p, 1, ldsl); __syncthreads(); ph_ret_T(p, 1, ldsl); } }
    SEAM(12);
    PH(14) ph_mixer_mfma(p, 1, false, ldsl);
    SEAM(14);
    PH(15) { pg8::DenseSched S{H, WOUT + (size_t)1024 * 1024, 1024, 1024, T_LAT / 256, 4, G, bid}; pg8::EpiBf16 E{YB, 1024}; pg8::gemm_phase(ldsl, S, E); }
    SEAM(15);
    PH(16) { if (bid & 1) { ph_conv_late(p, lds); __syncthreads(); }
             ph_norm(p, 1, 2, T_LAT, true, false, YB, 1, 2048, 0, p.ws + OFF_H, false);
             if (!(bid & 1)) { __syncthreads(); ph_conv_late(p, lds); } }
    SEAM(16);
#pragma unroll
    for (int s = 0; s < 2; ++s) {
        if (IN(17 + 2 * s) || IN(18 + 2 * s)) {
            LAS int* tab = (LAS int*)(ldsl + LDS_MISC + 64 + 128 * s);
            { const P p = load_p();
            __syncthreads();
            if (threadIdx.x < 8) tab[threadIdx.x] = __hip_atomic_load(CNT + s * 8 + (int)threadIdx.x, __ATOMIC_RELAXED, __HIP_MEMORY_SCOPE_AGENT);
            __syncthreads();
            if (threadIdx.x == 0) { int tbv = 0; tab[8] = 0;
                for (int e = 0; e < 8; ++e) { tbv += (tab[e] + 255) >> 8; tab[9 + e] = tbv; } }
            __syncthreads(); }
            const int nTm = tab[16];
            PH(17 + 2 * s) {
                if (s == 1) pg8::moe_combine((bf16_t*)(p.ws + OFF_YM), PARTB, (const LAS int*)(ldsl + LDS_MISC + 64), 4, 1.f / (F8_SA * F8_SW));
                pg8::MoeSched<true, true> S{H, MGU, 512, 512, 2 * D_FFE / 256, G, bid, (size_t)D_FFE * 1024, LIST + (size_t)s * 8 * 32768, tab, 0, nTm * (2 * D_FFE / 256), 1, 512 / 64};
                pg8::EpiSwigluT<true, true> E{ACT, D_FFE}; pg8::gemm_phase(ldsl, S, E);
            }
            SEAM(17 + 2 * s);
            PH(18 + 2 * s) {
                const int U = nTm * 4, rem = U % G, split = (rem > 0 && rem * MOE_WAYS <= G) ? 1 : 0, umain = split ? U - rem : U;
                { pg8::MoeSched<false, true> S{ACT, MDW, D_FFE / 2, D_FFE / 2, 4, G, bid, (size_t)512 * D_FFE, nullptr, tab, 0, umain, 1, D_FFE / 128};
                  pg8::EpiBf16S E{(bf16_t*)(p.ws + OFF_YM) + (size_t)s * ACT_ROWS * 1024, 1024, 1.f / (F8_SA * F8_SW)};
                  pg8::gemm_phase(ldsl, S, E); }
                if (split) { pg8::MoeSched<false, true> S{ACT, MDW, D_FFE / 2, D_FFE / 2, 4, G, bid, (size_t)512 * D_FFE, nullptr, tab, umain, U, MOE_WAYS, D_FFE / 128 / MOE_WAYS};
                  pg8::EpiPart E{PARTB}; pg8::gemm_phase(ldsl, S, E); }
            }
        }
        SEAM(18 + 2 * s);
    }
    PH(21) { const LAS int* tab1 = (const LAS int*)(ldsl + LDS_MISC + 64 + 128);
        pg8::moe_combine((bf16_t*)(p.ws + OFF_YM) + (size_t)ACT_ROWS * 1024, PARTB, tab1, 4, 1.f / (F8_SA * F8_SW)); }
    SEAM(21);
    PH(22) ph_final_moe(p, (const LAS int*)(ldsl + LDS_MISC + 64), (const LAS int*)(ldsl + LDS_MISC + 64 + 128));
}

extern "C" void kernel_launch(void* const* d_in, const int* in_sizes, int n_in, void* d_out, int out_size, void* d_ws, size_t ws_size, hipStream_t stream) {
    static int grid = 0;
    if (!grid) {
        if (n_in != 25 || out_size != T_LAT * 1024 || ws_size < WS_END) { fprintf(stderr, "kernel_launch: unexpected shapes (n_in %d out %d ws %zu need %zu)\n", n_in, out_size, ws_size, (size_t)WS_END); grid = -1; return; }
        int dev = 0, cus = 0, per_cu = 0;
        (void)hipGetDevice(&dev); (void)hipDeviceGetAttribute(&cus, hipDeviceAttributeMultiprocessorCount, dev);
        (void)hipFuncSetAttribute((const void*)fwd_kernel, hipFuncAttributeMaxDynamicSharedMemorySize, LDS_BYTES);
        (void)hipOccupancyMaxActiveBlocksPerMultiprocessor(&per_cu, (const void*)fwd_kernel, NT, LDS_BYTES);
        if (per_cu < 1) { fprintf(stderr, "kernel_launch: occupancy query says %d\n", per_cu); }
        grid = cus > 0 ? cus : 256;
    }
    if (grid < 0) return;
    (void)hipMemsetAsync((char*)d_ws + OFF_CTL, 0, CTL_BYTES, stream);
    P p{};
    for (int i = 0; i < 25; ++i) p.in[i] = (const float*)d_in[i];
    p.out = (float*)d_out; p.ws = (unsigned char*)d_ws;
    hipLaunchKernelGGL(fwd_kernel, dim3(grid), dim3(NT), LDS_BYTES, stream, p, 0, N_PHASES);
}
```
